# Optimizing an MI355X kernel written in HIP

```python
import math
import jax
import jax.numpy as jnp
from jax import lax
import numpy as np

D_MODEL = 1024
BATCH = 8
SEQ = 2048
DEPTH = 2

GRID_W = 64
CTX_LEN = 256
HEAD_DIM = 64
ROPE_BASE = 10000.0
ROPE_FREQS = HEAD_DIM // 4
LN_EPS = 1e-5
RMS_EPS = 1e-5
NEG_INF = -1e30

SWA_HEADS = 8
SWA_KV_HEADS = 2
SWA_GROUP = SWA_HEADS // SWA_KV_HEADS
SWA_WINDOW = 128
SWA_BLOCK = 128
SWA_Q_W = SWA_HEADS * HEAD_DIM
SWA_KV_W = SWA_KV_HEADS * HEAD_DIM

SSM_WIDTH = D_MODEL // 2
SSM_GROUP = 16
SSM_GROUPS = SSM_WIDTH // SSM_GROUP
SSM_STATE = 64
SSM_DT_MIN = 1e-3
SSM_DT_MAX = 1e-1

AB_IN_W = SWA_Q_W + 2 * SWA_KV_W + SSM_WIDTH
AB_OUT_W = SWA_Q_W + SSM_WIDTH

DIF_HEADS = D_MODEL // (2 * HEAD_DIM)
DIF_QK_W = DIF_HEADS * 2 * HEAD_DIM
DIF_V_HEAD = 2 * HEAD_DIM
DIF_V_W = DIF_HEADS * DIF_V_HEAD
DIF_BLOCK = 128

MOE_GROUPS = 4
MOE_EXPERTS_PER_GROUP = 8
MOE_EXPERTS = MOE_GROUPS * MOE_EXPERTS_PER_GROUP
MOE_TOPK = 2
MOE_HIDDEN = D_MODEL // 4

DEEPNORM_ALPHA = (2 * DEPTH) ** 0.25
DEEPNORM_BETA = (8 * DEPTH) ** -0.25
N_EVEN = (DEPTH + 1) // 2
N_ODD = DEPTH // 2

kernel_name = 'hybrid_swa_s5_diffattn_hmoe_dit'


def layer_norm(x, g, b):
    xf = x.astype(jnp.float32)
    mu = jnp.mean(xf, -1, keepdims=True)
    var = jnp.mean(jnp.square(xf - mu), -1, keepdims=True)
    return ((xf - mu) * lax.rsqrt(var + LN_EPS) * g + b).astype(x.dtype)


def axial_rope_tables(n_tokens):
    rows = n_tokens // GRID_W
    row = jnp.repeat(jnp.arange(rows, dtype=jnp.float32), GRID_W)
    col = jnp.tile(jnp.arange(GRID_W, dtype=jnp.float32), rows)
    inv = ROPE_BASE ** (-jnp.arange(ROPE_FREQS, dtype=jnp.float32) / ROPE_FREQS)
    ang_r = row[:, None] * inv[None, :]
    ang_c = col[:, None] * inv[None, :]
    return (jnp.cos(ang_r), jnp.sin(ang_r), jnp.cos(ang_c), jnp.sin(ang_c))


def apply_axial_rope(t, rope):
    cos_r, sin_r, cos_c, sin_c = rope
    n = t.shape[1]
    bshape = (n,) + (1,) * (t.ndim - 3) + (ROPE_FREQS,)
    tf = t.astype(jnp.float32)
    half = HEAD_DIM // 2

    def rot(u, cs, sn):
        cs = cs.reshape(bshape)
        sn = sn.reshape(bshape)
        u1, u2 = u[..., :ROPE_FREQS], u[..., ROPE_FREQS:]
        return jnp.concatenate([u1 * cs - u2 * sn, u2 * cs + u1 * sn], -1)

    out = jnp.concatenate([rot(tf[..., :half], cos_r, sin_r), rot(tf[..., half:], cos_c, sin_c)], -1)
    return out.astype(t.dtype)


def windowed_gqa_sink(q, k, v, qc, kc, vc, sink, need_ctx):
    bsz, n = q.shape[:2]
    ctx_len = kc.shape[1]
    nb = n // SWA_BLOCK
    span = 3 * SWA_BLOCK
    scale = HEAD_DIM ** -0.5
    qb = q.reshape(bsz, nb, SWA_BLOCK, SWA_KV_HEADS, SWA_GROUP, HEAD_DIM)
    pad = ((0, 0), (SWA_BLOCK, SWA_BLOCK), (0, 0), (0, 0))
    kp = jnp.pad(k, pad).reshape(bsz, nb + 2, SWA_BLOCK, SWA_KV_HEADS, HEAD_DIM)
    vp = jnp.pad(v, pad).reshape(bsz, nb + 2, SWA_BLOCK, SWA_KV_HEADS, HEAD_DIM)
    kb = jnp.concatenate([kp[:, :-2], kp[:, 1:-1], kp[:, 2:]], axis=2)
    vb = jnp.concatenate([vp[:, :-2], vp[:, 1:-1], vp[:, 2:]], axis=2)
    qi = jnp.arange(SWA_BLOCK)[:, None] + SWA_BLOCK
    ki = jnp.arange(span)[None, :]
    kabs = (jnp.arange(nb) * SWA_BLOCK - SWA_BLOCK)[:, None] + jnp.arange(span)[None, :]
    mask = (jnp.abs(qi - ki) <= SWA_WINDOW)[None] & ((kabs >= 0) & (kabs < n))[:, None, :]
    s_loc = jnp.einsum('bnqhgd,bnkhd->bnhgqk', qb, kb, preferred_element_type=jnp.float32) * scale
    s_loc = jnp.where(mask[None, :, None, None], s_loc, NEG_INF)
    s_ctx = jnp.einsum('bnqhgd,blhd->bnhgql', qb, kc, preferred_element_type=jnp.float32) * scale
    sk = sink.astype(jnp.float32).reshape(SWA_KV_HEADS, SWA_GROUP)
    s_sink = jnp.broadcast_to(sk[None, None, :, :, None, None], s_loc.shape[:-1] + (1,))
    p = jax.nn.softmax(jnp.concatenate([s_loc, s_ctx, s_sink], -1), -1).astype(v.dtype)
    o = (jnp.einsum('bnhgqk,bnkhd->bnqhgd', p[..., :span], vb)
         + jnp.einsum('bnhgql,blhd->bnqhgd', p[..., span:span + ctx_len], vc))
    o = o.reshape(bsz, n, SWA_Q_W)
    oc = None
    if need_ctx:
        sc = jnp.einsum('blhgd,bmhd->bhglm', qc, kc, preferred_element_type=jnp.float32) * scale
        sc_sink = jnp.broadcast_to(sk[None, :, :, None, None], sc.shape[:-1] + (1,))
        pc = jax.nn.softmax(jnp.concatenate([sc, sc_sink], -1), -1).astype(vc.dtype)
        oc = jnp.einsum('bhglm,bmhd->blhgd', pc[..., :ctx_len], vc).reshape(bsz, ctx_len, SWA_Q_W)
    return o, oc


def s5_discretize(a_re, a_im, log_step, b_re, b_im):
    dt = jnp.exp(log_step.astype(jnp.float32))[:, None]
    ar = a_re.astype(jnp.float32)
    ai = a_im.astype(jnp.float32)
    mag = jnp.exp(dt * ar)
    abar_re = mag * jnp.cos(dt * ai)
    abar_im = mag * jnp.sin(dt * ai)
    den = ar * ar + ai * ai
    nr = abar_re - 1.0
    coef_re = (nr * ar + abar_im * ai) / den
    coef_im = (abar_im * ar - nr * ai) / den
    br = b_re.astype(jnp.float32)
    bi = b_im.astype(jnp.float32)
    bb_re = coef_re[..., None] * br - coef_im[..., None] * bi
    bb_im = coef_re[..., None] * bi + coef_im[..., None] * br
    return abar_re, abar_im, bb_re, bb_im


def complex_linear_combine(e1, e2):
    a1r, a1i, b1r, b1i = e1
    a2r, a2i, b2r, b2i = e2
    return (a2r * a1r - a2i * a1i,
            a2r * a1i + a2i * a1r,
            a2r * b1r - a2i * b1i + b2r,
            a2r * b1i + a2i * b1r + b2i)


def s5_scan(u, abar_re, abar_im, bb_re, bb_im, reverse):
    t = u.shape[1]
    bu_re = jnp.einsum('btgc,gpc->btgp', u, bb_re)
    bu_im = jnp.einsum('btgc,gpc->btgp', u, bb_im)
    a_re = jnp.broadcast_to(abar_re, (1, t) + abar_re.shape)
    a_im = jnp.broadcast_to(abar_im, (1, t) + abar_im.shape)
    return lax.associative_scan(complex_linear_combine, (a_re, a_im, bu_re, bu_im), reverse=reverse, axis=1)


def s5_readout(s_re, s_im, c_re, c_im):
    return (jnp.einsum('btgp,gcp->btgc', s_re, c_re.astype(jnp.float32))
            - jnp.einsum('btgp,gcp->btgc', s_im, c_im.astype(jnp.float32)))


def s5_bidirectional(u, uc, a_re, a_im, log_step, b_re, b_im, c_re, c_im, d_skip, glu_w, glu_b, need_ctx):
    bsz, n = u.shape[:2]
    ctx_len = uc.shape[1]
    ug = u.astype(jnp.float32).reshape(bsz, n, SSM_GROUPS, SSM_GROUP)
    ucg = uc.astype(jnp.float32).reshape(bsz, ctx_len, SSM_GROUPS, SSM_GROUP)
    dg = d_skip.astype(jnp.float32).reshape(SSM_GROUPS, SSM_GROUP)
    y = ug * dg
    yc = ucg * dg if need_ctx else None
    for direction, reverse in ((0, False), (1, True)):
        ab_re, ab_im, bb_re, bb_im = s5_discretize(a_re[direction], a_im[direction], log_step[direction],
                                                   b_re[direction], b_im[direction])
        _, _, sc_re, sc_im = s5_scan(ucg, ab_re, ab_im, bb_re, bb_im, reverse)
        last = 0 if reverse else ctx_len - 1
        s0_re = sc_re[:, last:last + 1]
        s0_im = sc_im[:, last:last + 1]
        acc_re, acc_im, sl_re, sl_im = s5_scan(ug, ab_re, ab_im, bb_re, bb_im, reverse)
        s_re = acc_re * s0_re - acc_im * s0_im + sl_re
        s_im = acc_re * s0_im + acc_im * s0_re + sl_im
        y = y + s5_readout(s_re, s_im, c_re[direction], c_im[direction])
        if need_ctx:
            yc = yc + s5_readout(sc_re, sc_im, c_re[direction], c_im[direction])

    def glu(t):
        g = jax.nn.gelu(t.reshape(t.shape[:2] + (SSM_WIDTH,)))
        return g * jax.nn.sigmoid(g @ glu_w.astype(jnp.float32) + glu_b.astype(jnp.float32))

    out = glu(y).astype(u.dtype)
    outc = glu(yc).astype(uc.dtype) if need_ctx else None
    return out, outc


def mixer_swa_ssm(h, hc, rope, w_in, w_out, sink, a_re, a_im, log_step, b_re, b_im, c_re, c_im,
                  d_skip, glu_w, glu_b, need_ctx):
    splits = [SWA_Q_W, SWA_Q_W + SWA_KV_W, SWA_Q_W + 2 * SWA_KV_W]

    def proj(t):
        s = t.shape[:2]
        q, k, v, u = jnp.split(t @ w_in, splits, -1)
        return (q.reshape(s + (SWA_KV_HEADS, SWA_GROUP, HEAD_DIM)),
                k.reshape(s + (SWA_KV_HEADS, HEAD_DIM)),
                v.reshape(s + (SWA_KV_HEADS, HEAD_DIM)), u)

    q, k, v, u = proj(h)
    qc, kc, vc, uc = proj(hc)
    q = apply_axial_rope(q, rope)
    k = apply_axial_rope(k, rope)
    att, att_c = windowed_gqa_sink(q, k, v, qc, kc, vc, sink, need_ctx)
    ssm, ssm_c = s5_bidirectional(u, uc, a_re, a_im, log_step, b_re, b_im, c_re, c_im,
                                  d_skip, glu_w, glu_b, need_ctx)
    y = jnp.concatenate([att, ssm], -1) @ w_out
    yc = jnp.concatenate([att_c, ssm_c], -1) @ w_out if need_ctx else None
    return y, yc


def dif_head_out(o, g, lam_init):
    of = o.astype(jnp.float32)
    of = of * lax.rsqrt(jnp.mean(of * of, -1, keepdims=True) + RMS_EPS) * g.astype(jnp.float32)
    return (of * (1.0 - lam_init)).astype(o.dtype).reshape(o.shape[:2] + (DIF_V_W,))


def mixer_diff(h, hc, rope, w_in, w_out, lq1, lk1, lq2, lk2, subln_g, lam_init, need_ctx):
    bsz, n = h.shape[:2]
    scale = HEAD_DIM ** -0.5

    def proj(t):
        s = t.shape[:2]
        q, k, v = jnp.split(t @ w_in, [DIF_QK_W, 2 * DIF_QK_W], -1)
        return (q.reshape(s + (DIF_HEADS, 2, HEAD_DIM)), k.reshape(s + (DIF_HEADS, 2, HEAD_DIM)),
                v.reshape(s + (DIF_HEADS, DIF_V_HEAD)))

    q, k, v = proj(h)
    qc, kc, vc = proj(hc)
    q = apply_axial_rope(q, rope)
    k = apply_axial_rope(k, rope)
    lam = (jnp.exp(jnp.sum(lq1.astype(jnp.float32) * lk1.astype(jnp.float32)))
           - jnp.exp(jnp.sum(lq2.astype(jnp.float32) * lk2.astype(jnp.float32))) + lam_init)

    def attend(qq, kk, vv):
        s = jnp.einsum('bqhcd,bkhcd->bhcqk', qq, kk, preferred_element_type=jnp.float32) * scale
        p = jax.nn.softmax(s, -1)
        pd = (p[:, :, 0] - lam * p[:, :, 1]).astype(vv.dtype)
        return jnp.einsum('bhqk,bkhe->bqhe', pd, vv)

    kall = jnp.concatenate([k, kc], 1)
    vall = jnp.concatenate([v, vc], 1)
    nb = n // DIF_BLOCK
    qb = jnp.moveaxis(q.reshape(bsz, nb, DIF_BLOCK, DIF_HEADS, 2, HEAD_DIM), 1, 0)
    o = lax.map(lambda qq: attend(qq, kall, vall), qb)
    o = jnp.moveaxis(o, 0, 1).reshape(bsz, n, DIF_HEADS, DIF_V_HEAD)
    y = dif_head_out(o, subln_g, lam_init) @ w_out
    yc = dif_head_out(attend(qc, kc, vc), subln_g, lam_init) @ w_out if need_ctx else None
    return y, yc


def hier_moe(t, wg, bg, we, be, w1, w3, w2):
    pg = jax.nn.softmax((t @ wg).astype(jnp.float32) + bg.astype(jnp.float32), -1)
    gp, gi = lax.top_k(pg, 1)
    le = jnp.einsum('td,gde->tge', t, we).astype(jnp.float32) + be.astype(jnp.float32)
    le_sel = jnp.take_along_axis(le, gi[:, :, None], axis=1)[:, 0]
    tv, ti = lax.top_k(le_sel, MOE_TOPK)
    w_sel = jax.nn.softmax(tv, -1) * gp
    gate_e = jnp.sum(jax.nn.one_hot(ti, MOE_EXPERTS_PER_GROUP, dtype=jnp.float32) * w_sel[..., None], 1)
    gates = (jax.nn.one_hot(gi[:, 0], MOE_GROUPS, dtype=jnp.float32)[:, :, None]
             * gate_e[:, None, :]).astype(t.dtype)
    out = jnp.zeros_like(t)
    for g in range(MOE_GROUPS):
        sl = slice(g * MOE_EXPERTS_PER_GROUP, (g + 1) * MOE_EXPERTS_PER_GROUP)
        h1 = jnp.einsum('td,edf->tef', t, w1[sl])
        h3 = jnp.einsum('td,edf->tef', t, w3[sl])
        hh = jax.nn.silu(h1) * h3 * gates[:, g, :, None]
        out = out + jnp.einsum('tef,efd->td', hh, w2[sl])
    return out


def setup_inputs(seed: int = 0) -> dict:
    key = jax.random.key(seed)
    counter = [0]

    def nk():
        counter[0] += 1
        return jax.random.fold_in(key, counter[0])

    def nrm(shape, scale):
        return jax.random.normal(nk(), shape, jnp.float32) * scale

    D = D_MODEL
    NE, NO = N_EVEN, N_ODD
    G, P, C = SSM_GROUPS, SSM_STATE, SSM_GROUP
    E, F = MOE_EXPERTS, MOE_HIDDEN
    return {
        'x': nrm((BATCH, SEQ, D), 1.0),
        'c': nrm((BATCH, D), 1.0),
        'ctx': nrm((BATCH, CTX_LEN, D), 1.0),
        'c_ctx': nrm((D,), 1.0),
        'mod_w': nrm((DEPTH, D, 6 * D), D ** -0.5),
        'mod_b': nrm((DEPTH, 6 * D), 0.02),
        'ln1_g': 1.0 + nrm((DEPTH, D), 0.02),
        'ln1_b': nrm((DEPTH, D), 0.02),
        'ln2_g': 1.0 + nrm((DEPTH, D), 0.02),
        'ln2_b': nrm((DEPTH, D), 0.02),
        'swa_ssm_w_in': nrm((NE, D, AB_IN_W), D ** -0.5),
        'swa_ssm_w_out': nrm((NE, AB_OUT_W, D), AB_OUT_W ** -0.5 * DEEPNORM_BETA),
        'swa_sink': nrm((NE, SWA_HEADS), 0.5),
        'ssm_a_re': -0.5 + nrm((NE, 2, G, P), 0.01),
        'ssm_a_im': jnp.pi * jnp.arange(P, dtype=jnp.float32) + nrm((NE, 2, G, P), 0.01),
        'ssm_log_step': jax.random.uniform(nk(), (NE, 2, G), jnp.float32,
                                           math.log(SSM_DT_MIN), math.log(SSM_DT_MAX)),
        'ssm_b_re': nrm((NE, 2, G, P, C), (2 * C) ** -0.5),
        'ssm_b_im': nrm((NE, 2, G, P, C), (2 * C) ** -0.5),
        'ssm_c_re': nrm((NE, 2, G, C, P), P ** -0.5),
        'ssm_c_im': nrm((NE, 2, G, C, P), P ** -0.5),
        'ssm_d': nrm((NE, SSM_WIDTH), 1.0),
        'ssm_glu_w': nrm((NE, SSM_WIDTH, SSM_WIDTH), SSM_WIDTH ** -0.5),
        'ssm_glu_b': nrm((NE, SSM_WIDTH), 0.02),
        'dif_w_in': nrm((NO, D, 2 * DIF_QK_W + DIF_V_W), D ** -0.5),
        'dif_w_out': nrm((NO, DIF_V_W, D), DIF_V_W ** -0.5 * DEEPNORM_BETA),
        'dif_lam_q1': nrm((NO, HEAD_DIM), 0.1),
        'dif_lam_k1': nrm((NO, HEAD_DIM), 0.1),
        'dif_lam_q2': nrm((NO, HEAD_DIM), 0.1),
        'dif_lam_k2': nrm((NO, HEAD_DIM), 0.1),
        'dif_subln_g': 1.0 + nrm((NO, DIF_V_HEAD), 0.02),
        'moe_wg': nrm((DEPTH, D, MOE_GROUPS), D ** -0.5),
        'moe_bg': nrm((DEPTH, MOE_GROUPS), 0.01),
        'moe_we': nrm((DEPTH, MOE_GROUPS, D, MOE_EXPERTS_PER_GROUP), D ** -0.5),
        'moe_be': nrm((DEPTH, MOE_GROUPS, MOE_EXPERTS_PER_GROUP), 0.01),
        'moe_w1': nrm((DEPTH, E, D, F), D ** -0.5),
        'moe_w3': nrm((DEPTH, E, D, F), D ** -0.5),
        'moe_w2': nrm((DEPTH, E, F, D), F ** -0.5 * DEEPNORM_BETA),
    }


def reference(x, c, ctx, c_ctx, mod_w, mod_b, ln1_g, ln1_b, ln2_g, ln2_b,
              swa_ssm_w_in, swa_ssm_w_out, swa_sink,
              ssm_a_re, ssm_a_im, ssm_log_step, ssm_b_re, ssm_b_im, ssm_c_re, ssm_c_im,
              ssm_d, ssm_glu_w, ssm_glu_b,
              dif_w_in, dif_w_out, dif_lam_q1, dif_lam_k1, dif_lam_q2, dif_lam_k2, dif_subln_g,
              moe_wg, moe_bg, moe_we, moe_be, moe_w1, moe_w3, moe_w2):
    bsz, n, d = x.shape
    ctx_len = ctx.shape[1]
    rope = axial_rope_tables(n)
    xl, xc = x, ctx
    for layer in range(DEPTH):
        need_ctx = layer < DEPTH - 1
        i = layer // 2
        m_lat = jnp.split(jax.nn.silu(c) @ mod_w[layer] + mod_b[layer], 6, -1)
        sh1, sc1, g1, sh2, sc2, g2 = [m[:, None, :] for m in m_lat]
        csh1, csc1, cg1, csh2, csc2, cg2 = jnp.split(jax.nn.silu(c_ctx) @ mod_w[layer] + mod_b[layer], 6, -1)
        hl = xl * (1.0 + sc1) + sh1
        hc = xc * (1.0 + csc1) + csh1
        if layer % 2 == 0:
            yl, yc = mixer_swa_ssm(hl, hc, rope, swa_ssm_w_in[i], swa_ssm_w_out[i], swa_sink[i],
                                   ssm_a_re[i], ssm_a_im[i], ssm_log_step[i], ssm_b_re[i], ssm_b_im[i],
                                   ssm_c_re[i], ssm_c_im[i], ssm_d[i], ssm_glu_w[i], ssm_glu_b[i], need_ctx)
        else:
            lam_init = 0.8 - 0.6 * math.exp(-0.3 * layer)
            yl, yc = mixer_diff(hl, hc, rope, dif_w_in[i], dif_w_out[i], dif_lam_q1[i], dif_lam_k1[i],
                                dif_lam_q2[i], dif_lam_k2[i], dif_subln_g[i], lam_init, need_ctx)
        xl = layer_norm(DEEPNORM_ALPHA * xl + g1 * yl, ln1_g[layer], ln1_b[layer])
        hl = xl * (1.0 + sc2) + sh2
        if need_ctx:
            xc = layer_norm(DEEPNORM_ALPHA * xc + cg1 * yc, ln1_g[layer], ln1_b[layer])
            hc = xc * (1.0 + csc2) + csh2
            tok = jnp.concatenate([hl.reshape(-1, d), hc.reshape(-1, d)], 0)
        else:
            tok = hl.reshape(-1, d)
        f = hier_moe(tok, moe_wg[layer], moe_bg[layer], moe_we[layer], moe_be[layer],
                     moe_w1[layer], moe_w3[layer], moe_w2[layer])
        xl = layer_norm(DEEPNORM_ALPHA * xl + g2 * f[:bsz * n].reshape(bsz, n, d), ln2_g[layer], ln2_b[layer])
        if need_ctx:
            xc = layer_norm(DEEPNORM_ALPHA * xc + cg2 * f[bsz * n:].reshape(bsz, ctx_len, d),
                            ln2_g[layer], ln2_b[layer])
    return xl
```

```cpp
#ifndef HOST_EMU
#include <hip/hip_runtime.h>
#define HD __host__ __device__ __forceinline__
#else
#define HD inline
#endif
#include <stdint.h>
#include <math.h>

#ifndef CFG_D
#define CFG_D 1024
#define CFG_B 8
#define CFG_N 2048
#define CFG_CTX 256
#endif

constexpr int D = CFG_D, B = CFG_B, N = CFG_N, CTX = CFG_CTX;
constexpr int DEPTH = 2, GRID_W = 64, HD_ = 64;
constexpr int TL = B * N, TC = B * CTX, TA = TL + TC;
constexpr int SWA_H = 8, SWA_QW = 512, SWA_KVW = 128, SWA_WIN = 128;
constexpr int SSM_W = D / 2, SSM_C = 16, SSM_G = SSM_W / 16, SSM_P = 64;
constexpr int AB_IN = SWA_QW + 2 * SWA_KVW + SSM_W;
constexpr int AB_OUT = SWA_QW + SSM_W;
constexpr int A_KOFF = SWA_QW, A_VOFF = SWA_QW + SWA_KVW, A_UOFF = SWA_QW + 2 * SWA_KVW;
constexpr int DIF_H = D / 128, DIF_QK = DIF_H * 128, DIF_VW = DIF_H * 128, DIF_IN = 2 * DIF_QK + DIF_VW;
constexpr int MOE_G = 4, MOE_EPG = 8, MOE_E = 32, MOE_F = D / 4;
constexpr int SL = 64;
constexpr int SS = CTX + N;
constexpr int NCH = SS / SL;
constexpr float LN_EPS = 1e-5f, RMS_EPS = 1e-5f;
constexpr float ALPHA = 1.41421356237309515f;
static_assert(CTX % SL == 0 && N % SL == 0, "chunking");
constexpr int YW = AB_OUT > D ? AB_OUT : D;

struct Params {
  const float *x, *c, *ctx, *c_ctx, *mod_w, *mod_b, *ln1_g, *ln1_b, *ln2_g, *ln2_b;
  const float *w_in_a, *w_out_a, *sink, *a_re, *a_im, *log_step, *b_re, *b_im, *c_re, *c_im, *ssm_d, *glu_w, *glu_b;
  const float *dif_w_in, *dif_w_out, *lq1, *lk1, *lq2, *lk2, *subln_g;
  const float *moe_wg, *moe_bg, *moe_we, *moe_be, *moe_w1, *moe_w3, *moe_w2;
  float* out;
  float *X, *X1, *F, *HH, *Odif;
  uint16_t *P, *Ymix, *Gs;
  float *modv, *ropeT, *apow, *bbar, *KT, *E, *Sin, *route, *scal;
};

HD uint16_t f2bf(float f) {
  uint32_t u = __builtin_bit_cast(uint32_t, f);
  u += 0x7fffu + ((u >> 16) & 1u);
  return (uint16_t)(u >> 16);
}
HD float bf2f(uint16_t h) {
  uint32_t u = ((uint32_t)h) << 16;
  return __builtin_bit_cast(float, u);
}
HD float siluf(float x) { return x / (1.0f + expf(-x)); }
HD float sigmoidf_(float x) { return 1.0f / (1.0f + expf(-x)); }
HD float geluf_(float x) { return 0.5f * x * (1.0f + tanhf(0.7978845608028654f * (x + 0.044715f * x * x * x))); }

HD int tok_r(int t) { return t < TL ? t / N : B; }
HD const float* xrow(const Params& p, int layer, int t) {
  if (layer == 0) return t < TL ? p.x + (size_t)t * D : p.ctx + (size_t)(t - TL) * D;
  return p.X + (size_t)t * D;
}
HD const float* modp(const Params& p, int layer, int r, int which) {
  return p.modv + ((size_t)(layer * (B + 1) + r) * 6 + which) * D;
}

constexpr int N_MOD = DEPTH * (B + 1) * 6 * D;
HD void st_mod(const Params& p, int layer_unused, int idx) {
  int j = idx % (6 * D); int r = (idx / (6 * D)) % (B + 1); int l = idx / (6 * D * (B + 1));
  const float* cv = r < B ? p.c + (size_t)r * D : p.c_ctx;
  const float* w = p.mod_w + (size_t)l * D * 6 * D;
  float acc = p.mod_b[(size_t)l * 6 * D + j];
  for (int k = 0; k < D; ++k) acc += siluf(cv[k]) * w[(size_t)k * 6 * D + j];
  p.modv[idx] = acc;
}

constexpr int N_ROPE = 64 * 16;
constexpr int N_APOW = 2 * SSM_G * SSM_P * (SL + 1);
constexpr int N_BBAR = 2 * SSM_G * SSM_P * SSM_C;
constexpr int N_TABA = N_ROPE + N_APOW + N_BBAR + 1;
HD void st_taba(const Params& p, int layer_unused, int idx) {
  if (idx < N_ROPE) {
    int pos = idx / 16, f = idx % 16;
    float inv = powf(10000.0f, -(float)f / 16.0f);
    float ang = (float)pos * inv;
    p.ropeT[idx * 2] = cosf(ang); p.ropeT[idx * 2 + 1] = sinf(ang);
    return;
  }
  idx -= N_ROPE;
  if (idx < N_APOW) {
    int k = idx % (SL + 1); int q = idx / (SL + 1);
    int dg = q / SSM_P;
    double dt = exp((double)p.log_step[dg]);
    double ar = p.a_re[q], ai = p.a_im[q];
    double mag = exp(k * dt * ar);
    p.apow[(size_t)idx * 2] = (float)(mag * cos(k * dt * ai));
    p.apow[(size_t)idx * 2 + 1] = (float)(mag * sin(k * dt * ai));
    return;
  }
  idx -= N_APOW;
  if (idx < N_BBAR) {
    int cc = idx % SSM_C; int q = idx / SSM_C; int dg = q / SSM_P;
    (void)cc;
    double dt = exp((double)p.log_step[dg]);
    double ar = p.a_re[q], ai = p.a_im[q];
    double mag = exp(dt * ar);
    double abr = mag * cos(dt * ai), abi = mag * sin(dt * ai);
    double den = ar * ar + ai * ai, nr = abr - 1.0;
    double cr = (nr * ar + abi * ai) / den, ci = (abi * ar - nr * ai) / den;
    double br = p.b_re[idx], bi = p.b_im[idx];
    p.bbar[(size_t)idx * 2] = (float)(cr * br - ci * bi);
    p.bbar[(size_t)idx * 2 + 1] = (float)(cr * bi + ci * br);
    return;
  }
  double s1 = 0, s2 = 0;
  for (int i = 0; i < HD_; ++i) { s1 += (double)p.lq1[i] * p.lk1[i]; s2 += (double)p.lq2[i] * p.lk2[i]; }
  double lam_init = 0.8 - 0.6 * exp(-0.3 * 1.0);
  p.scal[0] = (float)(exp(s1) - exp(s2) + lam_init);
  p.scal[1] = (float)(1.0 - lam_init);
}

constexpr int N_KT = 2 * SSM_G * SL * SSM_C * SSM_C;
HD void st_tabb(const Params& p, int layer_unused, int idx) {
  int ci = idx % SSM_C; int co = (idx / SSM_C) % SSM_C; int k = (idx / (SSM_C * SSM_C)) % SL; int dg = idx / (SSM_C * SSM_C * SL);
  float acc = 0.f;
  for (int pp = 0; pp < SSM_P; ++pp) {
    int q = dg * SSM_P + pp;
    float ar = p.apow[((size_t)q * (SL + 1) + k) * 2], ai = p.apow[((size_t)q * (SL + 1) + k) * 2 + 1];
    float br = p.bbar[((size_t)q * SSM_C + ci) * 2], bi = p.bbar[((size_t)q * SSM_C + ci) * 2 + 1];
    float cr = p.c_re[((size_t)dg * SSM_C + co) * SSM_P + pp], cim = p.c_im[((size_t)dg * SSM_C + co) * SSM_P + pp];
    float tr = ar * br - ai * bi, ti = ar * bi + ai * br;
    acc += cr * tr - cim * ti;
  }
  p.KT[idx] = acc;
}

HD void st_proj(const Params& p, int layer, int idx) {
  const int W = layer == 0 ? AB_IN : DIF_IN;
  const float* w = layer == 0 ? p.w_in_a : p.dif_w_in;
  const int rope_end = layer == 0 ? (SWA_QW + SWA_KVW) : (2 * DIF_QK);
  int t = idx / W, n = idx % W;
  int r = tok_r(t);
  if (layer == 1 && t >= TL && n < DIF_QK) return;
  const float* xr = xrow(p, layer, t);
  const float* sh = modp(p, layer, r, 0);
  const float* sc = modp(p, layer, r, 1);
  bool rope = (t < TL) && (n < rope_end);
  if (!rope) {
    float acc = 0.f;
    for (int k = 0; k < D; ++k) { float h = xr[k] * (1.0f + sc[k]) + sh[k]; acc += h * w[(size_t)k * W + n]; }
    p.P[(size_t)t * W + n] = f2bf(acc);
    return;
  }
  int d = n % 64, sub = d % 32;
  if (sub >= 16) return;
  float a1 = 0.f, a2 = 0.f;
  for (int k = 0; k < D; ++k) {
    float h = xr[k] * (1.0f + sc[k]) + sh[k];
    a1 += h * w[(size_t)k * W + n]; a2 += h * w[(size_t)k * W + n + 16];
  }
  int i = t % N;
  int pos = d < 32 ? i / GRID_W : i % GRID_W;
  float cs = p.ropeT[(pos * 16 + sub) * 2], sn = p.ropeT[(pos * 16 + sub) * 2 + 1];
  p.P[(size_t)t * W + n] = f2bf(a1 * cs - a2 * sn);
  p.P[(size_t)t * W + n + 16] = f2bf(a2 * cs + a1 * sn);
}

HD void st_swa(const Params& p, int layer, int idx) {
  int hq = idx / TA, t = idx % TA;
  int kvh = hq / 4;
  const uint16_t* P = p.P;
  float q[64], o[64];
  _Pragma("unroll") for (int d = 0; d < 64; ++d) { q[d] = bf2f(P[(size_t)t * AB_IN + hq * 64 + d]) * 0.125f; o[d] = 0.f; }
  float m = p.sink[hq], l = 1.0f;
  int b = t < TL ? t / N : (t - TL) / CTX;
  int nloc = t < TL ? 2 * SWA_WIN + 1 : 0;
  int i = t < TL ? t % N : 0;
  for (int kk = 0; kk < nloc + CTX; ++kk) {
    int row;
    if (kk < nloc) {
      int j = i - SWA_WIN + kk;
      if (j < 0 || j >= N) continue;
      row = b * N + j;
    } else row = TL + b * CTX + (kk - nloc);
    const uint16_t* kr = P + (size_t)row * AB_IN + A_KOFF + kvh * 64;
    const uint16_t* vr = P + (size_t)row * AB_IN + A_VOFF + kvh * 64;
    float s = 0.f;
    _Pragma("unroll") for (int d = 0; d < 64; ++d) s += q[d] * bf2f(kr[d]);
    if (s > m) { float f = expf(m - s); l *= f; for (int d = 0; d < 64; ++d) o[d] *= f; m = s; }
    float pe = expf(s - m);
    l += pe;
    _Pragma("unroll") for (int d = 0; d < 64; ++d) o[d] += pe * bf2f(vr[d]);
  }
  float il = 1.0f / l;
  _Pragma("unroll") for (int d = 0; d < 64; ++d) p.Ymix[(size_t)t * YW + hq * 64 + d] = f2bf(o[d] * il);
}

HD int ssm_row(int dir, int b, int tau) {
  if (dir == 0) return tau < CTX ? TL + b * CTX + tau : b * N + (tau - CTX);
  return tau < CTX ? TL + b * CTX + (CTX - 1 - tau) : b * N + (N - 1 - (tau - CTX));
}
constexpr int N_SSME = 2 * B * NCH * SSM_G * SSM_P;
HD void st_ssm_e(const Params& p, int layer, int idx) {
  int pp = idx % SSM_P; int g = (idx / SSM_P) % SSM_G; int ch = (idx / (SSM_P * SSM_G)) % NCH;
  int b = (idx / (SSM_P * SSM_G * NCH)) % B; int dir = idx / (SSM_P * SSM_G * NCH * B);
  int q = (dir * SSM_G + g) * SSM_P + pp;
  float er = 0.f, ei = 0.f;
  for (int j = 0; j < SL; ++j) {
    int row = ssm_row(dir, b, ch * SL + j);
    const uint16_t* u = p.P + (size_t)row * AB_IN + A_UOFF + g * 16;
    float vr = 0.f, vi = 0.f;
    _Pragma("unroll") for (int cc = 0; cc < 16; ++cc) {
      float uv = bf2f(u[cc]);
      vr += p.bbar[((size_t)q * 16 + cc) * 2] * uv; vi += p.bbar[((size_t)q * 16 + cc) * 2 + 1] * uv;
    }
    float ar = p.apow[((size_t)q * (SL + 1) + (SL - 1 - j)) * 2], ai = p.apow[((size_t)q * (SL + 1) + (SL - 1 - j)) * 2 + 1];
    er += ar * vr - ai * vi; ei += ar * vi + ai * vr;
  }
  p.E[(size_t)idx * 2] = er; p.E[(size_t)idx * 2 + 1] = ei;
}
constexpr int N_SSMC = 2 * B * SSM_G * SSM_P;
HD void st_ssm_c(const Params& p, int layer, int idx) {
  int pp = idx % SSM_P; int g = (idx / SSM_P) % SSM_G; int b = (idx / (SSM_P * SSM_G)) % B; int dir = idx / (SSM_P * SSM_G * B);
  int q = (dir * SSM_G + g) * SSM_P + pp;
  float ar = p.apow[((size_t)q * (SL + 1) + SL) * 2], ai = p.apow[((size_t)q * (SL + 1) + SL) * 2 + 1];
  float sr = 0.f, si = 0.f;
  for (int ch = 0; ch < NCH; ++ch) {
    size_t e = ((((size_t)dir * B + b) * NCH + ch) * SSM_G + g) * SSM_P + pp;
    p.Sin[e * 2] = sr; p.Sin[e * 2 + 1] = si;
    float er = p.E[e * 2], ei = p.E[e * 2 + 1];
    float nr = ar * sr - ai * si + er, ni = ar * si + ai * sr + ei;
    sr = nr; si = ni;
  }
}
HD void st_ssm_o(const Params& p, int layer, int idx) {
  int t = idx / SSM_W, n = idx % SSM_W; int g = n / 16, co = n % 16;
  int b, dirtau[2];
  if (t < TL) { b = t / N; int i = t % N; dirtau[0] = CTX + i; dirtau[1] = CTX + (N - 1 - i); }
  else { b = (t - TL) / CTX; int i = (t - TL) % CTX; dirtau[0] = i; dirtau[1] = CTX - 1 - i; }
  float y = p.ssm_d[n] * bf2f(p.P[(size_t)t * AB_IN + A_UOFF + n]);
  for (int dir = 0; dir < 2; ++dir) {
    int tau = dirtau[dir]; int ch = tau / SL, j = tau % SL;
    int dg = dir * SSM_G + g;
    size_t e0 = ((((size_t)dir * B + b) * NCH + ch) * SSM_G + g) * SSM_P;
    for (int pp = 0; pp < SSM_P; ++pp) {
      int q = dg * SSM_P + pp;
      float ar = p.apow[((size_t)q * (SL + 1) + (j + 1)) * 2], ai = p.apow[((size_t)q * (SL + 1) + (j + 1)) * 2 + 1];
      float sr = p.Sin[(e0 + pp) * 2], si = p.Sin[(e0 + pp) * 2 + 1];
      float tr = ar * sr - ai * si, ti = ar * si + ai * sr;
      float cr = p.c_re[((size_t)dg * 16 + co) * SSM_P + pp], cim = p.c_im[((size_t)dg * 16 + co) * SSM_P + pp];
      y += cr * tr - cim * ti;
    }
    for (int j2 = 0; j2 <= j; ++j2) {
      int row = ssm_row(dir, b, ch * SL + j2);
      const uint16_t* u = p.P + (size_t)row * AB_IN + A_UOFF + g * 16;
      const float* kt = p.KT + (((size_t)dg * SL + (j - j2)) * 16 + co) * 16;
      _Pragma("unroll") for (int ci = 0; ci < 16; ++ci) y += kt[ci] * bf2f(u[ci]);
    }
  }
  p.Gs[(size_t)t * SSM_W + n] = f2bf(geluf_(y));
}
HD void st_glu(const Params& p, int layer, int idx) {
  int t = idx / SSM_W, n = idx % SSM_W;
  float z = p.glu_b[n];
  const uint16_t* g = p.Gs + (size_t)t * SSM_W;
  for (int k = 0; k < SSM_W; ++k) z += bf2f(g[k]) * p.glu_w[(size_t)k * SSM_W + n];
  p.Ymix[(size_t)t * YW + SWA_QW + n] = f2bf(bf2f(g[n]) * sigmoidf_(z));
}

HD void st_dif(const Params& p, int layer, int idx) {
  int t = idx % TL; int he = idx / TL; int eh = he % 2, h = he / 2;
  int b = t / N;
  const uint16_t* P = p.P;
  float res[64];
  float lam = p.scal[0];
  _Pragma("unroll") for (int c = 0; c < 2; ++c) {
    float q[64], o[64];
    _Pragma("unroll") for (int d = 0; d < 64; ++d) { q[d] = bf2f(P[(size_t)t * DIF_IN + h * 128 + c * 64 + d]) * 0.125f; o[d] = 0.f; }
    float m = -1e30f, l = 0.f;
    for (int kk = 0; kk < N + CTX; ++kk) {
      int row = kk < N ? b * N + kk : TL + b * CTX + (kk - N);
      const uint16_t* kr = P + (size_t)row * DIF_IN + DIF_QK + h * 128 + c * 64;
      const uint16_t* vr = P + (size_t)row * DIF_IN + 2 * DIF_QK + h * 128 + eh * 64;
      float s = 0.f;
      _Pragma("unroll") for (int d = 0; d < 64; ++d) s += q[d] * bf2f(kr[d]);
      if (s > m) { float f = expf(m - s); l *= f; for (int d = 0; d < 64; ++d) o[d] *= f; m = s; }
      float pe = expf(s - m);
      l += pe;
      _Pragma("unroll") for (int d = 0; d < 64; ++d) o[d] += pe * bf2f(vr[d]);
    }
    float il = 1.0f / l;
    if (c == 0) { for (int d = 0; d < 64; ++d) res[d] = o[d] * il; }
    else { for (int d = 0; d < 64; ++d) res[d] -= lam * o[d] * il; }
  }
  _Pragma("unroll") for (int d = 0; d < 64; ++d) p.Odif[(size_t)t * D + h * 128 + eh * 64 + d] = res[d];
}
HD void st_difnorm(const Params& p, int layer, int idx) {
  int t = idx / DIF_H, h = idx % DIF_H;
  const float* o = p.Odif + (size_t)t * D + h * 128;
  float ss = 0.f;
  _Pragma("unroll") for (int e = 0; e < 128; ++e) ss += o[e] * o[e];
  float r = 1.0f / sqrtf(ss / 128.0f + RMS_EPS) * p.scal[1];
  _Pragma("unroll") for (int e = 0; e < 128; ++e) p.Ymix[(size_t)t * YW + h * 128 + e] = f2bf(o[e] * r * p.subln_g[e]);
}

HD void st_outproj(const Params& p, int layer, int idx) {
  int t = idx / D, n = idx % D;
  const float* w = layer == 0 ? p.w_out_a : p.dif_w_out;
  const uint16_t* y = p.Ymix + (size_t)t * YW;
  const int KW = layer == 0 ? AB_OUT : DIF_VW;
  float acc = 0.f;
  for (int k = 0; k < KW; ++k) acc += bf2f(y[k]) * w[(size_t)k * D + n];
  p.F[(size_t)t * D + n] = acc;
}
HD void st_ln1(const Params& p, int layer, int t) {
  int r = tok_r(t);
  const float* xr = xrow(p, layer, t); const float* g1 = modp(p, layer, r, 2);
  const float* y = p.F + (size_t)t * D;
  float mu = 0.f;
  for (int k = 0; k < D; ++k) mu += ALPHA * xr[k] + g1[k] * y[k];
  mu /= D;
  float var = 0.f;
  for (int k = 0; k < D; ++k) { float v = ALPHA * xr[k] + g1[k] * y[k] - mu; var += v * v; }
  var /= D;
  float rs = 1.0f / sqrtf(var + LN_EPS);
  const float* lg = p.ln1_g + (size_t)layer * D; const float* lb = p.ln1_b + (size_t)layer * D;
  for (int k = 0; k < D; ++k) p.X1[(size_t)t * D + k] = (ALPHA * xr[k] + g1[k] * y[k] - mu) * rs * lg[k] + lb[k];
}
HD void st_route(const Params& p, int layer, int t) {
  int r = tok_r(t);
  const float* x1 = p.X1 + (size_t)t * D; const float* sh = modp(p, layer, r, 3); const float* sc = modp(p, layer, r, 4);
  float lg[MOE_G];
  _Pragma("unroll") for (int g = 0; g < MOE_G; ++g) lg[g] = p.moe_bg[layer * MOE_G + g];
  const float* wg = p.moe_wg + (size_t)layer * D * MOE_G;
  for (int k = 0; k < D; ++k) {
    float h = x1[k] * (1.0f + sc[k]) + sh[k];
    _Pragma("unroll") for (int g = 0; g < MOE_G; ++g) lg[g] += h * wg[k * MOE_G + g];
  }
  int gi = 0; float mx = lg[0];
  _Pragma("unroll") for (int g = 1; g < MOE_G; ++g) if (lg[g] > mx) { mx = lg[g]; gi = g; }
  float den = 0.f;
  _Pragma("unroll") for (int g = 0; g < MOE_G; ++g) den += expf(lg[g] - mx);
  float gp = 1.0f / den;
  float le[MOE_EPG];
  _Pragma("unroll") for (int e = 0; e < MOE_EPG; ++e) le[e] = p.moe_be[(layer * MOE_G + gi) * MOE_EPG + e];
  const float* we = p.moe_we + ((size_t)layer * MOE_G + gi) * D * MOE_EPG;
  for (int k = 0; k < D; ++k) {
    float h = x1[k] * (1.0f + sc[k]) + sh[k];
    _Pragma("unroll") for (int e = 0; e < MOE_EPG; ++e) le[e] += h * we[k * MOE_EPG + e];
  }
  int i0 = 0; float v0 = le[0];
  _Pragma("unroll") for (int e = 1; e < MOE_EPG; ++e) if (le[e] > v0) { v0 = le[e]; i0 = e; }
  int i1 = -1; float v1 = -3e38f;
  _Pragma("unroll") for (int e = 0; e < MOE_EPG; ++e) if (e != i0 && le[e] > v1) { v1 = le[e]; i1 = e; }
  float e1 = expf(v1 - v0);
  float w0 = gp / (1.0f + e1), w1 = gp * e1 / (1.0f + e1);
  p.route[(size_t)t * 4 + 0] = (float)(gi * MOE_EPG + i0);
  p.route[(size_t)t * 4 + 1] = (float)(gi * MOE_EPG + i1);
  p.route[(size_t)t * 4 + 2] = w0;
  p.route[(size_t)t * 4 + 3] = w1;
}
HD void st_moe_h(const Params& p, int layer, int idx) {
  int f = idx % MOE_F; int j = (idx / MOE_F) % 2; int t = idx / (2 * MOE_F);
  int r = tok_r(t);
  const float* x1 = p.X1 + (size_t)t * D; const float* sh = modp(p, layer, r, 3); const float* sc = modp(p, layer, r, 4);
  int e = (int)p.route[(size_t)t * 4 + j]; float wgt = p.route[(size_t)t * 4 + 2 + j];
  const float* w1 = p.moe_w1 + ((size_t)layer * MOE_E + e) * D * MOE_F;
  const float* w3 = p.moe_w3 + ((size_t)layer * MOE_E + e) * D * MOE_F;
  float h1 = 0.f, h3 = 0.f;
  for (int k = 0; k < D; ++k) {
    float h = x1[k] * (1.0f + sc[k]) + sh[k];
    h1 += h * w1[(size_t)k * MOE_F + f]; h3 += h * w3[(size_t)k * MOE_F + f];
  }
  p.HH[(size_t)idx] = siluf(h1) * h3 * wgt;
}
HD void st_moe_o(const Params& p, int layer, int idx) {
  int t = idx / D, n = idx % D;
  float acc = 0.f;
  for (int j = 0; j < 2; ++j) {
    int e = (int)p.route[(size_t)t * 4 + j];
    const float* w2 = p.moe_w2 + ((size_t)layer * MOE_E + e) * MOE_F * D;
    const float* hh = p.HH + ((size_t)t * 2 + j) * MOE_F;
    for (int f = 0; f < MOE_F; ++f) acc += hh[f] * w2[(size_t)f * D + n];
  }
  p.F[(size_t)t * D + n] = acc;
}
HD void st_ln2(const Params& p, int layer, int t) {
  int r = tok_r(t);
  const float* x1 = p.X1 + (size_t)t * D; const float* g2 = modp(p, layer, r, 5);
  const float* y = p.F + (size_t)t * D;
  float mu = 0.f;
  for (int k = 0; k < D; ++k) mu += ALPHA * x1[k] + g2[k] * y[k];
  mu /= D;
  float var = 0.f;
  for (int k = 0; k < D; ++k) { float v = ALPHA * x1[k] + g2[k] * y[k] - mu; var += v * v; }
  var /= D;
  float rs = 1.0f / sqrtf(var + LN_EPS);
  const float* lg = p.ln2_g + (size_t)layer * D; const float* lb = p.ln2_b + (size_t)layer * D;
  float* dst = layer == DEPTH - 1 ? p.out + (size_t)t * D : p.X + (size_t)t * D;
  for (int k = 0; k < D; ++k) dst[k] = (ALPHA * x1[k] + g2[k] * y[k] - mu) * rs * lg[k] + lb[k];
}

enum { S_MOD, S_TABA, S_TABB, S_PROJ, S_SWA, S_SSME, S_SSMC, S_SSMO, S_GLU, S_DIF, S_DIFNORM, S_OUTPROJ, S_LN1, S_ROUTE, S_MOEH, S_MOEO, S_LN2 };
template <int S> HD void run_elem(const Params& p, int layer, int idx) {
  if (S == S_MOD) st_mod(p, layer, idx);
  else if (S == S_TABA) st_taba(p, layer, idx);
  else if (S == S_TABB) st_tabb(p, layer, idx);
  else if (S == S_PROJ) st_proj(p, layer, idx);
  else if (S == S_SWA) st_swa(p, layer, idx);
  else if (S == S_SSME) st_ssm_e(p, layer, idx);
  else if (S == S_SSMC) st_ssm_c(p, layer, idx);
  else if (S == S_SSMO) st_ssm_o(p, layer, idx);
  else if (S == S_GLU) st_glu(p, layer, idx);
  else if (S == S_DIF) st_dif(p, layer, idx);
  else if (S == S_DIFNORM) st_difnorm(p, layer, idx);
  else if (S == S_OUTPROJ) st_outproj(p, layer, idx);
  else if (S == S_LN1) st_ln1(p, layer, idx);
  else if (S == S_ROUTE) st_route(p, layer, idx);
  else if (S == S_MOEH) st_moe_h(p, layer, idx);
  else if (S == S_MOEO) st_moe_o(p, layer, idx);
  else if (S == S_LN2) st_ln2(p, layer, idx);
}

struct WsLayout {
  size_t X, X1, P, Ymix, Gs, modv, ropeT, apow, bbar, KT, E, Sin, route, scal, total;
};
inline WsLayout ws_layout() {
  WsLayout L; size_t o = 0;
  auto take = [&](size_t bytes) { size_t r = o; o += (bytes + 255) & ~(size_t)255; return r; };
  L.X = take((size_t)TA * D * 4);
  L.X1 = take((size_t)TA * D * 4);
  L.P = take((size_t)TA * (AB_IN > DIF_IN ? AB_IN : DIF_IN) * 2);
  L.Ymix = take((size_t)TA * YW * 2);
  L.Gs = take((size_t)TA * SSM_W * 2);
  L.modv = take((size_t)N_MOD * 4);
  L.ropeT = take((size_t)N_ROPE * 2 * 4);
  L.apow = take((size_t)N_APOW * 2 * 4);
  L.bbar = take((size_t)N_BBAR * 2 * 4);
  L.KT = take((size_t)N_KT * 4);
  L.E = take((size_t)N_SSME * 2 * 4);
  L.Sin = take((size_t)N_SSME * 2 * 4);
  L.route = take((size_t)TA * 4 * 4);
  L.scal = take(256);
  L.total = o;
  return L;
}
inline void fill_ws(Params& p, char* ws) {
  WsLayout L = ws_layout();
  p.X = (float*)(ws + L.X); p.X1 = (float*)(ws + L.X1); p.P = (uint16_t*)(ws + L.P); p.F = (float*)(ws + L.P);
  p.Ymix = (uint16_t*)(ws + L.Ymix); p.HH = (float*)(ws + L.Ymix); p.Odif = (float*)(ws + L.X1);
  p.Gs = (uint16_t*)(ws + L.Gs); p.modv = (float*)(ws + L.modv); p.ropeT = (float*)(ws + L.ropeT);
  p.apow = (float*)(ws + L.apow); p.bbar = (float*)(ws + L.bbar); p.KT = (float*)(ws + L.KT);
  p.E = (float*)(ws + L.E); p.Sin = (float*)(ws + L.Sin); p.route = (float*)(ws + L.route); p.scal = (float*)(ws + L.scal);
}
inline void fill_inputs(Params& p, void* const* d_in) {
  const float* const* in = (const float* const*)d_in;
  p.x = in[0]; p.c = in[1]; p.ctx = in[2]; p.c_ctx = in[3]; p.mod_w = in[4]; p.mod_b = in[5];
  p.ln1_g = in[6]; p.ln1_b = in[7]; p.ln2_g = in[8]; p.ln2_b = in[9];
  p.w_in_a = in[10]; p.w_out_a = in[11]; p.sink = in[12]; p.a_re = in[13]; p.a_im = in[14]; p.log_step = in[15];
  p.b_re = in[16]; p.b_im = in[17]; p.c_re = in[18]; p.c_im = in[19]; p.ssm_d = in[20]; p.glu_w = in[21]; p.glu_b = in[22];
  p.dif_w_in = in[23]; p.dif_w_out = in[24]; p.lq1 = in[25]; p.lk1 = in[26]; p.lq2 = in[27]; p.lk2 = in[28]; p.subln_g = in[29];
  p.moe_wg = in[30]; p.moe_bg = in[31]; p.moe_we = in[32]; p.moe_be = in[33]; p.moe_w1 = in[34]; p.moe_w3 = in[35]; p.moe_w2 = in[36];
}

#define FORWARD_PROGRAM(RUN)                                   \
  RUN(S_MOD, 0, N_MOD)                                         \
  RUN(S_TABA, 0, N_TABA)                                       \
  RUN(S_TABB, 0, N_KT)                                         \
                                                   \
  RUN(S_PROJ, 0, TA * AB_IN)                                   \
  RUN(S_SWA, 0, SWA_H * TA)                                    \
  RUN(S_SSME, 0, N_SSME)                                       \
  RUN(S_SSMC, 0, N_SSMC)                                       \
  RUN(S_SSMO, 0, TA * SSM_W)                                   \
  RUN(S_GLU, 0, TA * SSM_W)                                    \
  RUN(S_OUTPROJ, 0, TA * D)                                    \
  RUN(S_LN1, 0, TA)                                            \
  RUN(S_ROUTE, 0, TA)                                          \
  RUN(S_MOEH, 0, TA * 2 * MOE_F)                               \
  RUN(S_MOEO, 0, TA * D)                                       \
  RUN(S_LN2, 0, TA)                                            \
                                                   \
  RUN(S_PROJ, 1, TA * DIF_IN)                                  \
  RUN(S_DIF, 1, DIF_H * 2 * TL)                                \
  RUN(S_DIFNORM, 1, TL * DIF_H)                                \
  RUN(S_OUTPROJ, 1, TL * D)                                    \
  RUN(S_LN1, 1, TL)                                            \
  RUN(S_ROUTE, 1, TL)                                          \
  RUN(S_MOEH, 1, TL * 2 * MOE_F)                               \
  RUN(S_MOEO, 1, TL * D)                                       \
  RUN(S_LN2, 1, TL)

#ifndef HOST_EMU
template <int S> __global__ void __launch_bounds__(256) stage_kernel(Params p, int layer, int n) {
  for (int idx = blockIdx.x * 256 + threadIdx.x; idx < n; idx += gridDim.x * 256) run_elem<S>(p, layer, idx);
}

extern "C" void kernel_launch(void* const* d_in, const int* in_sizes, int n_in, void* d_out, int out_size, void* d_ws,
                              size_t ws_size, hipStream_t stream) {
  Params p{};
  fill_inputs(p, d_in);
  p.out = (float*)d_out;
  fill_ws(p, (char*)d_ws);
#define RUN_GPU(S, layer, cnt)                                                                  \
  {                                                                                             \
    int n_ = (cnt);                                                                             \
    int blocks_ = (n_ + 255) / 256;                                                             \
    if (blocks_ > 65536) blocks_ = 65536;                                                       \
    stage_kernel<S><<<blocks_, 256, 0, stream>>>(p, layer, n_);                                 \
  }
  FORWARD_PROGRAM(RUN_GPU)
}
#endif
```

```cpp
#ifndef HOST_EMU
#include <hip/hip_runtime.h>
#define HD __host__ __device__ __forceinline__
#else
#define HD inline
#endif
#include <stdint.h>
#include <math.h>

#ifndef CFG_D
#define CFG_D 1024
#define CFG_B 8
#define CFG_N 2048
#define CFG_CTX 256
#endif

constexpr int D = CFG_D, B = CFG_B, N = CFG_N, CTX = CFG_CTX;
constexpr int DEPTH = 2, GRID_W = 64, HD_ = 64;
constexpr int TL = B * N, TC = B * CTX, TA = TL + TC;
constexpr int SWA_H = 8, SWA_QW = 512, SWA_KVW = 128, SWA_WIN = 128;
constexpr int SSM_W = D / 2, SSM_C = 16, SSM_G = SSM_W / 16, SSM_P = 64;
constexpr int AB_IN = SWA_QW + 2 * SWA_KVW + SSM_W;
constexpr int AB_OUT = SWA_QW + SSM_W;
constexpr int A_KOFF = SWA_QW, A_VOFF = SWA_QW + SWA_KVW, A_UOFF = SWA_QW + 2 * SWA_KVW;
constexpr int DIF_H = D / 128, DIF_QK = DIF_H * 128, DIF_VW = DIF_H * 128, DIF_IN = 2 * DIF_QK + DIF_VW;
constexpr int MOE_G = 4, MOE_EPG = 8, MOE_E = 32, MOE_F = D / 4;
constexpr int SL = 64;
constexpr int SS = CTX + N;
constexpr int NCH = SS / SL;
constexpr float LN_EPS = 1e-5f, RMS_EPS = 1e-5f;
constexpr float ALPHA = 1.41421356237309515f;
static_assert(CTX % SL == 0 && N % SL == 0, "chunking");
constexpr int YW = AB_OUT > D ? AB_OUT : D;

struct Params {
  const float *x, *c, *ctx, *c_ctx, *mod_w, *mod_b, *ln1_g, *ln1_b, *ln2_g, *ln2_b;
  const float *w_in_a, *w_out_a, *sink, *a_re, *a_im, *log_step, *b_re, *b_im, *c_re, *c_im, *ssm_d, *glu_w, *glu_b;
  const float *dif_w_in, *dif_w_out, *lq1, *lk1, *lq2, *lk2, *subln_g;
  const float *moe_wg, *moe_bg, *moe_we, *moe_be, *moe_w1, *moe_w3, *moe_w2;
  float* out;
  float *X, *X1, *F, *HH, *Odif;
  uint16_t *P, *Ymix, *Gs;
  float *modv, *ropeT, *apow, *bbar, *KT, *E, *Sin, *route, *scal;
};

HD uint16_t f2bf(float f) {
  uint32_t u = __builtin_bit_cast(uint32_t, f);
  u += 0x7fffu + ((u >> 16) & 1u);
  return (uint16_t)(u >> 16);
}
HD float bf2f(uint16_t h) {
  uint32_t u = ((uint32_t)h) << 16;
  return __builtin_bit_cast(float, u);
}
HD float siluf(float x) { return x / (1.0f + expf(-x)); }
HD float sigmoidf_(float x) { return 1.0f / (1.0f + expf(-x)); }
HD float geluf_(float x) { return 0.5f * x * (1.0f + tanhf(0.7978845608028654f * (x + 0.044715f * x * x * x))); }

HD int tok_r(int t) { return t < TL ? t / N : B; }
HD const float* xrow(const Params& p, int layer, int t) {
  if (layer == 0) return t < TL ? p.x + (size_t)t * D : p.ctx + (size_t)(t - TL) * D;
  return p.X + (size_t)t * D;
}
HD const float* modp(const Params& p, int layer, int r, int which) {
  return p.modv + ((size_t)(layer * (B + 1) + r) * 6 + which) * D;
}

constexpr int N_MOD = DEPTH * (B + 1) * 6 * D;
HD void st_mod(const Params& p, int layer_unused, int idx) {
  int j = idx % (6 * D); int r = (idx / (6 * D)) % (B + 1); int l = idx / (6 * D * (B + 1));
  const float* cv = r < B ? p.c + (size_t)r * D : p.c_ctx;
  const float* w = p.mod_w + (size_t)l * D * 6 * D;
  float acc = p.mod_b[(size_t)l * 6 * D + j];
  for (int k = 0; k < D; ++k) acc += siluf(cv[k]) * w[(size_t)k * 6 * D + j];
  p.modv[idx] = acc;
}

constexpr int N_ROPE = 64 * 16;
constexpr int N_APOW = 2 * SSM_G * SSM_P * (SL + 1);
constexpr int N_BBAR = 2 * SSM_G * SSM_P * SSM_C;
constexpr int N_TABA = N_ROPE + N_APOW + N_BBAR + 1;
HD void st_taba(const Params& p, int layer_unused, int idx) {
  if (idx < N_ROPE) {
    int pos = idx / 16, f = idx % 16;
    float inv = powf(10000.0f, -(float)f / 16.0f);
    float ang = (float)pos * inv;
    p.ropeT[idx * 2] = cosf(ang); p.ropeT[idx * 2 + 1] = sinf(ang);
    return;
  }
  idx -= N_ROPE;
  if (idx < N_APOW) {
    int k = idx % (SL + 1); int q = idx / (SL + 1);
    int dg = q / SSM_P;
    double dt = exp((double)p.log_step[dg]);
    double ar = p.a_re[q], ai = p.a_im[q];
    double mag = exp(k * dt * ar);
    p.apow[(size_t)idx * 2] = (float)(mag * cos(k * dt * ai));
    p.apow[(size_t)idx * 2 + 1] = (float)(mag * sin(k * dt * ai));
    return;
  }
  idx -= N_APOW;
  if (idx < N_BBAR) {
    int cc = idx % SSM_C; int q = idx / SSM_C; int dg = q / SSM_P;
    (void)cc;
    double dt = exp((double)p.log_step[dg]);
    double ar = p.a_re[q], ai = p.a_im[q];
    double mag = exp(dt * ar);
    double abr = mag * cos(dt * ai), abi = mag * sin(dt * ai);
    double den = ar * ar + ai * ai, nr = abr - 1.0;
    double cr = (nr * ar + abi * ai) / den, ci = (abi * ar - nr * ai) / den;
    double br = p.b_re[idx], bi = p.b_im[idx];
    p.bbar[(size_t)idx * 2] = (float)(cr * br - ci * bi);
    p.bbar[(size_t)idx * 2 + 1] = (float)(cr * bi + ci * br);
    return;
  }
  double s1 = 0, s2 = 0;
  for (int i = 0; i < HD_; ++i) { s1 += (double)p.lq1[i] * p.lk1[i]; s2 += (double)p.lq2[i] * p.lk2[i]; }
  double lam_init = 0.8 - 0.6 * exp(-0.3 * 1.0);
  p.scal[0] = (float)(exp(s1) - exp(s2) + lam_init);
  p.scal[1] = (float)(1.0 - lam_init);
}

constexpr int N_KT = 2 * SSM_G * SL * SSM_C * SSM_C;
HD void st_tabb(const Params& p, int layer_unused, int idx) {
  int ci = idx % SSM_C; int co = (idx / SSM_C) % SSM_C; int k = (idx / (SSM_C * SSM_C)) % SL; int dg = idx / (SSM_C * SSM_C * SL);
  float acc = 0.f;
  for (int pp = 0; pp < SSM_P; ++pp) {
    int q = dg * SSM_P + pp;
    float ar = p.apow[((size_t)q * (SL + 1) + k) * 2], ai = p.apow[((size_t)q * (SL + 1) + k) * 2 + 1];
    float br = p.bbar[((size_t)q * SSM_C + ci) * 2], bi = p.bbar[((size_t)q * SSM_C + ci) * 2 + 1];
    float cr = p.c_re[((size_t)dg * SSM_C + co) * SSM_P + pp], cim = p.c_im[((size_t)dg * SSM_C + co) * SSM_P + pp];
    float tr = ar * br - ai * bi, ti = ar * bi + ai * br;
    acc += cr * tr - cim * ti;
  }
  p.KT[idx] = acc;
}

HD void st_proj(const Params& p, int layer, int idx) {
  const int W = layer == 0 ? AB_IN : DIF_IN;
  const float* w = layer == 0 ? p.w_in_a : p.dif_w_in;
  const int rope_end = layer == 0 ? (SWA_QW + SWA_KVW) : (2 * DIF_QK);
  int t = idx / W, n = idx % W;
  int r = tok_r(t);
  if (layer == 1 && t >= TL && n < DIF_QK) return;
  const float* xr = xrow(p, layer, t);
  const float* sh = modp(p, layer, r, 0);
  const float* sc = modp(p, layer, r, 1);
  bool rope = (t < TL) && (n < rope_end);
  if (!rope) {
    float acc = 0.f;
    for (int k = 0; k < D; ++k) { float h = xr[k] * (1.0f + sc[k]) + sh[k]; acc += h * w[(size_t)k * W + n]; }
    p.P[(size_t)t * W + n] = f2bf(acc);
    return;
  }
  int d = n % 64, sub = d % 32;
  if (sub >= 16) return;
  float a1 = 0.f, a2 = 0.f;
  for (int k = 0; k < D; ++k) {
    float h = xr[k] * (1.0f + sc[k]) + sh[k];
    a1 += h * w[(size_t)k * W + n]; a2 += h * w[(size_t)k * W + n + 16];
  }
  int i = t % N;
  int pos = d < 32 ? i / GRID_W : i % GRID_W;
  float cs = p.ropeT[(pos * 16 + sub) * 2], sn = p.ropeT[(pos * 16 + sub) * 2 + 1];
  p.P[(size_t)t * W + n] = f2bf(a1 * cs - a2 * sn);
  p.P[(size_t)t * W + n + 16] = f2bf(a2 * cs + a1 * sn);
}

HD void st_swa(const Params& p, int layer, int idx) {
  int hq = idx / TA, t = idx % TA;
  int kvh = hq / 4;
  const uint16_t* P = p.P;
  float q[64], o[64];
  _Pragma("unroll") for (int d = 0; d < 64; ++d) { q[d] = bf2f(P[(size_t)t * AB_IN + hq * 64 + d]) * 0.125f; o[d] = 0.f; }
  float m = p.sink[hq], l = 1.0f;
  int b = t < TL ? t / N : (t - TL) / CTX;
  int nloc = t < TL ? 2 * SWA_WIN + 1 : 0;
  int i = t < TL ? t % N : 0;
  for (int kk = 0; kk < nloc + CTX; ++kk) {
    int row;
    if (kk < nloc) {
      int j = i - SWA_WIN + kk;
      if (j < 0 || j >= N) continue;
      row = b * N + j;
    } else row = TL + b * CTX + (kk - nloc);
    const uint16_t* kr = P + (size_t)row * AB_IN + A_KOFF + kvh * 64;
    const uint16_t* vr = P + (size_t)row * AB_IN + A_VOFF + kvh * 64;
    float s = 0.f;
    _Pragma("unroll") for (int d = 0; d < 64; ++d) s += q[d] * bf2f(kr[d]);
    if (s > m) { float f = expf(m - s); l *= f; for (int d = 0; d < 64; ++d) o[d] *= f; m = s; }
    float pe = expf(s - m);
    l += pe;
    _Pragma("unroll") for (int d = 0; d < 64; ++d) o[d] += pe * bf2f(vr[d]);
  }
  float il = 1.0f / l;
  _Pragma("unroll") for (int d = 0; d < 64; ++d) p.Ymix[(size_t)t * YW + hq * 64 + d] = f2bf(o[d] * il);
}

HD int ssm_row(int dir, int b, int tau) {
  if (dir == 0) return tau < CTX ? TL + b * CTX + tau : b * N + (tau - CTX);
  return tau < CTX ? TL + b * CTX + (CTX - 1 - tau) : b * N + (N - 1 - (tau - CTX));
}
constexpr int N_SSME = 2 * B * NCH * SSM_G * SSM_P;
HD void st_ssm_e(const Params& p, int layer, int idx) {
  int pp = idx % SSM_P; int g = (idx / SSM_P) % SSM_G; int ch = (idx / (SSM_P * SSM_G)) % NCH;
  int b = (idx / (SSM_P * SSM_G * NCH)) % B; int dir = idx / (SSM_P * SSM_G * NCH * B);
  int q = (dir * SSM_G + g) * SSM_P + pp;
  float er = 0.f, ei = 0.f;
  for (int j = 0; j < SL; ++j) {
    int row = ssm_row(dir, b, ch * SL + j);
    const uint16_t* u = p.P + (size_t)row * AB_IN + A_UOFF + g * 16;
    float vr = 0.f, vi = 0.f;
    _Pragma("unroll") for (int cc = 0; cc < 16; ++cc) {
      float uv = bf2f(u[cc]);
      vr += p.bbar[((size_t)q * 16 + cc) * 2] * uv; vi += p.bbar[((size_t)q * 16 + cc) * 2 + 1] * uv;
    }
    float ar = p.apow[((size_t)q * (SL + 1) + (SL - 1 - j)) * 2], ai = p.apow[((size_t)q * (SL + 1) + (SL - 1 - j)) * 2 + 1];
    er += ar * vr - ai * vi; ei += ar * vi + ai * vr;
  }
  p.E[(size_t)idx * 2] = er; p.E[(size_t)idx * 2 + 1] = ei;
}
constexpr int N_SSMC = 2 * B * SSM_G * SSM_P;
HD void st_ssm_c(const Params& p, int layer, int idx) {
  int pp = idx % SSM_P; int g = (idx / SSM_P) % SSM_G; int b = (idx / (SSM_P * SSM_G)) % B; int dir = idx / (SSM_P * SSM_G * B);
  int q = (dir * SSM_G + g) * SSM_P + pp;
  float ar = p.apow[((size_t)q * (SL + 1) + SL) * 2], ai = p.apow[((size_t)q * (SL + 1) + SL) * 2 + 1];
  float sr = 0.f, si = 0.f;
  for (int ch = 0; ch < NCH; ++ch) {
    size_t e = ((((size_t)dir * B + b) * NCH + ch) * SSM_G + g) * SSM_P + pp;
    p.Sin[e * 2] = sr; p.Sin[e * 2 + 1] = si;
    float er = p.E[e * 2], ei = p.E[e * 2 + 1];
    float nr = ar * sr - ai * si + er, ni = ar * si + ai * sr + ei;
    sr = nr; si = ni;
  }
}
HD void st_ssm_o(const Params& p, int layer, int idx) {
  int t = idx / SSM_W, n = idx % SSM_W; int g = n / 16, co = n % 16;
  int b, dirtau[2];
  if (t < TL) { b = t / N; int i = t % N; dirtau[0] = CTX + i; dirtau[1] = CTX + (N - 1 - i); }
  else { b = (t - TL) / CTX; int i = (t - TL) % CTX; dirtau[0] = i; dirtau[1] = CTX - 1 - i; }
  float y = p.ssm_d[n] * bf2f(p.P[(size_t)t * AB_IN + A_UOFF + n]);
  for (int dir = 0; dir < 2; ++dir) {
    int tau = dirtau[dir]; int ch = tau / SL, j = tau % SL;
    int dg = dir * SSM_G + g;
    size_t e0 = ((((size_t)dir * B + b) * NCH + ch) * SSM_G + g) * SSM_P;
    for (int pp = 0; pp < SSM_P; ++pp) {
      int q = dg * SSM_P + pp;
      float ar = p.apow[((size_t)q * (SL + 1) + (j + 1)) * 2], ai = p.apow[((size_t)q * (SL + 1) + (j + 1)) * 2 + 1];
      float sr = p.Sin[(e0 + pp) * 2], si = p.Sin[(e0 + pp) * 2 + 1];
      float tr = ar * sr - ai * si, ti = ar * si + ai * sr;
      float cr = p.c_re[((size_t)dg * 16 + co) * SSM_P + pp], cim = p.c_im[((size_t)dg * 16 + co) * SSM_P + pp];
      y += cr * tr - cim * ti;
    }
    for (int j2 = 0; j2 <= j; ++j2) {
      int row = ssm_row(dir, b, ch * SL + j2);
      const uint16_t* u = p.P + (size_t)row * AB_IN + A_UOFF + g * 16;
      const float* kt = p.KT + (((size_t)dg * SL + (j - j2)) * 16 + co) * 16;
      _Pragma("unroll") for (int ci = 0; ci < 16; ++ci) y += kt[ci] * bf2f(u[ci]);
    }
  }
  p.Gs[(size_t)t * SSM_W + n] = f2bf(geluf_(y));
}
HD void st_glu(const Params& p, int layer, int idx) {
  int t = idx / SSM_W, n = idx % SSM_W;
  float z = p.glu_b[n];
  const uint16_t* g = p.Gs + (size_t)t * SSM_W;
  for (int k = 0; k < SSM_W; ++k) z += bf2f(g[k]) * p.glu_w[(size_t)k * SSM_W + n];
  p.Ymix[(size_t)t * YW + SWA_QW + n] = f2bf(bf2f(g[n]) * sigmoidf_(z));
}

HD void st_dif(const Params& p, int layer, int idx) {
  int t = idx % TL; int he = idx / TL; int eh = he % 2, h = he / 2;
  int b = t / N;
  const uint16_t* P = p.P;
  float res[64];
  float lam = p.scal[0];
  _Pragma("unroll") for (int c = 0; c < 2; ++c) {
    float q[64], o[64];
    _Pragma("unroll") for (int d = 0; d < 64; ++d) { q[d] = bf2f(P[(size_t)t * DIF_IN + h * 128 + c * 64 + d]) * 0.125f; o[d] = 0.f; }
    float m = -1e30f, l = 0.f;
    for (int kk = 0; kk < N + CTX; ++kk) {
      int row = kk < N ? b * N + kk : TL + b * CTX + (kk - N);
      const uint16_t* kr = P + (size_t)row * DIF_IN + DIF_QK + h * 128 + c * 64;
      const uint16_t* vr = P + (size_t)row * DIF_IN + 2 * DIF_QK + h * 128 + eh * 64;
      float s = 0.f;
      _Pragma("unroll") for (int d = 0; d < 64; ++d) s += q[d] * bf2f(kr[d]);
      if (s > m) { float f = expf(m - s); l *= f; for (int d = 0; d < 64; ++d) o[d] *= f; m = s; }
      float pe = expf(s - m);
      l += pe;
      _Pragma("unroll") for (int d = 0; d < 64; ++d) o[d] += pe * bf2f(vr[d]);
    }
    float il = 1.0f / l;
    if (c == 0) { for (int d = 0; d < 64; ++d) res[d] = o[d] * il; }
    else { for (int d = 0; d < 64; ++d) res[d] -= lam * o[d] * il; }
  }
  _Pragma("unroll") for (int d = 0; d < 64; ++d) p.Odif[(size_t)t * D + h * 128 + eh * 64 + d] = res[d];
}
HD void st_difnorm(const Params& p, int layer, int idx) {
  int t = idx / DIF_H, h = idx % DIF_H;
  const float* o = p.Odif + (size_t)t * D + h * 128;
  float ss = 0.f;
  _Pragma("unroll") for (int e = 0; e < 128; ++e) ss += o[e] * o[e];
  float r = 1.0f / sqrtf(ss / 128.0f + RMS_EPS) * p.scal[1];
  _Pragma("unroll") for (int e = 0; e < 128; ++e) p.Ymix[(size_t)t * YW + h * 128 + e] = f2bf(o[e] * r * p.subln_g[e]);
}

HD void st_outproj(const Params& p, int layer, int idx) {
  int t = idx / D, n = idx % D;
  const float* w = layer == 0 ? p.w_out_a : p.dif_w_out;
  const uint16_t* y = p.Ymix + (size_t)t * YW;
  const int KW = layer == 0 ? AB_OUT : DIF_VW;
  float acc = 0.f;
  for (int k = 0; k < KW; ++k) acc += bf2f(y[k]) * w[(size_t)k * D + n];
  p.F[(size_t)t * D + n] = acc;
}
HD void st_ln1(const Params& p, int layer, int t) {
  int r = tok_r(t);
  const float* xr = xrow(p, layer, t); const float* g1 = modp(p, layer, r, 2);
  const float* y = p.F + (size_t)t * D;
  float mu = 0.f;
  for (int k = 0; k < D; ++k) mu += ALPHA * xr[k] + g1[k] * y[k];
  mu /= D;
  float var = 0.f;
  for (int k = 0; k < D; ++k) { float v = ALPHA * xr[k] + g1[k] * y[k] - mu; var += v * v; }
  var /= D;
  float rs = 1.0f / sqrtf(var + LN_EPS);
  const float* lg = p.ln1_g + (size_t)layer * D; const float* lb = p.ln1_b + (size_t)layer * D;
  for (int k = 0; k < D; ++k) p.X1[(size_t)t * D + k] = (ALPHA * xr[k] + g1[k] * y[k] - mu) * rs * lg[k] + lb[k];
}
HD void st_route(const Params& p, int layer, int t) {
  int r = tok_r(t);
  const float* x1 = p.X1 + (size_t)t * D; const float* sh = modp(p, layer, r, 3); const float* sc = modp(p, layer, r, 4);
  float lg[MOE_G];
  _Pragma("unroll") for (int g = 0; g < MOE_G; ++g) lg[g] = p.moe_bg[layer * MOE_G + g];
  const float* wg = p.moe_wg + (size_t)layer * D * MOE_G;
  for (int k = 0; k < D; ++k) {
    float h = x1[k] * (1.0f + sc[k]) + sh[k];
    _Pragma("unroll") for (int g = 0; g < MOE_G; ++g) lg[g] += h * wg[k * MOE_G + g];
  }
  int gi = 0; float mx = lg[0];
  _Pragma("unroll") for (int g = 1; g < MOE_G; ++g) if (lg[g] > mx) { mx = lg[g]; gi = g; }
  float den = 0.f;
  _Pragma("unroll") for (int g = 0; g < MOE_G; ++g) den += expf(lg[g] - mx);
  float gp = 1.0f / den;
  float le[MOE_EPG];
  _Pragma("unroll") for (int e = 0; e < MOE_EPG; ++e) le[e] = p.moe_be[(layer * MOE_G + gi) * MOE_EPG + e];
  const float* we = p.moe_we + ((size_t)layer * MOE_G + gi) * D * MOE_EPG;
  for (int k = 0; k < D; ++k) {
    float h = x1[k] * (1.0f + sc[k]) + sh[k];
    _Pragma("unroll") for (int e = 0; e < MOE_EPG; ++e) le[e] += h * we[k * MOE_EPG + e];
  }
  int i0 = 0; float v0 = le[0];
  _Pragma("unroll") for (int e = 1; e < MOE_EPG; ++e) if (le[e] > v0) { v0 = le[e]; i0 = e; }
  int i1 = -1; float v1 = -3e38f;
  _Pragma("unroll") for (int e = 0; e < MOE_EPG; ++e) if (e != i0 && le[e] > v1) { v1 = le[e]; i1 = e; }
  float e1 = expf(v1 - v0);
  float w0 = gp / (1.0f + e1), w1 = gp * e1 / (1.0f + e1);
  p.route[(size_t)t * 4 + 0] = (float)(gi * MOE_EPG + i0);
  p.route[(size_t)t * 4 + 1] = (float)(gi * MOE_EPG + i1);
  p.route[(size_t)t * 4 + 2] = w0;
  p.route[(size_t)t * 4 + 3] = w1;
}
HD void st_moe_h(const Params& p, int layer, int idx) {
  int f = idx % MOE_F; int j = (idx / MOE_F) % 2; int t = idx / (2 * MOE_F);
  int r = tok_r(t);
  const float* x1 = p.X1 + (size_t)t * D; const float* sh = modp(p, layer, r, 3); const float* sc = modp(p, layer, r, 4);
  int e = (int)p.route[(size_t)t * 4 + j]; float wgt = p.route[(size_t)t * 4 + 2 + j];
  const float* w1 = p.moe_w1 + ((size_t)layer * MOE_E + e) * D * MOE_F;
  const float* w3 = p.moe_w3 + ((size_t)layer * MOE_E + e) * D * MOE_F;
  float h1 = 0.f, h3 = 0.f;
  for (int k = 0; k < D; ++k) {
    float h = x1[k] * (1.0f + sc[k]) + sh[k];
    h1 += h * w1[(size_t)k * MOE_F + f]; h3 += h * w3[(size_t)k * MOE_F + f];
  }
  p.HH[(size_t)idx] = siluf(h1) * h3 * wgt;
}
HD void st_moe_o(const Params& p, int layer, int idx) {
  int t = idx / D, n = idx % D;
  float acc = 0.f;
  for (int j = 0; j < 2; ++j) {
    int e = (int)p.route[(size_t)t * 4 + j];
    const float* w2 = p.moe_w2 + ((size_t)layer * MOE_E + e) * MOE_F * D;
    const float* hh = p.HH + ((size_t)t * 2 + j) * MOE_F;
    for (int f = 0; f < MOE_F; ++f) acc += hh[f] * w2[(size_t)f * D + n];
  }
  p.F[(size_t)t * D + n] = acc;
}
HD void st_ln2(const Params& p, int layer, int t) {
  int r = tok_r(t);
  const float* x1 = p.X1 + (size_t)t * D; const float* g2 = modp(p, layer, r, 5);
  const float* y = p.F + (size_t)t * D;
  float mu = 0.f;
  for (int k = 0; k < D; ++k) mu += ALPHA * x1[k] + g2[k] * y[k];
  mu /= D;
  float var = 0.f;
  for (int k = 0; k < D; ++k) { float v = ALPHA * x1[k] + g2[k] * y[k] - mu; var += v * v; }
  var /= D;
  float rs = 1.0f / sqrtf(var + LN_EPS);
  const float* lg = p.ln2_g + (size_t)layer * D; const float* lb = p.ln2_b + (size_t)layer * D;
  float* dst = layer == DEPTH - 1 ? p.out + (size_t)t * D : p.X + (size_t)t * D;
  for (int k = 0; k < D; ++k) dst[k] = (ALPHA * x1[k] + g2[k] * y[k] - mu) * rs * lg[k] + lb[k];
}

enum { S_MOD, S_TABA, S_TABB, S_PROJ, S_SWA, S_SSME, S_SSMC, S_SSMO, S_GLU, S_DIF, S_DIFNORM, S_OUTPROJ, S_LN1, S_ROUTE, S_MOEH, S_MOEO, S_LN2 };
template <int S> HD void run_elem(const Params& p, int layer, int idx) {
  if (S == S_MOD) st_mod(p, layer, idx);
  else if (S == S_TABA) st_taba(p, layer, idx);
  else if (S == S_TABB) st_tabb(p, layer, idx);
  else if (S == S_PROJ) st_proj(p, layer, idx);
  else if (S == S_SWA) st_swa(p, layer, idx);
  else if (S == S_SSME) st_ssm_e(p, layer, idx);
  else if (S == S_SSMC) st_ssm_c(p, layer, idx);
  else if (S == S_SSMO) st_ssm_o(p, layer, idx);
  else if (S == S_GLU) st_glu(p, layer, idx);
  else if (S == S_DIF) st_dif(p, layer, idx);
  else if (S == S_DIFNORM) st_difnorm(p, layer, idx);
  else if (S == S_OUTPROJ) st_outproj(p, layer, idx);
  else if (S == S_LN1) st_ln1(p, layer, idx);
  else if (S == S_ROUTE) st_route(p, layer, idx);
  else if (S == S_MOEH) st_moe_h(p, layer, idx);
  else if (S == S_MOEO) st_moe_o(p, layer, idx);
  else if (S == S_LN2) st_ln2(p, layer, idx);
}

struct WsLayout {
  size_t X, X1, P, Ymix, Gs, modv, ropeT, apow, bbar, KT, E, Sin, route, scal, total;
};
inline WsLayout ws_layout() {
  WsLayout L; size_t o = 0;
  auto take = [&](size_t bytes) { size_t r = o; o += (bytes + 255) & ~(size_t)255; return r; };
  L.X = take((size_t)TA * D * 4);
  L.X1 = take((size_t)TA * D * 4);
  L.P = take((size_t)TA * (AB_IN > DIF_IN ? AB_IN : DIF_IN) * 2);
  L.Ymix = take((size_t)TA * YW * 2);
  L.Gs = take((size_t)TA * SSM_W * 2);
  L.modv = take((size_t)N_MOD * 4);
  L.ropeT = take((size_t)N_ROPE * 2 * 4);
  L.apow = take((size_t)N_APOW * 2 * 4);
  L.bbar = take((size_t)N_BBAR * 2 * 4);
  L.KT = take((size_t)N_KT * 4);
  L.E = take((size_t)N_SSME * 2 * 4);
  L.Sin = take((size_t)N_SSME * 2 * 4);
  L.route = take((size_t)TA * 4 * 4);
  L.scal = take(256);
  L.total = o;
  return L;
}
inline void fill_ws(Params& p, char* ws) {
  WsLayout L = ws_layout();
  p.X = (float*)(ws + L.X); p.X1 = (float*)(ws + L.X1); p.P = (uint16_t*)(ws + L.P); p.F = (float*)(ws + L.P);
  p.Ymix = (uint16_t*)(ws + L.Ymix); p.HH = (float*)(ws + L.Ymix); p.Odif = (float*)(ws + L.X1);
  p.Gs = (uint16_t*)(ws + L.Gs); p.modv = (float*)(ws + L.modv); p.ropeT = (float*)(ws + L.ropeT);
  p.apow = (float*)(ws + L.apow); p.bbar = (float*)(ws + L.bbar); p.KT = (float*)(ws + L.KT);
  p.E = (float*)(ws + L.E); p.Sin = (float*)(ws + L.Sin); p.route = (float*)(ws + L.route); p.scal = (float*)(ws + L.scal);
}
inline void fill_inputs(Params& p, void* const* d_in) {
  const float* const* in = (const float* const*)d_in;
  p.x = in[0]; p.c = in[1]; p.ctx = in[2]; p.c_ctx = in[3]; p.mod_w = in[4]; p.mod_b = in[5];
  p.ln1_g = in[6]; p.ln1_b = in[7]; p.ln2_g = in[8]; p.ln2_b = in[9];
  p.w_in_a = in[10]; p.w_out_a = in[11]; p.sink = in[12]; p.a_re = in[13]; p.a_im = in[14]; p.log_step = in[15];
  p.b_re = in[16]; p.b_im = in[17]; p.c_re = in[18]; p.c_im = in[19]; p.ssm_d = in[20]; p.glu_w = in[21]; p.glu_b = in[22];
  p.dif_w_in = in[23]; p.dif_w_out = in[24]; p.lq1 = in[25]; p.lk1 = in[26]; p.lq2 = in[27]; p.lk2 = in[28]; p.subln_g = in[29];
  p.moe_wg = in[30]; p.moe_bg = in[31]; p.moe_we = in[32]; p.moe_be = in[33]; p.moe_w1 = in[34]; p.moe_w3 = in[35]; p.moe_w2 = in[36];
}

#define FORWARD_PROGRAM(RUN)                                   \
  RUN(S_MOD, 0, N_MOD)                                         \
  RUN(S_TABA, 0, N_TABA)                                       \
  RUN(S_TABB, 0, N_KT)                                         \
                                                   \
  RUN(S_PROJ, 0, TA * AB_IN)                                   \
  RUN(S_SWA, 0, SWA_H * TA)                                    \
  RUN(S_SSME, 0, N_SSME)                                       \
  RUN(S_SSMC, 0, N_SSMC)                                       \
  RUN(S_SSMO, 0, TA * SSM_W)                                   \
  RUN(S_GLU, 0, TA * SSM_W)                                    \
  RUN(S_OUTPROJ, 0, TA * D)                                    \
  RUN(S_LN1, 0, TA)                                            \
  RUN(S_ROUTE, 0, TA)                                          \
  RUN(S_MOEH, 0, TA * 2 * MOE_F)                               \
  RUN(S_MOEO, 0, TA * D)                                       \
  RUN(S_LN2, 0, TA)                                            \
                                                   \
  RUN(S_PROJ, 1, TA * DIF_IN)                                  \
  RUN(S_DIF, 1, DIF_H * 2 * TL)                                \
  RUN(S_DIFNORM, 1, TL * DIF_H)                                \
  RUN(S_OUTPROJ, 1, TL * D)                                    \
  RUN(S_LN1, 1, TL)                                            \
  RUN(S_ROUTE, 1, TL)                                          \
  RUN(S_MOEH, 1, TL * 2 * MOE_F)                               \
  RUN(S_MOEO, 1, TL * D)                                       \
  RUN(S_LN2, 1, TL)

#ifndef HOST_EMU
#include <hip/hip_cooperative_groups.h>
#include <cstdio>
namespace cg = cooperative_groups;

#ifdef MULTI_LAUNCH
template <int S> __global__ void __launch_bounds__(256) stage_kernel(Params p, int layer, int n) {
  for (int idx = blockIdx.x * 256 + threadIdx.x; idx < n; idx += gridDim.x * 256) run_elem<S>(p, layer, idx);
}
#else
__global__ void __launch_bounds__(256) mega_kernel(Params p) {
  cg::grid_group grid = cg::this_grid();
#define RUN_MEGA(S, layer, cnt)                                                                              \
  {                                                                                                          \
    const int n_ = (cnt);                                                                                    \
    for (int idx = blockIdx.x * 256 + threadIdx.x; idx < n_; idx += gridDim.x * 256) run_elem<S>(p, layer, idx); \
    grid.sync();                                                                                             \
  }
  FORWARD_PROGRAM(RUN_MEGA)
}
#endif

extern "C" void kernel_launch(void* const* d_in, const int* in_sizes, int n_in, void* d_out, int out_size, void* d_ws,
                              size_t ws_size, hipStream_t stream) {
  Params p{};
  fill_inputs(p, d_in);
  p.out = (float*)d_out;
  fill_ws(p, (char*)d_ws);
  if (ws_layout().total > ws_size) { fprintf(stderr, "workspace too small\n"); return; }
#ifdef MULTI_LAUNCH
#define RUN_GPU(S, layer, cnt)                                                                  \
  {                                                                                             \
    int n_ = (cnt);                                                                             \
    int blocks_ = (n_ + 255) / 256;                                                             \
    if (blocks_ > 65536) blocks_ = 65536;                                                       \
    stage_kernel<S><<<blocks_, 256, 0, stream>>>(p, layer, n_);                                 \
  }
  FORWARD_PROGRAM(RUN_GPU)
#else
  static int grid_blocks = 0;
  if (!grid_blocks) {
    int dev = 0, cus = 0, per_cu = 0;
    hipGetDevice(&dev);
    hipDeviceGetAttribute(&cus, hipDeviceAttributeMultiprocessorCount, dev);
    hipOccupancyMaxActiveBlocksPerMultiprocessor(&per_cu, mega_kernel, 256, 0);
    if (per_cu > 4) per_cu = 4;
    grid_blocks = cus * per_cu;
  }
  void* args[] = {&p};
  hipError_t e = hipLaunchCooperativeKernel((void*)mega_kernel, dim3(grid_blocks), dim3(256), args, 0, stream);
  if (e != hipSuccess) fprintf(stderr, "cooperative launch failed: %s (grid %d)\n", hipGetErrorString(e), grid_blocks);
#endif
}
#endif
```

```cpp
#ifndef HOST_EMU
#include <hip/hip_runtime.h>
#define HD __host__ __device__ __forceinline__
#else
#define HD inline
#endif
#include <stdint.h>
#include <math.h>

#ifndef CFG_D
#define CFG_D 1024
#define CFG_B 8
#define CFG_N 2048
#define CFG_CTX 256
#endif

constexpr int D = CFG_D, B = CFG_B, N = CFG_N, CTX = CFG_CTX;
constexpr int DEPTH = 2, GRID_W = 64, HD_ = 64;
constexpr int TL = B * N, TC = B * CTX, TA = TL + TC;
constexpr int SWA_H = 8, SWA_QW = 512, SWA_KVW = 128, SWA_WIN = 128;
constexpr int SSM_W = D / 2, SSM_C = 16, SSM_G = SSM_W / 16, SSM_P = 64;
constexpr int AB_IN = SWA_QW + 2 * SWA_KVW + SSM_W;
constexpr int AB_OUT = SWA_QW + SSM_W;
constexpr int A_KOFF = SWA_QW, A_VOFF = SWA_QW + SWA_KVW, A_UOFF = SWA_QW + 2 * SWA_KVW;
constexpr int DIF_H = D / 128, DIF_QK = DIF_H * 128, DIF_VW = DIF_H * 128, DIF_IN = 2 * DIF_QK + DIF_VW;
constexpr int MOE_G = 4, MOE_EPG = 8, MOE_E = 32, MOE_F = D / 4;
constexpr int SL = 64;
constexpr int SS = CTX + N;
constexpr int NCH = SS / SL;
constexpr float LN_EPS = 1e-5f, RMS_EPS = 1e-5f;
constexpr float ALPHA = 1.41421356237309515f;
static_assert(CTX % SL == 0 && N % SL == 0, "chunking");
constexpr int YW = AB_OUT > D ? AB_OUT : D;

struct Params {
  const float *x, *c, *ctx, *c_ctx, *mod_w, *mod_b, *ln1_g, *ln1_b, *ln2_g, *ln2_b;
  const float *w_in_a, *w_out_a, *sink, *a_re, *a_im, *log_step, *b_re, *b_im, *c_re, *c_im, *ssm_d, *glu_w, *glu_b;
  const float *dif_w_in, *dif_w_out, *lq1, *lk1, *lq2, *lk2, *subln_g;
  const float *moe_wg, *moe_bg, *moe_we, *moe_be, *moe_w1, *moe_w3, *moe_w2;
  float* out;
  float *X, *X1, *F, *HH, *Odif;
  uint16_t *P, *Ymix, *Gs;
  float *modv, *ropeT, *apow, *bbar, *KT, *E, *Sin, *route, *scal;
  uint16_t *H;
  uint16_t *WinA_t, *DifIn_t;
  unsigned* ctl;
};

HD uint16_t f2bf(float f) {
  uint32_t u = __builtin_bit_cast(uint32_t, f);
  u += 0x7fffu + ((u >> 16) & 1u);
  return (uint16_t)(u >> 16);
}
HD float bf2f(uint16_t h) {
  uint32_t u = ((uint32_t)h) << 16;
  return __builtin_bit_cast(float, u);
}
HD float siluf(float x) { return x / (1.0f + expf(-x)); }
HD float sigmoidf_(float x) { return 1.0f / (1.0f + expf(-x)); }
HD float geluf_(float x) { return 0.5f * x * (1.0f + tanhf(0.7978845608028654f * (x + 0.044715f * x * x * x))); }

HD int tok_r(int t) { return t < TL ? t / N : B; }
HD const float* xrow(const Params& p, int layer, int t) {
  if (layer == 0) return t < TL ? p.x + (size_t)t * D : p.ctx + (size_t)(t - TL) * D;
  return p.X + (size_t)t * D;
}
HD const float* modp(const Params& p, int layer, int r, int which) {
  return p.modv + ((size_t)(layer * (B + 1) + r) * 6 + which) * D;
}

constexpr int N_MOD = DEPTH * (B + 1) * 6 * D;
HD void st_mod(const Params& p, int layer_unused, int idx) {
  int j = idx % (6 * D); int r = (idx / (6 * D)) % (B + 1); int l = idx / (6 * D * (B + 1));
  const float* cv = r < B ? p.c + (size_t)r * D : p.c_ctx;
  const float* w = p.mod_w + (size_t)l * D * 6 * D;
  float acc = p.mod_b[(size_t)l * 6 * D + j];
  for (int k = 0; k < D; ++k) acc += siluf(cv[k]) * w[(size_t)k * 6 * D + j];
  p.modv[idx] = acc;
}

constexpr int N_ROPE = 64 * 16;
constexpr int N_APOW = 2 * SSM_G * SSM_P * (SL + 1);
constexpr int N_BBAR = 2 * SSM_G * SSM_P * SSM_C;
constexpr int N_TABA = N_ROPE + N_APOW + N_BBAR + 1;
HD void st_taba(const Params& p, int layer_unused, int idx) {
  if (idx < N_ROPE) {
    int pos = idx / 16, f = idx % 16;
    float inv = powf(10000.0f, -(float)f / 16.0f);
    float ang = (float)pos * inv;
    p.ropeT[idx * 2] = cosf(ang); p.ropeT[idx * 2 + 1] = sinf(ang);
    return;
  }
  idx -= N_ROPE;
  if (idx < N_APOW) {
    int k = idx % (SL + 1); int q = idx / (SL + 1);
    int dg = q / SSM_P;
    double dt = exp((double)p.log_step[dg]);
    double ar = p.a_re[q], ai = p.a_im[q];
    double mag = exp(k * dt * ar);
    p.apow[(size_t)idx * 2] = (float)(mag * cos(k * dt * ai));
    p.apow[(size_t)idx * 2 + 1] = (float)(mag * sin(k * dt * ai));
    return;
  }
  idx -= N_APOW;
  if (idx < N_BBAR) {
    int cc = idx % SSM_C; int q = idx / SSM_C; int dg = q / SSM_P;
    (void)cc;
    double dt = exp((double)p.log_step[dg]);
    double ar = p.a_re[q], ai = p.a_im[q];
    double mag = exp(dt * ar);
    double abr = mag * cos(dt * ai), abi = mag * sin(dt * ai);
    double den = ar * ar + ai * ai, nr = abr - 1.0;
    double cr = (nr * ar + abi * ai) / den, ci = (abi * ar - nr * ai) / den;
    double br = p.b_re[idx], bi = p.b_im[idx];
    p.bbar[(size_t)idx * 2] = (float)(cr * br - ci * bi);
    p.bbar[(size_t)idx * 2 + 1] = (float)(cr * bi + ci * br);
    return;
  }
  double s1 = 0, s2 = 0;
  for (int i = 0; i < HD_; ++i) { s1 += (double)p.lq1[i] * p.lk1[i]; s2 += (double)p.lq2[i] * p.lk2[i]; }
  double lam_init = 0.8 - 0.6 * exp(-0.3 * 1.0);
  p.scal[0] = (float)(exp(s1) - exp(s2) + lam_init);
  p.scal[1] = (float)(1.0 - lam_init);
}

constexpr int N_KT = 2 * SSM_G * SL * SSM_C * SSM_C;
HD void st_tabb(const Params& p, int layer_unused, int idx) {
  int ci = idx % SSM_C; int co = (idx / SSM_C) % SSM_C; int k = (idx / (SSM_C * SSM_C)) % SL; int dg = idx / (SSM_C * SSM_C * SL);
  float acc = 0.f;
  for (int pp = 0; pp < SSM_P; ++pp) {
    int q = dg * SSM_P + pp;
    float ar = p.apow[((size_t)q * (SL + 1) + k) * 2], ai = p.apow[((size_t)q * (SL + 1) + k) * 2 + 1];
    float br = p.bbar[((size_t)q * SSM_C + ci) * 2], bi = p.bbar[((size_t)q * SSM_C + ci) * 2 + 1];
    float cr = p.c_re[((size_t)dg * SSM_C + co) * SSM_P + pp], cim = p.c_im[((size_t)dg * SSM_C + co) * SSM_P + pp];
    float tr = ar * br - ai * bi, ti = ar * bi + ai * br;
    acc += cr * tr - cim * ti;
  }
  p.KT[idx] = acc;
}

HD void st_proj(const Params& p, int layer, int idx) {
  const int W = layer == 0 ? AB_IN : DIF_IN;
  const float* w = layer == 0 ? p.w_in_a : p.dif_w_in;
  const int rope_end = layer == 0 ? (SWA_QW + SWA_KVW) : (2 * DIF_QK);
  int t = idx / W, n = idx % W;
  int r = tok_r(t);
  if (layer == 1 && t >= TL && n < DIF_QK) return;
  const float* xr = xrow(p, layer, t);
  const float* sh = modp(p, layer, r, 0);
  const float* sc = modp(p, layer, r, 1);
  bool rope = (t < TL) && (n < rope_end);
  if (!rope) {
    float acc = 0.f;
    for (int k = 0; k < D; ++k) { float h = xr[k] * (1.0f + sc[k]) + sh[k]; acc += h * w[(size_t)k * W + n]; }
    p.P[(size_t)t * W + n] = f2bf(acc);
    return;
  }
  int d = n % 64, sub = d % 32;
  if (sub >= 16) return;
  float a1 = 0.f, a2 = 0.f;
  for (int k = 0; k < D; ++k) {
    float h = xr[k] * (1.0f + sc[k]) + sh[k];
    a1 += h * w[(size_t)k * W + n]; a2 += h * w[(size_t)k * W + n + 16];
  }
  int i = t % N;
  int pos = d < 32 ? i / GRID_W : i % GRID_W;
  float cs = p.ropeT[(pos * 16 + sub) * 2], sn = p.ropeT[(pos * 16 + sub) * 2 + 1];
  p.P[(size_t)t * W + n] = f2bf(a1 * cs - a2 * sn);
  p.P[(size_t)t * W + n + 16] = f2bf(a2 * cs + a1 * sn);
}

HD void st_swa(const Params& p, int layer, int idx) {
  int hq = idx / TA, t = idx % TA;
  int kvh = hq / 4;
  const uint16_t* P = p.P;
  float q[64], o[64];
  _Pragma("unroll") for (int d = 0; d < 64; ++d) { q[d] = bf2f(P[(size_t)t * AB_IN + hq * 64 + d]) * 0.125f; o[d] = 0.f; }
  float m = p.sink[hq], l = 1.0f;
  int b = t < TL ? t / N : (t - TL) / CTX;
  int nloc = t < TL ? 2 * SWA_WIN + 1 : 0;
  int i = t < TL ? t % N : 0;
  for (int kk = 0; kk < nloc + CTX; ++kk) {
    int row;
    if (kk < nloc) {
      int j = i - SWA_WIN + kk;
      if (j < 0 || j >= N) continue;
      row = b * N + j;
    } else row = TL + b * CTX + (kk - nloc);
    const uint16_t* kr = P + (size_t)row * AB_IN + A_KOFF + kvh * 64;
    const uint16_t* vr = P + (size_t)row * AB_IN + A_VOFF + kvh * 64;
    float s = 0.f;
    _Pragma("unroll") for (int d = 0; d < 64; ++d) s += q[d] * bf2f(kr[d]);
    if (s > m) { float f = expf(m - s); l *= f; for (int d = 0; d < 64; ++d) o[d] *= f; m = s; }
    float pe = expf(s - m);
    l += pe;
    _Pragma("unroll") for (int d = 0; d < 64; ++d) o[d] += pe * bf2f(vr[d]);
  }
  float il = 1.0f / l;
  _Pragma("unroll") for (int d = 0; d < 64; ++d) p.Ymix[(size_t)t * YW + hq * 64 + d] = f2bf(o[d] * il);
}

HD int ssm_row(int dir, int b, int tau) {
  if (dir == 0) return tau < CTX ? TL + b * CTX + tau : b * N + (tau - CTX);
  return tau < CTX ? TL + b * CTX + (CTX - 1 - tau) : b * N + (N - 1 - (tau - CTX));
}
constexpr int N_SSME = 2 * B * NCH * SSM_G * SSM_P;
HD void st_ssm_e(const Params& p, int layer, int idx) {
  int pp = idx % SSM_P; int g = (idx / SSM_P) % SSM_G; int ch = (idx / (SSM_P * SSM_G)) % NCH;
  int b = (idx / (SSM_P * SSM_G * NCH)) % B; int dir = idx / (SSM_P * SSM_G * NCH * B);
  int q = (dir * SSM_G + g) * SSM_P + pp;
  float er = 0.f, ei = 0.f;
  for (int j = 0; j < SL; ++j) {
    int row = ssm_row(dir, b, ch * SL + j);
    const uint16_t* u = p.P + (size_t)row * AB_IN + A_UOFF + g * 16;
    float vr = 0.f, vi = 0.f;
    _Pragma("unroll") for (int cc = 0; cc < 16; ++cc) {
      float uv = bf2f(u[cc]);
      vr += p.bbar[((size_t)q * 16 + cc) * 2] * uv; vi += p.bbar[((size_t)q * 16 + cc) * 2 + 1] * uv;
    }
    float ar = p.apow[((size_t)q * (SL + 1) + (SL - 1 - j)) * 2], ai = p.apow[((size_t)q * (SL + 1) + (SL - 1 - j)) * 2 + 1];
    er += ar * vr - ai * vi; ei += ar * vi + ai * vr;
  }
  p.E[(size_t)idx * 2] = er; p.E[(size_t)idx * 2 + 1] = ei;
}
constexpr int N_SSMC = 2 * B * SSM_G * SSM_P;
HD void st_ssm_c(const Params& p, int layer, int idx) {
  int pp = idx % SSM_P; int g = (idx / SSM_P) % SSM_G; int b = (idx / (SSM_P * SSM_G)) % B; int dir = idx / (SSM_P * SSM_G * B);
  int q = (dir * SSM_G + g) * SSM_P + pp;
  float ar = p.apow[((size_t)q * (SL + 1) + SL) * 2], ai = p.apow[((size_t)q * (SL + 1) + SL) * 2 + 1];
  float sr = 0.f, si = 0.f;
  for (int ch = 0; ch < NCH; ++ch) {
    size_t e = ((((size_t)dir * B + b) * NCH + ch) * SSM_G + g) * SSM_P + pp;
    p.Sin[e * 2] = sr; p.Sin[e * 2 + 1] = si;
    float er = p.E[e * 2], ei = p.E[e * 2 + 1];
    float nr = ar * sr - ai * si + er, ni = ar * si + ai * sr + ei;
    sr = nr; si = ni;
  }
}
HD void st_ssm_o(const Params& p, int layer, int idx) {
  int t = idx / SSM_W, n = idx % SSM_W; int g = n / 16, co = n % 16;
  int b, dirtau[2];
  if (t < TL) { b = t / N; int i = t % N; dirtau[0] = CTX + i; dirtau[1] = CTX + (N - 1 - i); }
  else { b = (t - TL) / CTX; int i = (t - TL) % CTX; dirtau[0] = i; dirtau[1] = CTX - 1 - i; }
  float y = p.ssm_d[n] * bf2f(p.P[(size_t)t * AB_IN + A_UOFF + n]);
  for (int dir = 0; dir < 2; ++dir) {
    int tau = dirtau[dir]; int ch = tau / SL, j = tau % SL;
    int dg = dir * SSM_G + g;
    size_t e0 = ((((size_t)dir * B + b) * NCH + ch) * SSM_G + g) * SSM_P;
    for (int pp = 0; pp < SSM_P; ++pp) {
      int q = dg * SSM_P + pp;
      float ar = p.apow[((size_t)q * (SL + 1) + (j + 1)) * 2], ai = p.apow[((size_t)q * (SL + 1) + (j + 1)) * 2 + 1];
      float sr = p.Sin[(e0 + pp) * 2], si = p.Sin[(e0 + pp) * 2 + 1];
      float tr = ar * sr - ai * si, ti = ar * si + ai * sr;
      float cr = p.c_re[((size_t)dg * 16 + co) * SSM_P + pp], cim = p.c_im[((size_t)dg * 16 + co) * SSM_P + pp];
      y += cr * tr - cim * ti;
    }
    for (int j2 = 0; j2 <= j; ++j2) {
      int row = ssm_row(dir, b, ch * SL + j2);
      const uint16_t* u = p.P + (size_t)row * AB_IN + A_UOFF + g * 16;
      const float* kt = p.KT + (((size_t)dg * SL + (j - j2)) * 16 + co) * 16;
      _Pragma("unroll") for (int ci = 0; ci < 16; ++ci) y += kt[ci] * bf2f(u[ci]);
    }
  }
  p.Gs[(size_t)t * SSM_W + n] = f2bf(geluf_(y));
}
HD void st_glu(const Params& p, int layer, int idx) {
  int t = idx / SSM_W, n = idx % SSM_W;
  float z = p.glu_b[n];
  const uint16_t* g = p.Gs + (size_t)t * SSM_W;
  for (int k = 0; k < SSM_W; ++k) z += bf2f(g[k]) * p.glu_w[(size_t)k * SSM_W + n];
  p.Ymix[(size_t)t * YW + SWA_QW + n] = f2bf(bf2f(g[n]) * sigmoidf_(z));
}

HD void st_dif(const Params& p, int layer, int idx) {
  int t = idx % TL; int he = idx / TL; int eh = he % 2, h = he / 2;
  int b = t / N;
  const uint16_t* P = p.P;
  float res[64];
  float lam = p.scal[0];
  _Pragma("unroll") for (int c = 0; c < 2; ++c) {
    float q[64], o[64];
    _Pragma("unroll") for (int d = 0; d < 64; ++d) { q[d] = bf2f(P[(size_t)t * DIF_IN + h * 128 + c * 64 + d]) * 0.125f; o[d] = 0.f; }
    float m = -1e30f, l = 0.f;
    for (int kk = 0; kk < N + CTX; ++kk) {
      int row = kk < N ? b * N + kk : TL + b * CTX + (kk - N);
      const uint16_t* kr = P + (size_t)row * DIF_IN + DIF_QK + h * 128 + c * 64;
      const uint16_t* vr = P + (size_t)row * DIF_IN + 2 * DIF_QK + h * 128 + eh * 64;
      float s = 0.f;
      _Pragma("unroll") for (int d = 0; d < 64; ++d) s += q[d] * bf2f(kr[d]);
      if (s > m) { float f = expf(m - s); l *= f; for (int d = 0; d < 64; ++d) o[d] *= f; m = s; }
      float pe = expf(s - m);
      l += pe;
      _Pragma("unroll") for (int d = 0; d < 64; ++d) o[d] += pe * bf2f(vr[d]);
    }
    float il = 1.0f / l;
    if (c == 0) { for (int d = 0; d < 64; ++d) res[d] = o[d] * il; }
    else { for (int d = 0; d < 64; ++d) res[d] -= lam * o[d] * il; }
  }
  _Pragma("unroll") for (int d = 0; d < 64; ++d) p.Odif[(size_t)t * D + h * 128 + eh * 64 + d] = res[d];
}
HD void st_difnorm(const Params& p, int layer, int idx) {
  int t = idx / DIF_H, h = idx % DIF_H;
  const float* o = p.Odif + (size_t)t * D + h * 128;
  float ss = 0.f;
  for (int e = 0; e < 128; ++e) ss += o[e] * o[e];
  float r = 1.0f / sqrtf(ss / 128.0f + RMS_EPS) * p.scal[1];
  _Pragma("unroll 8") for (int e = 0; e < 128; ++e) p.Ymix[(size_t)t * YW + h * 128 + e] = f2bf(o[e] * r * p.subln_g[e]);
}

HD void st_outproj(const Params& p, int layer, int idx) {
  int t = idx / D, n = idx % D;
  const float* w = layer == 0 ? p.w_out_a : p.dif_w_out;
  const uint16_t* y = p.Ymix + (size_t)t * YW;
  const int KW = layer == 0 ? AB_OUT : DIF_VW;
  float acc = 0.f;
  for (int k = 0; k < KW; ++k) acc += bf2f(y[k]) * w[(size_t)k * D + n];
  p.F[(size_t)t * D + n] = acc;
}
HD void st_ln1(const Params& p, int layer, int t) {
  int r = tok_r(t);
  const float* xr = xrow(p, layer, t); const float* g1 = modp(p, layer, r, 2);
  const float* y = p.F + (size_t)t * D;
  float mu = 0.f;
  for (int k = 0; k < D; ++k) mu += ALPHA * xr[k] + g1[k] * y[k];
  mu /= D;
  float var = 0.f;
  for (int k = 0; k < D; ++k) { float v = ALPHA * xr[k] + g1[k] * y[k] - mu; var += v * v; }
  var /= D;
  float rs = 1.0f / sqrtf(var + LN_EPS);
  const float* lg = p.ln1_g + (size_t)layer * D; const float* lb = p.ln1_b + (size_t)layer * D;
  for (int k = 0; k < D; ++k) p.X1[(size_t)t * D + k] = (ALPHA * xr[k] + g1[k] * y[k] - mu) * rs * lg[k] + lb[k];
}
HD void st_route(const Params& p, int layer, int t) {
  int r = tok_r(t);
  const float* x1 = p.X1 + (size_t)t * D; const float* sh = modp(p, layer, r, 3); const float* sc = modp(p, layer, r, 4);
  float lg[MOE_G];
  _Pragma("unroll") for (int g = 0; g < MOE_G; ++g) lg[g] = p.moe_bg[layer * MOE_G + g];
  const float* wg = p.moe_wg + (size_t)layer * D * MOE_G;
  for (int k = 0; k < D; ++k) {
    float h = x1[k] * (1.0f + sc[k]) + sh[k];
    _Pragma("unroll") for (int g = 0; g < MOE_G; ++g) lg[g] += h * wg[k * MOE_G + g];
  }
  int gi = 0; float mx = lg[0];
  _Pragma("unroll") for (int g = 1; g < MOE_G; ++g) if (lg[g] > mx) { mx = lg[g]; gi = g; }
  float den = 0.f;
  _Pragma("unroll") for (int g = 0; g < MOE_G; ++g) den += expf(lg[g] - mx);
  float gp = 1.0f / den;
  float le[MOE_EPG];
  _Pragma("unroll") for (int e = 0; e < MOE_EPG; ++e) le[e] = p.moe_be[(layer * MOE_G + gi) * MOE_EPG + e];
  const float* we = p.moe_we + ((size_t)layer * MOE_G + gi) * D * MOE_EPG;
  for (int k = 0; k < D; ++k) {
    float h = x1[k] * (1.0f + sc[k]) + sh[k];
    _Pragma("unroll") for (int e = 0; e < MOE_EPG; ++e) le[e] += h * we[k * MOE_EPG + e];
  }
  int i0 = 0; float v0 = le[0];
  _Pragma("unroll") for (int e = 1; e < MOE_EPG; ++e) if (le[e] > v0) { v0 = le[e]; i0 = e; }
  int i1 = -1; float v1 = -3e38f;
  _Pragma("unroll") for (int e = 0; e < MOE_EPG; ++e) if (e != i0 && le[e] > v1) { v1 = le[e]; i1 = e; }
  float e1 = expf(v1 - v0);
  float w0 = gp / (1.0f + e1), w1 = gp * e1 / (1.0f + e1);
  p.route[(size_t)t * 4 + 0] = (float)(gi * MOE_EPG + i0);
  p.route[(size_t)t * 4 + 1] = (float)(gi * MOE_EPG + i1);
  p.route[(size_t)t * 4 + 2] = w0;
  p.route[(size_t)t * 4 + 3] = w1;
}
HD void st_moe_h(const Params& p, int layer, int idx) {
  int f = idx % MOE_F; int j = (idx / MOE_F) % 2; int t = idx / (2 * MOE_F);
  int r = tok_r(t);
  const float* x1 = p.X1 + (size_t)t * D; const float* sh = modp(p, layer, r, 3); const float* sc = modp(p, layer, r, 4);
  int e = (int)p.route[(size_t)t * 4 + j]; float wgt = p.route[(size_t)t * 4 + 2 + j];
  const float* w1 = p.moe_w1 + ((size_t)layer * MOE_E + e) * D * MOE_F;
  const float* w3 = p.moe_w3 + ((size_t)layer * MOE_E + e) * D * MOE_F;
  float h1 = 0.f, h3 = 0.f;
  for (int k = 0; k < D; ++k) {
    float h = x1[k] * (1.0f + sc[k]) + sh[k];
    h1 += h * w1[(size_t)k * MOE_F + f]; h3 += h * w3[(size_t)k * MOE_F + f];
  }
  p.HH[(size_t)idx] = siluf(h1) * h3 * wgt;
}
HD void st_moe_o(const Params& p, int layer, int idx) {
  int t = idx / D, n = idx % D;
  float acc = 0.f;
  for (int j = 0; j < 2; ++j) {
    int e = (int)p.route[(size_t)t * 4 + j];
    const float* w2 = p.moe_w2 + ((size_t)layer * MOE_E + e) * MOE_F * D;
    const float* hh = p.HH + ((size_t)t * 2 + j) * MOE_F;
    for (int f = 0; f < MOE_F; ++f) acc += hh[f] * w2[(size_t)f * D + n];
  }
  p.F[(size_t)t * D + n] = acc;
}
HD void st_ln2(const Params& p, int layer, int t) {
  int r = tok_r(t);
  const float* x1 = p.X1 + (size_t)t * D; const float* g2 = modp(p, layer, r, 5);
  const float* y = p.F + (size_t)t * D;
  float mu = 0.f;
  for (int k = 0; k < D; ++k) mu += ALPHA * x1[k] + g2[k] * y[k];
  mu /= D;
  float var = 0.f;
  for (int k = 0; k < D; ++k) { float v = ALPHA * x1[k] + g2[k] * y[k] - mu; var += v * v; }
  var /= D;
  float rs = 1.0f / sqrtf(var + LN_EPS);
  const float* lg = p.ln2_g + (size_t)layer * D; const float* lb = p.ln2_b + (size_t)layer * D;
  float* dst = layer == DEPTH - 1 ? p.out + (size_t)t * D : p.X + (size_t)t * D;
  for (int k = 0; k < D; ++k) dst[k] = (ALPHA * x1[k] + g2[k] * y[k] - mu) * rs * lg[k] + lb[k];
}

enum { S_MOD, S_TABA, S_TABB, S_PROJ, S_SWA, S_SSME, S_SSMC, S_SSMO, S_GLU, S_DIF, S_DIFNORM, S_OUTPROJ, S_LN1, S_ROUTE, S_MOEH, S_MOEO, S_LN2 };
template <int S> HD void run_elem(const Params& p, int layer, int idx) {
  if (S == S_MOD) st_mod(p, layer, idx);
  else if (S == S_TABA) st_taba(p, layer, idx);
  else if (S == S_TABB) st_tabb(p, layer, idx);
  else if (S == S_PROJ) st_proj(p, layer, idx);
  else if (S == S_SWA) st_swa(p, layer, idx);
  else if (S == S_SSME) st_ssm_e(p, layer, idx);
  else if (S == S_SSMC) st_ssm_c(p, layer, idx);
  else if (S == S_SSMO) st_ssm_o(p, layer, idx);
  else if (S == S_GLU) st_glu(p, layer, idx);
  else if (S == S_DIF) st_dif(p, layer, idx);
  else if (S == S_DIFNORM) st_difnorm(p, layer, idx);
  else if (S == S_OUTPROJ) st_outproj(p, layer, idx);
  else if (S == S_LN1) st_ln1(p, layer, idx);
  else if (S == S_ROUTE) st_route(p, layer, idx);
  else if (S == S_MOEH) st_moe_h(p, layer, idx);
  else if (S == S_MOEO) st_moe_o(p, layer, idx);
  else if (S == S_LN2) st_ln2(p, layer, idx);
}

constexpr size_t CTL_BYTES = 1u << 20;
struct WsLayout {
  size_t ctl, X, X1, P, Ymix, Gs, modv, ropeT, apow, bbar, KT, E, Sin, route, scal, WinA_t, DifIn_t, total;
};
inline WsLayout ws_layout() {
  WsLayout L; size_t o = 0;
  auto take = [&](size_t bytes) { size_t r = o; o += (bytes + 255) & ~(size_t)255; return r; };
  L.ctl = take(CTL_BYTES);
  L.X = take((size_t)TA * D * 4);
  L.X1 = take((size_t)TA * D * 4);
  L.P = take((size_t)TA * (AB_IN > DIF_IN ? AB_IN : DIF_IN) * 2);
  L.Ymix = take((size_t)TA * YW * 2);
  L.Gs = L.X;
  L.modv = take((size_t)N_MOD * 4);
  L.ropeT = take((size_t)N_ROPE * 2 * 4);
  L.apow = take((size_t)N_APOW * 2 * 4);
  L.bbar = take((size_t)N_BBAR * 2 * 4);
  L.KT = take((size_t)N_KT * 4);
  L.E = take((size_t)N_SSME * 2 * 4);
  L.Sin = take((size_t)N_SSME * 2 * 4);
  L.route = take((size_t)TA * 4 * 4);
  L.scal = take(256);
  L.WinA_t = take((size_t)AB_IN * D * 2);
  L.DifIn_t = take((size_t)DIF_IN * D * 2);
  L.total = o;
  return L;
}
inline void fill_ws(Params& p, char* ws) {
  WsLayout L = ws_layout();
  p.X = (float*)(ws + L.X); p.X1 = (float*)(ws + L.X1); p.P = (uint16_t*)(ws + L.P); p.F = (float*)(ws + L.P);
  p.Ymix = (uint16_t*)(ws + L.Ymix); p.HH = (float*)(ws + L.Ymix); p.Odif = (float*)(ws + L.X1);
  p.Gs = (uint16_t*)(ws + L.Gs); p.modv = (float*)(ws + L.modv); p.ropeT = (float*)(ws + L.ropeT);
  p.apow = (float*)(ws + L.apow); p.bbar = (float*)(ws + L.bbar); p.KT = (float*)(ws + L.KT);
  p.E = (float*)(ws + L.E); p.Sin = (float*)(ws + L.Sin); p.route = (float*)(ws + L.route); p.scal = (float*)(ws + L.scal);
  p.H = (uint16_t*)(ws + L.Ymix); p.WinA_t = (uint16_t*)(ws + L.WinA_t); p.DifIn_t = (uint16_t*)(ws + L.DifIn_t); p.ctl = (unsigned*)(ws + L.ctl);
}
inline void fill_inputs(Params& p, void* const* d_in) {
  const float* const* in = (const float* const*)d_in;
  p.x = in[0]; p.c = in[1]; p.ctx = in[2]; p.c_ctx = in[3]; p.mod_w = in[4]; p.mod_b = in[5];
  p.ln1_g = in[6]; p.ln1_b = in[7]; p.ln2_g = in[8]; p.ln2_b = in[9];
  p.w_in_a = in[10]; p.w_out_a = in[11]; p.sink = in[12]; p.a_re = in[13]; p.a_im = in[14]; p.log_step = in[15];
  p.b_re = in[16]; p.b_im = in[17]; p.c_re = in[18]; p.c_im = in[19]; p.ssm_d = in[20]; p.glu_w = in[21]; p.glu_b = in[22];
  p.dif_w_in = in[23]; p.dif_w_out = in[24]; p.lq1 = in[25]; p.lk1 = in[26]; p.lq2 = in[27]; p.lk2 = in[28]; p.subln_g = in[29];
  p.moe_wg = in[30]; p.moe_bg = in[31]; p.moe_we = in[32]; p.moe_be = in[33]; p.moe_w1 = in[34]; p.moe_w3 = in[35]; p.moe_w2 = in[36];
}

#define FORWARD_PROGRAM(RUN)                                   \
  RUN(S_MOD, 0, N_MOD)                                         \
  RUN(S_TABA, 0, N_TABA)                                       \
  RUN(S_TABB, 0, N_KT)                                         \
                                                   \
  RUN(S_PROJ, 0, TA * AB_IN)                                   \
  RUN(S_SWA, 0, SWA_H * TA)                                    \
  RUN(S_SSME, 0, N_SSME)                                       \
  RUN(S_SSMC, 0, N_SSMC)                                       \
  RUN(S_SSMO, 0, TA * SSM_W)                                   \
  RUN(S_GLU, 0, TA * SSM_W)                                    \
  RUN(S_OUTPROJ, 0, TA * D)                                    \
  RUN(S_LN1, 0, TA)                                            \
  RUN(S_ROUTE, 0, TA)                                          \
  RUN(S_MOEH, 0, TA * 2 * MOE_F)                               \
  RUN(S_MOEO, 0, TA * D)                                       \
  RUN(S_LN2, 0, TA)                                            \
                                                   \
  RUN(S_PROJ, 1, TA * DIF_IN)                                  \
  RUN(S_DIF, 1, DIF_H * 2 * TL)                                \
  RUN(S_DIFNORM, 1, TL * DIF_H)                                \
  RUN(S_OUTPROJ, 1, TL * D)                                    \
  RUN(S_LN1, 1, TL)                                            \
  RUN(S_ROUTE, 1, TL)                                          \
  RUN(S_MOEH, 1, TL * 2 * MOE_F)                               \
  RUN(S_MOEO, 1, TL * D)                                       \
  RUN(S_LN2, 1, TL)

#ifndef HOST_EMU
#include <cstdio>
#define LAS __attribute__((address_space(3)))
#define GAS __attribute__((address_space(1)))
typedef unsigned short bf16_t;
typedef short bf16x8 __attribute__((ext_vector_type(8)));
typedef float f32x4 __attribute__((ext_vector_type(4)));
typedef float f32x2 __attribute__((ext_vector_type(2)));
typedef unsigned u32x4 __attribute__((ext_vector_type(4)));
typedef unsigned u32x2 __attribute__((ext_vector_type(2)));
constexpr int NWAVES = 8, NTHR = 512;
constexpr int RING_BYTES = 131072, LDSCTL_OFF = RING_BYTES, MISC_OFF = LDSCTL_OFF + 320, LDS_BYTES = 147456;
#define LDS_WAIT() asm volatile("s_waitcnt lgkmcnt(0)" ::: "memory")
#define VM_WAIT() asm volatile("s_waitcnt vmcnt(0)" ::: "memory")
__device__ __forceinline__ unsigned cvt_pk_bf16(float lo, float hi) { unsigned r; asm volatile("v_cvt_pk_bf16_f32 %0, %1, %2" : "=v"(r) : "v"(lo), "v"(hi)); return r; }

namespace pg8 {
constexpr int BM = 256, BK = 64, HALF = 128, HTB = HALF * BK * 2, STAGE_BYTES = 8 * HTB, NXCD = 8, WGM = 8;
__host__ __device__ __forceinline__ int lds_byte(int r, int c) { const int st = (r >> 4) * 2 + (c >> 5), rr = r & 15, cc = c & 31, ob = rr * 64 + cc * 2; return st * 1024 + (ob ^ (((ob >> 9) & 1) << 5)); }
__host__ __device__ __forceinline__ void stage_rc(int b, int& R, int& C) { const int st = b / 1024, sb = b % 1024, swz = sb ^ (((sb >> 9) & 1) << 5); R = (st >> 1) * 16 + swz / 64; C = (st & 1) * 32 + (swz % 64) / 2; }
__host__ __device__ __forceinline__ int perm32(int rho) { const int n = rho >> 4, i = rho & 15; return 8 * (i >> 2) + 4 * n + (i & 3); }
struct Unit { int pm, pn; };
struct Gemm { const bf16_t* A; const bf16_t* Bt; int lda, ldb, K; };

struct StaticOrder {
  int nM, nN, nwg, G, c;
  __device__ void init(int M, int N, int G_, int c_) { nM = M / BM; nN = N / BM; nwg = nM * nN; G = G_; c = c_; }
  __device__ bool next(int i, Unit& u) const {
    const long L = (long)i * G + c; if (L >= nwg) return false;
    int wgid = (int)L; { const int q = nwg / NXCD, r = nwg % NXCD, xcd = wgid % NXCD, off = wgid / NXCD; wgid = (xcd < r ? xcd * (q + 1) : r * (q + 1) + (xcd - r) * q) + off; }
    const int nig = WGM * nN, gid = wgid / nig, fm = gid * WGM, gsz = (nM - fm) < WGM ? (nM - fm) : WGM;
    u.pm = fm + ((wgid % nig) % gsz); u.pn = (wgid % nig) / gsz; return true;
  }
  __device__ __forceinline__ void a_ready(const Unit&) const {}
  __device__ __forceinline__ void done(const Unit&) const {}
};

template <class Epi, class Sched, bool ALIGN_EPI = true, bool SP2 = true>
__device__ __forceinline__ void gemm_phase(LAS unsigned char* lds, const Gemm g, const Sched& S, const Epi& E) {
  const int tid = threadIdx.x, wid = __builtin_amdgcn_readfirstlane(tid >> 6), lane = tid & 63, wr = wid >> 2, wc = wid & 3, fr = lane & 15, fq = lane >> 4;
  const int K = g.K, nt = K / BK;
  unsigned voffA[2], voffB[2];
#pragma unroll
  for (int i = 0; i < 2; ++i) { int R, C; stage_rc(tid * 16 + i * 8192, R, C); const int Rb = Epi::PERM ? ((R & ~31) + perm32(R & 31)) : R;
    voffA[i] = (unsigned)(R * g.lda + C) * 2u; voffB[i] = (unsigned)(Rb * g.ldb + C) * 2u; }
  const size_t kstep = (size_t)(BK * 2);
  const size_t hA = (size_t)HALF * g.lda * 2, hB = (size_t)HALF * g.ldb * 2;
  const size_t tA = 2 * hA, tB = 2 * hB;
  const unsigned ldsw = (unsigned)wid * 1024u;
  const int aoff = lds_byte(wr * 64 + fr, fq * 8), boff = lds_byte(wc * 32 + fr, fq * 8);
#define PG8_SA(b, h) (((b) * 2 + (h)) * HTB)
#define PG8_SB(b, h) ((4 + (b) * 2 + (h)) * HTB)
#define PG8_STAGE(bufoff, gbase, voff) do { _Pragma("unroll") for (int _i = 0; _i < 2; ++_i) \
    __builtin_amdgcn_global_load_lds((const unsigned*)((const char*)(gbase) + (voff)[_i]), (LAS unsigned*)(lds + (bufoff) + ldsw + _i * 8192), 16, 0, 0); } while (0)
#define PG8_LDA(dst, b, h) do { _Pragma("unroll") for (int m = 0; m < 4; ++m) _Pragma("unroll") for (int k = 0; k < 2; ++k) dst[m][k] = *(const LAS bf16x8*)(lds + PG8_SA(b, h) + aoff + m * 2048 + k * 1024); } while (0)
#define PG8_LDB(dst, b, h) do { _Pragma("unroll") for (int n = 0; n < 2; ++n) _Pragma("unroll") for (int k = 0; k < 2; ++k) dst[n][k] = *(const LAS bf16x8*)(lds + PG8_SB(b, h) + boff + n * 2048 + k * 1024); } while (0)
#define PG8_MMA(ai, bj, At, Bt) do { __builtin_amdgcn_s_setprio(1); _Pragma("unroll") for (int m = 0; m < 4; ++m) _Pragma("unroll") for (int n = 0; n < 2; ++n) _Pragma("unroll") for (int k = 0; k < 2; ++k) \
    acc[ai][bj][m][n] = __builtin_amdgcn_mfma_f32_16x16x32_bf16(Bt[n][k], At[m][k], acc[ai][bj][m][n], 0, 0, 0); __builtin_amdgcn_s_setprio(0); } while (0)
#define PG8_WAIT_V(n) asm volatile("s_waitcnt vmcnt(" #n ")" ::: "memory")
#define PG8_WAIT_L(n) asm volatile("s_waitcnt lgkmcnt(" #n ")" ::: "memory")
#define PG8_BAR __builtin_amdgcn_s_barrier()
#define PG8_SCHED __builtin_amdgcn_sched_barrier(0)
  Unit cur, nxt; int ui = 0;
  if (!S.next(0, cur)) return;
  f32x4 acc[2][2][4][2];
#pragma unroll
  for (int a = 0; a < 2; ++a)
#pragma unroll
    for (int b = 0; b < 2; ++b)
#pragma unroll
      for (int m = 0; m < 4; ++m)
#pragma unroll
        for (int n = 0; n < 2; ++n) acc[a][b][m][n] = (f32x4){0.f, 0.f, 0.f, 0.f};
  bf16x8 At[4][2], B0[2][2], B1[2][2];
  const char* cA = (const char*)g.A + (size_t)cur.pm * tA; const char* cB = (const char*)g.Bt + (size_t)cur.pn * tB;
  S.a_ready(cur);
  if constexpr (SP2) {
    PG8_STAGE(PG8_SB(0, 0), cB, voffB); PG8_STAGE(PG8_SB(0, 1), cB + hB, voffB); PG8_STAGE(PG8_SA(0, 0), cA, voffA); PG8_STAGE(PG8_SA(0, 1), cA + hA, voffA);
    if (wr == 1) PG8_BAR;
    PG8_WAIT_V(2); PG8_BAR;
    PG8_STAGE(PG8_SB(1, 0), cB + kstep, voffB); PG8_STAGE(PG8_SA(1, 0), cA + kstep, voffA); PG8_STAGE(PG8_SB(1, 1), cB + hB + kstep, voffB);
    PG8_WAIT_V(6); PG8_BAR;
  } else {
    PG8_STAGE(PG8_SB(0, 0), cB, voffB); PG8_STAGE(PG8_SA(0, 0), cA, voffA); PG8_STAGE(PG8_SB(0, 1), cB + hB, voffB); PG8_STAGE(PG8_SA(0, 1), cA + hA, voffA);
    if (wr == 1) PG8_BAR;
    PG8_WAIT_V(4); PG8_BAR;
    PG8_STAGE(PG8_SB(1, 0), cB + kstep, voffB); PG8_STAGE(PG8_SA(1, 0), cA + kstep, voffA); PG8_STAGE(PG8_SB(1, 1), cB + hB + kstep, voffB);
    PG8_WAIT_V(6); PG8_BAR;
  }
  for (;;) {
    const bool has_next = S.next(ui + 1, nxt);
    const char* nA = has_next ? (const char*)g.A + (size_t)nxt.pm * tA : cA; const char* nB = has_next ? (const char*)g.Bt + (size_t)nxt.pn * tB : cB;
    for (int t = 0; t < nt; t += 2) {
      const bool last = (t == nt - 2);
      const char* a1 = cA + (size_t)(t + 1) * kstep;
      const char* a2 = last ? nA : cA + (size_t)(t + 2) * kstep; const char* b2 = last ? nB : cB + (size_t)(t + 2) * kstep;
      const char* a3 = a2 + kstep; const char* b3 = b2 + kstep;
      if (last && has_next) S.a_ready(nxt);
      if constexpr (SP2) {
        PG8_LDB(B0, 0, 0); PG8_LDB(B1, 0, 1); PG8_SCHED; PG8_LDA(At, 0, 0); PG8_STAGE(PG8_SA(1, 1), a1 + hA, voffA);
        PG8_WAIT_V(8); PG8_WAIT_L(0); PG8_BAR; PG8_MMA(0, 0, At, B0); PG8_MMA(0, 1, At, B1); PG8_BAR; PG8_SCHED;
        PG8_LDA(At, 0, 1); PG8_STAGE(PG8_SB(0, 0), b2, voffB); PG8_STAGE(PG8_SB(0, 1), b2 + hB, voffB); PG8_STAGE(PG8_SA(0, 0), a2, voffA);
        PG8_WAIT_V(8); PG8_WAIT_L(0); PG8_BAR; PG8_MMA(1, 0, At, B0); PG8_MMA(1, 1, At, B1); PG8_BAR; PG8_SCHED;
        PG8_LDB(B0, 1, 0); PG8_LDB(B1, 1, 1); PG8_SCHED; PG8_LDA(At, 1, 0); PG8_STAGE(PG8_SA(0, 1), a2 + hA, voffA);
        PG8_WAIT_V(8); PG8_WAIT_L(0); PG8_BAR; PG8_MMA(0, 0, At, B0); PG8_MMA(0, 1, At, B1); PG8_BAR; PG8_SCHED;
        PG8_LDA(At, 1, 1); PG8_STAGE(PG8_SB(1, 0), b3, voffB); PG8_STAGE(PG8_SB(1, 1), b3 + hB, voffB); PG8_STAGE(PG8_SA(1, 0), a3, voffA);
        PG8_WAIT_V(8); PG8_WAIT_L(0); PG8_BAR; PG8_MMA(1, 0, At, B0); PG8_MMA(1, 1, At, B1); PG8_BAR; PG8_SCHED;
      } else {
        PG8_LDB(B0, 0, 0); PG8_SCHED; PG8_LDA(At, 0, 0); PG8_STAGE(PG8_SA(1, 1), a1 + hA, voffA);
        PG8_WAIT_L(8); PG8_BAR; PG8_WAIT_L(0); PG8_MMA(0, 0, At, B0); PG8_BAR; PG8_SCHED;
        PG8_LDB(B1, 0, 1); PG8_STAGE(PG8_SB(0, 0), b2, voffB);
        PG8_BAR; PG8_WAIT_L(0); PG8_MMA(0, 1, At, B1); PG8_BAR;
        PG8_LDA(At, 0, 1); PG8_STAGE(PG8_SA(0, 0), a2, voffA);
        PG8_BAR; PG8_WAIT_L(0); PG8_MMA(1, 0, At, B0); PG8_BAR; PG8_SCHED;
        PG8_STAGE(PG8_SB(0, 1), b2 + hB, voffB);
        PG8_WAIT_V(6); PG8_BAR; PG8_MMA(1, 1, At, B1); PG8_BAR;
        PG8_LDB(B0, 1, 0); PG8_SCHED; PG8_LDA(At, 1, 0); PG8_STAGE(PG8_SA(0, 1), a2 + hA, voffA);
        PG8_WAIT_L(8); PG8_BAR; PG8_WAIT_L(0); PG8_MMA(0, 0, At, B0); PG8_BAR; PG8_SCHED;
        PG8_LDB(B1, 1, 1); PG8_STAGE(PG8_SB(1, 0), b3, voffB);
        PG8_BAR; PG8_WAIT_L(0); PG8_MMA(0, 1, At, B1); PG8_BAR;
        PG8_LDA(At, 1, 1); PG8_STAGE(PG8_SA(1, 0), a3, voffA);
        PG8_BAR; PG8_WAIT_L(0); PG8_MMA(1, 0, At, B0); PG8_BAR; PG8_SCHED;
        PG8_STAGE(PG8_SB(1, 1), b3 + hB, voffB);
        PG8_WAIT_V(6); PG8_BAR; PG8_MMA(1, 1, At, B1); PG8_BAR;
      }
    }
    if constexpr (ALIGN_EPI) { if (wr == 0) PG8_BAR; }
    E(acc, cur, wr, wc, fr, fq); S.done(cur);
    if (!has_next) break;
#pragma unroll
    for (int a = 0; a < 2; ++a)
#pragma unroll
      for (int b = 0; b < 2; ++b)
#pragma unroll
        for (int m = 0; m < 4; ++m)
#pragma unroll
          for (int n = 0; n < 2; ++n) acc[a][b][m][n] = (f32x4){0.f, 0.f, 0.f, 0.f};
    cur = nxt; cA = nA; cB = nB; ++ui;
    if constexpr (ALIGN_EPI) { if (wr == 1) PG8_BAR; }
  }
  PG8_WAIT_V(0);
  if constexpr (!ALIGN_EPI) { if (wr == 0) PG8_BAR; }
  PG8_BAR;
#undef PG8_SA
#undef PG8_SB
#undef PG8_STAGE
#undef PG8_LDA
#undef PG8_LDB
#undef PG8_MMA
#undef PG8_WAIT_V
#undef PG8_WAIT_L
#undef PG8_BAR
#undef PG8_SCHED
}
}

struct EpiProj {
  static constexpr bool PERM = false;
  bf16_t* O; int ldc; int rope_end; const float* ropeT;
  __device__ __forceinline__ void operator()(const f32x4 (&acc)[2][2][4][2], const pg8::Unit& u, int wr, int wc, int fr, int fq) const {
    const int row0 = u.pm * 256 + wr * 64 + fr, colb = u.pn * 256 + wc * 32;
    const bool rope_cols = colb < rope_end;
#pragma unroll
    for (int ai = 0; ai < 2; ++ai)
#pragma unroll
      for (int m = 0; m < 4; ++m) {
        const int r = row0 + ai * 128 + m * 16;
        bf16_t* rowp = O + (size_t)r * ldc + colb + 4 * fq;
        f32x4 cs0 = {1.f, 0.f, 1.f, 0.f}, cs1 = {1.f, 0.f, 1.f, 0.f};
        const bool rp = rope_cols && (r < TL);
        if (rp) { const int i = r % N; const int pos = (wc & 1) ? (i % GRID_W) : (i / GRID_W);
          const f32x4* tp = (const f32x4*)(ropeT + (size_t)(pos * 16 + 4 * fq) * 2); cs0 = tp[0]; cs1 = tp[1]; }
#pragma unroll
        for (int bj = 0; bj < 2; ++bj) {
          const bool rpb = rp && (colb + bj * 128 < rope_end);
          f32x4 a1 = acc[ai][bj][m][0], a2 = acc[ai][bj][m][1];
          f32x4 o1 = a1, o2 = a2;
          if (rpb) {
            o1[0] = a1[0] * cs0[0] - a2[0] * cs0[1]; o2[0] = a2[0] * cs0[0] + a1[0] * cs0[1];
            o1[1] = a1[1] * cs0[2] - a2[1] * cs0[3]; o2[1] = a2[1] * cs0[2] + a1[1] * cs0[3];
            o1[2] = a1[2] * cs1[0] - a2[2] * cs1[1]; o2[2] = a2[2] * cs1[0] + a1[2] * cs1[1];
            o1[3] = a1[3] * cs1[2] - a2[3] * cs1[3]; o2[3] = a2[3] * cs1[2] + a1[3] * cs1[3];
          }
          u32x2 w1 = {cvt_pk_bf16(o1[0], o1[1]), cvt_pk_bf16(o1[2], o1[3])}, w2 = {cvt_pk_bf16(o2[0], o2[1]), cvt_pk_bf16(o2[2], o2[3])};
          *(u32x2*)(rowp + bj * 128) = w1; *(u32x2*)(rowp + bj * 128 + 16) = w2;
        }
      }
  }
};

#define XB_TMO      128
#define XB_XCNT(j)  (256  + 64 * (j))
#define XB_XSUB(j)  (1280 + 64 * (j))
#define XB_XGEN(j)  (2304 + 64 * (j))
#define XB_TOP      3328
#define XB_TOPGEN   3392
#define XCD_BAR_WORDS 3456
#define XB_SPIN_CAP (1u << 22)
constexpr int CW_BAR = 4096;
__device__ __forceinline__ unsigned xb_ld(unsigned* p)              { return __hip_atomic_load(p, __ATOMIC_RELAXED, __HIP_MEMORY_SCOPE_AGENT); }
__device__ __forceinline__ unsigned xb_add(unsigned* p, unsigned v) { return __hip_atomic_fetch_add(p, v, __ATOMIC_RELAXED, __HIP_MEMORY_SCOPE_AGENT); }
__device__ __forceinline__ unsigned xb_xcc_id() { return (unsigned)__builtin_amdgcn_s_getreg((3 << 11) | 20) & 0xFu; }
#define XB_SPIN(cond, bar) do { unsigned _sp = 0; while (cond) { __builtin_amdgcn_s_sleep(1); \
    if ((++_sp & 255u) == 0u) { if (xb_ld(&(bar)[XB_TMO])) break; if (_sp > XB_SPIN_CAP) { atomicAdd(&(bar)[XB_TMO], 1u); break; } } } } while (0)
struct XcdBarrier { unsigned* bar; unsigned x; volatile LAS unsigned* st; };
__device__ __forceinline__ XcdBarrier xcd_barrier_post(unsigned* bar, volatile LAS unsigned* st) {
  XcdBarrier b; b.bar = bar; b.x = xb_xcc_id(); b.st = st;
  if (threadIdx.x == 0) (void)xb_add(&bar[XB_XCNT(b.x)], 1u);
  return b;
}
__device__ __forceinline__ void xcd_barrier_complete(unsigned* bar, unsigned x, unsigned& nloc, unsigned& nx) {
  const unsigned G = gridDim.x * gridDim.y * gridDim.z;
  unsigned sum, cnt, mine, sp = 0u;
  for (;;) {
    sum = 0u; cnt = 0u; mine = 0u;
#pragma unroll
    for (unsigned j = 0; j < 16; ++j) { const unsigned c = xb_ld(&bar[XB_XCNT(j)]); sum += c; cnt += (c > 0u) ? 1u : 0u; mine = (j == x) ? c : mine; }
    if (sum == G) break;
    __builtin_amdgcn_s_sleep(1);
    if ((++sp & 255u) == 0u) { if (xb_ld(&bar[XB_TMO])) break; if (sp > XB_SPIN_CAP) { atomicAdd(&bar[XB_TMO], 1u); break; } }
  }
  nloc = mine > 0u ? mine : 1u; nx = cnt > 0u ? cnt : 1u;
}
__device__ __forceinline__ void xcd_barrier(const XcdBarrier& b) {
  asm volatile("s_waitcnt vmcnt(0)" ::: "memory");
  __syncthreads();
  if (threadIdx.x == 0) {
    unsigned* bar = b.bar;
    __builtin_amdgcn_s_waitcnt(0);
    unsigned nloc = b.st[0], nx = b.st[1];
    if (nloc == 0u) { xcd_barrier_complete(bar, b.x, nloc, nx); b.st[0] = nloc; b.st[1] = nx; }
    const unsigned old = xb_add(&bar[XB_XSUB(b.x)], 1u);
    const unsigned gen = old / nloc;
    if (old + 1u == (gen + 1u) * nloc) {
      __builtin_amdgcn_fence(__ATOMIC_RELEASE, "agent");
      asm volatile("s_waitcnt vmcnt(0)" ::: "memory");
      const unsigned og = xb_add(&bar[XB_TOP], 1u);
      const unsigned tg = og / nx;
      if (og + 1u == (tg + 1u) * nx) xb_add(&bar[XB_TOPGEN], 1u);
      else XB_SPIN(xb_ld(&bar[XB_TOPGEN]) == tg, bar);
      __builtin_amdgcn_fence(__ATOMIC_ACQUIRE, "agent");
      xb_add(&bar[XB_XGEN(b.x)], 1u);
      asm volatile("s_waitcnt vmcnt(0)" ::: "memory");
    } else {
      XB_SPIN(xb_ld(&bar[XB_XGEN(b.x)]) == gen, bar);
      __builtin_amdgcn_fence(__ATOMIC_ACQUIRE, "agent");
      asm volatile("s_waitcnt vmcnt(0)" ::: "memory");
    }
  }
  __syncthreads();
}

__device__ __forceinline__ unsigned pk2(float lo, float hi) { return (unsigned)f2bf(lo) | ((unsigned)f2bf(hi) << 16); }
__device__ __forceinline__ void transpose_item(const float* W, int K, int N, bf16_t* WT, int k0, int n0, int dst_row0, LAS float* scr, int lane) {
#pragma unroll 8
  for (int i = 0; i < 32; ++i) { const int kk = 2 * i + (lane >> 5); scr[kk * 33 + (lane & 31)] = W[(size_t)(k0 + kk) * N + n0 + (lane & 31)]; }
  LDS_WAIT(); asm volatile("" ::: "memory");
  const int c = lane & 7;
#pragma unroll
  for (int j = 0; j < 4; ++j) { const int n = (lane >> 3) + 8 * j; const LAS float* s = scr + (8 * c) * 33 + n;
    u32x4 o; o.x = pk2(s[0 * 33], s[1 * 33]); o.y = pk2(s[2 * 33], s[3 * 33]); o.z = pk2(s[4 * 33], s[5 * 33]); o.w = pk2(s[6 * 33], s[7 * 33]);
    *(u32x4*)(WT + (size_t)(dst_row0 + n) * K + k0 + 8 * c) = o; }
  LDS_WAIT(); asm volatile("" ::: "memory");
}
__device__ __forceinline__ void transpose_matrix(const float* W, int K, int N, bf16_t* WT, LAS float* scr, int gw, int ngw, int lane) {
  const int nblk = N / 32, items = (K / 64) * nblk;
  for (int it = gw; it < items; it += ngw) { const int kb = it / nblk, nb = it % nblk; transpose_item(W, K, N, WT, 64 * kb, 32 * nb, 32 * nb, scr, lane); }
}
__device__ __forceinline__ void mod_row_to_bf16(const float* xr, const float* sc, const float* sh, bf16_t* orow, int lane) {
  const f32x4* x4 = (const f32x4*)xr + lane; const f32x4* c4 = (const f32x4*)sc + lane; const f32x4* h4 = (const f32x4*)sh + lane;
  unsigned long long* o8 = (unsigned long long*)orow + lane;
#pragma unroll
  for (int j = 0; j < 4; ++j) { const f32x4 v = x4[64 * j], c = c4[64 * j], h = h4[64 * j];
    const float a = v.x * (1.f + c.x) + h.x, b = v.y * (1.f + c.y) + h.y, cc = v.z * (1.f + c.z) + h.z, d = v.w * (1.f + c.w) + h.w;
    o8[64 * j] = (unsigned long long)pk2(a, b) | ((unsigned long long)pk2(cc, d) << 32); }
}

__global__ void __launch_bounds__(NTHR, 2) mega_kernel(Params p_by_value) {
  const Params& p = *(const Params*)__builtin_amdgcn_kernarg_segment_ptr();
  extern __shared__ __attribute__((aligned(16))) unsigned char lds_raw[];
  LAS unsigned char* lds = (LAS unsigned char*)lds_raw;
  volatile LAS unsigned* MISC = (volatile LAS unsigned*)(lds + MISC_OFF);
  const int tid = threadIdx.x, lane = tid & 63, wave = __builtin_amdgcn_readfirstlane(tid >> 6);
  const int G = gridDim.x;
  const int vcu = (G % 8 == 0) ? (int)(blockIdx.x % 8) * (G / 8) + (int)blockIdx.x / 8 : (int)blockIdx.x;
  const int gw = vcu * NWAVES + wave, ngw = G * NWAVES;
  for (int u = tid; u < (LDS_BYTES - LDSCTL_OFF) / 4; u += NTHR) ((LAS unsigned*)(lds + LDSCTL_OFF))[u] = 0u;
  __syncthreads();
  XcdBarrier bar = xcd_barrier_post(p.ctl + CW_BAR, MISC + 8);
#define GRID_BAR() xcd_barrier(bar)
#define RUN_NAIVE(S, layer, cnt)                                                                                  \
  {                                                                                                               \
    const int n_ = (cnt);                                                                                         \
    for (int idx = blockIdx.x * NTHR + tid; idx < n_; idx += G * NTHR) run_elem<S>(p, layer, idx);                \
  }
  LAS float* scr = (LAS float*)(lds + wave * 16384);

  RUN_NAIVE(S_MOD, 0, N_MOD)
  RUN_NAIVE(S_TABA, 0, N_TABA)
  transpose_matrix(p.w_in_a, D, AB_IN, p.WinA_t, scr, gw, ngw, lane);
  transpose_matrix(p.dif_w_in, D, DIF_IN, p.DifIn_t, scr, gw, ngw, lane);
  GRID_BAR();
  RUN_NAIVE(S_TABB, 0, N_KT)
#define LAYER_FRONT(layer, NW_, WT_, ROPE_END_)                                                                         \
  for (int m = gw; m < TA; m += ngw) { const int r = tok_r(m); mod_row_to_bf16(xrow(p, layer, m), modp(p, layer, r, 1), modp(p, layer, r, 0), p.H + (size_t)m * D, lane); } \
  GRID_BAR();                                                                                                           \
  {                                                                                                                     \
    pg8::Gemm g{p.H, WT_, D, D, D};                                                                                     \
    pg8::StaticOrder S; S.init(TA, NW_, G, (int)blockIdx.x);                                                            \
    EpiProj E{p.P, NW_, ROPE_END_, p.ropeT};                                                                            \
    pg8::gemm_phase<EpiProj, pg8::StaticOrder>(lds, g, S, E);                                                           \
  }                                                                                                                     \
  GRID_BAR();
#define LAYER_BACK(layer, T)                      \
  RUN_NAIVE(S_OUTPROJ, layer, T * D)              \
  GRID_BAR();                                     \
  RUN_NAIVE(S_LN1, layer, T)                      \
  GRID_BAR();                                     \
  RUN_NAIVE(S_ROUTE, layer, T)                    \
  GRID_BAR();                                     \
  RUN_NAIVE(S_MOEH, layer, T * 2 * MOE_F)         \
  GRID_BAR();                                     \
  RUN_NAIVE(S_MOEO, layer, T * D)                 \
  GRID_BAR();                                     \
  RUN_NAIVE(S_LN2, layer, T)                      \
  GRID_BAR();

  LAYER_FRONT(0, AB_IN, p.WinA_t, (SWA_QW + SWA_KVW))
  RUN_NAIVE(S_SWA, 0, SWA_H * TA)
  RUN_NAIVE(S_SSME, 0, N_SSME)
  GRID_BAR();
  RUN_NAIVE(S_SSMC, 0, N_SSMC)
  GRID_BAR();
  RUN_NAIVE(S_SSMO, 0, TA * SSM_W)
  GRID_BAR();
  RUN_NAIVE(S_GLU, 0, TA * SSM_W)
  GRID_BAR();
  LAYER_BACK(0, TA)
  LAYER_FRONT(1, DIF_IN, p.DifIn_t, (2 * DIF_QK))
  RUN_NAIVE(S_DIF, 1, DIF_H * 2 * TL)
  GRID_BAR();
  RUN_NAIVE(S_DIFNORM, 1, TL * DIF_H)
  GRID_BAR();
  LAYER_BACK(1, TL)
}

extern "C" void kernel_launch(void* const* d_in, const int* in_sizes, int n_in, void* d_out, int out_size, void* d_ws,
                              size_t ws_size, hipStream_t stream) {
  static int grid = 0;
  if (grid == 0) {
    if (ws_layout().total > ws_size || n_in != 37 || out_size != TL * D) { fprintf(stderr, "kernel_launch: bad sizes (ws need %zu have %zu)\n", ws_layout().total, ws_size); grid = -1; return; }
    int dev = 0, cus = 0;
    if (hipGetDevice(&dev) != hipSuccess || hipDeviceGetAttribute(&cus, hipDeviceAttributeMultiprocessorCount, dev) != hipSuccess) { grid = -1; return; }
    if (hipFuncSetAttribute((const void*)mega_kernel, hipFuncAttributeMaxDynamicSharedMemorySize, LDS_BYTES) != hipSuccess) { fprintf(stderr, "kernel_launch: hipFuncSetAttribute failed\n"); grid = -1; return; }
    grid = cus;
  }
  if (grid < 0) return;
  Params p{};
  fill_inputs(p, d_in);
  p.out = (float*)d_out;
  fill_ws(p, (char*)d_ws);
  if (hipMemsetAsync((char*)d_ws + ws_layout().ctl, 0, CTL_BYTES, stream) != hipSuccess) { fprintf(stderr, "kernel_launch: memset failed\n"); return; }
  hipLaunchKernelGGL(mega_kernel, dim3(grid), dim3(NTHR), LDS_BYTES, stream, p);
  const hipError_t le = hipPeekAtLastError();
  if (le != hipSuccess) fprintf(stderr, "kernel_launch: launch failed: %s\n", hipGetErrorName(le));
}
#endif
```

```cpp
#ifndef HOST_EMU
#include <hip/hip_runtime.h>
#define HD __host__ __device__ __forceinline__
#else
#define HD inline
#endif
#include <stdint.h>
#include <math.h>

#ifndef CFG_D
#define CFG_D 1024
#define CFG_B 8
#define CFG_N 2048
#define CFG_CTX 256
#endif

constexpr int D = CFG_D, B = CFG_B, N = CFG_N, CTX = CFG_CTX;
constexpr int DEPTH = 2, GRID_W = 64, HD_ = 64;
constexpr int TL = B * N, TC = B * CTX, TA = TL + TC;
constexpr int SWA_H = 8, SWA_QW = 512, SWA_KVW = 128, SWA_WIN = 128;
constexpr int SSM_W = D / 2, SSM_C = 16, SSM_G = SSM_W / 16, SSM_P = 64;
constexpr int AB_IN = SWA_QW + 2 * SWA_KVW + SSM_W;
constexpr int AB_OUT = SWA_QW + SSM_W;
constexpr int A_KOFF = SWA_QW, A_VOFF = SWA_QW + SWA_KVW, A_UOFF = SWA_QW + 2 * SWA_KVW;
constexpr int DIF_H = D / 128, DIF_QK = DIF_H * 128, DIF_VW = DIF_H * 128, DIF_IN = 2 * DIF_QK + DIF_VW;
constexpr int MOE_G = 4, MOE_EPG = 8, MOE_E = 32, MOE_F = D / 4;
constexpr int SL = 64;
constexpr int SS = CTX + N;
constexpr int NCH = SS / SL;
constexpr float LN_EPS = 1e-5f, RMS_EPS = 1e-5f;
constexpr float ALPHA = 1.41421356237309515f;
static_assert(CTX % SL == 0 && N % SL == 0, "chunking");
constexpr int YW = AB_OUT > D ? AB_OUT : D;

struct Params {
  const float *x, *c, *ctx, *c_ctx, *mod_w, *mod_b, *ln1_g, *ln1_b, *ln2_g, *ln2_b;
  const float *w_in_a, *w_out_a, *sink, *a_re, *a_im, *log_step, *b_re, *b_im, *c_re, *c_im, *ssm_d, *glu_w, *glu_b;
  const float *dif_w_in, *dif_w_out, *lq1, *lk1, *lq2, *lk2, *subln_g;
  const float *moe_wg, *moe_bg, *moe_we, *moe_be, *moe_w1, *moe_w3, *moe_w2;
  float* out;
  float *X, *X1, *F, *HH;
  uint16_t *P, *Ymix, *Gs;
  float *modv, *ropeT, *apow, *bbar, *KT, *E, *Sin, *route, *scal;
  uint16_t *H;
  uint16_t *WinA_t, *DifIn_t, *WoutA_t, *DifOut_t, *Glu_t, *W13t, *W2t;
  uint16_t *Amoe, *HHb, *F2;
  float* gate;
  int *tokslot, *moe_meta;
  unsigned* ctl;
};

HD uint16_t f2bf(float f) {
  uint32_t u = __builtin_bit_cast(uint32_t, f);
  u += 0x7fffu + ((u >> 16) & 1u);
  return (uint16_t)(u >> 16);
}
HD float bf2f(uint16_t h) {
  uint32_t u = ((uint32_t)h) << 16;
  return __builtin_bit_cast(float, u);
}
HD float siluf(float x) { return x / (1.0f + expf(-x)); }
HD float sigmoidf_(float x) { return 1.0f / (1.0f + expf(-x)); }
HD float geluf_(float x) { return 0.5f * x * (1.0f + tanhf(0.7978845608028654f * (x + 0.044715f * x * x * x))); }

HD int tok_r(int t) { return t < TL ? t / N : B; }
HD const float* xrow(const Params& p, int layer, int t) {
  if (layer == 0) return t < TL ? p.x + (size_t)t * D : p.ctx + (size_t)(t - TL) * D;
  return p.X + (size_t)t * D;
}
HD const float* modp(const Params& p, int layer, int r, int which) {
  return p.modv + ((size_t)(layer * (B + 1) + r) * 6 + which) * D;
}

constexpr int N_MOD = DEPTH * (B + 1) * 6 * D;
HD void st_mod(const Params& p, int layer_unused, int idx) {
  int j = idx % (6 * D); int r = (idx / (6 * D)) % (B + 1); int l = idx / (6 * D * (B + 1));
  const float* cv = r < B ? p.c + (size_t)r * D : p.c_ctx;
  const float* w = p.mod_w + (size_t)l * D * 6 * D;
  float acc = p.mod_b[(size_t)l * 6 * D + j];
  for (int k = 0; k < D; ++k) acc += siluf(cv[k]) * w[(size_t)k * 6 * D + j];
  p.modv[idx] = acc;
}

constexpr int N_ROPE = 64 * 16;
constexpr int N_APOW = 2 * SSM_G * SSM_P * (SL + 1);
constexpr int N_BBAR = 2 * SSM_G * SSM_P * SSM_C;
constexpr int N_TABA = N_ROPE + N_APOW + N_BBAR + 1;
HD void st_taba(const Params& p, int layer_unused, int idx) {
  if (idx < N_ROPE) {
    int pos = idx / 16, f = idx % 16;
    float inv = powf(10000.0f, -(float)f / 16.0f);
    float ang = (float)pos * inv;
    p.ropeT[idx * 2] = cosf(ang); p.ropeT[idx * 2 + 1] = sinf(ang);
    return;
  }
  idx -= N_ROPE;
  if (idx < N_APOW) {
    int k = idx % (SL + 1); int q = idx / (SL + 1);
    int dg = q / SSM_P;
    double dt = exp((double)p.log_step[dg]);
    double ar = p.a_re[q], ai = p.a_im[q];
    double mag = exp(k * dt * ar);
    p.apow[(size_t)idx * 2] = (float)(mag * cos(k * dt * ai));
    p.apow[(size_t)idx * 2 + 1] = (float)(mag * sin(k * dt * ai));
    return;
  }
  idx -= N_APOW;
  if (idx < N_BBAR) {
    int cc = idx % SSM_C; int q = idx / SSM_C; int dg = q / SSM_P;
    (void)cc;
    double dt = exp((double)p.log_step[dg]);
    double ar = p.a_re[q], ai = p.a_im[q];
    double mag = exp(dt * ar);
    double abr = mag * cos(dt * ai), abi = mag * sin(dt * ai);
    double den = ar * ar + ai * ai, nr = abr - 1.0;
    double cr = (nr * ar + abi * ai) / den, ci = (abi * ar - nr * ai) / den;
    double br = p.b_re[idx], bi = p.b_im[idx];
    p.bbar[(size_t)idx * 2] = (float)(cr * br - ci * bi);
    p.bbar[(size_t)idx * 2 + 1] = (float)(cr * bi + ci * br);
    return;
  }
  double s1 = 0, s2 = 0;
  for (int i = 0; i < HD_; ++i) { s1 += (double)p.lq1[i] * p.lk1[i]; s2 += (double)p.lq2[i] * p.lk2[i]; }
  double lam_init = 0.8 - 0.6 * exp(-0.3 * 1.0);
  p.scal[0] = (float)(exp(s1) - exp(s2) + lam_init);
  p.scal[1] = (float)(1.0 - lam_init);
}

constexpr int N_KT = 2 * SSM_G * SL * SSM_C * SSM_C;
HD void st_tabb(const Params& p, int layer_unused, int idx) {
  int ci = idx % SSM_C; int co = (idx / SSM_C) % SSM_C; int k = (idx / (SSM_C * SSM_C)) % SL; int dg = idx / (SSM_C * SSM_C * SL);
  float acc = 0.f;
  for (int pp = 0; pp < SSM_P; ++pp) {
    int q = dg * SSM_P + pp;
    float ar = p.apow[((size_t)q * (SL + 1) + k) * 2], ai = p.apow[((size_t)q * (SL + 1) + k) * 2 + 1];
    float br = p.bbar[((size_t)q * SSM_C + ci) * 2], bi = p.bbar[((size_t)q * SSM_C + ci) * 2 + 1];
    float cr = p.c_re[((size_t)dg * SSM_C + co) * SSM_P + pp], cim = p.c_im[((size_t)dg * SSM_C + co) * SSM_P + pp];
    float tr = ar * br - ai * bi, ti = ar * bi + ai * br;
    acc += cr * tr - cim * ti;
  }
  p.KT[idx] = acc;
}

HD void st_proj(const Params& p, int layer, int idx) {
  const int W = layer == 0 ? AB_IN : DIF_IN;
  const float* w = layer == 0 ? p.w_in_a : p.dif_w_in;
  const int rope_end = layer == 0 ? (SWA_QW + SWA_KVW) : (2 * DIF_QK);
  int t = idx / W, n = idx % W;
  int r = tok_r(t);
  if (layer == 1 && t >= TL && n < DIF_QK) return;
  const float* xr = xrow(p, layer, t);
  const float* sh = modp(p, layer, r, 0);
  const float* sc = modp(p, layer, r, 1);
  bool rope = (t < TL) && (n < rope_end);
  if (!rope) {
    float acc = 0.f;
    for (int k = 0; k < D; ++k) { float h = xr[k] * (1.0f + sc[k]) + sh[k]; acc += h * w[(size_t)k * W + n]; }
    p.P[(size_t)t * W + n] = f2bf(acc);
    return;
  }
  int d = n % 64, sub = d % 32;
  if (sub >= 16) return;
  float a1 = 0.f, a2 = 0.f;
  for (int k = 0; k < D; ++k) {
    float h = xr[k] * (1.0f + sc[k]) + sh[k];
    a1 += h * w[(size_t)k * W + n]; a2 += h * w[(size_t)k * W + n + 16];
  }
  int i = t % N;
  int pos = d < 32 ? i / GRID_W : i % GRID_W;
  float cs = p.ropeT[(pos * 16 + sub) * 2], sn = p.ropeT[(pos * 16 + sub) * 2 + 1];
  p.P[(size_t)t * W + n] = f2bf(a1 * cs - a2 * sn);
  p.P[(size_t)t * W + n + 16] = f2bf(a2 * cs + a1 * sn);
}

HD void st_swa(const Params& p, int layer, int idx) {
  int hq = idx / TA, t = idx % TA;
  int kvh = hq / 4;
  const uint16_t* P = p.P;
  float q[64], o[64];
  _Pragma("unroll") for (int d = 0; d < 64; ++d) { q[d] = bf2f(P[(size_t)t * AB_IN + hq * 64 + d]) * 0.125f; o[d] = 0.f; }
  float m = p.sink[hq], l = 1.0f;
  int b = t < TL ? t / N : (t - TL) / CTX;
  int nloc = t < TL ? 2 * SWA_WIN + 1 : 0;
  int i = t < TL ? t % N : 0;
  for (int kk = 0; kk < nloc + CTX; ++kk) {
    int row;
    if (kk < nloc) {
      int j = i - SWA_WIN + kk;
      if (j < 0 || j >= N) continue;
      row = b * N + j;
    } else row = TL + b * CTX + (kk - nloc);
    const uint16_t* kr = P + (size_t)row * AB_IN + A_KOFF + kvh * 64;
    const uint16_t* vr = P + (size_t)row * AB_IN + A_VOFF + kvh * 64;
    float s = 0.f;
    _Pragma("unroll") for (int d = 0; d < 64; ++d) s += q[d] * bf2f(kr[d]);
    if (s > m) { float f = expf(m - s); l *= f; for (int d = 0; d < 64; ++d) o[d] *= f; m = s; }
    float pe = expf(s - m);
    l += pe;
    _Pragma("unroll") for (int d = 0; d < 64; ++d) o[d] += pe * bf2f(vr[d]);
  }
  float il = 1.0f / l;
  _Pragma("unroll") for (int d = 0; d < 64; ++d) p.Ymix[(size_t)t * YW + hq * 64 + d] = f2bf(o[d] * il);
}

HD int ssm_row(int dir, int b, int tau) {
  if (dir == 0) return tau < CTX ? TL + b * CTX + tau : b * N + (tau - CTX);
  return tau < CTX ? TL + b * CTX + (CTX - 1 - tau) : b * N + (N - 1 - (tau - CTX));
}
constexpr int N_SSME = 2 * B * NCH * SSM_G * SSM_P;
HD void st_ssm_e(const Params& p, int layer, int idx) {
  int pp = idx % SSM_P; int g = (idx / SSM_P) % SSM_G; int ch = (idx / (SSM_P * SSM_G)) % NCH;
  int b = (idx / (SSM_P * SSM_G * NCH)) % B; int dir = idx / (SSM_P * SSM_G * NCH * B);
  int q = (dir * SSM_G + g) * SSM_P + pp;
  float er = 0.f, ei = 0.f;
  for (int j = 0; j < SL; ++j) {
    int row = ssm_row(dir, b, ch * SL + j);
    const uint16_t* u = p.P + (size_t)row * AB_IN + A_UOFF + g * 16;
    float vr = 0.f, vi = 0.f;
    _Pragma("unroll") for (int cc = 0; cc < 16; ++cc) {
      float uv = bf2f(u[cc]);
      vr += p.bbar[((size_t)q * 16 + cc) * 2] * uv; vi += p.bbar[((size_t)q * 16 + cc) * 2 + 1] * uv;
    }
    float ar = p.apow[((size_t)q * (SL + 1) + (SL - 1 - j)) * 2], ai = p.apow[((size_t)q * (SL + 1) + (SL - 1 - j)) * 2 + 1];
    er += ar * vr - ai * vi; ei += ar * vi + ai * vr;
  }
  p.E[(size_t)idx * 2] = er; p.E[(size_t)idx * 2 + 1] = ei;
}
constexpr int N_SSMC = 2 * B * SSM_G * SSM_P;
HD void st_ssm_c(const Params& p, int layer, int idx) {
  int pp = idx % SSM_P; int g = (idx / SSM_P) % SSM_G; int b = (idx / (SSM_P * SSM_G)) % B; int dir = idx / (SSM_P * SSM_G * B);
  int q = (dir * SSM_G + g) * SSM_P + pp;
  float ar = p.apow[((size_t)q * (SL + 1) + SL) * 2], ai = p.apow[((size_t)q * (SL + 1) + SL) * 2 + 1];
  float sr = 0.f, si = 0.f;
  for (int ch = 0; ch < NCH; ++ch) {
    size_t e = ((((size_t)dir * B + b) * NCH + ch) * SSM_G + g) * SSM_P + pp;
    p.Sin[e * 2] = sr; p.Sin[e * 2 + 1] = si;
    float er = p.E[e * 2], ei = p.E[e * 2 + 1];
    float nr = ar * sr - ai * si + er, ni = ar * si + ai * sr + ei;
    sr = nr; si = ni;
  }
}
HD void st_ssm_o(const Params& p, int layer, int idx) {
  int t = idx / SSM_W, n = idx % SSM_W; int g = n / 16, co = n % 16;
  int b, dirtau[2];
  if (t < TL) { b = t / N; int i = t % N; dirtau[0] = CTX + i; dirtau[1] = CTX + (N - 1 - i); }
  else { b = (t - TL) / CTX; int i = (t - TL) % CTX; dirtau[0] = i; dirtau[1] = CTX - 1 - i; }
  float y = p.ssm_d[n] * bf2f(p.P[(size_t)t * AB_IN + A_UOFF + n]);
  for (int dir = 0; dir < 2; ++dir) {
    int tau = dirtau[dir]; int ch = tau / SL, j = tau % SL;
    int dg = dir * SSM_G + g;
    size_t e0 = ((((size_t)dir * B + b) * NCH + ch) * SSM_G + g) * SSM_P;
    for (int pp = 0; pp < SSM_P; ++pp) {
      int q = dg * SSM_P + pp;
      float ar = p.apow[((size_t)q * (SL + 1) + (j + 1)) * 2], ai = p.apow[((size_t)q * (SL + 1) + (j + 1)) * 2 + 1];
      float sr = p.Sin[(e0 + pp) * 2], si = p.Sin[(e0 + pp) * 2 + 1];
      float tr = ar * sr - ai * si, ti = ar * si + ai * sr;
      float cr = p.c_re[((size_t)dg * 16 + co) * SSM_P + pp], cim = p.c_im[((size_t)dg * 16 + co) * SSM_P + pp];
      y += cr * tr - cim * ti;
    }
    for (int j2 = 0; j2 <= j; ++j2) {
      int row = ssm_row(dir, b, ch * SL + j2);
      const uint16_t* u = p.P + (size_t)row * AB_IN + A_UOFF + g * 16;
      const float* kt = p.KT + (((size_t)dg * SL + (j - j2)) * 16 + co) * 16;
      _Pragma("unroll") for (int ci = 0; ci < 16; ++ci) y += kt[ci] * bf2f(u[ci]);
    }
  }
  p.Gs[(size_t)t * SSM_W + n] = f2bf(geluf_(y));
}
HD void st_glu(const Params& p, int layer, int idx) {
  int t = idx / SSM_W, n = idx % SSM_W;
  float z = p.glu_b[n];
  const uint16_t* g = p.Gs + (size_t)t * SSM_W;
  for (int k = 0; k < SSM_W; ++k) z += bf2f(g[k]) * p.glu_w[(size_t)k * SSM_W + n];
  p.Ymix[(size_t)t * YW + SWA_QW + n] = f2bf(bf2f(g[n]) * sigmoidf_(z));
}

HD void st_dif(const Params& p, int layer, int idx) {
  int t = idx % TL; int he = idx / TL; int eh = he % 2, h = he / 2;
  int b = t / N;
  const uint16_t* P = p.P;
  float res[64];
  float lam = p.scal[0];
  _Pragma("unroll") for (int c = 0; c < 2; ++c) {
    float q[64], o[64];
    _Pragma("unroll") for (int d = 0; d < 64; ++d) { q[d] = bf2f(P[(size_t)t * DIF_IN + h * 128 + c * 64 + d]) * 0.125f; o[d] = 0.f; }
    float m = -1e30f, l = 0.f;
    for (int kk = 0; kk < N + CTX; ++kk) {
      int row = kk < N ? b * N + kk : TL + b * CTX + (kk - N);
      const uint16_t* kr = P + (size_t)row * DIF_IN + DIF_QK + h * 128 + c * 64;
      const uint16_t* vr = P + (size_t)row * DIF_IN + 2 * DIF_QK + h * 128 + eh * 64;
      float s = 0.f;
      _Pragma("unroll") for (int d = 0; d < 64; ++d) s += q[d] * bf2f(kr[d]);
      if (s > m) { float f = expf(m - s); l *= f; for (int d = 0; d < 64; ++d) o[d] *= f; m = s; }
      float pe = expf(s - m);
      l += pe;
      _Pragma("unroll") for (int d = 0; d < 64; ++d) o[d] += pe * bf2f(vr[d]);
    }
    float il = 1.0f / l;
    if (c == 0) { for (int d = 0; d < 64; ++d) res[d] = o[d] * il; }
    else { for (int d = 0; d < 64; ++d) res[d] -= lam * o[d] * il; }
  }
  _Pragma("unroll") for (int d = 0; d < 64; ++d) p.Ymix[(size_t)t * YW + h * 128 + eh * 64 + d] = f2bf(res[d]);
}
HD void st_difnorm(const Params& p, int layer, int idx) {
  int t = idx / DIF_H, h = idx % DIF_H;
  uint16_t* o = p.Ymix + (size_t)t * YW + h * 128;
  float ss = 0.f;
  for (int e = 0; e < 128; ++e) { float v = bf2f(o[e]); ss += v * v; }
  float r = 1.0f / sqrtf(ss / 128.0f + RMS_EPS) * p.scal[1];
  _Pragma("unroll 8") for (int e = 0; e < 128; ++e) o[e] = f2bf(bf2f(o[e]) * r * p.subln_g[e]);
}

HD void st_outproj(const Params& p, int layer, int idx) {
  int t = idx / D, n = idx % D;
  const float* w = layer == 0 ? p.w_out_a : p.dif_w_out;
  const uint16_t* y = p.Ymix + (size_t)t * YW;
  const int KW = layer == 0 ? AB_OUT : DIF_VW;
  float acc = 0.f;
  for (int k = 0; k < KW; ++k) acc += bf2f(y[k]) * w[(size_t)k * D + n];
  p.F[(size_t)t * D + n] = acc;
}
HD void st_ln1(const Params& p, int layer, int t) {
  int r = tok_r(t);
  const float* xr = xrow(p, layer, t); const float* g1 = modp(p, layer, r, 2);
  const float* y = p.F + (size_t)t * D;
  float mu = 0.f;
  for (int k = 0; k < D; ++k) mu += ALPHA * xr[k] + g1[k] * y[k];
  mu /= D;
  float var = 0.f;
  for (int k = 0; k < D; ++k) { float v = ALPHA * xr[k] + g1[k] * y[k] - mu; var += v * v; }
  var /= D;
  float rs = 1.0f / sqrtf(var + LN_EPS);
  const float* lg = p.ln1_g + (size_t)layer * D; const float* lb = p.ln1_b + (size_t)layer * D;
  for (int k = 0; k < D; ++k) p.X1[(size_t)t * D + k] = (ALPHA * xr[k] + g1[k] * y[k] - mu) * rs * lg[k] + lb[k];
}
HD void st_route(const Params& p, int layer, int t) {
  int r = tok_r(t);
  const float* x1 = p.X1 + (size_t)t * D; const float* sh = modp(p, layer, r, 3); const float* sc = modp(p, layer, r, 4);
  float lg[MOE_G];
  _Pragma("unroll") for (int g = 0; g < MOE_G; ++g) lg[g] = p.moe_bg[layer * MOE_G + g];
  const float* wg = p.moe_wg + (size_t)layer * D * MOE_G;
  for (int k = 0; k < D; ++k) {
    float h = x1[k] * (1.0f + sc[k]) + sh[k];
    _Pragma("unroll") for (int g = 0; g < MOE_G; ++g) lg[g] += h * wg[k * MOE_G + g];
  }
  int gi = 0; float mx = lg[0];
  _Pragma("unroll") for (int g = 1; g < MOE_G; ++g) if (lg[g] > mx) { mx = lg[g]; gi = g; }
  float den = 0.f;
  _Pragma("unroll") for (int g = 0; g < MOE_G; ++g) den += expf(lg[g] - mx);
  float gp = 1.0f / den;
  float le[MOE_EPG];
  _Pragma("unroll") for (int e = 0; e < MOE_EPG; ++e) le[e] = p.moe_be[(layer * MOE_G + gi) * MOE_EPG + e];
  const float* we = p.moe_we + ((size_t)layer * MOE_G + gi) * D * MOE_EPG;
  for (int k = 0; k < D; ++k) {
    float h = x1[k] * (1.0f + sc[k]) + sh[k];
    _Pragma("unroll") for (int e = 0; e < MOE_EPG; ++e) le[e] += h * we[k * MOE_EPG + e];
  }
  int i0 = 0; float v0 = le[0];
  _Pragma("unroll") for (int e = 1; e < MOE_EPG; ++e) if (le[e] > v0) { v0 = le[e]; i0 = e; }
  int i1 = -1; float v1 = -3e38f;
  _Pragma("unroll") for (int e = 0; e < MOE_EPG; ++e) if (e != i0 && le[e] > v1) { v1 = le[e]; i1 = e; }
  float e1 = expf(v1 - v0);
  float w0 = gp / (1.0f + e1), w1 = gp * e1 / (1.0f + e1);
  p.route[(size_t)t * 4 + 0] = (float)(gi * MOE_EPG + i0);
  p.route[(size_t)t * 4 + 1] = (float)(gi * MOE_EPG + i1);
  p.route[(size_t)t * 4 + 2] = w0;
  p.route[(size_t)t * 4 + 3] = w1;
}
HD void st_moe_h(const Params& p, int layer, int idx) {
  int f = idx % MOE_F; int j = (idx / MOE_F) % 2; int t = idx / (2 * MOE_F);
  int r = tok_r(t);
  const float* x1 = p.X1 + (size_t)t * D; const float* sh = modp(p, layer, r, 3); const float* sc = modp(p, layer, r, 4);
  int e = (int)p.route[(size_t)t * 4 + j]; float wgt = p.route[(size_t)t * 4 + 2 + j];
  const float* w1 = p.moe_w1 + ((size_t)layer * MOE_E + e) * D * MOE_F;
  const float* w3 = p.moe_w3 + ((size_t)layer * MOE_E + e) * D * MOE_F;
  float h1 = 0.f, h3 = 0.f;
  for (int k = 0; k < D; ++k) {
    float h = x1[k] * (1.0f + sc[k]) + sh[k];
    h1 += h * w1[(size_t)k * MOE_F + f]; h3 += h * w3[(size_t)k * MOE_F + f];
  }
  p.HH[(size_t)idx] = siluf(h1) * h3 * wgt;
}
HD void st_moe_o(const Params& p, int layer, int idx) {
  int t = idx / D, n = idx % D;
  float acc = 0.f;
  for (int j = 0; j < 2; ++j) {
    int e = (int)p.route[(size_t)t * 4 + j];
    const float* w2 = p.moe_w2 + ((size_t)layer * MOE_E + e) * MOE_F * D;
    const float* hh = p.HH + ((size_t)t * 2 + j) * MOE_F;
    for (int f = 0; f < MOE_F; ++f) acc += hh[f] * w2[(size_t)f * D + n];
  }
  p.F[(size_t)t * D + n] = acc;
}
HD void st_ln2(const Params& p, int layer, int t) {
  int r = tok_r(t);
  const float* x1 = p.X1 + (size_t)t * D; const float* g2 = modp(p, layer, r, 5);
  const float* y = p.F + (size_t)t * D;
  float mu = 0.f;
  for (int k = 0; k < D; ++k) mu += ALPHA * x1[k] + g2[k] * y[k];
  mu /= D;
  float var = 0.f;
  for (int k = 0; k < D; ++k) { float v = ALPHA * x1[k] + g2[k] * y[k] - mu; var += v * v; }
  var /= D;
  float rs = 1.0f / sqrtf(var + LN_EPS);
  const float* lg = p.ln2_g + (size_t)layer * D; const float* lb = p.ln2_b + (size_t)layer * D;
  float* dst = layer == DEPTH - 1 ? p.out + (size_t)t * D : p.X + (size_t)t * D;
  for (int k = 0; k < D; ++k) dst[k] = (ALPHA * x1[k] + g2[k] * y[k] - mu) * rs * lg[k] + lb[k];
}

enum { S_MOD, S_TABA, S_TABB, S_PROJ, S_SWA, S_SSME, S_SSMC, S_SSMO, S_GLU, S_DIF, S_DIFNORM, S_OUTPROJ, S_LN1, S_ROUTE, S_MOEH, S_MOEO, S_LN2 };
template <int S> HD void run_elem(const Params& p, int layer, int idx) {
  if (S == S_MOD) st_mod(p, layer, idx);
  else if (S == S_TABA) st_taba(p, layer, idx);
  else if (S == S_TABB) st_tabb(p, layer, idx);
  else if (S == S_PROJ) st_proj(p, layer, idx);
  else if (S == S_SWA) st_swa(p, layer, idx);
  else if (S == S_SSME) st_ssm_e(p, layer, idx);
  else if (S == S_SSMC) st_ssm_c(p, layer, idx);
  else if (S == S_SSMO) st_ssm_o(p, layer, idx);
  else if (S == S_GLU) st_glu(p, layer, idx);
  else if (S == S_DIF) st_dif(p, layer, idx);
  else if (S == S_DIFNORM) st_difnorm(p, layer, idx);
  else if (S == S_OUTPROJ) st_outproj(p, layer, idx);
  else if (S == S_LN1) st_ln1(p, layer, idx);
  else if (S == S_ROUTE) st_route(p, layer, idx);
  else if (S == S_MOEH) st_moe_h(p, layer, idx);
  else if (S == S_MOEO) st_moe_o(p, layer, idx);
  else if (S == S_LN2) st_ln2(p, layer, idx);
}

constexpr int NSLOT = 2 * TA + MOE_E * 256;
constexpr size_t CTL_BYTES = 1u << 20;
struct WsLayout {
  size_t ctl, X, X1, P, Ymix, Gs, modv, ropeT, apow, bbar, KT, E, Sin, route, scal, WinA_t, DifIn_t, WoutA_t, DifOut_t, Glu_t, W13t, W2t, gate, tokslot, moe_meta, total;
};
inline WsLayout ws_layout() {
  WsLayout L; size_t o = 0;
  auto take = [&](size_t bytes) { size_t r = o; o += (bytes + 255) & ~(size_t)255; return r; };
  L.ctl = take(CTL_BYTES);
  L.X = take((size_t)TA * D * 4);
  L.X1 = L.X;
  L.P = take((size_t)TA * (AB_IN > DIF_IN ? AB_IN : DIF_IN) * 2);
  L.Ymix = take((size_t)TA * YW * 2);
  L.Gs = L.X;
  L.modv = take((size_t)N_MOD * 4);
  L.ropeT = take((size_t)N_ROPE * 2 * 4);
  L.apow = take((size_t)N_APOW * 2 * 4);
  L.bbar = take((size_t)N_BBAR * 2 * 4);
  L.KT = take((size_t)N_KT * 4);
  L.E = L.X + (((size_t)TA * SSM_W * 2 + 255) & ~(size_t)255);
  L.Sin = L.E + (((size_t)N_SSME * 2 * 4 + 255) & ~(size_t)255);
  L.route = take((size_t)TA * 8 * 4);
  L.scal = take(256);
  L.WinA_t = take((size_t)AB_IN * D * 2);
  L.DifIn_t = take((size_t)DIF_IN * D * 2);
  L.WoutA_t = take((size_t)D * AB_OUT * 2);
  L.DifOut_t = take((size_t)D * DIF_VW * 2);
  L.Glu_t = take((size_t)SSM_W * SSM_W * 2);
  L.W13t = take((size_t)MOE_E * 2 * MOE_F * D * 2);
  L.W2t = take((size_t)MOE_E * D * MOE_F * 2);
  L.gate = take((size_t)NSLOT * 4);
  L.tokslot = take((size_t)TA * 2 * 4);
  L.moe_meta = take(4096);
  L.total = o;
  return L;
}
inline void fill_ws(Params& p, char* ws) {
  WsLayout L = ws_layout();
  p.X = (float*)(ws + L.X); p.X1 = (float*)(ws + L.X1); p.P = (uint16_t*)(ws + L.P); p.F = (float*)(ws + L.P);
  p.Ymix = (uint16_t*)(ws + L.Ymix); p.HH = (float*)(ws + L.Ymix);
  p.Gs = (uint16_t*)(ws + L.Gs); p.modv = (float*)(ws + L.modv); p.ropeT = (float*)(ws + L.ropeT);
  p.apow = (float*)(ws + L.apow); p.bbar = (float*)(ws + L.bbar); p.KT = (float*)(ws + L.KT);
  p.E = (float*)(ws + L.E); p.Sin = (float*)(ws + L.Sin); p.route = (float*)(ws + L.route); p.scal = (float*)(ws + L.scal);
  p.H = (uint16_t*)(ws + L.Ymix); p.WinA_t = (uint16_t*)(ws + L.WinA_t); p.DifIn_t = (uint16_t*)(ws + L.DifIn_t); p.ctl = (unsigned*)(ws + L.ctl);
  p.WoutA_t = (uint16_t*)(ws + L.WoutA_t); p.DifOut_t = (uint16_t*)(ws + L.DifOut_t); p.Glu_t = (uint16_t*)(ws + L.Glu_t);
  p.W13t = (uint16_t*)(ws + L.W13t); p.W2t = (uint16_t*)(ws + L.W2t);
  p.Amoe = (uint16_t*)(ws + L.P); p.F2 = (uint16_t*)(ws + L.P); p.HHb = (uint16_t*)(ws + L.Ymix);
  p.gate = (float*)(ws + L.gate); p.tokslot = (int*)(ws + L.tokslot); p.moe_meta = (int*)(ws + L.moe_meta);
}
inline void fill_inputs(Params& p, void* const* d_in) {
  const float* const* in = (const float* const*)d_in;
  p.x = in[0]; p.c = in[1]; p.ctx = in[2]; p.c_ctx = in[3]; p.mod_w = in[4]; p.mod_b = in[5];
  p.ln1_g = in[6]; p.ln1_b = in[7]; p.ln2_g = in[8]; p.ln2_b = in[9];
  p.w_in_a = in[10]; p.w_out_a = in[11]; p.sink = in[12]; p.a_re = in[13]; p.a_im = in[14]; p.log_step = in[15];
  p.b_re = in[16]; p.b_im = in[17]; p.c_re = in[18]; p.c_im = in[19]; p.ssm_d = in[20]; p.glu_w = in[21]; p.glu_b = in[22];
  p.dif_w_in = in[23]; p.dif_w_out = in[24]; p.lq1 = in[25]; p.lk1 = in[26]; p.lq2 = in[27]; p.lk2 = in[28]; p.subln_g = in[29];
  p.moe_wg = in[30]; p.moe_bg = in[31]; p.moe_we = in[32]; p.moe_be = in[33]; p.moe_w1 = in[34]; p.moe_w3 = in[35]; p.moe_w2 = in[36];
}

#define FORWARD_PROGRAM(RUN)                                   \
  RUN(S_MOD, 0, N_MOD)                                         \
  RUN(S_TABA, 0, N_TABA)                                       \
  RUN(S_TABB, 0, N_KT)                                         \
                                                   \
  RUN(S_PROJ, 0, TA * AB_IN)                                   \
  RUN(S_SWA, 0, SWA_H * TA)                                    \
  RUN(S_SSME, 0, N_SSME)                                       \
  RUN(S_SSMC, 0, N_SSMC)                                       \
  RUN(S_SSMO, 0, TA * SSM_W)                                   \
  RUN(S_GLU, 0, TA * SSM_W)                                    \
  RUN(S_OUTPROJ, 0, TA * D)                                    \
  RUN(S_LN1, 0, TA)                                            \
  RUN(S_ROUTE, 0, TA)                                          \
  RUN(S_MOEH, 0, TA * 2 * MOE_F)                               \
  RUN(S_MOEO, 0, TA * D)                                       \
  RUN(S_LN2, 0, TA)                                            \
                                                   \
  RUN(S_PROJ, 1, TA * DIF_IN)                                  \
  RUN(S_DIF, 1, DIF_H * 2 * TL)                                \
  RUN(S_DIFNORM, 1, TL * DIF_H)                                \
  RUN(S_OUTPROJ, 1, TL * D)                                    \
  RUN(S_LN1, 1, TL)                                            \
  RUN(S_ROUTE, 1, TL)                                          \
  RUN(S_MOEH, 1, TL * 2 * MOE_F)                               \
  RUN(S_MOEO, 1, TL * D)                                       \
  RUN(S_LN2, 1, TL)

#ifndef HOST_EMU
#include <cstdio>
#define LAS __attribute__((address_space(3)))
#define GAS __attribute__((address_space(1)))
typedef unsigned short bf16_t;
typedef short bf16x8 __attribute__((ext_vector_type(8)));
typedef float f32x4 __attribute__((ext_vector_type(4)));
typedef float f32x2 __attribute__((ext_vector_type(2)));
typedef unsigned u32x4 __attribute__((ext_vector_type(4)));
typedef unsigned u32x2 __attribute__((ext_vector_type(2)));
constexpr int NWAVES = 8, NTHR = 512;
constexpr int RING_BYTES = 131072, LDSCTL_OFF = RING_BYTES, MISC_OFF = LDSCTL_OFF + 320, LDS_BYTES = 147456;
#define LDS_WAIT() asm volatile("s_waitcnt lgkmcnt(0)" ::: "memory")
#define VM_WAIT() asm volatile("s_waitcnt vmcnt(0)" ::: "memory")
__device__ __forceinline__ unsigned cvt_pk_bf16(float lo, float hi) { unsigned r; asm volatile("v_cvt_pk_bf16_f32 %0, %1, %2" : "=v"(r) : "v"(lo), "v"(hi)); return r; }

namespace pg8 {
constexpr int BM = 256, BK = 64, HALF = 128, HTB = HALF * BK * 2, STAGE_BYTES = 8 * HTB, NXCD = 8, WGM = 8;
__host__ __device__ __forceinline__ int lds_byte(int r, int c) { const int st = (r >> 4) * 2 + (c >> 5), rr = r & 15, cc = c & 31, ob = rr * 64 + cc * 2; return st * 1024 + (ob ^ (((ob >> 9) & 1) << 5)); }
__host__ __device__ __forceinline__ void stage_rc(int b, int& R, int& C) { const int st = b / 1024, sb = b % 1024, swz = sb ^ (((sb >> 9) & 1) << 5); R = (st >> 1) * 16 + swz / 64; C = (st & 1) * 32 + (swz % 64) / 2; }
__host__ __device__ __forceinline__ int perm32(int rho) { const int n = rho >> 4, i = rho & 15; return 8 * (i >> 2) + 4 * n + (i & 3); }
struct Unit { int pm, pn; };
struct Gemm { const bf16_t* A; const bf16_t* Bt; int lda, ldb, K; };

struct StaticOrder {
  int nM, nN, nwg, G, c;
  __device__ void init(int M, int N, int G_, int c_) { nM = M / BM; nN = N / BM; nwg = nM * nN; G = G_; c = c_; }
  __device__ bool next(int i, Unit& u) const {
    const long L = (long)i * G + c; if (L >= nwg) return false;
    int wgid = (int)L; { const int q = nwg / NXCD, r = nwg % NXCD, xcd = wgid % NXCD, off = wgid / NXCD; wgid = (xcd < r ? xcd * (q + 1) : r * (q + 1) + (xcd - r) * q) + off; }
    const int nig = WGM * nN, gid = wgid / nig, fm = gid * WGM, gsz = (nM - fm) < WGM ? (nM - fm) : WGM;
    u.pm = fm + ((wgid % nig) % gsz); u.pn = (wgid % nig) / gsz; return true;
  }
  __device__ __forceinline__ void a_ready(const Unit&) const {}
  __device__ __forceinline__ void done(const Unit&) const {}
};

template <class Epi, class Sched, bool ALIGN_EPI = true, bool SP2 = true>
__device__ __forceinline__ void gemm_phase(LAS unsigned char* lds, const Gemm g, const Sched& S, const Epi& E) {
  int tid = threadIdx.x; asm volatile("" : "+v"(tid));
  const int wid = __builtin_amdgcn_readfirstlane(tid >> 6), lane = tid & 63, wr = wid >> 2, wc = wid & 3, fr = lane & 15, fq = lane >> 4;
  const int K = g.K, nt = K / BK;
  unsigned voffA[2], voffB[2];
#pragma unroll
  for (int i = 0; i < 2; ++i) { int R, C; stage_rc(tid * 16 + i * 8192, R, C); const int Rb = Epi::PERM ? ((R & ~31) + perm32(R & 31)) : R;
    voffA[i] = (unsigned)(R * g.lda + C) * 2u; voffB[i] = (unsigned)(Rb * g.ldb + C) * 2u; }
  const size_t kstep = (size_t)(BK * 2);
  const size_t hA = (size_t)HALF * g.lda * 2, hB = (size_t)HALF * g.ldb * 2;
  const size_t tA = 2 * hA, tB = 2 * hB;
  const unsigned ldsw = (unsigned)wid * 1024u;
  const int aoff = lds_byte(wr * 64 + fr, fq * 8), boff = lds_byte(wc * 32 + fr, fq * 8);
#define PG8_SA(b, h) (((b) * 2 + (h)) * HTB)
#define PG8_SB(b, h) ((4 + (b) * 2 + (h)) * HTB)
#define PG8_STAGE(bufoff, gbase, voff) do { _Pragma("unroll") for (int _i = 0; _i < 2; ++_i) \
    __builtin_amdgcn_global_load_lds((const unsigned*)((const char*)(gbase) + (voff)[_i]), (LAS unsigned*)(lds + (bufoff) + ldsw + _i * 8192), 16, 0, 0); } while (0)
#define PG8_LDA(dst, b, h) do { _Pragma("unroll") for (int m = 0; m < 4; ++m) _Pragma("unroll") for (int k = 0; k < 2; ++k) dst[m][k] = *(const LAS bf16x8*)(lds + PG8_SA(b, h) + aoff + m * 2048 + k * 1024); } while (0)
#define PG8_LDB(dst, b, h) do { _Pragma("unroll") for (int n = 0; n < 2; ++n) _Pragma("unroll") for (int k = 0; k < 2; ++k) dst[n][k] = *(const LAS bf16x8*)(lds + PG8_SB(b, h) + boff + n * 2048 + k * 1024); } while (0)
#define PG8_MMA(ai, bj, At, Bt) do { __builtin_amdgcn_s_setprio(1); _Pragma("unroll") for (int m = 0; m < 4; ++m) _Pragma("unroll") for (int n = 0; n < 2; ++n) _Pragma("unroll") for (int k = 0; k < 2; ++k) \
    acc[ai][bj][m][n] = __builtin_amdgcn_mfma_f32_16x16x32_bf16(Bt[n][k], At[m][k], acc[ai][bj][m][n], 0, 0, 0); __builtin_amdgcn_s_setprio(0); } while (0)
#define PG8_WAIT_V(n) asm volatile("s_waitcnt vmcnt(" #n ")" ::: "memory")
#define PG8_WAIT_L(n) asm volatile("s_waitcnt lgkmcnt(" #n ")" ::: "memory")
#define PG8_BAR __builtin_amdgcn_s_barrier()
#define PG8_SCHED __builtin_amdgcn_sched_barrier(0)
  Unit cur, nxt; int ui = 0;
  if (!S.next(0, cur)) return;
  f32x4 acc[2][2][4][2];
#pragma unroll
  for (int a = 0; a < 2; ++a)
#pragma unroll
    for (int b = 0; b < 2; ++b)
#pragma unroll
      for (int m = 0; m < 4; ++m)
#pragma unroll
        for (int n = 0; n < 2; ++n) acc[a][b][m][n] = (f32x4){0.f, 0.f, 0.f, 0.f};
  bf16x8 At[4][2], B0[2][2], B1[2][2];
  const char* cA = (const char*)g.A + (size_t)cur.pm * tA; const char* cB = (const char*)g.Bt + (size_t)cur.pn * tB;
  S.a_ready(cur);
  if constexpr (SP2) {
    PG8_STAGE(PG8_SB(0, 0), cB, voffB); PG8_STAGE(PG8_SB(0, 1), cB + hB, voffB); PG8_STAGE(PG8_SA(0, 0), cA, voffA); PG8_STAGE(PG8_SA(0, 1), cA + hA, voffA);
    if (wr == 1) PG8_BAR;
    PG8_WAIT_V(2); PG8_BAR;
    PG8_STAGE(PG8_SB(1, 0), cB + kstep, voffB); PG8_STAGE(PG8_SA(1, 0), cA + kstep, voffA); PG8_STAGE(PG8_SB(1, 1), cB + hB + kstep, voffB);
    PG8_WAIT_V(6); PG8_BAR;
  } else {
    PG8_STAGE(PG8_SB(0, 0), cB, voffB); PG8_STAGE(PG8_SA(0, 0), cA, voffA); PG8_STAGE(PG8_SB(0, 1), cB + hB, voffB); PG8_STAGE(PG8_SA(0, 1), cA + hA, voffA);
    if (wr == 1) PG8_BAR;
    PG8_WAIT_V(4); PG8_BAR;
    PG8_STAGE(PG8_SB(1, 0), cB + kstep, voffB); PG8_STAGE(PG8_SA(1, 0), cA + kstep, voffA); PG8_STAGE(PG8_SB(1, 1), cB + hB + kstep, voffB);
    PG8_WAIT_V(6); PG8_BAR;
  }
  for (;;) {
    const bool has_next = S.next(ui + 1, nxt);
    const char* nA = has_next ? (const char*)g.A + (size_t)nxt.pm * tA : cA; const char* nB = has_next ? (const char*)g.Bt + (size_t)nxt.pn * tB : cB;
#pragma unroll 1
    for (int t = 0; t < nt; t += 2) {
      const bool last = (t == nt - 2);
      const char* a1 = cA + (size_t)(t + 1) * kstep;
      const char* a2 = last ? nA : cA + (size_t)(t + 2) * kstep; const char* b2 = last ? nB : cB + (size_t)(t + 2) * kstep;
      const char* a3 = a2 + kstep; const char* b3 = b2 + kstep;
      if (last && has_next) S.a_ready(nxt);
      if constexpr (SP2) {
        PG8_LDB(B0, 0, 0); PG8_LDB(B1, 0, 1); PG8_SCHED; PG8_LDA(At, 0, 0); PG8_STAGE(PG8_SA(1, 1), a1 + hA, voffA);
        PG8_WAIT_V(8); PG8_WAIT_L(0); PG8_BAR; PG8_MMA(0, 0, At, B0); PG8_MMA(0, 1, At, B1); PG8_BAR; PG8_SCHED;
        PG8_LDA(At, 0, 1); PG8_STAGE(PG8_SB(0, 0), b2, voffB); PG8_STAGE(PG8_SB(0, 1), b2 + hB, voffB); PG8_STAGE(PG8_SA(0, 0), a2, voffA);
        PG8_WAIT_V(8); PG8_WAIT_L(0); PG8_BAR; PG8_MMA(1, 0, At, B0); PG8_MMA(1, 1, At, B1); PG8_BAR; PG8_SCHED;
        PG8_LDB(B0, 1, 0); PG8_LDB(B1, 1, 1); PG8_SCHED; PG8_LDA(At, 1, 0); PG8_STAGE(PG8_SA(0, 1), a2 + hA, voffA);
        PG8_WAIT_V(8); PG8_WAIT_L(0); PG8_BAR; PG8_MMA(0, 0, At, B0); PG8_MMA(0, 1, At, B1); PG8_BAR; PG8_SCHED;
        PG8_LDA(At, 1, 1); PG8_STAGE(PG8_SB(1, 0), b3, voffB); PG8_STAGE(PG8_SB(1, 1), b3 + hB, voffB); PG8_STAGE(PG8_SA(1, 0), a3, voffA);
        PG8_WAIT_V(8); PG8_WAIT_L(0); PG8_BAR; PG8_MMA(1, 0, At, B0); PG8_MMA(1, 1, At, B1); PG8_BAR; PG8_SCHED;
      } else {
        PG8_LDB(B0, 0, 0); PG8_SCHED; PG8_LDA(At, 0, 0); PG8_STAGE(PG8_SA(1, 1), a1 + hA, voffA);
        PG8_WAIT_L(8); PG8_BAR; PG8_WAIT_L(0); PG8_MMA(0, 0, At, B0); PG8_BAR; PG8_SCHED;
        PG8_LDB(B1, 0, 1); PG8_STAGE(PG8_SB(0, 0), b2, voffB);
        PG8_BAR; PG8_WAIT_L(0); PG8_MMA(0, 1, At, B1); PG8_BAR;
        PG8_LDA(At, 0, 1); PG8_STAGE(PG8_SA(0, 0), a2, voffA);
        PG8_BAR; PG8_WAIT_L(0); PG8_MMA(1, 0, At, B0); PG8_BAR; PG8_SCHED;
        PG8_STAGE(PG8_SB(0, 1), b2 + hB, voffB);
        PG8_WAIT_V(6); PG8_BAR; PG8_MMA(1, 1, At, B1); PG8_BAR;
        PG8_LDB(B0, 1, 0); PG8_SCHED; PG8_LDA(At, 1, 0); PG8_STAGE(PG8_SA(0, 1), a2 + hA, voffA);
        PG8_WAIT_L(8); PG8_BAR; PG8_WAIT_L(0); PG8_MMA(0, 0, At, B0); PG8_BAR; PG8_SCHED;
        PG8_LDB(B1, 1, 1); PG8_STAGE(PG8_SB(1, 0), b3, voffB);
        PG8_BAR; PG8_WAIT_L(0); PG8_MMA(0, 1, At, B1); PG8_BAR;
        PG8_LDA(At, 1, 1); PG8_STAGE(PG8_SA(1, 0), a3, voffA);
        PG8_BAR; PG8_WAIT_L(0); PG8_MMA(1, 0, At, B0); PG8_BAR; PG8_SCHED;
        PG8_STAGE(PG8_SB(1, 1), b3 + hB, voffB);
        PG8_WAIT_V(6); PG8_BAR; PG8_MMA(1, 1, At, B1); PG8_BAR;
      }
    }
    if constexpr (ALIGN_EPI) { if (wr == 0) PG8_BAR; }
    E(acc, cur, wr, wc, fr, fq); S.done(cur);
    if (!has_next) break;
#pragma unroll
    for (int a = 0; a < 2; ++a)
#pragma unroll
      for (int b = 0; b < 2; ++b)
#pragma unroll
        for (int m = 0; m < 4; ++m)
#pragma unroll
          for (int n = 0; n < 2; ++n) acc[a][b][m][n] = (f32x4){0.f, 0.f, 0.f, 0.f};
    cur = nxt; cA = nA; cB = nB; ++ui;
    if constexpr (ALIGN_EPI) { if (wr == 1) PG8_BAR; }
  }
  PG8_WAIT_V(0);
  if constexpr (!ALIGN_EPI) { if (wr == 0) PG8_BAR; }
  PG8_BAR;
#undef PG8_SA
#undef PG8_SB
#undef PG8_STAGE
#undef PG8_LDA
#undef PG8_LDB
#undef PG8_MMA
#undef PG8_WAIT_V
#undef PG8_WAIT_L
#undef PG8_BAR
#undef PG8_SCHED
}
}

struct EpiProj {
  static constexpr bool PERM = false;
  bf16_t* O; int ldc; int rope_end; const float* ropeT;
  __device__ __forceinline__ void operator()(const f32x4 (&acc)[2][2][4][2], const pg8::Unit& u, int wr, int wc, int fr, int fq) const {
    const int row0 = u.pm * 256 + wr * 64 + fr, colb = u.pn * 256 + wc * 32;
    const bool rope_cols = colb < rope_end;
#pragma unroll
    for (int ai = 0; ai < 2; ++ai)
#pragma unroll
      for (int m = 0; m < 4; ++m) {
        const int r = row0 + ai * 128 + m * 16;
        bf16_t* rowp = O + (size_t)r * ldc + colb + 4 * fq;
        f32x4 cs0 = {1.f, 0.f, 1.f, 0.f}, cs1 = {1.f, 0.f, 1.f, 0.f};
        const bool rp = rope_cols && (r < TL);
        if (rp) { const int i = r % N; const int pos = (wc & 1) ? (i % GRID_W) : (i / GRID_W);
          const f32x4* tp = (const f32x4*)(ropeT + (size_t)(pos * 16 + 4 * fq) * 2); cs0 = tp[0]; cs1 = tp[1]; }
#pragma unroll
        for (int bj = 0; bj < 2; ++bj) {
          const bool rpb = rp && (colb + bj * 128 < rope_end);
          f32x4 a1 = acc[ai][bj][m][0], a2 = acc[ai][bj][m][1];
          f32x4 o1 = a1, o2 = a2;
          if (rpb) {
            o1[0] = a1[0] * cs0[0] - a2[0] * cs0[1]; o2[0] = a2[0] * cs0[0] + a1[0] * cs0[1];
            o1[1] = a1[1] * cs0[2] - a2[1] * cs0[3]; o2[1] = a2[1] * cs0[2] + a1[1] * cs0[3];
            o1[2] = a1[2] * cs1[0] - a2[2] * cs1[1]; o2[2] = a2[2] * cs1[0] + a1[2] * cs1[1];
            o1[3] = a1[3] * cs1[2] - a2[3] * cs1[3]; o2[3] = a2[3] * cs1[2] + a1[3] * cs1[3];
          }
          u32x2 w1 = {cvt_pk_bf16(o1[0], o1[1]), cvt_pk_bf16(o1[2], o1[3])}, w2 = {cvt_pk_bf16(o2[0], o2[1]), cvt_pk_bf16(o2[2], o2[3])};
          *(u32x2*)(rowp + bj * 128) = w1; *(u32x2*)(rowp + bj * 128 + 16) = w2;
        }
      }
  }
};


struct EpiF32Out {
  static constexpr bool PERM = false;
  float* C; int ldc;
  __device__ __forceinline__ void operator()(const f32x4 (&acc)[2][2][4][2], const pg8::Unit& u, int wr, int wc, int fr, int fq) const {
    const int row0 = u.pm * 256 + wr * 64 + fr, col0 = u.pn * 256 + wc * 32 + 4 * fq;
#pragma unroll
    for (int ai = 0; ai < 2; ++ai)
#pragma unroll
      for (int m = 0; m < 4; ++m) { float* rowp = C + (size_t)(row0 + ai * 128 + m * 16) * ldc + col0;
#pragma unroll
        for (int bj = 0; bj < 2; ++bj)
#pragma unroll
          for (int n = 0; n < 2; ++n) *(f32x4*)(rowp + bj * 128 + n * 16) = acc[ai][bj][m][n]; }
  }
};
struct EpiBf16Out {
  static constexpr bool PERM = true;
  bf16_t* O; int ldc; int NJ;
  __device__ __forceinline__ void operator()(const f32x4 (&acc)[2][2][4][2], const pg8::Unit& u, int wr, int wc, int fr, int fq) const {
    const int row0 = u.pm * 256 + wr * 64 + fr, col0 = (NJ ? (u.pn % NJ) : u.pn) * 256 + wc * 32 + 8 * fq;
#pragma unroll
    for (int ai = 0; ai < 2; ++ai)
#pragma unroll
      for (int m = 0; m < 4; ++m) { bf16_t* rowp = O + (size_t)(row0 + ai * 128 + m * 16) * ldc + col0;
#pragma unroll
        for (int bj = 0; bj < 2; ++bj) { const f32x4 v0 = acc[ai][bj][m][0], v1 = acc[ai][bj][m][1];
          u32x4 w; w.x = cvt_pk_bf16(v0[0], v0[1]); w.y = cvt_pk_bf16(v0[2], v0[3]); w.z = cvt_pk_bf16(v1[0], v1[1]); w.w = cvt_pk_bf16(v1[2], v1[3]);
          *(u32x4*)(rowp + bj * 128) = w; } }
  }
};
__device__ __forceinline__ float fast_sigmoid(float x) { return __builtin_amdgcn_rcpf(1.f + __builtin_amdgcn_exp2f(-1.4426950408889634f * x)); }
struct EpiGlu {
  static constexpr bool PERM = true;
  const bf16_t* Gs; const float* bias; bf16_t* O; int ldo, coloff;
  __device__ __forceinline__ void operator()(const f32x4 (&acc)[2][2][4][2], const pg8::Unit& u, int wr, int wc, int fr, int fq) const {
    const int row0 = u.pm * 256 + wr * 64 + fr, col0 = u.pn * 256 + wc * 32 + 8 * fq;
#pragma unroll
    for (int ai = 0; ai < 2; ++ai)
#pragma unroll
      for (int m = 0; m < 4; ++m) { const int r = row0 + ai * 128 + m * 16;
#pragma unroll
        for (int bj = 0; bj < 2; ++bj) { const int c = col0 + bj * 128;
          const u32x4 gv = *(const u32x4*)(Gs + (size_t)r * SSM_W + c);
          const f32x4 b0 = *(const f32x4*)(bias + c), b1 = *(const f32x4*)(bias + c + 4);
          const f32x4 v0 = acc[ai][bj][m][0] + b0, v1 = acc[ai][bj][m][1] + b1;
          float o[8];
#pragma unroll
          for (int j = 0; j < 4; ++j) { const unsigned gw_ = j < 2 ? (j == 0 ? gv.x : gv.y) : (j == 2 ? gv.z : gv.w);
            const float g0 = __builtin_bit_cast(float, gw_ << 16), g1 = __builtin_bit_cast(float, gw_ & 0xffff0000u);
            const float z0 = j < 2 ? v0[2 * j] : v1[2 * j - 4], z1 = j < 2 ? v0[2 * j + 1] : v1[2 * j - 3];
            o[2 * j] = g0 * fast_sigmoid(z0); o[2 * j + 1] = g1 * fast_sigmoid(z1); }
          u32x4 w; w.x = cvt_pk_bf16(o[0], o[1]); w.y = cvt_pk_bf16(o[2], o[3]); w.z = cvt_pk_bf16(o[4], o[5]); w.w = cvt_pk_bf16(o[6], o[7]);
          *(u32x4*)(O + (size_t)r * ldo + coloff + c) = w; } }
  }
};
struct EpiMoe1 {
  static constexpr bool PERM = true;
  bf16_t* HH; const float* gate;
  __device__ __forceinline__ void operator()(const f32x4 (&acc)[2][2][4][2], const pg8::Unit& u, int wr, int wc, int fr, int fq) const {
    const int row0 = u.pm * 256 + wr * 64 + fr, col0 = (u.pn & 1) * 128 + wc * 32 + 8 * fq;
#pragma unroll
    for (int ai = 0; ai < 2; ++ai)
#pragma unroll
      for (int m = 0; m < 4; ++m) { const int r = row0 + ai * 128 + m * 16; const float gt = gate[r];
        float o[8];
#pragma unroll
        for (int n = 0; n < 2; ++n)
#pragma unroll
          for (int j = 0; j < 4; ++j) { const float h1 = acc[ai][0][m][n][j], h3 = acc[ai][1][m][n][j]; o[4 * n + j] = h1 * fast_sigmoid(h1) * h3 * gt; }
        u32x4 w; w.x = cvt_pk_bf16(o[0], o[1]); w.y = cvt_pk_bf16(o[2], o[3]); w.z = cvt_pk_bf16(o[4], o[5]); w.w = cvt_pk_bf16(o[6], o[7]);
        *(u32x4*)(HH + (size_t)r * MOE_F + col0) = w; }
  }
};
struct MoeOrder {
  const int* meta; int NJ, G, c;
  __device__ __forceinline__ bool next(int i, pg8::Unit& u) const {
    const int nt = __builtin_amdgcn_readfirstlane(__hip_atomic_load(meta, __ATOMIC_RELAXED, __HIP_MEMORY_SCOPE_AGENT));
    const long L = (long)i * G + c; if (L >= (long)nt * NJ) return false;
    const int rt = (int)(L / NJ), jn = (int)(L % NJ);
    const int e = __builtin_amdgcn_readfirstlane(__hip_atomic_load(meta + 1 + rt, __ATOMIC_RELAXED, __HIP_MEMORY_SCOPE_AGENT));
    u.pm = rt; u.pn = e * NJ + jn; return true;
  }
  __device__ __forceinline__ void a_ready(const pg8::Unit&) const {}
  __device__ __forceinline__ void done(const pg8::Unit&) const {}
};

#define XB_TMO      128
#define XB_XCNT(j)  (256  + 64 * (j))
#define XB_XSUB(j)  (1280 + 64 * (j))
#define XB_XGEN(j)  (2304 + 64 * (j))
#define XB_TOP      3328
#define XB_TOPGEN   3392
#define XCD_BAR_WORDS 3456
#define XB_SPIN_CAP (1u << 22)
constexpr int CW_BAR = 4096;
__device__ __forceinline__ unsigned xb_ld(unsigned* p)              { return __hip_atomic_load(p, __ATOMIC_RELAXED, __HIP_MEMORY_SCOPE_AGENT); }
__device__ __forceinline__ unsigned xb_add(unsigned* p, unsigned v) { return __hip_atomic_fetch_add(p, v, __ATOMIC_RELAXED, __HIP_MEMORY_SCOPE_AGENT); }
__device__ __forceinline__ unsigned xb_xcc_id() { return (unsigned)__builtin_amdgcn_s_getreg((3 << 11) | 20) & 0xFu; }
#define XB_SPIN(cond, bar) do { unsigned _sp = 0; while (cond) { __builtin_amdgcn_s_sleep(1); \
    if ((++_sp & 255u) == 0u) { if (xb_ld(&(bar)[XB_TMO])) break; if (_sp > XB_SPIN_CAP) { atomicAdd(&(bar)[XB_TMO], 1u); break; } } } } while (0)
struct XcdBarrier { unsigned* bar; unsigned x; volatile LAS unsigned* st; };
__device__ __forceinline__ XcdBarrier xcd_barrier_post(unsigned* bar, volatile LAS unsigned* st) {
  XcdBarrier b; b.bar = bar; b.x = xb_xcc_id(); b.st = st;
  if (threadIdx.x == 0) (void)xb_add(&bar[XB_XCNT(b.x)], 1u);
  return b;
}
__device__ __forceinline__ void xcd_barrier_complete(unsigned* bar, unsigned x, unsigned& nloc, unsigned& nx) {
  const unsigned G = gridDim.x * gridDim.y * gridDim.z;
  unsigned sum, cnt, mine, sp = 0u;
  for (;;) {
    sum = 0u; cnt = 0u; mine = 0u;
#pragma unroll
    for (unsigned j = 0; j < 16; ++j) { const unsigned c = xb_ld(&bar[XB_XCNT(j)]); sum += c; cnt += (c > 0u) ? 1u : 0u; mine = (j == x) ? c : mine; }
    if (sum == G) break;
    __builtin_amdgcn_s_sleep(1);
    if ((++sp & 255u) == 0u) { if (xb_ld(&bar[XB_TMO])) break; if (sp > XB_SPIN_CAP) { atomicAdd(&bar[XB_TMO], 1u); break; } }
  }
  nloc = mine > 0u ? mine : 1u; nx = cnt > 0u ? cnt : 1u;
}
__device__ __forceinline__ void xcd_barrier(const XcdBarrier& b) {
  asm volatile("s_waitcnt vmcnt(0)" ::: "memory");
  __syncthreads();
  if (threadIdx.x == 0) {
    unsigned* bar = b.bar;
    __builtin_amdgcn_s_waitcnt(0);
    unsigned nloc = b.st[0], nx = b.st[1];
    if (nloc == 0u) { xcd_barrier_complete(bar, b.x, nloc, nx); b.st[0] = nloc; b.st[1] = nx; }
    const unsigned old = xb_add(&bar[XB_XSUB(b.x)], 1u);
    const unsigned gen = old / nloc;
    if (old + 1u == (gen + 1u) * nloc) {
      __builtin_amdgcn_fence(__ATOMIC_RELEASE, "agent");
      asm volatile("s_waitcnt vmcnt(0)" ::: "memory");
      const unsigned og = xb_add(&bar[XB_TOP], 1u);
      const unsigned tg = og / nx;
      if (og + 1u == (tg + 1u) * nx) xb_add(&bar[XB_TOPGEN], 1u);
      else XB_SPIN(xb_ld(&bar[XB_TOPGEN]) == tg, bar);
      __builtin_amdgcn_fence(__ATOMIC_ACQUIRE, "agent");
      xb_add(&bar[XB_XGEN(b.x)], 1u);
      asm volatile("s_waitcnt vmcnt(0)" ::: "memory");
    } else {
      XB_SPIN(xb_ld(&bar[XB_XGEN(b.x)]) == gen, bar);
      __builtin_amdgcn_fence(__ATOMIC_ACQUIRE, "agent");
      asm volatile("s_waitcnt vmcnt(0)" ::: "memory");
    }
  }
  __syncthreads();
}

__device__ __forceinline__ unsigned pk2(float lo, float hi) { return (unsigned)f2bf(lo) | ((unsigned)f2bf(hi) << 16); }
__device__ __forceinline__ void transpose_item(const float* W, int K, int N, bf16_t* WT, int k0, int n0, int dst_row0, LAS float* scr, int lane) {
#pragma unroll 8
  for (int i = 0; i < 32; ++i) { const int kk = 2 * i + (lane >> 5); scr[kk * 33 + (lane & 31)] = W[(size_t)(k0 + kk) * N + n0 + (lane & 31)]; }
  LDS_WAIT(); asm volatile("" ::: "memory");
  const int c = lane & 7;
#pragma unroll
  for (int j = 0; j < 4; ++j) { const int n = (lane >> 3) + 8 * j; const LAS float* s = scr + (8 * c) * 33 + n;
    u32x4 o; o.x = pk2(s[0 * 33], s[1 * 33]); o.y = pk2(s[2 * 33], s[3 * 33]); o.z = pk2(s[4 * 33], s[5 * 33]); o.w = pk2(s[6 * 33], s[7 * 33]);
    *(u32x4*)(WT + (size_t)(dst_row0 + n) * K + k0 + 8 * c) = o; }
  LDS_WAIT(); asm volatile("" ::: "memory");
}
__device__ __forceinline__ void transpose_matrix(const float* W, int K, int N, bf16_t* WT, LAS float* scr, int gw, int ngw, int lane) {
  const int nblk = N / 32, items = (K / 64) * nblk;
  for (int it = gw; it < items; it += ngw) { const int kb = it / nblk, nb = it % nblk; transpose_item(W, K, N, WT, 64 * kb, 32 * nb, 32 * nb, scr, lane); }
}
__device__ __forceinline__ void mod_row_to_bf16(const float* xr, const float* sc, const float* sh, bf16_t* orow, int lane) {
  const f32x4* x4 = (const f32x4*)xr + lane; const f32x4* c4 = (const f32x4*)sc + lane; const f32x4* h4 = (const f32x4*)sh + lane;
  unsigned long long* o8 = (unsigned long long*)orow + lane;
#pragma unroll
  for (int j = 0; j < 4; ++j) { const f32x4 v = x4[64 * j], c = c4[64 * j], h = h4[64 * j];
    const float a = v.x * (1.f + c.x) + h.x, b = v.y * (1.f + c.y) + h.y, cc = v.z * (1.f + c.z) + h.z, d = v.w * (1.f + c.w) + h.w;
    o8[64 * j] = (unsigned long long)pk2(a, b) | ((unsigned long long)pk2(cc, d) << 32); }
}


__device__ __forceinline__ float wave_sum(float v) {
#pragma unroll
  for (int o = 1; o < 64; o <<= 1) v += __shfl_xor(v, o);
  return v;
}
constexpr int CW_CNT = 2048;
__device__ __forceinline__ void ln1_route_row(const Params& p, int layer, int t, int lane) {
  const int r = tok_r(t);
  const f32x4* x4 = (const f32x4*)xrow(p, layer, t) + lane; const f32x4* y4 = (const f32x4*)(p.F + (size_t)t * D) + lane;
  const f32x4* g4 = (const f32x4*)modp(p, layer, r, 2) + lane;
  f32x4 v[4]; float s = 0.f;
#pragma unroll
  for (int j = 0; j < 4; ++j) { v[j] = x4[64 * j] * ALPHA + g4[64 * j] * y4[64 * j]; s += (v[j].x + v[j].y) + (v[j].z + v[j].w); }
  const float mean = wave_sum(s) * (1.f / D); float s2 = 0.f;
#pragma unroll
  for (int j = 0; j < 4; ++j) { v[j] = v[j] - mean; s2 += (v[j].x * v[j].x + v[j].y * v[j].y) + (v[j].z * v[j].z + v[j].w * v[j].w); }
  const float rstd = 1.f / sqrtf(wave_sum(s2) * (1.f / D) + LN_EPS);
  const f32x4* lg4 = (const f32x4*)(p.ln1_g + (size_t)layer * D) + lane; const f32x4* lb4 = (const f32x4*)(p.ln1_b + (size_t)layer * D) + lane;
  const f32x4* sc4 = (const f32x4*)modp(p, layer, r, 4) + lane; const f32x4* sh4 = (const f32x4*)modp(p, layer, r, 3) + lane;
  f32x4* o4 = (f32x4*)(p.X1 + (size_t)t * D) + lane;
#pragma unroll
  for (int j = 0; j < 4; ++j) { v[j] = v[j] * rstd * lg4[64 * j] + lb4[64 * j]; o4[64 * j] = v[j]; v[j] = v[j] * (sc4[64 * j] + 1.f) + sh4[64 * j]; }
  const f32x4* wg4 = (const f32x4*)(p.moe_wg + (size_t)layer * D * MOE_G);
  f32x4 gl = {0.f, 0.f, 0.f, 0.f};
#pragma unroll
  for (int j = 0; j < 4; ++j)
#pragma unroll
    for (int c = 0; c < 4; ++c) gl += wg4[4 * (lane + 64 * j) + c] * v[j][c];
  asm volatile("" ::: "memory");
  float lgv[4];
#pragma unroll
  for (int g = 0; g < 4; ++g) lgv[g] = wave_sum(gl[g]) + p.moe_bg[layer * MOE_G + g];
  int gi = 0; float mx = lgv[0];
#pragma unroll
  for (int g = 1; g < 4; ++g) if (lgv[g] > mx) { mx = lgv[g]; gi = g; }
  float den = 0.f;
#pragma unroll
  for (int g = 0; g < 4; ++g) den += expf(lgv[g] - mx);
  const float gp = 1.0f / den;
  gi = __builtin_amdgcn_readfirstlane(gi);
  const f32x4* we4 = (const f32x4*)(p.moe_we + ((size_t)layer * MOE_G + gi) * D * MOE_EPG);
  f32x4 e0 = {0.f, 0.f, 0.f, 0.f}, e1 = {0.f, 0.f, 0.f, 0.f};
#pragma unroll
  for (int j = 0; j < 4; ++j) {
#pragma unroll
    for (int c = 0; c < 4; ++c) { const int k = 4 * (lane + 64 * j) + c; e0 += we4[2 * k] * v[j][c]; e1 += we4[2 * k + 1] * v[j][c]; }
    asm volatile("" ::: "memory"); }
  float le[8];
#pragma unroll
  for (int e = 0; e < 4; ++e) { le[e] = wave_sum(e0[e]) + p.moe_be[(layer * MOE_G + gi) * MOE_EPG + e]; le[4 + e] = wave_sum(e1[e]) + p.moe_be[(layer * MOE_G + gi) * MOE_EPG + 4 + e]; }
  int i0 = 0; float v0 = le[0];
#pragma unroll
  for (int e = 1; e < 8; ++e) if (le[e] > v0) { v0 = le[e]; i0 = e; }
  int i1 = -1; float v1 = -3e38f;
#pragma unroll
  for (int e = 0; e < 8; ++e) if (e != i0 && le[e] > v1) { v1 = le[e]; i1 = e; }
  if (lane == 0) {
    const float ex = expf(v1 - v0);
    const int ea = gi * MOE_EPG + i0, eb = gi * MOE_EPG + i1;
    const unsigned pa = atomicAdd(p.ctl + CW_CNT + 64 * layer + ea, 1u), pb = atomicAdd(p.ctl + CW_CNT + 64 * layer + eb, 1u);
    float* rt = p.route + (size_t)t * 8;
    rt[0] = (float)ea; rt[1] = (float)eb; rt[2] = gp / (1.0f + ex); rt[3] = gp * ex / (1.0f + ex); rt[4] = (float)pa; rt[5] = (float)pb;
  }
}
__device__ __forceinline__ void scatter_phase(const Params& p, int layer, int T, LAS unsigned char* lds, int gw, int ngw, int lane, int tid) {
  LAS int* off = (LAS int*)lds;
  if (tid == 0) {
    int o = 0, ntile = 0;
    for (int e = 0; e < MOE_E; ++e) { const int c = (int)__hip_atomic_load(p.ctl + CW_CNT + 64 * layer + e, __ATOMIC_RELAXED, __HIP_MEMORY_SCOPE_AGENT);
      off[e] = o; const int nt = (c + 255) >> 8;
      if (blockIdx.x == 0) for (int i = 0; i < nt; ++i) p.moe_meta[1 + ntile + i] = e;
      ntile += nt; o += nt * 256; }
    if (blockIdx.x == 0) p.moe_meta[0] = ntile;
  }
  __syncthreads();
  for (int t = gw; t < T; t += ngw) {
    const int r = tok_r(t);
    const float* rt = p.route + (size_t)t * 8;
    const int ea = (int)rt[0], eb = (int)rt[1]; const float wa = rt[2], wb = rt[3];
    const int sa = off[ea] + (int)rt[4], sb = off[eb] + (int)rt[5];
    const f32x4* x4 = (const f32x4*)(p.X1 + (size_t)t * D) + lane;
    const f32x4* sc4 = (const f32x4*)modp(p, layer, r, 4) + lane; const f32x4* sh4 = (const f32x4*)modp(p, layer, r, 3) + lane;
    unsigned long long* oa = (unsigned long long*)(p.Amoe + (size_t)sa * D) + lane; unsigned long long* ob = (unsigned long long*)(p.Amoe + (size_t)sb * D) + lane;
#pragma unroll
    for (int j = 0; j < 4; ++j) { const f32x4 h = x4[64 * j] * (sc4[64 * j] + 1.f) + sh4[64 * j];
      const unsigned long long w = (unsigned long long)pk2(h.x, h.y) | ((unsigned long long)pk2(h.z, h.w) << 32); oa[64 * j] = w; ob[64 * j] = w; }
    if (lane == 0) { p.gate[sa] = wa; p.gate[sb] = wb; p.tokslot[2 * t] = sa; p.tokslot[2 * t + 1] = sb; }
  }
}
__device__ __forceinline__ void ln2_row(const Params& p, int layer, int t, int lane) {
  const int r = tok_r(t);
  const int sa = p.tokslot[2 * t], sb = p.tokslot[2 * t + 1];
  const f32x4* x4 = (const f32x4*)(p.X1 + (size_t)t * D) + lane; const f32x4* g4 = (const f32x4*)modp(p, layer, r, 5) + lane;
  const u32x2* fa = (const u32x2*)(p.F2 + (size_t)sa * D) + lane; const u32x2* fb = (const u32x2*)(p.F2 + (size_t)sb * D) + lane;
  f32x4 v[4]; float s = 0.f;
#pragma unroll
  for (int j = 0; j < 4; ++j) { const u32x2 a = fa[64 * j], b = fb[64 * j];
    f32x4 f; f.x = __builtin_bit_cast(float, a.x << 16) + __builtin_bit_cast(float, b.x << 16); f.y = __builtin_bit_cast(float, a.x & 0xffff0000u) + __builtin_bit_cast(float, b.x & 0xffff0000u);
    f.z = __builtin_bit_cast(float, a.y << 16) + __builtin_bit_cast(float, b.y << 16); f.w = __builtin_bit_cast(float, a.y & 0xffff0000u) + __builtin_bit_cast(float, b.y & 0xffff0000u);
    v[j] = x4[64 * j] * ALPHA + g4[64 * j] * f; s += (v[j].x + v[j].y) + (v[j].z + v[j].w); }
  const float mean = wave_sum(s) * (1.f / D); float s2 = 0.f;
#pragma unroll
  for (int j = 0; j < 4; ++j) { v[j] = v[j] - mean; s2 += (v[j].x * v[j].x + v[j].y * v[j].y) + (v[j].z * v[j].z + v[j].w * v[j].w); }
  const float rstd = 1.f / sqrtf(wave_sum(s2) * (1.f / D) + LN_EPS);
  const f32x4* lg4 = (const f32x4*)(p.ln2_g + (size_t)layer * D) + lane; const f32x4* lb4 = (const f32x4*)(p.ln2_b + (size_t)layer * D) + lane;
  if (layer == DEPTH - 1) {
    f32x4* o4 = (f32x4*)(p.out + (size_t)t * D) + lane;
#pragma unroll
    for (int j = 0; j < 4; ++j) o4[64 * j] = v[j] * rstd * lg4[64 * j] + lb4[64 * j];
  } else {
    f32x4* o4 = (f32x4*)(p.X + (size_t)t * D) + lane;
    const f32x4* sc4 = (const f32x4*)modp(p, layer + 1, r, 1) + lane; const f32x4* sh4 = (const f32x4*)modp(p, layer + 1, r, 0) + lane;
    unsigned long long* h8 = (unsigned long long*)(p.H + (size_t)t * D) + lane;
#pragma unroll
    for (int j = 0; j < 4; ++j) { const f32x4 o = v[j] * rstd * lg4[64 * j] + lb4[64 * j]; o4[64 * j] = o;
      const f32x4 h = o * (sc4[64 * j] + 1.f) + sh4[64 * j];
      h8[64 * j] = (unsigned long long)pk2(h.x, h.y) | ((unsigned long long)pk2(h.z, h.w) << 32); }
  }
}
__device__ __forceinline__ void moe_weight_transposes(const Params& p, int layer, LAS float* scr, int gw, int ngw, int lane) {
  constexpr int I13 = (D / 64) * (MOE_F / 32), I2 = (MOE_F / 64) * (D / 32);
  constexpr int NIT = MOE_E * (2 * I13 + I2);
  for (int it = gw; it < NIT; it += ngw) {
    const int e = it / (2 * I13 + I2); int r = it % (2 * I13 + I2);
    if (r < 2 * I13) { const int which = r / I13; r %= I13; const int kb = r / (MOE_F / 32), nb = r % (MOE_F / 32), n0 = 32 * nb;
      const float* W = (which ? p.moe_w3 : p.moe_w1) + ((size_t)layer * MOE_E + e) * D * MOE_F;
      transpose_item(W, D, MOE_F, p.W13t, 64 * kb, n0, e * 2 * MOE_F + (n0 / 128) * 256 + which * 128 + (n0 % 128), scr, lane);
    } else { r -= 2 * I13; const int kb = r / (D / 32), nb = r % (D / 32);
      const float* W = p.moe_w2 + ((size_t)layer * MOE_E + e) * MOE_F * D;
      transpose_item(W, MOE_F, D, p.W2t, 64 * kb, 32 * nb, e * D + 32 * nb, scr, lane); }
  }
}

__global__ void __launch_bounds__(NTHR, 2) mega_kernel(Params p_by_value) {
  const Params& p = *(const Params*)__builtin_amdgcn_kernarg_segment_ptr();
  extern __shared__ __attribute__((aligned(16))) unsigned char lds_raw[];
  LAS unsigned char* lds = (LAS unsigned char*)lds_raw;
  volatile LAS unsigned* MISC = (volatile LAS unsigned*)(lds + MISC_OFF);
  for (int u = threadIdx.x; u < (LDS_BYTES - LDSCTL_OFF) / 4; u += NTHR) ((LAS unsigned*)(lds + LDSCTL_OFF))[u] = 0u;
  __syncthreads();
  XcdBarrier bar = xcd_barrier_post(p.ctl + CW_BAR, MISC + 8);
#define PH_VARS                                                                                                       \
  int tid = threadIdx.x; asm volatile("" : "+v"(tid));                                                                \
  int bx = blockIdx.x; asm volatile("" : "+s"(bx));                                                                   \
  const int lane = tid & 63, wave = __builtin_amdgcn_readfirstlane(tid >> 6), G = gridDim.x;                          \
  const int vcu = (G % 8 == 0) ? (bx % 8) * (G / 8) + bx / 8 : bx;                                                    \
  const int gw = vcu * NWAVES + wave, ngw = G * NWAVES;                                                               \
  LAS float* scr = (LAS float*)(lds + wave * 16384);                                                                  \
  (void)lane; (void)gw; (void)ngw; (void)scr; (void)vcu;
#define GRID_BAR() xcd_barrier(bar)
#define RUN_NAIVE(S, layer, cnt)                                                                                  \
  {                                                                                                               \
    const int n_ = (cnt);                                                                                         \
    PH_VARS                                                                                                       \
    for (int idx = bx * NTHR + tid; idx < n_; idx += G * NTHR) run_elem<S>(p, layer, idx);                        \
  }

  RUN_NAIVE(S_MOD, 0, N_MOD)
  RUN_NAIVE(S_TABA, 0, N_TABA)
  { PH_VARS
  transpose_matrix(p.w_in_a, D, AB_IN, p.WinA_t, scr, gw, ngw, lane);
  transpose_matrix(p.dif_w_in, D, DIF_IN, p.DifIn_t, scr, gw, ngw, lane);
  transpose_matrix(p.w_out_a, AB_OUT, D, p.WoutA_t, scr, gw, ngw, lane);
  transpose_matrix(p.dif_w_out, DIF_VW, D, p.DifOut_t, scr, gw, ngw, lane);
  transpose_matrix(p.glu_w, SSM_W, SSM_W, p.Glu_t, scr, gw, ngw, lane);
  moe_weight_transposes(p, 0, scr, gw, ngw, lane); }
  GRID_BAR();
  RUN_NAIVE(S_TABB, 0, N_KT)
  { PH_VARS for (int m = gw; m < TA; m += ngw) { const int r = tok_r(m); mod_row_to_bf16(xrow(p, 0, m), modp(p, 0, r, 1), modp(p, 0, r, 0), p.H + (size_t)m * D, lane); } }
  GRID_BAR();
#define PROJ_GEMM(NW_, WT_, ROPE_END_)                                                                                  \
  { PH_VARS                                                                                                             \
    pg8::Gemm g{p.H, WT_, D, D, D};                                                                                     \
    pg8::StaticOrder S; S.init(TA, NW_, G, bx);                                                            \
    EpiProj E{p.P, NW_, ROPE_END_, p.ropeT};                                                                            \
    pg8::gemm_phase<EpiProj, pg8::StaticOrder>(lds, g, S, E);                                                           \
  }                                                                                                                     \
  GRID_BAR();
#define LAYER_BACK(layer, T, WOT_, KO_)                                                                                 \
  { PH_VARS                                                                            \
    pg8::Gemm g{p.Ymix, WOT_, YW, KO_, KO_};                                                                            \
    pg8::StaticOrder S; S.init(T, D, G, bx);                                                               \
    EpiF32Out E{p.F, D};                                                                                                \
    pg8::gemm_phase<EpiF32Out, pg8::StaticOrder>(lds, g, S, E);                                                         \
  }                                                                                                                     \
  GRID_BAR();                                                                                                           \
  { PH_VARS for (int t = gw; t < T; t += ngw) ln1_route_row(p, layer, t, lane); }                                      \
  GRID_BAR();                                                                                                           \
  { PH_VARS scatter_phase(p, layer, T, lds, gw, ngw, lane, tid); }                                                      \
  GRID_BAR();                                                                                                           \
  { PH_VARS                                                             \
    pg8::Gemm g{p.Amoe, p.W13t, D, D, D};                                                                               \
    MoeOrder S{p.moe_meta, 2, G, vcu};                                                                                  \
    EpiMoe1 E{p.HHb, p.gate};                                                                                           \
    pg8::gemm_phase<EpiMoe1, MoeOrder>(lds, g, S, E);                                                                   \
  }                                                                                                                     \
  GRID_BAR();                                                                                                           \
  { PH_VARS                                                                                  \
    pg8::Gemm g{p.HHb, p.W2t, MOE_F, MOE_F, MOE_F};                                                                     \
    MoeOrder S{p.moe_meta, 4, G, vcu};                                                                                  \
    EpiBf16Out E{p.F2, D, 4};                                                                                           \
    pg8::gemm_phase<EpiBf16Out, MoeOrder>(lds, g, S, E);                                                                \
  }                                                                                                                     \
  GRID_BAR();                                                                                                           \
  { PH_VARS for (int t = gw; t < T; t += ngw) ln2_row(p, layer, t, lane); }

  PROJ_GEMM(AB_IN, p.WinA_t, (SWA_QW + SWA_KVW))
  RUN_NAIVE(S_SWA, 0, SWA_H * TA)
  RUN_NAIVE(S_SSME, 0, N_SSME)
  GRID_BAR();
  RUN_NAIVE(S_SSMC, 0, N_SSMC)
  GRID_BAR();
  RUN_NAIVE(S_SSMO, 0, TA * SSM_W)
  GRID_BAR();
  { PH_VARS
    pg8::Gemm g{p.Gs, p.Glu_t, SSM_W, SSM_W, SSM_W};
    pg8::StaticOrder S; S.init(TA, SSM_W, G, bx);
    EpiGlu E{p.Gs, p.glu_b, p.Ymix, YW, SWA_QW};
    pg8::gemm_phase<EpiGlu, pg8::StaticOrder>(lds, g, S, E);
  }
  GRID_BAR();
  LAYER_BACK(0, TA, p.WoutA_t, AB_OUT)
  { PH_VARS moe_weight_transposes(p, 1, scr, gw, ngw, lane); }
  GRID_BAR();
  PROJ_GEMM(DIF_IN, p.DifIn_t, (2 * DIF_QK))
  RUN_NAIVE(S_DIF, 1, DIF_H * 2 * TL)
  GRID_BAR();
  RUN_NAIVE(S_DIFNORM, 1, TL * DIF_H)
  GRID_BAR();
  LAYER_BACK(1, TL, p.DifOut_t, DIF_VW)
}

extern "C" void kernel_launch(void* const* d_in, const int* in_sizes, int n_in, void* d_out, int out_size, void* d_ws,
                              size_t ws_size, hipStream_t stream) {
  static int grid = 0;
  if (grid == 0) {
    if (ws_layout().total > ws_size || n_in != 37 || out_size != TL * D) { fprintf(stderr, "kernel_launch: bad sizes (ws need %zu have %zu)\n", ws_layout().total, ws_size); grid = -1; return; }
    int dev = 0, cus = 0;
    if (hipGetDevice(&dev) != hipSuccess || hipDeviceGetAttribute(&cus, hipDeviceAttributeMultiprocessorCount, dev) != hipSuccess) { grid = -1; return; }
    if (hipFuncSetAttribute((const void*)mega_kernel, hipFuncAttributeMaxDynamicSharedMemorySize, LDS_BYTES) != hipSuccess) { fprintf(stderr, "kernel_launch: hipFuncSetAttribute failed\n"); grid = -1; return; }
    grid = cus;
  }
  if (grid < 0) return;
  Params p{};
  fill_inputs(p, d_in);
  p.out = (float*)d_out;
  fill_ws(p, (char*)d_ws);
  if (hipMemsetAsync((char*)d_ws + ws_layout().ctl, 0, CTL_BYTES, stream) != hipSuccess) { fprintf(stderr, "kernel_launch: memset failed\n"); return; }
  hipLaunchKernelGGL(mega_kernel, dim3(grid), dim3(NTHR), LDS_BYTES, stream, p);
  const hipError_t le = hipPeekAtLastError();
  if (le != hipSuccess) fprintf(stderr, "kernel_launch: launch failed: %s\n", hipGetErrorName(le));
}
#endif
```

```cpp
#ifndef HOST_EMU
#include <hip/hip_runtime.h>
#define HD __host__ __device__ __forceinline__
#else
#define HD inline
#endif
#include <stdint.h>
#include <math.h>

#ifndef CFG_D
#define CFG_D 1024
#define CFG_B 8
#define CFG_N 2048
#define CFG_CTX 256
#endif

constexpr int D = CFG_D, B = CFG_B, N = CFG_N, CTX = CFG_CTX;
constexpr int DEPTH = 2, GRID_W = 64, HD_ = 64;
constexpr int TL = B * N, TC = B * CTX, TA = TL + TC;
constexpr int SWA_H = 8, SWA_QW = 512, SWA_KVW = 128, SWA_WIN = 128;
constexpr int SSM_W = D / 2, SSM_C = 16, SSM_G = SSM_W / 16, SSM_P = 64;
constexpr int AB_IN = SWA_QW + 2 * SWA_KVW + SSM_W;
constexpr int AB_OUT = SWA_QW + SSM_W;
constexpr int A_KOFF = SWA_QW, A_VOFF = SWA_QW + SWA_KVW, A_UOFF = SWA_QW + 2 * SWA_KVW;
constexpr int DIF_H = D / 128, DIF_QK = DIF_H * 128, DIF_VW = DIF_H * 128, DIF_IN = 2 * DIF_QK + DIF_VW;
constexpr int MOE_G = 4, MOE_EPG = 8, MOE_E = 32, MOE_F = D / 4;
constexpr int SL = 64;
constexpr int SS = CTX + N;
constexpr int NCH = SS / SL;
constexpr float LN_EPS = 1e-5f, RMS_EPS = 1e-5f;
constexpr float ALPHA = 1.41421356237309515f;
static_assert(CTX % SL == 0 && N % SL == 0, "chunking");
constexpr int YW = AB_OUT > D ? AB_OUT : D;

struct Params {
  const float *x, *c, *ctx, *c_ctx, *mod_w, *mod_b, *ln1_g, *ln1_b, *ln2_g, *ln2_b;
  const float *w_in_a, *w_out_a, *sink, *a_re, *a_im, *log_step, *b_re, *b_im, *c_re, *c_im, *ssm_d, *glu_w, *glu_b;
  const float *dif_w_in, *dif_w_out, *lq1, *lk1, *lq2, *lk2, *subln_g;
  const float *moe_wg, *moe_bg, *moe_we, *moe_be, *moe_w1, *moe_w3, *moe_w2;
  float* out;
  float *X, *X1, *F, *HH;
  uint16_t *P, *Ymix, *Gs;
  float *modv, *ropeT, *apow, *bbar, *KT, *E, *Sin, *route, *scal;
  uint16_t *H;
  uint16_t *WinA_t, *DifIn_t, *WoutA_t, *DifOut_t, *Glu_t, *W13t, *W2t;
  uint16_t *Amoe, *HHb, *F2;
  float* gate;
  int *tokslot, *moe_meta;
  unsigned* ctl;
};

HD uint16_t f2bf(float f) {
  uint32_t u = __builtin_bit_cast(uint32_t, f);
  u += 0x7fffu + ((u >> 16) & 1u);
  return (uint16_t)(u >> 16);
}
HD float bf2f(uint16_t h) {
  uint32_t u = ((uint32_t)h) << 16;
  return __builtin_bit_cast(float, u);
}
HD float siluf(float x) { return x / (1.0f + expf(-x)); }
HD float sigmoidf_(float x) { return 1.0f / (1.0f + expf(-x)); }
HD float geluf_(float x) { return 0.5f * x * (1.0f + tanhf(0.7978845608028654f * (x + 0.044715f * x * x * x))); }

HD int tok_r(int t) { return t < TL ? t / N : B; }
HD const float* xrow(const Params& p, int layer, int t) {
  if (layer == 0) return t < TL ? p.x + (size_t)t * D : p.ctx + (size_t)(t - TL) * D;
  return p.X + (size_t)t * D;
}
HD const float* modp(const Params& p, int layer, int r, int which) {
  return p.modv + ((size_t)(layer * (B + 1) + r) * 6 + which) * D;
}

constexpr int N_MOD = DEPTH * (B + 1) * 6 * D;
HD void st_mod(const Params& p, int layer_unused, int idx) {
  int j = idx % (6 * D); int r = (idx / (6 * D)) % (B + 1); int l = idx / (6 * D * (B + 1));
  const float* cv = r < B ? p.c + (size_t)r * D : p.c_ctx;
  const float* w = p.mod_w + (size_t)l * D * 6 * D;
  float acc = p.mod_b[(size_t)l * 6 * D + j];
  for (int k = 0; k < D; ++k) acc += siluf(cv[k]) * w[(size_t)k * 6 * D + j];
  p.modv[idx] = acc;
}

constexpr int N_ROPE = 64 * 16;
constexpr int N_APOW = 2 * SSM_G * SSM_P * (SL + 1);
constexpr int N_BBAR = 2 * SSM_G * SSM_P * SSM_C;
constexpr int N_TABA = N_ROPE + N_APOW + N_BBAR + 1;
HD void st_taba(const Params& p, int layer_unused, int idx) {
  if (idx < N_ROPE) {
    int pos = idx / 16, f = idx % 16;
    float inv = powf(10000.0f, -(float)f / 16.0f);
    float ang = (float)pos * inv;
    p.ropeT[idx * 2] = cosf(ang); p.ropeT[idx * 2 + 1] = sinf(ang);
    return;
  }
  idx -= N_ROPE;
  if (idx < N_APOW) {
    int k = idx % (SL + 1); int q = idx / (SL + 1);
    int dg = q / SSM_P;
    double dt = exp((double)p.log_step[dg]);
    double ar = p.a_re[q], ai = p.a_im[q];
    double mag = exp(k * dt * ar);
    p.apow[(size_t)idx * 2] = (float)(mag * cos(k * dt * ai));
    p.apow[(size_t)idx * 2 + 1] = (float)(mag * sin(k * dt * ai));
    return;
  }
  idx -= N_APOW;
  if (idx < N_BBAR) {
    int cc = idx % SSM_C; int q = idx / SSM_C; int dg = q / SSM_P;
    (void)cc;
    double dt = exp((double)p.log_step[dg]);
    double ar = p.a_re[q], ai = p.a_im[q];
    double mag = exp(dt * ar);
    double abr = mag * cos(dt * ai), abi = mag * sin(dt * ai);
    double den = ar * ar + ai * ai, nr = abr - 1.0;
    double cr = (nr * ar + abi * ai) / den, ci = (abi * ar - nr * ai) / den;
    double br = p.b_re[idx], bi = p.b_im[idx];
    p.bbar[(size_t)idx * 2] = (float)(cr * br - ci * bi);
    p.bbar[(size_t)idx * 2 + 1] = (float)(cr * bi + ci * br);
    return;
  }
  double s1 = 0, s2 = 0;
  for (int i = 0; i < HD_; ++i) { s1 += (double)p.lq1[i] * p.lk1[i]; s2 += (double)p.lq2[i] * p.lk2[i]; }
  double lam_init = 0.8 - 0.6 * exp(-0.3 * 1.0);
  p.scal[0] = (float)(exp(s1) - exp(s2) + lam_init);
  p.scal[1] = (float)(1.0 - lam_init);
}

constexpr int N_KT = 2 * SSM_G * SL * SSM_C * SSM_C;
HD void st_tabb(const Params& p, int layer_unused, int idx) {
  int ci = idx % SSM_C; int co = (idx / SSM_C) % SSM_C; int k = (idx / (SSM_C * SSM_C)) % SL; int dg = idx / (SSM_C * SSM_C * SL);
  float acc = 0.f;
  for (int pp = 0; pp < SSM_P; ++pp) {
    int q = dg * SSM_P + pp;
    float ar = p.apow[((size_t)q * (SL + 1) + k) * 2], ai = p.apow[((size_t)q * (SL + 1) + k) * 2 + 1];
    float br = p.bbar[((size_t)q * SSM_C + ci) * 2], bi = p.bbar[((size_t)q * SSM_C + ci) * 2 + 1];
    float cr = p.c_re[((size_t)dg * SSM_C + co) * SSM_P + pp], cim = p.c_im[((size_t)dg * SSM_C + co) * SSM_P + pp];
    float tr = ar * br - ai * bi, ti = ar * bi + ai * br;
    acc += cr * tr - cim * ti;
  }
  p.KT[idx] = acc;
}

HD void st_proj(const Params& p, int layer, int idx) {
  const int W = layer == 0 ? AB_IN : DIF_IN;
  const float* w = layer == 0 ? p.w_in_a : p.dif_w_in;
  const int rope_end = layer == 0 ? (SWA_QW + SWA_KVW) : (2 * DIF_QK);
  int t = idx / W, n = idx % W;
  int r = tok_r(t);
  if (layer == 1 && t >= TL && n < DIF_QK) return;
  const float* xr = xrow(p, layer, t);
  const float* sh = modp(p, layer, r, 0);
  const float* sc = modp(p, layer, r, 1);
  bool rope = (t < TL) && (n < rope_end);
  if (!rope) {
    float acc = 0.f;
    for (int k = 0; k < D; ++k) { float h = xr[k] * (1.0f + sc[k]) + sh[k]; acc += h * w[(size_t)k * W + n]; }
    p.P[(size_t)t * W + n] = f2bf(acc);
    return;
  }
  int d = n % 64, sub = d % 32;
  if (sub >= 16) return;
  float a1 = 0.f, a2 = 0.f;
  for (int k = 0; k < D; ++k) {
    float h = xr[k] * (1.0f + sc[k]) + sh[k];
    a1 += h * w[(size_t)k * W + n]; a2 += h * w[(size_t)k * W + n + 16];
  }
  int i = t % N;
  int pos = d < 32 ? i / GRID_W : i % GRID_W;
  float cs = p.ropeT[(pos * 16 + sub) * 2], sn = p.ropeT[(pos * 16 + sub) * 2 + 1];
  p.P[(size_t)t * W + n] = f2bf(a1 * cs - a2 * sn);
  p.P[(size_t)t * W + n + 16] = f2bf(a2 * cs + a1 * sn);
}

HD void st_swa(const Params& p, int layer, int idx) {
  int hq = idx / TA, t = idx % TA;
  int kvh = hq / 4;
  const uint16_t* P = p.P;
  float q[64], o[64];
  _Pragma("unroll") for (int d = 0; d < 64; ++d) { q[d] = bf2f(P[(size_t)t * AB_IN + hq * 64 + d]) * 0.125f; o[d] = 0.f; }
  float m = p.sink[hq], l = 1.0f;
  int b = t < TL ? t / N : (t - TL) / CTX;
  int nloc = t < TL ? 2 * SWA_WIN + 1 : 0;
  int i = t < TL ? t % N : 0;
  for (int kk = 0; kk < nloc + CTX; ++kk) {
    int row;
    if (kk < nloc) {
      int j = i - SWA_WIN + kk;
      if (j < 0 || j >= N) continue;
      row = b * N + j;
    } else row = TL + b * CTX + (kk - nloc);
    const uint16_t* kr = P + (size_t)row * AB_IN + A_KOFF + kvh * 64;
    const uint16_t* vr = P + (size_t)row * AB_IN + A_VOFF + kvh * 64;
    float s = 0.f;
    _Pragma("unroll") for (int d = 0; d < 64; ++d) s += q[d] * bf2f(kr[d]);
    if (s > m) { float f = expf(m - s); l *= f; for (int d = 0; d < 64; ++d) o[d] *= f; m = s; }
    float pe = expf(s - m);
    l += pe;
    _Pragma("unroll") for (int d = 0; d < 64; ++d) o[d] += pe * bf2f(vr[d]);
  }
  float il = 1.0f / l;
  _Pragma("unroll") for (int d = 0; d < 64; ++d) p.Ymix[(size_t)t * YW + hq * 64 + d] = f2bf(o[d] * il);
}

HD int ssm_row(int dir, int b, int tau) {
  if (dir == 0) return tau < CTX ? TL + b * CTX + tau : b * N + (tau - CTX);
  return tau < CTX ? TL + b * CTX + (CTX - 1 - tau) : b * N + (N - 1 - (tau - CTX));
}
constexpr int N_SSME = 2 * B * NCH * SSM_G * SSM_P;
HD void st_ssm_e(const Params& p, int layer, int idx) {
  int pp = idx % SSM_P; int g = (idx / SSM_P) % SSM_G; int ch = (idx / (SSM_P * SSM_G)) % NCH;
  int b = (idx / (SSM_P * SSM_G * NCH)) % B; int dir = idx / (SSM_P * SSM_G * NCH * B);
  int q = (dir * SSM_G + g) * SSM_P + pp;
  float er = 0.f, ei = 0.f;
  for (int j = 0; j < SL; ++j) {
    int row = ssm_row(dir, b, ch * SL + j);
    const uint16_t* u = p.P + (size_t)row * AB_IN + A_UOFF + g * 16;
    float vr = 0.f, vi = 0.f;
    _Pragma("unroll") for (int cc = 0; cc < 16; ++cc) {
      float uv = bf2f(u[cc]);
      vr += p.bbar[((size_t)q * 16 + cc) * 2] * uv; vi += p.bbar[((size_t)q * 16 + cc) * 2 + 1] * uv;
    }
    float ar = p.apow[((size_t)q * (SL + 1) + (SL - 1 - j)) * 2], ai = p.apow[((size_t)q * (SL + 1) + (SL - 1 - j)) * 2 + 1];
    er += ar * vr - ai * vi; ei += ar * vi + ai * vr;
  }
  p.E[(size_t)idx * 2] = er; p.E[(size_t)idx * 2 + 1] = ei;
}
constexpr int N_SSMC = 2 * B * SSM_G * SSM_P;
HD void st_ssm_c(const Params& p, int layer, int idx) {
  int pp = idx % SSM_P; int g = (idx / SSM_P) % SSM_G; int b = (idx / (SSM_P * SSM_G)) % B; int dir = idx / (SSM_P * SSM_G * B);
  int q = (dir * SSM_G + g) * SSM_P + pp;
  float ar = p.apow[((size_t)q * (SL + 1) + SL) * 2], ai = p.apow[((size_t)q * (SL + 1) + SL) * 2 + 1];
  float sr = 0.f, si = 0.f;
  for (int ch = 0; ch < NCH; ++ch) {
    size_t e = ((((size_t)dir * B + b) * NCH + ch) * SSM_G + g) * SSM_P + pp;
    p.Sin[e * 2] = sr; p.Sin[e * 2 + 1] = si;
    float er = p.E[e * 2], ei = p.E[e * 2 + 1];
    float nr = ar * sr - ai * si + er, ni = ar * si + ai * sr + ei;
    sr = nr; si = ni;
  }
}
HD void st_ssm_o(const Params& p, int layer, int idx) {
  int t = idx / SSM_W, n = idx % SSM_W; int g = n / 16, co = n % 16;
  int b, dirtau[2];
  if (t < TL) { b = t / N; int i = t % N; dirtau[0] = CTX + i; dirtau[1] = CTX + (N - 1 - i); }
  else { b = (t - TL) / CTX; int i = (t - TL) % CTX; dirtau[0] = i; dirtau[1] = CTX - 1 - i; }
  float y = p.ssm_d[n] * bf2f(p.P[(size_t)t * AB_IN + A_UOFF + n]);
  for (int dir = 0; dir < 2; ++dir) {
    int tau = dirtau[dir]; int ch = tau / SL, j = tau % SL;
    int dg = dir * SSM_G + g;
    size_t e0 = ((((size_t)dir * B + b) * NCH + ch) * SSM_G + g) * SSM_P;
    for (int pp = 0; pp < SSM_P; ++pp) {
      int q = dg * SSM_P + pp;
      float ar = p.apow[((size_t)q * (SL + 1) + (j + 1)) * 2], ai = p.apow[((size_t)q * (SL + 1) + (j + 1)) * 2 + 1];
      float sr = p.Sin[(e0 + pp) * 2], si = p.Sin[(e0 + pp) * 2 + 1];
      float tr = ar * sr - ai * si, ti = ar * si + ai * sr;
      float cr = p.c_re[((size_t)dg * 16 + co) * SSM_P + pp], cim = p.c_im[((size_t)dg * 16 + co) * SSM_P + pp];
      y += cr * tr - cim * ti;
    }
    for (int j2 = 0; j2 <= j; ++j2) {
      int row = ssm_row(dir, b, ch * SL + j2);
      const uint16_t* u = p.P + (size_t)row * AB_IN + A_UOFF + g * 16;
      const float* kt = p.KT + (((size_t)dg * SL + (j - j2)) * 16 + co) * 16;
      _Pragma("unroll") for (int ci = 0; ci < 16; ++ci) y += kt[ci] * bf2f(u[ci]);
    }
  }
  p.Gs[(size_t)t * SSM_W + n] = f2bf(geluf_(y));
}
HD void st_glu(const Params& p, int layer, int idx) {
  int t = idx / SSM_W, n = idx % SSM_W;
  float z = p.glu_b[n];
  const uint16_t* g = p.Gs + (size_t)t * SSM_W;
  for (int k = 0; k < SSM_W; ++k) z += bf2f(g[k]) * p.glu_w[(size_t)k * SSM_W + n];
  p.Ymix[(size_t)t * YW + SWA_QW + n] = f2bf(bf2f(g[n]) * sigmoidf_(z));
}

HD void st_dif(const Params& p, int layer, int idx) {
  int t = idx % TL; int he = idx / TL; int eh = he % 2, h = he / 2;
  int b = t / N;
  const uint16_t* P = p.P;
  float res[64];
  float lam = p.scal[0];
  _Pragma("unroll") for (int c = 0; c < 2; ++c) {
    float q[64], o[64];
    _Pragma("unroll") for (int d = 0; d < 64; ++d) { q[d] = bf2f(P[(size_t)t * DIF_IN + h * 128 + c * 64 + d]) * 0.125f; o[d] = 0.f; }
    float m = -1e30f, l = 0.f;
    for (int kk = 0; kk < N + CTX; ++kk) {
      int row = kk < N ? b * N + kk : TL + b * CTX + (kk - N);
      const uint16_t* kr = P + (size_t)row * DIF_IN + DIF_QK + h * 128 + c * 64;
      const uint16_t* vr = P + (size_t)row * DIF_IN + 2 * DIF_QK + h * 128 + eh * 64;
      float s = 0.f;
      _Pragma("unroll") for (int d = 0; d < 64; ++d) s += q[d] * bf2f(kr[d]);
      if (s > m) { float f = expf(m - s); l *= f; for (int d = 0; d < 64; ++d) o[d] *= f; m = s; }
      float pe = expf(s - m);
      l += pe;
      _Pragma("unroll") for (int d = 0; d < 64; ++d) o[d] += pe * bf2f(vr[d]);
    }
    float il = 1.0f / l;
    if (c == 0) { for (int d = 0; d < 64; ++d) res[d] = o[d] * il; }
    else { for (int d = 0; d < 64; ++d) res[d] -= lam * o[d] * il; }
  }
  _Pragma("unroll") for (int d = 0; d < 64; ++d) p.Ymix[(size_t)t * YW + h * 128 + eh * 64 + d] = f2bf(res[d]);
}
HD void st_difnorm(const Params& p, int layer, int idx) {
  int t = idx / DIF_H, h = idx % DIF_H;
  uint16_t* o = p.Ymix + (size_t)t * YW + h * 128;
  float ss = 0.f;
  for (int e = 0; e < 128; ++e) { float v = bf2f(o[e]); ss += v * v; }
  float r = 1.0f / sqrtf(ss / 128.0f + RMS_EPS) * p.scal[1];
  _Pragma("unroll 8") for (int e = 0; e < 128; ++e) o[e] = f2bf(bf2f(o[e]) * r * p.subln_g[e]);
}

HD void st_outproj(const Params& p, int layer, int idx) {
  int t = idx / D, n = idx % D;
  const float* w = layer == 0 ? p.w_out_a : p.dif_w_out;
  const uint16_t* y = p.Ymix + (size_t)t * YW;
  const int KW = layer == 0 ? AB_OUT : DIF_VW;
  float acc = 0.f;
  for (int k = 0; k < KW; ++k) acc += bf2f(y[k]) * w[(size_t)k * D + n];
  p.F[(size_t)t * D + n] = acc;
}
HD void st_ln1(const Params& p, int layer, int t) {
  int r = tok_r(t);
  const float* xr = xrow(p, layer, t); const float* g1 = modp(p, layer, r, 2);
  const float* y = p.F + (size_t)t * D;
  float mu = 0.f;
  for (int k = 0; k < D; ++k) mu += ALPHA * xr[k] + g1[k] * y[k];
  mu /= D;
  float var = 0.f;
  for (int k = 0; k < D; ++k) { float v = ALPHA * xr[k] + g1[k] * y[k] - mu; var += v * v; }
  var /= D;
  float rs = 1.0f / sqrtf(var + LN_EPS);
  const float* lg = p.ln1_g + (size_t)layer * D; const float* lb = p.ln1_b + (size_t)layer * D;
  for (int k = 0; k < D; ++k) p.X1[(size_t)t * D + k] = (ALPHA * xr[k] + g1[k] * y[k] - mu) * rs * lg[k] + lb[k];
}
HD void st_route(const Params& p, int layer, int t) {
  int r = tok_r(t);
  const float* x1 = p.X1 + (size_t)t * D; const float* sh = modp(p, layer, r, 3); const float* sc = modp(p, layer, r, 4);
  float lg[MOE_G];
  _Pragma("unroll") for (int g = 0; g < MOE_G; ++g) lg[g] = p.moe_bg[layer * MOE_G + g];
  const float* wg = p.moe_wg + (size_t)layer * D * MOE_G;
  for (int k = 0; k < D; ++k) {
    float h = x1[k] * (1.0f + sc[k]) + sh[k];
    _Pragma("unroll") for (int g = 0; g < MOE_G; ++g) lg[g] += h * wg[k * MOE_G + g];
  }
  int gi = 0; float mx = lg[0];
  _Pragma("unroll") for (int g = 1; g < MOE_G; ++g) if (lg[g] > mx) { mx = lg[g]; gi = g; }
  float den = 0.f;
  _Pragma("unroll") for (int g = 0; g < MOE_G; ++g) den += expf(lg[g] - mx);
  float gp = 1.0f / den;
  float le[MOE_EPG];
  _Pragma("unroll") for (int e = 0; e < MOE_EPG; ++e) le[e] = p.moe_be[(layer * MOE_G + gi) * MOE_EPG + e];
  const float* we = p.moe_we + ((size_t)layer * MOE_G + gi) * D * MOE_EPG;
  for (int k = 0; k < D; ++k) {
    float h = x1[k] * (1.0f + sc[k]) + sh[k];
    _Pragma("unroll") for (int e = 0; e < MOE_EPG; ++e) le[e] += h * we[k * MOE_EPG + e];
  }
  int i0 = 0; float v0 = le[0];
  _Pragma("unroll") for (int e = 1; e < MOE_EPG; ++e) if (le[e] > v0) { v0 = le[e]; i0 = e; }
  int i1 = -1; float v1 = -3e38f;
  _Pragma("unroll") for (int e = 0; e < MOE_EPG; ++e) if (e != i0 && le[e] > v1) { v1 = le[e]; i1 = e; }
  float e1 = expf(v1 - v0);
  float w0 = gp / (1.0f + e1), w1 = gp * e1 / (1.0f + e1);
  p.route[(size_t)t * 4 + 0] = (float)(gi * MOE_EPG + i0);
  p.route[(size_t)t * 4 + 1] = (float)(gi * MOE_EPG + i1);
  p.route[(size_t)t * 4 + 2] = w0;
  p.route[(size_t)t * 4 + 3] = w1;
}
HD void st_moe_h(const Params& p, int layer, int idx) {
  int f = idx % MOE_F; int j = (idx / MOE_F) % 2; int t = idx / (2 * MOE_F);
  int r = tok_r(t);
  const float* x1 = p.X1 + (size_t)t * D; const float* sh = modp(p, layer, r, 3); const float* sc = modp(p, layer, r, 4);
  int e = (int)p.route[(size_t)t * 4 + j]; float wgt = p.route[(size_t)t * 4 + 2 + j];
  const float* w1 = p.moe_w1 + ((size_t)layer * MOE_E + e) * D * MOE_F;
  const float* w3 = p.moe_w3 + ((size_t)layer * MOE_E + e) * D * MOE_F;
  float h1 = 0.f, h3 = 0.f;
  for (int k = 0; k < D; ++k) {
    float h = x1[k] * (1.0f + sc[k]) + sh[k];
    h1 += h * w1[(size_t)k * MOE_F + f]; h3 += h * w3[(size_t)k * MOE_F + f];
  }
  p.HH[(size_t)idx] = siluf(h1) * h3 * wgt;
}
HD void st_moe_o(const Params& p, int layer, int idx) {
  int t = idx / D, n = idx % D;
  float acc = 0.f;
  for (int j = 0; j < 2; ++j) {
    int e = (int)p.route[(size_t)t * 4 + j];
    const float* w2 = p.moe_w2 + ((size_t)layer * MOE_E + e) * MOE_F * D;
    const float* hh = p.HH + ((size_t)t * 2 + j) * MOE_F;
    for (int f = 0; f < MOE_F; ++f) acc += hh[f] * w2[(size_t)f * D + n];
  }
  p.F[(size_t)t * D + n] = acc;
}
HD void st_ln2(const Params& p, int layer, int t) {
  int r = tok_r(t);
  const float* x1 = p.X1 + (size_t)t * D; const float* g2 = modp(p, layer, r, 5);
  const float* y = p.F + (size_t)t * D;
  float mu = 0.f;
  for (int k = 0; k < D; ++k) mu += ALPHA * x1[k] + g2[k] * y[k];
  mu /= D;
  float var = 0.f;
  for (int k = 0; k < D; ++k) { float v = ALPHA * x1[k] + g2[k] * y[k] - mu; var += v * v; }
  var /= D;
  float rs = 1.0f / sqrtf(var + LN_EPS);
  const float* lg = p.ln2_g + (size_t)layer * D; const float* lb = p.ln2_b + (size_t)layer * D;
  float* dst = layer == DEPTH - 1 ? p.out + (size_t)t * D : p.X + (size_t)t * D;
  for (int k = 0; k < D; ++k) dst[k] = (ALPHA * x1[k] + g2[k] * y[k] - mu) * rs * lg[k] + lb[k];
}

enum { S_MOD, S_TABA, S_TABB, S_PROJ, S_SWA, S_SSME, S_SSMC, S_SSMO, S_GLU, S_DIF, S_DIFNORM, S_OUTPROJ, S_LN1, S_ROUTE, S_MOEH, S_MOEO, S_LN2 };
template <int S> HD void run_elem(const Params& p, int layer, int idx) {
  if (S == S_MOD) st_mod(p, layer, idx);
  else if (S == S_TABA) st_taba(p, layer, idx);
  else if (S == S_TABB) st_tabb(p, layer, idx);
  else if (S == S_PROJ) st_proj(p, layer, idx);
  else if (S == S_SWA) st_swa(p, layer, idx);
  else if (S == S_SSME) st_ssm_e(p, layer, idx);
  else if (S == S_SSMC) st_ssm_c(p, layer, idx);
  else if (S == S_SSMO) st_ssm_o(p, layer, idx);
  else if (S == S_GLU) st_glu(p, layer, idx);
  else if (S == S_DIF) st_dif(p, layer, idx);
  else if (S == S_DIFNORM) st_difnorm(p, layer, idx);
  else if (S == S_OUTPROJ) st_outproj(p, layer, idx);
  else if (S == S_LN1) st_ln1(p, layer, idx);
  else if (S == S_ROUTE) st_route(p, layer, idx);
  else if (S == S_MOEH) st_moe_h(p, layer, idx);
  else if (S == S_MOEO) st_moe_o(p, layer, idx);
  else if (S == S_LN2) st_ln2(p, layer, idx);
}

constexpr int NSLOT = 2 * TA + MOE_E * 256;
constexpr size_t CTL_BYTES = 1u << 20;
struct WsLayout {
  size_t ctl, X, X1, P, Ymix, Gs, modv, ropeT, apow, bbar, KT, E, Sin, route, scal, WinA_t, DifIn_t, WoutA_t, DifOut_t, Glu_t, W13t, W2t, gate, tokslot, moe_meta, total;
};
inline WsLayout ws_layout() {
  WsLayout L; size_t o = 0;
  auto take = [&](size_t bytes) { size_t r = o; o += (bytes + 255) & ~(size_t)255; return r; };
  L.ctl = take(CTL_BYTES);
  L.X = take((size_t)TA * D * 4);
  L.X1 = L.X;
  L.P = take((size_t)TA * (AB_IN > DIF_IN ? AB_IN : DIF_IN) * 2);
  L.Ymix = take((size_t)TA * YW * 2);
  L.Gs = L.X;
  L.modv = take((size_t)N_MOD * 4);
  L.ropeT = take((size_t)N_ROPE * 2 * 4);
  L.apow = take((size_t)N_APOW * 2 * 4);
  L.bbar = take((size_t)N_BBAR * 2 * 4);
  L.KT = take((size_t)N_KT * 4);
  L.E = L.X + (((size_t)TA * SSM_W * 2 + 255) & ~(size_t)255);
  L.Sin = L.E + (((size_t)N_SSME * 2 * 4 + 255) & ~(size_t)255);
  L.route = take((size_t)TA * 8 * 4);
  L.scal = take(256);
  L.WinA_t = take((size_t)AB_IN * D * 2);
  L.DifIn_t = take((size_t)DIF_IN * D * 2);
  L.WoutA_t = take((size_t)D * AB_OUT * 2);
  L.DifOut_t = take((size_t)D * DIF_VW * 2);
  L.Glu_t = take((size_t)SSM_W * SSM_W * 2);
  L.W13t = take((size_t)MOE_E * 2 * MOE_F * D * 2);
  L.W2t = take((size_t)MOE_E * D * MOE_F * 2);
  L.gate = take((size_t)NSLOT * 4);
  L.tokslot = take((size_t)TA * 2 * 4);
  L.moe_meta = take(4096);
  L.total = o;
  return L;
}
inline void fill_ws(Params& p, char* ws) {
  WsLayout L = ws_layout();
  p.X = (float*)(ws + L.X); p.X1 = (float*)(ws + L.X1); p.P = (uint16_t*)(ws + L.P); p.F = (float*)(ws + L.P);
  p.Ymix = (uint16_t*)(ws + L.Ymix); p.HH = (float*)(ws + L.Ymix);
  p.Gs = (uint16_t*)(ws + L.Gs); p.modv = (float*)(ws + L.modv); p.ropeT = (float*)(ws + L.ropeT);
  p.apow = (float*)(ws + L.apow); p.bbar = (float*)(ws + L.bbar); p.KT = (float*)(ws + L.KT);
  p.E = (float*)(ws + L.E); p.Sin = (float*)(ws + L.Sin); p.route = (float*)(ws + L.route); p.scal = (float*)(ws + L.scal);
  p.H = (uint16_t*)(ws + L.Ymix); p.WinA_t = (uint16_t*)(ws + L.WinA_t); p.DifIn_t = (uint16_t*)(ws + L.DifIn_t); p.ctl = (unsigned*)(ws + L.ctl);
  p.WoutA_t = (uint16_t*)(ws + L.WoutA_t); p.DifOut_t = (uint16_t*)(ws + L.DifOut_t); p.Glu_t = (uint16_t*)(ws + L.Glu_t);
  p.W13t = (uint16_t*)(ws + L.W13t); p.W2t = (uint16_t*)(ws + L.W2t);
  p.Amoe = (uint16_t*)(ws + L.P); p.F2 = (uint16_t*)(ws + L.P); p.HHb = (uint16_t*)(ws + L.Ymix);
  p.gate = (float*)(ws + L.gate); p.tokslot = (int*)(ws + L.tokslot); p.moe_meta = (int*)(ws + L.moe_meta);
}
inline void fill_inputs(Params& p, void* const* d_in) {
  const float* const* in = (const float* const*)d_in;
  p.x = in[0]; p.c = in[1]; p.ctx = in[2]; p.c_ctx = in[3]; p.mod_w = in[4]; p.mod_b = in[5];
  p.ln1_g = in[6]; p.ln1_b = in[7]; p.ln2_g = in[8]; p.ln2_b = in[9];
  p.w_in_a = in[10]; p.w_out_a = in[11]; p.sink = in[12]; p.a_re = in[13]; p.a_im = in[14]; p.log_step = in[15];
  p.b_re = in[16]; p.b_im = in[17]; p.c_re = in[18]; p.c_im = in[19]; p.ssm_d = in[20]; p.glu_w = in[21]; p.glu_b = in[22];
  p.dif_w_in = in[23]; p.dif_w_out = in[24]; p.lq1 = in[25]; p.lk1 = in[26]; p.lq2 = in[27]; p.lk2 = in[28]; p.subln_g = in[29];
  p.moe_wg = in[30]; p.moe_bg = in[31]; p.moe_we = in[32]; p.moe_be = in[33]; p.moe_w1 = in[34]; p.moe_w3 = in[35]; p.moe_w2 = in[36];
}

#define FORWARD_PROGRAM(RUN)                                   \
  RUN(S_MOD, 0, N_MOD)                                         \
  RUN(S_TABA, 0, N_TABA)                                       \
  RUN(S_TABB, 0, N_KT)                                         \
                                                   \
  RUN(S_PROJ, 0, TA * AB_IN)                                   \
  RUN(S_SWA, 0, SWA_H * TA)                                    \
  RUN(S_SSME, 0, N_SSME)                                       \
  RUN(S_SSMC, 0, N_SSMC)                                       \
  RUN(S_SSMO, 0, TA * SSM_W)                                   \
  RUN(S_GLU, 0, TA * SSM_W)                                    \
  RUN(S_OUTPROJ, 0, TA * D)                                    \
  RUN(S_LN1, 0, TA)                                            \
  RUN(S_ROUTE, 0, TA)                                          \
  RUN(S_MOEH, 0, TA * 2 * MOE_F)                               \
  RUN(S_MOEO, 0, TA * D)                                       \
  RUN(S_LN2, 0, TA)                                            \
                                                   \
  RUN(S_PROJ, 1, TA * DIF_IN)                                  \
  RUN(S_DIF, 1, DIF_H * 2 * TL)                                \
  RUN(S_DIFNORM, 1, TL * DIF_H)                                \
  RUN(S_OUTPROJ, 1, TL * D)                                    \
  RUN(S_LN1, 1, TL)                                            \
  RUN(S_ROUTE, 1, TL)                                          \
  RUN(S_MOEH, 1, TL * 2 * MOE_F)                               \
  RUN(S_MOEO, 1, TL * D)                                       \
  RUN(S_LN2, 1, TL)

#ifndef HOST_EMU
#include <cstdio>
#define LAS __attribute__((address_space(3)))
#define GAS __attribute__((address_space(1)))
typedef unsigned short bf16_t;
typedef short bf16x8 __attribute__((ext_vector_type(8)));
typedef float f32x4 __attribute__((ext_vector_type(4)));
typedef float f32x2 __attribute__((ext_vector_type(2)));
typedef unsigned u32x4 __attribute__((ext_vector_type(4)));
typedef unsigned u32x2 __attribute__((ext_vector_type(2)));
constexpr int NWAVES = 8, NTHR = 512;
constexpr int RING_BYTES = 131072, LDSCTL_OFF = RING_BYTES, MISC_OFF = LDSCTL_OFF + 320, LDS_BYTES = 147456;
#define LDS_WAIT() asm volatile("s_waitcnt lgkmcnt(0)" ::: "memory")
#define VM_WAIT() asm volatile("s_waitcnt vmcnt(0)" ::: "memory")
__device__ __forceinline__ unsigned cvt_pk_bf16(float lo, float hi) { unsigned r; asm volatile("v_cvt_pk_bf16_f32 %0, %1, %2" : "=v"(r) : "v"(lo), "v"(hi)); return r; }

namespace pg8 {
constexpr int BM = 256, BK = 64, HALF = 128, HTB = HALF * BK * 2, STAGE_BYTES = 8 * HTB, NXCD = 8, WGM = 8;
__host__ __device__ __forceinline__ int lds_byte(int r, int c) { const int st = (r >> 4) * 2 + (c >> 5), rr = r & 15, cc = c & 31, ob = rr * 64 + cc * 2; return st * 1024 + (ob ^ (((ob >> 9) & 1) << 5)); }
__host__ __device__ __forceinline__ void stage_rc(int b, int& R, int& C) { const int st = b / 1024, sb = b % 1024, swz = sb ^ (((sb >> 9) & 1) << 5); R = (st >> 1) * 16 + swz / 64; C = (st & 1) * 32 + (swz % 64) / 2; }
__host__ __device__ __forceinline__ int perm32(int rho) { const int n = rho >> 4, i = rho & 15; return 8 * (i >> 2) + 4 * n + (i & 3); }
struct Unit { int pm, pn; };
struct Gemm { const bf16_t* A; const bf16_t* Bt; int lda, ldb, K; };

struct StaticOrder {
  int nM, nN, nwg, G, c;
  __device__ void init(int M, int N, int G_, int c_) { nM = M / BM; nN = N / BM; nwg = nM * nN; G = G_; c = c_; }
  __device__ bool next(int i, Unit& u) const {
    const long L = (long)i * G + c; if (L >= nwg) return false;
    int wgid = (int)L; { const int q = nwg / NXCD, r = nwg % NXCD, xcd = wgid % NXCD, off = wgid / NXCD; wgid = (xcd < r ? xcd * (q + 1) : r * (q + 1) + (xcd - r) * q) + off; }
    const int nig = WGM * nN, gid = wgid / nig, fm = gid * WGM, gsz = (nM - fm) < WGM ? (nM - fm) : WGM;
    u.pm = fm + ((wgid % nig) % gsz); u.pn = (wgid % nig) / gsz; return true;
  }
  __device__ __forceinline__ void a_ready(const Unit&) const {}
  __device__ __forceinline__ void done(const Unit&) const {}
};

template <class Epi, class Sched, bool ALIGN_EPI = true, bool SP2 = true>
__device__ __forceinline__ void gemm_phase(LAS unsigned char* lds, const Gemm g, const Sched& S, const Epi& E) {
  int tid = threadIdx.x; asm volatile("" : "+v"(tid));
  const int wid = __builtin_amdgcn_readfirstlane(tid >> 6), lane = tid & 63, wr = wid >> 2, wc = wid & 3, fr = lane & 15, fq = lane >> 4;
  const int K = g.K, nt = K / BK;
  unsigned voffA[2], voffB[2];
#pragma unroll
  for (int i = 0; i < 2; ++i) { int R, C; stage_rc(tid * 16 + i * 8192, R, C); const int Rb = Epi::PERM ? ((R & ~31) + perm32(R & 31)) : R;
    voffA[i] = (unsigned)(R * g.lda + C) * 2u; voffB[i] = (unsigned)(Rb * g.ldb + C) * 2u; }
  const size_t kstep = (size_t)(BK * 2);
  const size_t hA = (size_t)HALF * g.lda * 2, hB = (size_t)HALF * g.ldb * 2;
  const size_t tA = 2 * hA, tB = 2 * hB;
  const unsigned ldsw = (unsigned)wid * 1024u;
  const int aoff = lds_byte(wr * 64 + fr, fq * 8), boff = lds_byte(wc * 32 + fr, fq * 8);
#define PG8_SA(b, h) (((b) * 2 + (h)) * HTB)
#define PG8_SB(b, h) ((4 + (b) * 2 + (h)) * HTB)
#define PG8_STAGE(bufoff, gbase, voff) do { _Pragma("unroll") for (int _i = 0; _i < 2; ++_i) \
    __builtin_amdgcn_global_load_lds((const unsigned*)((const char*)(gbase) + (voff)[_i]), (LAS unsigned*)(lds + (bufoff) + ldsw + _i * 8192), 16, 0, 0); } while (0)
#define PG8_LDA(dst, b, h) do { _Pragma("unroll") for (int m = 0; m < 4; ++m) _Pragma("unroll") for (int k = 0; k < 2; ++k) dst[m][k] = *(const LAS bf16x8*)(lds + PG8_SA(b, h) + aoff + m * 2048 + k * 1024); } while (0)
#define PG8_LDB(dst, b, h) do { _Pragma("unroll") for (int n = 0; n < 2; ++n) _Pragma("unroll") for (int k = 0; k < 2; ++k) dst[n][k] = *(const LAS bf16x8*)(lds + PG8_SB(b, h) + boff + n * 2048 + k * 1024); } while (0)
#define PG8_MMA(ai, bj, At, Bt) do { __builtin_amdgcn_s_setprio(1); _Pragma("unroll") for (int m = 0; m < 4; ++m) _Pragma("unroll") for (int n = 0; n < 2; ++n) _Pragma("unroll") for (int k = 0; k < 2; ++k) \
    acc[ai][bj][m][n] = __builtin_amdgcn_mfma_f32_16x16x32_bf16(Bt[n][k], At[m][k], acc[ai][bj][m][n], 0, 0, 0); __builtin_amdgcn_s_setprio(0); } while (0)
#define PG8_WAIT_V(n) asm volatile("s_waitcnt vmcnt(" #n ")" ::: "memory")
#define PG8_WAIT_L(n) asm volatile("s_waitcnt lgkmcnt(" #n ")" ::: "memory")
#define PG8_BAR __builtin_amdgcn_s_barrier()
#define PG8_SCHED __builtin_amdgcn_sched_barrier(0)
  Unit cur, nxt; int ui = 0;
  if (!S.next(0, cur)) return;
  f32x4 acc[2][2][4][2];
#pragma unroll
  for (int a = 0; a < 2; ++a)
#pragma unroll
    for (int b = 0; b < 2; ++b)
#pragma unroll
      for (int m = 0; m < 4; ++m)
#pragma unroll
        for (int n = 0; n < 2; ++n) acc[a][b][m][n] = (f32x4){0.f, 0.f, 0.f, 0.f};
  bf16x8 At[4][2], B0[2][2], B1[2][2];
  const char* cA = (const char*)g.A + (size_t)cur.pm * tA; const char* cB = (const char*)g.Bt + (size_t)cur.pn * tB;
  S.a_ready(cur);
  if constexpr (SP2) {
    PG8_STAGE(PG8_SB(0, 0), cB, voffB); PG8_STAGE(PG8_SB(0, 1), cB + hB, voffB); PG8_STAGE(PG8_SA(0, 0), cA, voffA); PG8_STAGE(PG8_SA(0, 1), cA + hA, voffA);
    if (wr == 1) PG8_BAR;
    PG8_WAIT_V(2); PG8_BAR;
    PG8_STAGE(PG8_SB(1, 0), cB + kstep, voffB); PG8_STAGE(PG8_SA(1, 0), cA + kstep, voffA); PG8_STAGE(PG8_SB(1, 1), cB + hB + kstep, voffB);
    PG8_WAIT_V(6); PG8_BAR;
  } else {
    PG8_STAGE(PG8_SB(0, 0), cB, voffB); PG8_STAGE(PG8_SA(0, 0), cA, voffA); PG8_STAGE(PG8_SB(0, 1), cB + hB, voffB); PG8_STAGE(PG8_SA(0, 1), cA + hA, voffA);
    if (wr == 1) PG8_BAR;
    PG8_WAIT_V(4); PG8_BAR;
    PG8_STAGE(PG8_SB(1, 0), cB + kstep, voffB); PG8_STAGE(PG8_SA(1, 0), cA + kstep, voffA); PG8_STAGE(PG8_SB(1, 1), cB + hB + kstep, voffB);
    PG8_WAIT_V(6); PG8_BAR;
  }
  for (;;) {
    const bool has_next = S.next(ui + 1, nxt);
    const char* nA = has_next ? (const char*)g.A + (size_t)nxt.pm * tA : cA; const char* nB = has_next ? (const char*)g.Bt + (size_t)nxt.pn * tB : cB;
#pragma unroll 1
    for (int t = 0; t < nt; t += 2) {
      const bool last = (t == nt - 2);
      const char* a1 = cA + (size_t)(t + 1) * kstep;
      const char* a2 = last ? nA : cA + (size_t)(t + 2) * kstep; const char* b2 = last ? nB : cB + (size_t)(t + 2) * kstep;
      const char* a3 = a2 + kstep; const char* b3 = b2 + kstep;
      if (last && has_next) S.a_ready(nxt);
      if constexpr (SP2) {
        PG8_LDB(B0, 0, 0); PG8_LDB(B1, 0, 1); PG8_SCHED; PG8_LDA(At, 0, 0); PG8_STAGE(PG8_SA(1, 1), a1 + hA, voffA);
        PG8_WAIT_V(8); PG8_WAIT_L(0); PG8_BAR; PG8_MMA(0, 0, At, B0); PG8_MMA(0, 1, At, B1); PG8_BAR; PG8_SCHED;
        PG8_LDA(At, 0, 1); PG8_STAGE(PG8_SB(0, 0), b2, voffB); PG8_STAGE(PG8_SB(0, 1), b2 + hB, voffB); PG8_STAGE(PG8_SA(0, 0), a2, voffA);
        PG8_WAIT_V(8); PG8_WAIT_L(0); PG8_BAR; PG8_MMA(1, 0, At, B0); PG8_MMA(1, 1, At, B1); PG8_BAR; PG8_SCHED;
        PG8_LDB(B0, 1, 0); PG8_LDB(B1, 1, 1); PG8_SCHED; PG8_LDA(At, 1, 0); PG8_STAGE(PG8_SA(0, 1), a2 + hA, voffA);
        PG8_WAIT_V(8); PG8_WAIT_L(0); PG8_BAR; PG8_MMA(0, 0, At, B0); PG8_MMA(0, 1, At, B1); PG8_BAR; PG8_SCHED;
        PG8_LDA(At, 1, 1); PG8_STAGE(PG8_SB(1, 0), b3, voffB); PG8_STAGE(PG8_SB(1, 1), b3 + hB, voffB); PG8_STAGE(PG8_SA(1, 0), a3, voffA);
        PG8_WAIT_V(8); PG8_WAIT_L(0); PG8_BAR; PG8_MMA(1, 0, At, B0); PG8_MMA(1, 1, At, B1); PG8_BAR; PG8_SCHED;
      } else {
        PG8_LDB(B0, 0, 0); PG8_SCHED; PG8_LDA(At, 0, 0); PG8_STAGE(PG8_SA(1, 1), a1 + hA, voffA);
        PG8_WAIT_L(8); PG8_BAR; PG8_WAIT_L(0); PG8_MMA(0, 0, At, B0); PG8_BAR; PG8_SCHED;
        PG8_LDB(B1, 0, 1); PG8_STAGE(PG8_SB(0, 0), b2, voffB);
        PG8_BAR; PG8_WAIT_L(0); PG8_MMA(0, 1, At, B1); PG8_BAR;
        PG8_LDA(At, 0, 1); PG8_STAGE(PG8_SA(0, 0), a2, voffA);
        PG8_BAR; PG8_WAIT_L(0); PG8_MMA(1, 0, At, B0); PG8_BAR; PG8_SCHED;
        PG8_STAGE(PG8_SB(0, 1), b2 + hB, voffB);
        PG8_WAIT_V(6); PG8_BAR; PG8_MMA(1, 1, At, B1); PG8_BAR;
        PG8_LDB(B0, 1, 0); PG8_SCHED; PG8_LDA(At, 1, 0); PG8_STAGE(PG8_SA(0, 1), a2 + hA, voffA);
        PG8_WAIT_L(8); PG8_BAR; PG8_WAIT_L(0); PG8_MMA(0, 0, At, B0); PG8_BAR; PG8_SCHED;
        PG8_LDB(B1, 1, 1); PG8_STAGE(PG8_SB(1, 0), b3, voffB);
        PG8_BAR; PG8_WAIT_L(0); PG8_MMA(0, 1, At, B1); PG8_BAR;
        PG8_LDA(At, 1, 1); PG8_STAGE(PG8_SA(1, 0), a3, voffA);
        PG8_BAR; PG8_WAIT_L(0); PG8_MMA(1, 0, At, B0); PG8_BAR; PG8_SCHED;
        PG8_STAGE(PG8_SB(1, 1), b3 + hB, voffB);
        PG8_WAIT_V(6); PG8_BAR; PG8_MMA(1, 1, At, B1); PG8_BAR;
      }
    }
    if constexpr (ALIGN_EPI) { if (wr == 0) PG8_BAR; }
    E(acc, cur, wr, wc, fr, fq); S.done(cur);
    if (!has_next) break;
#pragma unroll
    for (int a = 0; a < 2; ++a)
#pragma unroll
      for (int b = 0; b < 2; ++b)
#pragma unroll
        for (int m = 0; m < 4; ++m)
#pragma unroll
          for (int n = 0; n < 2; ++n) acc[a][b][m][n] = (f32x4){0.f, 0.f, 0.f, 0.f};
    cur = nxt; cA = nA; cB = nB; ++ui;
    if constexpr (ALIGN_EPI) { if (wr == 1) PG8_BAR; }
  }
  PG8_WAIT_V(0);
  if constexpr (!ALIGN_EPI) { if (wr == 0) PG8_BAR; }
  PG8_BAR;
#undef PG8_SA
#undef PG8_SB
#undef PG8_STAGE
#undef PG8_LDA
#undef PG8_LDB
#undef PG8_MMA
#undef PG8_WAIT_V
#undef PG8_WAIT_L
#undef PG8_BAR
#undef PG8_SCHED
}
}

struct EpiProj {
  static constexpr bool PERM = false;
  bf16_t* O; int ldc; int rope_end; const float* ropeT;
  __device__ __forceinline__ void operator()(const f32x4 (&acc)[2][2][4][2], const pg8::Unit& u, int wr, int wc, int fr, int fq) const {
    const int row0 = u.pm * 256 + wr * 64 + fr, colb = u.pn * 256 + wc * 32;
    const bool rope_cols = colb < rope_end;
#pragma unroll
    for (int ai = 0; ai < 2; ++ai)
#pragma unroll
      for (int m = 0; m < 4; ++m) {
        const int r = row0 + ai * 128 + m * 16;
        bf16_t* rowp = O + (size_t)r * ldc + colb + 4 * fq;
        f32x4 cs0 = {1.f, 0.f, 1.f, 0.f}, cs1 = {1.f, 0.f, 1.f, 0.f};
        const bool rp = rope_cols && (r < TL);
        if (rp) { const int i = r % N; const int pos = (wc & 1) ? (i % GRID_W) : (i / GRID_W);
          const f32x4* tp = (const f32x4*)(ropeT + (size_t)(pos * 16 + 4 * fq) * 2); cs0 = tp[0]; cs1 = tp[1]; }
#pragma unroll
        for (int bj = 0; bj < 2; ++bj) {
          const bool rpb = rp && (colb + bj * 128 < rope_end);
          f32x4 a1 = acc[ai][bj][m][0], a2 = acc[ai][bj][m][1];
          f32x4 o1 = a1, o2 = a2;
          if (rpb) {
            o1[0] = a1[0] * cs0[0] - a2[0] * cs0[1]; o2[0] = a2[0] * cs0[0] + a1[0] * cs0[1];
            o1[1] = a1[1] * cs0[2] - a2[1] * cs0[3]; o2[1] = a2[1] * cs0[2] + a1[1] * cs0[3];
            o1[2] = a1[2] * cs1[0] - a2[2] * cs1[1]; o2[2] = a2[2] * cs1[0] + a1[2] * cs1[1];
            o1[3] = a1[3] * cs1[2] - a2[3] * cs1[3]; o2[3] = a2[3] * cs1[2] + a1[3] * cs1[3];
          }
          u32x2 w1 = {cvt_pk_bf16(o1[0], o1[1]), cvt_pk_bf16(o1[2], o1[3])}, w2 = {cvt_pk_bf16(o2[0], o2[1]), cvt_pk_bf16(o2[2], o2[3])};
          *(u32x2*)(rowp + bj * 128) = w1; *(u32x2*)(rowp + bj * 128 + 16) = w2;
        }
      }
  }
};


struct EpiF32Out {
  static constexpr bool PERM = false;
  float* C; int ldc;
  __device__ __forceinline__ void operator()(const f32x4 (&acc)[2][2][4][2], const pg8::Unit& u, int wr, int wc, int fr, int fq) const {
    const int row0 = u.pm * 256 + wr * 64 + fr, col0 = u.pn * 256 + wc * 32 + 4 * fq;
#pragma unroll
    for (int ai = 0; ai < 2; ++ai)
#pragma unroll
      for (int m = 0; m < 4; ++m) { float* rowp = C + (size_t)(row0 + ai * 128 + m * 16) * ldc + col0;
#pragma unroll
        for (int bj = 0; bj < 2; ++bj)
#pragma unroll
          for (int n = 0; n < 2; ++n) *(f32x4*)(rowp + bj * 128 + n * 16) = acc[ai][bj][m][n]; }
  }
};
struct EpiBf16Out {
  static constexpr bool PERM = true;
  bf16_t* O; int ldc; int NJ;
  __device__ __forceinline__ void operator()(const f32x4 (&acc)[2][2][4][2], const pg8::Unit& u, int wr, int wc, int fr, int fq) const {
    const int row0 = u.pm * 256 + wr * 64 + fr, col0 = (NJ ? (u.pn % NJ) : u.pn) * 256 + wc * 32 + 8 * fq;
#pragma unroll
    for (int ai = 0; ai < 2; ++ai)
#pragma unroll
      for (int m = 0; m < 4; ++m) { bf16_t* rowp = O + (size_t)(row0 + ai * 128 + m * 16) * ldc + col0;
#pragma unroll
        for (int bj = 0; bj < 2; ++bj) { const f32x4 v0 = acc[ai][bj][m][0], v1 = acc[ai][bj][m][1];
          u32x4 w; w.x = cvt_pk_bf16(v0[0], v0[1]); w.y = cvt_pk_bf16(v0[2], v0[3]); w.z = cvt_pk_bf16(v1[0], v1[1]); w.w = cvt_pk_bf16(v1[2], v1[3]);
          *(u32x4*)(rowp + bj * 128) = w; } }
  }
};
__device__ __forceinline__ float fast_sigmoid(float x) { return __builtin_amdgcn_rcpf(1.f + __builtin_amdgcn_exp2f(-1.4426950408889634f * x)); }
struct EpiGlu {
  static constexpr bool PERM = true;
  const bf16_t* Gs; const float* bias; bf16_t* O; int ldo, coloff;
  __device__ __forceinline__ void operator()(const f32x4 (&acc)[2][2][4][2], const pg8::Unit& u, int wr, int wc, int fr, int fq) const {
    const int row0 = u.pm * 256 + wr * 64 + fr, col0 = u.pn * 256 + wc * 32 + 8 * fq;
#pragma unroll
    for (int ai = 0; ai < 2; ++ai)
#pragma unroll
      for (int m = 0; m < 4; ++m) { const int r = row0 + ai * 128 + m * 16;
#pragma unroll
        for (int bj = 0; bj < 2; ++bj) { const int c = col0 + bj * 128;
          const u32x4 gv = *(const u32x4*)(Gs + (size_t)r * SSM_W + c);
          const f32x4 b0 = *(const f32x4*)(bias + c), b1 = *(const f32x4*)(bias + c + 4);
          const f32x4 v0 = acc[ai][bj][m][0] + b0, v1 = acc[ai][bj][m][1] + b1;
          float o[8];
#pragma unroll
          for (int j = 0; j < 4; ++j) { const unsigned gw_ = j < 2 ? (j == 0 ? gv.x : gv.y) : (j == 2 ? gv.z : gv.w);
            const float g0 = __builtin_bit_cast(float, gw_ << 16), g1 = __builtin_bit_cast(float, gw_ & 0xffff0000u);
            const float z0 = j < 2 ? v0[2 * j] : v1[2 * j - 4], z1 = j < 2 ? v0[2 * j + 1] : v1[2 * j - 3];
            o[2 * j] = g0 * fast_sigmoid(z0); o[2 * j + 1] = g1 * fast_sigmoid(z1); }
          u32x4 w; w.x = cvt_pk_bf16(o[0], o[1]); w.y = cvt_pk_bf16(o[2], o[3]); w.z = cvt_pk_bf16(o[4], o[5]); w.w = cvt_pk_bf16(o[6], o[7]);
          *(u32x4*)(O + (size_t)r * ldo + coloff + c) = w; } }
  }
};
struct EpiMoe1 {
  static constexpr bool PERM = true;
  bf16_t* HH; const float* gate;
  __device__ __forceinline__ void operator()(const f32x4 (&acc)[2][2][4][2], const pg8::Unit& u, int wr, int wc, int fr, int fq) const {
    const int row0 = u.pm * 256 + wr * 64 + fr, col0 = (u.pn & 1) * 128 + wc * 32 + 8 * fq;
#pragma unroll
    for (int ai = 0; ai < 2; ++ai)
#pragma unroll
      for (int m = 0; m < 4; ++m) { const int r = row0 + ai * 128 + m * 16; const float gt = gate[r];
        float o[8];
#pragma unroll
        for (int n = 0; n < 2; ++n)
#pragma unroll
          for (int j = 0; j < 4; ++j) { const float h1 = acc[ai][0][m][n][j], h3 = acc[ai][1][m][n][j]; o[4 * n + j] = h1 * fast_sigmoid(h1) * h3 * gt; }
        u32x4 w; w.x = cvt_pk_bf16(o[0], o[1]); w.y = cvt_pk_bf16(o[2], o[3]); w.z = cvt_pk_bf16(o[4], o[5]); w.w = cvt_pk_bf16(o[6], o[7]);
        *(u32x4*)(HH + (size_t)r * MOE_F + col0) = w; }
  }
};
struct MoeOrder {
  const int* meta; int NJ, G, c;
  __device__ __forceinline__ bool next(int i, pg8::Unit& u) const {
    const int nt = __builtin_amdgcn_readfirstlane(__hip_atomic_load(meta, __ATOMIC_RELAXED, __HIP_MEMORY_SCOPE_AGENT));
    const long L = (long)i * G + c; if (L >= (long)nt * NJ) return false;
    const int rt = (int)(L / NJ), jn = (int)(L % NJ);
    const int e = __builtin_amdgcn_readfirstlane(__hip_atomic_load(meta + 1 + rt, __ATOMIC_RELAXED, __HIP_MEMORY_SCOPE_AGENT));
    u.pm = rt; u.pn = e * NJ + jn; return true;
  }
  __device__ __forceinline__ void a_ready(const pg8::Unit&) const {}
  __device__ __forceinline__ void done(const pg8::Unit&) const {}
};


namespace att {
using f32x16 = __attribute__((ext_vector_type(16))) float;
using s16x4  = __attribute__((ext_vector_type(4))) short;
constexpr int KVBLK = 64;
constexpr float SCALE = 0.125f, THR = 8.f;
constexpr size_t SHM_V = KVBLK * 128 * 2, SHM_K = KVBLK * 128 * 2;
constexpr size_t SHM_WS = 2 * SHM_V + 2 * SHM_K;
#define KSWZ(row, colB) ((row) * 256 + ((colB) ^ (((row) & 7) << 4)))
#define SBAR() __builtin_amdgcn_sched_barrier(0)
__device__ __forceinline__ int crow(int r, int hi) { return (r & 3) + 8 * (r >> 2) + 4 * hi; }
__device__ __forceinline__ unsigned cvtpk(float lo, float hi) { unsigned r; asm volatile("v_cvt_pk_bf16_f32 %0, %1, %2" : "=v"(r) : "v"(lo), "v"(hi)); return r; }
__device__ __forceinline__ void partialSM(f32x16& p0, f32x16& p1, float& m_reg, float& mn, float& alpha) {
  constexpr float C = SCALE * 1.4426950408889634f;
  float pmax = p0[0];
#pragma unroll
  for (int r = 1; r < 16; ++r) pmax = fmaxf(pmax, p0[r]);
#pragma unroll
  for (int r = 0; r < 16; ++r) pmax = fmaxf(pmax, p1[r]);
  { auto rr = __builtin_amdgcn_permlane32_swap(__float_as_uint(pmax), __float_as_uint(pmax), false, false);
    pmax = fmaxf(__uint_as_float(rr[0]), __uint_as_float(rr[1])); }
  if (__builtin_expect(__all(pmax - m_reg <= THR / SCALE), 1)) { mn = m_reg; alpha = 1.f; }
  else { mn = fmaxf(m_reg, pmax); alpha = __builtin_amdgcn_exp2f((m_reg - mn) * C); m_reg = mn; }
  const float mnC = -mn * C;
#pragma unroll
  for (int r = 0; r < 16; ++r) p0[r] = fmaf(p0[r], C, mnC);
#pragma unroll
  for (int r = 0; r < 16; ++r) p1[r] = fmaf(p1[r], C, mnC);
#pragma unroll
  for (int r = 0; r < 16; ++r) p0[r] = __builtin_amdgcn_exp2f(p0[r]);
}
__device__ __forceinline__ void finishSM(f32x16& p0, f32x16& p1, float alpha, float& l_reg, bf16x8& pa0, bf16x8& pa1, bf16x8& pa2, bf16x8& pa3) {
#pragma unroll
  for (int r = 0; r < 16; ++r) p1[r] = __builtin_amdgcn_exp2f(p1[r]);
  float ps = 0;
#pragma unroll
  for (int r = 0; r < 16; ++r) ps += p0[r];
#pragma unroll
  for (int r = 0; r < 16; ++r) ps += p1[r];
  { auto rr = __builtin_amdgcn_permlane32_swap(__float_as_uint(ps), __float_as_uint(ps), false, false);
    ps = __uint_as_float(rr[0]) + __uint_as_float(rr[1]); }
  l_reg = l_reg * alpha + ps;
#define PK4(P, BASE, OUT) do { unsigned a0 = cvtpk(P[BASE + 0], P[BASE + 1]), a1 = cvtpk(P[BASE + 2], P[BASE + 3]);   \
    unsigned b0 = cvtpk(P[BASE + 4], P[BASE + 5]), b1 = cvtpk(P[BASE + 6], P[BASE + 7]);                              \
    auto r0 = __builtin_amdgcn_permlane32_swap(a0, b0, false, false); auto r1 = __builtin_amdgcn_permlane32_swap(a1, b1, false, false); \
    u32x4 w = {r0[0], r1[0], r0[1], r1[1]}; OUT = *reinterpret_cast<bf16x8*>(&w); } while (0)
  PK4(p0, 0, pa0); PK4(p0, 8, pa1); PK4(p1, 0, pa2); PK4(p1, 8, pa3);
#undef PK4
}
__device__ __forceinline__ void qkt(f32x16& p0, f32x16& p1, const char* Ks, const bf16x8* qr, int r32, int hi, int c) {
  p0 = f32x16{}; p1 = f32x16{};
#pragma unroll
  for (int d0 = 0; d0 < 4; ++d0) { const int cb = (c * 64 + d0 * 16 + hi * 8) * 2;
    const bf16x8 b0 = *reinterpret_cast<const bf16x8*>(Ks + KSWZ(r32, cb));
    const bf16x8 b1 = *reinterpret_cast<const bf16x8*>(Ks + KSWZ(32 + r32, cb));
    p0 = __builtin_amdgcn_mfma_f32_32x32x16_bf16(b0, qr[d0], p0, 0, 0, 0);
    p1 = __builtin_amdgcn_mfma_f32_32x32x16_bf16(b1, qr[d0], p1, 0, 0, 0); }
}
__device__ __forceinline__ int v_st(int k, int c) { const int kk = (k & ~0xC) | ((k & 4) << 1) | ((k & 8) >> 1); return ((kk >> 3) * 4 + (c >> 5)) * 512 + ((kk & 7) * 32 + (c & 31)) * 2; }
__device__ __forceinline__ int v_rd_base(int lane) { return ((lane & 3) << 3) | (((lane >> 2) & 3) << 6) | (((lane >> 4) & 1) << 5) | (((lane >> 5) & 1) << 8); }
constexpr int v_rd_off(int d0, int ks, int half) { return d0 * 512 + ks * 4096 + half * 2048; }
template <int OFF> __device__ __forceinline__ s16x4 tr_read(int vb) {
  s16x4 r; asm volatile("ds_read_b64_tr_b16 %0, %1 offset:%2" : "=&v"(r) : "v"(vb), "i"(OFF) : "memory"); return r;
}
template <int D0> __device__ __forceinline__ void pv_one(f32x16& od, int vb, bf16x8 pa0, bf16x8 pa1, bf16x8 pa2, bf16x8 pa3) {
  const s16x4 l0 = tr_read<v_rd_off(D0, 0, 0)>(vb), h0 = tr_read<v_rd_off(D0, 0, 1)>(vb), l1 = tr_read<v_rd_off(D0, 1, 0)>(vb), h1 = tr_read<v_rd_off(D0, 1, 1)>(vb);
  const s16x4 l2 = tr_read<v_rd_off(D0, 2, 0)>(vb), h2 = tr_read<v_rd_off(D0, 2, 1)>(vb), l3 = tr_read<v_rd_off(D0, 3, 0)>(vb), h3 = tr_read<v_rd_off(D0, 3, 1)>(vb);
  asm volatile("s_waitcnt lgkmcnt(0)" ::: "memory"); SBAR();
#define PK(L, H) (bf16x8){L[0], L[1], L[2], L[3], H[0], H[1], H[2], H[3]}
  od = __builtin_amdgcn_mfma_f32_32x32x16_bf16(pa0, PK(l0, h0), od, 0, 0, 0);
  od = __builtin_amdgcn_mfma_f32_32x32x16_bf16(pa1, PK(l1, h1), od, 0, 0, 0);
  od = __builtin_amdgcn_mfma_f32_32x32x16_bf16(pa2, PK(l2, h2), od, 0, 0, 0);
  od = __builtin_amdgcn_mfma_f32_32x32x16_bf16(pa3, PK(l3, h3), od, 0, 0, 0);
#undef PK
}
template <int NB> __device__ __forceinline__ void pv_blocks(f32x16* o, int vb, int vsel, bf16x8 pa0, bf16x8 pa1, bf16x8 pa2, bf16x8 pa3) {
  if constexpr (NB == 4) { pv_one<0>(o[0], vb, pa0, pa1, pa2, pa3); pv_one<1>(o[1], vb, pa0, pa1, pa2, pa3); pv_one<2>(o[2], vb, pa0, pa1, pa2, pa3); pv_one<3>(o[3], vb, pa0, pa1, pa2, pa3); }
  else { if (vsel == 0) { pv_one<0>(o[0], vb, pa0, pa1, pa2, pa3); pv_one<1>(o[1], vb, pa0, pa1, pa2, pa3); }
         else { pv_one<2>(o[0], vb, pa0, pa1, pa2, pa3); pv_one<3>(o[1], vb, pa0, pa1, pa2, pa3); } }
}
__device__ __forceinline__ void apply_mask(f32x16& p0, f32x16& p1, int mt, int i, int k0, int hi) {
  if (mt == 0) return;
#pragma unroll
  for (int r = 0; r < 16; ++r) { const int j0 = k0 + crow(r, hi), j1 = j0 + 32;
    const bool ok0 = (mt == 1) && (j0 - i <= SWA_WIN) && (i - j0 <= SWA_WIN), ok1 = (mt == 1) && (j1 - i <= SWA_WIN) && (i - j1 <= SWA_WIN);
    p0[r] = ok0 ? p0[r] : -1e30f; p1[r] = ok1 ? p1[r] : -1e30f; }
}

struct TileMap {
  int nl, tlo, bN, bC;
  __device__ __forceinline__ int row(int t) const { return t < nl ? bN + 64 * (tlo + t) : (t < nl + CTX / 64 ? bC + 64 * (t - nl) : bN + 64 * tlo); }
  __device__ __forceinline__ int mtype(int t) const { return t < nl ? 1 : (t < nl + CTX / 64 ? 0 : 2); }
  __device__ __forceinline__ int key0(int t) const { return 64 * (tlo + (t < nl ? t : 0)); }
};

template <int MODE>
__device__ __forceinline__ void attn_unit(const bf16_t* __restrict__ Pq, const bf16_t* __restrict__ Pk, const bf16_t* __restrict__ Pv, int LD, const TileMap tm, int NT,
                                          float m_init, float l_init, int i0, LAS unsigned char* ldsb, f32x16* o, float& l_out, int tid) {
  constexpr int NB = MODE == 0 ? 4 : 2;
  const int wid = tid >> 6, lane = tid & 63, r32 = lane & 31, hi = lane >> 5, c = wid >> 2;
  char* lds = (char*)ldsb;
  char* V_lds = lds; char* K_lds = lds + 2 * SHM_V;
  float* ws = (float*)(lds + SHM_WS) + wid * 64; float* al_l = ws + 32;
  float m_reg = m_init, l_reg = l_init; bf16x8 qr[4];
#pragma unroll
  for (int d = 0; d < NB; ++d) o[d] = f32x16{};
  const bf16_t* Qw = Pq + (size_t)r32 * LD + hi * 8;
#pragma unroll
  for (int d0 = 0; d0 < 4; ++d0) qr[d0] = *reinterpret_cast<const bf16x8*>(Qw + d0 * 16);
  const int sr = tid >> 4, sc = (tid & 15) * 8, vst0 = v_st(sr, sc), vst1 = v_st(32 + sr, sc);
  const int vb0 = (int)(uintptr_t)V_lds + v_rd_base(lane);
  struct { bf16x8 vs0, vs1, ks0, ks1; } sr_[2];
#define SLOAD(i, t) do { const size_t rb_ = (size_t)tm.row(t); \
    sr_[i].vs0 = *reinterpret_cast<const bf16x8*>(Pv + (rb_ + sr) * LD + sc); sr_[i].vs1 = *reinterpret_cast<const bf16x8*>(Pv + (rb_ + 32 + sr) * LD + sc); \
    sr_[i].ks0 = *reinterpret_cast<const bf16x8*>(Pk + (rb_ + sr) * LD + sc); sr_[i].ks1 = *reinterpret_cast<const bf16x8*>(Pk + (rb_ + 32 + sr) * LD + sc); } while (0)
#define SWRITE(b, i) do { *(bf16x8*)(V_lds + (b) * SHM_V + vst0) = sr_[i].vs0; *(bf16x8*)(V_lds + (b) * SHM_V + vst1) = sr_[i].vs1; const int kc = sc * 2; \
    *(bf16x8*)(K_lds + (b) * SHM_K + KSWZ(sr, kc)) = sr_[i].ks0; *(bf16x8*)(K_lds + (b) * SHM_K + KSWZ(32 + sr, kc)) = sr_[i].ks1; } while (0)
#define SWAIT() asm volatile("s_waitcnt vmcnt(4)" ::: "memory")
#define RESC(a) do { if (__any((a) < 1.f)) { if (hi == 0) al_l[r32] = (a); asm volatile("s_waitcnt lgkmcnt(0)" ::: "memory"); \
    _Pragma("unroll") for (int d = 0; d < NB; ++d) _Pragma("unroll") for (int r = 0; r < 16; ++r) o[d][r] *= al_l[crow(r, hi)]; } } while (0)
#define MASK(P0, P1, t) do { if constexpr (MODE == 1) apply_mask(P0, P1, tm.mtype(t), i0 + r32, tm.key0(t), hi); } while (0)
  f32x16 pA0, pA1, pB0, pB1; float mnA, mnB, alA, alB; bf16x8 pa0, pa1, pa2, pa3;
  constexpr int SE = 0, SO = 1;
  SLOAD(SE, 0); asm volatile("s_waitcnt vmcnt(0)" ::: "memory"); SWRITE(0, SE); __syncthreads();
  qkt(pA0, pA1, K_lds, qr, r32, hi, c); MASK(pA0, pA1, 0); partialSM(pA0, pA1, m_reg, mnA, alA);
  SLOAD(SO, 1); if (2 < NT) SLOAD(SE, 2);
  SWAIT(); SWRITE(1, SO); __syncthreads();
  for (int j = 1; j + 1 < NT; j += 2) {
    SBAR(); qkt(pB0, pB1, K_lds + SHM_K, qr, r32, hi, c);
    finishSM(pA0, pA1, alA, l_reg, pa0, pa1, pa2, pa3); SBAR();
    SLOAD(SO, j + 2); SBAR();
    pv_blocks<NB>(o, vb0, c, pa0, pa1, pa2, pa3); MASK(pB0, pB1, j); partialSM(pB0, pB1, m_reg, mnB, alB);
    __syncthreads(); SWAIT(); SWRITE(0, SE);
    RESC(alB); __syncthreads();
    SBAR(); qkt(pA0, pA1, K_lds, qr, r32, hi, c);
    finishSM(pB0, pB1, alB, l_reg, pa0, pa1, pa2, pa3); SBAR();
    if (j + 3 < NT) SLOAD(SE, j + 3);
    SBAR();
    pv_blocks<NB>(o, vb0 + (int)SHM_V, c, pa0, pa1, pa2, pa3); MASK(pA0, pA1, j + 1); partialSM(pA0, pA1, m_reg, mnA, alA);
    __syncthreads(); SWAIT(); SWRITE(1, SO);
    RESC(alA); __syncthreads();
  }
  SBAR(); qkt(pB0, pB1, K_lds + SHM_K, qr, r32, hi, c);
  finishSM(pA0, pA1, alA, l_reg, pa0, pa1, pa2, pa3); SBAR();
  pv_blocks<NB>(o, vb0, c, pa0, pa1, pa2, pa3); MASK(pB0, pB1, NT - 1); partialSM(pB0, pB1, m_reg, mnB, alB);
  __syncthreads(); RESC(alB);
  finishSM(pB0, pB1, alB, l_reg, pa0, pa1, pa2, pa3); SBAR();
  pv_blocks<NB>(o, vb0 + (int)SHM_V, c, pa0, pa1, pa2, pa3);
  l_out = l_reg;
  asm volatile("s_waitcnt vmcnt(0)" ::: "memory");
  __syncthreads();
#undef SLOAD
#undef SWRITE
#undef SWAIT
#undef RESC
#undef MASK
}

__device__ __forceinline__ void dif_phase(const Params& p, LAS unsigned char* ldsb, int G, int vcu, int tid) {
  const int wid = tid >> 6, lane = tid & 63, r32 = lane & 31, hi = lane >> 5, c = wid >> 2, rg = wid & 3;
  constexpr int NQB = N / 128, NU = B * DIF_H * NQB;
  const float lam = p.scal[0], oscale = p.scal[1];
  for (int L = vcu; L < NU; L += G) {
    const int qb = L % NQB, h = (L / NQB) % DIF_H, b = L / (NQB * DIF_H);
    const int t0 = b * N + qb * 128 + rg * 32;
    TileMap tm; tm.nl = N / 64; tm.tlo = 0; tm.bN = b * N; tm.bC = TL + b * CTX;
    f32x16 o[4]; float l_reg;
    attn_unit<0>(p.P + (size_t)t0 * DIF_IN + h * 128 + c * 64, p.P + DIF_QK + h * 128, p.P + 2 * DIF_QK + h * 128, DIF_IN, tm, (N + CTX) / 64,
                 -1e30f, 0.f, 0, ldsb, o, l_reg, tid);
    char* lds = (char*)ldsb;
    float* ws = (float*)(lds + SHM_WS) + wid * 64;
    float* xb = (float*)lds;
    if (hi == 0) ws[r32] = l_reg;
    asm volatile("s_waitcnt lgkmcnt(0)" ::: "memory");
    float rli[16];
#pragma unroll
    for (int r = 0; r < 16; ++r) rli[r] = __builtin_amdgcn_rcpf(ws[crow(r, hi)]);
    if (c == 1) {
#pragma unroll
      for (int d0 = 0; d0 < 4; ++d0)
#pragma unroll
        for (int r = 0; r < 16; ++r) xb[(rg * 32 + crow(r, hi)) * 128 + d0 * 32 + r32] = o[d0][r] * rli[r];
    }
    __syncthreads();
    if (c == 0) {
      float ss[16];
#pragma unroll
      for (int r = 0; r < 16; ++r) ss[r] = 0.f;
#pragma unroll
      for (int d0 = 0; d0 < 4; ++d0)
#pragma unroll
        for (int r = 0; r < 16; ++r) { const float v = o[d0][r] * rli[r] - lam * xb[(rg * 32 + crow(r, hi)) * 128 + d0 * 32 + r32]; o[d0][r] = v; ss[r] += v * v; }
#pragma unroll
      for (int r = 0; r < 16; ++r) {
#pragma unroll
        for (int sft = 1; sft < 32; sft <<= 1) ss[r] += __shfl_xor(ss[r], sft);
        ss[r] = oscale / sqrtf(ss[r] * (1.f / 128.f) + RMS_EPS); }
#pragma unroll
      for (int d0 = 0; d0 < 4; ++d0) { const float gsub = p.subln_g[d0 * 32 + r32];
#pragma unroll
        for (int r = 0; r < 16; ++r) p.Ymix[(size_t)(t0 + crow(r, hi)) * YW + h * 128 + d0 * 32 + r32] = f2bf(o[d0][r] * ss[r] * gsub); }
    }
    __syncthreads();
  }
}
__device__ __forceinline__ void swa_phase(const Params& p, LAS unsigned char* ldsb, int G, int vcu, int tid) {
  const int wid = tid >> 6, lane = tid & 63, r32 = lane & 31, hi = lane >> 5;
  constexpr int NUL = TL / 32, NUC = TC / 32;
  const float sink_raw = p.sink[wid] * (1.0f / SCALE);
  for (int L = vcu; L < NUL + NUC; L += G) {
    TileMap tm; int t0, NT, i0;
    if (L < NUL) { const int b = L / (N / 32), qb = L % (N / 32); i0 = qb * 32; t0 = b * N + i0;
      const int lo = i0 - SWA_WIN < 0 ? 0 : i0 - SWA_WIN, hi_ = i0 + 31 + SWA_WIN > N - 1 ? N - 1 : i0 + 31 + SWA_WIN;
      tm.tlo = lo / 64; tm.nl = hi_ / 64 - tm.tlo + 1; tm.bN = b * N; tm.bC = TL + b * CTX; NT = (tm.nl + CTX / 64 + 1) & ~1;
    } else { const int Lc = L - NUL, b = Lc / (CTX / 32), qb = Lc % (CTX / 32); i0 = 0; t0 = TL + b * CTX + qb * 32;
      tm.tlo = 0; tm.nl = 0; tm.bN = b * N; tm.bC = TL + b * CTX; NT = CTX / 64; }
    f32x16 o[2]; float l_reg;
    attn_unit<1>(p.P + (size_t)t0 * AB_IN + wid * 64, p.P + A_KOFF, p.P + A_VOFF, AB_IN, tm, NT, sink_raw, 1.f, i0, ldsb, o, l_reg, tid);
    char* lds = (char*)ldsb;
    float* ws = (float*)(lds + SHM_WS) + wid * 64;
    if (hi == 0) ws[r32] = l_reg;
    asm volatile("s_waitcnt lgkmcnt(0)" ::: "memory");
#pragma unroll
    for (int r = 0; r < 16; ++r) { const float rl = __builtin_amdgcn_rcpf(ws[crow(r, hi)]);
#pragma unroll
      for (int d0 = 0; d0 < 2; ++d0) p.Ymix[(size_t)(t0 + crow(r, hi)) * YW + wid * 64 + d0 * 32 + r32] = f2bf(o[d0][r] * rl); }
    __syncthreads();
  }
}
}

#define XB_TMO      128
#define XB_XCNT(j)  (256  + 64 * (j))
#define XB_XSUB(j)  (1280 + 64 * (j))
#define XB_XGEN(j)  (2304 + 64 * (j))
#define XB_TOP      3328
#define XB_TOPGEN   3392
#define XCD_BAR_WORDS 3456
#define XB_SPIN_CAP (1u << 22)
constexpr int CW_BAR = 4096;
__device__ __forceinline__ unsigned xb_ld(unsigned* p)              { return __hip_atomic_load(p, __ATOMIC_RELAXED, __HIP_MEMORY_SCOPE_AGENT); }
__device__ __forceinline__ unsigned xb_add(unsigned* p, unsigned v) { return __hip_atomic_fetch_add(p, v, __ATOMIC_RELAXED, __HIP_MEMORY_SCOPE_AGENT); }
__device__ __forceinline__ unsigned xb_xcc_id() { return (unsigned)__builtin_amdgcn_s_getreg((3 << 11) | 20) & 0xFu; }
#define XB_SPIN(cond, bar) do { unsigned _sp = 0; while (cond) { __builtin_amdgcn_s_sleep(1); \
    if ((++_sp & 255u) == 0u) { if (xb_ld(&(bar)[XB_TMO])) break; if (_sp > XB_SPIN_CAP) { atomicAdd(&(bar)[XB_TMO], 1u); break; } } } } while (0)
struct XcdBarrier { unsigned* bar; unsigned x; volatile LAS unsigned* st; };
__device__ __forceinline__ XcdBarrier xcd_barrier_post(unsigned* bar, volatile LAS unsigned* st) {
  XcdBarrier b; b.bar = bar; b.x = xb_xcc_id(); b.st = st;
  if (threadIdx.x == 0) (void)xb_add(&bar[XB_XCNT(b.x)], 1u);
  return b;
}
__device__ __forceinline__ void xcd_barrier_complete(unsigned* bar, unsigned x, unsigned& nloc, unsigned& nx) {
  const unsigned G = gridDim.x * gridDim.y * gridDim.z;
  unsigned sum, cnt, mine, sp = 0u;
  for (;;) {
    sum = 0u; cnt = 0u; mine = 0u;
#pragma unroll
    for (unsigned j = 0; j < 16; ++j) { const unsigned c = xb_ld(&bar[XB_XCNT(j)]); sum += c; cnt += (c > 0u) ? 1u : 0u; mine = (j == x) ? c : mine; }
    if (sum == G) break;
    __builtin_amdgcn_s_sleep(1);
    if ((++sp & 255u) == 0u) { if (xb_ld(&bar[XB_TMO])) break; if (sp > XB_SPIN_CAP) { atomicAdd(&bar[XB_TMO], 1u); break; } }
  }
  nloc = mine > 0u ? mine : 1u; nx = cnt > 0u ? cnt : 1u;
}
__device__ __forceinline__ void xcd_barrier(const XcdBarrier& b) {
  asm volatile("s_waitcnt vmcnt(0)" ::: "memory");
  __syncthreads();
  if (threadIdx.x == 0) {
    unsigned* bar = b.bar;
    __builtin_amdgcn_s_waitcnt(0);
    unsigned nloc = b.st[0], nx = b.st[1];
    if (nloc == 0u) { xcd_barrier_complete(bar, b.x, nloc, nx); b.st[0] = nloc; b.st[1] = nx; }
    const unsigned old = xb_add(&bar[XB_XSUB(b.x)], 1u);
    const unsigned gen = old / nloc;
    if (old + 1u == (gen + 1u) * nloc) {
      __builtin_amdgcn_fence(__ATOMIC_RELEASE, "agent");
      asm volatile("s_waitcnt vmcnt(0)" ::: "memory");
      const unsigned og = xb_add(&bar[XB_TOP], 1u);
      const unsigned tg = og / nx;
      if (og + 1u == (tg + 1u) * nx) xb_add(&bar[XB_TOPGEN], 1u);
      else XB_SPIN(xb_ld(&bar[XB_TOPGEN]) == tg, bar);
      __builtin_amdgcn_fence(__ATOMIC_ACQUIRE, "agent");
      xb_add(&bar[XB_XGEN(b.x)], 1u);
      asm volatile("s_waitcnt vmcnt(0)" ::: "memory");
    } else {
      XB_SPIN(xb_ld(&bar[XB_XGEN(b.x)]) == gen, bar);
      __builtin_amdgcn_fence(__ATOMIC_ACQUIRE, "agent");
      asm volatile("s_waitcnt vmcnt(0)" ::: "memory");
    }
  }
  __syncthreads();
}

__device__ __forceinline__ unsigned pk2(float lo, float hi) { return (unsigned)f2bf(lo) | ((unsigned)f2bf(hi) << 16); }
__device__ __forceinline__ void transpose_item(const float* W, int K, int N, bf16_t* WT, int k0, int n0, int dst_row0, LAS float* scr, int lane) {
#pragma unroll 8
  for (int i = 0; i < 32; ++i) { const int kk = 2 * i + (lane >> 5); scr[kk * 33 + (lane & 31)] = W[(size_t)(k0 + kk) * N + n0 + (lane & 31)]; }
  LDS_WAIT(); asm volatile("" ::: "memory");
  const int c = lane & 7;
#pragma unroll
  for (int j = 0; j < 4; ++j) { const int n = (lane >> 3) + 8 * j; const LAS float* s = scr + (8 * c) * 33 + n;
    u32x4 o; o.x = pk2(s[0 * 33], s[1 * 33]); o.y = pk2(s[2 * 33], s[3 * 33]); o.z = pk2(s[4 * 33], s[5 * 33]); o.w = pk2(s[6 * 33], s[7 * 33]);
    *(u32x4*)(WT + (size_t)(dst_row0 + n) * K + k0 + 8 * c) = o; }
  LDS_WAIT(); asm volatile("" ::: "memory");
}
__device__ __forceinline__ void transpose_matrix(const float* W, int K, int N, bf16_t* WT, LAS float* scr, int gw, int ngw, int lane) {
  const int nblk = N / 32, items = (K / 64) * nblk;
  for (int it = gw; it < items; it += ngw) { const int kb = it / nblk, nb = it % nblk; transpose_item(W, K, N, WT, 64 * kb, 32 * nb, 32 * nb, scr, lane); }
}
__device__ __forceinline__ void mod_row_to_bf16(const float* xr, const float* sc, const float* sh, bf16_t* orow, int lane) {
  const f32x4* x4 = (const f32x4*)xr + lane; const f32x4* c4 = (const f32x4*)sc + lane; const f32x4* h4 = (const f32x4*)sh + lane;
  unsigned long long* o8 = (unsigned long long*)orow + lane;
#pragma unroll
  for (int j = 0; j < 4; ++j) { const f32x4 v = x4[64 * j], c = c4[64 * j], h = h4[64 * j];
    const float a = v.x * (1.f + c.x) + h.x, b = v.y * (1.f + c.y) + h.y, cc = v.z * (1.f + c.z) + h.z, d = v.w * (1.f + c.w) + h.w;
    o8[64 * j] = (unsigned long long)pk2(a, b) | ((unsigned long long)pk2(cc, d) << 32); }
}


__device__ __forceinline__ float wave_sum(float v) {
#pragma unroll
  for (int o = 1; o < 64; o <<= 1) v += __shfl_xor(v, o);
  return v;
}
constexpr int CW_CNT = 2048;
__device__ __forceinline__ void ln1_route_row(const Params& p, int layer, int t, int lane) {
  const int r = tok_r(t);
  const f32x4* x4 = (const f32x4*)xrow(p, layer, t) + lane; const f32x4* y4 = (const f32x4*)(p.F + (size_t)t * D) + lane;
  const f32x4* g4 = (const f32x4*)modp(p, layer, r, 2) + lane;
  f32x4 v[4]; float s = 0.f;
#pragma unroll
  for (int j = 0; j < 4; ++j) { v[j] = x4[64 * j] * ALPHA + g4[64 * j] * y4[64 * j]; s += (v[j].x + v[j].y) + (v[j].z + v[j].w); }
  const float mean = wave_sum(s) * (1.f / D); float s2 = 0.f;
#pragma unroll
  for (int j = 0; j < 4; ++j) { v[j] = v[j] - mean; s2 += (v[j].x * v[j].x + v[j].y * v[j].y) + (v[j].z * v[j].z + v[j].w * v[j].w); }
  const float rstd = 1.f / sqrtf(wave_sum(s2) * (1.f / D) + LN_EPS);
  const f32x4* lg4 = (const f32x4*)(p.ln1_g + (size_t)layer * D) + lane; const f32x4* lb4 = (const f32x4*)(p.ln1_b + (size_t)layer * D) + lane;
  const f32x4* sc4 = (const f32x4*)modp(p, layer, r, 4) + lane; const f32x4* sh4 = (const f32x4*)modp(p, layer, r, 3) + lane;
  f32x4* o4 = (f32x4*)(p.X1 + (size_t)t * D) + lane;
#pragma unroll
  for (int j = 0; j < 4; ++j) { v[j] = v[j] * rstd * lg4[64 * j] + lb4[64 * j]; o4[64 * j] = v[j]; v[j] = v[j] * (sc4[64 * j] + 1.f) + sh4[64 * j]; }
  const f32x4* wg4 = (const f32x4*)(p.moe_wg + (size_t)layer * D * MOE_G);
  f32x4 gl = {0.f, 0.f, 0.f, 0.f};
#pragma unroll
  for (int j = 0; j < 4; ++j)
#pragma unroll
    for (int c = 0; c < 4; ++c) gl += wg4[4 * (lane + 64 * j) + c] * v[j][c];
  asm volatile("" ::: "memory");
  float lgv[4];
#pragma unroll
  for (int g = 0; g < 4; ++g) lgv[g] = wave_sum(gl[g]) + p.moe_bg[layer * MOE_G + g];
  int gi = 0; float mx = lgv[0];
#pragma unroll
  for (int g = 1; g < 4; ++g) if (lgv[g] > mx) { mx = lgv[g]; gi = g; }
  float den = 0.f;
#pragma unroll
  for (int g = 0; g < 4; ++g) den += expf(lgv[g] - mx);
  const float gp = 1.0f / den;
  gi = __builtin_amdgcn_readfirstlane(gi);
  const f32x4* we4 = (const f32x4*)(p.moe_we + ((size_t)layer * MOE_G + gi) * D * MOE_EPG);
  f32x4 e0 = {0.f, 0.f, 0.f, 0.f}, e1 = {0.f, 0.f, 0.f, 0.f};
#pragma unroll
  for (int j = 0; j < 4; ++j) {
#pragma unroll
    for (int c = 0; c < 4; ++c) { const int k = 4 * (lane + 64 * j) + c; e0 += we4[2 * k] * v[j][c]; e1 += we4[2 * k + 1] * v[j][c]; }
    asm volatile("" ::: "memory"); }
  float le[8];
#pragma unroll
  for (int e = 0; e < 4; ++e) { le[e] = wave_sum(e0[e]) + p.moe_be[(layer * MOE_G + gi) * MOE_EPG + e]; le[4 + e] = wave_sum(e1[e]) + p.moe_be[(layer * MOE_G + gi) * MOE_EPG + 4 + e]; }
  int i0 = 0; float v0 = le[0];
#pragma unroll
  for (int e = 1; e < 8; ++e) if (le[e] > v0) { v0 = le[e]; i0 = e; }
  int i1 = -1; float v1 = -3e38f;
#pragma unroll
  for (int e = 0; e < 8; ++e) if (e != i0 && le[e] > v1) { v1 = le[e]; i1 = e; }
  if (lane == 0) {
    const float ex = expf(v1 - v0);
    const int ea = gi * MOE_EPG + i0, eb = gi * MOE_EPG + i1;
    const unsigned pa = atomicAdd(p.ctl + CW_CNT + 64 * layer + ea, 1u), pb = atomicAdd(p.ctl + CW_CNT + 64 * layer + eb, 1u);
    float* rt = p.route + (size_t)t * 8;
    rt[0] = (float)ea; rt[1] = (float)eb; rt[2] = gp / (1.0f + ex); rt[3] = gp * ex / (1.0f + ex); rt[4] = (float)pa; rt[5] = (float)pb;
  }
}
__device__ __forceinline__ void scatter_phase(const Params& p, int layer, int T, LAS unsigned char* lds, int gw, int ngw, int lane, int tid) {
  LAS int* off = (LAS int*)lds;
  if (tid == 0) {
    int o = 0, ntile = 0;
    for (int e = 0; e < MOE_E; ++e) { const int c = (int)__hip_atomic_load(p.ctl + CW_CNT + 64 * layer + e, __ATOMIC_RELAXED, __HIP_MEMORY_SCOPE_AGENT);
      off[e] = o; const int nt = (c + 255) >> 8;
      if (blockIdx.x == 0) for (int i = 0; i < nt; ++i) p.moe_meta[1 + ntile + i] = e;
      ntile += nt; o += nt * 256; }
    if (blockIdx.x == 0) p.moe_meta[0] = ntile;
  }
  __syncthreads();
  for (int t = gw; t < T; t += ngw) {
    const int r = tok_r(t);
    const float* rt = p.route + (size_t)t * 8;
    const int ea = (int)rt[0], eb = (int)rt[1]; const float wa = rt[2], wb = rt[3];
    const int sa = off[ea] + (int)rt[4], sb = off[eb] + (int)rt[5];
    const f32x4* x4 = (const f32x4*)(p.X1 + (size_t)t * D) + lane;
    const f32x4* sc4 = (const f32x4*)modp(p, layer, r, 4) + lane; const f32x4* sh4 = (const f32x4*)modp(p, layer, r, 3) + lane;
    unsigned long long* oa = (unsigned long long*)(p.Amoe + (size_t)sa * D) + lane; unsigned long long* ob = (unsigned long long*)(p.Amoe + (size_t)sb * D) + lane;
#pragma unroll
    for (int j = 0; j < 4; ++j) { const f32x4 h = x4[64 * j] * (sc4[64 * j] + 1.f) + sh4[64 * j];
      const unsigned long long w = (unsigned long long)pk2(h.x, h.y) | ((unsigned long long)pk2(h.z, h.w) << 32); oa[64 * j] = w; ob[64 * j] = w; }
    if (lane == 0) { p.gate[sa] = wa; p.gate[sb] = wb; p.tokslot[2 * t] = sa; p.tokslot[2 * t + 1] = sb; }
  }
}
__device__ __forceinline__ void ln2_row(const Params& p, int layer, int t, int lane) {
  const int r = tok_r(t);
  const int sa = p.tokslot[2 * t], sb = p.tokslot[2 * t + 1];
  const f32x4* x4 = (const f32x4*)(p.X1 + (size_t)t * D) + lane; const f32x4* g4 = (const f32x4*)modp(p, layer, r, 5) + lane;
  const u32x2* fa = (const u32x2*)(p.F2 + (size_t)sa * D) + lane; const u32x2* fb = (const u32x2*)(p.F2 + (size_t)sb * D) + lane;
  f32x4 v[4]; float s = 0.f;
#pragma unroll
  for (int j = 0; j < 4; ++j) { const u32x2 a = fa[64 * j], b = fb[64 * j];
    f32x4 f; f.x = __builtin_bit_cast(float, a.x << 16) + __builtin_bit_cast(float, b.x << 16); f.y = __builtin_bit_cast(float, a.x & 0xffff0000u) + __builtin_bit_cast(float, b.x & 0xffff0000u);
    f.z = __builtin_bit_cast(float, a.y << 16) + __builtin_bit_cast(float, b.y << 16); f.w = __builtin_bit_cast(float, a.y & 0xffff0000u) + __builtin_bit_cast(float, b.y & 0xffff0000u);
    v[j] = x4[64 * j] * ALPHA + g4[64 * j] * f; s += (v[j].x + v[j].y) + (v[j].z + v[j].w); }
  const float mean = wave_sum(s) * (1.f / D); float s2 = 0.f;
#pragma unroll
  for (int j = 0; j < 4; ++j) { v[j] = v[j] - mean; s2 += (v[j].x * v[j].x + v[j].y * v[j].y) + (v[j].z * v[j].z + v[j].w * v[j].w); }
  const float rstd = 1.f / sqrtf(wave_sum(s2) * (1.f / D) + LN_EPS);
  const f32x4* lg4 = (const f32x4*)(p.ln2_g + (size_t)layer * D) + lane; const f32x4* lb4 = (const f32x4*)(p.ln2_b + (size_t)layer * D) + lane;
  if (layer == DEPTH - 1) {
    f32x4* o4 = (f32x4*)(p.out + (size_t)t * D) + lane;
#pragma unroll
    for (int j = 0; j < 4; ++j) o4[64 * j] = v[j] * rstd * lg4[64 * j] + lb4[64 * j];
  } else {
    f32x4* o4 = (f32x4*)(p.X + (size_t)t * D) + lane;
    const f32x4* sc4 = (const f32x4*)modp(p, layer + 1, r, 1) + lane; const f32x4* sh4 = (const f32x4*)modp(p, layer + 1, r, 0) + lane;
    unsigned long long* h8 = (unsigned long long*)(p.H + (size_t)t * D) + lane;
#pragma unroll
    for (int j = 0; j < 4; ++j) { const f32x4 o = v[j] * rstd * lg4[64 * j] + lb4[64 * j]; o4[64 * j] = o;
      const f32x4 h = o * (sc4[64 * j] + 1.f) + sh4[64 * j];
      h8[64 * j] = (unsigned long long)pk2(h.x, h.y) | ((unsigned long long)pk2(h.z, h.w) << 32); }
  }
}
__device__ __forceinline__ void moe_weight_transposes(const Params& p, int layer, LAS float* scr, int gw, int ngw, int lane) {
  constexpr int I13 = (D / 64) * (MOE_F / 32), I2 = (MOE_F / 64) * (D / 32);
  constexpr int NIT = MOE_E * (2 * I13 + I2);
  for (int it = gw; it < NIT; it += ngw) {
    const int e = it / (2 * I13 + I2); int r = it % (2 * I13 + I2);
    if (r < 2 * I13) { const int which = r / I13; r %= I13; const int kb = r / (MOE_F / 32), nb = r % (MOE_F / 32), n0 = 32 * nb;
      const float* W = (which ? p.moe_w3 : p.moe_w1) + ((size_t)layer * MOE_E + e) * D * MOE_F;
      transpose_item(W, D, MOE_F, p.W13t, 64 * kb, n0, e * 2 * MOE_F + (n0 / 128) * 256 + which * 128 + (n0 % 128), scr, lane);
    } else { r -= 2 * I13; const int kb = r / (D / 32), nb = r % (D / 32);
      const float* W = p.moe_w2 + ((size_t)layer * MOE_E + e) * MOE_F * D;
      transpose_item(W, MOE_F, D, p.W2t, 64 * kb, 32 * nb, e * D + 32 * nb, scr, lane); }
  }
}

__global__ void __launch_bounds__(NTHR, 2) mega_kernel(Params p_by_value) {
  const Params& p = *(const Params*)__builtin_amdgcn_kernarg_segment_ptr();
  extern __shared__ __attribute__((aligned(16))) unsigned char lds_raw[];
  LAS unsigned char* lds = (LAS unsigned char*)lds_raw;
  volatile LAS unsigned* MISC = (volatile LAS unsigned*)(lds + MISC_OFF);
  for (int u = threadIdx.x; u < (LDS_BYTES - LDSCTL_OFF) / 4; u += NTHR) ((LAS unsigned*)(lds + LDSCTL_OFF))[u] = 0u;
  __syncthreads();
  XcdBarrier bar = xcd_barrier_post(p.ctl + CW_BAR, MISC + 8);
#define PH_VARS                                                                                                       \
  int tid = threadIdx.x; asm volatile("" : "+v"(tid));                                                                \
  int bx = blockIdx.x; asm volatile("" : "+s"(bx));                                                                   \
  const int lane = tid & 63, wave = __builtin_amdgcn_readfirstlane(tid >> 6), G = gridDim.x;                          \
  const int vcu = (G % 8 == 0) ? (bx % 8) * (G / 8) + bx / 8 : bx;                                                    \
  const int gw = vcu * NWAVES + wave, ngw = G * NWAVES;                                                               \
  LAS float* scr = (LAS float*)(lds + wave * 16384);                                                                  \
  (void)lane; (void)gw; (void)ngw; (void)scr; (void)vcu;
#define GRID_BAR() xcd_barrier(bar)
#define RUN_NAIVE(S, layer, cnt)                                                                                  \
  {                                                                                                               \
    const int n_ = (cnt);                                                                                         \
    PH_VARS                                                                                                       \
    for (int idx = bx * NTHR + tid; idx < n_; idx += G * NTHR) run_elem<S>(p, layer, idx);                        \
  }

  RUN_NAIVE(S_MOD, 0, N_MOD)
  RUN_NAIVE(S_TABA, 0, N_TABA)
  { PH_VARS
  transpose_matrix(p.w_in_a, D, AB_IN, p.WinA_t, scr, gw, ngw, lane);
  transpose_matrix(p.dif_w_in, D, DIF_IN, p.DifIn_t, scr, gw, ngw, lane);
  transpose_matrix(p.w_out_a, AB_OUT, D, p.WoutA_t, scr, gw, ngw, lane);
  transpose_matrix(p.dif_w_out, DIF_VW, D, p.DifOut_t, scr, gw, ngw, lane);
  transpose_matrix(p.glu_w, SSM_W, SSM_W, p.Glu_t, scr, gw, ngw, lane);
  moe_weight_transposes(p, 0, scr, gw, ngw, lane); }
  GRID_BAR();
  RUN_NAIVE(S_TABB, 0, N_KT)
  { PH_VARS for (int m = gw; m < TA; m += ngw) { const int r = tok_r(m); mod_row_to_bf16(xrow(p, 0, m), modp(p, 0, r, 1), modp(p, 0, r, 0), p.H + (size_t)m * D, lane); } }
  GRID_BAR();
#define PROJ_GEMM(NW_, WT_, ROPE_END_)                                                                                  \
  { PH_VARS                                                                                                             \
    pg8::Gemm g{p.H, WT_, D, D, D};                                                                                     \
    pg8::StaticOrder S; S.init(TA, NW_, G, bx);                                                            \
    EpiProj E{p.P, NW_, ROPE_END_, p.ropeT};                                                                            \
    pg8::gemm_phase<EpiProj, pg8::StaticOrder>(lds, g, S, E);                                                           \
  }                                                                                                                     \
  GRID_BAR();
#define LAYER_BACK(layer, T, WOT_, KO_)                                                                                 \
  { PH_VARS                                                                            \
    pg8::Gemm g{p.Ymix, WOT_, YW, KO_, KO_};                                                                            \
    pg8::StaticOrder S; S.init(T, D, G, bx);                                                               \
    EpiF32Out E{p.F, D};                                                                                                \
    pg8::gemm_phase<EpiF32Out, pg8::StaticOrder>(lds, g, S, E);                                                         \
  }                                                                                                                     \
  GRID_BAR();                                                                                                           \
  { PH_VARS for (int t = gw; t < T; t += ngw) ln1_route_row(p, layer, t, lane); }                                      \
  GRID_BAR();                                                                                                           \
  { PH_VARS scatter_phase(p, layer, T, lds, gw, ngw, lane, tid); }                                                      \
  GRID_BAR();                                                                                                           \
  { PH_VARS                                                             \
    pg8::Gemm g{p.Amoe, p.W13t, D, D, D};                                                                               \
    MoeOrder S{p.moe_meta, 2, G, vcu};                                                                                  \
    EpiMoe1 E{p.HHb, p.gate};                                                                                           \
    pg8::gemm_phase<EpiMoe1, MoeOrder>(lds, g, S, E);                                                                   \
  }                                                                                                                     \
  GRID_BAR();                                                                                                           \
  { PH_VARS                                                                                  \
    pg8::Gemm g{p.HHb, p.W2t, MOE_F, MOE_F, MOE_F};                                                                     \
    MoeOrder S{p.moe_meta, 4, G, vcu};                                                                                  \
    EpiBf16Out E{p.F2, D, 4};                                                                                           \
    pg8::gemm_phase<EpiBf16Out, MoeOrder>(lds, g, S, E);                                                                \
  }                                                                                                                     \
  GRID_BAR();                                                                                                           \
  { PH_VARS for (int t = gw; t < T; t += ngw) ln2_row(p, layer, t, lane); }

  PROJ_GEMM(AB_IN, p.WinA_t, (SWA_QW + SWA_KVW))
  { PH_VARS att::swa_phase(p, lds, G, vcu, tid); }
  RUN_NAIVE(S_SSME, 0, N_SSME)
  GRID_BAR();
  RUN_NAIVE(S_SSMC, 0, N_SSMC)
  GRID_BAR();
  RUN_NAIVE(S_SSMO, 0, TA * SSM_W)
  GRID_BAR();
  { PH_VARS
    pg8::Gemm g{p.Gs, p.Glu_t, SSM_W, SSM_W, SSM_W};
    pg8::StaticOrder S; S.init(TA, SSM_W, G, bx);
    EpiGlu E{p.Gs, p.glu_b, p.Ymix, YW, SWA_QW};
    pg8::gemm_phase<EpiGlu, pg8::StaticOrder>(lds, g, S, E);
  }
  GRID_BAR();
  LAYER_BACK(0, TA, p.WoutA_t, AB_OUT)
  { PH_VARS moe_weight_transposes(p, 1, scr, gw, ngw, lane); }
  GRID_BAR();
  PROJ_GEMM(DIF_IN, p.DifIn_t, (2 * DIF_QK))
  { PH_VARS att::dif_phase(p, lds, G, vcu, tid); }
  GRID_BAR();
  LAYER_BACK(1, TL, p.DifOut_t, DIF_VW)
}

extern "C" void kernel_launch(void* const* d_in, const int* in_sizes, int n_in, void* d_out, int out_size, void* d_ws,
                              size_t ws_size, hipStream_t stream) {
  static int grid = 0;
  if (grid == 0) {
    if (ws_layout().total > ws_size || n_in != 37 || out_size != TL * D) { fprintf(stderr, "kernel_launch: bad sizes (ws need %zu have %zu)\n", ws_layout().total, ws_size); grid = -1; return; }
    int dev = 0, cus = 0;
    if (hipGetDevice(&dev) != hipSuccess || hipDeviceGetAttribute(&cus, hipDeviceAttributeMultiprocessorCount, dev) != hipSuccess) { grid = -1; return; }
    if (hipFuncSetAttribute((const void*)mega_kernel, hipFuncAttributeMaxDynamicSharedMemorySize, LDS_BYTES) != hipSuccess) { fprintf(stderr, "kernel_launch: hipFuncSetAttribute failed\n"); grid = -1; return; }
    grid = cus;
  }
  if (grid < 0) return;
  Params p{};
  fill_inputs(p, d_in);
  p.out = (float*)d_out;
  fill_ws(p, (char*)d_ws);
  if (hipMemsetAsync((char*)d_ws + ws_layout().ctl, 0, CTL_BYTES, stream) != hipSuccess) { fprintf(stderr, "kernel_launch: memset failed\n"); return; }
  hipLaunchKernelGGL(mega_kernel, dim3(grid), dim3(NTHR), LDS_BYTES, stream, p);
  const hipError_t le = hipPeekAtLastError();
  if (le != hipSuccess) fprintf(stderr, "kernel_launch: launch failed: %s\n", hipGetErrorName(le));
}
#endif
```

```cpp
#ifndef HOST_EMU
#include <hip/hip_runtime.h>
#define HD __host__ __device__ __forceinline__
#else
#define HD inline
#endif
#include <stdint.h>
#include <math.h>

#ifndef CFG_D
#define CFG_D 1024
#define CFG_B 8
#define CFG_N 2048
#define CFG_CTX 256
#endif

constexpr int D = CFG_D, B = CFG_B, N = CFG_N, CTX = CFG_CTX;
constexpr int DEPTH = 2, GRID_W = 64, HD_ = 64;
constexpr int TL = B * N, TC = B * CTX, TA = TL + TC;
constexpr int SWA_H = 8, SWA_QW = 512, SWA_KVW = 128, SWA_WIN = 128;
constexpr int SSM_W = D / 2, SSM_C = 16, SSM_G = SSM_W / 16, SSM_P = 64;
constexpr int AB_IN = SWA_QW + 2 * SWA_KVW + SSM_W;
constexpr int AB_OUT = SWA_QW + SSM_W;
constexpr int A_KOFF = SWA_QW, A_VOFF = SWA_QW + SWA_KVW, A_UOFF = SWA_QW + 2 * SWA_KVW;
constexpr int DIF_H = D / 128, DIF_QK = DIF_H * 128, DIF_VW = DIF_H * 128, DIF_IN = 2 * DIF_QK + DIF_VW;
constexpr int MOE_G = 4, MOE_EPG = 8, MOE_E = 32, MOE_F = D / 4;
constexpr int SL = 64;
constexpr int SS = CTX + N;
constexpr int NCH = SS / SL;
constexpr float LN_EPS = 1e-5f, RMS_EPS = 1e-5f;
constexpr float ALPHA = 1.41421356237309515f;
static_assert(CTX % SL == 0 && N % SL == 0, "chunking");
constexpr int YW = AB_OUT > D ? AB_OUT : D;

struct Params {
  const float *x, *c, *ctx, *c_ctx, *mod_w, *mod_b, *ln1_g, *ln1_b, *ln2_g, *ln2_b;
  const float *w_in_a, *w_out_a, *sink, *a_re, *a_im, *log_step, *b_re, *b_im, *c_re, *c_im, *ssm_d, *glu_w, *glu_b;
  const float *dif_w_in, *dif_w_out, *lq1, *lk1, *lq2, *lk2, *subln_g;
  const float *moe_wg, *moe_bg, *moe_we, *moe_be, *moe_w1, *moe_w3, *moe_w2;
  float* out;
  float *X, *X1, *F, *HH;
  uint16_t *P, *Ymix, *Gs;
  float *modv, *ropeT, *apow, *bbar, *KT, *E, *Sin, *route, *scal;
  uint16_t *H;
  uint16_t *WinA_t, *DifIn_t, *WoutA_t, *DifOut_t, *Glu_t, *W13t, *W2t;
  uint16_t *Amoe, *HHb, *F2;
  float* gate;
  int *tokslot, *moe_meta;
  uint16_t *A2, *BtY, *BtE;
  float *apow16, *KT16, *E16, *Ypart;
  unsigned* ctl;
};

HD uint16_t f2bf(float f) {
  uint32_t u = __builtin_bit_cast(uint32_t, f);
  u += 0x7fffu + ((u >> 16) & 1u);
  return (uint16_t)(u >> 16);
}
HD float bf2f(uint16_t h) {
  uint32_t u = ((uint32_t)h) << 16;
  return __builtin_bit_cast(float, u);
}
HD float siluf(float x) { return x / (1.0f + expf(-x)); }
HD float sigmoidf_(float x) { return 1.0f / (1.0f + expf(-x)); }
HD float geluf_(float x) { return 0.5f * x * (1.0f + tanhf(0.7978845608028654f * (x + 0.044715f * x * x * x))); }

HD int tok_r(int t) { return t < TL ? t / N : B; }
HD const float* xrow(const Params& p, int layer, int t) {
  if (layer == 0) return t < TL ? p.x + (size_t)t * D : p.ctx + (size_t)(t - TL) * D;
  return p.X + (size_t)t * D;
}
HD const float* modp(const Params& p, int layer, int r, int which) {
  return p.modv + ((size_t)(layer * (B + 1) + r) * 6 + which) * D;
}

constexpr int N_MOD = DEPTH * (B + 1) * 6 * D;
HD void st_mod(const Params& p, int layer_unused, int idx) {
  int j = idx % (6 * D); int r = (idx / (6 * D)) % (B + 1); int l = idx / (6 * D * (B + 1));
  const float* cv = r < B ? p.c + (size_t)r * D : p.c_ctx;
  const float* w = p.mod_w + (size_t)l * D * 6 * D;
  float acc = p.mod_b[(size_t)l * 6 * D + j];
  for (int k = 0; k < D; ++k) acc += siluf(cv[k]) * w[(size_t)k * 6 * D + j];
  p.modv[idx] = acc;
}

constexpr int N_ROPE = 64 * 16;
constexpr int N_APOW = 2 * SSM_G * SSM_P * (SL + 1);
constexpr int N_BBAR = 2 * SSM_G * SSM_P * SSM_C;
constexpr int N_TABA = N_ROPE + N_APOW + N_BBAR + 1;
HD void st_taba(const Params& p, int layer_unused, int idx) {
  if (idx < N_ROPE) {
    int pos = idx / 16, f = idx % 16;
    float inv = powf(10000.0f, -(float)f / 16.0f);
    float ang = (float)pos * inv;
    p.ropeT[idx * 2] = cosf(ang); p.ropeT[idx * 2 + 1] = sinf(ang);
    return;
  }
  idx -= N_ROPE;
  if (idx < N_APOW) {
    int k = idx % (SL + 1); int q = idx / (SL + 1);
    int dg = q / SSM_P;
    double dt = exp((double)p.log_step[dg]);
    double ar = p.a_re[q], ai = p.a_im[q];
    double mag = exp(k * dt * ar);
    p.apow[(size_t)idx * 2] = (float)(mag * cos(k * dt * ai));
    p.apow[(size_t)idx * 2 + 1] = (float)(mag * sin(k * dt * ai));
    return;
  }
  idx -= N_APOW;
  if (idx < N_BBAR) {
    int cc = idx % SSM_C; int q = idx / SSM_C; int dg = q / SSM_P;
    (void)cc;
    double dt = exp((double)p.log_step[dg]);
    double ar = p.a_re[q], ai = p.a_im[q];
    double mag = exp(dt * ar);
    double abr = mag * cos(dt * ai), abi = mag * sin(dt * ai);
    double den = ar * ar + ai * ai, nr = abr - 1.0;
    double cr = (nr * ar + abi * ai) / den, ci = (abi * ar - nr * ai) / den;
    double br = p.b_re[idx], bi = p.b_im[idx];
    p.bbar[(size_t)idx * 2] = (float)(cr * br - ci * bi);
    p.bbar[(size_t)idx * 2 + 1] = (float)(cr * bi + ci * br);
    return;
  }
  double s1 = 0, s2 = 0;
  for (int i = 0; i < HD_; ++i) { s1 += (double)p.lq1[i] * p.lk1[i]; s2 += (double)p.lq2[i] * p.lk2[i]; }
  double lam_init = 0.8 - 0.6 * exp(-0.3 * 1.0);
  p.scal[0] = (float)(exp(s1) - exp(s2) + lam_init);
  p.scal[1] = (float)(1.0 - lam_init);
}

constexpr int N_KT = 2 * SSM_G * SL * SSM_C * SSM_C;
HD void st_tabb(const Params& p, int layer_unused, int idx) {
  int ci = idx % SSM_C; int co = (idx / SSM_C) % SSM_C; int k = (idx / (SSM_C * SSM_C)) % SL; int dg = idx / (SSM_C * SSM_C * SL);
  float acc = 0.f;
  for (int pp = 0; pp < SSM_P; ++pp) {
    int q = dg * SSM_P + pp;
    float ar = p.apow[((size_t)q * (SL + 1) + k) * 2], ai = p.apow[((size_t)q * (SL + 1) + k) * 2 + 1];
    float br = p.bbar[((size_t)q * SSM_C + ci) * 2], bi = p.bbar[((size_t)q * SSM_C + ci) * 2 + 1];
    float cr = p.c_re[((size_t)dg * SSM_C + co) * SSM_P + pp], cim = p.c_im[((size_t)dg * SSM_C + co) * SSM_P + pp];
    float tr = ar * br - ai * bi, ti = ar * bi + ai * br;
    acc += cr * tr - cim * ti;
  }
  p.KT[idx] = acc;
}

HD void st_proj(const Params& p, int layer, int idx) {
  const int W = layer == 0 ? AB_IN : DIF_IN;
  const float* w = layer == 0 ? p.w_in_a : p.dif_w_in;
  const int rope_end = layer == 0 ? (SWA_QW + SWA_KVW) : (2 * DIF_QK);
  int t = idx / W, n = idx % W;
  int r = tok_r(t);
  if (layer == 1 && t >= TL && n < DIF_QK) return;
  const float* xr = xrow(p, layer, t);
  const float* sh = modp(p, layer, r, 0);
  const float* sc = modp(p, layer, r, 1);
  bool rope = (t < TL) && (n < rope_end);
  if (!rope) {
    float acc = 0.f;
    for (int k = 0; k < D; ++k) { float h = xr[k] * (1.0f + sc[k]) + sh[k]; acc += h * w[(size_t)k * W + n]; }
    p.P[(size_t)t * W + n] = f2bf(acc);
    return;
  }
  int d = n % 64, sub = d % 32;
  if (sub >= 16) return;
  float a1 = 0.f, a2 = 0.f;
  for (int k = 0; k < D; ++k) {
    float h = xr[k] * (1.0f + sc[k]) + sh[k];
    a1 += h * w[(size_t)k * W + n]; a2 += h * w[(size_t)k * W + n + 16];
  }
  int i = t % N;
  int pos = d < 32 ? i / GRID_W : i % GRID_W;
  float cs = p.ropeT[(pos * 16 + sub) * 2], sn = p.ropeT[(pos * 16 + sub) * 2 + 1];
  p.P[(size_t)t * W + n] = f2bf(a1 * cs - a2 * sn);
  p.P[(size_t)t * W + n + 16] = f2bf(a2 * cs + a1 * sn);
}

HD void st_swa(const Params& p, int layer, int idx) {
  int hq = idx / TA, t = idx % TA;
  int kvh = hq / 4;
  const uint16_t* P = p.P;
  float q[64], o[64];
  _Pragma("unroll") for (int d = 0; d < 64; ++d) { q[d] = bf2f(P[(size_t)t * AB_IN + hq * 64 + d]) * 0.125f; o[d] = 0.f; }
  float m = p.sink[hq], l = 1.0f;
  int b = t < TL ? t / N : (t - TL) / CTX;
  int nloc = t < TL ? 2 * SWA_WIN + 1 : 0;
  int i = t < TL ? t % N : 0;
  for (int kk = 0; kk < nloc + CTX; ++kk) {
    int row;
    if (kk < nloc) {
      int j = i - SWA_WIN + kk;
      if (j < 0 || j >= N) continue;
      row = b * N + j;
    } else row = TL + b * CTX + (kk - nloc);
    const uint16_t* kr = P + (size_t)row * AB_IN + A_KOFF + kvh * 64;
    const uint16_t* vr = P + (size_t)row * AB_IN + A_VOFF + kvh * 64;
    float s = 0.f;
    _Pragma("unroll") for (int d = 0; d < 64; ++d) s += q[d] * bf2f(kr[d]);
    if (s > m) { float f = expf(m - s); l *= f; for (int d = 0; d < 64; ++d) o[d] *= f; m = s; }
    float pe = expf(s - m);
    l += pe;
    _Pragma("unroll") for (int d = 0; d < 64; ++d) o[d] += pe * bf2f(vr[d]);
  }
  float il = 1.0f / l;
  _Pragma("unroll") for (int d = 0; d < 64; ++d) p.Ymix[(size_t)t * YW + hq * 64 + d] = f2bf(o[d] * il);
}

HD int ssm_row(int dir, int b, int tau) {
  if (dir == 0) return tau < CTX ? TL + b * CTX + tau : b * N + (tau - CTX);
  return tau < CTX ? TL + b * CTX + (CTX - 1 - tau) : b * N + (N - 1 - (tau - CTX));
}
constexpr int N_SSME = 2 * B * NCH * SSM_G * SSM_P;
HD void st_ssm_e(const Params& p, int layer, int idx) {
  int pp = idx % SSM_P; int g = (idx / SSM_P) % SSM_G; int ch = (idx / (SSM_P * SSM_G)) % NCH;
  int b = (idx / (SSM_P * SSM_G * NCH)) % B; int dir = idx / (SSM_P * SSM_G * NCH * B);
  int q = (dir * SSM_G + g) * SSM_P + pp;
  float er = 0.f, ei = 0.f;
  for (int j = 0; j < SL; ++j) {
    int row = ssm_row(dir, b, ch * SL + j);
    const uint16_t* u = p.P + (size_t)row * AB_IN + A_UOFF + g * 16;
    float vr = 0.f, vi = 0.f;
    _Pragma("unroll") for (int cc = 0; cc < 16; ++cc) {
      float uv = bf2f(u[cc]);
      vr += p.bbar[((size_t)q * 16 + cc) * 2] * uv; vi += p.bbar[((size_t)q * 16 + cc) * 2 + 1] * uv;
    }
    float ar = p.apow[((size_t)q * (SL + 1) + (SL - 1 - j)) * 2], ai = p.apow[((size_t)q * (SL + 1) + (SL - 1 - j)) * 2 + 1];
    er += ar * vr - ai * vi; ei += ar * vi + ai * vr;
  }
  p.E[(size_t)idx * 2] = er; p.E[(size_t)idx * 2 + 1] = ei;
}
constexpr int N_SSMC = 2 * B * SSM_G * SSM_P;
HD void st_ssm_c(const Params& p, int layer, int idx) {
  int pp = idx % SSM_P; int g = (idx / SSM_P) % SSM_G; int b = (idx / (SSM_P * SSM_G)) % B; int dir = idx / (SSM_P * SSM_G * B);
  int q = (dir * SSM_G + g) * SSM_P + pp;
  float ar = p.apow[((size_t)q * (SL + 1) + SL) * 2], ai = p.apow[((size_t)q * (SL + 1) + SL) * 2 + 1];
  float sr = 0.f, si = 0.f;
  for (int ch = 0; ch < NCH; ++ch) {
    size_t e = ((((size_t)dir * B + b) * NCH + ch) * SSM_G + g) * SSM_P + pp;
    p.Sin[e * 2] = sr; p.Sin[e * 2 + 1] = si;
    float er = p.E[e * 2], ei = p.E[e * 2 + 1];
    float nr = ar * sr - ai * si + er, ni = ar * si + ai * sr + ei;
    sr = nr; si = ni;
  }
}
HD void st_ssm_o(const Params& p, int layer, int idx) {
  int t = idx / SSM_W, n = idx % SSM_W; int g = n / 16, co = n % 16;
  int b, dirtau[2];
  if (t < TL) { b = t / N; int i = t % N; dirtau[0] = CTX + i; dirtau[1] = CTX + (N - 1 - i); }
  else { b = (t - TL) / CTX; int i = (t - TL) % CTX; dirtau[0] = i; dirtau[1] = CTX - 1 - i; }
  float y = p.ssm_d[n] * bf2f(p.P[(size_t)t * AB_IN + A_UOFF + n]);
  for (int dir = 0; dir < 2; ++dir) {
    int tau = dirtau[dir]; int ch = tau / SL, j = tau % SL;
    int dg = dir * SSM_G + g;
    size_t e0 = ((((size_t)dir * B + b) * NCH + ch) * SSM_G + g) * SSM_P;
    for (int pp = 0; pp < SSM_P; ++pp) {
      int q = dg * SSM_P + pp;
      float ar = p.apow[((size_t)q * (SL + 1) + (j + 1)) * 2], ai = p.apow[((size_t)q * (SL + 1) + (j + 1)) * 2 + 1];
      float sr = p.Sin[(e0 + pp) * 2], si = p.Sin[(e0 + pp) * 2 + 1];
      float tr = ar * sr - ai * si, ti = ar * si + ai * sr;
      float cr = p.c_re[((size_t)dg * 16 + co) * SSM_P + pp], cim = p.c_im[((size_t)dg * 16 + co) * SSM_P + pp];
      y += cr * tr - cim * ti;
    }
    for (int j2 = 0; j2 <= j; ++j2) {
      int row = ssm_row(dir, b, ch * SL + j2);
      const uint16_t* u = p.P + (size_t)row * AB_IN + A_UOFF + g * 16;
      const float* kt = p.KT + (((size_t)dg * SL + (j - j2)) * 16 + co) * 16;
      _Pragma("unroll") for (int ci = 0; ci < 16; ++ci) y += kt[ci] * bf2f(u[ci]);
    }
  }
  p.Gs[(size_t)t * SSM_W + n] = f2bf(geluf_(y));
}
HD void st_glu(const Params& p, int layer, int idx) {
  int t = idx / SSM_W, n = idx % SSM_W;
  float z = p.glu_b[n];
  const uint16_t* g = p.Gs + (size_t)t * SSM_W;
  for (int k = 0; k < SSM_W; ++k) z += bf2f(g[k]) * p.glu_w[(size_t)k * SSM_W + n];
  p.Ymix[(size_t)t * YW + SWA_QW + n] = f2bf(bf2f(g[n]) * sigmoidf_(z));
}

HD void st_dif(const Params& p, int layer, int idx) {
  int t = idx % TL; int he = idx / TL; int eh = he % 2, h = he / 2;
  int b = t / N;
  const uint16_t* P = p.P;
  float res[64];
  float lam = p.scal[0];
  _Pragma("unroll") for (int c = 0; c < 2; ++c) {
    float q[64], o[64];
    _Pragma("unroll") for (int d = 0; d < 64; ++d) { q[d] = bf2f(P[(size_t)t * DIF_IN + h * 128 + c * 64 + d]) * 0.125f; o[d] = 0.f; }
    float m = -1e30f, l = 0.f;
    for (int kk = 0; kk < N + CTX; ++kk) {
      int row = kk < N ? b * N + kk : TL + b * CTX + (kk - N);
      const uint16_t* kr = P + (size_t)row * DIF_IN + DIF_QK + h * 128 + c * 64;
      const uint16_t* vr = P + (size_t)row * DIF_IN + 2 * DIF_QK + h * 128 + eh * 64;
      float s = 0.f;
      _Pragma("unroll") for (int d = 0; d < 64; ++d) s += q[d] * bf2f(kr[d]);
      if (s > m) { float f = expf(m - s); l *= f; for (int d = 0; d < 64; ++d) o[d] *= f; m = s; }
      float pe = expf(s - m);
      l += pe;
      _Pragma("unroll") for (int d = 0; d < 64; ++d) o[d] += pe * bf2f(vr[d]);
    }
    float il = 1.0f / l;
    if (c == 0) { for (int d = 0; d < 64; ++d) res[d] = o[d] * il; }
    else { for (int d = 0; d < 64; ++d) res[d] -= lam * o[d] * il; }
  }
  _Pragma("unroll") for (int d = 0; d < 64; ++d) p.Ymix[(size_t)t * YW + h * 128 + eh * 64 + d] = f2bf(res[d]);
}
HD void st_difnorm(const Params& p, int layer, int idx) {
  int t = idx / DIF_H, h = idx % DIF_H;
  uint16_t* o = p.Ymix + (size_t)t * YW + h * 128;
  float ss = 0.f;
  for (int e = 0; e < 128; ++e) { float v = bf2f(o[e]); ss += v * v; }
  float r = 1.0f / sqrtf(ss / 128.0f + RMS_EPS) * p.scal[1];
  _Pragma("unroll 8") for (int e = 0; e < 128; ++e) o[e] = f2bf(bf2f(o[e]) * r * p.subln_g[e]);
}

HD void st_outproj(const Params& p, int layer, int idx) {
  int t = idx / D, n = idx % D;
  const float* w = layer == 0 ? p.w_out_a : p.dif_w_out;
  const uint16_t* y = p.Ymix + (size_t)t * YW;
  const int KW = layer == 0 ? AB_OUT : DIF_VW;
  float acc = 0.f;
  for (int k = 0; k < KW; ++k) acc += bf2f(y[k]) * w[(size_t)k * D + n];
  p.F[(size_t)t * D + n] = acc;
}
HD void st_ln1(const Params& p, int layer, int t) {
  int r = tok_r(t);
  const float* xr = xrow(p, layer, t); const float* g1 = modp(p, layer, r, 2);
  const float* y = p.F + (size_t)t * D;
  float mu = 0.f;
  for (int k = 0; k < D; ++k) mu += ALPHA * xr[k] + g1[k] * y[k];
  mu /= D;
  float var = 0.f;
  for (int k = 0; k < D; ++k) { float v = ALPHA * xr[k] + g1[k] * y[k] - mu; var += v * v; }
  var /= D;
  float rs = 1.0f / sqrtf(var + LN_EPS);
  const float* lg = p.ln1_g + (size_t)layer * D; const float* lb = p.ln1_b + (size_t)layer * D;
  for (int k = 0; k < D; ++k) p.X1[(size_t)t * D + k] = (ALPHA * xr[k] + g1[k] * y[k] - mu) * rs * lg[k] + lb[k];
}
HD void st_route(const Params& p, int layer, int t) {
  int r = tok_r(t);
  const float* x1 = p.X1 + (size_t)t * D; const float* sh = modp(p, layer, r, 3); const float* sc = modp(p, layer, r, 4);
  float lg[MOE_G];
  _Pragma("unroll") for (int g = 0; g < MOE_G; ++g) lg[g] = p.moe_bg[layer * MOE_G + g];
  const float* wg = p.moe_wg + (size_t)layer * D * MOE_G;
  for (int k = 0; k < D; ++k) {
    float h = x1[k] * (1.0f + sc[k]) + sh[k];
    _Pragma("unroll") for (int g = 0; g < MOE_G; ++g) lg[g] += h * wg[k * MOE_G + g];
  }
  int gi = 0; float mx = lg[0];
  _Pragma("unroll") for (int g = 1; g < MOE_G; ++g) if (lg[g] > mx) { mx = lg[g]; gi = g; }
  float den = 0.f;
  _Pragma("unroll") for (int g = 0; g < MOE_G; ++g) den += expf(lg[g] - mx);
  float gp = 1.0f / den;
  float le[MOE_EPG];
  _Pragma("unroll") for (int e = 0; e < MOE_EPG; ++e) le[e] = p.moe_be[(layer * MOE_G + gi) * MOE_EPG + e];
  const float* we = p.moe_we + ((size_t)layer * MOE_G + gi) * D * MOE_EPG;
  for (int k = 0; k < D; ++k) {
    float h = x1[k] * (1.0f + sc[k]) + sh[k];
    _Pragma("unroll") for (int e = 0; e < MOE_EPG; ++e) le[e] += h * we[k * MOE_EPG + e];
  }
  int i0 = 0; float v0 = le[0];
  _Pragma("unroll") for (int e = 1; e < MOE_EPG; ++e) if (le[e] > v0) { v0 = le[e]; i0 = e; }
  int i1 = -1; float v1 = -3e38f;
  _Pragma("unroll") for (int e = 0; e < MOE_EPG; ++e) if (e != i0 && le[e] > v1) { v1 = le[e]; i1 = e; }
  float e1 = expf(v1 - v0);
  float w0 = gp / (1.0f + e1), w1 = gp * e1 / (1.0f + e1);
  p.route[(size_t)t * 4 + 0] = (float)(gi * MOE_EPG + i0);
  p.route[(size_t)t * 4 + 1] = (float)(gi * MOE_EPG + i1);
  p.route[(size_t)t * 4 + 2] = w0;
  p.route[(size_t)t * 4 + 3] = w1;
}
HD void st_moe_h(const Params& p, int layer, int idx) {
  int f = idx % MOE_F; int j = (idx / MOE_F) % 2; int t = idx / (2 * MOE_F);
  int r = tok_r(t);
  const float* x1 = p.X1 + (size_t)t * D; const float* sh = modp(p, layer, r, 3); const float* sc = modp(p, layer, r, 4);
  int e = (int)p.route[(size_t)t * 4 + j]; float wgt = p.route[(size_t)t * 4 + 2 + j];
  const float* w1 = p.moe_w1 + ((size_t)layer * MOE_E + e) * D * MOE_F;
  const float* w3 = p.moe_w3 + ((size_t)layer * MOE_E + e) * D * MOE_F;
  float h1 = 0.f, h3 = 0.f;
  for (int k = 0; k < D; ++k) {
    float h = x1[k] * (1.0f + sc[k]) + sh[k];
    h1 += h * w1[(size_t)k * MOE_F + f]; h3 += h * w3[(size_t)k * MOE_F + f];
  }
  p.HH[(size_t)idx] = siluf(h1) * h3 * wgt;
}
HD void st_moe_o(const Params& p, int layer, int idx) {
  int t = idx / D, n = idx % D;
  float acc = 0.f;
  for (int j = 0; j < 2; ++j) {
    int e = (int)p.route[(size_t)t * 4 + j];
    const float* w2 = p.moe_w2 + ((size_t)layer * MOE_E + e) * MOE_F * D;
    const float* hh = p.HH + ((size_t)t * 2 + j) * MOE_F;
    for (int f = 0; f < MOE_F; ++f) acc += hh[f] * w2[(size_t)f * D + n];
  }
  p.F[(size_t)t * D + n] = acc;
}
HD void st_ln2(const Params& p, int layer, int t) {
  int r = tok_r(t);
  const float* x1 = p.X1 + (size_t)t * D; const float* g2 = modp(p, layer, r, 5);
  const float* y = p.F + (size_t)t * D;
  float mu = 0.f;
  for (int k = 0; k < D; ++k) mu += ALPHA * x1[k] + g2[k] * y[k];
  mu /= D;
  float var = 0.f;
  for (int k = 0; k < D; ++k) { float v = ALPHA * x1[k] + g2[k] * y[k] - mu; var += v * v; }
  var /= D;
  float rs = 1.0f / sqrtf(var + LN_EPS);
  const float* lg = p.ln2_g + (size_t)layer * D; const float* lb = p.ln2_b + (size_t)layer * D;
  float* dst = layer == DEPTH - 1 ? p.out + (size_t)t * D : p.X + (size_t)t * D;
  for (int k = 0; k < D; ++k) dst[k] = (ALPHA * x1[k] + g2[k] * y[k] - mu) * rs * lg[k] + lb[k];
}

enum { S_MOD, S_TABA, S_TABB, S_PROJ, S_SWA, S_SSME, S_SSMC, S_SSMO, S_GLU, S_DIF, S_DIFNORM, S_OUTPROJ, S_LN1, S_ROUTE, S_MOEH, S_MOEO, S_LN2 };
template <int S> HD void run_elem(const Params& p, int layer, int idx) {
  if (S == S_MOD) st_mod(p, layer, idx);
  else if (S == S_TABA) st_taba(p, layer, idx);
  else if (S == S_TABB) st_tabb(p, layer, idx);
  else if (S == S_PROJ) st_proj(p, layer, idx);
  else if (S == S_SWA) st_swa(p, layer, idx);
  else if (S == S_SSME) st_ssm_e(p, layer, idx);
  else if (S == S_SSMC) st_ssm_c(p, layer, idx);
  else if (S == S_SSMO) st_ssm_o(p, layer, idx);
  else if (S == S_GLU) st_glu(p, layer, idx);
  else if (S == S_DIF) st_dif(p, layer, idx);
  else if (S == S_DIFNORM) st_difnorm(p, layer, idx);
  else if (S == S_OUTPROJ) st_outproj(p, layer, idx);
  else if (S == S_LN1) st_ln1(p, layer, idx);
  else if (S == S_ROUTE) st_route(p, layer, idx);
  else if (S == S_MOEH) st_moe_h(p, layer, idx);
  else if (S == S_MOEO) st_moe_o(p, layer, idx);
  else if (S == S_LN2) st_ln2(p, layer, idx);
}

constexpr int NSLOT = 2 * TA + MOE_E * 256;
constexpr size_t CTL_BYTES = 1u << 20;
struct WsLayout {
  size_t A2, BtY, BtE, apow16, KT16, E16, Ypart;
  size_t ctl, X, X1, P, Ymix, Gs, modv, ropeT, apow, bbar, KT, E, Sin, route, scal, WinA_t, DifIn_t, WoutA_t, DifOut_t, Glu_t, W13t, W2t, gate, tokslot, moe_meta, total;
};
inline WsLayout ws_layout() {
  WsLayout L; size_t o = 0;
  auto take = [&](size_t bytes) { size_t r = o; o += (bytes + 255) & ~(size_t)255; return r; };
  L.ctl = take(CTL_BYTES);
  L.X = take((size_t)TA * D * 4);
  L.X1 = L.X;
  L.P = take((size_t)TA * (AB_IN > DIF_IN ? AB_IN : DIF_IN) * 2);
  L.Ymix = take((size_t)TA * YW * 2);
  L.Gs = L.X;
  L.modv = take((size_t)N_MOD * 4);
  L.ropeT = take((size_t)N_ROPE * 2 * 4);
  L.apow = take((size_t)N_APOW * 2 * 4);
  L.bbar = take((size_t)N_BBAR * 2 * 4);
  L.KT = take((size_t)N_KT * 4);
  L.E = L.X + (((size_t)TA * SSM_W * 2 + 255) & ~(size_t)255);
  L.Sin = L.E + (((size_t)N_SSME * 2 * 4 + 255) & ~(size_t)255);
  L.route = take((size_t)TA * 8 * 4);
  L.scal = take(256);
  L.WinA_t = take((size_t)AB_IN * D * 2);
  L.DifIn_t = take((size_t)DIF_IN * D * 2);
  L.WoutA_t = take((size_t)D * AB_OUT * 2);
  L.DifOut_t = take((size_t)D * DIF_VW * 2);
  L.Glu_t = take((size_t)SSM_W * SSM_W * 2);
  L.W13t = take((size_t)MOE_E * 2 * MOE_F * D * 2);
  L.W2t = take((size_t)MOE_E * D * MOE_F * 2);
  L.gate = take((size_t)NSLOT * 4);
  L.tokslot = take((size_t)TA * 2 * 4);
  L.moe_meta = take(4096);
  L.BtY = take((size_t)2 * SSM_G * 256 * 384 * 2);
  L.BtE = take((size_t)2 * SSM_G * 256 * 256 * 2);
  L.apow16 = take((size_t)2 * SSM_G * SSM_P * 17 * 2 * 4);
  L.KT16 = take((size_t)2 * SSM_G * 16 * 256 * 4);
  L.A2 = L.P + (size_t)48 * 1024 * 1024;
  L.E16 = L.X + (size_t)19 * 1024 * 1024;
  L.Ypart = L.E16;
  L.total = o;
  return L;
}
inline void fill_ws(Params& p, char* ws) {
  WsLayout L = ws_layout();
  p.X = (float*)(ws + L.X); p.X1 = (float*)(ws + L.X1); p.P = (uint16_t*)(ws + L.P); p.F = (float*)(ws + L.P);
  p.Ymix = (uint16_t*)(ws + L.Ymix); p.HH = (float*)(ws + L.Ymix);
  p.Gs = (uint16_t*)(ws + L.Gs); p.modv = (float*)(ws + L.modv); p.ropeT = (float*)(ws + L.ropeT);
  p.apow = (float*)(ws + L.apow); p.bbar = (float*)(ws + L.bbar); p.KT = (float*)(ws + L.KT);
  p.E = (float*)(ws + L.E); p.Sin = (float*)(ws + L.Sin); p.route = (float*)(ws + L.route); p.scal = (float*)(ws + L.scal);
  p.H = (uint16_t*)(ws + L.Ymix); p.WinA_t = (uint16_t*)(ws + L.WinA_t); p.DifIn_t = (uint16_t*)(ws + L.DifIn_t); p.ctl = (unsigned*)(ws + L.ctl);
  p.WoutA_t = (uint16_t*)(ws + L.WoutA_t); p.DifOut_t = (uint16_t*)(ws + L.DifOut_t); p.Glu_t = (uint16_t*)(ws + L.Glu_t);
  p.W13t = (uint16_t*)(ws + L.W13t); p.W2t = (uint16_t*)(ws + L.W2t);
  p.Amoe = (uint16_t*)(ws + L.P); p.F2 = (uint16_t*)(ws + L.P); p.HHb = (uint16_t*)(ws + L.Ymix);
  p.A2 = (uint16_t*)(ws + L.A2); p.BtY = (uint16_t*)(ws + L.BtY); p.BtE = (uint16_t*)(ws + L.BtE);
  p.apow16 = (float*)(ws + L.apow16); p.KT16 = (float*)(ws + L.KT16); p.E16 = (float*)(ws + L.E16); p.Ypart = (float*)(ws + L.Ypart);
  p.gate = (float*)(ws + L.gate); p.tokslot = (int*)(ws + L.tokslot); p.moe_meta = (int*)(ws + L.moe_meta);
}
inline void fill_inputs(Params& p, void* const* d_in) {
  const float* const* in = (const float* const*)d_in;
  p.x = in[0]; p.c = in[1]; p.ctx = in[2]; p.c_ctx = in[3]; p.mod_w = in[4]; p.mod_b = in[5];
  p.ln1_g = in[6]; p.ln1_b = in[7]; p.ln2_g = in[8]; p.ln2_b = in[9];
  p.w_in_a = in[10]; p.w_out_a = in[11]; p.sink = in[12]; p.a_re = in[13]; p.a_im = in[14]; p.log_step = in[15];
  p.b_re = in[16]; p.b_im = in[17]; p.c_re = in[18]; p.c_im = in[19]; p.ssm_d = in[20]; p.glu_w = in[21]; p.glu_b = in[22];
  p.dif_w_in = in[23]; p.dif_w_out = in[24]; p.lq1 = in[25]; p.lk1 = in[26]; p.lq2 = in[27]; p.lk2 = in[28]; p.subln_g = in[29];
  p.moe_wg = in[30]; p.moe_bg = in[31]; p.moe_we = in[32]; p.moe_be = in[33]; p.moe_w1 = in[34]; p.moe_w3 = in[35]; p.moe_w2 = in[36];
}

#define FORWARD_PROGRAM(RUN)                                   \
  RUN(S_MOD, 0, N_MOD)                                         \
  RUN(S_TABA, 0, N_TABA)                                       \
  RUN(S_TABB, 0, N_KT)                                         \
                                                   \
  RUN(S_PROJ, 0, TA * AB_IN)                                   \
  RUN(S_SWA, 0, SWA_H * TA)                                    \
  RUN(S_SSME, 0, N_SSME)                                       \
  RUN(S_SSMC, 0, N_SSMC)                                       \
  RUN(S_SSMO, 0, TA * SSM_W)                                   \
  RUN(S_GLU, 0, TA * SSM_W)                                    \
  RUN(S_OUTPROJ, 0, TA * D)                                    \
  RUN(S_LN1, 0, TA)                                            \
  RUN(S_ROUTE, 0, TA)                                          \
  RUN(S_MOEH, 0, TA * 2 * MOE_F)                               \
  RUN(S_MOEO, 0, TA * D)                                       \
  RUN(S_LN2, 0, TA)                                            \
                                                   \
  RUN(S_PROJ, 1, TA * DIF_IN)                                  \
  RUN(S_DIF, 1, DIF_H * 2 * TL)                                \
  RUN(S_DIFNORM, 1, TL * DIF_H)                                \
  RUN(S_OUTPROJ, 1, TL * D)                                    \
  RUN(S_LN1, 1, TL)                                            \
  RUN(S_ROUTE, 1, TL)                                          \
  RUN(S_MOEH, 1, TL * 2 * MOE_F)                               \
  RUN(S_MOEO, 1, TL * D)                                       \
  RUN(S_LN2, 1, TL)

#ifndef HOST_EMU
#include <cstdio>
#define LAS __attribute__((address_space(3)))
#define GAS __attribute__((address_space(1)))
typedef unsigned short bf16_t;
typedef short bf16x8 __attribute__((ext_vector_type(8)));
typedef float f32x4 __attribute__((ext_vector_type(4)));
typedef float f32x2 __attribute__((ext_vector_type(2)));
typedef unsigned u32x4 __attribute__((ext_vector_type(4)));
typedef unsigned u32x2 __attribute__((ext_vector_type(2)));
constexpr int NWAVES = 8, NTHR = 512;
constexpr int RING_BYTES = 131072, LDSCTL_OFF = RING_BYTES, MISC_OFF = LDSCTL_OFF + 320, LDS_BYTES = 147456;
#define LDS_WAIT() asm volatile("s_waitcnt lgkmcnt(0)" ::: "memory")
#define VM_WAIT() asm volatile("s_waitcnt vmcnt(0)" ::: "memory")
__device__ __forceinline__ unsigned cvt_pk_bf16(float lo, float hi) { unsigned r; asm volatile("v_cvt_pk_bf16_f32 %0, %1, %2" : "=v"(r) : "v"(lo), "v"(hi)); return r; }

namespace pg8 {
constexpr int BM = 256, BK = 64, HALF = 128, HTB = HALF * BK * 2, STAGE_BYTES = 8 * HTB, NXCD = 8, WGM = 8;
__host__ __device__ __forceinline__ int lds_byte(int r, int c) { const int st = (r >> 4) * 2 + (c >> 5), rr = r & 15, cc = c & 31, ob = rr * 64 + cc * 2; return st * 1024 + (ob ^ (((ob >> 9) & 1) << 5)); }
__host__ __device__ __forceinline__ void stage_rc(int b, int& R, int& C) { const int st = b / 1024, sb = b % 1024, swz = sb ^ (((sb >> 9) & 1) << 5); R = (st >> 1) * 16 + swz / 64; C = (st & 1) * 32 + (swz % 64) / 2; }
__host__ __device__ __forceinline__ int perm32(int rho) { const int n = rho >> 4, i = rho & 15; return 8 * (i >> 2) + 4 * n + (i & 3); }
struct Unit { int pm, pn; };
struct Gemm { const bf16_t* A; const bf16_t* Bt; int lda, ldb, K; };

struct StaticOrder {
  int nM, nN, nwg, G, c;
  __device__ void init(int M, int N, int G_, int c_) { nM = M / BM; nN = N / BM; nwg = nM * nN; G = G_; c = c_; }
  __device__ bool next(int i, Unit& u) const {
    const long L = (long)i * G + c; if (L >= nwg) return false;
    int wgid = (int)L; { const int q = nwg / NXCD, r = nwg % NXCD, xcd = wgid % NXCD, off = wgid / NXCD; wgid = (xcd < r ? xcd * (q + 1) : r * (q + 1) + (xcd - r) * q) + off; }
    const int nig = WGM * nN, gid = wgid / nig, fm = gid * WGM, gsz = (nM - fm) < WGM ? (nM - fm) : WGM;
    u.pm = fm + ((wgid % nig) % gsz); u.pn = (wgid % nig) / gsz; return true;
  }
  __device__ __forceinline__ void a_ready(const Unit&) const {}
  __device__ __forceinline__ void done(const Unit&) const {}
};

template <class Epi, class Sched, bool ALIGN_EPI = true, bool SP2 = true>
__device__ __forceinline__ void gemm_phase(LAS unsigned char* lds, const Gemm g, const Sched& S, const Epi& E) {
  int tid = threadIdx.x; asm volatile("" : "+v"(tid));
  const int wid = __builtin_amdgcn_readfirstlane(tid >> 6), lane = tid & 63, wr = wid >> 2, wc = wid & 3, fr = lane & 15, fq = lane >> 4;
  const int K = g.K, nt = K / BK;
  unsigned voffA[2], voffB[2];
#pragma unroll
  for (int i = 0; i < 2; ++i) { int R, C; stage_rc(tid * 16 + i * 8192, R, C); const int Rb = Epi::PERM ? ((R & ~31) + perm32(R & 31)) : R;
    voffA[i] = (unsigned)(R * g.lda + C) * 2u; voffB[i] = (unsigned)(Rb * g.ldb + C) * 2u; }
  const size_t kstep = (size_t)(BK * 2);
  const size_t hA = (size_t)HALF * g.lda * 2, hB = (size_t)HALF * g.ldb * 2;
  const size_t tA = 2 * hA, tB = 2 * hB;
  const unsigned ldsw = (unsigned)wid * 1024u;
  const int aoff = lds_byte(wr * 64 + fr, fq * 8), boff = lds_byte(wc * 32 + fr, fq * 8);
#define PG8_SA(b, h) (((b) * 2 + (h)) * HTB)
#define PG8_SB(b, h) ((4 + (b) * 2 + (h)) * HTB)
#define PG8_STAGE(bufoff, gbase, voff) do { _Pragma("unroll") for (int _i = 0; _i < 2; ++_i) \
    __builtin_amdgcn_global_load_lds((const unsigned*)((const char*)(gbase) + (voff)[_i]), (LAS unsigned*)(lds + (bufoff) + ldsw + _i * 8192), 16, 0, 0); } while (0)
#define PG8_LDA(dst, b, h) do { _Pragma("unroll") for (int m = 0; m < 4; ++m) _Pragma("unroll") for (int k = 0; k < 2; ++k) dst[m][k] = *(const LAS bf16x8*)(lds + PG8_SA(b, h) + aoff + m * 2048 + k * 1024); } while (0)
#define PG8_LDB(dst, b, h) do { _Pragma("unroll") for (int n = 0; n < 2; ++n) _Pragma("unroll") for (int k = 0; k < 2; ++k) dst[n][k] = *(const LAS bf16x8*)(lds + PG8_SB(b, h) + boff + n * 2048 + k * 1024); } while (0)
#define PG8_MMA(ai, bj, At, Bt) do { __builtin_amdgcn_s_setprio(1); _Pragma("unroll") for (int m = 0; m < 4; ++m) _Pragma("unroll") for (int n = 0; n < 2; ++n) _Pragma("unroll") for (int k = 0; k < 2; ++k) \
    acc[ai][bj][m][n] = __builtin_amdgcn_mfma_f32_16x16x32_bf16(Bt[n][k], At[m][k], acc[ai][bj][m][n], 0, 0, 0); __builtin_amdgcn_s_setprio(0); } while (0)
#define PG8_WAIT_V(n) asm volatile("s_waitcnt vmcnt(" #n ")" ::: "memory")
#define PG8_WAIT_L(n) asm volatile("s_waitcnt lgkmcnt(" #n ")" ::: "memory")
#define PG8_BAR __builtin_amdgcn_s_barrier()
#define PG8_SCHED __builtin_amdgcn_sched_barrier(0)
  Unit cur, nxt; int ui = 0;
  if (!S.next(0, cur)) return;
  f32x4 acc[2][2][4][2];
#pragma unroll
  for (int a = 0; a < 2; ++a)
#pragma unroll
    for (int b = 0; b < 2; ++b)
#pragma unroll
      for (int m = 0; m < 4; ++m)
#pragma unroll
        for (int n = 0; n < 2; ++n) acc[a][b][m][n] = (f32x4){0.f, 0.f, 0.f, 0.f};
  bf16x8 At[4][2], B0[2][2], B1[2][2];
  const char* cA = (const char*)g.A + (size_t)cur.pm * tA; const char* cB = (const char*)g.Bt + (size_t)cur.pn * tB;
  S.a_ready(cur);
  if constexpr (SP2) {
    PG8_STAGE(PG8_SB(0, 0), cB, voffB); PG8_STAGE(PG8_SB(0, 1), cB + hB, voffB); PG8_STAGE(PG8_SA(0, 0), cA, voffA); PG8_STAGE(PG8_SA(0, 1), cA + hA, voffA);
    if (wr == 1) PG8_BAR;
    PG8_WAIT_V(2); PG8_BAR;
    PG8_STAGE(PG8_SB(1, 0), cB + kstep, voffB); PG8_STAGE(PG8_SA(1, 0), cA + kstep, voffA); PG8_STAGE(PG8_SB(1, 1), cB + hB + kstep, voffB);
    PG8_WAIT_V(6); PG8_BAR;
  } else {
    PG8_STAGE(PG8_SB(0, 0), cB, voffB); PG8_STAGE(PG8_SA(0, 0), cA, voffA); PG8_STAGE(PG8_SB(0, 1), cB + hB, voffB); PG8_STAGE(PG8_SA(0, 1), cA + hA, voffA);
    if (wr == 1) PG8_BAR;
    PG8_WAIT_V(4); PG8_BAR;
    PG8_STAGE(PG8_SB(1, 0), cB + kstep, voffB); PG8_STAGE(PG8_SA(1, 0), cA + kstep, voffA); PG8_STAGE(PG8_SB(1, 1), cB + hB + kstep, voffB);
    PG8_WAIT_V(6); PG8_BAR;
  }
  for (;;) {
    const bool has_next = S.next(ui + 1, nxt);
    const char* nA = has_next ? (const char*)g.A + (size_t)nxt.pm * tA : cA; const char* nB = has_next ? (const char*)g.Bt + (size_t)nxt.pn * tB : cB;
#pragma unroll 1
    for (int t = 0; t < nt; t += 2) {
      const bool last = (t == nt - 2);
      const char* a1 = cA + (size_t)(t + 1) * kstep;
      const char* a2 = last ? nA : cA + (size_t)(t + 2) * kstep; const char* b2 = last ? nB : cB + (size_t)(t + 2) * kstep;
      const char* a3 = a2 + kstep; const char* b3 = b2 + kstep;
      if (last && has_next) S.a_ready(nxt);
      if constexpr (SP2) {
        PG8_LDB(B0, 0, 0); PG8_LDB(B1, 0, 1); PG8_SCHED; PG8_LDA(At, 0, 0); PG8_STAGE(PG8_SA(1, 1), a1 + hA, voffA);
        PG8_WAIT_V(8); PG8_WAIT_L(0); PG8_BAR; PG8_MMA(0, 0, At, B0); PG8_MMA(0, 1, At, B1); PG8_BAR; PG8_SCHED;
        PG8_LDA(At, 0, 1); PG8_STAGE(PG8_SB(0, 0), b2, voffB); PG8_STAGE(PG8_SB(0, 1), b2 + hB, voffB); PG8_STAGE(PG8_SA(0, 0), a2, voffA);
        PG8_WAIT_V(8); PG8_WAIT_L(0); PG8_BAR; PG8_MMA(1, 0, At, B0); PG8_MMA(1, 1, At, B1); PG8_BAR; PG8_SCHED;
        PG8_LDB(B0, 1, 0); PG8_LDB(B1, 1, 1); PG8_SCHED; PG8_LDA(At, 1, 0); PG8_STAGE(PG8_SA(0, 1), a2 + hA, voffA);
        PG8_WAIT_V(8); PG8_WAIT_L(0); PG8_BAR; PG8_MMA(0, 0, At, B0); PG8_MMA(0, 1, At, B1); PG8_BAR; PG8_SCHED;
        PG8_LDA(At, 1, 1); PG8_STAGE(PG8_SB(1, 0), b3, voffB); PG8_STAGE(PG8_SB(1, 1), b3 + hB, voffB); PG8_STAGE(PG8_SA(1, 0), a3, voffA);
        PG8_WAIT_V(8); PG8_WAIT_L(0); PG8_BAR; PG8_MMA(1, 0, At, B0); PG8_MMA(1, 1, At, B1); PG8_BAR; PG8_SCHED;
      } else {
        PG8_LDB(B0, 0, 0); PG8_SCHED; PG8_LDA(At, 0, 0); PG8_STAGE(PG8_SA(1, 1), a1 + hA, voffA);
        PG8_WAIT_L(8); PG8_BAR; PG8_WAIT_L(0); PG8_MMA(0, 0, At, B0); PG8_BAR; PG8_SCHED;
        PG8_LDB(B1, 0, 1); PG8_STAGE(PG8_SB(0, 0), b2, voffB);
        PG8_BAR; PG8_WAIT_L(0); PG8_MMA(0, 1, At, B1); PG8_BAR;
        PG8_LDA(At, 0, 1); PG8_STAGE(PG8_SA(0, 0), a2, voffA);
        PG8_BAR; PG8_WAIT_L(0); PG8_MMA(1, 0, At, B0); PG8_BAR; PG8_SCHED;
        PG8_STAGE(PG8_SB(0, 1), b2 + hB, voffB);
        PG8_WAIT_V(6); PG8_BAR; PG8_MMA(1, 1, At, B1); PG8_BAR;
        PG8_LDB(B0, 1, 0); PG8_SCHED; PG8_LDA(At, 1, 0); PG8_STAGE(PG8_SA(0, 1), a2 + hA, voffA);
        PG8_WAIT_L(8); PG8_BAR; PG8_WAIT_L(0); PG8_MMA(0, 0, At, B0); PG8_BAR; PG8_SCHED;
        PG8_LDB(B1, 1, 1); PG8_STAGE(PG8_SB(1, 0), b3, voffB);
        PG8_BAR; PG8_WAIT_L(0); PG8_MMA(0, 1, At, B1); PG8_BAR;
        PG8_LDA(At, 1, 1); PG8_STAGE(PG8_SA(1, 0), a3, voffA);
        PG8_BAR; PG8_WAIT_L(0); PG8_MMA(1, 0, At, B0); PG8_BAR; PG8_SCHED;
        PG8_STAGE(PG8_SB(1, 1), b3 + hB, voffB);
        PG8_WAIT_V(6); PG8_BAR; PG8_MMA(1, 1, At, B1); PG8_BAR;
      }
    }
    if constexpr (ALIGN_EPI) { if (wr == 0) PG8_BAR; }
    E(acc, cur, wr, wc, fr, fq); S.done(cur);
    if (!has_next) break;
#pragma unroll
    for (int a = 0; a < 2; ++a)
#pragma unroll
      for (int b = 0; b < 2; ++b)
#pragma unroll
        for (int m = 0; m < 4; ++m)
#pragma unroll
          for (int n = 0; n < 2; ++n) acc[a][b][m][n] = (f32x4){0.f, 0.f, 0.f, 0.f};
    cur = nxt; cA = nA; cB = nB; ++ui;
    if constexpr (ALIGN_EPI) { if (wr == 1) PG8_BAR; }
  }
  PG8_WAIT_V(0);
  if constexpr (!ALIGN_EPI) { if (wr == 0) PG8_BAR; }
  PG8_BAR;
#undef PG8_SA
#undef PG8_SB
#undef PG8_STAGE
#undef PG8_LDA
#undef PG8_LDB
#undef PG8_MMA
#undef PG8_WAIT_V
#undef PG8_WAIT_L
#undef PG8_BAR
#undef PG8_SCHED
}
}

constexpr int LC = 16, NCH16 = SS / LC, GROWS = 1280, A2K = 384;
static_assert(B * NCH16 <= GROWS && GROWS % 256 == 0, "ssm group rows");
__device__ __forceinline__ void ssm_tau(int t, int& b, int& tau0, int& tau1) {
  if (t < TL) { b = t / N; const int i = t % N; tau0 = CTX + i; tau1 = CTX + (N - 1 - i); }
  else { b = (t - TL) / CTX; const int i = (t - TL) % CTX; tau0 = i; tau1 = CTX - 1 - i; }
}
struct EpiProj {
  static constexpr bool PERM = false;
  bf16_t* O; int ldc; int rope_end; const float* ropeT; bf16_t* A2;
  __device__ __forceinline__ void operator()(const f32x4 (&acc)[2][2][4][2], const pg8::Unit& u, int wr, int wc, int fr, int fq) const {
    const int row0 = u.pm * 256 + wr * 64 + fr, colb = u.pn * 256 + wc * 32;
    const bool rope_cols = colb < rope_end;
#pragma unroll
    for (int ai = 0; ai < 2; ++ai)
#pragma unroll
      for (int m = 0; m < 4; ++m) {
        const int r = row0 + ai * 128 + m * 16;
        bf16_t* rowp = O + (size_t)r * ldc + colb + 4 * fq;
        f32x4 cs0 = {1.f, 0.f, 1.f, 0.f}, cs1 = {1.f, 0.f, 1.f, 0.f};
        const bool rp = rope_cols && (r < TL);
        if (rp) { const int i = r % N; const int pos = (wc & 1) ? (i % GRID_W) : (i / GRID_W);
          const f32x4* tp = (const f32x4*)(ropeT + (size_t)(pos * 16 + 4 * fq) * 2); cs0 = tp[0]; cs1 = tp[1]; }
#pragma unroll
        for (int bj = 0; bj < 2; ++bj) {
          const bool rpb = rp && (colb + bj * 128 < rope_end);
          f32x4 a1 = acc[ai][bj][m][0], a2 = acc[ai][bj][m][1];
          f32x4 o1 = a1, o2 = a2;
          if (rpb) {
            o1[0] = a1[0] * cs0[0] - a2[0] * cs0[1]; o2[0] = a2[0] * cs0[0] + a1[0] * cs0[1];
            o1[1] = a1[1] * cs0[2] - a2[1] * cs0[3]; o2[1] = a2[1] * cs0[2] + a1[1] * cs0[3];
            o1[2] = a1[2] * cs1[0] - a2[2] * cs1[1]; o2[2] = a2[2] * cs1[0] + a1[2] * cs1[1];
            o1[3] = a1[3] * cs1[2] - a2[3] * cs1[3]; o2[3] = a2[3] * cs1[2] + a1[3] * cs1[3];
          }
          u32x2 w1 = {cvt_pk_bf16(o1[0], o1[1]), cvt_pk_bf16(o1[2], o1[3])}, w2 = {cvt_pk_bf16(o2[0], o2[1]), cvt_pk_bf16(o2[2], o2[3])};
          *(u32x2*)(rowp + bj * 128) = w1; *(u32x2*)(rowp + bj * 128 + 16) = w2;
          if (A2 != nullptr && colb + bj * 128 >= A_UOFF) {
            int b, tau0, tau1; ssm_tau(r, b, tau0, tau1);
            const int g0 = (colb + bj * 128 - A_UOFF) / 16;
            bf16_t* d0 = A2 + (((size_t)g0 * GROWS + b * NCH16 + tau0 / LC) * A2K + (tau0 % LC) * 16 + 4 * fq);
            bf16_t* d1 = A2 + (((size_t)(SSM_G + g0) * GROWS + b * NCH16 + tau1 / LC) * A2K + (tau1 % LC) * 16 + 4 * fq);
            *(u32x2*)d0 = w1; *(u32x2*)(d0 + (size_t)GROWS * A2K) = w2; *(u32x2*)d1 = w1; *(u32x2*)(d1 + (size_t)GROWS * A2K) = w2;
          }
        }
      }
  }
};


struct EpiF32Out {
  static constexpr bool PERM = false;
  float* C; int ldc;
  __device__ __forceinline__ void operator()(const f32x4 (&acc)[2][2][4][2], const pg8::Unit& u, int wr, int wc, int fr, int fq) const {
    const int row0 = u.pm * 256 + wr * 64 + fr, col0 = u.pn * 256 + wc * 32 + 4 * fq;
#pragma unroll
    for (int ai = 0; ai < 2; ++ai)
#pragma unroll
      for (int m = 0; m < 4; ++m) { float* rowp = C + (size_t)(row0 + ai * 128 + m * 16) * ldc + col0;
#pragma unroll
        for (int bj = 0; bj < 2; ++bj)
#pragma unroll
          for (int n = 0; n < 2; ++n) *(f32x4*)(rowp + bj * 128 + n * 16) = acc[ai][bj][m][n]; }
  }
};
struct EpiBf16Out {
  static constexpr bool PERM = true;
  bf16_t* O; int ldc; int NJ;
  __device__ __forceinline__ void operator()(const f32x4 (&acc)[2][2][4][2], const pg8::Unit& u, int wr, int wc, int fr, int fq) const {
    const int row0 = u.pm * 256 + wr * 64 + fr, col0 = (NJ ? (u.pn % NJ) : u.pn) * 256 + wc * 32 + 8 * fq;
#pragma unroll
    for (int ai = 0; ai < 2; ++ai)
#pragma unroll
      for (int m = 0; m < 4; ++m) { bf16_t* rowp = O + (size_t)(row0 + ai * 128 + m * 16) * ldc + col0;
#pragma unroll
        for (int bj = 0; bj < 2; ++bj) { const f32x4 v0 = acc[ai][bj][m][0], v1 = acc[ai][bj][m][1];
          u32x4 w; w.x = cvt_pk_bf16(v0[0], v0[1]); w.y = cvt_pk_bf16(v0[2], v0[3]); w.z = cvt_pk_bf16(v1[0], v1[1]); w.w = cvt_pk_bf16(v1[2], v1[3]);
          *(u32x4*)(rowp + bj * 128) = w; } }
  }
};
__device__ __forceinline__ float fast_sigmoid(float x) { return __builtin_amdgcn_rcpf(1.f + __builtin_amdgcn_exp2f(-1.4426950408889634f * x)); }
struct EpiGlu {
  static constexpr bool PERM = true;
  const bf16_t* Gs; const float* bias; bf16_t* O; int ldo, coloff;
  __device__ __forceinline__ void operator()(const f32x4 (&acc)[2][2][4][2], const pg8::Unit& u, int wr, int wc, int fr, int fq) const {
    const int row0 = u.pm * 256 + wr * 64 + fr, col0 = u.pn * 256 + wc * 32 + 8 * fq;
#pragma unroll
    for (int ai = 0; ai < 2; ++ai)
#pragma unroll
      for (int m = 0; m < 4; ++m) { const int r = row0 + ai * 128 + m * 16;
#pragma unroll
        for (int bj = 0; bj < 2; ++bj) { const int c = col0 + bj * 128;
          const u32x4 gv = *(const u32x4*)(Gs + (size_t)r * SSM_W + c);
          const f32x4 b0 = *(const f32x4*)(bias + c), b1 = *(const f32x4*)(bias + c + 4);
          const f32x4 v0 = acc[ai][bj][m][0] + b0, v1 = acc[ai][bj][m][1] + b1;
          float o[8];
#pragma unroll
          for (int j = 0; j < 4; ++j) { const unsigned gw_ = j < 2 ? (j == 0 ? gv.x : gv.y) : (j == 2 ? gv.z : gv.w);
            const float g0 = __builtin_bit_cast(float, gw_ << 16), g1 = __builtin_bit_cast(float, gw_ & 0xffff0000u);
            const float z0 = j < 2 ? v0[2 * j] : v1[2 * j - 4], z1 = j < 2 ? v0[2 * j + 1] : v1[2 * j - 3];
            o[2 * j] = g0 * fast_sigmoid(z0); o[2 * j + 1] = g1 * fast_sigmoid(z1); }
          u32x4 w; w.x = cvt_pk_bf16(o[0], o[1]); w.y = cvt_pk_bf16(o[2], o[3]); w.z = cvt_pk_bf16(o[4], o[5]); w.w = cvt_pk_bf16(o[6], o[7]);
          *(u32x4*)(O + (size_t)r * ldo + coloff + c) = w; } }
  }
};
struct EpiMoe1 {
  static constexpr bool PERM = true;
  bf16_t* HH; const float* gate;
  __device__ __forceinline__ void operator()(const f32x4 (&acc)[2][2][4][2], const pg8::Unit& u, int wr, int wc, int fr, int fq) const {
    const int row0 = u.pm * 256 + wr * 64 + fr, col0 = (u.pn & 1) * 128 + wc * 32 + 8 * fq;
#pragma unroll
    for (int ai = 0; ai < 2; ++ai)
#pragma unroll
      for (int m = 0; m < 4; ++m) { const int r = row0 + ai * 128 + m * 16; const float gt = gate[r];
        float o[8];
#pragma unroll
        for (int n = 0; n < 2; ++n)
#pragma unroll
          for (int j = 0; j < 4; ++j) { const float h1 = acc[ai][0][m][n][j], h3 = acc[ai][1][m][n][j]; o[4 * n + j] = h1 * fast_sigmoid(h1) * h3 * gt; }
        u32x4 w; w.x = cvt_pk_bf16(o[0], o[1]); w.y = cvt_pk_bf16(o[2], o[3]); w.z = cvt_pk_bf16(o[4], o[5]); w.w = cvt_pk_bf16(o[6], o[7]);
        *(u32x4*)(HH + (size_t)r * MOE_F + col0) = w; }
  }
};
struct MoeOrder {
  const int* meta; int NJ, G, c;
  __device__ __forceinline__ bool next(int i, pg8::Unit& u) const {
    const int nt = __builtin_amdgcn_readfirstlane(__hip_atomic_load(meta, __ATOMIC_RELAXED, __HIP_MEMORY_SCOPE_AGENT));
    const long L = (long)i * G + c; if (L >= (long)nt * NJ) return false;
    const int rt = (int)(L / NJ), jn = (int)(L % NJ);
    const int e = __builtin_amdgcn_readfirstlane(__hip_atomic_load(meta + 1 + rt, __ATOMIC_RELAXED, __HIP_MEMORY_SCOPE_AGENT));
    u.pm = rt; u.pn = e * NJ + jn; return true;
  }
  __device__ __forceinline__ void a_ready(const pg8::Unit&) const {}
  __device__ __forceinline__ void done(const pg8::Unit&) const {}
};


namespace att {
using f32x16 = __attribute__((ext_vector_type(16))) float;
using s16x4  = __attribute__((ext_vector_type(4))) short;
constexpr int KVBLK = 64;
constexpr float SCALE = 0.125f, THR = 8.f;
constexpr size_t SHM_V = KVBLK * 128 * 2, SHM_K = KVBLK * 128 * 2;
constexpr size_t SHM_WS = 2 * SHM_V + 2 * SHM_K;
#define KSWZ(row, colB) ((row) * 256 + ((colB) ^ (((row) & 7) << 4)))
#define SBAR() __builtin_amdgcn_sched_barrier(0)
__device__ __forceinline__ int crow(int r, int hi) { return (r & 3) + 8 * (r >> 2) + 4 * hi; }
__device__ __forceinline__ unsigned cvtpk(float lo, float hi) { unsigned r; asm volatile("v_cvt_pk_bf16_f32 %0, %1, %2" : "=v"(r) : "v"(lo), "v"(hi)); return r; }
__device__ __forceinline__ void partialSM(f32x16& p0, f32x16& p1, float& m_reg, float& mn, float& alpha) {
  constexpr float C = SCALE * 1.4426950408889634f;
  float pmax = p0[0];
#pragma unroll
  for (int r = 1; r < 16; ++r) pmax = fmaxf(pmax, p0[r]);
#pragma unroll
  for (int r = 0; r < 16; ++r) pmax = fmaxf(pmax, p1[r]);
  { auto rr = __builtin_amdgcn_permlane32_swap(__float_as_uint(pmax), __float_as_uint(pmax), false, false);
    pmax = fmaxf(__uint_as_float(rr[0]), __uint_as_float(rr[1])); }
  if (__builtin_expect(__all(pmax - m_reg <= THR / SCALE), 1)) { mn = m_reg; alpha = 1.f; }
  else { mn = fmaxf(m_reg, pmax); alpha = __builtin_amdgcn_exp2f((m_reg - mn) * C); m_reg = mn; }
  const float mnC = -mn * C;
#pragma unroll
  for (int r = 0; r < 16; ++r) p0[r] = fmaf(p0[r], C, mnC);
#pragma unroll
  for (int r = 0; r < 16; ++r) p1[r] = fmaf(p1[r], C, mnC);
#pragma unroll
  for (int r = 0; r < 16; ++r) p0[r] = __builtin_amdgcn_exp2f(p0[r]);
}
__device__ __forceinline__ void finishSM(f32x16& p0, f32x16& p1, float alpha, float& l_reg, bf16x8& pa0, bf16x8& pa1, bf16x8& pa2, bf16x8& pa3) {
#pragma unroll
  for (int r = 0; r < 16; ++r) p1[r] = __builtin_amdgcn_exp2f(p1[r]);
  float ps = 0;
#pragma unroll
  for (int r = 0; r < 16; ++r) ps += p0[r];
#pragma unroll
  for (int r = 0; r < 16; ++r) ps += p1[r];
  { auto rr = __builtin_amdgcn_permlane32_swap(__float_as_uint(ps), __float_as_uint(ps), false, false);
    ps = __uint_as_float(rr[0]) + __uint_as_float(rr[1]); }
  l_reg = l_reg * alpha + ps;
#define PK4(P, BASE, OUT) do { unsigned a0 = cvtpk(P[BASE + 0], P[BASE + 1]), a1 = cvtpk(P[BASE + 2], P[BASE + 3]);   \
    unsigned b0 = cvtpk(P[BASE + 4], P[BASE + 5]), b1 = cvtpk(P[BASE + 6], P[BASE + 7]);                              \
    auto r0 = __builtin_amdgcn_permlane32_swap(a0, b0, false, false); auto r1 = __builtin_amdgcn_permlane32_swap(a1, b1, false, false); \
    u32x4 w = {r0[0], r1[0], r0[1], r1[1]}; OUT = *reinterpret_cast<bf16x8*>(&w); } while (0)
  PK4(p0, 0, pa0); PK4(p0, 8, pa1); PK4(p1, 0, pa2); PK4(p1, 8, pa3);
#undef PK4
}
__device__ __forceinline__ void qkt(f32x16& p0, f32x16& p1, const char* Ks, const bf16x8* qr, int r32, int hi, int c) {
  p0 = f32x16{}; p1 = f32x16{};
#pragma unroll
  for (int d0 = 0; d0 < 4; ++d0) { const int cb = (c * 64 + d0 * 16 + hi * 8) * 2;
    const bf16x8 b0 = *reinterpret_cast<const bf16x8*>(Ks + KSWZ(r32, cb));
    const bf16x8 b1 = *reinterpret_cast<const bf16x8*>(Ks + KSWZ(32 + r32, cb));
    p0 = __builtin_amdgcn_mfma_f32_32x32x16_bf16(b0, qr[d0], p0, 0, 0, 0);
    p1 = __builtin_amdgcn_mfma_f32_32x32x16_bf16(b1, qr[d0], p1, 0, 0, 0); }
}
__device__ __forceinline__ int v_st(int k, int c) { const int kk = (k & ~0xC) | ((k & 4) << 1) | ((k & 8) >> 1); return ((kk >> 3) * 4 + (c >> 5)) * 512 + ((kk & 7) * 32 + (c & 31)) * 2; }
__device__ __forceinline__ int v_rd_base(int lane) { return ((lane & 3) << 3) | (((lane >> 2) & 3) << 6) | (((lane >> 4) & 1) << 5) | (((lane >> 5) & 1) << 8); }
constexpr int v_rd_off(int d0, int ks, int half) { return d0 * 512 + ks * 4096 + half * 2048; }
template <int OFF> __device__ __forceinline__ s16x4 tr_read(int vb) {
  s16x4 r; asm volatile("ds_read_b64_tr_b16 %0, %1 offset:%2" : "=&v"(r) : "v"(vb), "i"(OFF) : "memory"); return r;
}
template <int D0> __device__ __forceinline__ void pv_one(f32x16& od, int vb, bf16x8 pa0, bf16x8 pa1, bf16x8 pa2, bf16x8 pa3) {
  const s16x4 l0 = tr_read<v_rd_off(D0, 0, 0)>(vb), h0 = tr_read<v_rd_off(D0, 0, 1)>(vb), l1 = tr_read<v_rd_off(D0, 1, 0)>(vb), h1 = tr_read<v_rd_off(D0, 1, 1)>(vb);
  const s16x4 l2 = tr_read<v_rd_off(D0, 2, 0)>(vb), h2 = tr_read<v_rd_off(D0, 2, 1)>(vb), l3 = tr_read<v_rd_off(D0, 3, 0)>(vb), h3 = tr_read<v_rd_off(D0, 3, 1)>(vb);
  asm volatile("s_waitcnt lgkmcnt(0)" ::: "memory"); SBAR();
#define PK(L, H) (bf16x8){L[0], L[1], L[2], L[3], H[0], H[1], H[2], H[3]}
  od = __builtin_amdgcn_mfma_f32_32x32x16_bf16(pa0, PK(l0, h0), od, 0, 0, 0);
  od = __builtin_amdgcn_mfma_f32_32x32x16_bf16(pa1, PK(l1, h1), od, 0, 0, 0);
  od = __builtin_amdgcn_mfma_f32_32x32x16_bf16(pa2, PK(l2, h2), od, 0, 0, 0);
  od = __builtin_amdgcn_mfma_f32_32x32x16_bf16(pa3, PK(l3, h3), od, 0, 0, 0);
#undef PK
}
template <int NB> __device__ __forceinline__ void pv_blocks(f32x16* o, int vb, int vsel, bf16x8 pa0, bf16x8 pa1, bf16x8 pa2, bf16x8 pa3) {
  if constexpr (NB == 4) { pv_one<0>(o[0], vb, pa0, pa1, pa2, pa3); pv_one<1>(o[1], vb, pa0, pa1, pa2, pa3); pv_one<2>(o[2], vb, pa0, pa1, pa2, pa3); pv_one<3>(o[3], vb, pa0, pa1, pa2, pa3); }
  else { if (vsel == 0) { pv_one<0>(o[0], vb, pa0, pa1, pa2, pa3); pv_one<1>(o[1], vb, pa0, pa1, pa2, pa3); }
         else { pv_one<2>(o[0], vb, pa0, pa1, pa2, pa3); pv_one<3>(o[1], vb, pa0, pa1, pa2, pa3); } }
}
__device__ __forceinline__ void apply_mask(f32x16& p0, f32x16& p1, int mt, int i, int k0, int hi) {
  if (mt == 0) return;
#pragma unroll
  for (int r = 0; r < 16; ++r) { const int j0 = k0 + crow(r, hi), j1 = j0 + 32;
    const bool ok0 = (mt == 1) && (j0 - i <= SWA_WIN) && (i - j0 <= SWA_WIN), ok1 = (mt == 1) && (j1 - i <= SWA_WIN) && (i - j1 <= SWA_WIN);
    p0[r] = ok0 ? p0[r] : -1e30f; p1[r] = ok1 ? p1[r] : -1e30f; }
}

struct TileMap {
  int nl, tlo, bN, bC;
  __device__ __forceinline__ int row(int t) const { return t < nl ? bN + 64 * (tlo + t) : (t < nl + CTX / 64 ? bC + 64 * (t - nl) : bN + 64 * tlo); }
  __device__ __forceinline__ int mtype(int t) const { return t < nl ? 1 : (t < nl + CTX / 64 ? 0 : 2); }
  __device__ __forceinline__ int key0(int t) const { return 64 * (tlo + (t < nl ? t : 0)); }
};

template <int MODE>
__device__ __forceinline__ void attn_unit(const bf16_t* __restrict__ Pq, const bf16_t* __restrict__ Pk, const bf16_t* __restrict__ Pv, int LD, const TileMap tm, int NT,
                                          float m_init, float l_init, int i0, LAS unsigned char* ldsb, f32x16* o, float& l_out, int tid) {
  constexpr int NB = MODE == 0 ? 4 : 2;
  const int wid = tid >> 6, lane = tid & 63, r32 = lane & 31, hi = lane >> 5, c = wid >> 2;
  char* lds = (char*)ldsb;
  char* V_lds = lds; char* K_lds = lds + 2 * SHM_V;
  float* ws = (float*)(lds + SHM_WS) + wid * 64; float* al_l = ws + 32;
  float m_reg = m_init, l_reg = l_init; bf16x8 qr[4];
#pragma unroll
  for (int d = 0; d < NB; ++d) o[d] = f32x16{};
  const bf16_t* Qw = Pq + (size_t)r32 * LD + hi * 8;
#pragma unroll
  for (int d0 = 0; d0 < 4; ++d0) qr[d0] = *reinterpret_cast<const bf16x8*>(Qw + d0 * 16);
  const int sr = tid >> 4, sc = (tid & 15) * 8, vst0 = v_st(sr, sc), vst1 = v_st(32 + sr, sc);
  const int vb0 = (int)(uintptr_t)V_lds + v_rd_base(lane);
  struct { bf16x8 vs0, vs1, ks0, ks1; } sr_[2];
#define SLOAD(i, t) do { const size_t rb_ = (size_t)tm.row(t); \
    sr_[i].vs0 = *reinterpret_cast<const bf16x8*>(Pv + (rb_ + sr) * LD + sc); sr_[i].vs1 = *reinterpret_cast<const bf16x8*>(Pv + (rb_ + 32 + sr) * LD + sc); \
    sr_[i].ks0 = *reinterpret_cast<const bf16x8*>(Pk + (rb_ + sr) * LD + sc); sr_[i].ks1 = *reinterpret_cast<const bf16x8*>(Pk + (rb_ + 32 + sr) * LD + sc); } while (0)
#define SWRITE(b, i) do { *(bf16x8*)(V_lds + (b) * SHM_V + vst0) = sr_[i].vs0; *(bf16x8*)(V_lds + (b) * SHM_V + vst1) = sr_[i].vs1; const int kc = sc * 2; \
    *(bf16x8*)(K_lds + (b) * SHM_K + KSWZ(sr, kc)) = sr_[i].ks0; *(bf16x8*)(K_lds + (b) * SHM_K + KSWZ(32 + sr, kc)) = sr_[i].ks1; } while (0)
#define SWAIT() asm volatile("s_waitcnt vmcnt(4)" ::: "memory")
#define RESC(a) do { if (__any((a) < 1.f)) { if (hi == 0) al_l[r32] = (a); asm volatile("s_waitcnt lgkmcnt(0)" ::: "memory"); \
    _Pragma("unroll") for (int d = 0; d < NB; ++d) _Pragma("unroll") for (int r = 0; r < 16; ++r) o[d][r] *= al_l[crow(r, hi)]; } } while (0)
#define MASK(P0, P1, t) do { if constexpr (MODE == 1) apply_mask(P0, P1, tm.mtype(t), i0 + r32, tm.key0(t), hi); } while (0)
  f32x16 pA0, pA1, pB0, pB1; float mnA, mnB, alA, alB; bf16x8 pa0, pa1, pa2, pa3;
  constexpr int SE = 0, SO = 1;
  SLOAD(SE, 0); asm volatile("s_waitcnt vmcnt(0)" ::: "memory"); SWRITE(0, SE); __syncthreads();
  qkt(pA0, pA1, K_lds, qr, r32, hi, c); MASK(pA0, pA1, 0); partialSM(pA0, pA1, m_reg, mnA, alA);
  SLOAD(SO, 1); if (2 < NT) SLOAD(SE, 2);
  SWAIT(); SWRITE(1, SO); __syncthreads();
  for (int j = 1; j + 1 < NT; j += 2) {
    SBAR(); qkt(pB0, pB1, K_lds + SHM_K, qr, r32, hi, c);
    finishSM(pA0, pA1, alA, l_reg, pa0, pa1, pa2, pa3); SBAR();
    SLOAD(SO, j + 2); SBAR();
    pv_blocks<NB>(o, vb0, c, pa0, pa1, pa2, pa3); MASK(pB0, pB1, j); partialSM(pB0, pB1, m_reg, mnB, alB);
    __syncthreads(); SWAIT(); SWRITE(0, SE);
    RESC(alB); __syncthreads();
    SBAR(); qkt(pA0, pA1, K_lds, qr, r32, hi, c);
    finishSM(pB0, pB1, alB, l_reg, pa0, pa1, pa2, pa3); SBAR();
    if (j + 3 < NT) SLOAD(SE, j + 3);
    SBAR();
    pv_blocks<NB>(o, vb0 + (int)SHM_V, c, pa0, pa1, pa2, pa3); MASK(pA0, pA1, j + 1); partialSM(pA0, pA1, m_reg, mnA, alA);
    __syncthreads(); SWAIT(); SWRITE(1, SO);
    RESC(alA); __syncthreads();
  }
  SBAR(); qkt(pB0, pB1, K_lds + SHM_K, qr, r32, hi, c);
  finishSM(pA0, pA1, alA, l_reg, pa0, pa1, pa2, pa3); SBAR();
  pv_blocks<NB>(o, vb0, c, pa0, pa1, pa2, pa3); MASK(pB0, pB1, NT - 1); partialSM(pB0, pB1, m_reg, mnB, alB);
  __syncthreads(); RESC(alB);
  finishSM(pB0, pB1, alB, l_reg, pa0, pa1, pa2, pa3); SBAR();
  pv_blocks<NB>(o, vb0 + (int)SHM_V, c, pa0, pa1, pa2, pa3);
  l_out = l_reg;
  asm volatile("s_waitcnt vmcnt(0)" ::: "memory");
  __syncthreads();
#undef SLOAD
#undef SWRITE
#undef SWAIT
#undef RESC
#undef MASK
}

__device__ __forceinline__ void dif_phase(const Params& p, LAS unsigned char* ldsb, int G, int vcu, int tid) {
  const int wid = tid >> 6, lane = tid & 63, r32 = lane & 31, hi = lane >> 5, c = wid >> 2, rg = wid & 3;
  constexpr int NQB = N / 128, NU = B * DIF_H * NQB;
  const float lam = p.scal[0], oscale = p.scal[1];
  for (int L = vcu; L < NU; L += G) {
    const int qb = L % NQB, h = (L / NQB) % DIF_H, b = L / (NQB * DIF_H);
    const int t0 = b * N + qb * 128 + rg * 32;
    TileMap tm; tm.nl = N / 64; tm.tlo = 0; tm.bN = b * N; tm.bC = TL + b * CTX;
    f32x16 o[4]; float l_reg;
    attn_unit<0>(p.P + (size_t)t0 * DIF_IN + h * 128 + c * 64, p.P + DIF_QK + h * 128, p.P + 2 * DIF_QK + h * 128, DIF_IN, tm, (N + CTX) / 64,
                 -1e30f, 0.f, 0, ldsb, o, l_reg, tid);
    char* lds = (char*)ldsb;
    float* ws = (float*)(lds + SHM_WS) + wid * 64;
    float* xb = (float*)lds;
    if (hi == 0) ws[r32] = l_reg;
    asm volatile("s_waitcnt lgkmcnt(0)" ::: "memory");
    float rli[16];
#pragma unroll
    for (int r = 0; r < 16; ++r) rli[r] = __builtin_amdgcn_rcpf(ws[crow(r, hi)]);
    if (c == 1) {
#pragma unroll
      for (int d0 = 0; d0 < 4; ++d0)
#pragma unroll
        for (int r = 0; r < 16; ++r) xb[(rg * 32 + crow(r, hi)) * 128 + d0 * 32 + r32] = o[d0][r] * rli[r];
    }
    __syncthreads();
    if (c == 0) {
      float ss[16];
#pragma unroll
      for (int r = 0; r < 16; ++r) ss[r] = 0.f;
#pragma unroll
      for (int d0 = 0; d0 < 4; ++d0)
#pragma unroll
        for (int r = 0; r < 16; ++r) { const float v = o[d0][r] * rli[r] - lam * xb[(rg * 32 + crow(r, hi)) * 128 + d0 * 32 + r32]; o[d0][r] = v; ss[r] += v * v; }
#pragma unroll
      for (int r = 0; r < 16; ++r) {
#pragma unroll
        for (int sft = 1; sft < 32; sft <<= 1) ss[r] += __shfl_xor(ss[r], sft);
        ss[r] = oscale / sqrtf(ss[r] * (1.f / 128.f) + RMS_EPS); }
#pragma unroll
      for (int d0 = 0; d0 < 4; ++d0) { const float gsub = p.subln_g[d0 * 32 + r32];
#pragma unroll
        for (int r = 0; r < 16; ++r) p.Ymix[(size_t)(t0 + crow(r, hi)) * YW + h * 128 + d0 * 32 + r32] = f2bf(o[d0][r] * ss[r] * gsub); }
    }
    __syncthreads();
  }
}
__device__ __forceinline__ void swa_phase(const Params& p, LAS unsigned char* ldsb, int G, int vcu, int tid) {
  const int wid = tid >> 6, lane = tid & 63, r32 = lane & 31, hi = lane >> 5;
  constexpr int NUL = TL / 32, NUC = TC / 32;
  const float sink_raw = p.sink[wid] * (1.0f / SCALE);
  for (int L = vcu; L < NUL + NUC; L += G) {
    TileMap tm; int t0, NT, i0;
    if (L < NUL) { const int b = L / (N / 32), qb = L % (N / 32); i0 = qb * 32; t0 = b * N + i0;
      const int lo = i0 - SWA_WIN < 0 ? 0 : i0 - SWA_WIN, hi_ = i0 + 31 + SWA_WIN > N - 1 ? N - 1 : i0 + 31 + SWA_WIN;
      tm.tlo = lo / 64; tm.nl = hi_ / 64 - tm.tlo + 1; tm.bN = b * N; tm.bC = TL + b * CTX; NT = (tm.nl + CTX / 64 + 1) & ~1;
    } else { const int Lc = L - NUL, b = Lc / (CTX / 32), qb = Lc % (CTX / 32); i0 = 0; t0 = TL + b * CTX + qb * 32;
      tm.tlo = 0; tm.nl = 0; tm.bN = b * N; tm.bC = TL + b * CTX; NT = CTX / 64; }
    f32x16 o[2]; float l_reg;
    attn_unit<1>(p.P + (size_t)t0 * AB_IN + wid * 64, p.P + A_KOFF, p.P + A_VOFF, AB_IN, tm, NT, sink_raw, 1.f, i0, ldsb, o, l_reg, tid);
    char* lds = (char*)ldsb;
    float* ws = (float*)(lds + SHM_WS) + wid * 64;
    if (hi == 0) ws[r32] = l_reg;
    asm volatile("s_waitcnt lgkmcnt(0)" ::: "memory");
#pragma unroll
    for (int r = 0; r < 16; ++r) { const float rl = __builtin_amdgcn_rcpf(ws[crow(r, hi)]);
#pragma unroll
      for (int d0 = 0; d0 < 2; ++d0) p.Ymix[(size_t)(t0 + crow(r, hi)) * YW + wid * 64 + d0 * 32 + r32] = f2bf(o[d0][r] * rl); }
    __syncthreads();
  }
}
}


constexpr int N_TAB16A = 2 * SSM_G * SSM_P * 17;
__device__ __forceinline__ void st_tab16a(const Params& p, int idx) {
  const int k = idx % 17, q = idx / 17, dg = q / SSM_P;
  const double dt = exp((double)p.log_step[dg]), ar = p.a_re[q], ai = p.a_im[q], mag = exp(k * dt * ar);
  p.apow16[(size_t)idx * 2] = (float)(mag * cos(k * dt * ai)); p.apow16[(size_t)idx * 2 + 1] = (float)(mag * sin(k * dt * ai));
}
constexpr int N_TAB16B = 2 * SSM_G * 16 * 256;
__device__ __forceinline__ void st_tab16b(const Params& p, int idx) {
  const int ci = idx % 16, co = (idx / 16) % 16, lag = (idx / 256) % 16, dg = idx / 4096;
  float acc = 0.f;
  for (int pp = 0; pp < SSM_P; ++pp) { const int q = dg * SSM_P + pp;
    const float ar = p.apow16[((size_t)q * 17 + lag) * 2], ai = p.apow16[((size_t)q * 17 + lag) * 2 + 1];
    const float br = p.bbar[((size_t)q * 16 + ci) * 2], bi = p.bbar[((size_t)q * 16 + ci) * 2 + 1];
    const float cr = p.c_re[((size_t)dg * 16 + co) * SSM_P + pp], cim = p.c_im[((size_t)dg * 16 + co) * SSM_P + pp];
    acc += cr * (ar * br - ai * bi) - cim * (ar * bi + ai * br); }
  p.KT16[idx] = acc;
}
constexpr int N_BTY = 2 * SSM_G * 256 * A2K, N_BTE = 2 * SSM_G * 256 * 256;
__device__ __forceinline__ void st_tab16c(const Params& p, int idx) {
  if (idx < N_BTY) {
    const int k = idx % A2K, n = (idx / A2K) % 256, dg = idx / (A2K * 256); const int j = n / 16, co = n % 16;
    float v;
    if (k < 256) { const int j2 = k / 16, ci = k % 16; v = j2 <= j ? p.KT16[(((size_t)dg * 16 + (j - j2)) * 16 + co) * 16 + ci] : 0.f; }
    else { const int pp = (k - 256) % 64, im = (k - 256) / 64, q = dg * SSM_P + pp;
      const float ar = p.apow16[((size_t)q * 17 + j + 1) * 2], ai = p.apow16[((size_t)q * 17 + j + 1) * 2 + 1];
      const float cr = p.c_re[((size_t)dg * 16 + co) * SSM_P + pp], cim = p.c_im[((size_t)dg * 16 + co) * SSM_P + pp];
      v = im ? -(cr * ai + cim * ar) : (cr * ar - cim * ai); }
    p.BtY[idx] = f2bf(v); return; }
  idx -= N_BTY;
  const int k = idx % 256, n = (idx / 256) % 256, dg = idx / 65536; const int j = k / 16, ci = k % 16;
  float v = 0.f;
  if (n < 128) { const int pp = n % 64, im = n / 64, q = dg * SSM_P + pp;
    const float ar = p.apow16[((size_t)q * 17 + (15 - j)) * 2], ai = p.apow16[((size_t)q * 17 + (15 - j)) * 2 + 1];
    const float br = p.bbar[((size_t)q * 16 + ci) * 2], bi = p.bbar[((size_t)q * 16 + ci) * 2 + 1];
    v = im ? (ar * bi + ai * br) : (ar * br - ai * bi); }
  p.BtE[idx] = f2bf(v);
}
struct SsmOrder {
  int first, count, G, c;
  __device__ __forceinline__ bool next(int i, pg8::Unit& u) const { const int L = i * G + c; if (L >= count) return false; u.pm = first + L; u.pn = u.pm / 5; return true; }
  __device__ __forceinline__ void a_ready(const pg8::Unit&) const {}
  __device__ __forceinline__ void done(const pg8::Unit&) const {}
};
struct EpiE {
  static constexpr bool PERM = false;
  float* E;
  __device__ __forceinline__ void operator()(const f32x4 (&acc)[2][2][4][2], const pg8::Unit& u, int wr, int wc, int fr, int fq) const {
    const int row0 = u.pm * 256 + wr * 64 + fr, col0 = wc * 32 + 4 * fq;
#pragma unroll
    for (int ai = 0; ai < 2; ++ai)
#pragma unroll
      for (int m = 0; m < 4; ++m) { float* rowp = E + (size_t)(row0 + ai * 128 + m * 16) * 128 + col0;
#pragma unroll
        for (int n = 0; n < 2; ++n) *(f32x4*)(rowp + n * 16) = acc[ai][0][m][n]; }
  }
};
template <int DIR> struct EpiY {
  static constexpr bool PERM = false;
  float* Ypart; const bf16_t* P0; const float* dskip; bf16_t* Gs;
  __device__ __forceinline__ void operator()(const f32x4 (&acc)[2][2][4][2], const pg8::Unit& u, int wr, int wc, int fr, int fq) const {
    const int grp = u.pm / 5, g = grp % SSM_G, rg0 = (u.pm % 5) * 256 + wr * 64 + fr;
#pragma unroll
    for (int ai = 0; ai < 2; ++ai)
#pragma unroll
      for (int m = 0; m < 4; ++m) { const int rg = rg0 + ai * 128 + m * 16;
        if (rg < B * NCH16) { const int b = rg / NCH16, ch = rg % NCH16;
#pragma unroll
          for (int bj = 0; bj < 2; ++bj)
#pragma unroll
            for (int n = 0; n < 2; ++n) { const int j = 8 * bj + 2 * wc + n, tau = ch * LC + j;
              const int t = ssm_row(DIR, b, tau); const size_t o = (size_t)t * SSM_W + g * 16 + 4 * fq;
              if (DIR == 0) *(f32x4*)(Ypart + o) = acc[ai][bj][m][n];
              else { const f32x4 y0 = *(const f32x4*)(Ypart + o); const f32x4 dk = *(const f32x4*)(dskip + g * 16 + 4 * fq);
                const u32x2 uu = *(const u32x2*)(P0 + (size_t)t * AB_IN + A_UOFF + g * 16 + 4 * fq);
                f32x4 uv; uv.x = __builtin_bit_cast(float, uu.x << 16); uv.y = __builtin_bit_cast(float, uu.x & 0xffff0000u); uv.z = __builtin_bit_cast(float, uu.y << 16); uv.w = __builtin_bit_cast(float, uu.y & 0xffff0000u);
                const f32x4 y = acc[ai][bj][m][n] + y0 + dk * uv; float gl[4];
#pragma unroll
                for (int q = 0; q < 4; ++q) { const float x = y[q], w = 0.7978845608028654f * (x + 0.044715f * x * x * x); gl[q] = x * fast_sigmoid(2.f * w); }
                const u32x2 wv = {cvt_pk_bf16(gl[0], gl[1]), cvt_pk_bf16(gl[2], gl[3])};
                *(u32x2*)(Gs + o) = wv; } } } }
  }
};
__device__ __forceinline__ void ssm_carry_phase(const Params& p, int bx, int G, int tid) {
  for (int idx = bx * NTHR + tid; idx < 2 * SSM_G * B * SSM_P; idx += G * NTHR) {
    const int pp = idx % SSM_P, b = (idx / SSM_P) % B, dg = idx / (SSM_P * B), q = dg * SSM_P + pp;
    const float ar = p.apow16[((size_t)q * 17 + 16) * 2], ai = p.apow16[((size_t)q * 17 + 16) * 2 + 1];
    float sr = 0.f, si = 0.f;
    const size_t row0 = (size_t)dg * GROWS + (size_t)b * NCH16;
#pragma unroll 8
    for (int ch = 0; ch < NCH16; ++ch) { const size_t row = row0 + ch;
      p.A2[row * A2K + 256 + pp] = f2bf(sr); p.A2[row * A2K + 320 + pp] = f2bf(si);
      const float er = p.E16[row * 128 + pp], ei = p.E16[row * 128 + 64 + pp];
      const float nr = ar * sr - ai * si + er, ni = ar * si + ai * sr + ei; sr = nr; si = ni; }
  }
}

#define XB_TMO      128
#define XB_XCNT(j)  (256  + 64 * (j))
#define XB_XSUB(j)  (1280 + 64 * (j))
#define XB_XGEN(j)  (2304 + 64 * (j))
#define XB_TOP      3328
#define XB_TOPGEN   3392
#define XCD_BAR_WORDS 3456
#define XB_SPIN_CAP (1u << 22)
constexpr int CW_BAR = 4096;
__device__ __forceinline__ unsigned xb_ld(unsigned* p)              { return __hip_atomic_load(p, __ATOMIC_RELAXED, __HIP_MEMORY_SCOPE_AGENT); }
__device__ __forceinline__ unsigned xb_add(unsigned* p, unsigned v) { return __hip_atomic_fetch_add(p, v, __ATOMIC_RELAXED, __HIP_MEMORY_SCOPE_AGENT); }
__device__ __forceinline__ unsigned xb_xcc_id() { return (unsigned)__builtin_amdgcn_s_getreg((3 << 11) | 20) & 0xFu; }
#define XB_SPIN(cond, bar) do { unsigned _sp = 0; while (cond) { __builtin_amdgcn_s_sleep(1); \
    if ((++_sp & 255u) == 0u) { if (xb_ld(&(bar)[XB_TMO])) break; if (_sp > XB_SPIN_CAP) { atomicAdd(&(bar)[XB_TMO], 1u); break; } } } } while (0)
struct XcdBarrier { unsigned* bar; unsigned x; volatile LAS unsigned* st; };
__device__ __forceinline__ XcdBarrier xcd_barrier_post(unsigned* bar, volatile LAS unsigned* st) {
  XcdBarrier b; b.bar = bar; b.x = xb_xcc_id(); b.st = st;
  if (threadIdx.x == 0) (void)xb_add(&bar[XB_XCNT(b.x)], 1u);
  return b;
}
__device__ __forceinline__ void xcd_barrier_complete(unsigned* bar, unsigned x, unsigned& nloc, unsigned& nx) {
  const unsigned G = gridDim.x * gridDim.y * gridDim.z;
  unsigned sum, cnt, mine, sp = 0u;
  for (;;) {
    sum = 0u; cnt = 0u; mine = 0u;
#pragma unroll
    for (unsigned j = 0; j < 16; ++j) { const unsigned c = xb_ld(&bar[XB_XCNT(j)]); sum += c; cnt += (c > 0u) ? 1u : 0u; mine = (j == x) ? c : mine; }
    if (sum == G) break;
    __builtin_amdgcn_s_sleep(1);
    if ((++sp & 255u) == 0u) { if (xb_ld(&bar[XB_TMO])) break; if (sp > XB_SPIN_CAP) { atomicAdd(&bar[XB_TMO], 1u); break; } }
  }
  nloc = mine > 0u ? mine : 1u; nx = cnt > 0u ? cnt : 1u;
}
__device__ __forceinline__ void xcd_barrier(const XcdBarrier& b) {
  asm volatile("s_waitcnt vmcnt(0)" ::: "memory");
  __syncthreads();
  if (threadIdx.x == 0) {
    unsigned* bar = b.bar;
    __builtin_amdgcn_s_waitcnt(0);
    unsigned nloc = b.st[0], nx = b.st[1];
    if (nloc == 0u) { xcd_barrier_complete(bar, b.x, nloc, nx); b.st[0] = nloc; b.st[1] = nx; }
    const unsigned old = xb_add(&bar[XB_XSUB(b.x)], 1u);
    const unsigned gen = old / nloc;
    if (old + 1u == (gen + 1u) * nloc) {
      __builtin_amdgcn_fence(__ATOMIC_RELEASE, "agent");
      asm volatile("s_waitcnt vmcnt(0)" ::: "memory");
      const unsigned og = xb_add(&bar[XB_TOP], 1u);
      const unsigned tg = og / nx;
      if (og + 1u == (tg + 1u) * nx) xb_add(&bar[XB_TOPGEN], 1u);
      else XB_SPIN(xb_ld(&bar[XB_TOPGEN]) == tg, bar);
      __builtin_amdgcn_fence(__ATOMIC_ACQUIRE, "agent");
      xb_add(&bar[XB_XGEN(b.x)], 1u);
      asm volatile("s_waitcnt vmcnt(0)" ::: "memory");
    } else {
      XB_SPIN(xb_ld(&bar[XB_XGEN(b.x)]) == gen, bar);
      __builtin_amdgcn_fence(__ATOMIC_ACQUIRE, "agent");
      asm volatile("s_waitcnt vmcnt(0)" ::: "memory");
    }
  }
  __syncthreads();
}

__device__ __forceinline__ unsigned pk2(float lo, float hi) { return (unsigned)f2bf(lo) | ((unsigned)f2bf(hi) << 16); }
__device__ __forceinline__ void transpose_item(const float* W, int K, int N, bf16_t* WT, int k0, int n0, int dst_row0, LAS float* scr, int lane) {
#pragma unroll 8
  for (int i = 0; i < 32; ++i) { const int kk = 2 * i + (lane >> 5); scr[kk * 33 + (lane & 31)] = W[(size_t)(k0 + kk) * N + n0 + (lane & 31)]; }
  LDS_WAIT(); asm volatile("" ::: "memory");
  const int c = lane & 7;
#pragma unroll
  for (int j = 0; j < 4; ++j) { const int n = (lane >> 3) + 8 * j; const LAS float* s = scr + (8 * c) * 33 + n;
    u32x4 o; o.x = pk2(s[0 * 33], s[1 * 33]); o.y = pk2(s[2 * 33], s[3 * 33]); o.z = pk2(s[4 * 33], s[5 * 33]); o.w = pk2(s[6 * 33], s[7 * 33]);
    *(u32x4*)(WT + (size_t)(dst_row0 + n) * K + k0 + 8 * c) = o; }
  LDS_WAIT(); asm volatile("" ::: "memory");
}
__device__ __forceinline__ void transpose_matrix(const float* W, int K, int N, bf16_t* WT, LAS float* scr, int gw, int ngw, int lane) {
  const int nblk = N / 32, items = (K / 64) * nblk;
  for (int it = gw; it < items; it += ngw) { const int kb = it / nblk, nb = it % nblk; transpose_item(W, K, N, WT, 64 * kb, 32 * nb, 32 * nb, scr, lane); }
}
__device__ __forceinline__ void mod_row_to_bf16(const float* xr, const float* sc, const float* sh, bf16_t* orow, int lane) {
  const f32x4* x4 = (const f32x4*)xr + lane; const f32x4* c4 = (const f32x4*)sc + lane; const f32x4* h4 = (const f32x4*)sh + lane;
  unsigned long long* o8 = (unsigned long long*)orow + lane;
#pragma unroll
  for (int j = 0; j < 4; ++j) { const f32x4 v = x4[64 * j], c = c4[64 * j], h = h4[64 * j];
    const float a = v.x * (1.f + c.x) + h.x, b = v.y * (1.f + c.y) + h.y, cc = v.z * (1.f + c.z) + h.z, d = v.w * (1.f + c.w) + h.w;
    o8[64 * j] = (unsigned long long)pk2(a, b) | ((unsigned long long)pk2(cc, d) << 32); }
}


__device__ __forceinline__ float wave_sum(float v) {
#pragma unroll
  for (int o = 1; o < 64; o <<= 1) v += __shfl_xor(v, o);
  return v;
}
constexpr int CW_CNT = 2048;
__device__ __forceinline__ void ln1_route_row(const Params& p, int layer, int t, int lane) {
  const int r = tok_r(t);
  const f32x4* x4 = (const f32x4*)xrow(p, layer, t) + lane; const f32x4* y4 = (const f32x4*)(p.F + (size_t)t * D) + lane;
  const f32x4* g4 = (const f32x4*)modp(p, layer, r, 2) + lane;
  f32x4 v[4]; float s = 0.f;
#pragma unroll
  for (int j = 0; j < 4; ++j) { v[j] = x4[64 * j] * ALPHA + g4[64 * j] * y4[64 * j]; s += (v[j].x + v[j].y) + (v[j].z + v[j].w); }
  const float mean = wave_sum(s) * (1.f / D); float s2 = 0.f;
#pragma unroll
  for (int j = 0; j < 4; ++j) { v[j] = v[j] - mean; s2 += (v[j].x * v[j].x + v[j].y * v[j].y) + (v[j].z * v[j].z + v[j].w * v[j].w); }
  const float rstd = 1.f / sqrtf(wave_sum(s2) * (1.f / D) + LN_EPS);
  const f32x4* lg4 = (const f32x4*)(p.ln1_g + (size_t)layer * D) + lane; const f32x4* lb4 = (const f32x4*)(p.ln1_b + (size_t)layer * D) + lane;
  const f32x4* sc4 = (const f32x4*)modp(p, layer, r, 4) + lane; const f32x4* sh4 = (const f32x4*)modp(p, layer, r, 3) + lane;
  f32x4* o4 = (f32x4*)(p.X1 + (size_t)t * D) + lane;
#pragma unroll
  for (int j = 0; j < 4; ++j) { v[j] = v[j] * rstd * lg4[64 * j] + lb4[64 * j]; o4[64 * j] = v[j]; v[j] = v[j] * (sc4[64 * j] + 1.f) + sh4[64 * j]; }
  const f32x4* wg4 = (const f32x4*)(p.moe_wg + (size_t)layer * D * MOE_G);
  f32x4 gl = {0.f, 0.f, 0.f, 0.f};
#pragma unroll
  for (int j = 0; j < 4; ++j)
#pragma unroll
    for (int c = 0; c < 4; ++c) gl += wg4[4 * (lane + 64 * j) + c] * v[j][c];
  asm volatile("" ::: "memory");
  float lgv[4];
#pragma unroll
  for (int g = 0; g < 4; ++g) lgv[g] = wave_sum(gl[g]) + p.moe_bg[layer * MOE_G + g];
  int gi = 0; float mx = lgv[0];
#pragma unroll
  for (int g = 1; g < 4; ++g) if (lgv[g] > mx) { mx = lgv[g]; gi = g; }
  float den = 0.f;
#pragma unroll
  for (int g = 0; g < 4; ++g) den += expf(lgv[g] - mx);
  const float gp = 1.0f / den;
  gi = __builtin_amdgcn_readfirstlane(gi);
  const f32x4* we4 = (const f32x4*)(p.moe_we + ((size_t)layer * MOE_G + gi) * D * MOE_EPG);
  f32x4 e0 = {0.f, 0.f, 0.f, 0.f}, e1 = {0.f, 0.f, 0.f, 0.f};
#pragma unroll
  for (int j = 0; j < 4; ++j) {
#pragma unroll
    for (int c = 0; c < 4; ++c) { const int k = 4 * (lane + 64 * j) + c; e0 += we4[2 * k] * v[j][c]; e1 += we4[2 * k + 1] * v[j][c]; }
    asm volatile("" ::: "memory"); }
  float le[8];
#pragma unroll
  for (int e = 0; e < 4; ++e) { le[e] = wave_sum(e0[e]) + p.moe_be[(layer * MOE_G + gi) * MOE_EPG + e]; le[4 + e] = wave_sum(e1[e]) + p.moe_be[(layer * MOE_G + gi) * MOE_EPG + 4 + e]; }
  int i0 = 0; float v0 = le[0];
#pragma unroll
  for (int e = 1; e < 8; ++e) if (le[e] > v0) { v0 = le[e]; i0 = e; }
  int i1 = -1; float v1 = -3e38f;
#pragma unroll
  for (int e = 0; e < 8; ++e) if (e != i0 && le[e] > v1) { v1 = le[e]; i1 = e; }
  if (lane == 0) {
    const float ex = expf(v1 - v0);
    const int ea = gi * MOE_EPG + i0, eb = gi * MOE_EPG + i1;
    const unsigned pa = atomicAdd(p.ctl + CW_CNT + 64 * layer + ea, 1u), pb = atomicAdd(p.ctl + CW_CNT + 64 * layer + eb, 1u);
    float* rt = p.route + (size_t)t * 8;
    rt[0] = (float)ea; rt[1] = (float)eb; rt[2] = gp / (1.0f + ex); rt[3] = gp * ex / (1.0f + ex); rt[4] = (float)pa; rt[5] = (float)pb;
  }
}
__device__ __forceinline__ void scatter_phase(const Params& p, int layer, int T, LAS unsigned char* lds, int gw, int ngw, int lane, int tid) {
  LAS int* off = (LAS int*)lds;
  if (tid == 0) {
    int o = 0, ntile = 0;
    for (int e = 0; e < MOE_E; ++e) { const int c = (int)__hip_atomic_load(p.ctl + CW_CNT + 64 * layer + e, __ATOMIC_RELAXED, __HIP_MEMORY_SCOPE_AGENT);
      off[e] = o; const int nt = (c + 255) >> 8;
      if (blockIdx.x == 0) for (int i = 0; i < nt; ++i) p.moe_meta[1 + ntile + i] = e;
      ntile += nt; o += nt * 256; }
    if (blockIdx.x == 0) p.moe_meta[0] = ntile;
  }
  __syncthreads();
  for (int t = gw; t < T; t += ngw) {
    const int r = tok_r(t);
    const float* rt = p.route + (size_t)t * 8;
    const int ea = (int)rt[0], eb = (int)rt[1]; const float wa = rt[2], wb = rt[3];
    const int sa = off[ea] + (int)rt[4], sb = off[eb] + (int)rt[5];
    const f32x4* x4 = (const f32x4*)(p.X1 + (size_t)t * D) + lane;
    const f32x4* sc4 = (const f32x4*)modp(p, layer, r, 4) + lane; const f32x4* sh4 = (const f32x4*)modp(p, layer, r, 3) + lane;
    unsigned long long* oa = (unsigned long long*)(p.Amoe + (size_t)sa * D) + lane; unsigned long long* ob = (unsigned long long*)(p.Amoe + (size_t)sb * D) + lane;
#pragma unroll
    for (int j = 0; j < 4; ++j) { const f32x4 h = x4[64 * j] * (sc4[64 * j] + 1.f) + sh4[64 * j];
      const unsigned long long w = (unsigned long long)pk2(h.x, h.y) | ((unsigned long long)pk2(h.z, h.w) << 32); oa[64 * j] = w; ob[64 * j] = w; }
    if (lane == 0) { p.gate[sa] = wa; p.gate[sb] = wb; p.tokslot[2 * t] = sa; p.tokslot[2 * t + 1] = sb; }
  }
}
__device__ __forceinline__ void ln2_row(const Params& p, int layer, int t, int lane) {
  const int r = tok_r(t);
  const int sa = p.tokslot[2 * t], sb = p.tokslot[2 * t + 1];
  const f32x4* x4 = (const f32x4*)(p.X1 + (size_t)t * D) + lane; const f32x4* g4 = (const f32x4*)modp(p, layer, r, 5) + lane;
  const u32x2* fa = (const u32x2*)(p.F2 + (size_t)sa * D) + lane; const u32x2* fb = (const u32x2*)(p.F2 + (size_t)sb * D) + lane;
  f32x4 v[4]; float s = 0.f;
#pragma unroll
  for (int j = 0; j < 4; ++j) { const u32x2 a = fa[64 * j], b = fb[64 * j];
    f32x4 f; f.x = __builtin_bit_cast(float, a.x << 16) + __builtin_bit_cast(float, b.x << 16); f.y = __builtin_bit_cast(float, a.x & 0xffff0000u) + __builtin_bit_cast(float, b.x & 0xffff0000u);
    f.z = __builtin_bit_cast(float, a.y << 16) + __builtin_bit_cast(float, b.y << 16); f.w = __builtin_bit_cast(float, a.y & 0xffff0000u) + __builtin_bit_cast(float, b.y & 0xffff0000u);
    v[j] = x4[64 * j] * ALPHA + g4[64 * j] * f; s += (v[j].x + v[j].y) + (v[j].z + v[j].w); }
  const float mean = wave_sum(s) * (1.f / D); float s2 = 0.f;
#pragma unroll
  for (int j = 0; j < 4; ++j) { v[j] = v[j] - mean; s2 += (v[j].x * v[j].x + v[j].y * v[j].y) + (v[j].z * v[j].z + v[j].w * v[j].w); }
  const float rstd = 1.f / sqrtf(wave_sum(s2) * (1.f / D) + LN_EPS);
  const f32x4* lg4 = (const f32x4*)(p.ln2_g + (size_t)layer * D) + lane; const f32x4* lb4 = (const f32x4*)(p.ln2_b + (size_t)layer * D) + lane;
  if (layer == DEPTH - 1) {
    f32x4* o4 = (f32x4*)(p.out + (size_t)t * D) + lane;
#pragma unroll
    for (int j = 0; j < 4; ++j) o4[64 * j] = v[j] * rstd * lg4[64 * j] + lb4[64 * j];
  } else {
    f32x4* o4 = (f32x4*)(p.X + (size_t)t * D) + lane;
    const f32x4* sc4 = (const f32x4*)modp(p, layer + 1, r, 1) + lane; const f32x4* sh4 = (const f32x4*)modp(p, layer + 1, r, 0) + lane;
    unsigned long long* h8 = (unsigned long long*)(p.H + (size_t)t * D) + lane;
#pragma unroll
    for (int j = 0; j < 4; ++j) { const f32x4 o = v[j] * rstd * lg4[64 * j] + lb4[64 * j]; o4[64 * j] = o;
      const f32x4 h = o * (sc4[64 * j] + 1.f) + sh4[64 * j];
      h8[64 * j] = (unsigned long long)pk2(h.x, h.y) | ((unsigned long long)pk2(h.z, h.w) << 32); }
  }
}
__device__ __forceinline__ void moe_weight_transposes(const Params& p, int layer, LAS float* scr, int gw, int ngw, int lane) {
  constexpr int I13 = (D / 64) * (MOE_F / 32), I2 = (MOE_F / 64) * (D / 32);
  constexpr int NIT = MOE_E * (2 * I13 + I2);
  for (int it = gw; it < NIT; it += ngw) {
    const int e = it / (2 * I13 + I2); int r = it % (2 * I13 + I2);
    if (r < 2 * I13) { const int which = r / I13; r %= I13; const int kb = r / (MOE_F / 32), nb = r % (MOE_F / 32), n0 = 32 * nb;
      const float* W = (which ? p.moe_w3 : p.moe_w1) + ((size_t)layer * MOE_E + e) * D * MOE_F;
      transpose_item(W, D, MOE_F, p.W13t, 64 * kb, n0, e * 2 * MOE_F + (n0 / 128) * 256 + which * 128 + (n0 % 128), scr, lane);
    } else { r -= 2 * I13; const int kb = r / (D / 32), nb = r % (D / 32);
      const float* W = p.moe_w2 + ((size_t)layer * MOE_E + e) * MOE_F * D;
      transpose_item(W, MOE_F, D, p.W2t, 64 * kb, 32 * nb, e * D + 32 * nb, scr, lane); }
  }
}

__global__ void __launch_bounds__(NTHR, 2) mega_kernel(Params p_by_value) {
  const Params& p = *(const Params*)__builtin_amdgcn_kernarg_segment_ptr();
  extern __shared__ __attribute__((aligned(16))) unsigned char lds_raw[];
  LAS unsigned char* lds = (LAS unsigned char*)lds_raw;
  volatile LAS unsigned* MISC = (volatile LAS unsigned*)(lds + MISC_OFF);
  for (int u = threadIdx.x; u < (LDS_BYTES - LDSCTL_OFF) / 4; u += NTHR) ((LAS unsigned*)(lds + LDSCTL_OFF))[u] = 0u;
  __syncthreads();
  XcdBarrier bar = xcd_barrier_post(p.ctl + CW_BAR, MISC + 8);
#define PH_VARS                                                                                                       \
  int tid = threadIdx.x; asm volatile("" : "+v"(tid));                                                                \
  int bx = blockIdx.x; asm volatile("" : "+s"(bx));                                                                   \
  const int lane = tid & 63, wave = __builtin_amdgcn_readfirstlane(tid >> 6), G = gridDim.x;                          \
  const int vcu = (G % 8 == 0) ? (bx % 8) * (G / 8) + bx / 8 : bx;                                                    \
  const int gw = vcu * NWAVES + wave, ngw = G * NWAVES;                                                               \
  LAS float* scr = (LAS float*)(lds + wave * 16384);                                                                  \
  (void)lane; (void)gw; (void)ngw; (void)scr; (void)vcu;
#define GRID_BAR() xcd_barrier(bar)
#define RUN_NAIVE(S, layer, cnt)                                                                                  \
  {                                                                                                               \
    const int n_ = (cnt);                                                                                         \
    PH_VARS                                                                                                       \
    for (int idx = bx * NTHR + tid; idx < n_; idx += G * NTHR) run_elem<S>(p, layer, idx);                        \
  }

  RUN_NAIVE(S_MOD, 0, N_MOD)
  RUN_NAIVE(S_TABA, 0, N_TABA)
  { PH_VARS for (int idx = bx * NTHR + tid; idx < N_TAB16A; idx += G * NTHR) st_tab16a(p, idx); }
  { PH_VARS
  transpose_matrix(p.w_in_a, D, AB_IN, p.WinA_t, scr, gw, ngw, lane);
  transpose_matrix(p.dif_w_in, D, DIF_IN, p.DifIn_t, scr, gw, ngw, lane);
  transpose_matrix(p.w_out_a, AB_OUT, D, p.WoutA_t, scr, gw, ngw, lane);
  transpose_matrix(p.dif_w_out, DIF_VW, D, p.DifOut_t, scr, gw, ngw, lane);
  transpose_matrix(p.glu_w, SSM_W, SSM_W, p.Glu_t, scr, gw, ngw, lane);
  moe_weight_transposes(p, 0, scr, gw, ngw, lane); }
  GRID_BAR();
  { PH_VARS for (int idx = bx * NTHR + tid; idx < N_TAB16B; idx += G * NTHR) st_tab16b(p, idx); }
  { PH_VARS for (int m = gw; m < TA; m += ngw) { const int r = tok_r(m); mod_row_to_bf16(xrow(p, 0, m), modp(p, 0, r, 1), modp(p, 0, r, 0), p.H + (size_t)m * D, lane); } }
  GRID_BAR();
#define PROJ_GEMM(NW_, WT_, ROPE_END_, A2_)                                                                                  \
  { PH_VARS                                                                                                             \
    pg8::Gemm g{p.H, WT_, D, D, D};                                                                                     \
    pg8::StaticOrder S; S.init(TA, NW_, G, bx);                                                            \
    EpiProj E{p.P, NW_, ROPE_END_, p.ropeT, A2_};                                                                            \
    pg8::gemm_phase<EpiProj, pg8::StaticOrder>(lds, g, S, E);                                                           \
  }                                                                                                                     \
  GRID_BAR();
#define LAYER_BACK(layer, T, WOT_, KO_)                                                                                 \
  { PH_VARS                                                                            \
    pg8::Gemm g{p.Ymix, WOT_, YW, KO_, KO_};                                                                            \
    pg8::StaticOrder S; S.init(T, D, G, bx);                                                               \
    EpiF32Out E{p.F, D};                                                                                                \
    pg8::gemm_phase<EpiF32Out, pg8::StaticOrder>(lds, g, S, E);                                                         \
  }                                                                                                                     \
  GRID_BAR();                                                                                                           \
  { PH_VARS for (int t = gw; t < T; t += ngw) ln1_route_row(p, layer, t, lane); }                                      \
  GRID_BAR();                                                                                                           \
  { PH_VARS scatter_phase(p, layer, T, lds, gw, ngw, lane, tid); }                                                      \
  GRID_BAR();                                                                                                           \
  { PH_VARS                                                             \
    pg8::Gemm g{p.Amoe, p.W13t, D, D, D};                                                                               \
    MoeOrder S{p.moe_meta, 2, G, vcu};                                                                                  \
    EpiMoe1 E{p.HHb, p.gate};                                                                                           \
    pg8::gemm_phase<EpiMoe1, MoeOrder>(lds, g, S, E);                                                                   \
  }                                                                                                                     \
  GRID_BAR();                                                                                                           \
  { PH_VARS                                                                                  \
    pg8::Gemm g{p.HHb, p.W2t, MOE_F, MOE_F, MOE_F};                                                                     \
    MoeOrder S{p.moe_meta, 4, G, vcu};                                                                                  \
    EpiBf16Out E{p.F2, D, 4};                                                                                           \
    pg8::gemm_phase<EpiBf16Out, MoeOrder>(lds, g, S, E);                                                                \
  }                                                                                                                     \
  GRID_BAR();                                                                                                           \
  { PH_VARS for (int t = gw; t < T; t += ngw) ln2_row(p, layer, t, lane); }

  { PH_VARS for (int idx = bx * NTHR + tid; idx < N_BTY + N_BTE; idx += G * NTHR) st_tab16c(p, idx); }
  PROJ_GEMM(AB_IN, p.WinA_t, (SWA_QW + SWA_KVW), p.A2)
  { PH_VARS att::swa_phase(p, lds, G, vcu, tid); }
  { PH_VARS
    pg8::Gemm g{p.A2, p.BtE, A2K, 256, 256};
    SsmOrder S{0, 2 * SSM_G * 5, G, vcu};
    EpiE E{p.E16};
    pg8::gemm_phase<EpiE, SsmOrder>(lds, g, S, E);
  }
  GRID_BAR();
  { PH_VARS ssm_carry_phase(p, bx, G, tid); }
  GRID_BAR();
  { PH_VARS
    pg8::Gemm g{p.A2, p.BtY, A2K, A2K, A2K};
    SsmOrder S{0, SSM_G * 5, G, vcu};
    EpiY<0> E{p.Ypart, p.P, p.ssm_d, p.Gs};
    pg8::gemm_phase<EpiY<0>, SsmOrder>(lds, g, S, E);
  }
  GRID_BAR();
  { PH_VARS
    pg8::Gemm g{p.A2, p.BtY, A2K, A2K, A2K};
    SsmOrder S{SSM_G * 5, SSM_G * 5, G, vcu};
    EpiY<1> E{p.Ypart, p.P, p.ssm_d, p.Gs};
    pg8::gemm_phase<EpiY<1>, SsmOrder>(lds, g, S, E);
  }
  GRID_BAR();
  { PH_VARS
    pg8::Gemm g{p.Gs, p.Glu_t, SSM_W, SSM_W, SSM_W};
    pg8::StaticOrder S; S.init(TA, SSM_W, G, bx);
    EpiGlu E{p.Gs, p.glu_b, p.Ymix, YW, SWA_QW};
    pg8::gemm_phase<EpiGlu, pg8::StaticOrder>(lds, g, S, E);
  }
  GRID_BAR();
  LAYER_BACK(0, TA, p.WoutA_t, AB_OUT)
  { PH_VARS moe_weight_transposes(p, 1, scr, gw, ngw, lane); }
  GRID_BAR();
  PROJ_GEMM(DIF_IN, p.DifIn_t, (2 * DIF_QK), nullptr)
  { PH_VARS att::dif_phase(p, lds, G, vcu, tid); }
  GRID_BAR();
  LAYER_BACK(1, TL, p.DifOut_t, DIF_VW)
}

extern "C" void kernel_launch(void* const* d_in, const int* in_sizes, int n_in, void* d_out, int out_size, void* d_ws,
                              size_t ws_size, hipStream_t stream) {
  static int grid = 0;
  if (grid == 0) {
    if (ws_layout().total > ws_size || n_in != 37 || out_size != TL * D) { fprintf(stderr, "kernel_launch: bad sizes (ws need %zu have %zu)\n", ws_layout().total, ws_size); grid = -1; return; }
    int dev = 0, cus = 0;
    if (hipGetDevice(&dev) != hipSuccess || hipDeviceGetAttribute(&cus, hipDeviceAttributeMultiprocessorCount, dev) != hipSuccess) { grid = -1; return; }
    if (hipFuncSetAttribute((const void*)mega_kernel, hipFuncAttributeMaxDynamicSharedMemorySize, LDS_BYTES) != hipSuccess) { fprintf(stderr, "kernel_launch: hipFuncSetAttribute failed\n"); grid = -1; return; }
    grid = cus;
  }
  if (grid < 0) return;
  Params p{};
  fill_inputs(p, d_in);
  p.out = (float*)d_out;
  fill_ws(p, (char*)d_ws);
  if (hipMemsetAsync((char*)d_ws + ws_layout().ctl, 0, CTL_BYTES, stream) != hipSuccess) { fprintf(stderr, "kernel_launch: memset failed\n"); return; }
  hipLaunchKernelGGL(mega_kernel, dim3(grid), dim3(NTHR), LDS_BYTES, stream, p);
  const hipError_t le = hipPeekAtLastError();
  if (le != hipSuccess) fprintf(stderr, "kernel_launch: launch failed: %s\n", hipGetErrorName(le));
}
#endif
```

```cpp
#ifndef HOST_EMU
#include <hip/hip_runtime.h>
#define HD __host__ __device__ __forceinline__
#else
#define HD inline
#endif
#include <stdint.h>
#include <math.h>

#ifndef CFG_D
#define CFG_D 1024
#define CFG_B 8
#define CFG_N 2048
#define CFG_CTX 256
#endif

constexpr int D = CFG_D, B = CFG_B, N = CFG_N, CTX = CFG_CTX;
constexpr int DEPTH = 2, GRID_W = 64, HD_ = 64;
constexpr int TL = B * N, TC = B * CTX, TA = TL + TC;
constexpr int SWA_H = 8, SWA_QW = 512, SWA_KVW = 128, SWA_WIN = 128;
constexpr int SSM_W = D / 2, SSM_C = 16, SSM_G = SSM_W / 16, SSM_P = 64;
constexpr int AB_IN = SWA_QW + 2 * SWA_KVW + SSM_W;
constexpr int AB_OUT = SWA_QW + SSM_W;
constexpr int A_KOFF = SWA_QW, A_VOFF = SWA_QW + SWA_KVW, A_UOFF = SWA_QW + 2 * SWA_KVW;
constexpr int DIF_H = D / 128, DIF_QK = DIF_H * 128, DIF_VW = DIF_H * 128, DIF_IN = 2 * DIF_QK + DIF_VW;
constexpr int MOE_G = 4, MOE_EPG = 8, MOE_E = 32, MOE_F = D / 4;
constexpr int SL = 64;
constexpr int SS = CTX + N;
constexpr int NCH = SS / SL;
constexpr float LN_EPS = 1e-5f, RMS_EPS = 1e-5f;
constexpr float ALPHA = 1.41421356237309515f;
static_assert(CTX % SL == 0 && N % SL == 0, "chunking");
constexpr int YW = AB_OUT > D ? AB_OUT : D;

struct Params {
  const float *x, *c, *ctx, *c_ctx, *mod_w, *mod_b, *ln1_g, *ln1_b, *ln2_g, *ln2_b;
  const float *w_in_a, *w_out_a, *sink, *a_re, *a_im, *log_step, *b_re, *b_im, *c_re, *c_im, *ssm_d, *glu_w, *glu_b;
  const float *dif_w_in, *dif_w_out, *lq1, *lk1, *lq2, *lk2, *subln_g;
  const float *moe_wg, *moe_bg, *moe_we, *moe_be, *moe_w1, *moe_w3, *moe_w2;
  float* out;
  float *X, *X1, *F, *HH;
  uint16_t *P, *Ymix, *Gs;
  float *modv, *ropeT, *apow, *bbar, *KT, *E, *Sin, *route, *scal;
  uint16_t *H;
  uint16_t *WinA_t, *DifIn_t, *WoutA_t, *DifOut_t, *Glu_t, *W13t, *W2t;
  uint16_t *Amoe, *HHb, *F2;
  float* gate;
  int *tokslot, *moe_meta;
  uint16_t *A2, *BtY, *BtE;
  float *apow16, *KT16, *E16, *Ypart;
  unsigned* ctl;
};

HD uint16_t f2bf(float f) {
  uint32_t u = __builtin_bit_cast(uint32_t, f);
  u += 0x7fffu + ((u >> 16) & 1u);
  return (uint16_t)(u >> 16);
}
HD float bf2f(uint16_t h) {
  uint32_t u = ((uint32_t)h) << 16;
  return __builtin_bit_cast(float, u);
}
HD float siluf(float x) { return x / (1.0f + expf(-x)); }
HD float sigmoidf_(float x) { return 1.0f / (1.0f + expf(-x)); }
HD float geluf_(float x) { return 0.5f * x * (1.0f + tanhf(0.7978845608028654f * (x + 0.044715f * x * x * x))); }

HD int tok_r(int t) { return t < TL ? t / N : B; }
HD const float* xrow(const Params& p, int layer, int t) {
  if (layer == 0) return t < TL ? p.x + (size_t)t * D : p.ctx + (size_t)(t - TL) * D;
  return p.X + (size_t)t * D;
}
HD const float* modp(const Params& p, int layer, int r, int which) {
  return p.modv + ((size_t)(layer * (B + 1) + r) * 6 + which) * D;
}

constexpr int N_MOD = DEPTH * (B + 1) * 6 * D;
HD void st_mod(const Params& p, int layer_unused, int idx) {
  int j = idx % (6 * D); int r = (idx / (6 * D)) % (B + 1); int l = idx / (6 * D * (B + 1));
  const float* cv = r < B ? p.c + (size_t)r * D : p.c_ctx;
  const float* w = p.mod_w + (size_t)l * D * 6 * D;
  float acc = p.mod_b[(size_t)l * 6 * D + j];
  for (int k = 0; k < D; ++k) acc += siluf(cv[k]) * w[(size_t)k * 6 * D + j];
  p.modv[idx] = acc;
}

constexpr int N_ROPE = 64 * 16;
constexpr int N_APOW = 2 * SSM_G * SSM_P * (SL + 1);
constexpr int N_BBAR = 2 * SSM_G * SSM_P * SSM_C;
constexpr int N_TABA = N_ROPE + N_APOW + N_BBAR + 1;
HD void st_taba(const Params& p, int layer_unused, int idx) {
  if (idx < N_ROPE) {
    int pos = idx / 16, f = idx % 16;
    float inv = powf(10000.0f, -(float)f / 16.0f);
    float ang = (float)pos * inv;
    p.ropeT[idx * 2] = cosf(ang); p.ropeT[idx * 2 + 1] = sinf(ang);
    return;
  }
  idx -= N_ROPE;
  if (idx < N_APOW) {
#ifndef HOST_EMU
    return;
#endif
    int k = idx % (SL + 1); int q = idx / (SL + 1);
    int dg = q / SSM_P;
    double dt = exp((double)p.log_step[dg]);
    double ar = p.a_re[q], ai = p.a_im[q];
    double mag = exp(k * dt * ar);
    p.apow[(size_t)idx * 2] = (float)(mag * cos(k * dt * ai));
    p.apow[(size_t)idx * 2 + 1] = (float)(mag * sin(k * dt * ai));
    return;
  }
  idx -= N_APOW;
  if (idx < N_BBAR) {
    int cc = idx % SSM_C; int q = idx / SSM_C; int dg = q / SSM_P;
    (void)cc;
    double dt = exp((double)p.log_step[dg]);
    double ar = p.a_re[q], ai = p.a_im[q];
    double mag = exp(dt * ar);
    double abr = mag * cos(dt * ai), abi = mag * sin(dt * ai);
    double den = ar * ar + ai * ai, nr = abr - 1.0;
    double cr = (nr * ar + abi * ai) / den, ci = (abi * ar - nr * ai) / den;
    double br = p.b_re[idx], bi = p.b_im[idx];
    p.bbar[(size_t)idx * 2] = (float)(cr * br - ci * bi);
    p.bbar[(size_t)idx * 2 + 1] = (float)(cr * bi + ci * br);
    return;
  }
  double s1 = 0, s2 = 0;
  for (int i = 0; i < HD_; ++i) { s1 += (double)p.lq1[i] * p.lk1[i]; s2 += (double)p.lq2[i] * p.lk2[i]; }
  double lam_init = 0.8 - 0.6 * exp(-0.3 * 1.0);
  p.scal[0] = (float)(exp(s1) - exp(s2) + lam_init);
  p.scal[1] = (float)(1.0 - lam_init);
}

constexpr int N_KT = 2 * SSM_G * SL * SSM_C * SSM_C;
HD void st_tabb(const Params& p, int layer_unused, int idx) {
  int ci = idx % SSM_C; int co = (idx / SSM_C) % SSM_C; int k = (idx / (SSM_C * SSM_C)) % SL; int dg = idx / (SSM_C * SSM_C * SL);
  float acc = 0.f;
  for (int pp = 0; pp < SSM_P; ++pp) {
    int q = dg * SSM_P + pp;
    float ar = p.apow[((size_t)q * (SL + 1) + k) * 2], ai = p.apow[((size_t)q * (SL + 1) + k) * 2 + 1];
    float br = p.bbar[((size_t)q * SSM_C + ci) * 2], bi = p.bbar[((size_t)q * SSM_C + ci) * 2 + 1];
    float cr = p.c_re[((size_t)dg * SSM_C + co) * SSM_P + pp], cim = p.c_im[((size_t)dg * SSM_C + co) * SSM_P + pp];
    float tr = ar * br - ai * bi, ti = ar * bi + ai * br;
    acc += cr * tr - cim * ti;
  }
  p.KT[idx] = acc;
}

HD void st_proj(const Params& p, int layer, int idx) {
  const int W = layer == 0 ? AB_IN : DIF_IN;
  const float* w = layer == 0 ? p.w_in_a : p.dif_w_in;
  const int rope_end = layer == 0 ? (SWA_QW + SWA_KVW) : (2 * DIF_QK);
  int t = idx / W, n = idx % W;
  int r = tok_r(t);
  if (layer == 1 && t >= TL && n < DIF_QK) return;
  const float* xr = xrow(p, layer, t);
  const float* sh = modp(p, layer, r, 0);
  const float* sc = modp(p, layer, r, 1);
  bool rope = (t < TL) && (n < rope_end);
  if (!rope) {
    float acc = 0.f;
    for (int k = 0; k < D; ++k) { float h = xr[k] * (1.0f + sc[k]) + sh[k]; acc += h * w[(size_t)k * W + n]; }
    p.P[(size_t)t * W + n] = f2bf(acc);
    return;
  }
  int d = n % 64, sub = d % 32;
  if (sub >= 16) return;
  float a1 = 0.f, a2 = 0.f;
  for (int k = 0; k < D; ++k) {
    float h = xr[k] * (1.0f + sc[k]) + sh[k];
    a1 += h * w[(size_t)k * W + n]; a2 += h * w[(size_t)k * W + n + 16];
  }
  int i = t % N;
  int pos = d < 32 ? i / GRID_W : i % GRID_W;
  float cs = p.ropeT[(pos * 16 + sub) * 2], sn = p.ropeT[(pos * 16 + sub) * 2 + 1];
  p.P[(size_t)t * W + n] = f2bf(a1 * cs - a2 * sn);
  p.P[(size_t)t * W + n + 16] = f2bf(a2 * cs + a1 * sn);
}

HD void st_swa(const Params& p, int layer, int idx) {
  int hq = idx / TA, t = idx % TA;
  int kvh = hq / 4;
  const uint16_t* P = p.P;
  float q[64], o[64];
  _Pragma("unroll") for (int d = 0; d < 64; ++d) { q[d] = bf2f(P[(size_t)t * AB_IN + hq * 64 + d]) * 0.125f; o[d] = 0.f; }
  float m = p.sink[hq], l = 1.0f;
  int b = t < TL ? t / N : (t - TL) / CTX;
  int nloc = t < TL ? 2 * SWA_WIN + 1 : 0;
  int i = t < TL ? t % N : 0;
  for (int kk = 0; kk < nloc + CTX; ++kk) {
    int row;
    if (kk < nloc) {
      int j = i - SWA_WIN + kk;
      if (j < 0 || j >= N) continue;
      row = b * N + j;
    } else row = TL + b * CTX + (kk - nloc);
    const uint16_t* kr = P + (size_t)row * AB_IN + A_KOFF + kvh * 64;
    const uint16_t* vr = P + (size_t)row * AB_IN + A_VOFF + kvh * 64;
    float s = 0.f;
    _Pragma("unroll") for (int d = 0; d < 64; ++d) s += q[d] * bf2f(kr[d]);
    if (s > m) { float f = expf(m - s); l *= f; for (int d = 0; d < 64; ++d) o[d] *= f; m = s; }
    float pe = expf(s - m);
    l += pe;
    _Pragma("unroll") for (int d = 0; d < 64; ++d) o[d] += pe * bf2f(vr[d]);
  }
  float il = 1.0f / l;
  _Pragma("unroll") for (int d = 0; d < 64; ++d) p.Ymix[(size_t)t * YW + hq * 64 + d] = f2bf(o[d] * il);
}

HD int ssm_row(int dir, int b, int tau) {
  if (dir == 0) return tau < CTX ? TL + b * CTX + tau : b * N + (tau - CTX);
  return tau < CTX ? TL + b * CTX + (CTX - 1 - tau) : b * N + (N - 1 - (tau - CTX));
}
constexpr int N_SSME = 2 * B * NCH * SSM_G * SSM_P;
HD void st_ssm_e(const Params& p, int layer, int idx) {
  int pp = idx % SSM_P; int g = (idx / SSM_P) % SSM_G; int ch = (idx / (SSM_P * SSM_G)) % NCH;
  int b = (idx / (SSM_P * SSM_G * NCH)) % B; int dir = idx / (SSM_P * SSM_G * NCH * B);
  int q = (dir * SSM_G + g) * SSM_P + pp;
  float er = 0.f, ei = 0.f;
  for (int j = 0; j < SL; ++j) {
    int row = ssm_row(dir, b, ch * SL + j);
    const uint16_t* u = p.P + (size_t)row * AB_IN + A_UOFF + g * 16;
    float vr = 0.f, vi = 0.f;
    _Pragma("unroll") for (int cc = 0; cc < 16; ++cc) {
      float uv = bf2f(u[cc]);
      vr += p.bbar[((size_t)q * 16 + cc) * 2] * uv; vi += p.bbar[((size_t)q * 16 + cc) * 2 + 1] * uv;
    }
    float ar = p.apow[((size_t)q * (SL + 1) + (SL - 1 - j)) * 2], ai = p.apow[((size_t)q * (SL + 1) + (SL - 1 - j)) * 2 + 1];
    er += ar * vr - ai * vi; ei += ar * vi + ai * vr;
  }
  p.E[(size_t)idx * 2] = er; p.E[(size_t)idx * 2 + 1] = ei;
}
constexpr int N_SSMC = 2 * B * SSM_G * SSM_P;
HD void st_ssm_c(const Params& p, int layer, int idx) {
  int pp = idx % SSM_P; int g = (idx / SSM_P) % SSM_G; int b = (idx / (SSM_P * SSM_G)) % B; int dir = idx / (SSM_P * SSM_G * B);
  int q = (dir * SSM_G + g) * SSM_P + pp;
  float ar = p.apow[((size_t)q * (SL + 1) + SL) * 2], ai = p.apow[((size_t)q * (SL + 1) + SL) * 2 + 1];
  float sr = 0.f, si = 0.f;
  for (int ch = 0; ch < NCH; ++ch) {
    size_t e = ((((size_t)dir * B + b) * NCH + ch) * SSM_G + g) * SSM_P + pp;
    p.Sin[e * 2] = sr; p.Sin[e * 2 + 1] = si;
    float er = p.E[e * 2], ei = p.E[e * 2 + 1];
    float nr = ar * sr - ai * si + er, ni = ar * si + ai * sr + ei;
    sr = nr; si = ni;
  }
}
HD void st_ssm_o(const Params& p, int layer, int idx) {
  int t = idx / SSM_W, n = idx % SSM_W; int g = n / 16, co = n % 16;
  int b, dirtau[2];
  if (t < TL) { b = t / N; int i = t % N; dirtau[0] = CTX + i; dirtau[1] = CTX + (N - 1 - i); }
  else { b = (t - TL) / CTX; int i = (t - TL) % CTX; dirtau[0] = i; dirtau[1] = CTX - 1 - i; }
  float y = p.ssm_d[n] * bf2f(p.P[(size_t)t * AB_IN + A_UOFF + n]);
  for (int dir = 0; dir < 2; ++dir) {
    int tau = dirtau[dir]; int ch = tau / SL, j = tau % SL;
    int dg = dir * SSM_G + g;
    size_t e0 = ((((size_t)dir * B + b) * NCH + ch) * SSM_G + g) * SSM_P;
    for (int pp = 0; pp < SSM_P; ++pp) {
      int q = dg * SSM_P + pp;
      float ar = p.apow[((size_t)q * (SL + 1) + (j + 1)) * 2], ai = p.apow[((size_t)q * (SL + 1) + (j + 1)) * 2 + 1];
      float sr = p.Sin[(e0 + pp) * 2], si = p.Sin[(e0 + pp) * 2 + 1];
      float tr = ar * sr - ai * si, ti = ar * si + ai * sr;
      float cr = p.c_re[((size_t)dg * 16 + co) * SSM_P + pp], cim = p.c_im[((size_t)dg * 16 + co) * SSM_P + pp];
      y += cr * tr - cim * ti;
    }
    for (int j2 = 0; j2 <= j; ++j2) {
      int row = ssm_row(dir, b, ch * SL + j2);
      const uint16_t* u = p.P + (size_t)row * AB_IN + A_UOFF + g * 16;
      const float* kt = p.KT + (((size_t)dg * SL + (j - j2)) * 16 + co) * 16;
      _Pragma("unroll") for (int ci = 0; ci < 16; ++ci) y += kt[ci] * bf2f(u[ci]);
    }
  }
  p.Gs[(size_t)t * SSM_W + n] = f2bf(geluf_(y));
}
HD void st_glu(const Params& p, int layer, int idx) {
  int t = idx / SSM_W, n = idx % SSM_W;
  float z = p.glu_b[n];
  const uint16_t* g = p.Gs + (size_t)t * SSM_W;
  for (int k = 0; k < SSM_W; ++k) z += bf2f(g[k]) * p.glu_w[(size_t)k * SSM_W + n];
  p.Ymix[(size_t)t * YW + SWA_QW + n] = f2bf(bf2f(g[n]) * sigmoidf_(z));
}

HD void st_dif(const Params& p, int layer, int idx) {
  int t = idx % TL; int he = idx / TL; int eh = he % 2, h = he / 2;
  int b = t / N;
  const uint16_t* P = p.P;
  float res[64];
  float lam = p.scal[0];
  _Pragma("unroll") for (int c = 0; c < 2; ++c) {
    float q[64], o[64];
    _Pragma("unroll") for (int d = 0; d < 64; ++d) { q[d] = bf2f(P[(size_t)t * DIF_IN + h * 128 + c * 64 + d]) * 0.125f; o[d] = 0.f; }
    float m = -1e30f, l = 0.f;
    for (int kk = 0; kk < N + CTX; ++kk) {
      int row = kk < N ? b * N + kk : TL + b * CTX + (kk - N);
      const uint16_t* kr = P + (size_t)row * DIF_IN + DIF_QK + h * 128 + c * 64;
      const uint16_t* vr = P + (size_t)row * DIF_IN + 2 * DIF_QK + h * 128 + eh * 64;
      float s = 0.f;
      _Pragma("unroll") for (int d = 0; d < 64; ++d) s += q[d] * bf2f(kr[d]);
      if (s > m) { float f = expf(m - s); l *= f; for (int d = 0; d < 64; ++d) o[d] *= f; m = s; }
      float pe = expf(s - m);
      l += pe;
      _Pragma("unroll") for (int d = 0; d < 64; ++d) o[d] += pe * bf2f(vr[d]);
    }
    float il = 1.0f / l;
    if (c == 0) { for (int d = 0; d < 64; ++d) res[d] = o[d] * il; }
    else { for (int d = 0; d < 64; ++d) res[d] -= lam * o[d] * il; }
  }
  _Pragma("unroll") for (int d = 0; d < 64; ++d) p.Ymix[(size_t)t * YW + h * 128 + eh * 64 + d] = f2bf(res[d]);
}
HD void st_difnorm(const Params& p, int layer, int idx) {
  int t = idx / DIF_H, h = idx % DIF_H;
  uint16_t* o = p.Ymix + (size_t)t * YW + h * 128;
  float ss = 0.f;
  for (int e = 0; e < 128; ++e) { float v = bf2f(o[e]); ss += v * v; }
  float r = 1.0f / sqrtf(ss / 128.0f + RMS_EPS) * p.scal[1];
  _Pragma("unroll 8") for (int e = 0; e < 128; ++e) o[e] = f2bf(bf2f(o[e]) * r * p.subln_g[e]);
}

HD void st_outproj(const Params& p, int layer, int idx) {
  int t = idx / D, n = idx % D;
  const float* w = layer == 0 ? p.w_out_a : p.dif_w_out;
  const uint16_t* y = p.Ymix + (size_t)t * YW;
  const int KW = layer == 0 ? AB_OUT : DIF_VW;
  float acc = 0.f;
  for (int k = 0; k < KW; ++k) acc += bf2f(y[k]) * w[(size_t)k * D + n];
  p.F[(size_t)t * D + n] = acc;
}
HD void st_ln1(const Params& p, int layer, int t) {
  int r = tok_r(t);
  const float* xr = xrow(p, layer, t); const float* g1 = modp(p, layer, r, 2);
  const float* y = p.F + (size_t)t * D;
  float mu = 0.f;
  for (int k = 0; k < D; ++k) mu += ALPHA * xr[k] + g1[k] * y[k];
  mu /= D;
  float var = 0.f;
  for (int k = 0; k < D; ++k) { float v = ALPHA * xr[k] + g1[k] * y[k] - mu; var += v * v; }
  var /= D;
  float rs = 1.0f / sqrtf(var + LN_EPS);
  const float* lg = p.ln1_g + (size_t)layer * D; const float* lb = p.ln1_b + (size_t)layer * D;
  for (int k = 0; k < D; ++k) p.X1[(size_t)t * D + k] = (ALPHA * xr[k] + g1[k] * y[k] - mu) * rs * lg[k] + lb[k];
}
HD void st_route(const Params& p, int layer, int t) {
  int r = tok_r(t);
  const float* x1 = p.X1 + (size_t)t * D; const float* sh = modp(p, layer, r, 3); const float* sc = modp(p, layer, r, 4);
  float lg[MOE_G];
  _Pragma("unroll") for (int g = 0; g < MOE_G; ++g) lg[g] = p.moe_bg[layer * MOE_G + g];
  const float* wg = p.moe_wg + (size_t)layer * D * MOE_G;
  for (int k = 0; k < D; ++k) {
    float h = x1[k] * (1.0f + sc[k]) + sh[k];
    _Pragma("unroll") for (int g = 0; g < MOE_G; ++g) lg[g] += h * wg[k * MOE_G + g];
  }
  int gi = 0; float mx = lg[0];
  _Pragma("unroll") for (int g = 1; g < MOE_G; ++g) if (lg[g] > mx) { mx = lg[g]; gi = g; }
  float den = 0.f;
  _Pragma("unroll") for (int g = 0; g < MOE_G; ++g) den += expf(lg[g] - mx);
  float gp = 1.0f / den;
  float le[MOE_EPG];
  _Pragma("unroll") for (int e = 0; e < MOE_EPG; ++e) le[e] = p.moe_be[(layer * MOE_G + gi) * MOE_EPG + e];
  const float* we = p.moe_we + ((size_t)layer * MOE_G + gi) * D * MOE_EPG;
  for (int k = 0; k < D; ++k) {
    float h = x1[k] * (1.0f + sc[k]) + sh[k];
    _Pragma("unroll") for (int e = 0; e < MOE_EPG; ++e) le[e] += h * we[k * MOE_EPG + e];
  }
  int i0 = 0; float v0 = le[0];
  _Pragma("unroll") for (int e = 1; e < MOE_EPG; ++e) if (le[e] > v0) { v0 = le[e]; i0 = e; }
  int i1 = -1; float v1 = -3e38f;
  _Pragma("unroll") for (int e = 0; e < MOE_EPG; ++e) if (e != i0 && le[e] > v1) { v1 = le[e]; i1 = e; }
  float e1 = expf(v1 - v0);
  float w0 = gp / (1.0f + e1), w1 = gp * e1 / (1.0f + e1);
  p.route[(size_t)t * 4 + 0] = (float)(gi * MOE_EPG + i0);
  p.route[(size_t)t * 4 + 1] = (float)(gi * MOE_EPG + i1);
  p.route[(size_t)t * 4 + 2] = w0;
  p.route[(size_t)t * 4 + 3] = w1;
}
HD void st_moe_h(const Params& p, int layer, int idx) {
  int f = idx % MOE_F; int j = (idx / MOE_F) % 2; int t = idx / (2 * MOE_F);
  int r = tok_r(t);
  const float* x1 = p.X1 + (size_t)t * D; const float* sh = modp(p, layer, r, 3); const float* sc = modp(p, layer, r, 4);
  int e = (int)p.route[(size_t)t * 4 + j]; float wgt = p.route[(size_t)t * 4 + 2 + j];
  const float* w1 = p.moe_w1 + ((size_t)layer * MOE_E + e) * D * MOE_F;
  const float* w3 = p.moe_w3 + ((size_t)layer * MOE_E + e) * D * MOE_F;
  float h1 = 0.f, h3 = 0.f;
  for (int k = 0; k < D; ++k) {
    float h = x1[k] * (1.0f + sc[k]) + sh[k];
    h1 += h * w1[(size_t)k * MOE_F + f]; h3 += h * w3[(size_t)k * MOE_F + f];
  }
  p.HH[(size_t)idx] = siluf(h1) * h3 * wgt;
}
HD void st_moe_o(const Params& p, int layer, int idx) {
  int t = idx / D, n = idx % D;
  float acc = 0.f;
  for (int j = 0; j < 2; ++j) {
    int e = (int)p.route[(size_t)t * 4 + j];
    const float* w2 = p.moe_w2 + ((size_t)layer * MOE_E + e) * MOE_F * D;
    const float* hh = p.HH + ((size_t)t * 2 + j) * MOE_F;
    for (int f = 0; f < MOE_F; ++f) acc += hh[f] * w2[(size_t)f * D + n];
  }
  p.F[(size_t)t * D + n] = acc;
}
HD void st_ln2(const Params& p, int layer, int t) {
  int r = tok_r(t);
  const float* x1 = p.X1 + (size_t)t * D; const float* g2 = modp(p, layer, r, 5);
  const float* y = p.F + (size_t)t * D;
  float mu = 0.f;
  for (int k = 0; k < D; ++k) mu += ALPHA * x1[k] + g2[k] * y[k];
  mu /= D;
  float var = 0.f;
  for (int k = 0; k < D; ++k) { float v = ALPHA * x1[k] + g2[k] * y[k] - mu; var += v * v; }
  var /= D;
  float rs = 1.0f / sqrtf(var + LN_EPS);
  const float* lg = p.ln2_g + (size_t)layer * D; const float* lb = p.ln2_b + (size_t)layer * D;
  float* dst = layer == DEPTH - 1 ? p.out + (size_t)t * D : p.X + (size_t)t * D;
  for (int k = 0; k < D; ++k) dst[k] = (ALPHA * x1[k] + g2[k] * y[k] - mu) * rs * lg[k] + lb[k];
}

enum { S_MOD, S_TABA, S_TABB, S_PROJ, S_SWA, S_SSME, S_SSMC, S_SSMO, S_GLU, S_DIF, S_DIFNORM, S_OUTPROJ, S_LN1, S_ROUTE, S_MOEH, S_MOEO, S_LN2 };
template <int S> HD void run_elem(const Params& p, int layer, int idx) {
  if (S == S_MOD) st_mod(p, layer, idx);
  else if (S == S_TABA) st_taba(p, layer, idx);
  else if (S == S_TABB) st_tabb(p, layer, idx);
  else if (S == S_PROJ) st_proj(p, layer, idx);
  else if (S == S_SWA) st_swa(p, layer, idx);
  else if (S == S_SSME) st_ssm_e(p, layer, idx);
  else if (S == S_SSMC) st_ssm_c(p, layer, idx);
  else if (S == S_SSMO) st_ssm_o(p, layer, idx);
  else if (S == S_GLU) st_glu(p, layer, idx);
  else if (S == S_DIF) st_dif(p, layer, idx);
  else if (S == S_DIFNORM) st_difnorm(p, layer, idx);
  else if (S == S_OUTPROJ) st_outproj(p, layer, idx);
  else if (S == S_LN1) st_ln1(p, layer, idx);
  else if (S == S_ROUTE) st_route(p, layer, idx);
  else if (S == S_MOEH) st_moe_h(p, layer, idx);
  else if (S == S_MOEO) st_moe_o(p, layer, idx);
  else if (S == S_LN2) st_ln2(p, layer, idx);
}

constexpr int NSLOT = 2 * TA + MOE_E * 256;
constexpr size_t CTL_BYTES = 1u << 20;
struct WsLayout {
  size_t A2, BtY, BtE, apow16, KT16, E16, Ypart;
  size_t ctl, X, X1, P, Ymix, Gs, modv, ropeT, apow, bbar, KT, E, Sin, route, scal, WinA_t, DifIn_t, WoutA_t, DifOut_t, Glu_t, W13t, W2t, gate, tokslot, moe_meta, total;
};
inline WsLayout ws_layout() {
  WsLayout L; size_t o = 0;
  auto take = [&](size_t bytes) { size_t r = o; o += (bytes + 255) & ~(size_t)255; return r; };
  L.ctl = take(CTL_BYTES);
  L.X = take((size_t)TA * D * 4);
  L.X1 = L.X;
  L.P = take((size_t)TA * (AB_IN > DIF_IN ? AB_IN : DIF_IN) * 2);
  L.Ymix = take((size_t)TA * YW * 2);
  L.Gs = L.X;
  L.modv = take((size_t)N_MOD * 4);
  L.ropeT = take((size_t)N_ROPE * 2 * 4);
  L.apow = take((size_t)N_APOW * 2 * 4);
  L.bbar = take((size_t)N_BBAR * 2 * 4);
  L.KT = take((size_t)N_KT * 4);
  L.E = L.X + (((size_t)TA * SSM_W * 2 + 255) & ~(size_t)255);
  L.Sin = L.E + (((size_t)N_SSME * 2 * 4 + 255) & ~(size_t)255);
  L.route = take((size_t)TA * 8 * 4);
  L.scal = take(256);
  L.WinA_t = take((size_t)AB_IN * D * 2);
  L.DifIn_t = take((size_t)DIF_IN * D * 2);
  L.WoutA_t = take((size_t)D * AB_OUT * 2);
  L.DifOut_t = take((size_t)D * DIF_VW * 2);
  L.Glu_t = take((size_t)SSM_W * SSM_W * 2);
  L.W13t = take((size_t)MOE_E * 2 * MOE_F * D * 2);
  L.W2t = take((size_t)MOE_E * D * MOE_F * 2);
  L.gate = take((size_t)NSLOT * 4);
  L.tokslot = take((size_t)TA * 2 * 4);
  L.moe_meta = take(4096);
  L.BtY = take((size_t)2 * SSM_G * 256 * 384 * 2);
  L.BtE = take((size_t)2 * SSM_G * 256 * 256 * 2);
  L.apow16 = take((size_t)2 * SSM_G * SSM_P * 17 * 2 * 4);
  L.KT16 = take((size_t)2 * SSM_G * 16 * 256 * 4);
  L.A2 = L.P + (size_t)48 * 1024 * 1024;
  L.E16 = L.X + (size_t)19 * 1024 * 1024;
  L.Ypart = L.E16;
  L.total = o;
  return L;
}
inline void fill_ws(Params& p, char* ws) {
  WsLayout L = ws_layout();
  p.X = (float*)(ws + L.X); p.X1 = (float*)(ws + L.X1); p.P = (uint16_t*)(ws + L.P); p.F = (float*)(ws + L.P);
  p.Ymix = (uint16_t*)(ws + L.Ymix); p.HH = (float*)(ws + L.Ymix);
  p.Gs = (uint16_t*)(ws + L.Gs); p.modv = (float*)(ws + L.modv); p.ropeT = (float*)(ws + L.ropeT);
  p.apow = (float*)(ws + L.apow); p.bbar = (float*)(ws + L.bbar); p.KT = (float*)(ws + L.KT);
  p.E = (float*)(ws + L.E); p.Sin = (float*)(ws + L.Sin); p.route = (float*)(ws + L.route); p.scal = (float*)(ws + L.scal);
  p.H = (uint16_t*)(ws + L.Ymix); p.WinA_t = (uint16_t*)(ws + L.WinA_t); p.DifIn_t = (uint16_t*)(ws + L.DifIn_t); p.ctl = (unsigned*)(ws + L.ctl);
  p.WoutA_t = (uint16_t*)(ws + L.WoutA_t); p.DifOut_t = (uint16_t*)(ws + L.DifOut_t); p.Glu_t = (uint16_t*)(ws + L.Glu_t);
  p.W13t = (uint16_t*)(ws + L.W13t); p.W2t = (uint16_t*)(ws + L.W2t);
  p.Amoe = (uint16_t*)(ws + L.P); p.F2 = (uint16_t*)(ws + L.P); p.HHb = (uint16_t*)(ws + L.Ymix);
  p.A2 = (uint16_t*)(ws + L.A2); p.BtY = (uint16_t*)(ws + L.BtY); p.BtE = (uint16_t*)(ws + L.BtE);
  p.apow16 = (float*)(ws + L.apow16); p.KT16 = (float*)(ws + L.KT16); p.E16 = (float*)(ws + L.E16); p.Ypart = (float*)(ws + L.Ypart);
  p.gate = (float*)(ws + L.gate); p.tokslot = (int*)(ws + L.tokslot); p.moe_meta = (int*)(ws + L.moe_meta);
}
inline void fill_inputs(Params& p, void* const* d_in) {
  const float* const* in = (const float* const*)d_in;
  p.x = in[0]; p.c = in[1]; p.ctx = in[2]; p.c_ctx = in[3]; p.mod_w = in[4]; p.mod_b = in[5];
  p.ln1_g = in[6]; p.ln1_b = in[7]; p.ln2_g = in[8]; p.ln2_b = in[9];
  p.w_in_a = in[10]; p.w_out_a = in[11]; p.sink = in[12]; p.a_re = in[13]; p.a_im = in[14]; p.log_step = in[15];
  p.b_re = in[16]; p.b_im = in[17]; p.c_re = in[18]; p.c_im = in[19]; p.ssm_d = in[20]; p.glu_w = in[21]; p.glu_b = in[22];
  p.dif_w_in = in[23]; p.dif_w_out = in[24]; p.lq1 = in[25]; p.lk1 = in[26]; p.lq2 = in[27]; p.lk2 = in[28]; p.subln_g = in[29];
  p.moe_wg = in[30]; p.moe_bg = in[31]; p.moe_we = in[32]; p.moe_be = in[33]; p.moe_w1 = in[34]; p.moe_w3 = in[35]; p.moe_w2 = in[36];
}

#define FORWARD_PROGRAM(RUN)                                   \
  RUN(S_MOD, 0, N_MOD)                                         \
  RUN(S_TABA, 0, N_TABA)                                       \
  RUN(S_TABB, 0, N_KT)                                         \
                                                   \
  RUN(S_PROJ, 0, TA * AB_IN)                                   \
  RUN(S_SWA, 0, SWA_H * TA)                                    \
  RUN(S_SSME, 0, N_SSME)                                       \
  RUN(S_SSMC, 0, N_SSMC)                                       \
  RUN(S_SSMO, 0, TA * SSM_W)                                   \
  RUN(S_GLU, 0, TA * SSM_W)                                    \
  RUN(S_OUTPROJ, 0, TA * D)                                    \
  RUN(S_LN1, 0, TA)                                            \
  RUN(S_ROUTE, 0, TA)                                          \
  RUN(S_MOEH, 0, TA * 2 * MOE_F)                               \
  RUN(S_MOEO, 0, TA * D)                                       \
  RUN(S_LN2, 0, TA)                                            \
                                                   \
  RUN(S_PROJ, 1, TA * DIF_IN)                                  \
  RUN(S_DIF, 1, DIF_H * 2 * TL)                                \
  RUN(S_DIFNORM, 1, TL * DIF_H)                                \
  RUN(S_OUTPROJ, 1, TL * D)                                    \
  RUN(S_LN1, 1, TL)                                            \
  RUN(S_ROUTE, 1, TL)                                          \
  RUN(S_MOEH, 1, TL * 2 * MOE_F)                               \
  RUN(S_MOEO, 1, TL * D)                                       \
  RUN(S_LN2, 1, TL)

#ifndef HOST_EMU
#include <cstdio>
#define LAS __attribute__((address_space(3)))
#define GAS __attribute__((address_space(1)))
typedef unsigned short bf16_t;
typedef short bf16x8 __attribute__((ext_vector_type(8)));
typedef float f32x4 __attribute__((ext_vector_type(4)));
typedef float f32x2 __attribute__((ext_vector_type(2)));
typedef unsigned u32x4 __attribute__((ext_vector_type(4)));
typedef unsigned u32x2 __attribute__((ext_vector_type(2)));
constexpr int NWAVES = 8, NTHR = 512;
constexpr int RING_BYTES = 131072, LDSCTL_OFF = RING_BYTES, MISC_OFF = LDSCTL_OFF + 320, LDS_BYTES = 147456;
#define LDS_WAIT() asm volatile("s_waitcnt lgkmcnt(0)" ::: "memory")
#define VM_WAIT() asm volatile("s_waitcnt vmcnt(0)" ::: "memory")
__device__ __forceinline__ unsigned cvt_pk_bf16(float lo, float hi) { unsigned r; asm volatile("v_cvt_pk_bf16_f32 %0, %1, %2" : "=v"(r) : "v"(lo), "v"(hi)); return r; }

namespace pg8 {
constexpr int BM = 256, BK = 64, HALF = 128, HTB = HALF * BK * 2, STAGE_BYTES = 8 * HTB, NXCD = 8, WGM = 8;
__host__ __device__ __forceinline__ int lds_byte(int r, int c) { const int st = (r >> 4) * 2 + (c >> 5), rr = r & 15, cc = c & 31, ob = rr * 64 + cc * 2; return st * 1024 + (ob ^ (((ob >> 9) & 1) << 5)); }
__host__ __device__ __forceinline__ void stage_rc(int b, int& R, int& C) { const int st = b / 1024, sb = b % 1024, swz = sb ^ (((sb >> 9) & 1) << 5); R = (st >> 1) * 16 + swz / 64; C = (st & 1) * 32 + (swz % 64) / 2; }
__host__ __device__ __forceinline__ int perm32(int rho) { const int n = rho >> 4, i = rho & 15; return 8 * (i >> 2) + 4 * n + (i & 3); }
struct Unit { int pm, pn; };
struct Gemm { const bf16_t* A; const bf16_t* Bt; int lda, ldb, K; };

struct StaticOrder {
  int nM, nN, nwg, G, c;
  __device__ void init(int M, int N, int G_, int c_) { nM = M / BM; nN = N / BM; nwg = nM * nN; G = G_; c = c_; }
  __device__ bool next(int i, Unit& u) const {
    const long L = (long)i * G + c; if (L >= nwg) return false;
    int wgid = (int)L; { const int q = nwg / NXCD, r = nwg % NXCD, xcd = wgid % NXCD, off = wgid / NXCD; wgid = (xcd < r ? xcd * (q + 1) : r * (q + 1) + (xcd - r) * q) + off; }
    const int nig = WGM * nN, gid = wgid / nig, fm = gid * WGM, gsz = (nM - fm) < WGM ? (nM - fm) : WGM;
    u.pm = fm + ((wgid % nig) % gsz); u.pn = (wgid % nig) / gsz; return true;
  }
  __device__ __forceinline__ void a_ready(const Unit&) const {}
  __device__ __forceinline__ void done(const Unit&) const {}
};

template <class Epi, class Sched, bool ALIGN_EPI = true, bool SP2 = true>
__device__ __forceinline__ void gemm_phase(LAS unsigned char* lds, const Gemm g, const Sched& S, const Epi& E) {
  int tid = threadIdx.x; asm volatile("" : "+v"(tid));
  const int wid = __builtin_amdgcn_readfirstlane(tid >> 6), lane = tid & 63, wr = wid >> 2, wc = wid & 3, fr = lane & 15, fq = lane >> 4;
  const int K = g.K, nt = K / BK;
  unsigned voffA[2], voffB[2];
#pragma unroll
  for (int i = 0; i < 2; ++i) { int R, C; stage_rc(tid * 16 + i * 8192, R, C); const int Rb = Epi::PERM ? ((R & ~31) + perm32(R & 31)) : R;
    voffA[i] = (unsigned)(R * g.lda + C) * 2u; voffB[i] = (unsigned)(Rb * g.ldb + C) * 2u; }
  const size_t kstep = (size_t)(BK * 2);
  const size_t hA = (size_t)HALF * g.lda * 2, hB = (size_t)HALF * g.ldb * 2;
  const size_t tA = 2 * hA, tB = 2 * hB;
  const unsigned ldsw = (unsigned)wid * 1024u;
  const int aoff = lds_byte(wr * 64 + fr, fq * 8), boff = lds_byte(wc * 32 + fr, fq * 8);
#define PG8_SA(b, h) (((b) * 2 + (h)) * HTB)
#define PG8_SB(b, h) ((4 + (b) * 2 + (h)) * HTB)
#define PG8_STAGE(bufoff, gbase, voff) do { _Pragma("unroll") for (int _i = 0; _i < 2; ++_i) \
    __builtin_amdgcn_global_load_lds((const unsigned*)((const char*)(gbase) + (voff)[_i]), (LAS unsigned*)(lds + (bufoff) + ldsw + _i * 8192), 16, 0, 0); } while (0)
#define PG8_LDA(dst, b, h) do { _Pragma("unroll") for (int m = 0; m < 4; ++m) _Pragma("unroll") for (int k = 0; k < 2; ++k) dst[m][k] = *(const LAS bf16x8*)(lds + PG8_SA(b, h) + aoff + m * 2048 + k * 1024); } while (0)
#define PG8_LDB(dst, b, h) do { _Pragma("unroll") for (int n = 0; n < 2; ++n) _Pragma("unroll") for (int k = 0; k < 2; ++k) dst[n][k] = *(const LAS bf16x8*)(lds + PG8_SB(b, h) + boff + n * 2048 + k * 1024); } while (0)
#define PG8_MMA(ai, bj, At, Bt) do { __builtin_amdgcn_s_setprio(1); _Pragma("unroll") for (int m = 0; m < 4; ++m) _Pragma("unroll") for (int n = 0; n < 2; ++n) _Pragma("unroll") for (int k = 0; k < 2; ++k) \
    acc[ai][bj][m][n] = __builtin_amdgcn_mfma_f32_16x16x32_bf16(Bt[n][k], At[m][k], acc[ai][bj][m][n], 0, 0, 0); __builtin_amdgcn_s_setprio(0); } while (0)
#define PG8_WAIT_V(n) asm volatile("s_waitcnt vmcnt(" #n ")" ::: "memory")
#define PG8_WAIT_L(n) asm volatile("s_waitcnt lgkmcnt(" #n ")" ::: "memory")
#define PG8_BAR __builtin_amdgcn_s_barrier()
#define PG8_SCHED __builtin_amdgcn_sched_barrier(0)
  Unit cur, nxt; int ui = 0;
  if (!S.next(0, cur)) return;
  f32x4 acc[2][2][4][2];
#pragma unroll
  for (int a = 0; a < 2; ++a)
#pragma unroll
    for (int b = 0; b < 2; ++b)
#pragma unroll
      for (int m = 0; m < 4; ++m)
#pragma unroll
        for (int n = 0; n < 2; ++n) acc[a][b][m][n] = (f32x4){0.f, 0.f, 0.f, 0.f};
  bf16x8 At[4][2], B0[2][2], B1[2][2];
  const char* cA = (const char*)g.A + (size_t)cur.pm * tA; const char* cB = (const char*)g.Bt + (size_t)cur.pn * tB;
  S.a_ready(cur);
  if constexpr (SP2) {
    PG8_STAGE(PG8_SB(0, 0), cB, voffB); PG8_STAGE(PG8_SB(0, 1), cB + hB, voffB); PG8_STAGE(PG8_SA(0, 0), cA, voffA); PG8_STAGE(PG8_SA(0, 1), cA + hA, voffA);
    if (wr == 1) PG8_BAR;
    PG8_WAIT_V(2); PG8_BAR;
    PG8_STAGE(PG8_SB(1, 0), cB + kstep, voffB); PG8_STAGE(PG8_SA(1, 0), cA + kstep, voffA); PG8_STAGE(PG8_SB(1, 1), cB + hB + kstep, voffB);
    PG8_WAIT_V(6); PG8_BAR;
  } else {
    PG8_STAGE(PG8_SB(0, 0), cB, voffB); PG8_STAGE(PG8_SA(0, 0), cA, voffA); PG8_STAGE(PG8_SB(0, 1), cB + hB, voffB); PG8_STAGE(PG8_SA(0, 1), cA + hA, voffA);
    if (wr == 1) PG8_BAR;
    PG8_WAIT_V(4); PG8_BAR;
    PG8_STAGE(PG8_SB(1, 0), cB + kstep, voffB); PG8_STAGE(PG8_SA(1, 0), cA + kstep, voffA); PG8_STAGE(PG8_SB(1, 1), cB + hB + kstep, voffB);
    PG8_WAIT_V(6); PG8_BAR;
  }
  for (;;) {
    const bool has_next = S.next(ui + 1, nxt);
    const char* nA = has_next ? (const char*)g.A + (size_t)nxt.pm * tA : cA; const char* nB = has_next ? (const char*)g.Bt + (size_t)nxt.pn * tB : cB;
#pragma unroll 1
    for (int t = 0; t < nt; t += 2) {
      const bool last = (t == nt - 2);
      const char* a1 = cA + (size_t)(t + 1) * kstep;
      const char* a2 = last ? nA : cA + (size_t)(t + 2) * kstep; const char* b2 = last ? nB : cB + (size_t)(t + 2) * kstep;
      const char* a3 = a2 + kstep; const char* b3 = b2 + kstep;
      if (last && has_next) S.a_ready(nxt);
      if constexpr (SP2) {
        PG8_LDB(B0, 0, 0); PG8_LDB(B1, 0, 1); PG8_SCHED; PG8_LDA(At, 0, 0); PG8_STAGE(PG8_SA(1, 1), a1 + hA, voffA);
        PG8_WAIT_V(8); PG8_WAIT_L(0); PG8_BAR; PG8_MMA(0, 0, At, B0); PG8_MMA(0, 1, At, B1); PG8_BAR; PG8_SCHED;
        PG8_LDA(At, 0, 1); PG8_STAGE(PG8_SB(0, 0), b2, voffB); PG8_STAGE(PG8_SB(0, 1), b2 + hB, voffB); PG8_STAGE(PG8_SA(0, 0), a2, voffA);
        PG8_WAIT_V(8); PG8_WAIT_L(0); PG8_BAR; PG8_MMA(1, 0, At, B0); PG8_MMA(1, 1, At, B1); PG8_BAR; PG8_SCHED;
        PG8_LDB(B0, 1, 0); PG8_LDB(B1, 1, 1); PG8_SCHED; PG8_LDA(At, 1, 0); PG8_STAGE(PG8_SA(0, 1), a2 + hA, voffA);
        PG8_WAIT_V(8); PG8_WAIT_L(0); PG8_BAR; PG8_MMA(0, 0, At, B0); PG8_MMA(0, 1, At, B1); PG8_BAR; PG8_SCHED;
        PG8_LDA(At, 1, 1); PG8_STAGE(PG8_SB(1, 0), b3, voffB); PG8_STAGE(PG8_SB(1, 1), b3 + hB, voffB); PG8_STAGE(PG8_SA(1, 0), a3, voffA);
        PG8_WAIT_V(8); PG8_WAIT_L(0); PG8_BAR; PG8_MMA(1, 0, At, B0); PG8_MMA(1, 1, At, B1); PG8_BAR; PG8_SCHED;
      } else {
        PG8_LDB(B0, 0, 0); PG8_SCHED; PG8_LDA(At, 0, 0); PG8_STAGE(PG8_SA(1, 1), a1 + hA, voffA);
        PG8_WAIT_L(8); PG8_BAR; PG8_WAIT_L(0); PG8_MMA(0, 0, At, B0); PG8_BAR; PG8_SCHED;
        PG8_LDB(B1, 0, 1); PG8_STAGE(PG8_SB(0, 0), b2, voffB);
        PG8_BAR; PG8_WAIT_L(0); PG8_MMA(0, 1, At, B1); PG8_BAR;
        PG8_LDA(At, 0, 1); PG8_STAGE(PG8_SA(0, 0), a2, voffA);
        PG8_BAR; PG8_WAIT_L(0); PG8_MMA(1, 0, At, B0); PG8_BAR; PG8_SCHED;
        PG8_STAGE(PG8_SB(0, 1), b2 + hB, voffB);
        PG8_WAIT_V(6); PG8_BAR; PG8_MMA(1, 1, At, B1); PG8_BAR;
        PG8_LDB(B0, 1, 0); PG8_SCHED; PG8_LDA(At, 1, 0); PG8_STAGE(PG8_SA(0, 1), a2 + hA, voffA);
        PG8_WAIT_L(8); PG8_BAR; PG8_WAIT_L(0); PG8_MMA(0, 0, At, B0); PG8_BAR; PG8_SCHED;
        PG8_LDB(B1, 1, 1); PG8_STAGE(PG8_SB(1, 0), b3, voffB);
        PG8_BAR; PG8_WAIT_L(0); PG8_MMA(0, 1, At, B1); PG8_BAR;
        PG8_LDA(At, 1, 1); PG8_STAGE(PG8_SA(1, 0), a3, voffA);
        PG8_BAR; PG8_WAIT_L(0); PG8_MMA(1, 0, At, B0); PG8_BAR; PG8_SCHED;
        PG8_STAGE(PG8_SB(1, 1), b3 + hB, voffB);
        PG8_WAIT_V(6); PG8_BAR; PG8_MMA(1, 1, At, B1); PG8_BAR;
      }
    }
    if constexpr (ALIGN_EPI) { if (wr == 0) PG8_BAR; }
    E(acc, cur, wr, wc, fr, fq); S.done(cur);
    if (!has_next) break;
#pragma unroll
    for (int a = 0; a < 2; ++a)
#pragma unroll
      for (int b = 0; b < 2; ++b)
#pragma unroll
        for (int m = 0; m < 4; ++m)
#pragma unroll
          for (int n = 0; n < 2; ++n) acc[a][b][m][n] = (f32x4){0.f, 0.f, 0.f, 0.f};
    cur = nxt; cA = nA; cB = nB; ++ui;
    if constexpr (ALIGN_EPI) { if (wr == 1) PG8_BAR; }
  }
  PG8_WAIT_V(0);
  if constexpr (!ALIGN_EPI) { if (wr == 0) PG8_BAR; }
  PG8_BAR;
#undef PG8_SA
#undef PG8_SB
#undef PG8_STAGE
#undef PG8_LDA
#undef PG8_LDB
#undef PG8_MMA
#undef PG8_WAIT_V
#undef PG8_WAIT_L
#undef PG8_BAR
#undef PG8_SCHED
}
}

constexpr int LC = 16, NCH16 = SS / LC, GROWS = 1280, A2K = 384;
static_assert(B * NCH16 <= GROWS && GROWS % 256 == 0, "ssm group rows");
__device__ __forceinline__ void ssm_tau(int t, int& b, int& tau0, int& tau1) {
  if (t < TL) { b = t / N; const int i = t % N; tau0 = CTX + i; tau1 = CTX + (N - 1 - i); }
  else { b = (t - TL) / CTX; const int i = (t - TL) % CTX; tau0 = i; tau1 = CTX - 1 - i; }
}
struct EpiProj {
  static constexpr bool PERM = false;
  bf16_t* O; int ldc; int rope_end; const float* ropeT; bf16_t* A2;
  __device__ __forceinline__ void operator()(const f32x4 (&acc)[2][2][4][2], const pg8::Unit& u, int wr, int wc, int fr, int fq) const {
    const int row0 = u.pm * 256 + wr * 64 + fr, colb = u.pn * 256 + wc * 32;
    const bool rope_cols = colb < rope_end;
#pragma unroll
    for (int ai = 0; ai < 2; ++ai)
#pragma unroll
      for (int m = 0; m < 4; ++m) {
        const int r = row0 + ai * 128 + m * 16;
        bf16_t* rowp = O + (size_t)r * ldc + colb + 4 * fq;
        f32x4 cs0 = {1.f, 0.f, 1.f, 0.f}, cs1 = {1.f, 0.f, 1.f, 0.f};
        const bool rp = rope_cols && (r < TL);
        if (rp) { const int i = r % N; const int pos = (wc & 1) ? (i % GRID_W) : (i / GRID_W);
          const f32x4* tp = (const f32x4*)(ropeT + (size_t)(pos * 16 + 4 * fq) * 2); cs0 = tp[0]; cs1 = tp[1]; }
#pragma unroll
        for (int bj = 0; bj < 2; ++bj) {
          const bool rpb = rp && (colb + bj * 128 < rope_end);
          f32x4 a1 = acc[ai][bj][m][0], a2 = acc[ai][bj][m][1];
          f32x4 o1 = a1, o2 = a2;
          if (rpb) {
            o1[0] = a1[0] * cs0[0] - a2[0] * cs0[1]; o2[0] = a2[0] * cs0[0] + a1[0] * cs0[1];
            o1[1] = a1[1] * cs0[2] - a2[1] * cs0[3]; o2[1] = a2[1] * cs0[2] + a1[1] * cs0[3];
            o1[2] = a1[2] * cs1[0] - a2[2] * cs1[1]; o2[2] = a2[2] * cs1[0] + a1[2] * cs1[1];
            o1[3] = a1[3] * cs1[2] - a2[3] * cs1[3]; o2[3] = a2[3] * cs1[2] + a1[3] * cs1[3];
          }
          u32x2 w1 = {cvt_pk_bf16(o1[0], o1[1]), cvt_pk_bf16(o1[2], o1[3])}, w2 = {cvt_pk_bf16(o2[0], o2[1]), cvt_pk_bf16(o2[2], o2[3])};
          *(u32x2*)(rowp + bj * 128) = w1; *(u32x2*)(rowp + bj * 128 + 16) = w2;
          if (A2 != nullptr && colb + bj * 128 >= A_UOFF) {
            int b, tau0, tau1; ssm_tau(r, b, tau0, tau1);
            const int g0 = (colb + bj * 128 - A_UOFF) / 16;
            bf16_t* d0 = A2 + (((size_t)g0 * GROWS + b * NCH16 + tau0 / LC) * A2K + (tau0 % LC) * 16 + 4 * fq);
            bf16_t* d1 = A2 + (((size_t)(SSM_G + g0) * GROWS + b * NCH16 + tau1 / LC) * A2K + (tau1 % LC) * 16 + 4 * fq);
            *(u32x2*)d0 = w1; *(u32x2*)(d0 + (size_t)GROWS * A2K) = w2; *(u32x2*)d1 = w1; *(u32x2*)(d1 + (size_t)GROWS * A2K) = w2;
          }
        }
      }
  }
};


struct EpiF32Out {
  static constexpr bool PERM = false;
  float* C; int ldc;
  __device__ __forceinline__ void operator()(const f32x4 (&acc)[2][2][4][2], const pg8::Unit& u, int wr, int wc, int fr, int fq) const {
    const int row0 = u.pm * 256 + wr * 64 + fr, col0 = u.pn * 256 + wc * 32 + 4 * fq;
#pragma unroll
    for (int ai = 0; ai < 2; ++ai)
#pragma unroll
      for (int m = 0; m < 4; ++m) { float* rowp = C + (size_t)(row0 + ai * 128 + m * 16) * ldc + col0;
#pragma unroll
        for (int bj = 0; bj < 2; ++bj)
#pragma unroll
          for (int n = 0; n < 2; ++n) *(f32x4*)(rowp + bj * 128 + n * 16) = acc[ai][bj][m][n]; }
  }
};
struct EpiBf16Out {
  static constexpr bool PERM = true;
  bf16_t* O; int ldc; int NJ;
  __device__ __forceinline__ void operator()(const f32x4 (&acc)[2][2][4][2], const pg8::Unit& u, int wr, int wc, int fr, int fq) const {
    const int row0 = u.pm * 256 + wr * 64 + fr, col0 = (NJ ? (u.pn % NJ) : u.pn) * 256 + wc * 32 + 8 * fq;
#pragma unroll
    for (int ai = 0; ai < 2; ++ai)
#pragma unroll
      for (int m = 0; m < 4; ++m) { bf16_t* rowp = O + (size_t)(row0 + ai * 128 + m * 16) * ldc + col0;
#pragma unroll
        for (int bj = 0; bj < 2; ++bj) { const f32x4 v0 = acc[ai][bj][m][0], v1 = acc[ai][bj][m][1];
          u32x4 w; w.x = cvt_pk_bf16(v0[0], v0[1]); w.y = cvt_pk_bf16(v0[2], v0[3]); w.z = cvt_pk_bf16(v1[0], v1[1]); w.w = cvt_pk_bf16(v1[2], v1[3]);
          *(u32x4*)(rowp + bj * 128) = w; } }
  }
};
__device__ __forceinline__ float fast_sigmoid(float x) { return __builtin_amdgcn_rcpf(1.f + __builtin_amdgcn_exp2f(-1.4426950408889634f * x)); }
struct EpiGlu {
  static constexpr bool PERM = true;
  const bf16_t* Gs; const float* bias; bf16_t* O; int ldo, coloff;
  __device__ __forceinline__ void operator()(const f32x4 (&acc)[2][2][4][2], const pg8::Unit& u, int wr, int wc, int fr, int fq) const {
    const int row0 = u.pm * 256 + wr * 64 + fr, col0 = u.pn * 256 + wc * 32 + 8 * fq;
#pragma unroll
    for (int ai = 0; ai < 2; ++ai)
#pragma unroll
      for (int m = 0; m < 4; ++m) { const int r = row0 + ai * 128 + m * 16;
#pragma unroll
        for (int bj = 0; bj < 2; ++bj) { const int c = col0 + bj * 128;
          const u32x4 gv = *(const u32x4*)(Gs + (size_t)r * SSM_W + c);
          const f32x4 b0 = *(const f32x4*)(bias + c), b1 = *(const f32x4*)(bias + c + 4);
          const f32x4 v0 = acc[ai][bj][m][0] + b0, v1 = acc[ai][bj][m][1] + b1;
          float o[8];
#pragma unroll
          for (int j = 0; j < 4; ++j) { const unsigned gw_ = j < 2 ? (j == 0 ? gv.x : gv.y) : (j == 2 ? gv.z : gv.w);
            const float g0 = __builtin_bit_cast(float, gw_ << 16), g1 = __builtin_bit_cast(float, gw_ & 0xffff0000u);
            const float z0 = j < 2 ? v0[2 * j] : v1[2 * j - 4], z1 = j < 2 ? v0[2 * j + 1] : v1[2 * j - 3];
            o[2 * j] = g0 * fast_sigmoid(z0); o[2 * j + 1] = g1 * fast_sigmoid(z1); }
          u32x4 w; w.x = cvt_pk_bf16(o[0], o[1]); w.y = cvt_pk_bf16(o[2], o[3]); w.z = cvt_pk_bf16(o[4], o[5]); w.w = cvt_pk_bf16(o[6], o[7]);
          *(u32x4*)(O + (size_t)r * ldo + coloff + c) = w; } }
  }
};
struct EpiMoe1 {
  static constexpr bool PERM = true;
  bf16_t* HH; const float* gate;
  __device__ __forceinline__ void operator()(const f32x4 (&acc)[2][2][4][2], const pg8::Unit& u, int wr, int wc, int fr, int fq) const {
    const int row0 = u.pm * 256 + wr * 64 + fr, col0 = (u.pn & 1) * 128 + wc * 32 + 8 * fq;
#pragma unroll
    for (int ai = 0; ai < 2; ++ai)
#pragma unroll
      for (int m = 0; m < 4; ++m) { const int r = row0 + ai * 128 + m * 16; const float gt = gate[r];
        float o[8];
#pragma unroll
        for (int n = 0; n < 2; ++n)
#pragma unroll
          for (int j = 0; j < 4; ++j) { const float h1 = acc[ai][0][m][n][j], h3 = acc[ai][1][m][n][j]; o[4 * n + j] = h1 * fast_sigmoid(h1) * h3 * gt; }
        u32x4 w; w.x = cvt_pk_bf16(o[0], o[1]); w.y = cvt_pk_bf16(o[2], o[3]); w.z = cvt_pk_bf16(o[4], o[5]); w.w = cvt_pk_bf16(o[6], o[7]);
        *(u32x4*)(HH + (size_t)r * MOE_F + col0) = w; }
  }
};
struct MoeOrder {
  const int* meta; int NJ, G, c;
  __device__ __forceinline__ bool next(int i, pg8::Unit& u) const {
    const int nt = __builtin_amdgcn_readfirstlane(__hip_atomic_load(meta, __ATOMIC_RELAXED, __HIP_MEMORY_SCOPE_AGENT));
    const long L = (long)i * G + c; if (L >= (long)nt * NJ) return false;
    const int rt = (int)(L / NJ), jn = (int)(L % NJ);
    const int e = __builtin_amdgcn_readfirstlane(__hip_atomic_load(meta + 1 + rt, __ATOMIC_RELAXED, __HIP_MEMORY_SCOPE_AGENT));
    u.pm = rt; u.pn = e * NJ + jn; return true;
  }
  __device__ __forceinline__ void a_ready(const pg8::Unit&) const {}
  __device__ __forceinline__ void done(const pg8::Unit&) const {}
};


namespace att {
using f32x16 = __attribute__((ext_vector_type(16))) float;
using s16x4  = __attribute__((ext_vector_type(4))) short;
constexpr int KVBLK = 64;
constexpr float SCALE = 0.125f, THR = 8.f;
constexpr size_t SHM_V = KVBLK * 128 * 2, SHM_K = KVBLK * 128 * 2;
constexpr size_t SHM_WS = 2 * SHM_V + 2 * SHM_K;
#define KSWZ(row, colB) ((row) * 256 + ((colB) ^ (((row) & 7) << 4)))
#define SBAR() __builtin_amdgcn_sched_barrier(0)
__device__ __forceinline__ int crow(int r, int hi) { return (r & 3) + 8 * (r >> 2) + 4 * hi; }
__device__ __forceinline__ unsigned cvtpk(float lo, float hi) { unsigned r; asm volatile("v_cvt_pk_bf16_f32 %0, %1, %2" : "=v"(r) : "v"(lo), "v"(hi)); return r; }
__device__ __forceinline__ void partialSM(f32x16& p0, f32x16& p1, float& m_reg, float& mn, float& alpha) {
  constexpr float C = SCALE * 1.4426950408889634f;
  float pmax = p0[0];
#pragma unroll
  for (int r = 1; r < 16; ++r) pmax = fmaxf(pmax, p0[r]);
#pragma unroll
  for (int r = 0; r < 16; ++r) pmax = fmaxf(pmax, p1[r]);
  { auto rr = __builtin_amdgcn_permlane32_swap(__float_as_uint(pmax), __float_as_uint(pmax), false, false);
    pmax = fmaxf(__uint_as_float(rr[0]), __uint_as_float(rr[1])); }
  if (__builtin_expect(__all(pmax - m_reg <= THR / SCALE), 1)) { mn = m_reg; alpha = 1.f; }
  else { mn = fmaxf(m_reg, pmax); alpha = __builtin_amdgcn_exp2f((m_reg - mn) * C); m_reg = mn; }
  const float mnC = -mn * C;
#pragma unroll
  for (int r = 0; r < 16; ++r) p0[r] = fmaf(p0[r], C, mnC);
#pragma unroll
  for (int r = 0; r < 16; ++r) p1[r] = fmaf(p1[r], C, mnC);
#pragma unroll
  for (int r = 0; r < 16; ++r) p0[r] = __builtin_amdgcn_exp2f(p0[r]);
}
__device__ __forceinline__ void finishSM(f32x16& p0, f32x16& p1, float alpha, float& l_reg, bf16x8& pa0, bf16x8& pa1, bf16x8& pa2, bf16x8& pa3) {
#pragma unroll
  for (int r = 0; r < 16; ++r) p1[r] = __builtin_amdgcn_exp2f(p1[r]);
  float ps = 0;
#pragma unroll
  for (int r = 0; r < 16; ++r) ps += p0[r];
#pragma unroll
  for (int r = 0; r < 16; ++r) ps += p1[r];
  { auto rr = __builtin_amdgcn_permlane32_swap(__float_as_uint(ps), __float_as_uint(ps), false, false);
    ps = __uint_as_float(rr[0]) + __uint_as_float(rr[1]); }
  l_reg = l_reg * alpha + ps;
#define PK4(P, BASE, OUT) do { unsigned a0 = cvtpk(P[BASE + 0], P[BASE + 1]), a1 = cvtpk(P[BASE + 2], P[BASE + 3]);   \
    unsigned b0 = cvtpk(P[BASE + 4], P[BASE + 5]), b1 = cvtpk(P[BASE + 6], P[BASE + 7]);                              \
    auto r0 = __builtin_amdgcn_permlane32_swap(a0, b0, false, false); auto r1 = __builtin_amdgcn_permlane32_swap(a1, b1, false, false); \
    u32x4 w = {r0[0], r1[0], r0[1], r1[1]}; OUT = *reinterpret_cast<bf16x8*>(&w); } while (0)
  PK4(p0, 0, pa0); PK4(p0, 8, pa1); PK4(p1, 0, pa2); PK4(p1, 8, pa3);
#undef PK4
}
__device__ __forceinline__ void qkt(f32x16& p0, f32x16& p1, const char* Ks, const bf16x8* qr, int r32, int hi, int c) {
  p0 = f32x16{}; p1 = f32x16{};
#pragma unroll
  for (int d0 = 0; d0 < 4; ++d0) { const int cb = (c * 64 + d0 * 16 + hi * 8) * 2;
    const bf16x8 b0 = *reinterpret_cast<const bf16x8*>(Ks + KSWZ(r32, cb));
    const bf16x8 b1 = *reinterpret_cast<const bf16x8*>(Ks + KSWZ(32 + r32, cb));
    p0 = __builtin_amdgcn_mfma_f32_32x32x16_bf16(b0, qr[d0], p0, 0, 0, 0);
    p1 = __builtin_amdgcn_mfma_f32_32x32x16_bf16(b1, qr[d0], p1, 0, 0, 0); }
}
__device__ __forceinline__ int v_st(int k, int c) { const int kk = (k & ~0xC) | ((k & 4) << 1) | ((k & 8) >> 1); return ((kk >> 3) * 4 + (c >> 5)) * 512 + ((kk & 7) * 32 + (c & 31)) * 2; }
__device__ __forceinline__ int v_rd_base(int lane) { return ((lane & 3) << 3) | (((lane >> 2) & 3) << 6) | (((lane >> 4) & 1) << 5) | (((lane >> 5) & 1) << 8); }
constexpr int v_rd_off(int d0, int ks, int half) { return d0 * 512 + ks * 4096 + half * 2048; }
template <int OFF> __device__ __forceinline__ s16x4 tr_read(int vb) {
  s16x4 r; asm volatile("ds_read_b64_tr_b16 %0, %1 offset:%2" : "=&v"(r) : "v"(vb), "i"(OFF) : "memory"); return r;
}
template <int D0> __device__ __forceinline__ void pv_one(f32x16& od, int vb, bf16x8 pa0, bf16x8 pa1, bf16x8 pa2, bf16x8 pa3) {
  const s16x4 l0 = tr_read<v_rd_off(D0, 0, 0)>(vb), h0 = tr_read<v_rd_off(D0, 0, 1)>(vb), l1 = tr_read<v_rd_off(D0, 1, 0)>(vb), h1 = tr_read<v_rd_off(D0, 1, 1)>(vb);
  const s16x4 l2 = tr_read<v_rd_off(D0, 2, 0)>(vb), h2 = tr_read<v_rd_off(D0, 2, 1)>(vb), l3 = tr_read<v_rd_off(D0, 3, 0)>(vb), h3 = tr_read<v_rd_off(D0, 3, 1)>(vb);
  asm volatile("s_waitcnt lgkmcnt(0)" ::: "memory"); SBAR();
#define PK(L, H) (bf16x8){L[0], L[1], L[2], L[3], H[0], H[1], H[2], H[3]}
  od = __builtin_amdgcn_mfma_f32_32x32x16_bf16(pa0, PK(l0, h0), od, 0, 0, 0);
  od = __builtin_amdgcn_mfma_f32_32x32x16_bf16(pa1, PK(l1, h1), od, 0, 0, 0);
  od = __builtin_amdgcn_mfma_f32_32x32x16_bf16(pa2, PK(l2, h2), od, 0, 0, 0);
  od = __builtin_amdgcn_mfma_f32_32x32x16_bf16(pa3, PK(l3, h3), od, 0, 0, 0);
#undef PK
}
template <int NB> __device__ __forceinline__ void pv_blocks(f32x16* o, int vb, int vsel, bf16x8 pa0, bf16x8 pa1, bf16x8 pa2, bf16x8 pa3) {
  if constexpr (NB == 4) { pv_one<0>(o[0], vb, pa0, pa1, pa2, pa3); pv_one<1>(o[1], vb, pa0, pa1, pa2, pa3); pv_one<2>(o[2], vb, pa0, pa1, pa2, pa3); pv_one<3>(o[3], vb, pa0, pa1, pa2, pa3); }
  else { if (vsel == 0) { pv_one<0>(o[0], vb, pa0, pa1, pa2, pa3); pv_one<1>(o[1], vb, pa0, pa1, pa2, pa3); }
         else { pv_one<2>(o[0], vb, pa0, pa1, pa2, pa3); pv_one<3>(o[1], vb, pa0, pa1, pa2, pa3); } }
}
__device__ __forceinline__ void apply_mask(f32x16& p0, f32x16& p1, int mt, int i, int k0, int hi) {
  if (mt == 0) return;
#pragma unroll
  for (int r = 0; r < 16; ++r) { const int j0 = k0 + crow(r, hi), j1 = j0 + 32;
    const bool ok0 = (mt == 1) && (j0 - i <= SWA_WIN) && (i - j0 <= SWA_WIN), ok1 = (mt == 1) && (j1 - i <= SWA_WIN) && (i - j1 <= SWA_WIN);
    p0[r] = ok0 ? p0[r] : -1e30f; p1[r] = ok1 ? p1[r] : -1e30f; }
}

struct TileMap {
  int nl, tlo, bN, bC;
  __device__ __forceinline__ int row(int t) const { return t < nl ? bN + 64 * (tlo + t) : (t < nl + CTX / 64 ? bC + 64 * (t - nl) : bN + 64 * tlo); }
  __device__ __forceinline__ int mtype(int t) const { return t < nl ? 1 : (t < nl + CTX / 64 ? 0 : 2); }
  __device__ __forceinline__ int key0(int t) const { return 64 * (tlo + (t < nl ? t : 0)); }
};

template <int MODE>
__device__ __forceinline__ void attn_unit(const bf16_t* __restrict__ Pq, const bf16_t* __restrict__ Pk, const bf16_t* __restrict__ Pv, int LD, const TileMap tm, int NT,
                                          float m_init, float l_init, int i0, LAS unsigned char* ldsb, f32x16* o, float& l_out, int tid) {
  constexpr int NB = MODE == 0 ? 4 : 2;
  const int wid = tid >> 6, lane = tid & 63, r32 = lane & 31, hi = lane >> 5, c = wid >> 2;
  char* lds = (char*)ldsb;
  char* V_lds = lds; char* K_lds = lds + 2 * SHM_V;
  float* ws = (float*)(lds + SHM_WS) + wid * 64; float* al_l = ws + 32;
  float m_reg = m_init, l_reg = l_init; bf16x8 qr[4];
#pragma unroll
  for (int d = 0; d < NB; ++d) o[d] = f32x16{};
  const bf16_t* Qw = Pq + (size_t)r32 * LD + hi * 8;
#pragma unroll
  for (int d0 = 0; d0 < 4; ++d0) qr[d0] = *reinterpret_cast<const bf16x8*>(Qw + d0 * 16);
  const int sr = tid >> 4, sc = (tid & 15) * 8, vst0 = v_st(sr, sc), vst1 = v_st(32 + sr, sc);
  const int vb0 = (int)(uintptr_t)V_lds + v_rd_base(lane);
  struct { bf16x8 vs0, vs1, ks0, ks1; } sr_[2];
#define SLOAD(i, t) do { const size_t rb_ = (size_t)tm.row(t); \
    sr_[i].vs0 = *reinterpret_cast<const bf16x8*>(Pv + (rb_ + sr) * LD + sc); sr_[i].vs1 = *reinterpret_cast<const bf16x8*>(Pv + (rb_ + 32 + sr) * LD + sc); \
    sr_[i].ks0 = *reinterpret_cast<const bf16x8*>(Pk + (rb_ + sr) * LD + sc); sr_[i].ks1 = *reinterpret_cast<const bf16x8*>(Pk + (rb_ + 32 + sr) * LD + sc); } while (0)
#define SWRITE(b, i) do { *(bf16x8*)(V_lds + (b) * SHM_V + vst0) = sr_[i].vs0; *(bf16x8*)(V_lds + (b) * SHM_V + vst1) = sr_[i].vs1; const int kc = sc * 2; \
    *(bf16x8*)(K_lds + (b) * SHM_K + KSWZ(sr, kc)) = sr_[i].ks0; *(bf16x8*)(K_lds + (b) * SHM_K + KSWZ(32 + sr, kc)) = sr_[i].ks1; } while (0)
#define SWAIT() asm volatile("s_waitcnt vmcnt(4)" ::: "memory")
#define RESC(a) do { if (__any((a) < 1.f)) { if (hi == 0) al_l[r32] = (a); asm volatile("s_waitcnt lgkmcnt(0)" ::: "memory"); \
    _Pragma("unroll") for (int d = 0; d < NB; ++d) _Pragma("unroll") for (int r = 0; r < 16; ++r) o[d][r] *= al_l[crow(r, hi)]; } } while (0)
#define MASK(P0, P1, t) do { if constexpr (MODE == 1) apply_mask(P0, P1, tm.mtype(t), i0 + r32, tm.key0(t), hi); } while (0)
  f32x16 pA0, pA1, pB0, pB1; float mnA, mnB, alA, alB; bf16x8 pa0, pa1, pa2, pa3;
  constexpr int SE = 0, SO = 1;
  SLOAD(SE, 0); asm volatile("s_waitcnt vmcnt(0)" ::: "memory"); SWRITE(0, SE); __syncthreads();
  qkt(pA0, pA1, K_lds, qr, r32, hi, c); MASK(pA0, pA1, 0); partialSM(pA0, pA1, m_reg, mnA, alA);
  SLOAD(SO, 1); if (2 < NT) SLOAD(SE, 2);
  SWAIT(); SWRITE(1, SO); __syncthreads();
  for (int j = 1; j + 1 < NT; j += 2) {
    SBAR(); qkt(pB0, pB1, K_lds + SHM_K, qr, r32, hi, c);
    finishSM(pA0, pA1, alA, l_reg, pa0, pa1, pa2, pa3); SBAR();
    SLOAD(SO, j + 2); SBAR();
    pv_blocks<NB>(o, vb0, c, pa0, pa1, pa2, pa3); MASK(pB0, pB1, j); partialSM(pB0, pB1, m_reg, mnB, alB);
    __syncthreads(); SWAIT(); SWRITE(0, SE);
    RESC(alB); __syncthreads();
    SBAR(); qkt(pA0, pA1, K_lds, qr, r32, hi, c);
    finishSM(pB0, pB1, alB, l_reg, pa0, pa1, pa2, pa3); SBAR();
    if (j + 3 < NT) SLOAD(SE, j + 3);
    SBAR();
    pv_blocks<NB>(o, vb0 + (int)SHM_V, c, pa0, pa1, pa2, pa3); MASK(pA0, pA1, j + 1); partialSM(pA0, pA1, m_reg, mnA, alA);
    __syncthreads(); SWAIT(); SWRITE(1, SO);
    RESC(alA); __syncthreads();
  }
  SBAR(); qkt(pB0, pB1, K_lds + SHM_K, qr, r32, hi, c);
  finishSM(pA0, pA1, alA, l_reg, pa0, pa1, pa2, pa3); SBAR();
  pv_blocks<NB>(o, vb0, c, pa0, pa1, pa2, pa3); MASK(pB0, pB1, NT - 1); partialSM(pB0, pB1, m_reg, mnB, alB);
  __syncthreads(); RESC(alB);
  finishSM(pB0, pB1, alB, l_reg, pa0, pa1, pa2, pa3); SBAR();
  pv_blocks<NB>(o, vb0 + (int)SHM_V, c, pa0, pa1, pa2, pa3);
  l_out = l_reg;
  asm volatile("s_waitcnt vmcnt(0)" ::: "memory");
  __syncthreads();
#undef SLOAD
#undef SWRITE
#undef SWAIT
#undef RESC
#undef MASK
}

__device__ __forceinline__ void dif_phase(const Params& p, LAS unsigned char* ldsb, int G, int vcu, int tid) {
  const int wid = tid >> 6, lane = tid & 63, r32 = lane & 31, hi = lane >> 5, c = wid >> 2, rg = wid & 3;
  constexpr int NQB = N / 128, NU = B * DIF_H * NQB;
  const float lam = p.scal[0], oscale = p.scal[1];
  for (int L = vcu; L < NU; L += G) {
    const int qb = L % NQB, h = (L / NQB) % DIF_H, b = L / (NQB * DIF_H);
    const int t0 = b * N + qb * 128 + rg * 32;
    TileMap tm; tm.nl = N / 64; tm.tlo = 0; tm.bN = b * N; tm.bC = TL + b * CTX;
    f32x16 o[4]; float l_reg;
    attn_unit<0>(p.P + (size_t)t0 * DIF_IN + h * 128 + c * 64, p.P + DIF_QK + h * 128, p.P + 2 * DIF_QK + h * 128, DIF_IN, tm, (N + CTX) / 64,
                 -1e30f, 0.f, 0, ldsb, o, l_reg, tid);
    char* lds = (char*)ldsb;
    float* ws = (float*)(lds + SHM_WS) + wid * 64;
    float* xb = (float*)lds;
    if (hi == 0) ws[r32] = l_reg;
    asm volatile("s_waitcnt lgkmcnt(0)" ::: "memory");
    float rli[16];
#pragma unroll
    for (int r = 0; r < 16; ++r) rli[r] = __builtin_amdgcn_rcpf(ws[crow(r, hi)]);
    if (c == 1) {
#pragma unroll
      for (int d0 = 0; d0 < 4; ++d0)
#pragma unroll
        for (int r = 0; r < 16; ++r) xb[(rg * 32 + crow(r, hi)) * 128 + d0 * 32 + r32] = o[d0][r] * rli[r];
    }
    __syncthreads();
    if (c == 0) {
      float ss[16];
#pragma unroll
      for (int r = 0; r < 16; ++r) ss[r] = 0.f;
#pragma unroll
      for (int d0 = 0; d0 < 4; ++d0)
#pragma unroll
        for (int r = 0; r < 16; ++r) { const float v = o[d0][r] * rli[r] - lam * xb[(rg * 32 + crow(r, hi)) * 128 + d0 * 32 + r32]; o[d0][r] = v; ss[r] += v * v; }
#pragma unroll
      for (int r = 0; r < 16; ++r) {
#pragma unroll
        for (int sft = 1; sft < 32; sft <<= 1) ss[r] += __shfl_xor(ss[r], sft);
        ss[r] = oscale / sqrtf(ss[r] * (1.f / 128.f) + RMS_EPS); }
#pragma unroll
      for (int d0 = 0; d0 < 4; ++d0) { const float gsub = p.subln_g[d0 * 32 + r32];
#pragma unroll
        for (int r = 0; r < 16; ++r) p.Ymix[(size_t)(t0 + crow(r, hi)) * YW + h * 128 + d0 * 32 + r32] = f2bf(o[d0][r] * ss[r] * gsub); }
    }
    __syncthreads();
  }
}
__device__ __forceinline__ void swa_phase(const Params& p, LAS unsigned char* ldsb, int G, int vcu, int tid) {
  const int wid = tid >> 6, lane = tid & 63, r32 = lane & 31, hi = lane >> 5;
  constexpr int NUL = TL / 32, NUC = TC / 32;
  const float sink_raw = p.sink[wid] * (1.0f / SCALE);
  for (int L = vcu; L < NUL + NUC; L += G) {
    TileMap tm; int t0, NT, i0;
    if (L < NUL) { const int b = L / (N / 32), qb = L % (N / 32); i0 = qb * 32; t0 = b * N + i0;
      const int lo = i0 - SWA_WIN < 0 ? 0 : i0 - SWA_WIN, hi_ = i0 + 31 + SWA_WIN > N - 1 ? N - 1 : i0 + 31 + SWA_WIN;
      tm.tlo = lo / 64; tm.nl = hi_ / 64 - tm.tlo + 1; tm.bN = b * N; tm.bC = TL + b * CTX; NT = (tm.nl + CTX / 64 + 1) & ~1;
    } else { const int Lc = L - NUL, b = Lc / (CTX / 32), qb = Lc % (CTX / 32); i0 = 0; t0 = TL + b * CTX + qb * 32;
      tm.tlo = 0; tm.nl = 0; tm.bN = b * N; tm.bC = TL + b * CTX; NT = CTX / 64; }
    f32x16 o[2]; float l_reg;
    attn_unit<1>(p.P + (size_t)t0 * AB_IN + wid * 64, p.P + A_KOFF, p.P + A_VOFF, AB_IN, tm, NT, sink_raw, 1.f, i0, ldsb, o, l_reg, tid);
    char* lds = (char*)ldsb;
    float* ws = (float*)(lds + SHM_WS) + wid * 64;
    if (hi == 0) ws[r32] = l_reg;
    asm volatile("s_waitcnt lgkmcnt(0)" ::: "memory");
#pragma unroll
    for (int r = 0; r < 16; ++r) { const float rl = __builtin_amdgcn_rcpf(ws[crow(r, hi)]);
#pragma unroll
      for (int d0 = 0; d0 < 2; ++d0) p.Ymix[(size_t)(t0 + crow(r, hi)) * YW + wid * 64 + d0 * 32 + r32] = f2bf(o[d0][r] * rl); }
    __syncthreads();
  }
}
}


constexpr int N_TAB16A = 2 * SSM_G * SSM_P * 17;
__device__ __forceinline__ void st_tab16a(const Params& p, int idx) {
  const int k = idx % 17, q = idx / 17, dg = q / SSM_P;
  const double dt = exp((double)p.log_step[dg]), ar = p.a_re[q], ai = p.a_im[q], mag = exp(k * dt * ar);
  p.apow16[(size_t)idx * 2] = (float)(mag * cos(k * dt * ai)); p.apow16[(size_t)idx * 2 + 1] = (float)(mag * sin(k * dt * ai));
}
constexpr int N_TAB16B = 2 * SSM_G * 16 * 256;
__device__ __forceinline__ void st_tab16b(const Params& p, int idx) {
  const int ci = idx % 16, co = (idx / 16) % 16, lag = (idx / 256) % 16, dg = idx / 4096;
  float acc = 0.f;
  for (int pp = 0; pp < SSM_P; ++pp) { const int q = dg * SSM_P + pp;
    const float ar = p.apow16[((size_t)q * 17 + lag) * 2], ai = p.apow16[((size_t)q * 17 + lag) * 2 + 1];
    const float br = p.bbar[((size_t)q * 16 + ci) * 2], bi = p.bbar[((size_t)q * 16 + ci) * 2 + 1];
    const float cr = p.c_re[((size_t)dg * 16 + co) * SSM_P + pp], cim = p.c_im[((size_t)dg * 16 + co) * SSM_P + pp];
    acc += cr * (ar * br - ai * bi) - cim * (ar * bi + ai * br); }
  p.KT16[idx] = acc;
}
constexpr int N_BTY = 2 * SSM_G * 256 * A2K, N_BTE = 2 * SSM_G * 256 * 256;
__device__ __forceinline__ void st_tab16c(const Params& p, int idx) {
  if (idx < N_BTY) {
    const int k = idx % A2K, n = (idx / A2K) % 256, dg = idx / (A2K * 256); const int j = n / 16, co = n % 16;
    float v;
    if (k < 256) { const int j2 = k / 16, ci = k % 16; v = j2 <= j ? p.KT16[(((size_t)dg * 16 + (j - j2)) * 16 + co) * 16 + ci] : 0.f; }
    else { const int pp = (k - 256) % 64, im = (k - 256) / 64, q = dg * SSM_P + pp;
      const float ar = p.apow16[((size_t)q * 17 + j + 1) * 2], ai = p.apow16[((size_t)q * 17 + j + 1) * 2 + 1];
      const float cr = p.c_re[((size_t)dg * 16 + co) * SSM_P + pp], cim = p.c_im[((size_t)dg * 16 + co) * SSM_P + pp];
      v = im ? -(cr * ai + cim * ar) : (cr * ar - cim * ai); }
    p.BtY[idx] = f2bf(v); return; }
  idx -= N_BTY;
  const int k = idx % 256, n = (idx / 256) % 256, dg = idx / 65536; const int j = k / 16, ci = k % 16;
  float v = 0.f;
  if (n < 128) { const int pp = n % 64, im = n / 64, q = dg * SSM_P + pp;
    const float ar = p.apow16[((size_t)q * 17 + (15 - j)) * 2], ai = p.apow16[((size_t)q * 17 + (15 - j)) * 2 + 1];
    const float br = p.bbar[((size_t)q * 16 + ci) * 2], bi = p.bbar[((size_t)q * 16 + ci) * 2 + 1];
    v = im ? (ar * bi + ai * br) : (ar * br - ai * bi); }
  p.BtE[idx] = f2bf(v);
}
struct SsmOrder {
  int first, count, G, c;
  __device__ __forceinline__ bool next(int i, pg8::Unit& u) const { const int L = i * G + c; if (L >= count) return false; u.pm = first + L; u.pn = u.pm / 5; return true; }
  __device__ __forceinline__ void a_ready(const pg8::Unit&) const {}
  __device__ __forceinline__ void done(const pg8::Unit&) const {}
};
struct EpiE {
  static constexpr bool PERM = false;
  float* E;
  __device__ __forceinline__ void operator()(const f32x4 (&acc)[2][2][4][2], const pg8::Unit& u, int wr, int wc, int fr, int fq) const {
    const int row0 = u.pm * 256 + wr * 64 + fr, col0 = wc * 32 + 4 * fq;
#pragma unroll
    for (int ai = 0; ai < 2; ++ai)
#pragma unroll
      for (int m = 0; m < 4; ++m) { float* rowp = E + (size_t)(row0 + ai * 128 + m * 16) * 128 + col0;
#pragma unroll
        for (int n = 0; n < 2; ++n) *(f32x4*)(rowp + n * 16) = acc[ai][0][m][n]; }
  }
};
template <int DIR> struct EpiY {
  static constexpr bool PERM = false;
  float* Ypart; const bf16_t* P0; const float* dskip; bf16_t* Gs;
  __device__ __forceinline__ void operator()(const f32x4 (&acc)[2][2][4][2], const pg8::Unit& u, int wr, int wc, int fr, int fq) const {
    const int grp = u.pm / 5, g = grp % SSM_G, rg0 = (u.pm % 5) * 256 + wr * 64 + fr;
#pragma unroll
    for (int ai = 0; ai < 2; ++ai)
#pragma unroll
      for (int m = 0; m < 4; ++m) { const int rg = rg0 + ai * 128 + m * 16;
        if (rg < B * NCH16) { const int b = rg / NCH16, ch = rg % NCH16;
#pragma unroll
          for (int bj = 0; bj < 2; ++bj)
#pragma unroll
            for (int n = 0; n < 2; ++n) { const int j = 8 * bj + 2 * wc + n, tau = ch * LC + j;
              const int t = ssm_row(DIR, b, tau); const size_t o = (size_t)t * SSM_W + g * 16 + 4 * fq;
              if (DIR == 0) *(f32x4*)(Ypart + o) = acc[ai][bj][m][n];
              else { const f32x4 y0 = *(const f32x4*)(Ypart + o); const f32x4 dk = *(const f32x4*)(dskip + g * 16 + 4 * fq);
                const u32x2 uu = *(const u32x2*)(P0 + (size_t)t * AB_IN + A_UOFF + g * 16 + 4 * fq);
                f32x4 uv; uv.x = __builtin_bit_cast(float, uu.x << 16); uv.y = __builtin_bit_cast(float, uu.x & 0xffff0000u); uv.z = __builtin_bit_cast(float, uu.y << 16); uv.w = __builtin_bit_cast(float, uu.y & 0xffff0000u);
                const f32x4 y = acc[ai][bj][m][n] + y0 + dk * uv; float gl[4];
#pragma unroll
                for (int q = 0; q < 4; ++q) { const float x = y[q], w = 0.7978845608028654f * (x + 0.044715f * x * x * x); gl[q] = x * fast_sigmoid(2.f * w); }
                const u32x2 wv = {cvt_pk_bf16(gl[0], gl[1]), cvt_pk_bf16(gl[2], gl[3])};
                *(u32x2*)(Gs + o) = wv; } } } }
  }
};
__device__ __forceinline__ void ssm_carry_phase(const Params& p, int bx, int G, int tid) {
  for (int idx = bx * NTHR + tid; idx < 2 * SSM_G * B * SSM_P; idx += G * NTHR) {
    const int pp = idx % SSM_P, b = (idx / SSM_P) % B, dg = idx / (SSM_P * B), q = dg * SSM_P + pp;
    const float ar = p.apow16[((size_t)q * 17 + 16) * 2], ai = p.apow16[((size_t)q * 17 + 16) * 2 + 1];
    float sr = 0.f, si = 0.f;
    const size_t row0 = (size_t)dg * GROWS + (size_t)b * NCH16;
#pragma unroll 8
    for (int ch = 0; ch < NCH16; ++ch) { const size_t row = row0 + ch;
      p.A2[row * A2K + 256 + pp] = f2bf(sr); p.A2[row * A2K + 320 + pp] = f2bf(si);
      const float er = p.E16[row * 128 + pp], ei = p.E16[row * 128 + 64 + pp];
      const float nr = ar * sr - ai * si + er, ni = ar * si + ai * sr + ei; sr = nr; si = ni; }
  }
}

#define XB_TMO      128
#define XB_XCNT(j)  (256  + 64 * (j))
#define XB_XSUB(j)  (1280 + 64 * (j))
#define XB_XGEN(j)  (2304 + 64 * (j))
#define XB_TOP      3328
#define XB_TOPGEN   3392
#define XCD_BAR_WORDS 3456
#define XB_SPIN_CAP (1u << 22)
constexpr int CW_BAR = 4096;
__device__ __forceinline__ unsigned xb_ld(unsigned* p)              { return __hip_atomic_load(p, __ATOMIC_RELAXED, __HIP_MEMORY_SCOPE_AGENT); }
__device__ __forceinline__ unsigned xb_add(unsigned* p, unsigned v) { return __hip_atomic_fetch_add(p, v, __ATOMIC_RELAXED, __HIP_MEMORY_SCOPE_AGENT); }
__device__ __forceinline__ unsigned xb_xcc_id() { return (unsigned)__builtin_amdgcn_s_getreg((3 << 11) | 20) & 0xFu; }
#define XB_SPIN(cond, bar) do { unsigned _sp = 0; while (cond) { __builtin_amdgcn_s_sleep(1); \
    if ((++_sp & 255u) == 0u) { if (xb_ld(&(bar)[XB_TMO])) break; if (_sp > XB_SPIN_CAP) { atomicAdd(&(bar)[XB_TMO], 1u); break; } } } } while (0)
struct XcdBarrier { unsigned* bar; unsigned x; volatile LAS unsigned* st; };
__device__ __forceinline__ XcdBarrier xcd_barrier_post(unsigned* bar, volatile LAS unsigned* st) {
  XcdBarrier b; b.bar = bar; b.x = xb_xcc_id(); b.st = st;
  if (threadIdx.x == 0) (void)xb_add(&bar[XB_XCNT(b.x)], 1u);
  return b;
}
__device__ __forceinline__ void xcd_barrier_complete(unsigned* bar, unsigned x, unsigned& nloc, unsigned& nx) {
  const unsigned G = gridDim.x * gridDim.y * gridDim.z;
  unsigned sum, cnt, mine, sp = 0u;
  for (;;) {
    sum = 0u; cnt = 0u; mine = 0u;
#pragma unroll
    for (unsigned j = 0; j < 16; ++j) { const unsigned c = xb_ld(&bar[XB_XCNT(j)]); sum += c; cnt += (c > 0u) ? 1u : 0u; mine = (j == x) ? c : mine; }
    if (sum == G) break;
    __builtin_amdgcn_s_sleep(1);
    if ((++sp & 255u) == 0u) { if (xb_ld(&bar[XB_TMO])) break; if (sp > XB_SPIN_CAP) { atomicAdd(&bar[XB_TMO], 1u); break; } }
  }
  nloc = mine > 0u ? mine : 1u; nx = cnt > 0u ? cnt : 1u;
}
__device__ __forceinline__ void xcd_barrier(const XcdBarrier& b) {
  asm volatile("s_waitcnt vmcnt(0)" ::: "memory");
  __syncthreads();
  if (threadIdx.x == 0) {
    unsigned* bar = b.bar;
    __builtin_amdgcn_s_waitcnt(0);
    unsigned nloc = b.st[0], nx = b.st[1];
    if (nloc == 0u) { xcd_barrier_complete(bar, b.x, nloc, nx); b.st[0] = nloc; b.st[1] = nx; }
    const unsigned old = xb_add(&bar[XB_XSUB(b.x)], 1u);
    const unsigned gen = old / nloc;
    if (old + 1u == (gen + 1u) * nloc) {
      __builtin_amdgcn_fence(__ATOMIC_RELEASE, "agent");
      asm volatile("s_waitcnt vmcnt(0)" ::: "memory");
      const unsigned og = xb_add(&bar[XB_TOP], 1u);
      const unsigned tg = og / nx;
      if (og + 1u == (tg + 1u) * nx) xb_add(&bar[XB_TOPGEN], 1u);
      else XB_SPIN(xb_ld(&bar[XB_TOPGEN]) == tg, bar);
      __builtin_amdgcn_fence(__ATOMIC_ACQUIRE, "agent");
      xb_add(&bar[XB_XGEN(b.x)], 1u);
      asm volatile("s_waitcnt vmcnt(0)" ::: "memory");
    } else {
      XB_SPIN(xb_ld(&bar[XB_XGEN(b.x)]) == gen, bar);
      __builtin_amdgcn_fence(__ATOMIC_ACQUIRE, "agent");
      asm volatile("s_waitcnt vmcnt(0)" ::: "memory");
    }
  }
  __syncthreads();
}

__device__ __forceinline__ unsigned pk2(float lo, float hi) { return (unsigned)f2bf(lo) | ((unsigned)f2bf(hi) << 16); }
__device__ __forceinline__ void transpose_item(const float* W, int K, int N, bf16_t* WT, int k0, int n0, int dst_row0, LAS float* scr, int lane) {
#pragma unroll 8
  for (int i = 0; i < 32; ++i) { const int kk = 2 * i + (lane >> 5); scr[kk * 33 + (lane & 31)] = W[(size_t)(k0 + kk) * N + n0 + (lane & 31)]; }
  LDS_WAIT(); asm volatile("" ::: "memory");
  const int c = lane & 7;
#pragma unroll
  for (int j = 0; j < 4; ++j) { const int n = (lane >> 3) + 8 * j; const LAS float* s = scr + (8 * c) * 33 + n;
    u32x4 o; o.x = pk2(s[0 * 33], s[1 * 33]); o.y = pk2(s[2 * 33], s[3 * 33]); o.z = pk2(s[4 * 33], s[5 * 33]); o.w = pk2(s[6 * 33], s[7 * 33]);
    *(u32x4*)(WT + (size_t)(dst_row0 + n) * K + k0 + 8 * c) = o; }
  LDS_WAIT(); asm volatile("" ::: "memory");
}
__device__ __forceinline__ void transpose_matrix(const float* W, int K, int N, bf16_t* WT, LAS float* scr, int gw, int ngw, int lane) {
  const int nblk = N / 32, items = (K / 64) * nblk;
  for (int it = gw; it < items; it += ngw) { const int kb = it / nblk, nb = it % nblk; transpose_item(W, K, N, WT, 64 * kb, 32 * nb, 32 * nb, scr, lane); }
}
__device__ __forceinline__ void mod_row_to_bf16(const float* xr, const float* sc, const float* sh, bf16_t* orow, int lane) {
  const f32x4* x4 = (const f32x4*)xr + lane; const f32x4* c4 = (const f32x4*)sc + lane; const f32x4* h4 = (const f32x4*)sh + lane;
  unsigned long long* o8 = (unsigned long long*)orow + lane;
#pragma unroll
  for (int j = 0; j < 4; ++j) { const f32x4 v = x4[64 * j], c = c4[64 * j], h = h4[64 * j];
    const float a = v.x * (1.f + c.x) + h.x, b = v.y * (1.f + c.y) + h.y, cc = v.z * (1.f + c.z) + h.z, d = v.w * (1.f + c.w) + h.w;
    o8[64 * j] = (unsigned long long)pk2(a, b) | ((unsigned long long)pk2(cc, d) << 32); }
}


__device__ __forceinline__ float wave_sum(float v) {
#pragma unroll
  for (int o = 1; o < 64; o <<= 1) v += __shfl_xor(v, o);
  return v;
}
constexpr int CW_CNT = 2048;
__device__ __forceinline__ void ln1_route_row(const Params& p, int layer, int t, int lane) {
  const int r = tok_r(t);
  const f32x4* x4 = (const f32x4*)xrow(p, layer, t) + lane; const f32x4* y4 = (const f32x4*)(p.F + (size_t)t * D) + lane;
  const f32x4* g4 = (const f32x4*)modp(p, layer, r, 2) + lane;
  f32x4 v[4]; float s = 0.f;
#pragma unroll
  for (int j = 0; j < 4; ++j) { v[j] = x4[64 * j] * ALPHA + g4[64 * j] * y4[64 * j]; s += (v[j].x + v[j].y) + (v[j].z + v[j].w); }
  const float mean = wave_sum(s) * (1.f / D); float s2 = 0.f;
#pragma unroll
  for (int j = 0; j < 4; ++j) { v[j] = v[j] - mean; s2 += (v[j].x * v[j].x + v[j].y * v[j].y) + (v[j].z * v[j].z + v[j].w * v[j].w); }
  const float rstd = 1.f / sqrtf(wave_sum(s2) * (1.f / D) + LN_EPS);
  const f32x4* lg4 = (const f32x4*)(p.ln1_g + (size_t)layer * D) + lane; const f32x4* lb4 = (const f32x4*)(p.ln1_b + (size_t)layer * D) + lane;
  const f32x4* sc4 = (const f32x4*)modp(p, layer, r, 4) + lane; const f32x4* sh4 = (const f32x4*)modp(p, layer, r, 3) + lane;
  f32x4* o4 = (f32x4*)(p.X1 + (size_t)t * D) + lane;
#pragma unroll
  for (int j = 0; j < 4; ++j) { v[j] = v[j] * rstd * lg4[64 * j] + lb4[64 * j]; o4[64 * j] = v[j]; v[j] = v[j] * (sc4[64 * j] + 1.f) + sh4[64 * j]; }
  const f32x4* wg4 = (const f32x4*)(p.moe_wg + (size_t)layer * D * MOE_G);
  f32x4 gl = {0.f, 0.f, 0.f, 0.f};
#pragma unroll
  for (int j = 0; j < 4; ++j)
#pragma unroll
    for (int c = 0; c < 4; ++c) gl += wg4[4 * (lane + 64 * j) + c] * v[j][c];
  asm volatile("" ::: "memory");
  float lgv[4];
#pragma unroll
  for (int g = 0; g < 4; ++g) lgv[g] = wave_sum(gl[g]) + p.moe_bg[layer * MOE_G + g];
  int gi = 0; float mx = lgv[0];
#pragma unroll
  for (int g = 1; g < 4; ++g) if (lgv[g] > mx) { mx = lgv[g]; gi = g; }
  float den = 0.f;
#pragma unroll
  for (int g = 0; g < 4; ++g) den += expf(lgv[g] - mx);
  const float gp = 1.0f / den;
  gi = __builtin_amdgcn_readfirstlane(gi);
  const f32x4* we4 = (const f32x4*)(p.moe_we + ((size_t)layer * MOE_G + gi) * D * MOE_EPG);
  f32x4 e0 = {0.f, 0.f, 0.f, 0.f}, e1 = {0.f, 0.f, 0.f, 0.f};
#pragma unroll
  for (int j = 0; j < 4; ++j) {
#pragma unroll
    for (int c = 0; c < 4; ++c) { const int k = 4 * (lane + 64 * j) + c; e0 += we4[2 * k] * v[j][c]; e1 += we4[2 * k + 1] * v[j][c]; }
    asm volatile("" ::: "memory"); }
  float le[8];
#pragma unroll
  for (int e = 0; e < 4; ++e) { le[e] = wave_sum(e0[e]) + p.moe_be[(layer * MOE_G + gi) * MOE_EPG + e]; le[4 + e] = wave_sum(e1[e]) + p.moe_be[(layer * MOE_G + gi) * MOE_EPG + 4 + e]; }
  int i0 = 0; float v0 = le[0];
#pragma unroll
  for (int e = 1; e < 8; ++e) if (le[e] > v0) { v0 = le[e]; i0 = e; }
  int i1 = -1; float v1 = -3e38f;
#pragma unroll
  for (int e = 0; e < 8; ++e) if (e != i0 && le[e] > v1) { v1 = le[e]; i1 = e; }
  if (lane == 0) {
    const float ex = expf(v1 - v0);
    const int ea = gi * MOE_EPG + i0, eb = gi * MOE_EPG + i1;
    const unsigned pa = atomicAdd(p.ctl + CW_CNT + 64 * layer + ea, 1u), pb = atomicAdd(p.ctl + CW_CNT + 64 * layer + eb, 1u);
    float* rt = p.route + (size_t)t * 8;
    rt[0] = (float)ea; rt[1] = (float)eb; rt[2] = gp / (1.0f + ex); rt[3] = gp * ex / (1.0f + ex); rt[4] = (float)pa; rt[5] = (float)pb;
  }
}
__device__ __forceinline__ void scatter_phase(const Params& p, int layer, int T, LAS unsigned char* lds, int gw, int ngw, int lane, int tid) {
  LAS int* off = (LAS int*)lds;
  if (tid == 0) {
    int o = 0, ntile = 0;
    for (int e = 0; e < MOE_E; ++e) { const int c = (int)__hip_atomic_load(p.ctl + CW_CNT + 64 * layer + e, __ATOMIC_RELAXED, __HIP_MEMORY_SCOPE_AGENT);
      off[e] = o; const int nt = (c + 255) >> 8;
      if (blockIdx.x == 0) for (int i = 0; i < nt; ++i) p.moe_meta[1 + ntile + i] = e;
      ntile += nt; o += nt * 256; }
    if (blockIdx.x == 0) p.moe_meta[0] = ntile;
  }
  __syncthreads();
  for (int t = gw; t < T; t += ngw) {
    const int r = tok_r(t);
    const float* rt = p.route + (size_t)t * 8;
    const int ea = (int)rt[0], eb = (int)rt[1]; const float wa = rt[2], wb = rt[3];
    const int sa = off[ea] + (int)rt[4], sb = off[eb] + (int)rt[5];
    const f32x4* x4 = (const f32x4*)(p.X1 + (size_t)t * D) + lane;
    const f32x4* sc4 = (const f32x4*)modp(p, layer, r, 4) + lane; const f32x4* sh4 = (const f32x4*)modp(p, layer, r, 3) + lane;
    unsigned long long* oa = (unsigned long long*)(p.Amoe + (size_t)sa * D) + lane; unsigned long long* ob = (unsigned long long*)(p.Amoe + (size_t)sb * D) + lane;
#pragma unroll
    for (int j = 0; j < 4; ++j) { const f32x4 h = x4[64 * j] * (sc4[64 * j] + 1.f) + sh4[64 * j];
      const unsigned long long w = (unsigned long long)pk2(h.x, h.y) | ((unsigned long long)pk2(h.z, h.w) << 32); oa[64 * j] = w; ob[64 * j] = w; }
    if (lane == 0) { p.gate[sa] = wa; p.gate[sb] = wb; p.tokslot[2 * t] = sa; p.tokslot[2 * t + 1] = sb; }
  }
}
__device__ __forceinline__ void ln2_row(const Params& p, int layer, int t, int lane) {
  const int r = tok_r(t);
  const int sa = p.tokslot[2 * t], sb = p.tokslot[2 * t + 1];
  const f32x4* x4 = (const f32x4*)(p.X1 + (size_t)t * D) + lane; const f32x4* g4 = (const f32x4*)modp(p, layer, r, 5) + lane;
  const u32x2* fa = (const u32x2*)(p.F2 + (size_t)sa * D) + lane; const u32x2* fb = (const u32x2*)(p.F2 + (size_t)sb * D) + lane;
  f32x4 v[4]; float s = 0.f;
#pragma unroll
  for (int j = 0; j < 4; ++j) { const u32x2 a = fa[64 * j], b = fb[64 * j];
    f32x4 f; f.x = __builtin_bit_cast(float, a.x << 16) + __builtin_bit_cast(float, b.x << 16); f.y = __builtin_bit_cast(float, a.x & 0xffff0000u) + __builtin_bit_cast(float, b.x & 0xffff0000u);
    f.z = __builtin_bit_cast(float, a.y << 16) + __builtin_bit_cast(float, b.y << 16); f.w = __builtin_bit_cast(float, a.y & 0xffff0000u) + __builtin_bit_cast(float, b.y & 0xffff0000u);
    v[j] = x4[64 * j] * ALPHA + g4[64 * j] * f; s += (v[j].x + v[j].y) + (v[j].z + v[j].w); }
  const float mean = wave_sum(s) * (1.f / D); float s2 = 0.f;
#pragma unroll
  for (int j = 0; j < 4; ++j) { v[j] = v[j] - mean; s2 += (v[j].x * v[j].x + v[j].y * v[j].y) + (v[j].z * v[j].z + v[j].w * v[j].w); }
  const float rstd = 1.f / sqrtf(wave_sum(s2) * (1.f / D) + LN_EPS);
  const f32x4* lg4 = (const f32x4*)(p.ln2_g + (size_t)layer * D) + lane; const f32x4* lb4 = (const f32x4*)(p.ln2_b + (size_t)layer * D) + lane;
  if (layer == DEPTH - 1) {
    f32x4* o4 = (f32x4*)(p.out + (size_t)t * D) + lane;
#pragma unroll
    for (int j = 0; j < 4; ++j) o4[64 * j] = v[j] * rstd * lg4[64 * j] + lb4[64 * j];
  } else {
    f32x4* o4 = (f32x4*)(p.X + (size_t)t * D) + lane;
    const f32x4* sc4 = (const f32x4*)modp(p, layer + 1, r, 1) + lane; const f32x4* sh4 = (const f32x4*)modp(p, layer + 1, r, 0) + lane;
    unsigned long long* h8 = (unsigned long long*)(p.H + (size_t)t * D) + lane;
#pragma unroll
    for (int j = 0; j < 4; ++j) { const f32x4 o = v[j] * rstd * lg4[64 * j] + lb4[64 * j]; o4[64 * j] = o;
      const f32x4 h = o * (sc4[64 * j] + 1.f) + sh4[64 * j];
      h8[64 * j] = (unsigned long long)pk2(h.x, h.y) | ((unsigned long long)pk2(h.z, h.w) << 32); }
  }
}
__device__ __forceinline__ void moe_weight_transposes(const Params& p, int layer, LAS float* scr, int gw, int ngw, int lane) {
  constexpr int I13 = (D / 64) * (MOE_F / 32), I2 = (MOE_F / 64) * (D / 32);
  constexpr int NIT = MOE_E * (2 * I13 + I2);
  for (int it = gw; it < NIT; it += ngw) {
    const int e = it / (2 * I13 + I2); int r = it % (2 * I13 + I2);
    if (r < 2 * I13) { const int which = r / I13; r %= I13; const int kb = r / (MOE_F / 32), nb = r % (MOE_F / 32), n0 = 32 * nb;
      const float* W = (which ? p.moe_w3 : p.moe_w1) + ((size_t)layer * MOE_E + e) * D * MOE_F;
      transpose_item(W, D, MOE_F, p.W13t, 64 * kb, n0, e * 2 * MOE_F + (n0 / 128) * 256 + which * 128 + (n0 % 128), scr, lane);
    } else { r -= 2 * I13; const int kb = r / (D / 32), nb = r % (D / 32);
      const float* W = p.moe_w2 + ((size_t)layer * MOE_E + e) * MOE_F * D;
      transpose_item(W, MOE_F, D, p.W2t, 64 * kb, 32 * nb, e * D + 32 * nb, scr, lane); }
  }
}


__device__ __forceinline__ void mod_phase(const Params& p, LAS unsigned char* lds, int vcu, int G, int tid, int lane, int wave) {
  constexpr int NR = B + 1, RP = 12;
  LAS float* sT = (LAS float*)lds;
  LAS float* part = sT + D * RP;
  for (int i = tid; i < NR * D; i += NTHR) { const int r = i / D, k = i % D; const float c = r < B ? p.c[(size_t)r * D + k] : p.c_ctx[k]; sT[k * RP + r] = c / (1.0f + __expf(-c)); }
  __syncthreads();
  constexpr int NT_ = DEPTH * (6 * D / 64);
  for (int task = vcu; task < NT_; task += G) {
    const int l = task / (6 * D / 64), j = (task % (6 * D / 64)) * 64 + lane;
    const float* w = p.mod_w + (size_t)l * D * 6 * D + (size_t)(wave * 128) * 6 * D + j;
    float acc[NR];
#pragma unroll
    for (int r = 0; r < NR; ++r) acc[r] = 0.f;
#pragma unroll 1
    for (int k0 = 0; k0 < 128; k0 += 16) {
      float wv[16];
#pragma unroll
      for (int u = 0; u < 16; ++u) wv[u] = w[(size_t)(k0 + u) * 6 * D];
#pragma unroll
      for (int u = 0; u < 16; ++u) { const LAS float* sr = sT + (wave * 128 + k0 + u) * RP;
        const f32x4 s0 = *(const LAS f32x4*)sr, s1 = *(const LAS f32x4*)(sr + 4); const float s8 = sr[8];
        acc[0] += s0.x * wv[u]; acc[1] += s0.y * wv[u]; acc[2] += s0.z * wv[u]; acc[3] += s0.w * wv[u];
        acc[4] += s1.x * wv[u]; acc[5] += s1.y * wv[u]; acc[6] += s1.z * wv[u]; acc[7] += s1.w * wv[u]; acc[8] += s8 * wv[u]; }
    }
#pragma unroll
    for (int r = 0; r < NR; ++r) part[(wave * NR + r) * 64 + lane] = acc[r];
    __syncthreads();
    for (int i = tid; i < NR * 64; i += NTHR) { const int r = i / 64, c = i % 64; float v = p.mod_b[(size_t)l * 6 * D + (task % (6 * D / 64)) * 64 + c];
#pragma unroll
      for (int ww = 0; ww < 8; ++ww) v += part[(ww * NR + r) * 64 + c];
      p.modv[((size_t)(l * NR + r) * 6 * D) + (task % (6 * D / 64)) * 64 + c] = v; }
    __syncthreads();
  }
}

__global__ void __launch_bounds__(NTHR, 2) mega_kernel(Params p_by_value) {
  const Params& p = *(const Params*)__builtin_amdgcn_kernarg_segment_ptr();
  extern __shared__ __attribute__((aligned(16))) unsigned char lds_raw[];
  LAS unsigned char* lds = (LAS unsigned char*)lds_raw;
  volatile LAS unsigned* MISC = (volatile LAS unsigned*)(lds + MISC_OFF);
  for (int u = threadIdx.x; u < (LDS_BYTES - LDSCTL_OFF) / 4; u += NTHR) ((LAS unsigned*)(lds + LDSCTL_OFF))[u] = 0u;
  __syncthreads();
  XcdBarrier bar = xcd_barrier_post(p.ctl + CW_BAR, MISC + 8);
#define PH_VARS                                                                                                       \
  int tid = threadIdx.x; asm volatile("" : "+v"(tid));                                                                \
  int bx = blockIdx.x; asm volatile("" : "+s"(bx));                                                                   \
  const int lane = tid & 63, wave = __builtin_amdgcn_readfirstlane(tid >> 6), G = gridDim.x;                          \
  const int vcu = (G % 8 == 0) ? (bx % 8) * (G / 8) + bx / 8 : bx;                                                    \
  const int gw = vcu * NWAVES + wave, ngw = G * NWAVES;                                                               \
  LAS float* scr = (LAS float*)(lds + wave * 16384);                                                                  \
  (void)lane; (void)gw; (void)ngw; (void)scr; (void)vcu;
#define GRID_BAR() xcd_barrier(bar)
#define RUN_NAIVE(S, layer, cnt)                                                                                  \
  {                                                                                                               \
    const int n_ = (cnt);                                                                                         \
    PH_VARS                                                                                                       \
    for (int idx = bx * NTHR + tid; idx < n_; idx += G * NTHR) run_elem<S>(p, layer, idx);                        \
  }

  { PH_VARS mod_phase(p, lds, vcu, G, tid, lane, wave); }
  RUN_NAIVE(S_TABA, 0, N_TABA)
  { PH_VARS for (int idx = bx * NTHR + tid; idx < N_TAB16A; idx += G * NTHR) st_tab16a(p, idx); }
  { PH_VARS
  transpose_matrix(p.w_in_a, D, AB_IN, p.WinA_t, scr, gw, ngw, lane);
  transpose_matrix(p.dif_w_in, D, DIF_IN, p.DifIn_t, scr, gw, ngw, lane);
  transpose_matrix(p.w_out_a, AB_OUT, D, p.WoutA_t, scr, gw, ngw, lane);
  transpose_matrix(p.dif_w_out, DIF_VW, D, p.DifOut_t, scr, gw, ngw, lane);
  transpose_matrix(p.glu_w, SSM_W, SSM_W, p.Glu_t, scr, gw, ngw, lane);
  moe_weight_transposes(p, 0, scr, gw, ngw, lane); }
  GRID_BAR();
  { PH_VARS for (int idx = bx * NTHR + tid; idx < N_TAB16B; idx += G * NTHR) st_tab16b(p, idx); }
  { PH_VARS for (int m = gw; m < TA; m += ngw) { const int r = tok_r(m); mod_row_to_bf16(xrow(p, 0, m), modp(p, 0, r, 1), modp(p, 0, r, 0), p.H + (size_t)m * D, lane); } }
  GRID_BAR();
#define PROJ_GEMM(NW_, WT_, ROPE_END_, A2_)                                                                                  \
  { PH_VARS                                                                                                             \
    pg8::Gemm g{p.H, WT_, D, D, D};                                                                                     \
    pg8::StaticOrder S; S.init(TA, NW_, G, bx);                                                            \
    EpiProj E{p.P, NW_, ROPE_END_, p.ropeT, A2_};                                                                            \
    pg8::gemm_phase<EpiProj, pg8::StaticOrder>(lds, g, S, E);                                                           \
  }                                                                                                                     \
  GRID_BAR();
#define LAYER_BACK(layer, T, WOT_, KO_)                                                                                 \
  { PH_VARS                                                                            \
    pg8::Gemm g{p.Ymix, WOT_, YW, KO_, KO_};                                                                            \
    pg8::StaticOrder S; S.init(T, D, G, bx);                                                               \
    EpiF32Out E{p.F, D};                                                                                                \
    pg8::gemm_phase<EpiF32Out, pg8::StaticOrder>(lds, g, S, E);                                                         \
  }                                                                                                                     \
  GRID_BAR();                                                                                                           \
  { PH_VARS for (int t = gw; t < T; t += ngw) ln1_route_row(p, layer, t, lane); }                                      \
  GRID_BAR();                                                                                                           \
  { PH_VARS scatter_phase(p, layer, T, lds, gw, ngw, lane, tid); }                                                      \
  GRID_BAR();                                                                                                           \
  { PH_VARS                                                             \
    pg8::Gemm g{p.Amoe, p.W13t, D, D, D};                                                                               \
    MoeOrder S{p.moe_meta, 2, G, vcu};                                                                                  \
    EpiMoe1 E{p.HHb, p.gate};                                                                                           \
    pg8::gemm_phase<EpiMoe1, MoeOrder>(lds, g, S, E);                                                                   \
  }                                                                                                                     \
  GRID_BAR();                                                                                                           \
  { PH_VARS                                                                                  \
    pg8::Gemm g{p.HHb, p.W2t, MOE_F, MOE_F, MOE_F};                                                                     \
    MoeOrder S{p.moe_meta, 4, G, vcu};                                                                                  \
    EpiBf16Out E{p.F2, D, 4};                                                                                           \
    pg8::gemm_phase<EpiBf16Out, MoeOrder>(lds, g, S, E);                                                                \
  }                                                                                                                     \
  GRID_BAR();                                                                                                           \
  { PH_VARS for (int t = gw; t < T; t += ngw) ln2_row(p, layer, t, lane); }

  { PH_VARS for (int idx = bx * NTHR + tid; idx < N_BTY + N_BTE; idx += G * NTHR) st_tab16c(p, idx); }
  PROJ_GEMM(AB_IN, p.WinA_t, (SWA_QW + SWA_KVW), p.A2)
  { PH_VARS att::swa_phase(p, lds, G, vcu, tid); }
  { PH_VARS
    pg8::Gemm g{p.A2, p.BtE, A2K, 256, 256};
    SsmOrder S{0, 2 * SSM_G * 5, G, vcu};
    EpiE E{p.E16};
    pg8::gemm_phase<EpiE, SsmOrder>(lds, g, S, E);
  }
  GRID_BAR();
  { PH_VARS ssm_carry_phase(p, bx, G, tid); }
  GRID_BAR();
  { PH_VARS
    pg8::Gemm g{p.A2, p.BtY, A2K, A2K, A2K};
    SsmOrder S{0, SSM_G * 5, G, vcu};
    EpiY<0> E{p.Ypart, p.P, p.ssm_d, p.Gs};
    pg8::gemm_phase<EpiY<0>, SsmOrder>(lds, g, S, E);
  }
  GRID_BAR();
  { PH_VARS
    pg8::Gemm g{p.A2, p.BtY, A2K, A2K, A2K};
    SsmOrder S{SSM_G * 5, SSM_G * 5, G, vcu};
    EpiY<1> E{p.Ypart, p.P, p.ssm_d, p.Gs};
    pg8::gemm_phase<EpiY<1>, SsmOrder>(lds, g, S, E);
  }
  GRID_BAR();
  { PH_VARS
    pg8::Gemm g{p.Gs, p.Glu_t, SSM_W, SSM_W, SSM_W};
    pg8::StaticOrder S; S.init(TA, SSM_W, G, bx);
    EpiGlu E{p.Gs, p.glu_b, p.Ymix, YW, SWA_QW};
    pg8::gemm_phase<EpiGlu, pg8::StaticOrder>(lds, g, S, E);
  }
  GRID_BAR();
  LAYER_BACK(0, TA, p.WoutA_t, AB_OUT)
  { PH_VARS moe_weight_transposes(p, 1, scr, gw, ngw, lane); }
  GRID_BAR();
  PROJ_GEMM(DIF_IN, p.DifIn_t, (2 * DIF_QK), nullptr)
  { PH_VARS att::dif_phase(p, lds, G, vcu, tid); }
  GRID_BAR();
  LAYER_BACK(1, TL, p.DifOut_t, DIF_VW)
}

extern "C" void kernel_launch(void* const* d_in, const int* in_sizes, int n_in, void* d_out, int out_size, void* d_ws,
                              size_t ws_size, hipStream_t stream) {
  static int grid = 0;
  if (grid == 0) {
    if (ws_layout().total > ws_size || n_in != 37 || out_size != TL * D) { fprintf(stderr, "kernel_launch: bad sizes (ws need %zu have %zu)\n", ws_layout().total, ws_size); grid = -1; return; }
    int dev = 0, cus = 0;
    if (hipGetDevice(&dev) != hipSuccess || hipDeviceGetAttribute(&cus, hipDeviceAttributeMultiprocessorCount, dev) != hipSuccess) { grid = -1; return; }
    if (hipFuncSetAttribute((const void*)mega_kernel, hipFuncAttributeMaxDynamicSharedMemorySize, LDS_BYTES) != hipSuccess) { fprintf(stderr, "kernel_launch: hipFuncSetAttribute failed\n"); grid = -1; return; }
    grid = cus;
  }
  if (grid < 0) return;
  Params p{};
  fill_inputs(p, d_in);
  p.out = (float*)d_out;
  fill_ws(p, (char*)d_ws);
  if (hipMemsetAsync((char*)d_ws + ws_layout().ctl, 0, CTL_BYTES, stream) != hipSuccess) { fprintf(stderr, "kernel_launch: memset failed\n"); return; }
  hipLaunchKernelGGL(mega_kernel, dim3(grid), dim3(NTHR), LDS_BYTES, stream, p);
  const hipError_t le = hipPeekAtLastError();
  if (le != hipSuccess) fprintf(stderr, "kernel_launch: launch failed: %s\n", hipGetErrorName(le));
}
#endif
```

```cpp
#ifndef HOST_EMU
#include <hip/hip_runtime.h>
#define HD __host__ __device__ __forceinline__
#else
#define HD inline
#endif
#include <stdint.h>
#include <math.h>

#ifndef CFG_D
#define CFG_D 1024
#define CFG_B 8
#define CFG_N 2048
#define CFG_CTX 256
#endif

constexpr int D = CFG_D, B = CFG_B, N = CFG_N, CTX = CFG_CTX;
constexpr int DEPTH = 2, GRID_W = 64, HD_ = 64;
constexpr int TL = B * N, TC = B * CTX, TA = TL + TC;
constexpr int SWA_H = 8, SWA_QW = 512, SWA_KVW = 128, SWA_WIN = 128;
constexpr int SSM_W = D / 2, SSM_C = 16, SSM_G = SSM_W / 16, SSM_P = 64;
constexpr int AB_IN = SWA_QW + 2 * SWA_KVW + SSM_W;
constexpr int AB_OUT = SWA_QW + SSM_W;
constexpr int A_KOFF = SWA_QW, A_VOFF = SWA_QW + SWA_KVW, A_UOFF = SWA_QW + 2 * SWA_KVW;
constexpr int DIF_H = D / 128, DIF_QK = DIF_H * 128, DIF_VW = DIF_H * 128, DIF_IN = 2 * DIF_QK + DIF_VW;
constexpr int MOE_G = 4, MOE_EPG = 8, MOE_E = 32, MOE_F = D / 4;
constexpr int SL = 64;
constexpr int SS = CTX + N;
constexpr int NCH = SS / SL;
constexpr float LN_EPS = 1e-5f, RMS_EPS = 1e-5f;
constexpr float ALPHA = 1.41421356237309515f;
static_assert(CTX % SL == 0 && N % SL == 0, "chunking");
constexpr int YW = AB_OUT > D ? AB_OUT : D;

struct Params {
  const float *x, *c, *ctx, *c_ctx, *mod_w, *mod_b, *ln1_g, *ln1_b, *ln2_g, *ln2_b;
  const float *w_in_a, *w_out_a, *sink, *a_re, *a_im, *log_step, *b_re, *b_im, *c_re, *c_im, *ssm_d, *glu_w, *glu_b;
  const float *dif_w_in, *dif_w_out, *lq1, *lk1, *lq2, *lk2, *subln_g;
  const float *moe_wg, *moe_bg, *moe_we, *moe_be, *moe_w1, *moe_w3, *moe_w2;
  float* out;
  float *X, *X1, *F, *HH;
  uint16_t *P, *Ymix, *Gs;
  float *modv, *ropeT, *apow, *bbar, *KT, *E, *Sin, *route, *scal;
  uint16_t *H;
  uint16_t *WinA_t, *DifIn_t, *WoutA_t, *DifOut_t, *Glu_t, *W13t, *W2t;
  uint16_t *Amoe, *HHb, *F2;
  float* gate;
  int *wgbase;
  int *tokslot, *moe_meta;
  uint16_t *A2, *BtY, *BtE;
  float *apow16, *KT16, *E16, *Ypart;
  unsigned* ctl;
};

HD uint16_t f2bf(float f) {
  uint32_t u = __builtin_bit_cast(uint32_t, f);
  u += 0x7fffu + ((u >> 16) & 1u);
  return (uint16_t)(u >> 16);
}
HD float bf2f(uint16_t h) {
  uint32_t u = ((uint32_t)h) << 16;
  return __builtin_bit_cast(float, u);
}
HD float siluf(float x) { return x / (1.0f + expf(-x)); }
HD float sigmoidf_(float x) { return 1.0f / (1.0f + expf(-x)); }
HD float geluf_(float x) { return 0.5f * x * (1.0f + tanhf(0.7978845608028654f * (x + 0.044715f * x * x * x))); }

HD int tok_r(int t) { return t < TL ? t / N : B; }
HD const float* xrow(const Params& p, int layer, int t) {
  if (layer == 0) return t < TL ? p.x + (size_t)t * D : p.ctx + (size_t)(t - TL) * D;
  return p.X + (size_t)t * D;
}
HD const float* modp(const Params& p, int layer, int r, int which) {
  return p.modv + ((size_t)(layer * (B + 1) + r) * 6 + which) * D;
}

constexpr int N_MOD = DEPTH * (B + 1) * 6 * D;
HD void st_mod(const Params& p, int layer_unused, int idx) {
  int j = idx % (6 * D); int r = (idx / (6 * D)) % (B + 1); int l = idx / (6 * D * (B + 1));
  const float* cv = r < B ? p.c + (size_t)r * D : p.c_ctx;
  const float* w = p.mod_w + (size_t)l * D * 6 * D;
  float acc = p.mod_b[(size_t)l * 6 * D + j];
  for (int k = 0; k < D; ++k) acc += siluf(cv[k]) * w[(size_t)k * 6 * D + j];
  p.modv[idx] = acc;
}

constexpr int N_ROPE = 64 * 16;
constexpr int N_APOW = 2 * SSM_G * SSM_P * (SL + 1);
constexpr int N_BBAR = 2 * SSM_G * SSM_P * SSM_C;
constexpr int N_TABA = N_ROPE + N_APOW + N_BBAR + 1;
HD void st_taba(const Params& p, int layer_unused, int idx) {
  if (idx < N_ROPE) {
    int pos = idx / 16, f = idx % 16;
    float inv = powf(10000.0f, -(float)f / 16.0f);
    float ang = (float)pos * inv;
    p.ropeT[idx * 2] = cosf(ang); p.ropeT[idx * 2 + 1] = sinf(ang);
    return;
  }
  idx -= N_ROPE;
  if (idx < N_APOW) {
#ifndef HOST_EMU
    return;
#endif
    int k = idx % (SL + 1); int q = idx / (SL + 1);
    int dg = q / SSM_P;
    double dt = exp((double)p.log_step[dg]);
    double ar = p.a_re[q], ai = p.a_im[q];
    double mag = exp(k * dt * ar);
    p.apow[(size_t)idx * 2] = (float)(mag * cos(k * dt * ai));
    p.apow[(size_t)idx * 2 + 1] = (float)(mag * sin(k * dt * ai));
    return;
  }
  idx -= N_APOW;
  if (idx < N_BBAR) {
    int cc = idx % SSM_C; int q = idx / SSM_C; int dg = q / SSM_P;
    (void)cc;
    double dt = exp((double)p.log_step[dg]);
    double ar = p.a_re[q], ai = p.a_im[q];
    double mag = exp(dt * ar);
    double abr = mag * cos(dt * ai), abi = mag * sin(dt * ai);
    double den = ar * ar + ai * ai, nr = abr - 1.0;
    double cr = (nr * ar + abi * ai) / den, ci = (abi * ar - nr * ai) / den;
    double br = p.b_re[idx], bi = p.b_im[idx];
    p.bbar[(size_t)idx * 2] = (float)(cr * br - ci * bi);
    p.bbar[(size_t)idx * 2 + 1] = (float)(cr * bi + ci * br);
    return;
  }
  double s1 = 0, s2 = 0;
  for (int i = 0; i < HD_; ++i) { s1 += (double)p.lq1[i] * p.lk1[i]; s2 += (double)p.lq2[i] * p.lk2[i]; }
  double lam_init = 0.8 - 0.6 * exp(-0.3 * 1.0);
  p.scal[0] = (float)(exp(s1) - exp(s2) + lam_init);
  p.scal[1] = (float)(1.0 - lam_init);
}

constexpr int N_KT = 2 * SSM_G * SL * SSM_C * SSM_C;
HD void st_tabb(const Params& p, int layer_unused, int idx) {
  int ci = idx % SSM_C; int co = (idx / SSM_C) % SSM_C; int k = (idx / (SSM_C * SSM_C)) % SL; int dg = idx / (SSM_C * SSM_C * SL);
  float acc = 0.f;
  for (int pp = 0; pp < SSM_P; ++pp) {
    int q = dg * SSM_P + pp;
    float ar = p.apow[((size_t)q * (SL + 1) + k) * 2], ai = p.apow[((size_t)q * (SL + 1) + k) * 2 + 1];
    float br = p.bbar[((size_t)q * SSM_C + ci) * 2], bi = p.bbar[((size_t)q * SSM_C + ci) * 2 + 1];
    float cr = p.c_re[((size_t)dg * SSM_C + co) * SSM_P + pp], cim = p.c_im[((size_t)dg * SSM_C + co) * SSM_P + pp];
    float tr = ar * br - ai * bi, ti = ar * bi + ai * br;
    acc += cr * tr - cim * ti;
  }
  p.KT[idx] = acc;
}

HD void st_proj(const Params& p, int layer, int idx) {
  const int W = layer == 0 ? AB_IN : DIF_IN;
  const float* w = layer == 0 ? p.w_in_a : p.dif_w_in;
  const int rope_end = layer == 0 ? (SWA_QW + SWA_KVW) : (2 * DIF_QK);
  int t = idx / W, n = idx % W;
  int r = tok_r(t);
  if (layer == 1 && t >= TL && n < DIF_QK) return;
  const float* xr = xrow(p, layer, t);
  const float* sh = modp(p, layer, r, 0);
  const float* sc = modp(p, layer, r, 1);
  bool rope = (t < TL) && (n < rope_end);
  if (!rope) {
    float acc = 0.f;
    for (int k = 0; k < D; ++k) { float h = xr[k] * (1.0f + sc[k]) + sh[k]; acc += h * w[(size_t)k * W + n]; }
    p.P[(size_t)t * W + n] = f2bf(acc);
    return;
  }
  int d = n % 64, sub = d % 32;
  if (sub >= 16) return;
  float a1 = 0.f, a2 = 0.f;
  for (int k = 0; k < D; ++k) {
    float h = xr[k] * (1.0f + sc[k]) + sh[k];
    a1 += h * w[(size_t)k * W + n]; a2 += h * w[(size_t)k * W + n + 16];
  }
  int i = t % N;
  int pos = d < 32 ? i / GRID_W : i % GRID_W;
  float cs = p.ropeT[(pos * 16 + sub) * 2], sn = p.ropeT[(pos * 16 + sub) * 2 + 1];
  p.P[(size_t)t * W + n] = f2bf(a1 * cs - a2 * sn);
  p.P[(size_t)t * W + n + 16] = f2bf(a2 * cs + a1 * sn);
}

HD void st_swa(const Params& p, int layer, int idx) {
  int hq = idx / TA, t = idx % TA;
  int kvh = hq / 4;
  const uint16_t* P = p.P;
  float q[64], o[64];
  _Pragma("unroll") for (int d = 0; d < 64; ++d) { q[d] = bf2f(P[(size_t)t * AB_IN + hq * 64 + d]) * 0.125f; o[d] = 0.f; }
  float m = p.sink[hq], l = 1.0f;
  int b = t < TL ? t / N : (t - TL) / CTX;
  int nloc = t < TL ? 2 * SWA_WIN + 1 : 0;
  int i = t < TL ? t % N : 0;
  for (int kk = 0; kk < nloc + CTX; ++kk) {
    int row;
    if (kk < nloc) {
      int j = i - SWA_WIN + kk;
      if (j < 0 || j >= N) continue;
      row = b * N + j;
    } else row = TL + b * CTX + (kk - nloc);
    const uint16_t* kr = P + (size_t)row * AB_IN + A_KOFF + kvh * 64;
    const uint16_t* vr = P + (size_t)row * AB_IN + A_VOFF + kvh * 64;
    float s = 0.f;
    _Pragma("unroll") for (int d = 0; d < 64; ++d) s += q[d] * bf2f(kr[d]);
    if (s > m) { float f = expf(m - s); l *= f; for (int d = 0; d < 64; ++d) o[d] *= f; m = s; }
    float pe = expf(s - m);
    l += pe;
    _Pragma("unroll") for (int d = 0; d < 64; ++d) o[d] += pe * bf2f(vr[d]);
  }
  float il = 1.0f / l;
  _Pragma("unroll") for (int d = 0; d < 64; ++d) p.Ymix[(size_t)t * YW + hq * 64 + d] = f2bf(o[d] * il);
}

HD int ssm_row(int dir, int b, int tau) {
  if (dir == 0) return tau < CTX ? TL + b * CTX + tau : b * N + (tau - CTX);
  return tau < CTX ? TL + b * CTX + (CTX - 1 - tau) : b * N + (N - 1 - (tau - CTX));
}
constexpr int N_SSME = 2 * B * NCH * SSM_G * SSM_P;
HD void st_ssm_e(const Params& p, int layer, int idx) {
  int pp = idx % SSM_P; int g = (idx / SSM_P) % SSM_G; int ch = (idx / (SSM_P * SSM_G)) % NCH;
  int b = (idx / (SSM_P * SSM_G * NCH)) % B; int dir = idx / (SSM_P * SSM_G * NCH * B);
  int q = (dir * SSM_G + g) * SSM_P + pp;
  float er = 0.f, ei = 0.f;
  for (int j = 0; j < SL; ++j) {
    int row = ssm_row(dir, b, ch * SL + j);
    const uint16_t* u = p.P + (size_t)row * AB_IN + A_UOFF + g * 16;
    float vr = 0.f, vi = 0.f;
    _Pragma("unroll") for (int cc = 0; cc < 16; ++cc) {
      float uv = bf2f(u[cc]);
      vr += p.bbar[((size_t)q * 16 + cc) * 2] * uv; vi += p.bbar[((size_t)q * 16 + cc) * 2 + 1] * uv;
    }
    float ar = p.apow[((size_t)q * (SL + 1) + (SL - 1 - j)) * 2], ai = p.apow[((size_t)q * (SL + 1) + (SL - 1 - j)) * 2 + 1];
    er += ar * vr - ai * vi; ei += ar * vi + ai * vr;
  }
  p.E[(size_t)idx * 2] = er; p.E[(size_t)idx * 2 + 1] = ei;
}
constexpr int N_SSMC = 2 * B * SSM_G * SSM_P;
HD void st_ssm_c(const Params& p, int layer, int idx) {
  int pp = idx % SSM_P; int g = (idx / SSM_P) % SSM_G; int b = (idx / (SSM_P * SSM_G)) % B; int dir = idx / (SSM_P * SSM_G * B);
  int q = (dir * SSM_G + g) * SSM_P + pp;
  float ar = p.apow[((size_t)q * (SL + 1) + SL) * 2], ai = p.apow[((size_t)q * (SL + 1) + SL) * 2 + 1];
  float sr = 0.f, si = 0.f;
  for (int ch = 0; ch < NCH; ++ch) {
    size_t e = ((((size_t)dir * B + b) * NCH + ch) * SSM_G + g) * SSM_P + pp;
    p.Sin[e * 2] = sr; p.Sin[e * 2 + 1] = si;
    float er = p.E[e * 2], ei = p.E[e * 2 + 1];
    float nr = ar * sr - ai * si + er, ni = ar * si + ai * sr + ei;
    sr = nr; si = ni;
  }
}
HD void st_ssm_o(const Params& p, int layer, int idx) {
  int t = idx / SSM_W, n = idx % SSM_W; int g = n / 16, co = n % 16;
  int b, dirtau[2];
  if (t < TL) { b = t / N; int i = t % N; dirtau[0] = CTX + i; dirtau[1] = CTX + (N - 1 - i); }
  else { b = (t - TL) / CTX; int i = (t - TL) % CTX; dirtau[0] = i; dirtau[1] = CTX - 1 - i; }
  float y = p.ssm_d[n] * bf2f(p.P[(size_t)t * AB_IN + A_UOFF + n]);
  for (int dir = 0; dir < 2; ++dir) {
    int tau = dirtau[dir]; int ch = tau / SL, j = tau % SL;
    int dg = dir * SSM_G + g;
    size_t e0 = ((((size_t)dir * B + b) * NCH + ch) * SSM_G + g) * SSM_P;
    for (int pp = 0; pp < SSM_P; ++pp) {
      int q = dg * SSM_P + pp;
      float ar = p.apow[((size_t)q * (SL + 1) + (j + 1)) * 2], ai = p.apow[((size_t)q * (SL + 1) + (j + 1)) * 2 + 1];
      float sr = p.Sin[(e0 + pp) * 2], si = p.Sin[(e0 + pp) * 2 + 1];
      float tr = ar * sr - ai * si, ti = ar * si + ai * sr;
      float cr = p.c_re[((size_t)dg * 16 + co) * SSM_P + pp], cim = p.c_im[((size_t)dg * 16 + co) * SSM_P + pp];
      y += cr * tr - cim * ti;
    }
    for (int j2 = 0; j2 <= j; ++j2) {
      int row = ssm_row(dir, b, ch * SL + j2);
      const uint16_t* u = p.P + (size_t)row * AB_IN + A_UOFF + g * 16;
      const float* kt = p.KT + (((size_t)dg * SL + (j - j2)) * 16 + co) * 16;
      _Pragma("unroll") for (int ci = 0; ci < 16; ++ci) y += kt[ci] * bf2f(u[ci]);
    }
  }
  p.Gs[(size_t)t * SSM_W + n] = f2bf(geluf_(y));
}
HD void st_glu(const Params& p, int layer, int idx) {
  int t = idx / SSM_W, n = idx % SSM_W;
  float z = p.glu_b[n];
  const uint16_t* g = p.Gs + (size_t)t * SSM_W;
  for (int k = 0; k < SSM_W; ++k) z += bf2f(g[k]) * p.glu_w[(size_t)k * SSM_W + n];
  p.Ymix[(size_t)t * YW + SWA_QW + n] = f2bf(bf2f(g[n]) * sigmoidf_(z));
}

HD void st_dif(const Params& p, int layer, int idx) {
  int t = idx % TL; int he = idx / TL; int eh = he % 2, h = he / 2;
  int b = t / N;
  const uint16_t* P = p.P;
  float res[64];
  float lam = p.scal[0];
  _Pragma("unroll") for (int c = 0; c < 2; ++c) {
    float q[64], o[64];
    _Pragma("unroll") for (int d = 0; d < 64; ++d) { q[d] = bf2f(P[(size_t)t * DIF_IN + h * 128 + c * 64 + d]) * 0.125f; o[d] = 0.f; }
    float m = -1e30f, l = 0.f;
    for (int kk = 0; kk < N + CTX; ++kk) {
      int row = kk < N ? b * N + kk : TL + b * CTX + (kk - N);
      const uint16_t* kr = P + (size_t)row * DIF_IN + DIF_QK + h * 128 + c * 64;
      const uint16_t* vr = P + (size_t)row * DIF_IN + 2 * DIF_QK + h * 128 + eh * 64;
      float s = 0.f;
      _Pragma("unroll") for (int d = 0; d < 64; ++d) s += q[d] * bf2f(kr[d]);
      if (s > m) { float f = expf(m - s); l *= f; for (int d = 0; d < 64; ++d) o[d] *= f; m = s; }
      float pe = expf(s - m);
      l += pe;
      _Pragma("unroll") for (int d = 0; d < 64; ++d) o[d] += pe * bf2f(vr[d]);
    }
    float il = 1.0f / l;
    if (c == 0) { for (int d = 0; d < 64; ++d) res[d] = o[d] * il; }
    else { for (int d = 0; d < 64; ++d) res[d] -= lam * o[d] * il; }
  }
  _Pragma("unroll") for (int d = 0; d < 64; ++d) p.Ymix[(size_t)t * YW + h * 128 + eh * 64 + d] = f2bf(res[d]);
}
HD void st_difnorm(const Params& p, int layer, int idx) {
  int t = idx / DIF_H, h = idx % DIF_H;
  uint16_t* o = p.Ymix + (size_t)t * YW + h * 128;
  float ss = 0.f;
  for (int e = 0; e < 128; ++e) { float v = bf2f(o[e]); ss += v * v; }
  float r = 1.0f / sqrtf(ss / 128.0f + RMS_EPS) * p.scal[1];
  _Pragma("unroll 8") for (int e = 0; e < 128; ++e) o[e] = f2bf(bf2f(o[e]) * r * p.subln_g[e]);
}

HD void st_outproj(const Params& p, int layer, int idx) {
  int t = idx / D, n = idx % D;
  const float* w = layer == 0 ? p.w_out_a : p.dif_w_out;
  const uint16_t* y = p.Ymix + (size_t)t * YW;
  const int KW = layer == 0 ? AB_OUT : DIF_VW;
  float acc = 0.f;
  for (int k = 0; k < KW; ++k) acc += bf2f(y[k]) * w[(size_t)k * D + n];
  p.F[(size_t)t * D + n] = acc;
}
HD void st_ln1(const Params& p, int layer, int t) {
  int r = tok_r(t);
  const float* xr = xrow(p, layer, t); const float* g1 = modp(p, layer, r, 2);
  const float* y = p.F + (size_t)t * D;
  float mu = 0.f;
  for (int k = 0; k < D; ++k) mu += ALPHA * xr[k] + g1[k] * y[k];
  mu /= D;
  float var = 0.f;
  for (int k = 0; k < D; ++k) { float v = ALPHA * xr[k] + g1[k] * y[k] - mu; var += v * v; }
  var /= D;
  float rs = 1.0f / sqrtf(var + LN_EPS);
  const float* lg = p.ln1_g + (size_t)layer * D; const float* lb = p.ln1_b + (size_t)layer * D;
  for (int k = 0; k < D; ++k) p.X1[(size_t)t * D + k] = (ALPHA * xr[k] + g1[k] * y[k] - mu) * rs * lg[k] + lb[k];
}
HD void st_route(const Params& p, int layer, int t) {
  int r = tok_r(t);
  const float* x1 = p.X1 + (size_t)t * D; const float* sh = modp(p, layer, r, 3); const float* sc = modp(p, layer, r, 4);
  float lg[MOE_G];
  _Pragma("unroll") for (int g = 0; g < MOE_G; ++g) lg[g] = p.moe_bg[layer * MOE_G + g];
  const float* wg = p.moe_wg + (size_t)layer * D * MOE_G;
  for (int k = 0; k < D; ++k) {
    float h = x1[k] * (1.0f + sc[k]) + sh[k];
    _Pragma("unroll") for (int g = 0; g < MOE_G; ++g) lg[g] += h * wg[k * MOE_G + g];
  }
  int gi = 0; float mx = lg[0];
  _Pragma("unroll") for (int g = 1; g < MOE_G; ++g) if (lg[g] > mx) { mx = lg[g]; gi = g; }
  float den = 0.f;
  _Pragma("unroll") for (int g = 0; g < MOE_G; ++g) den += expf(lg[g] - mx);
  float gp = 1.0f / den;
  float le[MOE_EPG];
  _Pragma("unroll") for (int e = 0; e < MOE_EPG; ++e) le[e] = p.moe_be[(layer * MOE_G + gi) * MOE_EPG + e];
  const float* we = p.moe_we + ((size_t)layer * MOE_G + gi) * D * MOE_EPG;
  for (int k = 0; k < D; ++k) {
    float h = x1[k] * (1.0f + sc[k]) + sh[k];
    _Pragma("unroll") for (int e = 0; e < MOE_EPG; ++e) le[e] += h * we[k * MOE_EPG + e];
  }
  int i0 = 0; float v0 = le[0];
  _Pragma("unroll") for (int e = 1; e < MOE_EPG; ++e) if (le[e] > v0) { v0 = le[e]; i0 = e; }
  int i1 = -1; float v1 = -3e38f;
  _Pragma("unroll") for (int e = 0; e < MOE_EPG; ++e) if (e != i0 && le[e] > v1) { v1 = le[e]; i1 = e; }
  float e1 = expf(v1 - v0);
  float w0 = gp / (1.0f + e1), w1 = gp * e1 / (1.0f + e1);
  p.route[(size_t)t * 4 + 0] = (float)(gi * MOE_EPG + i0);
  p.route[(size_t)t * 4 + 1] = (float)(gi * MOE_EPG + i1);
  p.route[(size_t)t * 4 + 2] = w0;
  p.route[(size_t)t * 4 + 3] = w1;
}
HD void st_moe_h(const Params& p, int layer, int idx) {
  int f = idx % MOE_F; int j = (idx / MOE_F) % 2; int t = idx / (2 * MOE_F);
  int r = tok_r(t);
  const float* x1 = p.X1 + (size_t)t * D; const float* sh = modp(p, layer, r, 3); const float* sc = modp(p, layer, r, 4);
  int e = (int)p.route[(size_t)t * 4 + j]; float wgt = p.route[(size_t)t * 4 + 2 + j];
  const float* w1 = p.moe_w1 + ((size_t)layer * MOE_E + e) * D * MOE_F;
  const float* w3 = p.moe_w3 + ((size_t)layer * MOE_E + e) * D * MOE_F;
  float h1 = 0.f, h3 = 0.f;
  for (int k = 0; k < D; ++k) {
    float h = x1[k] * (1.0f + sc[k]) + sh[k];
    h1 += h * w1[(size_t)k * MOE_F + f]; h3 += h * w3[(size_t)k * MOE_F + f];
  }
  p.HH[(size_t)idx] = siluf(h1) * h3 * wgt;
}
HD void st_moe_o(const Params& p, int layer, int idx) {
  int t = idx / D, n = idx % D;
  float acc = 0.f;
  for (int j = 0; j < 2; ++j) {
    int e = (int)p.route[(size_t)t * 4 + j];
    const float* w2 = p.moe_w2 + ((size_t)layer * MOE_E + e) * MOE_F * D;
    const float* hh = p.HH + ((size_t)t * 2 + j) * MOE_F;
    for (int f = 0; f < MOE_F; ++f) acc += hh[f] * w2[(size_t)f * D + n];
  }
  p.F[(size_t)t * D + n] = acc;
}
HD void st_ln2(const Params& p, int layer, int t) {
  int r = tok_r(t);
  const float* x1 = p.X1 + (size_t)t * D; const float* g2 = modp(p, layer, r, 5);
  const float* y = p.F + (size_t)t * D;
  float mu = 0.f;
  for (int k = 0; k < D; ++k) mu += ALPHA * x1[k] + g2[k] * y[k];
  mu /= D;
  float var = 0.f;
  for (int k = 0; k < D; ++k) { float v = ALPHA * x1[k] + g2[k] * y[k] - mu; var += v * v; }
  var /= D;
  float rs = 1.0f / sqrtf(var + LN_EPS);
  const float* lg = p.ln2_g + (size_t)layer * D; const float* lb = p.ln2_b + (size_t)layer * D;
  float* dst = layer == DEPTH - 1 ? p.out + (size_t)t * D : p.X + (size_t)t * D;
  for (int k = 0; k < D; ++k) dst[k] = (ALPHA * x1[k] + g2[k] * y[k] - mu) * rs * lg[k] + lb[k];
}

enum { S_MOD, S_TABA, S_TABB, S_PROJ, S_SWA, S_SSME, S_SSMC, S_SSMO, S_GLU, S_DIF, S_DIFNORM, S_OUTPROJ, S_LN1, S_ROUTE, S_MOEH, S_MOEO, S_LN2 };
template <int S> HD void run_elem(const Params& p, int layer, int idx) {
  if (S == S_MOD) st_mod(p, layer, idx);
  else if (S == S_TABA) st_taba(p, layer, idx);
  else if (S == S_TABB) st_tabb(p, layer, idx);
  else if (S == S_PROJ) st_proj(p, layer, idx);
  else if (S == S_SWA) st_swa(p, layer, idx);
  else if (S == S_SSME) st_ssm_e(p, layer, idx);
  else if (S == S_SSMC) st_ssm_c(p, layer, idx);
  else if (S == S_SSMO) st_ssm_o(p, layer, idx);
  else if (S == S_GLU) st_glu(p, layer, idx);
  else if (S == S_DIF) st_dif(p, layer, idx);
  else if (S == S_DIFNORM) st_difnorm(p, layer, idx);
  else if (S == S_OUTPROJ) st_outproj(p, layer, idx);
  else if (S == S_LN1) st_ln1(p, layer, idx);
  else if (S == S_ROUTE) st_route(p, layer, idx);
  else if (S == S_MOEH) st_moe_h(p, layer, idx);
  else if (S == S_MOEO) st_moe_o(p, layer, idx);
  else if (S == S_LN2) st_ln2(p, layer, idx);
}

constexpr int NSLOT = 2 * TA + MOE_E * 256;
constexpr size_t CTL_BYTES = 1u << 20;
struct WsLayout {
  size_t A2, BtY, BtE, apow16, KT16, E16, Ypart, wgbase;
  size_t ctl, X, X1, P, Ymix, Gs, modv, ropeT, apow, bbar, KT, E, Sin, route, scal, WinA_t, DifIn_t, WoutA_t, DifOut_t, Glu_t, W13t, W2t, gate, tokslot, moe_meta, total;
};
inline WsLayout ws_layout() {
  WsLayout L; size_t o = 0;
  auto take = [&](size_t bytes) { size_t r = o; o += (bytes + 255) & ~(size_t)255; return r; };
  L.ctl = take(CTL_BYTES);
  L.X = take((size_t)TA * D * 4);
  L.X1 = L.X;
  L.P = take((size_t)TA * (AB_IN > DIF_IN ? AB_IN : DIF_IN) * 2);
  L.Ymix = take((size_t)TA * YW * 2);
  L.Gs = L.X;
  L.modv = take((size_t)N_MOD * 4);
  L.ropeT = take((size_t)N_ROPE * 2 * 4);
  L.apow = take((size_t)N_APOW * 2 * 4);
  L.bbar = take((size_t)N_BBAR * 2 * 4);
  L.KT = take((size_t)N_KT * 4);
  L.E = L.X + (((size_t)TA * SSM_W * 2 + 255) & ~(size_t)255);
  L.Sin = L.E + (((size_t)N_SSME * 2 * 4 + 255) & ~(size_t)255);
  L.route = take((size_t)TA * 8 * 4);
  L.scal = take(256);
  L.WinA_t = take((size_t)AB_IN * D * 2);
  L.DifIn_t = take((size_t)DIF_IN * D * 2);
  L.WoutA_t = take((size_t)D * AB_OUT * 2);
  L.DifOut_t = take((size_t)D * DIF_VW * 2);
  L.Glu_t = take((size_t)SSM_W * SSM_W * 2);
  L.W13t = take((size_t)MOE_E * 2 * MOE_F * D * 2);
  L.W2t = take((size_t)MOE_E * D * MOE_F * 2);
  L.gate = take((size_t)NSLOT * 4);
  L.tokslot = take((size_t)TA * 2 * 4);
  L.moe_meta = take(4096);
  L.wgbase = take((size_t)DEPTH * 1024 * MOE_E * 4);
  L.BtY = take((size_t)2 * SSM_G * 256 * 384 * 2);
  L.BtE = take((size_t)2 * SSM_G * 256 * 256 * 2);
  L.apow16 = take((size_t)2 * SSM_G * SSM_P * 17 * 2 * 4);
  L.KT16 = take((size_t)2 * SSM_G * 16 * 256 * 4);
  L.A2 = L.P + (size_t)48 * 1024 * 1024;
  L.E16 = L.X + (size_t)19 * 1024 * 1024;
  L.Ypart = L.E16;
  L.total = o;
  return L;
}
inline void fill_ws(Params& p, char* ws) {
  WsLayout L = ws_layout();
  p.X = (float*)(ws + L.X); p.X1 = (float*)(ws + L.X1); p.P = (uint16_t*)(ws + L.P); p.F = (float*)(ws + L.P);
  p.Ymix = (uint16_t*)(ws + L.Ymix); p.HH = (float*)(ws + L.Ymix);
  p.Gs = (uint16_t*)(ws + L.Gs); p.modv = (float*)(ws + L.modv); p.ropeT = (float*)(ws + L.ropeT);
  p.apow = (float*)(ws + L.apow); p.bbar = (float*)(ws + L.bbar); p.KT = (float*)(ws + L.KT);
  p.E = (float*)(ws + L.E); p.Sin = (float*)(ws + L.Sin); p.route = (float*)(ws + L.route); p.scal = (float*)(ws + L.scal);
  p.H = (uint16_t*)(ws + L.Ymix); p.WinA_t = (uint16_t*)(ws + L.WinA_t); p.DifIn_t = (uint16_t*)(ws + L.DifIn_t); p.ctl = (unsigned*)(ws + L.ctl);
  p.WoutA_t = (uint16_t*)(ws + L.WoutA_t); p.DifOut_t = (uint16_t*)(ws + L.DifOut_t); p.Glu_t = (uint16_t*)(ws + L.Glu_t);
  p.W13t = (uint16_t*)(ws + L.W13t); p.W2t = (uint16_t*)(ws + L.W2t);
  p.Amoe = (uint16_t*)(ws + L.P); p.F2 = (uint16_t*)(ws + L.P); p.HHb = (uint16_t*)(ws + L.Ymix);
  p.A2 = (uint16_t*)(ws + L.A2); p.BtY = (uint16_t*)(ws + L.BtY); p.BtE = (uint16_t*)(ws + L.BtE);
  p.apow16 = (float*)(ws + L.apow16); p.KT16 = (float*)(ws + L.KT16); p.E16 = (float*)(ws + L.E16); p.Ypart = (float*)(ws + L.Ypart);
  p.wgbase = (int*)(ws + L.wgbase);
  p.gate = (float*)(ws + L.gate); p.tokslot = (int*)(ws + L.tokslot); p.moe_meta = (int*)(ws + L.moe_meta);
}
inline void fill_inputs(Params& p, void* const* d_in) {
  const float* const* in = (const float* const*)d_in;
  p.x = in[0]; p.c = in[1]; p.ctx = in[2]; p.c_ctx = in[3]; p.mod_w = in[4]; p.mod_b = in[5];
  p.ln1_g = in[6]; p.ln1_b = in[7]; p.ln2_g = in[8]; p.ln2_b = in[9];
  p.w_in_a = in[10]; p.w_out_a = in[11]; p.sink = in[12]; p.a_re = in[13]; p.a_im = in[14]; p.log_step = in[15];
  p.b_re = in[16]; p.b_im = in[17]; p.c_re = in[18]; p.c_im = in[19]; p.ssm_d = in[20]; p.glu_w = in[21]; p.glu_b = in[22];
  p.dif_w_in = in[23]; p.dif_w_out = in[24]; p.lq1 = in[25]; p.lk1 = in[26]; p.lq2 = in[27]; p.lk2 = in[28]; p.subln_g = in[29];
  p.moe_wg = in[30]; p.moe_bg = in[31]; p.moe_we = in[32]; p.moe_be = in[33]; p.moe_w1 = in[34]; p.moe_w3 = in[35]; p.moe_w2 = in[36];
}

#define FORWARD_PROGRAM(RUN)                                   \
  RUN(S_MOD, 0, N_MOD)                                         \
  RUN(S_TABA, 0, N_TABA)                                       \
  RUN(S_TABB, 0, N_KT)                                         \
                                                   \
  RUN(S_PROJ, 0, TA * AB_IN)                                   \
  RUN(S_SWA, 0, SWA_H * TA)                                    \
  RUN(S_SSME, 0, N_SSME)                                       \
  RUN(S_SSMC, 0, N_SSMC)                                       \
  RUN(S_SSMO, 0, TA * SSM_W)                                   \
  RUN(S_GLU, 0, TA * SSM_W)                                    \
  RUN(S_OUTPROJ, 0, TA * D)                                    \
  RUN(S_LN1, 0, TA)                                            \
  RUN(S_ROUTE, 0, TA)                                          \
  RUN(S_MOEH, 0, TA * 2 * MOE_F)                               \
  RUN(S_MOEO, 0, TA * D)                                       \
  RUN(S_LN2, 0, TA)                                            \
                                                   \
  RUN(S_PROJ, 1, TA * DIF_IN)                                  \
  RUN(S_DIF, 1, DIF_H * 2 * TL)                                \
  RUN(S_DIFNORM, 1, TL * DIF_H)                                \
  RUN(S_OUTPROJ, 1, TL * D)                                    \
  RUN(S_LN1, 1, TL)                                            \
  RUN(S_ROUTE, 1, TL)                                          \
  RUN(S_MOEH, 1, TL * 2 * MOE_F)                               \
  RUN(S_MOEO, 1, TL * D)                                       \
  RUN(S_LN2, 1, TL)

#ifndef HOST_EMU
#include <cstdio>
#define LAS __attribute__((address_space(3)))
#define GAS __attribute__((address_space(1)))
typedef unsigned short bf16_t;
typedef short bf16x8 __attribute__((ext_vector_type(8)));
typedef float f32x4 __attribute__((ext_vector_type(4)));
typedef float f32x2 __attribute__((ext_vector_type(2)));
typedef unsigned u32x4 __attribute__((ext_vector_type(4)));
typedef unsigned u32x2 __attribute__((ext_vector_type(2)));
constexpr int NWAVES = 8, NTHR = 512;
constexpr int RING_BYTES = 131072, LDSCTL_OFF = RING_BYTES, MISC_OFF = LDSCTL_OFF + 320, LDS_BYTES = 147456;
#define LDS_WAIT() asm volatile("s_waitcnt lgkmcnt(0)" ::: "memory")
#define VM_WAIT() asm volatile("s_waitcnt vmcnt(0)" ::: "memory")
__device__ __forceinline__ unsigned cvt_pk_bf16(float lo, float hi) { unsigned r; asm volatile("v_cvt_pk_bf16_f32 %0, %1, %2" : "=v"(r) : "v"(lo), "v"(hi)); return r; }

namespace pg8 {
constexpr int BM = 256, BK = 64, HALF = 128, HTB = HALF * BK * 2, STAGE_BYTES = 8 * HTB, NXCD = 8, WGM = 8;
__host__ __device__ __forceinline__ int lds_byte(int r, int c) { const int st = (r >> 4) * 2 + (c >> 5), rr = r & 15, cc = c & 31, ob = rr * 64 + cc * 2; return st * 1024 + (ob ^ (((ob >> 9) & 1) << 5)); }
__host__ __device__ __forceinline__ void stage_rc(int b, int& R, int& C) { const int st = b / 1024, sb = b % 1024, swz = sb ^ (((sb >> 9) & 1) << 5); R = (st >> 1) * 16 + swz / 64; C = (st & 1) * 32 + (swz % 64) / 2; }
__host__ __device__ __forceinline__ int perm32(int rho) { const int n = rho >> 4, i = rho & 15; return 8 * (i >> 2) + 4 * n + (i & 3); }
struct Unit { int pm, pn; };
struct Gemm { const bf16_t* A; const bf16_t* Bt; int lda, ldb, K; };

struct StaticOrder {
  int nM, nN, nwg, G, c;
  __device__ void init(int M, int N, int G_, int c_) { nM = M / BM; nN = N / BM; nwg = nM * nN; G = G_; c = c_; }
  __device__ bool next(int i, Unit& u) const {
    const long L = (long)i * G + c; if (L >= nwg) return false;
    int wgid = (int)L; { const int q = nwg / NXCD, r = nwg % NXCD, xcd = wgid % NXCD, off = wgid / NXCD; wgid = (xcd < r ? xcd * (q + 1) : r * (q + 1) + (xcd - r) * q) + off; }
    const int nig = WGM * nN, gid = wgid / nig, fm = gid * WGM, gsz = (nM - fm) < WGM ? (nM - fm) : WGM;
    u.pm = fm + ((wgid % nig) % gsz); u.pn = (wgid % nig) / gsz; return true;
  }
  __device__ __forceinline__ void a_ready(const Unit&) const {}
  __device__ __forceinline__ void done(const Unit&) const {}
};

template <class Epi, class Sched, bool ALIGN_EPI = true, bool SP2 = true>
__device__ __forceinline__ void gemm_phase(LAS unsigned char* lds, const Gemm g, const Sched& S, const Epi& E) {
  int tid = threadIdx.x; asm volatile("" : "+v"(tid));
  const int wid = __builtin_amdgcn_readfirstlane(tid >> 6), lane = tid & 63, wr = wid >> 2, wc = wid & 3, fr = lane & 15, fq = lane >> 4;
  const int K = g.K, nt = K / BK;
  unsigned voffA[2], voffB[2];
#pragma unroll
  for (int i = 0; i < 2; ++i) { int R, C; stage_rc(tid * 16 + i * 8192, R, C); const int Rb = Epi::PERM ? ((R & ~31) + perm32(R & 31)) : R;
    voffA[i] = (unsigned)(R * g.lda + C) * 2u; voffB[i] = (unsigned)(Rb * g.ldb + C) * 2u; }
  const size_t kstep = (size_t)(BK * 2);
  const size_t hA = (size_t)HALF * g.lda * 2, hB = (size_t)HALF * g.ldb * 2;
  const size_t tA = 2 * hA, tB = 2 * hB;
  const unsigned ldsw = (unsigned)wid * 1024u;
  const int aoff = lds_byte(wr * 64 + fr, fq * 8), boff = lds_byte(wc * 32 + fr, fq * 8);
#define PG8_SA(b, h) (((b) * 2 + (h)) * HTB)
#define PG8_SB(b, h) ((4 + (b) * 2 + (h)) * HTB)
#define PG8_STAGE(bufoff, gbase, voff) do { _Pragma("unroll") for (int _i = 0; _i < 2; ++_i) \
    __builtin_amdgcn_global_load_lds((const unsigned*)((const char*)(gbase) + (voff)[_i]), (LAS unsigned*)(lds + (bufoff) + ldsw + _i * 8192), 16, 0, 0); } while (0)
#define PG8_LDA(dst, b, h) do { _Pragma("unroll") for (int m = 0; m < 4; ++m) _Pragma("unroll") for (int k = 0; k < 2; ++k) dst[m][k] = *(const LAS bf16x8*)(lds + PG8_SA(b, h) + aoff + m * 2048 + k * 1024); } while (0)
#define PG8_LDB(dst, b, h) do { _Pragma("unroll") for (int n = 0; n < 2; ++n) _Pragma("unroll") for (int k = 0; k < 2; ++k) dst[n][k] = *(const LAS bf16x8*)(lds + PG8_SB(b, h) + boff + n * 2048 + k * 1024); } while (0)
#define PG8_MMA(ai, bj, At, Bt) do { __builtin_amdgcn_s_setprio(1); _Pragma("unroll") for (int m = 0; m < 4; ++m) _Pragma("unroll") for (int n = 0; n < 2; ++n) _Pragma("unroll") for (int k = 0; k < 2; ++k) \
    acc[ai][bj][m][n] = __builtin_amdgcn_mfma_f32_16x16x32_bf16(Bt[n][k], At[m][k], acc[ai][bj][m][n], 0, 0, 0); __builtin_amdgcn_s_setprio(0); } while (0)
#define PG8_WAIT_V(n) asm volatile("s_waitcnt vmcnt(" #n ")" ::: "memory")
#define PG8_WAIT_L(n) asm volatile("s_waitcnt lgkmcnt(" #n ")" ::: "memory")
#define PG8_BAR __builtin_amdgcn_s_barrier()
#define PG8_SCHED __builtin_amdgcn_sched_barrier(0)
  Unit cur, nxt; int ui = 0;
  if (!S.next(0, cur)) return;
  f32x4 acc[2][2][4][2];
#pragma unroll
  for (int a = 0; a < 2; ++a)
#pragma unroll
    for (int b = 0; b < 2; ++b)
#pragma unroll
      for (int m = 0; m < 4; ++m)
#pragma unroll
        for (int n = 0; n < 2; ++n) acc[a][b][m][n] = (f32x4){0.f, 0.f, 0.f, 0.f};
  bf16x8 At[4][2], B0[2][2], B1[2][2];
  const char* cA = (const char*)g.A + (size_t)cur.pm * tA; const char* cB = (const char*)g.Bt + (size_t)cur.pn * tB;
  S.a_ready(cur);
  if constexpr (SP2) {
    PG8_STAGE(PG8_SB(0, 0), cB, voffB); PG8_STAGE(PG8_SB(0, 1), cB + hB, voffB); PG8_STAGE(PG8_SA(0, 0), cA, voffA); PG8_STAGE(PG8_SA(0, 1), cA + hA, voffA);
    if (wr == 1) PG8_BAR;
    PG8_WAIT_V(2); PG8_BAR;
    PG8_STAGE(PG8_SB(1, 0), cB + kstep, voffB); PG8_STAGE(PG8_SA(1, 0), cA + kstep, voffA); PG8_STAGE(PG8_SB(1, 1), cB + hB + kstep, voffB);
    PG8_WAIT_V(6); PG8_BAR;
  } else {
    PG8_STAGE(PG8_SB(0, 0), cB, voffB); PG8_STAGE(PG8_SA(0, 0), cA, voffA); PG8_STAGE(PG8_SB(0, 1), cB + hB, voffB); PG8_STAGE(PG8_SA(0, 1), cA + hA, voffA);
    if (wr == 1) PG8_BAR;
    PG8_WAIT_V(4); PG8_BAR;
    PG8_STAGE(PG8_SB(1, 0), cB + kstep, voffB); PG8_STAGE(PG8_SA(1, 0), cA + kstep, voffA); PG8_STAGE(PG8_SB(1, 1), cB + hB + kstep, voffB);
    PG8_WAIT_V(6); PG8_BAR;
  }
  for (;;) {
    const bool has_next = S.next(ui + 1, nxt);
    const char* nA = has_next ? (const char*)g.A + (size_t)nxt.pm * tA : cA; const char* nB = has_next ? (const char*)g.Bt + (size_t)nxt.pn * tB : cB;
#pragma unroll 1
    for (int t = 0; t < nt; t += 2) {
      const bool last = (t == nt - 2);
      const char* a1 = cA + (size_t)(t + 1) * kstep;
      const char* a2 = last ? nA : cA + (size_t)(t + 2) * kstep; const char* b2 = last ? nB : cB + (size_t)(t + 2) * kstep;
      const char* a3 = a2 + kstep; const char* b3 = b2 + kstep;
      if (last && has_next) S.a_ready(nxt);
      if constexpr (SP2) {
        PG8_LDB(B0, 0, 0); PG8_LDB(B1, 0, 1); PG8_SCHED; PG8_LDA(At, 0, 0); PG8_STAGE(PG8_SA(1, 1), a1 + hA, voffA);
        PG8_WAIT_V(8); PG8_WAIT_L(0); PG8_BAR; PG8_MMA(0, 0, At, B0); PG8_MMA(0, 1, At, B1); PG8_BAR; PG8_SCHED;
        PG8_LDA(At, 0, 1); PG8_STAGE(PG8_SB(0, 0), b2, voffB); PG8_STAGE(PG8_SB(0, 1), b2 + hB, voffB); PG8_STAGE(PG8_SA(0, 0), a2, voffA);
        PG8_WAIT_V(8); PG8_WAIT_L(0); PG8_BAR; PG8_MMA(1, 0, At, B0); PG8_MMA(1, 1, At, B1); PG8_BAR; PG8_SCHED;
        PG8_LDB(B0, 1, 0); PG8_LDB(B1, 1, 1); PG8_SCHED; PG8_LDA(At, 1, 0); PG8_STAGE(PG8_SA(0, 1), a2 + hA, voffA);
        PG8_WAIT_V(8); PG8_WAIT_L(0); PG8_BAR; PG8_MMA(0, 0, At, B0); PG8_MMA(0, 1, At, B1); PG8_BAR; PG8_SCHED;
        PG8_LDA(At, 1, 1); PG8_STAGE(PG8_SB(1, 0), b3, voffB); PG8_STAGE(PG8_SB(1, 1), b3 + hB, voffB); PG8_STAGE(PG8_SA(1, 0), a3, voffA);
        PG8_WAIT_V(8); PG8_WAIT_L(0); PG8_BAR; PG8_MMA(1, 0, At, B0); PG8_MMA(1, 1, At, B1); PG8_BAR; PG8_SCHED;
      } else {
        PG8_LDB(B0, 0, 0); PG8_SCHED; PG8_LDA(At, 0, 0); PG8_STAGE(PG8_SA(1, 1), a1 + hA, voffA);
        PG8_WAIT_L(8); PG8_BAR; PG8_WAIT_L(0); PG8_MMA(0, 0, At, B0); PG8_BAR; PG8_SCHED;
        PG8_LDB(B1, 0, 1); PG8_STAGE(PG8_SB(0, 0), b2, voffB);
        PG8_BAR; PG8_WAIT_L(0); PG8_MMA(0, 1, At, B1); PG8_BAR;
        PG8_LDA(At, 0, 1); PG8_STAGE(PG8_SA(0, 0), a2, voffA);
        PG8_BAR; PG8_WAIT_L(0); PG8_MMA(1, 0, At, B0); PG8_BAR; PG8_SCHED;
        PG8_STAGE(PG8_SB(0, 1), b2 + hB, voffB);
        PG8_WAIT_V(6); PG8_BAR; PG8_MMA(1, 1, At, B1); PG8_BAR;
        PG8_LDB(B0, 1, 0); PG8_SCHED; PG8_LDA(At, 1, 0); PG8_STAGE(PG8_SA(0, 1), a2 + hA, voffA);
        PG8_WAIT_L(8); PG8_BAR; PG8_WAIT_L(0); PG8_MMA(0, 0, At, B0); PG8_BAR; PG8_SCHED;
        PG8_LDB(B1, 1, 1); PG8_STAGE(PG8_SB(1, 0), b3, voffB);
        PG8_BAR; PG8_WAIT_L(0); PG8_MMA(0, 1, At, B1); PG8_BAR;
        PG8_LDA(At, 1, 1); PG8_STAGE(PG8_SA(1, 0), a3, voffA);
        PG8_BAR; PG8_WAIT_L(0); PG8_MMA(1, 0, At, B0); PG8_BAR; PG8_SCHED;
        PG8_STAGE(PG8_SB(1, 1), b3 + hB, voffB);
        PG8_WAIT_V(6); PG8_BAR; PG8_MMA(1, 1, At, B1); PG8_BAR;
      }
    }
    if constexpr (ALIGN_EPI) { if (wr == 0) PG8_BAR; }
    E(acc, cur, wr, wc, fr, fq); S.done(cur);
    if (!has_next) break;
#pragma unroll
    for (int a = 0; a < 2; ++a)
#pragma unroll
      for (int b = 0; b < 2; ++b)
#pragma unroll
        for (int m = 0; m < 4; ++m)
#pragma unroll
          for (int n = 0; n < 2; ++n) acc[a][b][m][n] = (f32x4){0.f, 0.f, 0.f, 0.f};
    cur = nxt; cA = nA; cB = nB; ++ui;
    if constexpr (ALIGN_EPI) { if (wr == 1) PG8_BAR; }
  }
  PG8_WAIT_V(0);
  if constexpr (!ALIGN_EPI) { if (wr == 0) PG8_BAR; }
  PG8_BAR;
#undef PG8_SA
#undef PG8_SB
#undef PG8_STAGE
#undef PG8_LDA
#undef PG8_LDB
#undef PG8_MMA
#undef PG8_WAIT_V
#undef PG8_WAIT_L
#undef PG8_BAR
#undef PG8_SCHED
}
}

constexpr int LC = 16, NCH16 = SS / LC, GROWS = 1280, A2K = 384;
static_assert(B * NCH16 <= GROWS && GROWS % 256 == 0, "ssm group rows");
__device__ __forceinline__ void ssm_tau(int t, int& b, int& tau0, int& tau1) {
  if (t < TL) { b = t / N; const int i = t % N; tau0 = CTX + i; tau1 = CTX + (N - 1 - i); }
  else { b = (t - TL) / CTX; const int i = (t - TL) % CTX; tau0 = i; tau1 = CTX - 1 - i; }
}
struct EpiProj {
  static constexpr bool PERM = false;
  bf16_t* O; int ldc; int rope_end; const float* ropeT; bf16_t* A2;
  __device__ __forceinline__ void operator()(const f32x4 (&acc)[2][2][4][2], const pg8::Unit& u, int wr, int wc, int fr, int fq) const {
    const int row0 = u.pm * 256 + wr * 64 + fr, colb = u.pn * 256 + wc * 32;
    const bool rope_cols = colb < rope_end;
#pragma unroll
    for (int ai = 0; ai < 2; ++ai)
#pragma unroll
      for (int m = 0; m < 4; ++m) {
        const int r = row0 + ai * 128 + m * 16;
        bf16_t* rowp = O + (size_t)r * ldc + colb + 4 * fq;
        f32x4 cs0 = {1.f, 0.f, 1.f, 0.f}, cs1 = {1.f, 0.f, 1.f, 0.f};
        const bool rp = rope_cols && (r < TL);
        if (rp) { const int i = r % N; const int pos = (wc & 1) ? (i % GRID_W) : (i / GRID_W);
          const f32x4* tp = (const f32x4*)(ropeT + (size_t)(pos * 16 + 4 * fq) * 2); cs0 = tp[0]; cs1 = tp[1]; }
#pragma unroll
        for (int bj = 0; bj < 2; ++bj) {
          const bool rpb = rp && (colb + bj * 128 < rope_end);
          f32x4 a1 = acc[ai][bj][m][0], a2 = acc[ai][bj][m][1];
          f32x4 o1 = a1, o2 = a2;
          if (rpb) {
            o1[0] = a1[0] * cs0[0] - a2[0] * cs0[1]; o2[0] = a2[0] * cs0[0] + a1[0] * cs0[1];
            o1[1] = a1[1] * cs0[2] - a2[1] * cs0[3]; o2[1] = a2[1] * cs0[2] + a1[1] * cs0[3];
            o1[2] = a1[2] * cs1[0] - a2[2] * cs1[1]; o2[2] = a2[2] * cs1[0] + a1[2] * cs1[1];
            o1[3] = a1[3] * cs1[2] - a2[3] * cs1[3]; o2[3] = a2[3] * cs1[2] + a1[3] * cs1[3];
          }
          u32x2 w1 = {cvt_pk_bf16(o1[0], o1[1]), cvt_pk_bf16(o1[2], o1[3])}, w2 = {cvt_pk_bf16(o2[0], o2[1]), cvt_pk_bf16(o2[2], o2[3])};
          *(u32x2*)(rowp + bj * 128) = w1; *(u32x2*)(rowp + bj * 128 + 16) = w2;
          if (A2 != nullptr && colb + bj * 128 >= A_UOFF) {
            int b, tau0, tau1; ssm_tau(r, b, tau0, tau1);
            const int g0 = (colb + bj * 128 - A_UOFF) / 16;
            bf16_t* d0 = A2 + (((size_t)g0 * GROWS + b * NCH16 + tau0 / LC) * A2K + (tau0 % LC) * 16 + 4 * fq);
            bf16_t* d1 = A2 + (((size_t)(SSM_G + g0) * GROWS + b * NCH16 + tau1 / LC) * A2K + (tau1 % LC) * 16 + 4 * fq);
            *(u32x2*)d0 = w1; *(u32x2*)(d0 + (size_t)GROWS * A2K) = w2; *(u32x2*)d1 = w1; *(u32x2*)(d1 + (size_t)GROWS * A2K) = w2;
          }
        }
      }
  }
};


struct EpiF32Out {
  static constexpr bool PERM = false;
  float* C; int ldc;
  __device__ __forceinline__ void operator()(const f32x4 (&acc)[2][2][4][2], const pg8::Unit& u, int wr, int wc, int fr, int fq) const {
    const int row0 = u.pm * 256 + wr * 64 + fr, col0 = u.pn * 256 + wc * 32 + 4 * fq;
#pragma unroll
    for (int ai = 0; ai < 2; ++ai)
#pragma unroll
      for (int m = 0; m < 4; ++m) { float* rowp = C + (size_t)(row0 + ai * 128 + m * 16) * ldc + col0;
#pragma unroll
        for (int bj = 0; bj < 2; ++bj)
#pragma unroll
          for (int n = 0; n < 2; ++n) *(f32x4*)(rowp + bj * 128 + n * 16) = acc[ai][bj][m][n]; }
  }
};
struct EpiBf16Out {
  static constexpr bool PERM = true;
  bf16_t* O; int ldc; int NJ;
  __device__ __forceinline__ void operator()(const f32x4 (&acc)[2][2][4][2], const pg8::Unit& u, int wr, int wc, int fr, int fq) const {
    const int row0 = u.pm * 256 + wr * 64 + fr, col0 = (NJ ? (u.pn % NJ) : u.pn) * 256 + wc * 32 + 8 * fq;
#pragma unroll
    for (int ai = 0; ai < 2; ++ai)
#pragma unroll
      for (int m = 0; m < 4; ++m) { bf16_t* rowp = O + (size_t)(row0 + ai * 128 + m * 16) * ldc + col0;
#pragma unroll
        for (int bj = 0; bj < 2; ++bj) { const f32x4 v0 = acc[ai][bj][m][0], v1 = acc[ai][bj][m][1];
          u32x4 w; w.x = cvt_pk_bf16(v0[0], v0[1]); w.y = cvt_pk_bf16(v0[2], v0[3]); w.z = cvt_pk_bf16(v1[0], v1[1]); w.w = cvt_pk_bf16(v1[2], v1[3]);
          *(u32x4*)(rowp + bj * 128) = w; } }
  }
};
__device__ __forceinline__ float fast_sigmoid(float x) { return __builtin_amdgcn_rcpf(1.f + __builtin_amdgcn_exp2f(-1.4426950408889634f * x)); }
struct EpiGlu {
  static constexpr bool PERM = true;
  const bf16_t* Gs; const float* bias; bf16_t* O; int ldo, coloff;
  __device__ __forceinline__ void operator()(const f32x4 (&acc)[2][2][4][2], const pg8::Unit& u, int wr, int wc, int fr, int fq) const {
    const int row0 = u.pm * 256 + wr * 64 + fr, col0 = u.pn * 256 + wc * 32 + 8 * fq;
#pragma unroll
    for (int ai = 0; ai < 2; ++ai)
#pragma unroll
      for (int m = 0; m < 4; ++m) { const int r = row0 + ai * 128 + m * 16;
#pragma unroll
        for (int bj = 0; bj < 2; ++bj) { const int c = col0 + bj * 128;
          const u32x4 gv = *(const u32x4*)(Gs + (size_t)r * SSM_W + c);
          const f32x4 b0 = *(const f32x4*)(bias + c), b1 = *(const f32x4*)(bias + c + 4);
          const f32x4 v0 = acc[ai][bj][m][0] + b0, v1 = acc[ai][bj][m][1] + b1;
          float o[8];
#pragma unroll
          for (int j = 0; j < 4; ++j) { const unsigned gw_ = j < 2 ? (j == 0 ? gv.x : gv.y) : (j == 2 ? gv.z : gv.w);
            const float g0 = __builtin_bit_cast(float, gw_ << 16), g1 = __builtin_bit_cast(float, gw_ & 0xffff0000u);
            const float z0 = j < 2 ? v0[2 * j] : v1[2 * j - 4], z1 = j < 2 ? v0[2 * j + 1] : v1[2 * j - 3];
            o[2 * j] = g0 * fast_sigmoid(z0); o[2 * j + 1] = g1 * fast_sigmoid(z1); }
          u32x4 w; w.x = cvt_pk_bf16(o[0], o[1]); w.y = cvt_pk_bf16(o[2], o[3]); w.z = cvt_pk_bf16(o[4], o[5]); w.w = cvt_pk_bf16(o[6], o[7]);
          *(u32x4*)(O + (size_t)r * ldo + coloff + c) = w; } }
  }
};
struct EpiMoe1 {
  static constexpr bool PERM = true;
  bf16_t* HH; const float* gate;
  __device__ __forceinline__ void operator()(const f32x4 (&acc)[2][2][4][2], const pg8::Unit& u, int wr, int wc, int fr, int fq) const {
    const int row0 = u.pm * 256 + wr * 64 + fr, col0 = (u.pn & 1) * 128 + wc * 32 + 8 * fq;
#pragma unroll
    for (int ai = 0; ai < 2; ++ai)
#pragma unroll
      for (int m = 0; m < 4; ++m) { const int r = row0 + ai * 128 + m * 16; const float gt = gate[r];
        float o[8];
#pragma unroll
        for (int n = 0; n < 2; ++n)
#pragma unroll
          for (int j = 0; j < 4; ++j) { const float h1 = acc[ai][0][m][n][j], h3 = acc[ai][1][m][n][j]; o[4 * n + j] = h1 * fast_sigmoid(h1) * h3 * gt; }
        u32x4 w; w.x = cvt_pk_bf16(o[0], o[1]); w.y = cvt_pk_bf16(o[2], o[3]); w.z = cvt_pk_bf16(o[4], o[5]); w.w = cvt_pk_bf16(o[6], o[7]);
        *(u32x4*)(HH + (size_t)r * MOE_F + col0) = w; }
  }
};
struct MoeOrder {
  const int* meta; int NJ, G, c;
  __device__ __forceinline__ bool next(int i, pg8::Unit& u) const {
    const int nt = __builtin_amdgcn_readfirstlane(__hip_atomic_load(meta, __ATOMIC_RELAXED, __HIP_MEMORY_SCOPE_AGENT));
    const long L = (long)i * G + c; if (L >= (long)nt * NJ) return false;
    const int rt = (int)(L / NJ), jn = (int)(L % NJ);
    const int e = __builtin_amdgcn_readfirstlane(__hip_atomic_load(meta + 1 + rt, __ATOMIC_RELAXED, __HIP_MEMORY_SCOPE_AGENT));
    u.pm = rt; u.pn = e * NJ + jn; return true;
  }
  __device__ __forceinline__ void a_ready(const pg8::Unit&) const {}
  __device__ __forceinline__ void done(const pg8::Unit&) const {}
};


namespace att {
using f32x16 = __attribute__((ext_vector_type(16))) float;
using s16x4  = __attribute__((ext_vector_type(4))) short;
constexpr int KVBLK = 64;
constexpr float SCALE = 0.125f, THR = 8.f;
constexpr size_t SHM_V = KVBLK * 128 * 2, SHM_K = KVBLK * 128 * 2;
constexpr size_t SHM_WS = 2 * SHM_V + 2 * SHM_K;
#define KSWZ(row, colB) ((row) * 256 + ((colB) ^ (((row) & 7) << 4)))
#define SBAR() __builtin_amdgcn_sched_barrier(0)
__device__ __forceinline__ int crow(int r, int hi) { return (r & 3) + 8 * (r >> 2) + 4 * hi; }
__device__ __forceinline__ unsigned cvtpk(float lo, float hi) { unsigned r; asm volatile("v_cvt_pk_bf16_f32 %0, %1, %2" : "=v"(r) : "v"(lo), "v"(hi)); return r; }
__device__ __forceinline__ void partialSM(f32x16& p0, f32x16& p1, float& m_reg, float& mn, float& alpha) {
  constexpr float C = SCALE * 1.4426950408889634f;
  float pmax = p0[0];
#pragma unroll
  for (int r = 1; r < 16; ++r) pmax = fmaxf(pmax, p0[r]);
#pragma unroll
  for (int r = 0; r < 16; ++r) pmax = fmaxf(pmax, p1[r]);
  { auto rr = __builtin_amdgcn_permlane32_swap(__float_as_uint(pmax), __float_as_uint(pmax), false, false);
    pmax = fmaxf(__uint_as_float(rr[0]), __uint_as_float(rr[1])); }
  if (__builtin_expect(__all(pmax - m_reg <= THR / SCALE), 1)) { mn = m_reg; alpha = 1.f; }
  else { mn = fmaxf(m_reg, pmax); alpha = __builtin_amdgcn_exp2f((m_reg - mn) * C); m_reg = mn; }
  const float mnC = -mn * C;
#pragma unroll
  for (int r = 0; r < 16; ++r) p0[r] = fmaf(p0[r], C, mnC);
#pragma unroll
  for (int r = 0; r < 16; ++r) p1[r] = fmaf(p1[r], C, mnC);
#pragma unroll
  for (int r = 0; r < 16; ++r) p0[r] = __builtin_amdgcn_exp2f(p0[r]);
}
__device__ __forceinline__ void finishSM(f32x16& p0, f32x16& p1, float alpha, float& l_reg, bf16x8& pa0, bf16x8& pa1, bf16x8& pa2, bf16x8& pa3) {
#pragma unroll
  for (int r = 0; r < 16; ++r) p1[r] = __builtin_amdgcn_exp2f(p1[r]);
  float ps = 0;
#pragma unroll
  for (int r = 0; r < 16; ++r) ps += p0[r];
#pragma unroll
  for (int r = 0; r < 16; ++r) ps += p1[r];
  { auto rr = __builtin_amdgcn_permlane32_swap(__float_as_uint(ps), __float_as_uint(ps), false, false);
    ps = __uint_as_float(rr[0]) + __uint_as_float(rr[1]); }
  l_reg = l_reg * alpha + ps;
#define PK4(P, BASE, OUT) do { unsigned a0 = cvtpk(P[BASE + 0], P[BASE + 1]), a1 = cvtpk(P[BASE + 2], P[BASE + 3]);   \
    unsigned b0 = cvtpk(P[BASE + 4], P[BASE + 5]), b1 = cvtpk(P[BASE + 6], P[BASE + 7]);                              \
    auto r0 = __builtin_amdgcn_permlane32_swap(a0, b0, false, false); auto r1 = __builtin_amdgcn_permlane32_swap(a1, b1, false, false); \
    u32x4 w = {r0[0], r1[0], r0[1], r1[1]}; OUT = *reinterpret_cast<bf16x8*>(&w); } while (0)
  PK4(p0, 0, pa0); PK4(p0, 8, pa1); PK4(p1, 0, pa2); PK4(p1, 8, pa3);
#undef PK4
}
__device__ __forceinline__ void qkt(f32x16& p0, f32x16& p1, const char* Ks, const bf16x8* qr, int r32, int hi, int c) {
  p0 = f32x16{}; p1 = f32x16{};
#pragma unroll
  for (int d0 = 0; d0 < 4; ++d0) { const int cb = (c * 64 + d0 * 16 + hi * 8) * 2;
    const bf16x8 b0 = *reinterpret_cast<const bf16x8*>(Ks + KSWZ(r32, cb));
    const bf16x8 b1 = *reinterpret_cast<const bf16x8*>(Ks + KSWZ(32 + r32, cb));
    p0 = __builtin_amdgcn_mfma_f32_32x32x16_bf16(b0, qr[d0], p0, 0, 0, 0);
    p1 = __builtin_amdgcn_mfma_f32_32x32x16_bf16(b1, qr[d0], p1, 0, 0, 0); }
}
__device__ __forceinline__ int v_st(int k, int c) { const int kk = (k & ~0xC) | ((k & 4) << 1) | ((k & 8) >> 1); return ((kk >> 3) * 4 + (c >> 5)) * 512 + ((kk & 7) * 32 + (c & 31)) * 2; }
__device__ __forceinline__ int v_rd_base(int lane) { return ((lane & 3) << 3) | (((lane >> 2) & 3) << 6) | (((lane >> 4) & 1) << 5) | (((lane >> 5) & 1) << 8); }
constexpr int v_rd_off(int d0, int ks, int half) { return d0 * 512 + ks * 4096 + half * 2048; }
template <int OFF> __device__ __forceinline__ s16x4 tr_read(int vb) {
  s16x4 r; asm volatile("ds_read_b64_tr_b16 %0, %1 offset:%2" : "=&v"(r) : "v"(vb), "i"(OFF) : "memory"); return r;
}
template <int D0> __device__ __forceinline__ void pv_one(f32x16& od, int vb, bf16x8 pa0, bf16x8 pa1, bf16x8 pa2, bf16x8 pa3) {
  const s16x4 l0 = tr_read<v_rd_off(D0, 0, 0)>(vb), h0 = tr_read<v_rd_off(D0, 0, 1)>(vb), l1 = tr_read<v_rd_off(D0, 1, 0)>(vb), h1 = tr_read<v_rd_off(D0, 1, 1)>(vb);
  const s16x4 l2 = tr_read<v_rd_off(D0, 2, 0)>(vb), h2 = tr_read<v_rd_off(D0, 2, 1)>(vb), l3 = tr_read<v_rd_off(D0, 3, 0)>(vb), h3 = tr_read<v_rd_off(D0, 3, 1)>(vb);
  asm volatile("s_waitcnt lgkmcnt(0)" ::: "memory"); SBAR();
#define PK(L, H) (bf16x8){L[0], L[1], L[2], L[3], H[0], H[1], H[2], H[3]}
  od = __builtin_amdgcn_mfma_f32_32x32x16_bf16(pa0, PK(l0, h0), od, 0, 0, 0);
  od = __builtin_amdgcn_mfma_f32_32x32x16_bf16(pa1, PK(l1, h1), od, 0, 0, 0);
  od = __builtin_amdgcn_mfma_f32_32x32x16_bf16(pa2, PK(l2, h2), od, 0, 0, 0);
  od = __builtin_amdgcn_mfma_f32_32x32x16_bf16(pa3, PK(l3, h3), od, 0, 0, 0);
#undef PK
}
template <int NB> __device__ __forceinline__ void pv_blocks(f32x16* o, int vb, int vsel, bf16x8 pa0, bf16x8 pa1, bf16x8 pa2, bf16x8 pa3) {
  if constexpr (NB == 4) { pv_one<0>(o[0], vb, pa0, pa1, pa2, pa3); pv_one<1>(o[1], vb, pa0, pa1, pa2, pa3); pv_one<2>(o[2], vb, pa0, pa1, pa2, pa3); pv_one<3>(o[3], vb, pa0, pa1, pa2, pa3); }
  else { if (vsel == 0) { pv_one<0>(o[0], vb, pa0, pa1, pa2, pa3); pv_one<1>(o[1], vb, pa0, pa1, pa2, pa3); }
         else { pv_one<2>(o[0], vb, pa0, pa1, pa2, pa3); pv_one<3>(o[1], vb, pa0, pa1, pa2, pa3); } }
}
__device__ __forceinline__ void apply_mask(f32x16& p0, f32x16& p1, int mt, int i, int k0, int hi) {
  if (mt == 0) return;
#pragma unroll
  for (int r = 0; r < 16; ++r) { const int j0 = k0 + crow(r, hi), j1 = j0 + 32;
    const bool ok0 = (mt == 1) && (j0 - i <= SWA_WIN) && (i - j0 <= SWA_WIN), ok1 = (mt == 1) && (j1 - i <= SWA_WIN) && (i - j1 <= SWA_WIN);
    p0[r] = ok0 ? p0[r] : -1e30f; p1[r] = ok1 ? p1[r] : -1e30f; }
}

struct TileMap {
  int nl, tlo, bN, bC;
  __device__ __forceinline__ int row(int t) const { return t < nl ? bN + 64 * (tlo + t) : (t < nl + CTX / 64 ? bC + 64 * (t - nl) : bN + 64 * tlo); }
  __device__ __forceinline__ int mtype(int t) const { return t < nl ? 1 : (t < nl + CTX / 64 ? 0 : 2); }
  __device__ __forceinline__ int key0(int t) const { return 64 * (tlo + (t < nl ? t : 0)); }
};

template <int MODE>
__device__ __forceinline__ void attn_unit(const bf16_t* __restrict__ Pq, const bf16_t* __restrict__ Pk, const bf16_t* __restrict__ Pv, int LD, const TileMap tm, int NT,
                                          float m_init, float l_init, int i0, LAS unsigned char* ldsb, f32x16* o, float& l_out, int tid) {
  constexpr int NB = MODE == 0 ? 4 : 2;
  const int wid = tid >> 6, lane = tid & 63, r32 = lane & 31, hi = lane >> 5, c = wid >> 2;
  char* lds = (char*)ldsb;
  char* V_lds = lds; char* K_lds = lds + 2 * SHM_V;
  float* ws = (float*)(lds + SHM_WS) + wid * 64; float* al_l = ws + 32;
  float m_reg = m_init, l_reg = l_init; bf16x8 qr[4];
#pragma unroll
  for (int d = 0; d < NB; ++d) o[d] = f32x16{};
  const bf16_t* Qw = Pq + (size_t)r32 * LD + hi * 8;
#pragma unroll
  for (int d0 = 0; d0 < 4; ++d0) qr[d0] = *reinterpret_cast<const bf16x8*>(Qw + d0 * 16);
  const int sr = tid >> 4, sc = (tid & 15) * 8, vst0 = v_st(sr, sc), vst1 = v_st(32 + sr, sc);
  const int vb0 = (int)(uintptr_t)V_lds + v_rd_base(lane);
  struct { bf16x8 vs0, vs1, ks0, ks1; } sr_[2];
#define SLOAD(i, t) do { const size_t rb_ = (size_t)tm.row(t); \
    sr_[i].vs0 = *reinterpret_cast<const bf16x8*>(Pv + (rb_ + sr) * LD + sc); sr_[i].vs1 = *reinterpret_cast<const bf16x8*>(Pv + (rb_ + 32 + sr) * LD + sc); \
    sr_[i].ks0 = *reinterpret_cast<const bf16x8*>(Pk + (rb_ + sr) * LD + sc); sr_[i].ks1 = *reinterpret_cast<const bf16x8*>(Pk + (rb_ + 32 + sr) * LD + sc); } while (0)
#define SWRITE(b, i) do { *(bf16x8*)(V_lds + (b) * SHM_V + vst0) = sr_[i].vs0; *(bf16x8*)(V_lds + (b) * SHM_V + vst1) = sr_[i].vs1; const int kc = sc * 2; \
    *(bf16x8*)(K_lds + (b) * SHM_K + KSWZ(sr, kc)) = sr_[i].ks0; *(bf16x8*)(K_lds + (b) * SHM_K + KSWZ(32 + sr, kc)) = sr_[i].ks1; } while (0)
#define SWAIT() asm volatile("s_waitcnt vmcnt(4)" ::: "memory")
#define RESC(a) do { if (__any((a) < 1.f)) { if (hi == 0) al_l[r32] = (a); asm volatile("s_waitcnt lgkmcnt(0)" ::: "memory"); \
    _Pragma("unroll") for (int d = 0; d < NB; ++d) _Pragma("unroll") for (int r = 0; r < 16; ++r) o[d][r] *= al_l[crow(r, hi)]; } } while (0)
#define MASK(P0, P1, t) do { if constexpr (MODE == 1) apply_mask(P0, P1, tm.mtype(t), i0 + r32, tm.key0(t), hi); } while (0)
  f32x16 pA0, pA1, pB0, pB1; float mnA, mnB, alA, alB; bf16x8 pa0, pa1, pa2, pa3;
  constexpr int SE = 0, SO = 1;
  SLOAD(SE, 0); asm volatile("s_waitcnt vmcnt(0)" ::: "memory"); SWRITE(0, SE); __syncthreads();
  qkt(pA0, pA1, K_lds, qr, r32, hi, c); MASK(pA0, pA1, 0); partialSM(pA0, pA1, m_reg, mnA, alA);
  SLOAD(SO, 1); if (2 < NT) SLOAD(SE, 2);
  SWAIT(); SWRITE(1, SO); __syncthreads();
  for (int j = 1; j + 1 < NT; j += 2) {
    SBAR(); qkt(pB0, pB1, K_lds + SHM_K, qr, r32, hi, c);
    finishSM(pA0, pA1, alA, l_reg, pa0, pa1, pa2, pa3); SBAR();
    SLOAD(SO, j + 2); SBAR();
    pv_blocks<NB>(o, vb0, c, pa0, pa1, pa2, pa3); MASK(pB0, pB1, j); partialSM(pB0, pB1, m_reg, mnB, alB);
    __syncthreads(); SWAIT(); SWRITE(0, SE);
    RESC(alB); __syncthreads();
    SBAR(); qkt(pA0, pA1, K_lds, qr, r32, hi, c);
    finishSM(pB0, pB1, alB, l_reg, pa0, pa1, pa2, pa3); SBAR();
    if (j + 3 < NT) SLOAD(SE, j + 3);
    SBAR();
    pv_blocks<NB>(o, vb0 + (int)SHM_V, c, pa0, pa1, pa2, pa3); MASK(pA0, pA1, j + 1); partialSM(pA0, pA1, m_reg, mnA, alA);
    __syncthreads(); SWAIT(); SWRITE(1, SO);
    RESC(alA); __syncthreads();
  }
  SBAR(); qkt(pB0, pB1, K_lds + SHM_K, qr, r32, hi, c);
  finishSM(pA0, pA1, alA, l_reg, pa0, pa1, pa2, pa3); SBAR();
  pv_blocks<NB>(o, vb0, c, pa0, pa1, pa2, pa3); MASK(pB0, pB1, NT - 1); partialSM(pB0, pB1, m_reg, mnB, alB);
  __syncthreads(); RESC(alB);
  finishSM(pB0, pB1, alB, l_reg, pa0, pa1, pa2, pa3); SBAR();
  pv_blocks<NB>(o, vb0 + (int)SHM_V, c, pa0, pa1, pa2, pa3);
  l_out = l_reg;
  asm volatile("s_waitcnt vmcnt(0)" ::: "memory");
  __syncthreads();
#undef SLOAD
#undef SWRITE
#undef SWAIT
#undef RESC
#undef MASK
}

__device__ __forceinline__ void dif_phase(const Params& p, LAS unsigned char* ldsb, int G, int vcu, int tid) {
  const int wid = tid >> 6, lane = tid & 63, r32 = lane & 31, hi = lane >> 5, c = wid >> 2, rg = wid & 3;
  constexpr int NQB = N / 128, NU = B * DIF_H * NQB;
  const float lam = p.scal[0], oscale = p.scal[1];
  for (int L = vcu; L < NU; L += G) {
    const int qb = L % NQB, h = (L / NQB) % DIF_H, b = L / (NQB * DIF_H);
    const int t0 = b * N + qb * 128 + rg * 32;
    TileMap tm; tm.nl = N / 64; tm.tlo = 0; tm.bN = b * N; tm.bC = TL + b * CTX;
    f32x16 o[4]; float l_reg;
    attn_unit<0>(p.P + (size_t)t0 * DIF_IN + h * 128 + c * 64, p.P + DIF_QK + h * 128, p.P + 2 * DIF_QK + h * 128, DIF_IN, tm, (N + CTX) / 64,
                 -1e30f, 0.f, 0, ldsb, o, l_reg, tid);
    char* lds = (char*)ldsb;
    float* ws = (float*)(lds + SHM_WS) + wid * 64;
    float* xb = (float*)lds;
    if (hi == 0) ws[r32] = l_reg;
    asm volatile("s_waitcnt lgkmcnt(0)" ::: "memory");
    float rli[16];
#pragma unroll
    for (int r = 0; r < 16; ++r) rli[r] = __builtin_amdgcn_rcpf(ws[crow(r, hi)]);
    if (c == 1) {
#pragma unroll
      for (int d0 = 0; d0 < 4; ++d0)
#pragma unroll
        for (int r = 0; r < 16; ++r) xb[(rg * 32 + crow(r, hi)) * 128 + d0 * 32 + r32] = o[d0][r] * rli[r];
    }
    __syncthreads();
    if (c == 0) {
      float ss[16];
#pragma unroll
      for (int r = 0; r < 16; ++r) ss[r] = 0.f;
#pragma unroll
      for (int d0 = 0; d0 < 4; ++d0)
#pragma unroll
        for (int r = 0; r < 16; ++r) { const float v = o[d0][r] * rli[r] - lam * xb[(rg * 32 + crow(r, hi)) * 128 + d0 * 32 + r32]; o[d0][r] = v; ss[r] += v * v; }
#pragma unroll
      for (int r = 0; r < 16; ++r) {
#pragma unroll
        for (int sft = 1; sft < 32; sft <<= 1) ss[r] += __shfl_xor(ss[r], sft);
        ss[r] = oscale / sqrtf(ss[r] * (1.f / 128.f) + RMS_EPS); }
#pragma unroll
      for (int d0 = 0; d0 < 4; ++d0) { const float gsub = p.subln_g[d0 * 32 + r32];
#pragma unroll
        for (int r = 0; r < 16; ++r) p.Ymix[(size_t)(t0 + crow(r, hi)) * YW + h * 128 + d0 * 32 + r32] = f2bf(o[d0][r] * ss[r] * gsub); }
    }
    __syncthreads();
  }
}
__device__ __forceinline__ void swa_phase(const Params& p, LAS unsigned char* ldsb, int G, int vcu, int tid) {
  const int wid = tid >> 6, lane = tid & 63, r32 = lane & 31, hi = lane >> 5;
  constexpr int NUL = TL / 32, NUC = TC / 32;
  const float sink_raw = p.sink[wid] * (1.0f / SCALE);
  for (int L = vcu; L < NUL + NUC; L += G) {
    TileMap tm; int t0, NT, i0;
    if (L < NUL) { const int b = L / (N / 32), qb = L % (N / 32); i0 = qb * 32; t0 = b * N + i0;
      const int lo = i0 - SWA_WIN < 0 ? 0 : i0 - SWA_WIN, hi_ = i0 + 31 + SWA_WIN > N - 1 ? N - 1 : i0 + 31 + SWA_WIN;
      tm.tlo = lo / 64; tm.nl = hi_ / 64 - tm.tlo + 1; tm.bN = b * N; tm.bC = TL + b * CTX; NT = (tm.nl + CTX / 64 + 1) & ~1;
    } else { const int Lc = L - NUL, b = Lc / (CTX / 32), qb = Lc % (CTX / 32); i0 = 0; t0 = TL + b * CTX + qb * 32;
      tm.tlo = 0; tm.nl = 0; tm.bN = b * N; tm.bC = TL + b * CTX; NT = CTX / 64; }
    f32x16 o[2]; float l_reg;
    attn_unit<1>(p.P + (size_t)t0 * AB_IN + wid * 64, p.P + A_KOFF, p.P + A_VOFF, AB_IN, tm, NT, sink_raw, 1.f, i0, ldsb, o, l_reg, tid);
    char* lds = (char*)ldsb;
    float* ws = (float*)(lds + SHM_WS) + wid * 64;
    if (hi == 0) ws[r32] = l_reg;
    asm volatile("s_waitcnt lgkmcnt(0)" ::: "memory");
#pragma unroll
    for (int r = 0; r < 16; ++r) { const float rl = __builtin_amdgcn_rcpf(ws[crow(r, hi)]);
#pragma unroll
      for (int d0 = 0; d0 < 2; ++d0) p.Ymix[(size_t)(t0 + crow(r, hi)) * YW + wid * 64 + d0 * 32 + r32] = f2bf(o[d0][r] * rl); }
    __syncthreads();
  }
}
}


constexpr int N_TAB16A = 2 * SSM_G * SSM_P * 17;
__device__ __forceinline__ void st_tab16a(const Params& p, int idx) {
  const int k = idx % 17, q = idx / 17, dg = q / SSM_P;
  const double dt = exp((double)p.log_step[dg]), ar = p.a_re[q], ai = p.a_im[q], mag = exp(k * dt * ar);
  p.apow16[(size_t)idx * 2] = (float)(mag * cos(k * dt * ai)); p.apow16[(size_t)idx * 2 + 1] = (float)(mag * sin(k * dt * ai));
}
constexpr int N_TAB16B = 2 * SSM_G * 16 * 256;
__device__ __forceinline__ void st_tab16b(const Params& p, int idx) {
  const int ci = idx % 16, co = (idx / 16) % 16, lag = (idx / 256) % 16, dg = idx / 4096;
  float acc = 0.f;
  for (int pp = 0; pp < SSM_P; ++pp) { const int q = dg * SSM_P + pp;
    const float ar = p.apow16[((size_t)q * 17 + lag) * 2], ai = p.apow16[((size_t)q * 17 + lag) * 2 + 1];
    const float br = p.bbar[((size_t)q * 16 + ci) * 2], bi = p.bbar[((size_t)q * 16 + ci) * 2 + 1];
    const float cr = p.c_re[((size_t)dg * 16 + co) * SSM_P + pp], cim = p.c_im[((size_t)dg * 16 + co) * SSM_P + pp];
    acc += cr * (ar * br - ai * bi) - cim * (ar * bi + ai * br); }
  p.KT16[idx] = acc;
}
constexpr int N_BTY = 2 * SSM_G * 256 * A2K, N_BTE = 2 * SSM_G * 256 * 256;
__device__ __forceinline__ void st_tab16c(const Params& p, int idx) {
  if (idx < N_BTY) {
    const int k = idx % A2K, n = (idx / A2K) % 256, dg = idx / (A2K * 256); const int j = n / 16, co = n % 16;
    float v;
    if (k < 256) { const int j2 = k / 16, ci = k % 16; v = j2 <= j ? p.KT16[(((size_t)dg * 16 + (j - j2)) * 16 + co) * 16 + ci] : 0.f; }
    else { const int pp = (k - 256) % 64, im = (k - 256) / 64, q = dg * SSM_P + pp;
      const float ar = p.apow16[((size_t)q * 17 + j + 1) * 2], ai = p.apow16[((size_t)q * 17 + j + 1) * 2 + 1];
      const float cr = p.c_re[((size_t)dg * 16 + co) * SSM_P + pp], cim = p.c_im[((size_t)dg * 16 + co) * SSM_P + pp];
      v = im ? -(cr * ai + cim * ar) : (cr * ar - cim * ai); }
    p.BtY[idx] = f2bf(v); return; }
  idx -= N_BTY;
  const int k = idx % 256, n = (idx / 256) % 256, dg = idx / 65536; const int j = k / 16, ci = k % 16;
  float v = 0.f;
  if (n < 128) { const int pp = n % 64, im = n / 64, q = dg * SSM_P + pp;
    const float ar = p.apow16[((size_t)q * 17 + (15 - j)) * 2], ai = p.apow16[((size_t)q * 17 + (15 - j)) * 2 + 1];
    const float br = p.bbar[((size_t)q * 16 + ci) * 2], bi = p.bbar[((size_t)q * 16 + ci) * 2 + 1];
    v = im ? (ar * bi + ai * br) : (ar * br - ai * bi); }
  p.BtE[idx] = f2bf(v);
}
struct SsmOrder {
  int first, count, G, c;
  __device__ __forceinline__ bool next(int i, pg8::Unit& u) const { const int L = i * G + c; if (L >= count) return false; u.pm = first + L; u.pn = u.pm / 5; return true; }
  __device__ __forceinline__ void a_ready(const pg8::Unit&) const {}
  __device__ __forceinline__ void done(const pg8::Unit&) const {}
};
struct EpiE {
  static constexpr bool PERM = false;
  float* E;
  __device__ __forceinline__ void operator()(const f32x4 (&acc)[2][2][4][2], const pg8::Unit& u, int wr, int wc, int fr, int fq) const {
    const int row0 = u.pm * 256 + wr * 64 + fr, col0 = wc * 32 + 4 * fq;
#pragma unroll
    for (int ai = 0; ai < 2; ++ai)
#pragma unroll
      for (int m = 0; m < 4; ++m) { float* rowp = E + (size_t)(row0 + ai * 128 + m * 16) * 128 + col0;
#pragma unroll
        for (int n = 0; n < 2; ++n) *(f32x4*)(rowp + n * 16) = acc[ai][0][m][n]; }
  }
};
template <int DIR> struct EpiY {
  static constexpr bool PERM = false;
  float* Ypart; const bf16_t* P0; const float* dskip; bf16_t* Gs;
  __device__ __forceinline__ void operator()(const f32x4 (&acc)[2][2][4][2], const pg8::Unit& u, int wr, int wc, int fr, int fq) const {
    const int grp = u.pm / 5, g = grp % SSM_G, rg0 = (u.pm % 5) * 256 + wr * 64 + fr;
#pragma unroll
    for (int ai = 0; ai < 2; ++ai)
#pragma unroll
      for (int m = 0; m < 4; ++m) { const int rg = rg0 + ai * 128 + m * 16;
        if (rg < B * NCH16) { const int b = rg / NCH16, ch = rg % NCH16;
#pragma unroll
          for (int bj = 0; bj < 2; ++bj)
#pragma unroll
            for (int n = 0; n < 2; ++n) { const int j = 8 * bj + 2 * wc + n, tau = ch * LC + j;
              const int t = ssm_row(DIR, b, tau); const size_t o = (size_t)t * SSM_W + g * 16 + 4 * fq;
              if (DIR == 0) *(f32x4*)(Ypart + o) = acc[ai][bj][m][n];
              else { const f32x4 y0 = *(const f32x4*)(Ypart + o); const f32x4 dk = *(const f32x4*)(dskip + g * 16 + 4 * fq);
                const u32x2 uu = *(const u32x2*)(P0 + (size_t)t * AB_IN + A_UOFF + g * 16 + 4 * fq);
                f32x4 uv; uv.x = __builtin_bit_cast(float, uu.x << 16); uv.y = __builtin_bit_cast(float, uu.x & 0xffff0000u); uv.z = __builtin_bit_cast(float, uu.y << 16); uv.w = __builtin_bit_cast(float, uu.y & 0xffff0000u);
                const f32x4 y = acc[ai][bj][m][n] + y0 + dk * uv; float gl[4];
#pragma unroll
                for (int q = 0; q < 4; ++q) { const float x = y[q], w = 0.7978845608028654f * (x + 0.044715f * x * x * x); gl[q] = x * fast_sigmoid(2.f * w); }
                const u32x2 wv = {cvt_pk_bf16(gl[0], gl[1]), cvt_pk_bf16(gl[2], gl[3])};
                *(u32x2*)(Gs + o) = wv; } } } }
  }
};
__device__ __forceinline__ void ssm_carry_phase(const Params& p, int bx, int G, int tid) {
  for (int idx = bx * NTHR + tid; idx < 2 * SSM_G * B * SSM_P; idx += G * NTHR) {
    const int pp = idx % SSM_P, b = (idx / SSM_P) % B, dg = idx / (SSM_P * B), q = dg * SSM_P + pp;
    const float ar = p.apow16[((size_t)q * 17 + 16) * 2], ai = p.apow16[((size_t)q * 17 + 16) * 2 + 1];
    float sr = 0.f, si = 0.f;
    const size_t row0 = (size_t)dg * GROWS + (size_t)b * NCH16;
#pragma unroll 8
    for (int ch = 0; ch < NCH16; ++ch) { const size_t row = row0 + ch;
      p.A2[row * A2K + 256 + pp] = f2bf(sr); p.A2[row * A2K + 320 + pp] = f2bf(si);
      const float er = p.E16[row * 128 + pp], ei = p.E16[row * 128 + 64 + pp];
      const float nr = ar * sr - ai * si + er, ni = ar * si + ai * sr + ei; sr = nr; si = ni; }
  }
}

#define XB_TMO      128
#define XB_XCNT(j)  (256  + 64 * (j))
#define XB_XSUB(j)  (1280 + 64 * (j))
#define XB_XGEN(j)  (2304 + 64 * (j))
#define XB_TOP      3328
#define XB_TOPGEN   3392
#define XCD_BAR_WORDS 3456
#define XB_SPIN_CAP (1u << 22)
constexpr int CW_BAR = 4096;
__device__ __forceinline__ unsigned xb_ld(unsigned* p)              { return __hip_atomic_load(p, __ATOMIC_RELAXED, __HIP_MEMORY_SCOPE_AGENT); }
__device__ __forceinline__ unsigned xb_add(unsigned* p, unsigned v) { return __hip_atomic_fetch_add(p, v, __ATOMIC_RELAXED, __HIP_MEMORY_SCOPE_AGENT); }
__device__ __forceinline__ unsigned xb_xcc_id() { return (unsigned)__builtin_amdgcn_s_getreg((3 << 11) | 20) & 0xFu; }
#define XB_SPIN(cond, bar) do { unsigned _sp = 0; while (cond) { __builtin_amdgcn_s_sleep(1); \
    if ((++_sp & 255u) == 0u) { if (xb_ld(&(bar)[XB_TMO])) break; if (_sp > XB_SPIN_CAP) { atomicAdd(&(bar)[XB_TMO], 1u); break; } } } } while (0)
struct XcdBarrier { unsigned* bar; unsigned x; volatile LAS unsigned* st; };
__device__ __forceinline__ XcdBarrier xcd_barrier_post(unsigned* bar, volatile LAS unsigned* st) {
  XcdBarrier b; b.bar = bar; b.x = xb_xcc_id(); b.st = st;
  if (threadIdx.x == 0) (void)xb_add(&bar[XB_XCNT(b.x)], 1u);
  return b;
}
__device__ __forceinline__ void xcd_barrier_complete(unsigned* bar, unsigned x, unsigned& nloc, unsigned& nx) {
  const unsigned G = gridDim.x * gridDim.y * gridDim.z;
  unsigned sum, cnt, mine, sp = 0u;
  for (;;) {
    sum = 0u; cnt = 0u; mine = 0u;
#pragma unroll
    for (unsigned j = 0; j < 16; ++j) { const unsigned c = xb_ld(&bar[XB_XCNT(j)]); sum += c; cnt += (c > 0u) ? 1u : 0u; mine = (j == x) ? c : mine; }
    if (sum == G) break;
    __builtin_amdgcn_s_sleep(1);
    if ((++sp & 255u) == 0u) { if (xb_ld(&bar[XB_TMO])) break; if (sp > XB_SPIN_CAP) { atomicAdd(&bar[XB_TMO], 1u); break; } }
  }
  nloc = mine > 0u ? mine : 1u; nx = cnt > 0u ? cnt : 1u;
}
__device__ __forceinline__ void xcd_barrier(const XcdBarrier& b) {
  asm volatile("s_waitcnt vmcnt(0)" ::: "memory");
  __syncthreads();
  if (threadIdx.x == 0) {
    unsigned* bar = b.bar;
    __builtin_amdgcn_s_waitcnt(0);
    unsigned nloc = b.st[0], nx = b.st[1];
    if (nloc == 0u) { xcd_barrier_complete(bar, b.x, nloc, nx); b.st[0] = nloc; b.st[1] = nx; }
    const unsigned old = xb_add(&bar[XB_XSUB(b.x)], 1u);
    const unsigned gen = old / nloc;
    if (old + 1u == (gen + 1u) * nloc) {
      __builtin_amdgcn_fence(__ATOMIC_RELEASE, "agent");
      asm volatile("s_waitcnt vmcnt(0)" ::: "memory");
      const unsigned og = xb_add(&bar[XB_TOP], 1u);
      const unsigned tg = og / nx;
      if (og + 1u == (tg + 1u) * nx) xb_add(&bar[XB_TOPGEN], 1u);
      else XB_SPIN(xb_ld(&bar[XB_TOPGEN]) == tg, bar);
      __builtin_amdgcn_fence(__ATOMIC_ACQUIRE, "agent");
      xb_add(&bar[XB_XGEN(b.x)], 1u);
      asm volatile("s_waitcnt vmcnt(0)" ::: "memory");
    } else {
      XB_SPIN(xb_ld(&bar[XB_XGEN(b.x)]) == gen, bar);
      __builtin_amdgcn_fence(__ATOMIC_ACQUIRE, "agent");
      asm volatile("s_waitcnt vmcnt(0)" ::: "memory");
    }
  }
  __syncthreads();
}

__device__ __forceinline__ unsigned pk2(float lo, float hi) { return (unsigned)f2bf(lo) | ((unsigned)f2bf(hi) << 16); }
__device__ __forceinline__ void transpose_item(const float* W, int K, int N, bf16_t* WT, int k0, int n0, int dst_row0, LAS float* scr, int lane) {
#pragma unroll 8
  for (int i = 0; i < 32; ++i) { const int kk = 2 * i + (lane >> 5); scr[kk * 33 + (lane & 31)] = W[(size_t)(k0 + kk) * N + n0 + (lane & 31)]; }
  LDS_WAIT(); asm volatile("" ::: "memory");
  const int c = lane & 7;
#pragma unroll
  for (int j = 0; j < 4; ++j) { const int n = (lane >> 3) + 8 * j; const LAS float* s = scr + (8 * c) * 33 + n;
    u32x4 o; o.x = pk2(s[0 * 33], s[1 * 33]); o.y = pk2(s[2 * 33], s[3 * 33]); o.z = pk2(s[4 * 33], s[5 * 33]); o.w = pk2(s[6 * 33], s[7 * 33]);
    *(u32x4*)(WT + (size_t)(dst_row0 + n) * K + k0 + 8 * c) = o; }
  LDS_WAIT(); asm volatile("" ::: "memory");
}
__device__ __forceinline__ void transpose_matrix(const float* W, int K, int N, bf16_t* WT, LAS float* scr, int gw, int ngw, int lane) {
  const int nblk = N / 32, items = (K / 64) * nblk;
  for (int it = gw; it < items; it += ngw) { const int kb = it / nblk, nb = it % nblk; transpose_item(W, K, N, WT, 64 * kb, 32 * nb, 32 * nb, scr, lane); }
}
__device__ __forceinline__ void mod_row_to_bf16(const float* xr, const float* sc, const float* sh, bf16_t* orow, int lane) {
  const f32x4* x4 = (const f32x4*)xr + lane; const f32x4* c4 = (const f32x4*)sc + lane; const f32x4* h4 = (const f32x4*)sh + lane;
  unsigned long long* o8 = (unsigned long long*)orow + lane;
#pragma unroll
  for (int j = 0; j < 4; ++j) { const f32x4 v = x4[64 * j], c = c4[64 * j], h = h4[64 * j];
    const float a = v.x * (1.f + c.x) + h.x, b = v.y * (1.f + c.y) + h.y, cc = v.z * (1.f + c.z) + h.z, d = v.w * (1.f + c.w) + h.w;
    o8[64 * j] = (unsigned long long)pk2(a, b) | ((unsigned long long)pk2(cc, d) << 32); }
}


__device__ __forceinline__ float wave_sum(float v) {
#pragma unroll
  for (int o = 1; o < 64; o <<= 1) v += __shfl_xor(v, o);
  return v;
}
constexpr int CW_CNT = 8192;
#define CNT_WORD(layer, e) (CW_CNT + 64 * (MOE_E * (layer) + (e)))
#define LD4(dst, ptr) do { const f32x4* p4_ = (const f32x4*)(ptr) + lane; _Pragma("unroll") for (int j = 0; j < 4; ++j) dst[j] = p4_[64 * j]; } while (0)
constexpr int RT_CNT = 0, RT_WG = 256, RT_WE = RT_WG + D * 8;
__device__ __forceinline__ int rt_slot(int k) { return ((k & 3) * 4 + (k >> 8)) * 64 + ((k >> 2) & 63); }
__device__ __forceinline__ float bflo(unsigned w) { return __builtin_bit_cast(float, w << 16); }
__device__ __forceinline__ float bfhi(unsigned w) { return __builtin_bit_cast(float, w & 0xffff0000u); }
__device__ __forceinline__ void ln1_phase(const Params& p, int layer, int T, LAS unsigned char* lds, int gw, int ngw, int vcu, int lane, int tid) {
  LAS int* cnt_l = (LAS int*)(lds + RT_CNT);
  if (tid < MOE_E) cnt_l[tid] = 0;
  { const float* wg = p.moe_wg + (size_t)layer * D * MOE_G; const float* we = p.moe_we + (size_t)layer * MOE_G * D * MOE_EPG;
    for (int k = tid; k < D; k += NTHR) { const f32x4 w = *(const f32x4*)(wg + (size_t)k * 4); u32x2 o = {pk2(w.x, w.y), pk2(w.z, w.w)}; *(LAS u32x2*)(lds + RT_WG + rt_slot(k) * 8) = o; }
    for (int i = tid; i < MOE_G * D; i += NTHR) { const int g = i / D, k = i % D; const f32x4 a = *(const f32x4*)(we + (size_t)i * 8), b = *(const f32x4*)(we + (size_t)i * 8 + 4);
      u32x4 o = {pk2(a.x, a.y), pk2(a.z, a.w), pk2(b.x, b.y), pk2(b.z, b.w)}; *(LAS u32x4*)(lds + RT_WE + (g * D + rt_slot(k)) * 16) = o; } }
  __syncthreads();
  const int rpw = (T + ngw - 1) / ngw, t0 = gw * rpw;
  f32x4 g1[4], lg[4], lb[4], sc[4], sh[4]; int cur_r = -1;
  LD4(lg, p.ln1_g + (size_t)layer * D); LD4(lb, p.ln1_b + (size_t)layer * D);
  for (int t = t0; t < t0 + rpw && t < T; ++t) {
    const int r = tok_r(t);
    if (r != cur_r) { cur_r = r; LD4(g1, modp(p, layer, r, 2)); LD4(sc, modp(p, layer, r, 4)); LD4(sh, modp(p, layer, r, 3)); }
    f32x4 v[4], y[4]; LD4(v, xrow(p, layer, t)); LD4(y, p.F + (size_t)t * D);
    float s = 0.f;
#pragma unroll
    for (int j = 0; j < 4; ++j) { v[j] = v[j] * ALPHA + g1[j] * y[j]; s += (v[j].x + v[j].y) + (v[j].z + v[j].w); }
    const float mean = wave_sum(s) * (1.f / D); float s2 = 0.f;
#pragma unroll
    for (int j = 0; j < 4; ++j) { v[j] = v[j] - mean; s2 += (v[j].x * v[j].x + v[j].y * v[j].y) + (v[j].z * v[j].z + v[j].w * v[j].w); }
    const float rstd = 1.f / sqrtf(wave_sum(s2) * (1.f / D) + LN_EPS);
    f32x4* o4 = (f32x4*)(p.X1 + (size_t)t * D) + lane;
#pragma unroll
    for (int j = 0; j < 4; ++j) { v[j] = v[j] * rstd * lg[j] + lb[j]; o4[64 * j] = v[j]; v[j] = v[j] * (sc[j] + 1.f) + sh[j]; }
    f32x4 gl = {0.f, 0.f, 0.f, 0.f};
#pragma unroll
    for (int j = 0; j < 4; ++j)
#pragma unroll
      for (int c = 0; c < 4; ++c) { const u32x2 w = *(const LAS u32x2*)(lds + RT_WG + ((4 * c + j) * 64 + lane) * 8); const float h = v[j][c];
        gl.x += h * bflo(w.x); gl.y += h * bfhi(w.x); gl.z += h * bflo(w.y); gl.w += h * bfhi(w.y); }
    float lgv[4];
#pragma unroll
    for (int g = 0; g < 4; ++g) lgv[g] = wave_sum(gl[g]) + p.moe_bg[layer * MOE_G + g];
    int gi = 0; float mx = lgv[0];
#pragma unroll
    for (int g = 1; g < 4; ++g) if (lgv[g] > mx) { mx = lgv[g]; gi = g; }
    float den = 0.f;
#pragma unroll
    for (int g = 0; g < 4; ++g) den += __expf(lgv[g] - mx);
    const float gp = 1.0f / den;
    gi = __builtin_amdgcn_readfirstlane(gi);
    f32x4 e0 = {0.f, 0.f, 0.f, 0.f}, e1 = {0.f, 0.f, 0.f, 0.f};
#pragma unroll
    for (int j = 0; j < 4; ++j)
#pragma unroll
      for (int c = 0; c < 4; ++c) { const u32x4 w = *(const LAS u32x4*)(lds + RT_WE + (gi * D + (4 * c + j) * 64 + lane) * 16); const float h = v[j][c];
        e0.x += h * bflo(w.x); e0.y += h * bfhi(w.x); e0.z += h * bflo(w.y); e0.w += h * bfhi(w.y);
        e1.x += h * bflo(w.z); e1.y += h * bfhi(w.z); e1.z += h * bflo(w.w); e1.w += h * bfhi(w.w); }
    float le[8];
#pragma unroll
    for (int e = 0; e < 4; ++e) { le[e] = wave_sum(e0[e]) + p.moe_be[(layer * MOE_G + gi) * MOE_EPG + e]; le[4 + e] = wave_sum(e1[e]) + p.moe_be[(layer * MOE_G + gi) * MOE_EPG + 4 + e]; }
    int i0 = 0; float v0 = le[0];
#pragma unroll
    for (int e = 1; e < 8; ++e) if (le[e] > v0) { v0 = le[e]; i0 = e; }
    int i1 = -1; float v1 = -3e38f;
#pragma unroll
    for (int e = 0; e < 8; ++e) if (e != i0 && le[e] > v1) { v1 = le[e]; i1 = e; }
    if (lane == 0) {
      const float ex = __expf(v1 - v0);
      const int ea = gi * MOE_EPG + i0, eb = gi * MOE_EPG + i1;
      const int pa = __hip_atomic_fetch_add(cnt_l + ea, 1, __ATOMIC_RELAXED, __HIP_MEMORY_SCOPE_WORKGROUP), pb = __hip_atomic_fetch_add(cnt_l + eb, 1, __ATOMIC_RELAXED, __HIP_MEMORY_SCOPE_WORKGROUP);
      float* rt = p.route + (size_t)t * 8;
      rt[0] = (float)ea; rt[1] = (float)eb; rt[2] = gp / (1.0f + ex); rt[3] = gp * ex / (1.0f + ex); rt[4] = (float)pa; rt[5] = (float)pb;
    }
  }
  __syncthreads();
  if (tid < MOE_E) { const int c = cnt_l[tid];
    const int base = c ? (int)__hip_atomic_fetch_add(p.ctl + CNT_WORD(layer, tid), (unsigned)c, __ATOMIC_RELAXED, __HIP_MEMORY_SCOPE_AGENT) : 0;
    p.wgbase[((size_t)layer * 1024 + vcu) * MOE_E + tid] = base; }
}
__device__ __forceinline__ void scatter_phase(const Params& p, int layer, int T, LAS unsigned char* lds, int gw, int ngw, int vcu, int lane, int tid) {
  LAS int* off = (LAS int*)lds;
  if (tid == 0) {
    int o = 0, ntile = 0;
    for (int e = 0; e < MOE_E; ++e) { const int c = (int)__hip_atomic_load(p.ctl + CNT_WORD(layer, e), __ATOMIC_RELAXED, __HIP_MEMORY_SCOPE_AGENT);
      off[e] = o + p.wgbase[((size_t)layer * 1024 + vcu) * MOE_E + e]; const int nt = (c + 255) >> 8;
      if (blockIdx.x == 0) for (int i = 0; i < nt; ++i) p.moe_meta[1 + ntile + i] = e;
      ntile += nt; o += nt * 256; }
    if (blockIdx.x == 0) p.moe_meta[0] = ntile;
  }
  __syncthreads();
  const int rpw = (T + ngw - 1) / ngw, t0 = gw * rpw;
  f32x4 sc[4], sh[4]; int cur_r = -1;
  for (int t = t0; t < t0 + rpw && t < T; ++t) {
    const int r = tok_r(t);
    if (r != cur_r) { cur_r = r; LD4(sc, modp(p, layer, r, 4)); LD4(sh, modp(p, layer, r, 3)); }
    const float* rt = p.route + (size_t)t * 8;
    const int ea = (int)rt[0], eb = (int)rt[1]; const float wa = rt[2], wb = rt[3];
    const int sa = off[ea] + (int)rt[4], sb = off[eb] + (int)rt[5];
    f32x4 x[4]; LD4(x, p.X1 + (size_t)t * D);
    unsigned long long* oa = (unsigned long long*)(p.Amoe + (size_t)sa * D) + lane; unsigned long long* ob = (unsigned long long*)(p.Amoe + (size_t)sb * D) + lane;
#pragma unroll
    for (int j = 0; j < 4; ++j) { const f32x4 h = x[j] * (sc[j] + 1.f) + sh[j];
      const unsigned long long w = (unsigned long long)pk2(h.x, h.y) | ((unsigned long long)pk2(h.z, h.w) << 32); oa[64 * j] = w; ob[64 * j] = w; }
    if (lane == 0) { p.gate[sa] = wa; p.gate[sb] = wb; p.tokslot[2 * t] = sa; p.tokslot[2 * t + 1] = sb; }
  }
}
__device__ __forceinline__ void ln2_phase(const Params& p, int layer, int T, int gw, int ngw, int lane) {
  const int rpw = (T + ngw - 1) / ngw, t0 = gw * rpw;
  f32x4 g2[4], lg[4], lb[4], sc[4], sh[4]; int cur_r = -1;
  LD4(lg, p.ln2_g + (size_t)layer * D); LD4(lb, p.ln2_b + (size_t)layer * D);
  for (int t = t0; t < t0 + rpw && t < T; ++t) {
    const int r = tok_r(t);
    if (r != cur_r) { cur_r = r; LD4(g2, modp(p, layer, r, 5)); if (layer + 1 < DEPTH) { LD4(sc, modp(p, layer + 1, r, 1)); LD4(sh, modp(p, layer + 1, r, 0)); } }
    const int sa = p.tokslot[2 * t], sb = p.tokslot[2 * t + 1];
    const u32x2* fa = (const u32x2*)(p.F2 + (size_t)sa * D) + lane; const u32x2* fb = (const u32x2*)(p.F2 + (size_t)sb * D) + lane;
    f32x4 v[4]; LD4(v, p.X1 + (size_t)t * D); float s = 0.f;
#pragma unroll
    for (int j = 0; j < 4; ++j) { const u32x2 a = fa[64 * j], b = fb[64 * j];
      f32x4 f; f.x = bflo(a.x) + bflo(b.x); f.y = bfhi(a.x) + bfhi(b.x); f.z = bflo(a.y) + bflo(b.y); f.w = bfhi(a.y) + bfhi(b.y);
      v[j] = v[j] * ALPHA + g2[j] * f; s += (v[j].x + v[j].y) + (v[j].z + v[j].w); }
    const float mean = wave_sum(s) * (1.f / D); float s2 = 0.f;
#pragma unroll
    for (int j = 0; j < 4; ++j) { v[j] = v[j] - mean; s2 += (v[j].x * v[j].x + v[j].y * v[j].y) + (v[j].z * v[j].z + v[j].w * v[j].w); }
    const float rstd = 1.f / sqrtf(wave_sum(s2) * (1.f / D) + LN_EPS);
    if (layer == DEPTH - 1) {
      f32x4* o4 = (f32x4*)(p.out + (size_t)t * D) + lane;
#pragma unroll
      for (int j = 0; j < 4; ++j) o4[64 * j] = v[j] * rstd * lg[j] + lb[j];
    } else {
      f32x4* o4 = (f32x4*)(p.X + (size_t)t * D) + lane;
      unsigned long long* h8 = (unsigned long long*)(p.H + (size_t)t * D) + lane;
#pragma unroll
      for (int j = 0; j < 4; ++j) { const f32x4 o = v[j] * rstd * lg[j] + lb[j]; o4[64 * j] = o;
        const f32x4 h = o * (sc[j] + 1.f) + sh[j];
        h8[64 * j] = (unsigned long long)pk2(h.x, h.y) | ((unsigned long long)pk2(h.z, h.w) << 32); }
    }
  }
}
__device__ __forceinline__ void h0_phase(const Params& p, int gw, int ngw, int lane) {
  const int rpw = (TA + ngw - 1) / ngw, t0 = gw * rpw;
  f32x4 sc[4], sh[4]; int cur_r = -1;
  for (int t = t0; t < t0 + rpw && t < TA; ++t) {
    const int r = tok_r(t);
    if (r != cur_r) { cur_r = r; LD4(sc, modp(p, 0, r, 1)); LD4(sh, modp(p, 0, r, 0)); }
    f32x4 x[4]; LD4(x, xrow(p, 0, t));
    unsigned long long* h8 = (unsigned long long*)(p.H + (size_t)t * D) + lane;
#pragma unroll
    for (int j = 0; j < 4; ++j) { const f32x4 h = x[j] * (sc[j] + 1.f) + sh[j]; h8[64 * j] = (unsigned long long)pk2(h.x, h.y) | ((unsigned long long)pk2(h.z, h.w) << 32); }
  }
}
__device__ __forceinline__ void moe_weight_transposes(const Params& p, int layer, LAS float* scr, int gw, int ngw, int lane) {
  constexpr int I13 = (D / 64) * (MOE_F / 32), I2 = (MOE_F / 64) * (D / 32);
  constexpr int NIT = MOE_E * (2 * I13 + I2);
  for (int it = gw; it < NIT; it += ngw) {
    const int e = it / (2 * I13 + I2); int r = it % (2 * I13 + I2);
    if (r < 2 * I13) { const int which = r / I13; r %= I13; const int kb = r / (MOE_F / 32), nb = r % (MOE_F / 32), n0 = 32 * nb;
      const float* W = (which ? p.moe_w3 : p.moe_w1) + ((size_t)layer * MOE_E + e) * D * MOE_F;
      transpose_item(W, D, MOE_F, p.W13t, 64 * kb, n0, e * 2 * MOE_F + (n0 / 128) * 256 + which * 128 + (n0 % 128), scr, lane);
    } else { r -= 2 * I13; const int kb = r / (D / 32), nb = r % (D / 32);
      const float* W = p.moe_w2 + ((size_t)layer * MOE_E + e) * MOE_F * D;
      transpose_item(W, MOE_F, D, p.W2t, 64 * kb, 32 * nb, e * D + 32 * nb, scr, lane); }
  }
}


__device__ __forceinline__ void mod_phase(const Params& p, LAS unsigned char* lds, int vcu, int G, int tid, int lane, int wave) {
  constexpr int NR = B + 1, RP = 12;
  LAS float* sT = (LAS float*)lds;
  LAS float* part = sT + D * RP;
  for (int i = tid; i < NR * D; i += NTHR) { const int r = i / D, k = i % D; const float c = r < B ? p.c[(size_t)r * D + k] : p.c_ctx[k]; sT[k * RP + r] = c / (1.0f + __expf(-c)); }
  __syncthreads();
  constexpr int NT_ = DEPTH * (6 * D / 64);
  for (int task = vcu; task < NT_; task += G) {
    const int l = task / (6 * D / 64), j = (task % (6 * D / 64)) * 64 + lane;
    const float* w = p.mod_w + (size_t)l * D * 6 * D + (size_t)(wave * 128) * 6 * D + j;
    float acc[NR];
#pragma unroll
    for (int r = 0; r < NR; ++r) acc[r] = 0.f;
#pragma unroll 1
    for (int k0 = 0; k0 < 128; k0 += 16) {
      float wv[16];
#pragma unroll
      for (int u = 0; u < 16; ++u) wv[u] = w[(size_t)(k0 + u) * 6 * D];
#pragma unroll
      for (int u = 0; u < 16; ++u) { const LAS float* sr = sT + (wave * 128 + k0 + u) * RP;
        const f32x4 s0 = *(const LAS f32x4*)sr, s1 = *(const LAS f32x4*)(sr + 4); const float s8 = sr[8];
        acc[0] += s0.x * wv[u]; acc[1] += s0.y * wv[u]; acc[2] += s0.z * wv[u]; acc[3] += s0.w * wv[u];
        acc[4] += s1.x * wv[u]; acc[5] += s1.y * wv[u]; acc[6] += s1.z * wv[u]; acc[7] += s1.w * wv[u]; acc[8] += s8 * wv[u]; }
    }
#pragma unroll
    for (int r = 0; r < NR; ++r) part[(wave * NR + r) * 64 + lane] = acc[r];
    __syncthreads();
    for (int i = tid; i < NR * 64; i += NTHR) { const int r = i / 64, c = i % 64; float v = p.mod_b[(size_t)l * 6 * D + (task % (6 * D / 64)) * 64 + c];
#pragma unroll
      for (int ww = 0; ww < 8; ++ww) v += part[(ww * NR + r) * 64 + c];
      p.modv[((size_t)(l * NR + r) * 6 * D) + (task % (6 * D / 64)) * 64 + c] = v; }
    __syncthreads();
  }
}

__global__ void __launch_bounds__(NTHR, 2) mega_kernel(Params p_by_value) {
  const Params& p = *(const Params*)__builtin_amdgcn_kernarg_segment_ptr();
  extern __shared__ __attribute__((aligned(16))) unsigned char lds_raw[];
  LAS unsigned char* lds = (LAS unsigned char*)lds_raw;
  volatile LAS unsigned* MISC = (volatile LAS unsigned*)(lds + MISC_OFF);
  for (int u = threadIdx.x; u < (LDS_BYTES - LDSCTL_OFF) / 4; u += NTHR) ((LAS unsigned*)(lds + LDSCTL_OFF))[u] = 0u;
  __syncthreads();
  XcdBarrier bar = xcd_barrier_post(p.ctl + CW_BAR, MISC + 8);
#define PH_VARS                                                                                                       \
  int tid = threadIdx.x; asm volatile("" : "+v"(tid));                                                                \
  int bx = blockIdx.x; asm volatile("" : "+s"(bx));                                                                   \
  const int lane = tid & 63, wave = __builtin_amdgcn_readfirstlane(tid >> 6), G = gridDim.x;                          \
  const int vcu = (G % 8 == 0) ? (bx % 8) * (G / 8) + bx / 8 : bx;                                                    \
  const int gw = vcu * NWAVES + wave, ngw = G * NWAVES;                                                               \
  LAS float* scr = (LAS float*)(lds + wave * 16384);                                                                  \
  (void)lane; (void)gw; (void)ngw; (void)scr; (void)vcu;
#define GRID_BAR() xcd_barrier(bar)
#define RUN_NAIVE(S, layer, cnt)                                                                                  \
  {                                                                                                               \
    const int n_ = (cnt);                                                                                         \
    PH_VARS                                                                                                       \
    for (int idx = bx * NTHR + tid; idx < n_; idx += G * NTHR) run_elem<S>(p, layer, idx);                        \
  }

  { PH_VARS mod_phase(p, lds, vcu, G, tid, lane, wave); }
  RUN_NAIVE(S_TABA, 0, N_TABA)
  { PH_VARS for (int idx = bx * NTHR + tid; idx < N_TAB16A; idx += G * NTHR) st_tab16a(p, idx); }
  { PH_VARS
  transpose_matrix(p.w_in_a, D, AB_IN, p.WinA_t, scr, gw, ngw, lane);
  transpose_matrix(p.dif_w_in, D, DIF_IN, p.DifIn_t, scr, gw, ngw, lane);
  transpose_matrix(p.w_out_a, AB_OUT, D, p.WoutA_t, scr, gw, ngw, lane);
  transpose_matrix(p.dif_w_out, DIF_VW, D, p.DifOut_t, scr, gw, ngw, lane);
  transpose_matrix(p.glu_w, SSM_W, SSM_W, p.Glu_t, scr, gw, ngw, lane);
  moe_weight_transposes(p, 0, scr, gw, ngw, lane); }
  GRID_BAR();
  { PH_VARS for (int idx = bx * NTHR + tid; idx < N_TAB16B; idx += G * NTHR) st_tab16b(p, idx); }
  { PH_VARS h0_phase(p, gw, ngw, lane); }
  GRID_BAR();
#define PROJ_GEMM(NW_, WT_, ROPE_END_, A2_)                                                                                  \
  { PH_VARS                                                                                                             \
    pg8::Gemm g{p.H, WT_, D, D, D};                                                                                     \
    pg8::StaticOrder S; S.init(TA, NW_, G, bx);                                                            \
    EpiProj E{p.P, NW_, ROPE_END_, p.ropeT, A2_};                                                                            \
    pg8::gemm_phase<EpiProj, pg8::StaticOrder>(lds, g, S, E);                                                           \
  }                                                                                                                     \
  GRID_BAR();
#define LAYER_BACK(layer, T, WOT_, KO_)                                                                                 \
  { PH_VARS                                                                            \
    pg8::Gemm g{p.Ymix, WOT_, YW, KO_, KO_};                                                                            \
    pg8::StaticOrder S; S.init(T, D, G, bx);                                                               \
    EpiF32Out E{p.F, D};                                                                                                \
    pg8::gemm_phase<EpiF32Out, pg8::StaticOrder>(lds, g, S, E);                                                         \
  }                                                                                                                     \
  GRID_BAR();                                                                                                           \
  { PH_VARS ln1_phase(p, layer, T, lds, gw, ngw, vcu, lane, tid); }                                                      \
  GRID_BAR();                                                                                                           \
  { PH_VARS scatter_phase(p, layer, T, lds, gw, ngw, vcu, lane, tid); }                                                 \
  GRID_BAR();                                                                                                           \
  { PH_VARS                                                             \
    pg8::Gemm g{p.Amoe, p.W13t, D, D, D};                                                                               \
    MoeOrder S{p.moe_meta, 2, G, vcu};                                                                                  \
    EpiMoe1 E{p.HHb, p.gate};                                                                                           \
    pg8::gemm_phase<EpiMoe1, MoeOrder>(lds, g, S, E);                                                                   \
  }                                                                                                                     \
  GRID_BAR();                                                                                                           \
  { PH_VARS                                                                                  \
    pg8::Gemm g{p.HHb, p.W2t, MOE_F, MOE_F, MOE_F};                                                                     \
    MoeOrder S{p.moe_meta, 4, G, vcu};                                                                                  \
    EpiBf16Out E{p.F2, D, 4};                                                                                           \
    pg8::gemm_phase<EpiBf16Out, MoeOrder>(lds, g, S, E);                                                                \
  }                                                                                                                     \
  GRID_BAR();                                                                                                           \
  { PH_VARS ln2_phase(p, layer, T, gw, ngw, lane); }

  { PH_VARS for (int idx = bx * NTHR + tid; idx < N_BTY + N_BTE; idx += G * NTHR) st_tab16c(p, idx); }
  PROJ_GEMM(AB_IN, p.WinA_t, (SWA_QW + SWA_KVW), p.A2)
  { PH_VARS att::swa_phase(p, lds, G, vcu, tid); }
  { PH_VARS
    pg8::Gemm g{p.A2, p.BtE, A2K, 256, 256};
    SsmOrder S{0, 2 * SSM_G * 5, G, vcu};
    EpiE E{p.E16};
    pg8::gemm_phase<EpiE, SsmOrder>(lds, g, S, E);
  }
  GRID_BAR();
  { PH_VARS ssm_carry_phase(p, bx, G, tid); }
  GRID_BAR();
  { PH_VARS
    pg8::Gemm g{p.A2, p.BtY, A2K, A2K, A2K};
    SsmOrder S{0, SSM_G * 5, G, vcu};
    EpiY<0> E{p.Ypart, p.P, p.ssm_d, p.Gs};
    pg8::gemm_phase<EpiY<0>, SsmOrder>(lds, g, S, E);
  }
  GRID_BAR();
  { PH_VARS
    pg8::Gemm g{p.A2, p.BtY, A2K, A2K, A2K};
    SsmOrder S{SSM_G * 5, SSM_G * 5, G, vcu};
    EpiY<1> E{p.Ypart, p.P, p.ssm_d, p.Gs};
    pg8::gemm_phase<EpiY<1>, SsmOrder>(lds, g, S, E);
  }
  GRID_BAR();
  { PH_VARS
    pg8::Gemm g{p.Gs, p.Glu_t, SSM_W, SSM_W, SSM_W};
    pg8::StaticOrder S; S.init(TA, SSM_W, G, bx);
    EpiGlu E{p.Gs, p.glu_b, p.Ymix, YW, SWA_QW};
    pg8::gemm_phase<EpiGlu, pg8::StaticOrder>(lds, g, S, E);
  }
  GRID_BAR();
  LAYER_BACK(0, TA, p.WoutA_t, AB_OUT)
  { PH_VARS moe_weight_transposes(p, 1, scr, gw, ngw, lane); }
  GRID_BAR();
  PROJ_GEMM(DIF_IN, p.DifIn_t, (2 * DIF_QK), nullptr)
  { PH_VARS att::dif_phase(p, lds, G, vcu, tid); }
  GRID_BAR();
  LAYER_BACK(1, TL, p.DifOut_t, DIF_VW)
}

extern "C" void kernel_launch(void* const* d_in, const int* in_sizes, int n_in, void* d_out, int out_size, void* d_ws,
                              size_t ws_size, hipStream_t stream) {
  static int grid = 0;
  if (grid == 0) {
    if (ws_layout().total > ws_size || n_in != 37 || out_size != TL * D) { fprintf(stderr, "kernel_launch: bad sizes (ws need %zu have %zu)\n", ws_layout().total, ws_size); grid = -1; return; }
    int dev = 0, cus = 0;
    if (hipGetDevice(&dev) != hipSuccess || hipDeviceGetAttribute(&cus, hipDeviceAttributeMultiprocessorCount, dev) != hipSuccess) { grid = -1; return; }
    if (hipFuncSetAttribute((const void*)mega_kernel, hipFuncAttributeMaxDynamicSharedMemorySize, LDS_BYTES) != hipSuccess) { fprintf(stderr, "kernel_launch: hipFuncSetAttribute failed\n"); grid = -1; return; }
    grid = cus;
  }
  if (grid < 0) return;
  Params p{};
  fill_inputs(p, d_in);
  p.out = (float*)d_out;
  fill_ws(p, (char*)d_ws);
  if (hipMemsetAsync((char*)d_ws + ws_layout().ctl, 0, CTL_BYTES, stream) != hipSuccess) { fprintf(stderr, "kernel_launch: memset failed\n"); return; }
  hipLaunchKernelGGL(mega_kernel, dim3(grid), dim3(NTHR), LDS_BYTES, stream, p);
  const hipError_t le = hipPeekAtLastError();
  if (le != hipSuccess) fprintf(stderr, "kernel_launch: launch failed: %s\n", hipGetErrorName(le));
}
#endif
```

```cpp
#ifndef HOST_EMU
#include <hip/hip_runtime.h>
#define HD __host__ __device__ __forceinline__
#else
#define HD inline
#endif
#include <stdint.h>
#include <math.h>

#ifndef CFG_D
#define CFG_D 1024
#define CFG_B 8
#define CFG_N 2048
#define CFG_CTX 256
#endif

constexpr int D = CFG_D, B = CFG_B, N = CFG_N, CTX = CFG_CTX;
constexpr int DEPTH = 2, GRID_W = 64, HD_ = 64;
constexpr int TL = B * N, TC = B * CTX, TA = TL + TC;
constexpr int SWA_H = 8, SWA_QW = 512, SWA_KVW = 128, SWA_WIN = 128;
constexpr int SSM_W = D / 2, SSM_C = 16, SSM_G = SSM_W / 16, SSM_P = 64;
constexpr int AB_IN = SWA_QW + 2 * SWA_KVW + SSM_W;
constexpr int AB_OUT = SWA_QW + SSM_W;
constexpr int A_KOFF = SWA_QW, A_VOFF = SWA_QW + SWA_KVW, A_UOFF = SWA_QW + 2 * SWA_KVW;
constexpr int DIF_H = D / 128, DIF_QK = DIF_H * 128, DIF_VW = DIF_H * 128, DIF_IN = 2 * DIF_QK + DIF_VW;
constexpr int MOE_G = 4, MOE_EPG = 8, MOE_E = 32, MOE_F = D / 4;
constexpr int SL = 64;
constexpr int SS = CTX + N;
constexpr int NCH = SS / SL;
constexpr float LN_EPS = 1e-5f, RMS_EPS = 1e-5f;
constexpr float ALPHA = 1.41421356237309515f;
static_assert(CTX % SL == 0 && N % SL == 0, "chunking");
constexpr int YW = AB_OUT > D ? AB_OUT : D;

struct Params {
  const float *x, *c, *ctx, *c_ctx, *mod_w, *mod_b, *ln1_g, *ln1_b, *ln2_g, *ln2_b;
  const float *w_in_a, *w_out_a, *sink, *a_re, *a_im, *log_step, *b_re, *b_im, *c_re, *c_im, *ssm_d, *glu_w, *glu_b;
  const float *dif_w_in, *dif_w_out, *lq1, *lk1, *lq2, *lk2, *subln_g;
  const float *moe_wg, *moe_bg, *moe_we, *moe_be, *moe_w1, *moe_w3, *moe_w2;
  float* out;
  float *X, *X1, *F, *HH;
  uint16_t *P, *Ymix, *Gs;
  float *modv, *ropeT, *apow, *bbar, *KT, *E, *Sin, *route, *scal;
  uint16_t *H;
  uint16_t *WinA_t, *DifIn_t, *WoutA_t, *DifOut_t, *Glu_t, *W13t, *W2t;
  uint16_t *Amoe, *HHb, *F2;
  float* gate;
  int *wgbase;
  int *tokslot, *moe_meta;
  uint16_t *A2, *BtY, *BtE;
  float *apow16, *KT16, *E16, *Ypart;
  unsigned* ctl;
};

HD uint16_t f2bf(float f) {
  uint32_t u = __builtin_bit_cast(uint32_t, f);
  u += 0x7fffu + ((u >> 16) & 1u);
  return (uint16_t)(u >> 16);
}
HD float bf2f(uint16_t h) {
  uint32_t u = ((uint32_t)h) << 16;
  return __builtin_bit_cast(float, u);
}
HD float siluf(float x) { return x / (1.0f + expf(-x)); }
HD float sigmoidf_(float x) { return 1.0f / (1.0f + expf(-x)); }
HD float geluf_(float x) { return 0.5f * x * (1.0f + tanhf(0.7978845608028654f * (x + 0.044715f * x * x * x))); }

HD int tok_r(int t) { return t < TL ? t / N : B; }
HD const float* xrow(const Params& p, int layer, int t) {
  if (layer == 0) return t < TL ? p.x + (size_t)t * D : p.ctx + (size_t)(t - TL) * D;
  return p.X + (size_t)t * D;
}
HD const float* modp(const Params& p, int layer, int r, int which) {
  return p.modv + ((size_t)(layer * (B + 1) + r) * 6 + which) * D;
}

constexpr int N_MOD = DEPTH * (B + 1) * 6 * D;
HD void st_mod(const Params& p, int layer_unused, int idx) {
  int j = idx % (6 * D); int r = (idx / (6 * D)) % (B + 1); int l = idx / (6 * D * (B + 1));
  const float* cv = r < B ? p.c + (size_t)r * D : p.c_ctx;
  const float* w = p.mod_w + (size_t)l * D * 6 * D;
  float acc = p.mod_b[(size_t)l * 6 * D + j];
  for (int k = 0; k < D; ++k) acc += siluf(cv[k]) * w[(size_t)k * 6 * D + j];
  p.modv[idx] = acc;
}

constexpr int N_ROPE = 64 * 16;
constexpr int N_APOW = 2 * SSM_G * SSM_P * (SL + 1);
constexpr int N_BBAR = 2 * SSM_G * SSM_P * SSM_C;
constexpr int N_TABA = N_ROPE + N_APOW + N_BBAR + 1;
HD void st_taba(const Params& p, int layer_unused, int idx) {
  if (idx < N_ROPE) {
    int pos = idx / 16, f = idx % 16;
    float inv = powf(10000.0f, -(float)f / 16.0f);
    float ang = (float)pos * inv;
    p.ropeT[idx * 2] = cosf(ang); p.ropeT[idx * 2 + 1] = sinf(ang);
    return;
  }
  idx -= N_ROPE;
  if (idx < N_APOW) {
#ifndef HOST_EMU
    return;
#endif
    int k = idx % (SL + 1); int q = idx / (SL + 1);
    int dg = q / SSM_P;
    double dt = exp((double)p.log_step[dg]);
    double ar = p.a_re[q], ai = p.a_im[q];
    double mag = exp(k * dt * ar);
    p.apow[(size_t)idx * 2] = (float)(mag * cos(k * dt * ai));
    p.apow[(size_t)idx * 2 + 1] = (float)(mag * sin(k * dt * ai));
    return;
  }
  idx -= N_APOW;
  if (idx < N_BBAR) {
    int cc = idx % SSM_C; int q = idx / SSM_C; int dg = q / SSM_P;
    (void)cc;
    double dt = exp((double)p.log_step[dg]);
    double ar = p.a_re[q], ai = p.a_im[q];
    double mag = exp(dt * ar);
    double abr = mag * cos(dt * ai), abi = mag * sin(dt * ai);
    double den = ar * ar + ai * ai, nr = abr - 1.0;
    double cr = (nr * ar + abi * ai) / den, ci = (abi * ar - nr * ai) / den;
    double br = p.b_re[idx], bi = p.b_im[idx];
    p.bbar[(size_t)idx * 2] = (float)(cr * br - ci * bi);
    p.bbar[(size_t)idx * 2 + 1] = (float)(cr * bi + ci * br);
    return;
  }
  double s1 = 0, s2 = 0;
  for (int i = 0; i < HD_; ++i) { s1 += (double)p.lq1[i] * p.lk1[i]; s2 += (double)p.lq2[i] * p.lk2[i]; }
  double lam_init = 0.8 - 0.6 * exp(-0.3 * 1.0);
  p.scal[0] = (float)(exp(s1) - exp(s2) + lam_init);
  p.scal[1] = (float)(1.0 - lam_init);
}

constexpr int N_KT = 2 * SSM_G * SL * SSM_C * SSM_C;
HD void st_tabb(const Params& p, int layer_unused, int idx) {
  int ci = idx % SSM_C; int co = (idx / SSM_C) % SSM_C; int k = (idx / (SSM_C * SSM_C)) % SL; int dg = idx / (SSM_C * SSM_C * SL);
  float acc = 0.f;
  for (int pp = 0; pp < SSM_P; ++pp) {
    int q = dg * SSM_P + pp;
    float ar = p.apow[((size_t)q * (SL + 1) + k) * 2], ai = p.apow[((size_t)q * (SL + 1) + k) * 2 + 1];
    float br = p.bbar[((size_t)q * SSM_C + ci) * 2], bi = p.bbar[((size_t)q * SSM_C + ci) * 2 + 1];
    float cr = p.c_re[((size_t)dg * SSM_C + co) * SSM_P + pp], cim = p.c_im[((size_t)dg * SSM_C + co) * SSM_P + pp];
    float tr = ar * br - ai * bi, ti = ar * bi + ai * br;
    acc += cr * tr - cim * ti;
  }
  p.KT[idx] = acc;
}

HD void st_proj(const Params& p, int layer, int idx) {
  const int W = layer == 0 ? AB_IN : DIF_IN;
  const float* w = layer == 0 ? p.w_in_a : p.dif_w_in;
  const int rope_end = layer == 0 ? (SWA_QW + SWA_KVW) : (2 * DIF_QK);
  int t = idx / W, n = idx % W;
  int r = tok_r(t);
  if (layer == 1 && t >= TL && n < DIF_QK) return;
  const float* xr = xrow(p, layer, t);
  const float* sh = modp(p, layer, r, 0);
  const float* sc = modp(p, layer, r, 1);
  bool rope = (t < TL) && (n < rope_end);
  if (!rope) {
    float acc = 0.f;
    for (int k = 0; k < D; ++k) { float h = xr[k] * (1.0f + sc[k]) + sh[k]; acc += h * w[(size_t)k * W + n]; }
    p.P[(size_t)t * W + n] = f2bf(acc);
    return;
  }
  int d = n % 64, sub = d % 32;
  if (sub >= 16) return;
  float a1 = 0.f, a2 = 0.f;
  for (int k = 0; k < D; ++k) {
    float h = xr[k] * (1.0f + sc[k]) + sh[k];
    a1 += h * w[(size_t)k * W + n]; a2 += h * w[(size_t)k * W + n + 16];
  }
  int i = t % N;
  int pos = d < 32 ? i / GRID_W : i % GRID_W;
  float cs = p.ropeT[(pos * 16 + sub) * 2], sn = p.ropeT[(pos * 16 + sub) * 2 + 1];
  p.P[(size_t)t * W + n] = f2bf(a1 * cs - a2 * sn);
  p.P[(size_t)t * W + n + 16] = f2bf(a2 * cs + a1 * sn);
}

HD void st_swa(const Params& p, int layer, int idx) {
  int hq = idx / TA, t = idx % TA;
  int kvh = hq / 4;
  const uint16_t* P = p.P;
  float q[64], o[64];
  _Pragma("unroll") for (int d = 0; d < 64; ++d) { q[d] = bf2f(P[(size_t)t * AB_IN + hq * 64 + d]) * 0.125f; o[d] = 0.f; }
  float m = p.sink[hq], l = 1.0f;
  int b = t < TL ? t / N : (t - TL) / CTX;
  int nloc = t < TL ? 2 * SWA_WIN + 1 : 0;
  int i = t < TL ? t % N : 0;
  for (int kk = 0; kk < nloc + CTX; ++kk) {
    int row;
    if (kk < nloc) {
      int j = i - SWA_WIN + kk;
      if (j < 0 || j >= N) continue;
      row = b * N + j;
    } else row = TL + b * CTX + (kk - nloc);
    const uint16_t* kr = P + (size_t)row * AB_IN + A_KOFF + kvh * 64;
    const uint16_t* vr = P + (size_t)row * AB_IN + A_VOFF + kvh * 64;
    float s = 0.f;
    _Pragma("unroll") for (int d = 0; d < 64; ++d) s += q[d] * bf2f(kr[d]);
    if (s > m) { float f = expf(m - s); l *= f; for (int d = 0; d < 64; ++d) o[d] *= f; m = s; }
    float pe = expf(s - m);
    l += pe;
    _Pragma("unroll") for (int d = 0; d < 64; ++d) o[d] += pe * bf2f(vr[d]);
  }
  float il = 1.0f / l;
  _Pragma("unroll") for (int d = 0; d < 64; ++d) p.Ymix[(size_t)t * YW + hq * 64 + d] = f2bf(o[d] * il);
}

HD int ssm_row(int dir, int b, int tau) {
  if (dir == 0) return tau < CTX ? TL + b * CTX + tau : b * N + (tau - CTX);
  return tau < CTX ? TL + b * CTX + (CTX - 1 - tau) : b * N + (N - 1 - (tau - CTX));
}
constexpr int N_SSME = 2 * B * NCH * SSM_G * SSM_P;
HD void st_ssm_e(const Params& p, int layer, int idx) {
  int pp = idx % SSM_P; int g = (idx / SSM_P) % SSM_G; int ch = (idx / (SSM_P * SSM_G)) % NCH;
  int b = (idx / (SSM_P * SSM_G * NCH)) % B; int dir = idx / (SSM_P * SSM_G * NCH * B);
  int q = (dir * SSM_G + g) * SSM_P + pp;
  float er = 0.f, ei = 0.f;
  for (int j = 0; j < SL; ++j) {
    int row = ssm_row(dir, b, ch * SL + j);
    const uint16_t* u = p.P + (size_t)row * AB_IN + A_UOFF + g * 16;
    float vr = 0.f, vi = 0.f;
    _Pragma("unroll") for (int cc = 0; cc < 16; ++cc) {
      float uv = bf2f(u[cc]);
      vr += p.bbar[((size_t)q * 16 + cc) * 2] * uv; vi += p.bbar[((size_t)q * 16 + cc) * 2 + 1] * uv;
    }
    float ar = p.apow[((size_t)q * (SL + 1) + (SL - 1 - j)) * 2], ai = p.apow[((size_t)q * (SL + 1) + (SL - 1 - j)) * 2 + 1];
    er += ar * vr - ai * vi; ei += ar * vi + ai * vr;
  }
  p.E[(size_t)idx * 2] = er; p.E[(size_t)idx * 2 + 1] = ei;
}
constexpr int N_SSMC = 2 * B * SSM_G * SSM_P;
HD void st_ssm_c(const Params& p, int layer, int idx) {
  int pp = idx % SSM_P; int g = (idx / SSM_P) % SSM_G; int b = (idx / (SSM_P * SSM_G)) % B; int dir = idx / (SSM_P * SSM_G * B);
  int q = (dir * SSM_G + g) * SSM_P + pp;
  float ar = p.apow[((size_t)q * (SL + 1) + SL) * 2], ai = p.apow[((size_t)q * (SL + 1) + SL) * 2 + 1];
  float sr = 0.f, si = 0.f;
  for (int ch = 0; ch < NCH; ++ch) {
    size_t e = ((((size_t)dir * B + b) * NCH + ch) * SSM_G + g) * SSM_P + pp;
    p.Sin[e * 2] = sr; p.Sin[e * 2 + 1] = si;
    float er = p.E[e * 2], ei = p.E[e * 2 + 1];
    float nr = ar * sr - ai * si + er, ni = ar * si + ai * sr + ei;
    sr = nr; si = ni;
  }
}
HD void st_ssm_o(const Params& p, int layer, int idx) {
  int t = idx / SSM_W, n = idx % SSM_W; int g = n / 16, co = n % 16;
  int b, dirtau[2];
  if (t < TL) { b = t / N; int i = t % N; dirtau[0] = CTX + i; dirtau[1] = CTX + (N - 1 - i); }
  else { b = (t - TL) / CTX; int i = (t - TL) % CTX; dirtau[0] = i; dirtau[1] = CTX - 1 - i; }
  float y = p.ssm_d[n] * bf2f(p.P[(size_t)t * AB_IN + A_UOFF + n]);
  for (int dir = 0; dir < 2; ++dir) {
    int tau = dirtau[dir]; int ch = tau / SL, j = tau % SL;
    int dg = dir * SSM_G + g;
    size_t e0 = ((((size_t)dir * B + b) * NCH + ch) * SSM_G + g) * SSM_P;
    for (int pp = 0; pp < SSM_P; ++pp) {
      int q = dg * SSM_P + pp;
      float ar = p.apow[((size_t)q * (SL + 1) + (j + 1)) * 2], ai = p.apow[((size_t)q * (SL + 1) + (j + 1)) * 2 + 1];
      float sr = p.Sin[(e0 + pp) * 2], si = p.Sin[(e0 + pp) * 2 + 1];
      float tr = ar * sr - ai * si, ti = ar * si + ai * sr;
      float cr = p.c_re[((size_t)dg * 16 + co) * SSM_P + pp], cim = p.c_im[((size_t)dg * 16 + co) * SSM_P + pp];
      y += cr * tr - cim * ti;
    }
    for (int j2 = 0; j2 <= j; ++j2) {
      int row = ssm_row(dir, b, ch * SL + j2);
      const uint16_t* u = p.P + (size_t)row * AB_IN + A_UOFF + g * 16;
      const float* kt = p.KT + (((size_t)dg * SL + (j - j2)) * 16 + co) * 16;
      _Pragma("unroll") for (int ci = 0; ci < 16; ++ci) y += kt[ci] * bf2f(u[ci]);
    }
  }
  p.Gs[(size_t)t * SSM_W + n] = f2bf(geluf_(y));
}
HD void st_glu(const Params& p, int layer, int idx) {
  int t = idx / SSM_W, n = idx % SSM_W;
  float z = p.glu_b[n];
  const uint16_t* g = p.Gs + (size_t)t * SSM_W;
  for (int k = 0; k < SSM_W; ++k) z += bf2f(g[k]) * p.glu_w[(size_t)k * SSM_W + n];
  p.Ymix[(size_t)t * YW + SWA_QW + n] = f2bf(bf2f(g[n]) * sigmoidf_(z));
}

HD void st_dif(const Params& p, int layer, int idx) {
  int t = idx % TL; int he = idx / TL; int eh = he % 2, h = he / 2;
  int b = t / N;
  const uint16_t* P = p.P;
  float res[64];
  float lam = p.scal[0];
  _Pragma("unroll") for (int c = 0; c < 2; ++c) {
    float q[64], o[64];
    _Pragma("unroll") for (int d = 0; d < 64; ++d) { q[d] = bf2f(P[(size_t)t * DIF_IN + h * 128 + c * 64 + d]) * 0.125f; o[d] = 0.f; }
    float m = -1e30f, l = 0.f;
    for (int kk = 0; kk < N + CTX; ++kk) {
      int row = kk < N ? b * N + kk : TL + b * CTX + (kk - N);
      const uint16_t* kr = P + (size_t)row * DIF_IN + DIF_QK + h * 128 + c * 64;
      const uint16_t* vr = P + (size_t)row * DIF_IN + 2 * DIF_QK + h * 128 + eh * 64;
      float s = 0.f;
      _Pragma("unroll") for (int d = 0; d < 64; ++d) s += q[d] * bf2f(kr[d]);
      if (s > m) { float f = expf(m - s); l *= f; for (int d = 0; d < 64; ++d) o[d] *= f; m = s; }
      float pe = expf(s - m);
      l += pe;
      _Pragma("unroll") for (int d = 0; d < 64; ++d) o[d] += pe * bf2f(vr[d]);
    }
    float il = 1.0f / l;
    if (c == 0) { for (int d = 0; d < 64; ++d) res[d] = o[d] * il; }
    else { for (int d = 0; d < 64; ++d) res[d] -= lam * o[d] * il; }
  }
  _Pragma("unroll") for (int d = 0; d < 64; ++d) p.Ymix[(size_t)t * YW + h * 128 + eh * 64 + d] = f2bf(res[d]);
}
HD void st_difnorm(const Params& p, int layer, int idx) {
  int t = idx / DIF_H, h = idx % DIF_H;
  uint16_t* o = p.Ymix + (size_t)t * YW + h * 128;
  float ss = 0.f;
  for (int e = 0; e < 128; ++e) { float v = bf2f(o[e]); ss += v * v; }
  float r = 1.0f / sqrtf(ss / 128.0f + RMS_EPS) * p.scal[1];
  _Pragma("unroll 8") for (int e = 0; e < 128; ++e) o[e] = f2bf(bf2f(o[e]) * r * p.subln_g[e]);
}

HD void st_outproj(const Params& p, int layer, int idx) {
  int t = idx / D, n = idx % D;
  const float* w = layer == 0 ? p.w_out_a : p.dif_w_out;
  const uint16_t* y = p.Ymix + (size_t)t * YW;
  const int KW = layer == 0 ? AB_OUT : DIF_VW;
  float acc = 0.f;
  for (int k = 0; k < KW; ++k) acc += bf2f(y[k]) * w[(size_t)k * D + n];
  p.F[(size_t)t * D + n] = acc;
}
HD void st_ln1(const Params& p, int layer, int t) {
  int r = tok_r(t);
  const float* xr = xrow(p, layer, t); const float* g1 = modp(p, layer, r, 2);
  const float* y = p.F + (size_t)t * D;
  float mu = 0.f;
  for (int k = 0; k < D; ++k) mu += ALPHA * xr[k] + g1[k] * y[k];
  mu /= D;
  float var = 0.f;
  for (int k = 0; k < D; ++k) { float v = ALPHA * xr[k] + g1[k] * y[k] - mu; var += v * v; }
  var /= D;
  float rs = 1.0f / sqrtf(var + LN_EPS);
  const float* lg = p.ln1_g + (size_t)layer * D; const float* lb = p.ln1_b + (size_t)layer * D;
  for (int k = 0; k < D; ++k) p.X1[(size_t)t * D + k] = (ALPHA * xr[k] + g1[k] * y[k] - mu) * rs * lg[k] + lb[k];
}
HD void st_route(const Params& p, int layer, int t) {
  int r = tok_r(t);
  const float* x1 = p.X1 + (size_t)t * D; const float* sh = modp(p, layer, r, 3); const float* sc = modp(p, layer, r, 4);
  float lg[MOE_G];
  _Pragma("unroll") for (int g = 0; g < MOE_G; ++g) lg[g] = p.moe_bg[layer * MOE_G + g];
  const float* wg = p.moe_wg + (size_t)layer * D * MOE_G;
  for (int k = 0; k < D; ++k) {
    float h = x1[k] * (1.0f + sc[k]) + sh[k];
    _Pragma("unroll") for (int g = 0; g < MOE_G; ++g) lg[g] += h * wg[k * MOE_G + g];
  }
  int gi = 0; float mx = lg[0];
  _Pragma("unroll") for (int g = 1; g < MOE_G; ++g) if (lg[g] > mx) { mx = lg[g]; gi = g; }
  float den = 0.f;
  _Pragma("unroll") for (int g = 0; g < MOE_G; ++g) den += expf(lg[g] - mx);
  float gp = 1.0f / den;
  float le[MOE_EPG];
  _Pragma("unroll") for (int e = 0; e < MOE_EPG; ++e) le[e] = p.moe_be[(layer * MOE_G + gi) * MOE_EPG + e];
  const float* we = p.moe_we + ((size_t)layer * MOE_G + gi) * D * MOE_EPG;
  for (int k = 0; k < D; ++k) {
    float h = x1[k] * (1.0f + sc[k]) + sh[k];
    _Pragma("unroll") for (int e = 0; e < MOE_EPG; ++e) le[e] += h * we[k * MOE_EPG + e];
  }
  int i0 = 0; float v0 = le[0];
  _Pragma("unroll") for (int e = 1; e < MOE_EPG; ++e) if (le[e] > v0) { v0 = le[e]; i0 = e; }
  int i1 = -1; float v1 = -3e38f;
  _Pragma("unroll") for (int e = 0; e < MOE_EPG; ++e) if (e != i0 && le[e] > v1) { v1 = le[e]; i1 = e; }
  float e1 = expf(v1 - v0);
  float w0 = gp / (1.0f + e1), w1 = gp * e1 / (1.0f + e1);
  p.route[(size_t)t * 4 + 0] = (float)(gi * MOE_EPG + i0);
  p.route[(size_t)t * 4 + 1] = (float)(gi * MOE_EPG + i1);
  p.route[(size_t)t * 4 + 2] = w0;
  p.route[(size_t)t * 4 + 3] = w1;
}
HD void st_moe_h(const Params& p, int layer, int idx) {
  int f = idx % MOE_F; int j = (idx / MOE_F) % 2; int t = idx / (2 * MOE_F);
  int r = tok_r(t);
  const float* x1 = p.X1 + (size_t)t * D; const float* sh = modp(p, layer, r, 3); const float* sc = modp(p, layer, r, 4);
  int e = (int)p.route[(size_t)t * 4 + j]; float wgt = p.route[(size_t)t * 4 + 2 + j];
  const float* w1 = p.moe_w1 + ((size_t)layer * MOE_E + e) * D * MOE_F;
  const float* w3 = p.moe_w3 + ((size_t)layer * MOE_E + e) * D * MOE_F;
  float h1 = 0.f, h3 = 0.f;
  for (int k = 0; k < D; ++k) {
    float h = x1[k] * (1.0f + sc[k]) + sh[k];
    h1 += h * w1[(size_t)k * MOE_F + f]; h3 += h * w3[(size_t)k * MOE_F + f];
  }
  p.HH[(size_t)idx] = siluf(h1) * h3 * wgt;
}
HD void st_moe_o(const Params& p, int layer, int idx) {
  int t = idx / D, n = idx % D;
  float acc = 0.f;
  for (int j = 0; j < 2; ++j) {
    int e = (int)p.route[(size_t)t * 4 + j];
    const float* w2 = p.moe_w2 + ((size_t)layer * MOE_E + e) * MOE_F * D;
    const float* hh = p.HH + ((size_t)t * 2 + j) * MOE_F;
    for (int f = 0; f < MOE_F; ++f) acc += hh[f] * w2[(size_t)f * D + n];
  }
  p.F[(size_t)t * D + n] = acc;
}
HD void st_ln2(const Params& p, int layer, int t) {
  int r = tok_r(t);
  const float* x1 = p.X1 + (size_t)t * D; const float* g2 = modp(p, layer, r, 5);
  const float* y = p.F + (size_t)t * D;
  float mu = 0.f;
  for (int k = 0; k < D; ++k) mu += ALPHA * x1[k] + g2[k] * y[k];
  mu /= D;
  float var = 0.f;
  for (int k = 0; k < D; ++k) { float v = ALPHA * x1[k] + g2[k] * y[k] - mu; var += v * v; }
  var /= D;
  float rs = 1.0f / sqrtf(var + LN_EPS);
  const float* lg = p.ln2_g + (size_t)layer * D; const float* lb = p.ln2_b + (size_t)layer * D;
  float* dst = layer == DEPTH - 1 ? p.out + (size_t)t * D : p.X + (size_t)t * D;
  for (int k = 0; k < D; ++k) dst[k] = (ALPHA * x1[k] + g2[k] * y[k] - mu) * rs * lg[k] + lb[k];
}

enum { S_MOD, S_TABA, S_TABB, S_PROJ, S_SWA, S_SSME, S_SSMC, S_SSMO, S_GLU, S_DIF, S_DIFNORM, S_OUTPROJ, S_LN1, S_ROUTE, S_MOEH, S_MOEO, S_LN2 };
template <int S> HD void run_elem(const Params& p, int layer, int idx) {
  if (S == S_MOD) st_mod(p, layer, idx);
  else if (S == S_TABA) st_taba(p, layer, idx);
  else if (S == S_TABB) st_tabb(p, layer, idx);
  else if (S == S_PROJ) st_proj(p, layer, idx);
  else if (S == S_SWA) st_swa(p, layer, idx);
  else if (S == S_SSME) st_ssm_e(p, layer, idx);
  else if (S == S_SSMC) st_ssm_c(p, layer, idx);
  else if (S == S_SSMO) st_ssm_o(p, layer, idx);
  else if (S == S_GLU) st_glu(p, layer, idx);
  else if (S == S_DIF) st_dif(p, layer, idx);
  else if (S == S_DIFNORM) st_difnorm(p, layer, idx);
  else if (S == S_OUTPROJ) st_outproj(p, layer, idx);
  else if (S == S_LN1) st_ln1(p, layer, idx);
  else if (S == S_ROUTE) st_route(p, layer, idx);
  else if (S == S_MOEH) st_moe_h(p, layer, idx);
  else if (S == S_MOEO) st_moe_o(p, layer, idx);
  else if (S == S_LN2) st_ln2(p, layer, idx);
}

constexpr int NSLOT = 2 * TA + MOE_E * 256;
constexpr size_t CTL_BYTES = 1u << 20;
struct WsLayout {
  size_t A2, BtY, BtE, apow16, KT16, E16, Ypart, wgbase;
  size_t ctl, X, X1, P, Ymix, Gs, modv, ropeT, apow, bbar, KT, E, Sin, route, scal, WinA_t, DifIn_t, WoutA_t, DifOut_t, Glu_t, W13t, W2t, gate, tokslot, moe_meta, total;
};
inline WsLayout ws_layout() {
  WsLayout L; size_t o = 0;
  auto take = [&](size_t bytes) { size_t r = o; o += (bytes + 255) & ~(size_t)255; return r; };
  L.ctl = take(CTL_BYTES);
  L.X = take((size_t)TA * D * 4);
  L.X1 = L.X;
  L.P = take((size_t)TA * (AB_IN > DIF_IN ? AB_IN : DIF_IN) * 2);
  L.Ymix = take((size_t)TA * YW * 2);
  L.Gs = L.X;
  L.modv = take((size_t)N_MOD * 4);
  L.ropeT = take((size_t)N_ROPE * 2 * 4);
  L.apow = take((size_t)N_APOW * 2 * 4);
  L.bbar = take((size_t)N_BBAR * 2 * 4);
  L.KT = take((size_t)N_KT * 4);
  L.E = L.X + (((size_t)TA * SSM_W * 2 + 255) & ~(size_t)255);
  L.Sin = L.E + (((size_t)N_SSME * 2 * 4 + 255) & ~(size_t)255);
  L.route = take((size_t)TA * 8 * 4);
  L.scal = take(256);
  L.WinA_t = take((size_t)AB_IN * D * 2);
  L.DifIn_t = take((size_t)DIF_IN * D * 2);
  L.WoutA_t = take((size_t)D * AB_OUT * 2);
  L.DifOut_t = take((size_t)D * DIF_VW * 2);
  L.Glu_t = take((size_t)SSM_W * SSM_W * 2);
  L.W13t = take((size_t)MOE_E * 2 * MOE_F * D * 2);
  L.W2t = take((size_t)MOE_E * D * MOE_F * 2);
  L.gate = take((size_t)NSLOT * 4);
  L.tokslot = take((size_t)TA * 2 * 4);
  L.moe_meta = take(4096);
  L.wgbase = take((size_t)DEPTH * 1024 * MOE_E * 4);
  L.BtY = take((size_t)2 * SSM_G * 256 * 384 * 2);
  L.BtE = take((size_t)2 * SSM_G * 256 * 256 * 2);
  L.apow16 = take((size_t)2 * SSM_G * SSM_P * 17 * 2 * 4);
  L.KT16 = take((size_t)2 * SSM_G * 16 * 256 * 4);
  L.A2 = L.P + (size_t)48 * 1024 * 1024;
  L.E16 = L.X + (size_t)19 * 1024 * 1024;
  L.Ypart = L.E16;
  L.total = o;
  return L;
}
inline void fill_ws(Params& p, char* ws) {
  WsLayout L = ws_layout();
  p.X = (float*)(ws + L.X); p.X1 = (float*)(ws + L.X1); p.P = (uint16_t*)(ws + L.P); p.F = (float*)(ws + L.P);
  p.Ymix = (uint16_t*)(ws + L.Ymix); p.HH = (float*)(ws + L.Ymix);
  p.Gs = (uint16_t*)(ws + L.Gs); p.modv = (float*)(ws + L.modv); p.ropeT = (float*)(ws + L.ropeT);
  p.apow = (float*)(ws + L.apow); p.bbar = (float*)(ws + L.bbar); p.KT = (float*)(ws + L.KT);
  p.E = (float*)(ws + L.E); p.Sin = (float*)(ws + L.Sin); p.route = (float*)(ws + L.route); p.scal = (float*)(ws + L.scal);
  p.H = (uint16_t*)(ws + L.Ymix); p.WinA_t = (uint16_t*)(ws + L.WinA_t); p.DifIn_t = (uint16_t*)(ws + L.DifIn_t); p.ctl = (unsigned*)(ws + L.ctl);
  p.WoutA_t = (uint16_t*)(ws + L.WoutA_t); p.DifOut_t = (uint16_t*)(ws + L.DifOut_t); p.Glu_t = (uint16_t*)(ws + L.Glu_t);
  p.W13t = (uint16_t*)(ws + L.W13t); p.W2t = (uint16_t*)(ws + L.W2t);
  p.Amoe = (uint16_t*)(ws + L.P); p.F2 = (uint16_t*)(ws + L.P); p.HHb = (uint16_t*)(ws + L.Ymix);
  p.A2 = (uint16_t*)(ws + L.A2); p.BtY = (uint16_t*)(ws + L.BtY); p.BtE = (uint16_t*)(ws + L.BtE);
  p.apow16 = (float*)(ws + L.apow16); p.KT16 = (float*)(ws + L.KT16); p.E16 = (float*)(ws + L.E16); p.Ypart = (float*)(ws + L.Ypart);
  p.wgbase = (int*)(ws + L.wgbase);
  p.gate = (float*)(ws + L.gate); p.tokslot = (int*)(ws + L.tokslot); p.moe_meta = (int*)(ws + L.moe_meta);
}
inline void fill_inputs(Params& p, void* const* d_in) {
  const float* const* in = (const float* const*)d_in;
  p.x = in[0]; p.c = in[1]; p.ctx = in[2]; p.c_ctx = in[3]; p.mod_w = in[4]; p.mod_b = in[5];
  p.ln1_g = in[6]; p.ln1_b = in[7]; p.ln2_g = in[8]; p.ln2_b = in[9];
  p.w_in_a = in[10]; p.w_out_a = in[11]; p.sink = in[12]; p.a_re = in[13]; p.a_im = in[14]; p.log_step = in[15];
  p.b_re = in[16]; p.b_im = in[17]; p.c_re = in[18]; p.c_im = in[19]; p.ssm_d = in[20]; p.glu_w = in[21]; p.glu_b = in[22];
  p.dif_w_in = in[23]; p.dif_w_out = in[24]; p.lq1 = in[25]; p.lk1 = in[26]; p.lq2 = in[27]; p.lk2 = in[28]; p.subln_g = in[29];
  p.moe_wg = in[30]; p.moe_bg = in[31]; p.moe_we = in[32]; p.moe_be = in[33]; p.moe_w1 = in[34]; p.moe_w3 = in[35]; p.moe_w2 = in[36];
}

#define FORWARD_PROGRAM(RUN)                                   \
  RUN(S_MOD, 0, N_MOD)                                         \
  RUN(S_TABA, 0, N_TABA)                                       \
  RUN(S_TABB, 0, N_KT)                                         \
                                                   \
  RUN(S_PROJ, 0, TA * AB_IN)                                   \
  RUN(S_SWA, 0, SWA_H * TA)                                    \
  RUN(S_SSME, 0, N_SSME)                                       \
  RUN(S_SSMC, 0, N_SSMC)                                       \
  RUN(S_SSMO, 0, TA * SSM_W)                                   \
  RUN(S_GLU, 0, TA * SSM_W)                                    \
  RUN(S_OUTPROJ, 0, TA * D)                                    \
  RUN(S_LN1, 0, TA)                                            \
  RUN(S_ROUTE, 0, TA)                                          \
  RUN(S_MOEH, 0, TA * 2 * MOE_F)                               \
  RUN(S_MOEO, 0, TA * D)                                       \
  RUN(S_LN2, 0, TA)                                            \
                                                   \
  RUN(S_PROJ, 1, TA * DIF_IN)                                  \
  RUN(S_DIF, 1, DIF_H * 2 * TL)                                \
  RUN(S_DIFNORM, 1, TL * DIF_H)                                \
  RUN(S_OUTPROJ, 1, TL * D)                                    \
  RUN(S_LN1, 1, TL)                                            \
  RUN(S_ROUTE, 1, TL)                                          \
  RUN(S_MOEH, 1, TL * 2 * MOE_F)                               \
  RUN(S_MOEO, 1, TL * D)                                       \
  RUN(S_LN2, 1, TL)

#ifndef HOST_EMU
#include <cstdio>
#define LAS __attribute__((address_space(3)))
#define GAS __attribute__((address_space(1)))
typedef unsigned short bf16_t;
typedef short bf16x8 __attribute__((ext_vector_type(8)));
typedef float f32x4 __attribute__((ext_vector_type(4)));
typedef float f32x2 __attribute__((ext_vector_type(2)));
typedef unsigned u32x4 __attribute__((ext_vector_type(4)));
typedef unsigned u32x2 __attribute__((ext_vector_type(2)));
constexpr int NWAVES = 8, NTHR = 512;
constexpr int RING_BYTES = 131072, LDSCTL_OFF = RING_BYTES, MISC_OFF = LDSCTL_OFF + 320, LDS_BYTES = 147456;
#define LDS_WAIT() asm volatile("s_waitcnt lgkmcnt(0)" ::: "memory")
#define VM_WAIT() asm volatile("s_waitcnt vmcnt(0)" ::: "memory")
__device__ __forceinline__ unsigned cvt_pk_bf16(float lo, float hi) { unsigned r; asm volatile("v_cvt_pk_bf16_f32 %0, %1, %2" : "=v"(r) : "v"(lo), "v"(hi)); return r; }

namespace pg8 {
constexpr int BM = 256, BK = 64, HALF = 128, HTB = HALF * BK * 2, STAGE_BYTES = 8 * HTB, NXCD = 8, WGM = 8;
__host__ __device__ __forceinline__ int lds_byte(int r, int c) { const int st = (r >> 4) * 2 + (c >> 5), rr = r & 15, cc = c & 31, ob = rr * 64 + cc * 2; return st * 1024 + (ob ^ (((ob >> 9) & 1) << 5)); }
__host__ __device__ __forceinline__ void stage_rc(int b, int& R, int& C) { const int st = b / 1024, sb = b % 1024, swz = sb ^ (((sb >> 9) & 1) << 5); R = (st >> 1) * 16 + swz / 64; C = (st & 1) * 32 + (swz % 64) / 2; }
__host__ __device__ __forceinline__ int perm32(int rho) { const int n = rho >> 4, i = rho & 15; return 8 * (i >> 2) + 4 * n + (i & 3); }
struct Unit { int pm, pn; };
struct Gemm { const bf16_t* A; const bf16_t* Bt; int lda, ldb, K; };

struct StaticOrder {
  int nM, nN, nwg, G, c;
  __device__ void init(int M, int N, int G_, int c_) { nM = M / BM; nN = N / BM; nwg = nM * nN; G = G_; c = c_; }
  __device__ bool next(int i, Unit& u) const { return at((long)i * G + c, u); }
  __device__ bool at(long L, Unit& u) const {
    if (L >= nwg) return false;
    int wgid = (int)L; { const int q = nwg / NXCD, r = nwg % NXCD, xcd = wgid % NXCD, off = wgid / NXCD; wgid = (xcd < r ? xcd * (q + 1) : r * (q + 1) + (xcd - r) * q) + off; }
    const int nig = WGM * nN, gid = wgid / nig, fm = gid * WGM, gsz = (nM - fm) < WGM ? (nM - fm) : WGM;
    u.pm = fm + ((wgid % nig) % gsz); u.pn = (wgid % nig) / gsz; return true;
  }
  __device__ __forceinline__ void a_ready(const Unit&) const {}
  __device__ __forceinline__ void done(const Unit&) const {}
};

template <class Epi, class Sched, bool ALIGN_EPI = true, bool SP2 = true>
__device__ __forceinline__ void gemm_phase(LAS unsigned char* lds, const Gemm g, const Sched& S, const Epi& E) {
  int tid = threadIdx.x; asm volatile("" : "+v"(tid));
  const int wid = __builtin_amdgcn_readfirstlane(tid >> 6), lane = tid & 63, wr = wid >> 2, wc = wid & 3, fr = lane & 15, fq = lane >> 4;
  const int K = g.K, nt = K / BK;
  unsigned voffA[2], voffB[2];
#pragma unroll
  for (int i = 0; i < 2; ++i) { int R, C; stage_rc(tid * 16 + i * 8192, R, C); const int Rb = Epi::PERM ? ((R & ~31) + perm32(R & 31)) : R;
    voffA[i] = (unsigned)(R * g.lda + C) * 2u; voffB[i] = (unsigned)(Rb * g.ldb + C) * 2u; }
  const size_t kstep = (size_t)(BK * 2);
  const size_t hA = (size_t)HALF * g.lda * 2, hB = (size_t)HALF * g.ldb * 2;
  const size_t tA = 2 * hA, tB = 2 * hB;
  const unsigned ldsw = (unsigned)wid * 1024u;
  const int aoff = lds_byte(wr * 64 + fr, fq * 8), boff = lds_byte(wc * 32 + fr, fq * 8);
#define PG8_SA(b, h) (((b) * 2 + (h)) * HTB)
#define PG8_SB(b, h) ((4 + (b) * 2 + (h)) * HTB)
#define PG8_STAGE(bufoff, gbase, voff) do { _Pragma("unroll") for (int _i = 0; _i < 2; ++_i) \
    __builtin_amdgcn_global_load_lds((const unsigned*)((const char*)(gbase) + (voff)[_i]), (LAS unsigned*)(lds + (bufoff) + ldsw + _i * 8192), 16, 0, 0); } while (0)
#define PG8_LDA(dst, b, h) do { _Pragma("unroll") for (int m = 0; m < 4; ++m) _Pragma("unroll") for (int k = 0; k < 2; ++k) dst[m][k] = *(const LAS bf16x8*)(lds + PG8_SA(b, h) + aoff + m * 2048 + k * 1024); } while (0)
#define PG8_LDB(dst, b, h) do { _Pragma("unroll") for (int n = 0; n < 2; ++n) _Pragma("unroll") for (int k = 0; k < 2; ++k) dst[n][k] = *(const LAS bf16x8*)(lds + PG8_SB(b, h) + boff + n * 2048 + k * 1024); } while (0)
#define PG8_MMA(ai, bj, At, Bt) do { __builtin_amdgcn_s_setprio(1); _Pragma("unroll") for (int m = 0; m < 4; ++m) _Pragma("unroll") for (int n = 0; n < 2; ++n) _Pragma("unroll") for (int k = 0; k < 2; ++k) \
    acc[ai][bj][m][n] = __builtin_amdgcn_mfma_f32_16x16x32_bf16(Bt[n][k], At[m][k], acc[ai][bj][m][n], 0, 0, 0); __builtin_amdgcn_s_setprio(0); } while (0)
#define PG8_WAIT_V(n) asm volatile("s_waitcnt vmcnt(" #n ")" ::: "memory")
#define PG8_WAIT_L(n) asm volatile("s_waitcnt lgkmcnt(" #n ")" ::: "memory")
#define PG8_BAR __builtin_amdgcn_s_barrier()
#define PG8_SCHED __builtin_amdgcn_sched_barrier(0)
  Unit cur, nxt; int ui = 0;
  if (!S.next(0, cur)) return;
  f32x4 acc[2][2][4][2];
#pragma unroll
  for (int a = 0; a < 2; ++a)
#pragma unroll
    for (int b = 0; b < 2; ++b)
#pragma unroll
      for (int m = 0; m < 4; ++m)
#pragma unroll
        for (int n = 0; n < 2; ++n) acc[a][b][m][n] = (f32x4){0.f, 0.f, 0.f, 0.f};
  bf16x8 At[4][2], B0[2][2], B1[2][2];
  const char* cA = (const char*)g.A + (size_t)cur.pm * tA; const char* cB = (const char*)g.Bt + (size_t)cur.pn * tB;
  S.a_ready(cur);
  if constexpr (SP2) {
    PG8_STAGE(PG8_SB(0, 0), cB, voffB); PG8_STAGE(PG8_SB(0, 1), cB + hB, voffB); PG8_STAGE(PG8_SA(0, 0), cA, voffA); PG8_STAGE(PG8_SA(0, 1), cA + hA, voffA);
    if (wr == 1) PG8_BAR;
    PG8_WAIT_V(2); PG8_BAR;
    PG8_STAGE(PG8_SB(1, 0), cB + kstep, voffB); PG8_STAGE(PG8_SA(1, 0), cA + kstep, voffA); PG8_STAGE(PG8_SB(1, 1), cB + hB + kstep, voffB);
    PG8_WAIT_V(6); PG8_BAR;
  } else {
    PG8_STAGE(PG8_SB(0, 0), cB, voffB); PG8_STAGE(PG8_SA(0, 0), cA, voffA); PG8_STAGE(PG8_SB(0, 1), cB + hB, voffB); PG8_STAGE(PG8_SA(0, 1), cA + hA, voffA);
    if (wr == 1) PG8_BAR;
    PG8_WAIT_V(4); PG8_BAR;
    PG8_STAGE(PG8_SB(1, 0), cB + kstep, voffB); PG8_STAGE(PG8_SA(1, 0), cA + kstep, voffA); PG8_STAGE(PG8_SB(1, 1), cB + hB + kstep, voffB);
    PG8_WAIT_V(6); PG8_BAR;
  }
  for (;;) {
    const bool has_next = S.next(ui + 1, nxt);
    const char* nA = has_next ? (const char*)g.A + (size_t)nxt.pm * tA : cA; const char* nB = has_next ? (const char*)g.Bt + (size_t)nxt.pn * tB : cB;
#pragma unroll 1
    for (int t = 0; t < nt; t += 2) {
      const bool last = (t == nt - 2);
      const char* a1 = cA + (size_t)(t + 1) * kstep;
      const char* a2 = last ? nA : cA + (size_t)(t + 2) * kstep; const char* b2 = last ? nB : cB + (size_t)(t + 2) * kstep;
      const char* a3 = a2 + kstep; const char* b3 = b2 + kstep;
      if (last && has_next) S.a_ready(nxt);
      if constexpr (SP2) {
        PG8_LDB(B0, 0, 0); PG8_LDB(B1, 0, 1); PG8_SCHED; PG8_LDA(At, 0, 0); PG8_STAGE(PG8_SA(1, 1), a1 + hA, voffA);
        PG8_WAIT_V(8); PG8_WAIT_L(0); PG8_BAR; PG8_MMA(0, 0, At, B0); PG8_MMA(0, 1, At, B1); PG8_BAR; PG8_SCHED;
        PG8_LDA(At, 0, 1); PG8_STAGE(PG8_SB(0, 0), b2, voffB); PG8_STAGE(PG8_SB(0, 1), b2 + hB, voffB); PG8_STAGE(PG8_SA(0, 0), a2, voffA);
        PG8_WAIT_V(8); PG8_WAIT_L(0); PG8_BAR; PG8_MMA(1, 0, At, B0); PG8_MMA(1, 1, At, B1); PG8_BAR; PG8_SCHED;
        PG8_LDB(B0, 1, 0); PG8_LDB(B1, 1, 1); PG8_SCHED; PG8_LDA(At, 1, 0); PG8_STAGE(PG8_SA(0, 1), a2 + hA, voffA);
        PG8_WAIT_V(8); PG8_WAIT_L(0); PG8_BAR; PG8_MMA(0, 0, At, B0); PG8_MMA(0, 1, At, B1); PG8_BAR; PG8_SCHED;
        PG8_LDA(At, 1, 1); PG8_STAGE(PG8_SB(1, 0), b3, voffB); PG8_STAGE(PG8_SB(1, 1), b3 + hB, voffB); PG8_STAGE(PG8_SA(1, 0), a3, voffA);
        PG8_WAIT_V(8); PG8_WAIT_L(0); PG8_BAR; PG8_MMA(1, 0, At, B0); PG8_MMA(1, 1, At, B1); PG8_BAR; PG8_SCHED;
      } else {
        PG8_LDB(B0, 0, 0); PG8_SCHED; PG8_LDA(At, 0, 0); PG8_STAGE(PG8_SA(1, 1), a1 + hA, voffA);
        PG8_WAIT_L(8); PG8_BAR; PG8_WAIT_L(0); PG8_MMA(0, 0, At, B0); PG8_BAR; PG8_SCHED;
        PG8_LDB(B1, 0, 1); PG8_STAGE(PG8_SB(0, 0), b2, voffB);
        PG8_BAR; PG8_WAIT_L(0); PG8_MMA(0, 1, At, B1); PG8_BAR;
        PG8_LDA(At, 0, 1); PG8_STAGE(PG8_SA(0, 0), a2, voffA);
        PG8_BAR; PG8_WAIT_L(0); PG8_MMA(1, 0, At, B0); PG8_BAR; PG8_SCHED;
        PG8_STAGE(PG8_SB(0, 1), b2 + hB, voffB);
        PG8_WAIT_V(6); PG8_BAR; PG8_MMA(1, 1, At, B1); PG8_BAR;
        PG8_LDB(B0, 1, 0); PG8_SCHED; PG8_LDA(At, 1, 0); PG8_STAGE(PG8_SA(0, 1), a2 + hA, voffA);
        PG8_WAIT_L(8); PG8_BAR; PG8_WAIT_L(0); PG8_MMA(0, 0, At, B0); PG8_BAR; PG8_SCHED;
        PG8_LDB(B1, 1, 1); PG8_STAGE(PG8_SB(1, 0), b3, voffB);
        PG8_BAR; PG8_WAIT_L(0); PG8_MMA(0, 1, At, B1); PG8_BAR;
        PG8_LDA(At, 1, 1); PG8_STAGE(PG8_SA(1, 0), a3, voffA);
        PG8_BAR; PG8_WAIT_L(0); PG8_MMA(1, 0, At, B0); PG8_BAR; PG8_SCHED;
        PG8_STAGE(PG8_SB(1, 1), b3 + hB, voffB);
        PG8_WAIT_V(6); PG8_BAR; PG8_MMA(1, 1, At, B1); PG8_BAR;
      }
    }
    if constexpr (ALIGN_EPI) { if (wr == 0) PG8_BAR; }
    E(acc, cur, wr, wc, fr, fq); S.done(cur);
    if (!has_next) break;
#pragma unroll
    for (int a = 0; a < 2; ++a)
#pragma unroll
      for (int b = 0; b < 2; ++b)
#pragma unroll
        for (int m = 0; m < 4; ++m)
#pragma unroll
          for (int n = 0; n < 2; ++n) acc[a][b][m][n] = (f32x4){0.f, 0.f, 0.f, 0.f};
    cur = nxt; cA = nA; cB = nB; ++ui;
    if constexpr (ALIGN_EPI) { if (wr == 1) PG8_BAR; }
  }
  PG8_WAIT_V(0);
  if constexpr (!ALIGN_EPI) { if (wr == 0) PG8_BAR; }
  PG8_BAR;
#undef PG8_SA
#undef PG8_SB
#undef PG8_STAGE
#undef PG8_LDA
#undef PG8_LDB
#undef PG8_MMA
#undef PG8_WAIT_V
#undef PG8_WAIT_L
#undef PG8_BAR
#undef PG8_SCHED
}
}

constexpr int LC = 16, NCH16 = SS / LC, GROWS = 1280, A2K = 384;
static_assert(B * NCH16 <= GROWS && GROWS % 256 == 0, "ssm group rows");
__device__ __forceinline__ void ssm_tau(int t, int& b, int& tau0, int& tau1) {
  if (t < TL) { b = t / N; const int i = t % N; tau0 = CTX + i; tau1 = CTX + (N - 1 - i); }
  else { b = (t - TL) / CTX; const int i = (t - TL) % CTX; tau0 = i; tau1 = CTX - 1 - i; }
}
struct EpiProj {
  static constexpr bool PERM = false;
  bf16_t* O; int ldc; int rope_end; const float* ropeT; bf16_t* A2;
  __device__ __forceinline__ void operator()(const f32x4 (&acc)[2][2][4][2], const pg8::Unit& u, int wr, int wc, int fr, int fq) const {
    const int row0 = u.pm * 256 + wr * 64 + fr, colb = u.pn * 256 + wc * 32;
    const bool rope_cols = colb < rope_end;
#pragma unroll
    for (int ai = 0; ai < 2; ++ai)
#pragma unroll
      for (int m = 0; m < 4; ++m) {
        const int r = row0 + ai * 128 + m * 16;
        bf16_t* rowp = O + (size_t)r * ldc + colb + 4 * fq;
        f32x4 cs0 = {1.f, 0.f, 1.f, 0.f}, cs1 = {1.f, 0.f, 1.f, 0.f};
        const bool rp = rope_cols && (r < TL);
        if (rp) { const int i = r % N; const int pos = (wc & 1) ? (i % GRID_W) : (i / GRID_W);
          const f32x4* tp = (const f32x4*)(ropeT + (size_t)(pos * 16 + 4 * fq) * 2); cs0 = tp[0]; cs1 = tp[1]; }
#pragma unroll
        for (int bj = 0; bj < 2; ++bj) {
          const bool rpb = rp && (colb + bj * 128 < rope_end);
          f32x4 a1 = acc[ai][bj][m][0], a2 = acc[ai][bj][m][1];
          f32x4 o1 = a1, o2 = a2;
          if (rpb) {
            o1[0] = a1[0] * cs0[0] - a2[0] * cs0[1]; o2[0] = a2[0] * cs0[0] + a1[0] * cs0[1];
            o1[1] = a1[1] * cs0[2] - a2[1] * cs0[3]; o2[1] = a2[1] * cs0[2] + a1[1] * cs0[3];
            o1[2] = a1[2] * cs1[0] - a2[2] * cs1[1]; o2[2] = a2[2] * cs1[0] + a1[2] * cs1[1];
            o1[3] = a1[3] * cs1[2] - a2[3] * cs1[3]; o2[3] = a2[3] * cs1[2] + a1[3] * cs1[3];
          }
          u32x2 w1 = {cvt_pk_bf16(o1[0], o1[1]), cvt_pk_bf16(o1[2], o1[3])}, w2 = {cvt_pk_bf16(o2[0], o2[1]), cvt_pk_bf16(o2[2], o2[3])};
          *(u32x2*)(rowp + bj * 128) = w1; *(u32x2*)(rowp + bj * 128 + 16) = w2;
          if (A2 != nullptr && colb + bj * 128 >= A_UOFF) {
            int b, tau0, tau1; ssm_tau(r, b, tau0, tau1);
            const int g0 = (colb + bj * 128 - A_UOFF) / 16;
            bf16_t* d0 = A2 + (((size_t)g0 * GROWS + b * NCH16 + tau0 / LC) * A2K + (tau0 % LC) * 16 + 4 * fq);
            bf16_t* d1 = A2 + (((size_t)(SSM_G + g0) * GROWS + b * NCH16 + tau1 / LC) * A2K + (tau1 % LC) * 16 + 4 * fq);
            *(u32x2*)d0 = w1; *(u32x2*)(d0 + (size_t)GROWS * A2K) = w2; *(u32x2*)d1 = w1; *(u32x2*)(d1 + (size_t)GROWS * A2K) = w2;
          }
        }
      }
  }
};


struct ProjOrder1 {
  static constexpr int NM0 = TL / 256, NN = DIF_IN / 256, NQ = DIF_QK / 256, NU = NM0 * NN + (TC / 256) * (NN - NQ);
  pg8::StaticOrder S0; int G, c;
  __device__ __forceinline__ bool next(int i, pg8::Unit& u) const {
    const long L = (long)i * G + c;
    if (L < NM0 * NN) return S0.at(L, u);
    const int l2 = (int)(L - NM0 * NN); if (l2 >= (TC / 256) * (NN - NQ)) return false;
    u.pm = NM0 + l2 / (NN - NQ); u.pn = NQ + l2 % (NN - NQ); return true;
  }
  __device__ __forceinline__ void a_ready(const pg8::Unit&) const {}
  __device__ __forceinline__ void done(const pg8::Unit&) const {}
};
struct EpiF32Out {
  static constexpr bool PERM = false;
  float* C; int ldc;
  __device__ __forceinline__ void operator()(const f32x4 (&acc)[2][2][4][2], const pg8::Unit& u, int wr, int wc, int fr, int fq) const {
    const int row0 = u.pm * 256 + wr * 64 + fr, col0 = u.pn * 256 + wc * 32 + 4 * fq;
#pragma unroll
    for (int ai = 0; ai < 2; ++ai)
#pragma unroll
      for (int m = 0; m < 4; ++m) { float* rowp = C + (size_t)(row0 + ai * 128 + m * 16) * ldc + col0;
#pragma unroll
        for (int bj = 0; bj < 2; ++bj)
#pragma unroll
          for (int n = 0; n < 2; ++n) *(f32x4*)(rowp + bj * 128 + n * 16) = acc[ai][bj][m][n]; }
  }
};
struct EpiBf16Out {
  static constexpr bool PERM = true;
  bf16_t* O; int ldc; int NJ;
  __device__ __forceinline__ void operator()(const f32x4 (&acc)[2][2][4][2], const pg8::Unit& u, int wr, int wc, int fr, int fq) const {
    const int row0 = u.pm * 256 + wr * 64 + fr, col0 = (NJ ? (u.pn % NJ) : u.pn) * 256 + wc * 32 + 8 * fq;
#pragma unroll
    for (int ai = 0; ai < 2; ++ai)
#pragma unroll
      for (int m = 0; m < 4; ++m) { bf16_t* rowp = O + (size_t)(row0 + ai * 128 + m * 16) * ldc + col0;
#pragma unroll
        for (int bj = 0; bj < 2; ++bj) { const f32x4 v0 = acc[ai][bj][m][0], v1 = acc[ai][bj][m][1];
          u32x4 w; w.x = cvt_pk_bf16(v0[0], v0[1]); w.y = cvt_pk_bf16(v0[2], v0[3]); w.z = cvt_pk_bf16(v1[0], v1[1]); w.w = cvt_pk_bf16(v1[2], v1[3]);
          *(u32x4*)(rowp + bj * 128) = w; } }
  }
};
__device__ __forceinline__ float fast_sigmoid(float x) { return __builtin_amdgcn_rcpf(1.f + __builtin_amdgcn_exp2f(-1.4426950408889634f * x)); }
struct EpiGlu {
  static constexpr bool PERM = true;
  const bf16_t* Gs; const float* bias; bf16_t* O; int ldo, coloff;
  __device__ __forceinline__ void operator()(const f32x4 (&acc)[2][2][4][2], const pg8::Unit& u, int wr, int wc, int fr, int fq) const {
    const int row0 = u.pm * 256 + wr * 64 + fr, col0 = u.pn * 256 + wc * 32 + 8 * fq;
#pragma unroll
    for (int ai = 0; ai < 2; ++ai)
#pragma unroll
      for (int m = 0; m < 4; ++m) { const int r = row0 + ai * 128 + m * 16;
#pragma unroll
        for (int bj = 0; bj < 2; ++bj) { const int c = col0 + bj * 128;
          const u32x4 gv = *(const u32x4*)(Gs + (size_t)r * SSM_W + c);
          const f32x4 b0 = *(const f32x4*)(bias + c), b1 = *(const f32x4*)(bias + c + 4);
          const f32x4 v0 = acc[ai][bj][m][0] + b0, v1 = acc[ai][bj][m][1] + b1;
          float o[8];
#pragma unroll
          for (int j = 0; j < 4; ++j) { const unsigned gw_ = j < 2 ? (j == 0 ? gv.x : gv.y) : (j == 2 ? gv.z : gv.w);
            const float g0 = __builtin_bit_cast(float, gw_ << 16), g1 = __builtin_bit_cast(float, gw_ & 0xffff0000u);
            const float z0 = j < 2 ? v0[2 * j] : v1[2 * j - 4], z1 = j < 2 ? v0[2 * j + 1] : v1[2 * j - 3];
            o[2 * j] = g0 * fast_sigmoid(z0); o[2 * j + 1] = g1 * fast_sigmoid(z1); }
          u32x4 w; w.x = cvt_pk_bf16(o[0], o[1]); w.y = cvt_pk_bf16(o[2], o[3]); w.z = cvt_pk_bf16(o[4], o[5]); w.w = cvt_pk_bf16(o[6], o[7]);
          *(u32x4*)(O + (size_t)r * ldo + coloff + c) = w; } }
  }
};
struct EpiMoe1 {
  static constexpr bool PERM = true;
  bf16_t* HH; const float* gate;
  __device__ __forceinline__ void operator()(const f32x4 (&acc)[2][2][4][2], const pg8::Unit& u, int wr, int wc, int fr, int fq) const {
    const int row0 = u.pm * 256 + wr * 64 + fr, col0 = (u.pn & 1) * 128 + wc * 32 + 8 * fq;
#pragma unroll
    for (int ai = 0; ai < 2; ++ai)
#pragma unroll
      for (int m = 0; m < 4; ++m) { const int r = row0 + ai * 128 + m * 16; const float gt = gate[r];
        float o[8];
#pragma unroll
        for (int n = 0; n < 2; ++n)
#pragma unroll
          for (int j = 0; j < 4; ++j) { const float h1 = acc[ai][0][m][n][j], h3 = acc[ai][1][m][n][j]; o[4 * n + j] = h1 * fast_sigmoid(h1) * h3 * gt; }
        u32x4 w; w.x = cvt_pk_bf16(o[0], o[1]); w.y = cvt_pk_bf16(o[2], o[3]); w.z = cvt_pk_bf16(o[4], o[5]); w.w = cvt_pk_bf16(o[6], o[7]);
        *(u32x4*)(HH + (size_t)r * MOE_F + col0) = w; }
  }
};
struct MoeOrder {
  const int* meta; int NJ, G, c;
  __device__ __forceinline__ bool next(int i, pg8::Unit& u) const {
    const int nt = __builtin_amdgcn_readfirstlane(__hip_atomic_load(meta, __ATOMIC_RELAXED, __HIP_MEMORY_SCOPE_AGENT));
    const long L = (long)i * G + c; if (L >= (long)nt * NJ) return false;
    const int rt = (int)(L / NJ), jn = (int)(L % NJ);
    const int e = __builtin_amdgcn_readfirstlane(__hip_atomic_load(meta + 1 + rt, __ATOMIC_RELAXED, __HIP_MEMORY_SCOPE_AGENT));
    u.pm = rt; u.pn = e * NJ + jn; return true;
  }
  __device__ __forceinline__ void a_ready(const pg8::Unit&) const {}
  __device__ __forceinline__ void done(const pg8::Unit&) const {}
};


namespace att {
using f32x16 = __attribute__((ext_vector_type(16))) float;
using s16x4  = __attribute__((ext_vector_type(4))) short;
constexpr int KVBLK = 64;
constexpr float SCALE = 0.125f, THR = 8.f;
constexpr size_t SHM_V = KVBLK * 128 * 2, SHM_K = KVBLK * 128 * 2;
constexpr size_t SHM_WS = 2 * SHM_V + 2 * SHM_K;
#define KSWZ(row, colB) ((row) * 256 + ((colB) ^ (((row) & 7) << 4)))
#define SBAR() __builtin_amdgcn_sched_barrier(0)
__device__ __forceinline__ int crow(int r, int hi) { return (r & 3) + 8 * (r >> 2) + 4 * hi; }
__device__ __forceinline__ unsigned cvtpk(float lo, float hi) { unsigned r; asm volatile("v_cvt_pk_bf16_f32 %0, %1, %2" : "=v"(r) : "v"(lo), "v"(hi)); return r; }
__device__ __forceinline__ void partialSM(f32x16& p0, f32x16& p1, float& m_reg, float& mn, float& alpha) {
  constexpr float C = SCALE * 1.4426950408889634f;
  float pmax = p0[0];
#pragma unroll
  for (int r = 1; r < 16; ++r) pmax = fmaxf(pmax, p0[r]);
#pragma unroll
  for (int r = 0; r < 16; ++r) pmax = fmaxf(pmax, p1[r]);
  { auto rr = __builtin_amdgcn_permlane32_swap(__float_as_uint(pmax), __float_as_uint(pmax), false, false);
    pmax = fmaxf(__uint_as_float(rr[0]), __uint_as_float(rr[1])); }
  if (__builtin_expect(__all(pmax - m_reg <= THR / SCALE), 1)) { mn = m_reg; alpha = 1.f; }
  else { mn = fmaxf(m_reg, pmax); alpha = __builtin_amdgcn_exp2f((m_reg - mn) * C); m_reg = mn; }
  const float mnC = -mn * C;
#pragma unroll
  for (int r = 0; r < 16; ++r) p0[r] = fmaf(p0[r], C, mnC);
#pragma unroll
  for (int r = 0; r < 16; ++r) p1[r] = fmaf(p1[r], C, mnC);
#pragma unroll
  for (int r = 0; r < 16; ++r) p0[r] = __builtin_amdgcn_exp2f(p0[r]);
}
__device__ __forceinline__ void finishSM(f32x16& p0, f32x16& p1, float alpha, float& l_reg, bf16x8& pa0, bf16x8& pa1, bf16x8& pa2, bf16x8& pa3) {
#pragma unroll
  for (int r = 0; r < 16; ++r) p1[r] = __builtin_amdgcn_exp2f(p1[r]);
  float ps = 0;
#pragma unroll
  for (int r = 0; r < 16; ++r) ps += p0[r];
#pragma unroll
  for (int r = 0; r < 16; ++r) ps += p1[r];
  { auto rr = __builtin_amdgcn_permlane32_swap(__float_as_uint(ps), __float_as_uint(ps), false, false);
    ps = __uint_as_float(rr[0]) + __uint_as_float(rr[1]); }
  l_reg = l_reg * alpha + ps;
#define PK4(P, BASE, OUT) do { unsigned a0 = cvtpk(P[BASE + 0], P[BASE + 1]), a1 = cvtpk(P[BASE + 2], P[BASE + 3]);   \
    unsigned b0 = cvtpk(P[BASE + 4], P[BASE + 5]), b1 = cvtpk(P[BASE + 6], P[BASE + 7]);                              \
    auto r0 = __builtin_amdgcn_permlane32_swap(a0, b0, false, false); auto r1 = __builtin_amdgcn_permlane32_swap(a1, b1, false, false); \
    u32x4 w = {r0[0], r1[0], r0[1], r1[1]}; OUT = *reinterpret_cast<bf16x8*>(&w); } while (0)
  PK4(p0, 0, pa0); PK4(p0, 8, pa1); PK4(p1, 0, pa2); PK4(p1, 8, pa3);
#undef PK4
}
__device__ __forceinline__ void qkt(f32x16& p0, f32x16& p1, const char* Ks, const bf16x8* qr, int r32, int hi, int c) {
  p0 = f32x16{}; p1 = f32x16{};
#pragma unroll
  for (int d0 = 0; d0 < 4; ++d0) { const int cb = (c * 64 + d0 * 16 + hi * 8) * 2;
    const bf16x8 b0 = *reinterpret_cast<const bf16x8*>(Ks + KSWZ(r32, cb));
    const bf16x8 b1 = *reinterpret_cast<const bf16x8*>(Ks + KSWZ(32 + r32, cb));
    p0 = __builtin_amdgcn_mfma_f32_32x32x16_bf16(b0, qr[d0], p0, 0, 0, 0);
    p1 = __builtin_amdgcn_mfma_f32_32x32x16_bf16(b1, qr[d0], p1, 0, 0, 0); }
}
__device__ __forceinline__ int v_st(int k, int c) { const int kk = (k & ~0xC) | ((k & 4) << 1) | ((k & 8) >> 1); return ((kk >> 3) * 4 + (c >> 5)) * 512 + ((kk & 7) * 32 + (c & 31)) * 2; }
__device__ __forceinline__ int v_rd_base(int lane) { return ((lane & 3) << 3) | (((lane >> 2) & 3) << 6) | (((lane >> 4) & 1) << 5) | (((lane >> 5) & 1) << 8); }
constexpr int v_rd_off(int d0, int ks, int half) { return d0 * 512 + ks * 4096 + half * 2048; }
template <int OFF> __device__ __forceinline__ s16x4 tr_read(int vb) {
  s16x4 r; asm volatile("ds_read_b64_tr_b16 %0, %1 offset:%2" : "=&v"(r) : "v"(vb), "i"(OFF) : "memory"); return r;
}
template <int D0> __device__ __forceinline__ void pv_one(f32x16& od, int vb, bf16x8 pa0, bf16x8 pa1, bf16x8 pa2, bf16x8 pa3) {
  const s16x4 l0 = tr_read<v_rd_off(D0, 0, 0)>(vb), h0 = tr_read<v_rd_off(D0, 0, 1)>(vb), l1 = tr_read<v_rd_off(D0, 1, 0)>(vb), h1 = tr_read<v_rd_off(D0, 1, 1)>(vb);
  const s16x4 l2 = tr_read<v_rd_off(D0, 2, 0)>(vb), h2 = tr_read<v_rd_off(D0, 2, 1)>(vb), l3 = tr_read<v_rd_off(D0, 3, 0)>(vb), h3 = tr_read<v_rd_off(D0, 3, 1)>(vb);
  asm volatile("s_waitcnt lgkmcnt(0)" ::: "memory"); SBAR();
#define PK(L, H) (bf16x8){L[0], L[1], L[2], L[3], H[0], H[1], H[2], H[3]}
  od = __builtin_amdgcn_mfma_f32_32x32x16_bf16(pa0, PK(l0, h0), od, 0, 0, 0);
  od = __builtin_amdgcn_mfma_f32_32x32x16_bf16(pa1, PK(l1, h1), od, 0, 0, 0);
  od = __builtin_amdgcn_mfma_f32_32x32x16_bf16(pa2, PK(l2, h2), od, 0, 0, 0);
  od = __builtin_amdgcn_mfma_f32_32x32x16_bf16(pa3, PK(l3, h3), od, 0, 0, 0);
#undef PK
}
template <int NB> __device__ __forceinline__ void pv_blocks(f32x16* o, int vb, int vsel, bf16x8 pa0, bf16x8 pa1, bf16x8 pa2, bf16x8 pa3) {
  if constexpr (NB == 4) { pv_one<0>(o[0], vb, pa0, pa1, pa2, pa3); pv_one<1>(o[1], vb, pa0, pa1, pa2, pa3); pv_one<2>(o[2], vb, pa0, pa1, pa2, pa3); pv_one<3>(o[3], vb, pa0, pa1, pa2, pa3); }
  else { if (vsel == 0) { pv_one<0>(o[0], vb, pa0, pa1, pa2, pa3); pv_one<1>(o[1], vb, pa0, pa1, pa2, pa3); }
         else { pv_one<2>(o[0], vb, pa0, pa1, pa2, pa3); pv_one<3>(o[1], vb, pa0, pa1, pa2, pa3); } }
}
__device__ __forceinline__ void apply_mask(f32x16& p0, f32x16& p1, int mt, int i, int k0, int hi) {
  if (mt == 0) return;
#pragma unroll
  for (int r = 0; r < 16; ++r) { const int j0 = k0 + crow(r, hi), j1 = j0 + 32;
    const bool ok0 = (mt == 1) && (j0 - i <= SWA_WIN) && (i - j0 <= SWA_WIN), ok1 = (mt == 1) && (j1 - i <= SWA_WIN) && (i - j1 <= SWA_WIN);
    p0[r] = ok0 ? p0[r] : -1e30f; p1[r] = ok1 ? p1[r] : -1e30f; }
}

struct TileMap {
  int nl, tlo, bN, bC;
  __device__ __forceinline__ int row(int t) const { return t < nl ? bN + 64 * (tlo + t) : (t < nl + CTX / 64 ? bC + 64 * (t - nl) : bN + 64 * tlo); }
  __device__ __forceinline__ int mtype(int t) const { return t < nl ? 1 : (t < nl + CTX / 64 ? 0 : 2); }
  __device__ __forceinline__ int key0(int t) const { return 64 * (tlo + (t < nl ? t : 0)); }
};

template <int MODE>
__device__ __forceinline__ void attn_unit(const bf16_t* __restrict__ Pq, const bf16_t* __restrict__ Pk, const bf16_t* __restrict__ Pv, int LD, const TileMap tm, int NT,
                                          float m_init, float l_init, int i0, LAS unsigned char* ldsb, f32x16* o, float& l_out, int tid) {
  constexpr int NB = MODE == 0 ? 4 : 2;
  const int wid = tid >> 6, lane = tid & 63, r32 = lane & 31, hi = lane >> 5, c = wid >> 2;
  char* lds = (char*)ldsb;
  char* V_lds = lds; char* K_lds = lds + 2 * SHM_V;
  float* ws = (float*)(lds + SHM_WS) + wid * 64; float* al_l = ws + 32;
  float m_reg = m_init, l_reg = l_init; bf16x8 qr[4];
#pragma unroll
  for (int d = 0; d < NB; ++d) o[d] = f32x16{};
  const bf16_t* Qw = Pq + (size_t)r32 * LD + hi * 8;
#pragma unroll
  for (int d0 = 0; d0 < 4; ++d0) qr[d0] = *reinterpret_cast<const bf16x8*>(Qw + d0 * 16);
  const int sr = tid >> 4, sc = (tid & 15) * 8, vst0 = v_st(sr, sc), vst1 = v_st(32 + sr, sc);
  const int vb0 = (int)(uintptr_t)V_lds + v_rd_base(lane);
  struct { bf16x8 vs0, vs1, ks0, ks1; } sr_[2];
#define SLOAD(i, t) do { const size_t rb_ = (size_t)tm.row(t); \
    sr_[i].vs0 = *reinterpret_cast<const bf16x8*>(Pv + (rb_ + sr) * LD + sc); sr_[i].vs1 = *reinterpret_cast<const bf16x8*>(Pv + (rb_ + 32 + sr) * LD + sc); \
    sr_[i].ks0 = *reinterpret_cast<const bf16x8*>(Pk + (rb_ + sr) * LD + sc); sr_[i].ks1 = *reinterpret_cast<const bf16x8*>(Pk + (rb_ + 32 + sr) * LD + sc); } while (0)
#define SWRITE(b, i) do { *(bf16x8*)(V_lds + (b) * SHM_V + vst0) = sr_[i].vs0; *(bf16x8*)(V_lds + (b) * SHM_V + vst1) = sr_[i].vs1; const int kc = sc * 2; \
    *(bf16x8*)(K_lds + (b) * SHM_K + KSWZ(sr, kc)) = sr_[i].ks0; *(bf16x8*)(K_lds + (b) * SHM_K + KSWZ(32 + sr, kc)) = sr_[i].ks1; } while (0)
#define SWAIT() asm volatile("s_waitcnt vmcnt(4)" ::: "memory")
#define RESC(a) do { if (__any((a) < 1.f)) { if (hi == 0) al_l[r32] = (a); asm volatile("s_waitcnt lgkmcnt(0)" ::: "memory"); \
    _Pragma("unroll") for (int d = 0; d < NB; ++d) _Pragma("unroll") for (int r = 0; r < 16; ++r) o[d][r] *= al_l[crow(r, hi)]; } } while (0)
#define MASK(P0, P1, t) do { if constexpr (MODE == 1) apply_mask(P0, P1, tm.mtype(t), i0 + r32, tm.key0(t), hi); } while (0)
  f32x16 pA0, pA1, pB0, pB1; float mnA, mnB, alA, alB; bf16x8 pa0, pa1, pa2, pa3;
  constexpr int SE = 0, SO = 1;
  SLOAD(SE, 0); asm volatile("s_waitcnt vmcnt(0)" ::: "memory"); SWRITE(0, SE); __syncthreads();
  qkt(pA0, pA1, K_lds, qr, r32, hi, c); MASK(pA0, pA1, 0); partialSM(pA0, pA1, m_reg, mnA, alA);
  SLOAD(SO, 1); if (2 < NT) SLOAD(SE, 2);
  SWAIT(); SWRITE(1, SO); __syncthreads();
  for (int j = 1; j + 1 < NT; j += 2) {
    SBAR(); qkt(pB0, pB1, K_lds + SHM_K, qr, r32, hi, c);
    finishSM(pA0, pA1, alA, l_reg, pa0, pa1, pa2, pa3); SBAR();
    SLOAD(SO, j + 2); SBAR();
    pv_blocks<NB>(o, vb0, c, pa0, pa1, pa2, pa3); MASK(pB0, pB1, j); partialSM(pB0, pB1, m_reg, mnB, alB);
    __syncthreads(); SWAIT(); SWRITE(0, SE);
    RESC(alB); __syncthreads();
    SBAR(); qkt(pA0, pA1, K_lds, qr, r32, hi, c);
    finishSM(pB0, pB1, alB, l_reg, pa0, pa1, pa2, pa3); SBAR();
    if (j + 3 < NT) SLOAD(SE, j + 3);
    SBAR();
    pv_blocks<NB>(o, vb0 + (int)SHM_V, c, pa0, pa1, pa2, pa3); MASK(pA0, pA1, j + 1); partialSM(pA0, pA1, m_reg, mnA, alA);
    __syncthreads(); SWAIT(); SWRITE(1, SO);
    RESC(alA); __syncthreads();
  }
  SBAR(); qkt(pB0, pB1, K_lds + SHM_K, qr, r32, hi, c);
  finishSM(pA0, pA1, alA, l_reg, pa0, pa1, pa2, pa3); SBAR();
  pv_blocks<NB>(o, vb0, c, pa0, pa1, pa2, pa3); MASK(pB0, pB1, NT - 1); partialSM(pB0, pB1, m_reg, mnB, alB);
  __syncthreads(); RESC(alB);
  finishSM(pB0, pB1, alB, l_reg, pa0, pa1, pa2, pa3); SBAR();
  pv_blocks<NB>(o, vb0 + (int)SHM_V, c, pa0, pa1, pa2, pa3);
  l_out = l_reg;
  asm volatile("s_waitcnt vmcnt(0)" ::: "memory");
  __syncthreads();
#undef SLOAD
#undef SWRITE
#undef SWAIT
#undef RESC
#undef MASK
}

__device__ __forceinline__ void dif_phase(const Params& p, LAS unsigned char* ldsb, int G, int vcu, int tid) {
  const int wid = tid >> 6, lane = tid & 63, r32 = lane & 31, hi = lane >> 5, c = wid >> 2, rg = wid & 3;
  constexpr int NQB = N / 128, NU = B * DIF_H * NQB;
  const float lam = p.scal[0], oscale = p.scal[1];
  for (int L = vcu; L < NU; L += G) {
    const int qb = L % NQB, h = (L / NQB) % DIF_H, b = L / (NQB * DIF_H);
    const int t0 = b * N + qb * 128 + rg * 32;
    TileMap tm; tm.nl = N / 64; tm.tlo = 0; tm.bN = b * N; tm.bC = TL + b * CTX;
    f32x16 o[4]; float l_reg;
    attn_unit<0>(p.P + (size_t)t0 * DIF_IN + h * 128 + c * 64, p.P + DIF_QK + h * 128, p.P + 2 * DIF_QK + h * 128, DIF_IN, tm, (N + CTX) / 64,
                 -1e30f, 0.f, 0, ldsb, o, l_reg, tid);
    char* lds = (char*)ldsb;
    float* ws = (float*)(lds + SHM_WS) + wid * 64;
    float* xb = (float*)lds;
    if (hi == 0) ws[r32] = l_reg;
    asm volatile("s_waitcnt lgkmcnt(0)" ::: "memory");
    float rli[16];
#pragma unroll
    for (int r = 0; r < 16; ++r) rli[r] = __builtin_amdgcn_rcpf(ws[crow(r, hi)]);
    if (c == 1) {
#pragma unroll
      for (int d0 = 0; d0 < 4; ++d0)
#pragma unroll
        for (int r = 0; r < 16; ++r) xb[(rg * 32 + crow(r, hi)) * 128 + d0 * 32 + r32] = o[d0][r] * rli[r];
    }
    __syncthreads();
    if (c == 0) {
      float ss[16];
#pragma unroll
      for (int r = 0; r < 16; ++r) ss[r] = 0.f;
#pragma unroll
      for (int d0 = 0; d0 < 4; ++d0)
#pragma unroll
        for (int r = 0; r < 16; ++r) { const float v = o[d0][r] * rli[r] - lam * xb[(rg * 32 + crow(r, hi)) * 128 + d0 * 32 + r32]; o[d0][r] = v; ss[r] += v * v; }
#pragma unroll
      for (int r = 0; r < 16; ++r) {
#pragma unroll
        for (int sft = 1; sft < 32; sft <<= 1) ss[r] += __shfl_xor(ss[r], sft);
        ss[r] = oscale / sqrtf(ss[r] * (1.f / 128.f) + RMS_EPS); }
#pragma unroll
      for (int d0 = 0; d0 < 4; ++d0) { const float gsub = p.subln_g[d0 * 32 + r32];
#pragma unroll
        for (int r = 0; r < 16; ++r) p.Ymix[(size_t)(t0 + crow(r, hi)) * YW + h * 128 + d0 * 32 + r32] = f2bf(o[d0][r] * ss[r] * gsub); }
    }
    __syncthreads();
  }
}
__device__ __forceinline__ void swa_unit(const Params& p, LAS unsigned char* ldsb, int L, int tid) {
  const int wid = tid >> 6, lane = tid & 63, r32 = lane & 31, hi = lane >> 5;
  constexpr int NUL = TL / 32;
  const float sink_raw = p.sink[wid] * (1.0f / SCALE);
  TileMap tm; int t0, NT, i0;
  if (L < NUL) { const int b = L / (N / 32), qb = L % (N / 32); i0 = qb * 32; t0 = b * N + i0;
    const int lo = i0 - SWA_WIN < 0 ? 0 : i0 - SWA_WIN, hi_ = i0 + 31 + SWA_WIN > N - 1 ? N - 1 : i0 + 31 + SWA_WIN;
    tm.tlo = lo / 64; tm.nl = hi_ / 64 - tm.tlo + 1; tm.bN = b * N; tm.bC = TL + b * CTX; NT = (tm.nl + CTX / 64 + 1) & ~1;
  } else { const int Lc = L - NUL, b = Lc / (CTX / 32), qb = Lc % (CTX / 32); i0 = 0; t0 = TL + b * CTX + qb * 32;
    tm.tlo = 0; tm.nl = 0; tm.bN = b * N; tm.bC = TL + b * CTX; NT = CTX / 64; }
  f32x16 o[2]; float l_reg;
  attn_unit<1>(p.P + (size_t)t0 * AB_IN + wid * 64, p.P + A_KOFF, p.P + A_VOFF, AB_IN, tm, NT, sink_raw, 1.f, i0, ldsb, o, l_reg, tid);
  char* lds = (char*)ldsb;
  float* ws = (float*)(lds + SHM_WS) + wid * 64;
  if (hi == 0) ws[r32] = l_reg;
  asm volatile("s_waitcnt lgkmcnt(0)" ::: "memory");
#pragma unroll
  for (int r = 0; r < 16; ++r) { const float rl = __builtin_amdgcn_rcpf(ws[crow(r, hi)]);
#pragma unroll
    for (int d0 = 0; d0 < 2; ++d0) p.Ymix[(size_t)(t0 + crow(r, hi)) * YW + wid * 64 + d0 * 32 + r32] = f2bf(o[d0][r] * rl); }
  __syncthreads();
}
constexpr int SWA_UNITS = TL / 32 + TC / 32;
}


constexpr int N_TAB16A = 2 * SSM_G * SSM_P * 17;
__device__ __forceinline__ void st_tab16a(const Params& p, int idx) {
  const int k = idx % 17, q = idx / 17, dg = q / SSM_P;
  const double dt = exp((double)p.log_step[dg]), ar = p.a_re[q], ai = p.a_im[q], mag = exp(k * dt * ar);
  p.apow16[(size_t)idx * 2] = (float)(mag * cos(k * dt * ai)); p.apow16[(size_t)idx * 2 + 1] = (float)(mag * sin(k * dt * ai));
}
constexpr int N_TAB16B = 2 * SSM_G * 16 * 256;
__device__ __forceinline__ void st_tab16b(const Params& p, int idx) {
  const int ci = idx % 16, co = (idx / 16) % 16, lag = (idx / 256) % 16, dg = idx / 4096;
  float acc = 0.f;
  for (int pp = 0; pp < SSM_P; ++pp) { const int q = dg * SSM_P + pp;
    const float ar = p.apow16[((size_t)q * 17 + lag) * 2], ai = p.apow16[((size_t)q * 17 + lag) * 2 + 1];
    const float br = p.bbar[((size_t)q * 16 + ci) * 2], bi = p.bbar[((size_t)q * 16 + ci) * 2 + 1];
    const float cr = p.c_re[((size_t)dg * 16 + co) * SSM_P + pp], cim = p.c_im[((size_t)dg * 16 + co) * SSM_P + pp];
    acc += cr * (ar * br - ai * bi) - cim * (ar * bi + ai * br); }
  p.KT16[idx] = acc;
}
constexpr int N_BTY = 2 * SSM_G * 256 * A2K, N_BTE = 2 * SSM_G * 256 * 256;
__device__ __forceinline__ void st_tab16c(const Params& p, int idx) {
  if (idx < N_BTY) {
    const int k = idx % A2K, n = (idx / A2K) % 256, dg = idx / (A2K * 256); const int j = n / 16, co = n % 16;
    float v;
    if (k < 256) { const int j2 = k / 16, ci = k % 16; v = j2 <= j ? p.KT16[(((size_t)dg * 16 + (j - j2)) * 16 + co) * 16 + ci] : 0.f; }
    else { const int pp = (k - 256) % 64, im = (k - 256) / 64, q = dg * SSM_P + pp;
      const float ar = p.apow16[((size_t)q * 17 + j + 1) * 2], ai = p.apow16[((size_t)q * 17 + j + 1) * 2 + 1];
      const float cr = p.c_re[((size_t)dg * 16 + co) * SSM_P + pp], cim = p.c_im[((size_t)dg * 16 + co) * SSM_P + pp];
      v = im ? -(cr * ai + cim * ar) : (cr * ar - cim * ai); }
    p.BtY[idx] = f2bf(v); return; }
  idx -= N_BTY;
  const int k = idx % 256, n = (idx / 256) % 256, dg = idx / 65536; const int j = k / 16, ci = k % 16;
  float v = 0.f;
  if (n < 128) { const int pp = n % 64, im = n / 64, q = dg * SSM_P + pp;
    const float ar = p.apow16[((size_t)q * 17 + (15 - j)) * 2], ai = p.apow16[((size_t)q * 17 + (15 - j)) * 2 + 1];
    const float br = p.bbar[((size_t)q * 16 + ci) * 2], bi = p.bbar[((size_t)q * 16 + ci) * 2 + 1];
    v = im ? (ar * bi + ai * br) : (ar * br - ai * bi); }
  p.BtE[idx] = f2bf(v);
}
struct SsmOrder {
  int first, count, G, c;
  __device__ __forceinline__ bool next(int i, pg8::Unit& u) const { const int L = i * G + c; if (L >= count) return false; u.pm = first + L; u.pn = u.pm / 5; return true; }
  __device__ __forceinline__ void a_ready(const pg8::Unit&) const {}
  __device__ __forceinline__ void done(const pg8::Unit&) const {}
};
struct EpiE {
  static constexpr bool PERM = false;
  float* E;
  __device__ __forceinline__ void operator()(const f32x4 (&acc)[2][2][4][2], const pg8::Unit& u, int wr, int wc, int fr, int fq) const {
    const int row0 = u.pm * 256 + wr * 64 + fr, col0 = wc * 32 + 4 * fq;
#pragma unroll
    for (int ai = 0; ai < 2; ++ai)
#pragma unroll
      for (int m = 0; m < 4; ++m) { float* rowp = E + (size_t)(row0 + ai * 128 + m * 16) * 128 + col0;
#pragma unroll
        for (int n = 0; n < 2; ++n) *(f32x4*)(rowp + n * 16) = acc[ai][0][m][n]; }
  }
};
template <int DIR> struct EpiY {
  static constexpr bool PERM = false;
  float* Ypart; const bf16_t* P0; const float* dskip; bf16_t* Gs;
  __device__ __forceinline__ void operator()(const f32x4 (&acc)[2][2][4][2], const pg8::Unit& u, int wr, int wc, int fr, int fq) const {
    const int grp = u.pm / 5, g = grp % SSM_G, rg0 = (u.pm % 5) * 256 + wr * 64 + fr;
#pragma unroll
    for (int ai = 0; ai < 2; ++ai)
#pragma unroll
      for (int m = 0; m < 4; ++m) { const int rg = rg0 + ai * 128 + m * 16;
        if (rg < B * NCH16) { const int b = rg / NCH16, ch = rg % NCH16;
#pragma unroll
          for (int bj = 0; bj < 2; ++bj)
#pragma unroll
            for (int n = 0; n < 2; ++n) { const int j = 8 * bj + 2 * wc + n, tau = ch * LC + j;
              const int t = ssm_row(DIR, b, tau); const size_t o = (size_t)t * SSM_W + g * 16 + 4 * fq;
              if (DIR == 0) *(f32x4*)(Ypart + o) = acc[ai][bj][m][n];
              else { const f32x4 y0 = *(const f32x4*)(Ypart + o); const f32x4 dk = *(const f32x4*)(dskip + g * 16 + 4 * fq);
                const u32x2 uu = *(const u32x2*)(P0 + (size_t)t * AB_IN + A_UOFF + g * 16 + 4 * fq);
                f32x4 uv; uv.x = __builtin_bit_cast(float, uu.x << 16); uv.y = __builtin_bit_cast(float, uu.x & 0xffff0000u); uv.z = __builtin_bit_cast(float, uu.y << 16); uv.w = __builtin_bit_cast(float, uu.y & 0xffff0000u);
                const f32x4 y = acc[ai][bj][m][n] + y0 + dk * uv; float gl[4];
#pragma unroll
                for (int q = 0; q < 4; ++q) { const float x = y[q], w = 0.7978845608028654f * (x + 0.044715f * x * x * x); gl[q] = x * fast_sigmoid(2.f * w); }
                const u32x2 wv = {cvt_pk_bf16(gl[0], gl[1]), cvt_pk_bf16(gl[2], gl[3])};
                *(u32x2*)(Gs + o) = wv; } } } }
  }
};
__device__ __forceinline__ void ssm_carry_phase(const Params& p, int bx, int G, int tid) {
  for (int idx = bx * NTHR + tid; idx < 2 * SSM_G * B * SSM_P; idx += G * NTHR) {
    const int pp = idx % SSM_P, b = (idx / SSM_P) % B, dg = idx / (SSM_P * B), q = dg * SSM_P + pp;
    const float ar = p.apow16[((size_t)q * 17 + 16) * 2], ai = p.apow16[((size_t)q * 17 + 16) * 2 + 1];
    float sr = 0.f, si = 0.f;
    const size_t row0 = (size_t)dg * GROWS + (size_t)b * NCH16;
#pragma unroll 8
    for (int ch = 0; ch < NCH16; ++ch) { const size_t row = row0 + ch;
      p.A2[row * A2K + 256 + pp] = f2bf(sr); p.A2[row * A2K + 320 + pp] = f2bf(si);
      const float er = p.E16[row * 128 + pp], ei = p.E16[row * 128 + 64 + pp];
      const float nr = ar * sr - ai * si + er, ni = ar * si + ai * sr + ei; sr = nr; si = ni; }
  }
}

#define XB_TMO      128
#define XB_XCNT(j)  (256  + 64 * (j))
#define XB_XSUB(j)  (1280 + 64 * (j))
#define XB_XGEN(j)  (2304 + 64 * (j))
#define XB_TOP      3328
#define XB_TOPGEN   3392
#define XCD_BAR_WORDS 3456
#define XB_SPIN_CAP (1u << 22)
constexpr int CW_BAR = 4096;
__device__ __forceinline__ unsigned xb_ld(unsigned* p)              { return __hip_atomic_load(p, __ATOMIC_RELAXED, __HIP_MEMORY_SCOPE_AGENT); }
__device__ __forceinline__ unsigned xb_add(unsigned* p, unsigned v) { return __hip_atomic_fetch_add(p, v, __ATOMIC_RELAXED, __HIP_MEMORY_SCOPE_AGENT); }
__device__ __forceinline__ unsigned xb_xcc_id() { return (unsigned)__builtin_amdgcn_s_getreg((3 << 11) | 20) & 0xFu; }
#define XB_SPIN(cond, bar) do { unsigned _sp = 0; while (cond) { __builtin_amdgcn_s_sleep(1); \
    if ((++_sp & 255u) == 0u) { if (xb_ld(&(bar)[XB_TMO])) break; if (_sp > XB_SPIN_CAP) { atomicAdd(&(bar)[XB_TMO], 1u); break; } } } } while (0)
struct XcdBarrier { unsigned* bar; unsigned x; volatile LAS unsigned* st; };
__device__ __forceinline__ XcdBarrier xcd_barrier_post(unsigned* bar, volatile LAS unsigned* st) {
  XcdBarrier b; b.bar = bar; b.x = xb_xcc_id(); b.st = st;
  if (threadIdx.x == 0) (void)xb_add(&bar[XB_XCNT(b.x)], 1u);
  return b;
}
__device__ __forceinline__ void xcd_barrier_complete(unsigned* bar, unsigned x, unsigned& nloc, unsigned& nx) {
  const unsigned G = gridDim.x * gridDim.y * gridDim.z;
  unsigned sum, cnt, mine, sp = 0u;
  for (;;) {
    sum = 0u; cnt = 0u; mine = 0u;
#pragma unroll
    for (unsigned j = 0; j < 16; ++j) { const unsigned c = xb_ld(&bar[XB_XCNT(j)]); sum += c; cnt += (c > 0u) ? 1u : 0u; mine = (j == x) ? c : mine; }
    if (sum == G) break;
    __builtin_amdgcn_s_sleep(1);
    if ((++sp & 255u) == 0u) { if (xb_ld(&bar[XB_TMO])) break; if (sp > XB_SPIN_CAP) { atomicAdd(&bar[XB_TMO], 1u); break; } }
  }
  nloc = mine > 0u ? mine : 1u; nx = cnt > 0u ? cnt : 1u;
}
__device__ __forceinline__ void xcd_barrier(const XcdBarrier& b) {
  asm volatile("s_waitcnt vmcnt(0)" ::: "memory");
  __syncthreads();
  if (threadIdx.x == 0) {
    unsigned* bar = b.bar;
    __builtin_amdgcn_s_waitcnt(0);
    unsigned nloc = b.st[0], nx = b.st[1];
    if (nloc == 0u) { xcd_barrier_complete(bar, b.x, nloc, nx); b.st[0] = nloc; b.st[1] = nx; }
    const unsigned old = xb_add(&bar[XB_XSUB(b.x)], 1u);
    const unsigned gen = old / nloc;
    if (old + 1u == (gen + 1u) * nloc) {
      __builtin_amdgcn_fence(__ATOMIC_RELEASE, "agent");
      asm volatile("s_waitcnt vmcnt(0)" ::: "memory");
      const unsigned og = xb_add(&bar[XB_TOP], 1u);
      const unsigned tg = og / nx;
      if (og + 1u == (tg + 1u) * nx) xb_add(&bar[XB_TOPGEN], 1u);
      else XB_SPIN(xb_ld(&bar[XB_TOPGEN]) == tg, bar);
      __builtin_amdgcn_fence(__ATOMIC_ACQUIRE, "agent");
      xb_add(&bar[XB_XGEN(b.x)], 1u);
      asm volatile("s_waitcnt vmcnt(0)" ::: "memory");
    } else {
      XB_SPIN(xb_ld(&bar[XB_XGEN(b.x)]) == gen, bar);
      __builtin_amdgcn_fence(__ATOMIC_ACQUIRE, "agent");
      asm volatile("s_waitcnt vmcnt(0)" ::: "memory");
    }
  }
  __syncthreads();
}

__device__ __forceinline__ unsigned pk2(float lo, float hi) { return (unsigned)f2bf(lo) | ((unsigned)f2bf(hi) << 16); }
__device__ __forceinline__ void transpose_item(const float* W, int K, int N, bf16_t* WT, int k0, int n0, int dst_row0, LAS float* scr, int lane) {
#pragma unroll 8
  for (int i = 0; i < 32; ++i) { const int kk = 2 * i + (lane >> 5); scr[kk * 33 + (lane & 31)] = W[(size_t)(k0 + kk) * N + n0 + (lane & 31)]; }
  LDS_WAIT(); asm volatile("" ::: "memory");
  const int c = lane & 7;
#pragma unroll
  for (int j = 0; j < 4; ++j) { const int n = (lane >> 3) + 8 * j; const LAS float* s = scr + (8 * c) * 33 + n;
    u32x4 o; o.x = pk2(s[0 * 33], s[1 * 33]); o.y = pk2(s[2 * 33], s[3 * 33]); o.z = pk2(s[4 * 33], s[5 * 33]); o.w = pk2(s[6 * 33], s[7 * 33]);
    *(u32x4*)(WT + (size_t)(dst_row0 + n) * K + k0 + 8 * c) = o; }
  LDS_WAIT(); asm volatile("" ::: "memory");
}
__device__ __forceinline__ void transpose_matrix(const float* W, int K, int N, bf16_t* WT, LAS float* scr, int gw, int ngw, int lane) {
  const int nblk = N / 32, items = (K / 64) * nblk;
  for (int it = gw; it < items; it += ngw) { const int kb = it / nblk, nb = it % nblk; transpose_item(W, K, N, WT, 64 * kb, 32 * nb, 32 * nb, scr, lane); }
}
__device__ __forceinline__ void mod_row_to_bf16(const float* xr, const float* sc, const float* sh, bf16_t* orow, int lane) {
  const f32x4* x4 = (const f32x4*)xr + lane; const f32x4* c4 = (const f32x4*)sc + lane; const f32x4* h4 = (const f32x4*)sh + lane;
  unsigned long long* o8 = (unsigned long long*)orow + lane;
#pragma unroll
  for (int j = 0; j < 4; ++j) { const f32x4 v = x4[64 * j], c = c4[64 * j], h = h4[64 * j];
    const float a = v.x * (1.f + c.x) + h.x, b = v.y * (1.f + c.y) + h.y, cc = v.z * (1.f + c.z) + h.z, d = v.w * (1.f + c.w) + h.w;
    o8[64 * j] = (unsigned long long)pk2(a, b) | ((unsigned long long)pk2(cc, d) << 32); }
}


__device__ __forceinline__ float wave_sum(float v) {
#pragma unroll
  for (int o = 1; o < 64; o <<= 1) v += __shfl_xor(v, o);
  return v;
}
constexpr int CW_CNT = 8192;
#define CNT_WORD(layer, e) (CW_CNT + 64 * (MOE_E * (layer) + (e)))
#define LD4(dst, ptr) do { const f32x4* p4_ = (const f32x4*)(ptr) + lane; _Pragma("unroll") for (int j = 0; j < 4; ++j) dst[j] = p4_[64 * j]; } while (0)
constexpr int RT_CNT = 0, RT_WG = 256, RT_WE = RT_WG + D * 8;
__device__ __forceinline__ int rt_slot(int k) { return ((k & 3) * 4 + (k >> 8)) * 64 + ((k >> 2) & 63); }
__device__ __forceinline__ float bflo(unsigned w) { return __builtin_bit_cast(float, w << 16); }
__device__ __forceinline__ float bfhi(unsigned w) { return __builtin_bit_cast(float, w & 0xffff0000u); }
__device__ __forceinline__ void ln1_phase(const Params& p, int layer, int T, LAS unsigned char* lds, int gw, int ngw, int vcu, int lane, int tid) {
  LAS int* cnt_l = (LAS int*)(lds + RT_CNT);
  if (tid < MOE_E) cnt_l[tid] = 0;
  { const float* wg = p.moe_wg + (size_t)layer * D * MOE_G; const float* we = p.moe_we + (size_t)layer * MOE_G * D * MOE_EPG;
    for (int k = tid; k < D; k += NTHR) { const f32x4 w = *(const f32x4*)(wg + (size_t)k * 4); u32x2 o = {pk2(w.x, w.y), pk2(w.z, w.w)}; *(LAS u32x2*)(lds + RT_WG + rt_slot(k) * 8) = o; }
    for (int i = tid; i < MOE_G * D; i += NTHR) { const int g = i / D, k = i % D; const f32x4 a = *(const f32x4*)(we + (size_t)i * 8), b = *(const f32x4*)(we + (size_t)i * 8 + 4);
      u32x4 o = {pk2(a.x, a.y), pk2(a.z, a.w), pk2(b.x, b.y), pk2(b.z, b.w)}; *(LAS u32x4*)(lds + RT_WE + (g * D + rt_slot(k)) * 16) = o; } }
  __syncthreads();
  const int rpw = (T + ngw - 1) / ngw, t0 = gw * rpw;
  f32x4 g1[4], lg[4], lb[4], sc[4], sh[4]; int cur_r = -1;
  LD4(lg, p.ln1_g + (size_t)layer * D); LD4(lb, p.ln1_b + (size_t)layer * D);
  const int tend = (t0 + rpw < T) ? t0 + rpw : T;
#define LDY(dst, tt) do { const u32x2* y2_ = (const u32x2*)((const bf16_t*)p.F + (size_t)(tt) * D) + lane; _Pragma("unroll") for (int j = 0; j < 4; ++j) dst[j] = y2_[64 * j]; } while (0)
  f32x4 xn[4]; u32x2 yn[4];
  if (t0 < tend) { LD4(xn, xrow(p, layer, t0)); LDY(yn, t0); }
  for (int t = t0; t < tend; ++t) {
    const int r = tok_r(t);
    if (r != cur_r) { cur_r = r; LD4(g1, modp(p, layer, r, 2)); LD4(sc, modp(p, layer, r, 4)); LD4(sh, modp(p, layer, r, 3)); }
    f32x4 v[4], y[4];
#pragma unroll
    for (int j = 0; j < 4; ++j) { v[j] = xn[j]; y[j] = (f32x4){bflo(yn[j].x), bfhi(yn[j].x), bflo(yn[j].y), bfhi(yn[j].y)}; }
    if (t + 1 < tend) { LD4(xn, xrow(p, layer, t + 1)); LDY(yn, t + 1); }
    float s = 0.f;
#pragma unroll
    for (int j = 0; j < 4; ++j) { v[j] = v[j] * ALPHA + g1[j] * y[j]; s += (v[j].x + v[j].y) + (v[j].z + v[j].w); }
    const float mean = wave_sum(s) * (1.f / D); float s2 = 0.f;
#pragma unroll
    for (int j = 0; j < 4; ++j) { v[j] = v[j] - mean; s2 += (v[j].x * v[j].x + v[j].y * v[j].y) + (v[j].z * v[j].z + v[j].w * v[j].w); }
    const float rstd = 1.f / sqrtf(wave_sum(s2) * (1.f / D) + LN_EPS);
    f32x4* o4 = (f32x4*)(p.X1 + (size_t)t * D) + lane;
#pragma unroll
    for (int j = 0; j < 4; ++j) { v[j] = v[j] * rstd * lg[j] + lb[j]; o4[64 * j] = v[j]; v[j] = v[j] * (sc[j] + 1.f) + sh[j]; }
    f32x4 gl = {0.f, 0.f, 0.f, 0.f};
#pragma unroll
    for (int j = 0; j < 4; ++j)
#pragma unroll
      for (int c = 0; c < 4; ++c) { const u32x2 w = *(const LAS u32x2*)(lds + RT_WG + ((4 * c + j) * 64 + lane) * 8); const float h = v[j][c];
        gl.x += h * bflo(w.x); gl.y += h * bfhi(w.x); gl.z += h * bflo(w.y); gl.w += h * bfhi(w.y); }
    float lgv[4];
#pragma unroll
    for (int g = 0; g < 4; ++g) lgv[g] = wave_sum(gl[g]) + p.moe_bg[layer * MOE_G + g];
    int gi = 0; float mx = lgv[0];
#pragma unroll
    for (int g = 1; g < 4; ++g) if (lgv[g] > mx) { mx = lgv[g]; gi = g; }
    float den = 0.f;
#pragma unroll
    for (int g = 0; g < 4; ++g) den += __expf(lgv[g] - mx);
    const float gp = 1.0f / den;
    gi = __builtin_amdgcn_readfirstlane(gi);
    f32x4 e0 = {0.f, 0.f, 0.f, 0.f}, e1 = {0.f, 0.f, 0.f, 0.f};
#pragma unroll
    for (int j = 0; j < 4; ++j)
#pragma unroll
      for (int c = 0; c < 4; ++c) { const u32x4 w = *(const LAS u32x4*)(lds + RT_WE + (gi * D + (4 * c + j) * 64 + lane) * 16); const float h = v[j][c];
        e0.x += h * bflo(w.x); e0.y += h * bfhi(w.x); e0.z += h * bflo(w.y); e0.w += h * bfhi(w.y);
        e1.x += h * bflo(w.z); e1.y += h * bfhi(w.z); e1.z += h * bflo(w.w); e1.w += h * bfhi(w.w); }
    float le[8];
#pragma unroll
    for (int e = 0; e < 4; ++e) { le[e] = wave_sum(e0[e]) + p.moe_be[(layer * MOE_G + gi) * MOE_EPG + e]; le[4 + e] = wave_sum(e1[e]) + p.moe_be[(layer * MOE_G + gi) * MOE_EPG + 4 + e]; }
    int i0 = 0; float v0 = le[0];
#pragma unroll
    for (int e = 1; e < 8; ++e) if (le[e] > v0) { v0 = le[e]; i0 = e; }
    int i1 = -1; float v1 = -3e38f;
#pragma unroll
    for (int e = 0; e < 8; ++e) if (e != i0 && le[e] > v1) { v1 = le[e]; i1 = e; }
    if (lane == 0) {
      const float ex = __expf(v1 - v0);
      const int ea = gi * MOE_EPG + i0, eb = gi * MOE_EPG + i1;
      const int pa = __hip_atomic_fetch_add(cnt_l + ea, 1, __ATOMIC_RELAXED, __HIP_MEMORY_SCOPE_WORKGROUP), pb = __hip_atomic_fetch_add(cnt_l + eb, 1, __ATOMIC_RELAXED, __HIP_MEMORY_SCOPE_WORKGROUP);
      float* rt = p.route + (size_t)t * 8;
      rt[0] = (float)ea; rt[1] = (float)eb; rt[2] = gp / (1.0f + ex); rt[3] = gp * ex / (1.0f + ex); rt[4] = (float)pa; rt[5] = (float)pb;
    }
  }
  __syncthreads();
  if (tid < MOE_E) { const int c = cnt_l[tid];
    const int base = c ? (int)__hip_atomic_fetch_add(p.ctl + CNT_WORD(layer, tid), (unsigned)c, __ATOMIC_RELAXED, __HIP_MEMORY_SCOPE_AGENT) : 0;
    p.wgbase[((size_t)layer * 1024 + vcu) * MOE_E + tid] = base; }
}
__device__ __forceinline__ void scatter_phase(const Params& p, int layer, int T, LAS unsigned char* lds, int gw, int ngw, int vcu, int lane, int tid) {
  LAS int* off = (LAS int*)lds;
  if (tid == 0) {
    int o = 0, ntile = 0;
    for (int e = 0; e < MOE_E; ++e) { const int c = (int)__hip_atomic_load(p.ctl + CNT_WORD(layer, e), __ATOMIC_RELAXED, __HIP_MEMORY_SCOPE_AGENT);
      off[e] = o + p.wgbase[((size_t)layer * 1024 + vcu) * MOE_E + e]; const int nt = (c + 255) >> 8;
      if (blockIdx.x == 0) for (int i = 0; i < nt; ++i) p.moe_meta[1 + ntile + i] = e;
      ntile += nt; o += nt * 256; }
    if (blockIdx.x == 0) p.moe_meta[0] = ntile;
  }
  __syncthreads();
  const int rpw = (T + ngw - 1) / ngw, t0 = gw * rpw;
  f32x4 sc[4], sh[4]; int cur_r = -1;
  const int tend = (t0 + rpw < T) ? t0 + rpw : T;
  f32x4 xn[4]; f32x4 rn0 = {0.f, 0.f, 0.f, 0.f}; f32x2 rn1 = {0.f, 0.f};
  if (t0 < tend) { LD4(xn, p.X1 + (size_t)t0 * D); rn0 = *(const f32x4*)(p.route + (size_t)t0 * 8); rn1 = *(const f32x2*)(p.route + (size_t)t0 * 8 + 4); }
  for (int t = t0; t < tend; ++t) {
    const int r = tok_r(t);
    if (r != cur_r) { cur_r = r; LD4(sc, modp(p, layer, r, 4)); LD4(sh, modp(p, layer, r, 3)); }
    const int ea = (int)rn0.x, eb = (int)rn0.y; const float wa = rn0.z, wb = rn0.w;
    const int sa = off[ea] + (int)rn1.x, sb = off[eb] + (int)rn1.y;
    f32x4 x[4];
#pragma unroll
    for (int j = 0; j < 4; ++j) x[j] = xn[j];
    if (t + 1 < tend) { LD4(xn, p.X1 + (size_t)(t + 1) * D); rn0 = *(const f32x4*)(p.route + (size_t)(t + 1) * 8); rn1 = *(const f32x2*)(p.route + (size_t)(t + 1) * 8 + 4); }
    unsigned long long* oa = (unsigned long long*)(p.Amoe + (size_t)sa * D) + lane; unsigned long long* ob = (unsigned long long*)(p.Amoe + (size_t)sb * D) + lane;
#pragma unroll
    for (int j = 0; j < 4; ++j) { const f32x4 h = x[j] * (sc[j] + 1.f) + sh[j];
      const unsigned long long w = (unsigned long long)pk2(h.x, h.y) | ((unsigned long long)pk2(h.z, h.w) << 32); oa[64 * j] = w; ob[64 * j] = w; }
    if (lane == 0) { p.gate[sa] = wa; p.gate[sb] = wb; p.tokslot[2 * t] = sa; p.tokslot[2 * t + 1] = sb; }
  }
}
__device__ __forceinline__ void ln2_phase(const Params& p, int layer, int T, int gw, int ngw, int lane) {
  const int rpw = (T + ngw - 1) / ngw, t0 = gw * rpw;
  f32x4 g2[4], lg[4], lb[4], sc[4], sh[4]; int cur_r = -1;
  LD4(lg, p.ln2_g + (size_t)layer * D); LD4(lb, p.ln2_b + (size_t)layer * D);
  const int tend = (t0 + rpw < T) ? t0 + rpw : T;
  const int myslot = (2 * t0 + lane < 2 * tend) ? p.tokslot[2 * t0 + lane] : 0;
  f32x4 xn[4]; u32x2 an[4], bn[4];
#define LDF2(tt) do { const int sa_ = __shfl(myslot, 2 * ((tt) - t0)), sb_ = __shfl(myslot, 2 * ((tt) - t0) + 1); \
    const u32x2* fa_ = (const u32x2*)(p.F2 + (size_t)sa_ * D) + lane; const u32x2* fb_ = (const u32x2*)(p.F2 + (size_t)sb_ * D) + lane; \
    _Pragma("unroll") for (int j = 0; j < 4; ++j) { an[j] = fa_[64 * j]; bn[j] = fb_[64 * j]; } LD4(xn, p.X1 + (size_t)(tt) * D); } while (0)
  if (t0 < tend) LDF2(t0);
  for (int t = t0; t < tend; ++t) {
    const int r = tok_r(t);
    if (r != cur_r) { cur_r = r; LD4(g2, modp(p, layer, r, 5)); if (layer + 1 < DEPTH) { LD4(sc, modp(p, layer + 1, r, 1)); LD4(sh, modp(p, layer + 1, r, 0)); } }
    f32x4 v[4]; u32x2 fa[4], fb[4];
#pragma unroll
    for (int j = 0; j < 4; ++j) { v[j] = xn[j]; fa[j] = an[j]; fb[j] = bn[j]; }
    if (t + 1 < tend) LDF2(t + 1);
    float s = 0.f;
#pragma unroll
    for (int j = 0; j < 4; ++j) { const u32x2 a = fa[j], b = fb[j];
      f32x4 f; f.x = bflo(a.x) + bflo(b.x); f.y = bfhi(a.x) + bfhi(b.x); f.z = bflo(a.y) + bflo(b.y); f.w = bfhi(a.y) + bfhi(b.y);
      v[j] = v[j] * ALPHA + g2[j] * f; s += (v[j].x + v[j].y) + (v[j].z + v[j].w); }
    const float mean = wave_sum(s) * (1.f / D); float s2 = 0.f;
#pragma unroll
    for (int j = 0; j < 4; ++j) { v[j] = v[j] - mean; s2 += (v[j].x * v[j].x + v[j].y * v[j].y) + (v[j].z * v[j].z + v[j].w * v[j].w); }
    const float rstd = 1.f / sqrtf(wave_sum(s2) * (1.f / D) + LN_EPS);
    if (layer == DEPTH - 1) {
      f32x4* o4 = (f32x4*)(p.out + (size_t)t * D) + lane;
#pragma unroll
      for (int j = 0; j < 4; ++j) o4[64 * j] = v[j] * rstd * lg[j] + lb[j];
    } else {
      f32x4* o4 = (f32x4*)(p.X + (size_t)t * D) + lane;
      unsigned long long* h8 = (unsigned long long*)(p.H + (size_t)t * D) + lane;
#pragma unroll
      for (int j = 0; j < 4; ++j) { const f32x4 o = v[j] * rstd * lg[j] + lb[j]; o4[64 * j] = o;
        const f32x4 h = o * (sc[j] + 1.f) + sh[j];
        h8[64 * j] = (unsigned long long)pk2(h.x, h.y) | ((unsigned long long)pk2(h.z, h.w) << 32); }
    }
  }
#undef LDF2
}
__device__ __forceinline__ void h0_phase(const Params& p, int gw, int ngw, int lane) {
  const int rpw = (TA + ngw - 1) / ngw, t0 = gw * rpw;
  f32x4 sc[4], sh[4]; int cur_r = -1;
  const int tend = (t0 + rpw < TA) ? t0 + rpw : TA;
  f32x4 xn[4], xm[4];
  if (t0 < tend) LD4(xn, xrow(p, 0, t0));
  if (t0 + 1 < tend) LD4(xm, xrow(p, 0, t0 + 1));
  for (int t = t0; t < tend; ++t) {
    const int r = tok_r(t);
    if (r != cur_r) { cur_r = r; LD4(sc, modp(p, 0, r, 1)); LD4(sh, modp(p, 0, r, 0)); }
    f32x4 x[4];
#pragma unroll
    for (int j = 0; j < 4; ++j) { x[j] = xn[j]; xn[j] = xm[j]; }
    if (t + 2 < tend) LD4(xm, xrow(p, 0, t + 2));
    unsigned long long* h8 = (unsigned long long*)(p.H + (size_t)t * D) + lane;
#pragma unroll
    for (int j = 0; j < 4; ++j) { const f32x4 h = x[j] * (sc[j] + 1.f) + sh[j]; h8[64 * j] = (unsigned long long)pk2(h.x, h.y) | ((unsigned long long)pk2(h.z, h.w) << 32); }
  }
}
__device__ __forceinline__ void moe_weight_transposes(const Params& p, int layer, LAS float* scr, int gw, int ngw, int lane) {
  constexpr int I13 = (D / 64) * (MOE_F / 32), I2 = (MOE_F / 64) * (D / 32);
  constexpr int NIT = MOE_E * (2 * I13 + I2);
  for (int it = gw; it < NIT; it += ngw) {
    const int e = it / (2 * I13 + I2); int r = it % (2 * I13 + I2);
    if (r < 2 * I13) { const int which = r / I13; r %= I13; const int kb = r / (MOE_F / 32), nb = r % (MOE_F / 32), n0 = 32 * nb;
      const float* W = (which ? p.moe_w3 : p.moe_w1) + ((size_t)layer * MOE_E + e) * D * MOE_F;
      transpose_item(W, D, MOE_F, p.W13t, 64 * kb, n0, e * 2 * MOE_F + (n0 / 128) * 256 + which * 128 + (n0 % 128), scr, lane);
    } else { r -= 2 * I13; const int kb = r / (D / 32), nb = r % (D / 32);
      const float* W = p.moe_w2 + ((size_t)layer * MOE_E + e) * MOE_F * D;
      transpose_item(W, MOE_F, D, p.W2t, 64 * kb, 32 * nb, e * D + 32 * nb, scr, lane); }
  }
}


__device__ __forceinline__ void mod_phase(const Params& p, LAS unsigned char* lds, int vcu, int G, int tid, int lane, int wave) {
  constexpr int NR = B + 1, RP = 12;
  LAS float* sT = (LAS float*)lds;
  LAS float* part = sT + D * RP;
  for (int i = tid; i < NR * D; i += NTHR) { const int r = i / D, k = i % D; const float c = r < B ? p.c[(size_t)r * D + k] : p.c_ctx[k]; sT[k * RP + r] = c / (1.0f + __expf(-c)); }
  __syncthreads();
  constexpr int NT_ = DEPTH * (6 * D / 64);
  for (int task = vcu; task < NT_; task += G) {
    const int l = task / (6 * D / 64), j = (task % (6 * D / 64)) * 64 + lane;
    const float* w = p.mod_w + (size_t)l * D * 6 * D + (size_t)(wave * 128) * 6 * D + j;
    float acc[NR];
#pragma unroll
    for (int r = 0; r < NR; ++r) acc[r] = 0.f;
#pragma unroll 1
    for (int k0 = 0; k0 < 128; k0 += 16) {
      float wv[16];
#pragma unroll
      for (int u = 0; u < 16; ++u) wv[u] = w[(size_t)(k0 + u) * 6 * D];
#pragma unroll
      for (int u = 0; u < 16; ++u) { const LAS float* sr = sT + (wave * 128 + k0 + u) * RP;
        const f32x4 s0 = *(const LAS f32x4*)sr, s1 = *(const LAS f32x4*)(sr + 4); const float s8 = sr[8];
        acc[0] += s0.x * wv[u]; acc[1] += s0.y * wv[u]; acc[2] += s0.z * wv[u]; acc[3] += s0.w * wv[u];
        acc[4] += s1.x * wv[u]; acc[5] += s1.y * wv[u]; acc[6] += s1.z * wv[u]; acc[7] += s1.w * wv[u]; acc[8] += s8 * wv[u]; }
    }
#pragma unroll
    for (int r = 0; r < NR; ++r) part[(wave * NR + r) * 64 + lane] = acc[r];
    __syncthreads();
    for (int i = tid; i < NR * 64; i += NTHR) { const int r = i / 64, c = i % 64; float v = p.mod_b[(size_t)l * 6 * D + (task % (6 * D / 64)) * 64 + c];
#pragma unroll
      for (int ww = 0; ww < 8; ++ww) v += part[(ww * NR + r) * 64 + c];
      p.modv[((size_t)(l * NR + r) * 6 * D) + (task % (6 * D / 64)) * 64 + c] = v; }
    __syncthreads();
  }
}

__global__ void __launch_bounds__(NTHR, 2) mega_kernel(Params p_by_value) {
  const Params& p = *(const Params*)__builtin_amdgcn_kernarg_segment_ptr();
  extern __shared__ __attribute__((aligned(16))) unsigned char lds_raw[];
  LAS unsigned char* lds = (LAS unsigned char*)lds_raw;
  volatile LAS unsigned* MISC = (volatile LAS unsigned*)(lds + MISC_OFF);
  for (int u = threadIdx.x; u < (LDS_BYTES - LDSCTL_OFF) / 4; u += NTHR) ((LAS unsigned*)(lds + LDSCTL_OFF))[u] = 0u;
  __syncthreads();
  XcdBarrier bar = xcd_barrier_post(p.ctl + CW_BAR, MISC + 8);
#define PH_VARS                                                                                                       \
  int tid = threadIdx.x; asm volatile("" : "+v"(tid));                                                                \
  int bx = blockIdx.x; asm volatile("" : "+s"(bx));                                                                   \
  const int lane = tid & 63, wave = __builtin_amdgcn_readfirstlane(tid >> 6), G = gridDim.x;                          \
  const int vcu = (G % 8 == 0) ? (bx % 8) * (G / 8) + bx / 8 : bx;                                                    \
  const int gw = vcu * NWAVES + wave, ngw = G * NWAVES;                                                               \
  LAS float* scr = (LAS float*)(lds + wave * 16384);                                                                  \
  (void)lane; (void)gw; (void)ngw; (void)scr; (void)vcu;
#define GRID_BAR() xcd_barrier(bar)
#define RUN_NAIVE(S, layer, cnt)                                                                                  \
  {                                                                                                               \
    const int n_ = (cnt);                                                                                         \
    PH_VARS                                                                                                       \
    for (int idx = bx * NTHR + tid; idx < n_; idx += G * NTHR) run_elem<S>(p, layer, idx);                        \
  }

  { PH_VARS mod_phase(p, lds, vcu, G, tid, lane, wave); }
  RUN_NAIVE(S_TABA, 0, N_TABA)
  { PH_VARS for (int idx = bx * NTHR + tid; idx < N_TAB16A; idx += G * NTHR) st_tab16a(p, idx); }
  { PH_VARS
  transpose_matrix(p.w_in_a, D, AB_IN, p.WinA_t, scr, gw, ngw, lane);
  transpose_matrix(p.dif_w_in, D, DIF_IN, p.DifIn_t, scr, gw, ngw, lane);
  transpose_matrix(p.w_out_a, AB_OUT, D, p.WoutA_t, scr, gw, ngw, lane);
  transpose_matrix(p.dif_w_out, DIF_VW, D, p.DifOut_t, scr, gw, ngw, lane);
  transpose_matrix(p.glu_w, SSM_W, SSM_W, p.Glu_t, scr, gw, ngw, lane); }
  GRID_BAR();
  { PH_VARS for (int idx = bx * NTHR + tid; idx < N_TAB16B; idx += G * NTHR) st_tab16b(p, idx); }
  { PH_VARS h0_phase(p, gw, ngw, lane); }
  GRID_BAR();
#define LAYER_BACK(layer, T, WOT_, KO_)                                                                                 \
  { PH_VARS                                                                    \
    pg8::Gemm g{p.Ymix, WOT_, YW, KO_, KO_};                                                                            \
    pg8::StaticOrder S; S.init(T, D, G, bx);                                                                            \
    EpiBf16Out E{(bf16_t*)p.F, D, 0};                                                                                   \
    pg8::gemm_phase<EpiBf16Out, pg8::StaticOrder>(lds, g, S, E);                                                        \
  }                                                                                                                     \
  GRID_BAR();                                                                                                           \
  { PH_VARS ln1_phase(p, layer, T, lds, gw, ngw, vcu, lane, tid); }                                                      \
  GRID_BAR();                                                                                                           \
  { PH_VARS scatter_phase(p, layer, T, lds, gw, ngw, vcu, lane, tid); }                                                 \
  GRID_BAR();                                                                                                           \
  { PH_VARS                                                             \
    pg8::Gemm g{p.Amoe, p.W13t, D, D, D};                                                                               \
    MoeOrder S{p.moe_meta, 2, G, vcu};                                                                                  \
    EpiMoe1 E{p.HHb, p.gate};                                                                                           \
    pg8::gemm_phase<EpiMoe1, MoeOrder>(lds, g, S, E);                                                                   \
  }                                                                                                                     \
  GRID_BAR();                                                                                                           \
  { PH_VARS                                                                                  \
    pg8::Gemm g{p.HHb, p.W2t, MOE_F, MOE_F, MOE_F};                                                                     \
    MoeOrder S{p.moe_meta, 4, G, vcu};                                                                                  \
    EpiBf16Out E{p.F2, D, 4};                                                                                           \
    pg8::gemm_phase<EpiBf16Out, MoeOrder>(lds, g, S, E);                                                                \
  }                                                                                                                     \
  GRID_BAR();                                                                                                           \
  { PH_VARS ln2_phase(p, layer, T, gw, ngw, lane); }
#define SWA_IF(cond, rank, first, cnt) { if (G == 256 && (cond) && (rank) < (cnt)) att::swa_unit(p, lds, (first) + (rank), tid); }

  { PH_VARS for (int idx = bx * NTHR + tid; idx < N_BTY + N_BTE; idx += G * NTHR) st_tab16c(p, idx); }
  { PH_VARS
    pg8::Gemm g{p.H, p.WinA_t, D, D, D};
    pg8::StaticOrder S; S.init(TA, AB_IN, G, bx);
    EpiProj E{p.P, AB_IN, SWA_QW + SWA_KVW, p.ropeT, p.A2};
    pg8::gemm_phase<EpiProj, pg8::StaticOrder>(lds, g, S, E);
    constexpr int NU_ = (TA / 256) * (AB_IN / 256);
    const int nlast = NU_ % G;
    if (nlast == 0) moe_weight_transposes(p, 0, scr, gw, ngw, lane);
    else if (bx >= nlast) moe_weight_transposes(p, 0, scr, (bx - nlast) * NWAVES + wave, (G - nlast) * NWAVES, lane);
  }
  GRID_BAR();
  { PH_VARS
    pg8::Gemm g{p.A2, p.BtE, A2K, 256, 256};
    SsmOrder S{0, 2 * SSM_G * 5, G, vcu};
    EpiE E{p.E16};
    pg8::gemm_phase<EpiE, SsmOrder>(lds, g, S, E);
    if (G != 256) { for (int L = vcu; L < att::SWA_UNITS; L += G) att::swa_unit(p, lds, L, tid); }
    SWA_IF(vcu >= 64, vcu - 64, 496, 80)
  }
  GRID_BAR();
  { PH_VARS ssm_carry_phase(p, bx, G, tid); SWA_IF(bx >= 64, bx - 64, 0, 192) }
  GRID_BAR();
  { PH_VARS
    pg8::Gemm g{p.A2, p.BtY, A2K, A2K, A2K};
    SsmOrder S{0, SSM_G * 5, G, vcu};
    EpiY<0> E{p.Ypart, p.P, p.ssm_d, p.Gs};
    pg8::gemm_phase<EpiY<0>, SsmOrder>(lds, g, S, E);
    SWA_IF(vcu >= 160, vcu - 160, 192, 96)
  }
  GRID_BAR();
  { PH_VARS
    pg8::Gemm g{p.A2, p.BtY, A2K, A2K, A2K};
    SsmOrder S{SSM_G * 5, SSM_G * 5, G, vcu};
    EpiY<1> E{p.Ypart, p.P, p.ssm_d, p.Gs};
    pg8::gemm_phase<EpiY<1>, SsmOrder>(lds, g, S, E);
    SWA_IF(vcu >= 160, vcu - 160, 288, 96)
  }
  GRID_BAR();
  { PH_VARS
    pg8::Gemm g{p.Gs, p.Glu_t, SSM_W, SSM_W, SSM_W};
    pg8::StaticOrder S; S.init(TA, SSM_W, G, bx);
    EpiGlu E{p.Gs, p.glu_b, p.Ymix, YW, SWA_QW};
    pg8::gemm_phase<EpiGlu, pg8::StaticOrder>(lds, g, S, E);
    SWA_IF(bx >= 144, bx - 144, 384, 112)
  }
  GRID_BAR();
  LAYER_BACK(0, TA, p.WoutA_t, AB_OUT)
  GRID_BAR();
  { PH_VARS
    pg8::Gemm g{p.H, p.DifIn_t, D, D, D};
    ProjOrder1 S; S.S0.init(TL, DIF_IN, G, bx); S.G = G; S.c = bx;
    EpiProj E{p.P, DIF_IN, 2 * DIF_QK, p.ropeT, nullptr};
    pg8::gemm_phase<EpiProj, ProjOrder1>(lds, g, S, E);
    constexpr int NU_ = ProjOrder1::NU;
    const int nlast = NU_ % G;
    if (nlast == 0) moe_weight_transposes(p, 1, scr, gw, ngw, lane);
    else if (bx >= nlast) moe_weight_transposes(p, 1, scr, (bx - nlast) * NWAVES + wave, (G - nlast) * NWAVES, lane);
  }
  GRID_BAR();
  { PH_VARS att::dif_phase(p, lds, G, vcu, tid); }
  GRID_BAR();
  LAYER_BACK(1, TL, p.DifOut_t, DIF_VW)
}

extern "C" void kernel_launch(void* const* d_in, const int* in_sizes, int n_in, void* d_out, int out_size, void* d_ws,
                              size_t ws_size, hipStream_t stream) {
  static int grid = 0;
  if (grid == 0) {
    if (ws_layout().total > ws_size || n_in != 37 || out_size != TL * D) { fprintf(stderr, "kernel_launch: bad sizes (ws need %zu have %zu)\n", ws_layout().total, ws_size); grid = -1; return; }
    int dev = 0, cus = 0;
    if (hipGetDevice(&dev) != hipSuccess || hipDeviceGetAttribute(&cus, hipDeviceAttributeMultiprocessorCount, dev) != hipSuccess) { grid = -1; return; }
    if (hipFuncSetAttribute((const void*)mega_kernel, hipFuncAttributeMaxDynamicSharedMemorySize, LDS_BYTES) != hipSuccess) { fprintf(stderr, "kernel_launch: hipFuncSetAttribute failed\n"); grid = -1; return; }
    grid = cus;
  }
  if (grid < 0) return;
  Params p{};
  fill_inputs(p, d_in);
  p.out = (float*)d_out;
  fill_ws(p, (char*)d_ws);
  if (hipMemsetAsync((char*)d_ws + ws_layout().ctl, 0, CTL_BYTES, stream) != hipSuccess) { fprintf(stderr, "kernel_launch: memset failed\n"); return; }
  hipLaunchKernelGGL(mega_kernel, dim3(grid), dim3(NTHR), LDS_BYTES, stream, p);
  const hipError_t le = hipPeekAtLastError();
  if (le != hipSuccess) fprintf(stderr, "kernel_launch: launch failed: %s\n", hipGetErrorName(le));
}
#endif
```

```cpp
#ifndef HOST_EMU
#include <hip/hip_runtime.h>
#define HD __host__ __device__ __forceinline__
#else
#define HD inline
#endif
#include <stdint.h>
#include <math.h>

#ifndef CFG_D
#define CFG_D 1024
#define CFG_B 8
#define CFG_N 2048
#define CFG_CTX 256
#endif

constexpr int D = CFG_D, B = CFG_B, N = CFG_N, CTX = CFG_CTX;
constexpr int DEPTH = 2, GRID_W = 64, HD_ = 64;
constexpr int TL = B * N, TC = B * CTX, TA = TL + TC;
constexpr int SWA_H = 8, SWA_QW = 512, SWA_KVW = 128, SWA_WIN = 128;
constexpr int SSM_W = D / 2, SSM_C = 16, SSM_G = SSM_W / 16, SSM_P = 64;
constexpr int AB_IN = SWA_QW + 2 * SWA_KVW + SSM_W;
constexpr int AB_OUT = SWA_QW + SSM_W;
constexpr int A_KOFF = SWA_QW, A_VOFF = SWA_QW + SWA_KVW, A_UOFF = SWA_QW + 2 * SWA_KVW;
constexpr int DIF_H = D / 128, DIF_QK = DIF_H * 128, DIF_VW = DIF_H * 128, DIF_IN = 2 * DIF_QK + DIF_VW;
constexpr int MOE_G = 4, MOE_EPG = 8, MOE_E = 32, MOE_F = D / 4;
constexpr int SL = 64;
constexpr int SS = CTX + N;
constexpr int NCH = SS / SL;
constexpr float LN_EPS = 1e-5f, RMS_EPS = 1e-5f;
constexpr float ALPHA = 1.41421356237309515f;
static_assert(CTX % SL == 0 && N % SL == 0, "chunking");
constexpr int YW = AB_OUT > D ? AB_OUT : D;

struct Params {
  const float *x, *c, *ctx, *c_ctx, *mod_w, *mod_b, *ln1_g, *ln1_b, *ln2_g, *ln2_b;
  const float *w_in_a, *w_out_a, *sink, *a_re, *a_im, *log_step, *b_re, *b_im, *c_re, *c_im, *ssm_d, *glu_w, *glu_b;
  const float *dif_w_in, *dif_w_out, *lq1, *lk1, *lq2, *lk2, *subln_g;
  const float *moe_wg, *moe_bg, *moe_we, *moe_be, *moe_w1, *moe_w3, *moe_w2;
  float* out;
  float *X, *X1, *F, *HH;
  uint16_t *P, *Ymix, *Gs;
  float *modv, *ropeT, *apow, *bbar, *KT, *E, *Sin, *route, *scal;
  uint16_t *H;
  uint16_t *WinA_t, *DifIn_t, *WoutA_t, *DifOut_t, *Glu_t, *W13t, *W2t;
  uint16_t *Amoe, *HHb, *F2;
  float* gate;
  int *wgbase;
  int *tokslot, *moe_meta;
  uint16_t *A2, *BtY, *BtE;
  float *apow16, *KT16, *E16, *Ypart;
  unsigned* ctl;
};

HD uint16_t f2bf(float f) {
  uint32_t u = __builtin_bit_cast(uint32_t, f);
  u += 0x7fffu + ((u >> 16) & 1u);
  return (uint16_t)(u >> 16);
}
HD float bf2f(uint16_t h) {
  uint32_t u = ((uint32_t)h) << 16;
  return __builtin_bit_cast(float, u);
}
HD float siluf(float x) { return x / (1.0f + expf(-x)); }
HD float sigmoidf_(float x) { return 1.0f / (1.0f + expf(-x)); }
HD float geluf_(float x) { return 0.5f * x * (1.0f + tanhf(0.7978845608028654f * (x + 0.044715f * x * x * x))); }

HD int tok_r(int t) { return t < TL ? t / N : B; }
HD const float* xrow(const Params& p, int layer, int t) {
  if (layer == 0) return t < TL ? p.x + (size_t)t * D : p.ctx + (size_t)(t - TL) * D;
  return p.X + (size_t)t * D;
}
HD const float* modp(const Params& p, int layer, int r, int which) {
  return p.modv + ((size_t)(layer * (B + 1) + r) * 6 + which) * D;
}

constexpr int N_MOD = DEPTH * (B + 1) * 6 * D;
HD void st_mod(const Params& p, int layer_unused, int idx) {
  int j = idx % (6 * D); int r = (idx / (6 * D)) % (B + 1); int l = idx / (6 * D * (B + 1));
  const float* cv = r < B ? p.c + (size_t)r * D : p.c_ctx;
  const float* w = p.mod_w + (size_t)l * D * 6 * D;
  float acc = p.mod_b[(size_t)l * 6 * D + j];
  for (int k = 0; k < D; ++k) acc += siluf(cv[k]) * w[(size_t)k * 6 * D + j];
  p.modv[idx] = acc;
}

constexpr int N_ROPE = 64 * 16;
constexpr int N_APOW = 2 * SSM_G * SSM_P * (SL + 1);
constexpr int N_BBAR = 2 * SSM_G * SSM_P * SSM_C;
constexpr int N_TABA = N_ROPE + N_APOW + N_BBAR + 1;
HD void st_taba(const Params& p, int layer_unused, int idx) {
  if (idx < N_ROPE) {
    int pos = idx / 16, f = idx % 16;
    float inv = powf(10000.0f, -(float)f / 16.0f);
    float ang = (float)pos * inv;
    p.ropeT[idx * 2] = cosf(ang); p.ropeT[idx * 2 + 1] = sinf(ang);
    return;
  }
  idx -= N_ROPE;
  if (idx < N_APOW) {
#ifndef HOST_EMU
    return;
#endif
    int k = idx % (SL + 1); int q = idx / (SL + 1);
    int dg = q / SSM_P;
    double dt = exp((double)p.log_step[dg]);
    double ar = p.a_re[q], ai = p.a_im[q];
    double mag = exp(k * dt * ar);
    p.apow[(size_t)idx * 2] = (float)(mag * cos(k * dt * ai));
    p.apow[(size_t)idx * 2 + 1] = (float)(mag * sin(k * dt * ai));
    return;
  }
  idx -= N_APOW;
  if (idx < N_BBAR) {
    int cc = idx % SSM_C; int q = idx / SSM_C; int dg = q / SSM_P;
    (void)cc;
    double dt = exp((double)p.log_step[dg]);
    double ar = p.a_re[q], ai = p.a_im[q];
    double mag = exp(dt * ar);
    double abr = mag * cos(dt * ai), abi = mag * sin(dt * ai);
    double den = ar * ar + ai * ai, nr = abr - 1.0;
    double cr = (nr * ar + abi * ai) / den, ci = (abi * ar - nr * ai) / den;
    double br = p.b_re[idx], bi = p.b_im[idx];
    p.bbar[(size_t)idx * 2] = (float)(cr * br - ci * bi);
    p.bbar[(size_t)idx * 2 + 1] = (float)(cr * bi + ci * br);
    return;
  }
  double s1 = 0, s2 = 0;
  for (int i = 0; i < HD_; ++i) { s1 += (double)p.lq1[i] * p.lk1[i]; s2 += (double)p.lq2[i] * p.lk2[i]; }
  double lam_init = 0.8 - 0.6 * exp(-0.3 * 1.0);
  p.scal[0] = (float)(exp(s1) - exp(s2) + lam_init);
  p.scal[1] = (float)(1.0 - lam_init);
}

constexpr int N_KT = 2 * SSM_G * SL * SSM_C * SSM_C;
HD void st_tabb(const Params& p, int layer_unused, int idx) {
  int ci = idx % SSM_C; int co = (idx / SSM_C) % SSM_C; int k = (idx / (SSM_C * SSM_C)) % SL; int dg = idx / (SSM_C * SSM_C * SL);
  float acc = 0.f;
  for (int pp = 0; pp < SSM_P; ++pp) {
    int q = dg * SSM_P + pp;
    float ar = p.apow[((size_t)q * (SL + 1) + k) * 2], ai = p.apow[((size_t)q * (SL + 1) + k) * 2 + 1];
    float br = p.bbar[((size_t)q * SSM_C + ci) * 2], bi = p.bbar[((size_t)q * SSM_C + ci) * 2 + 1];
    float cr = p.c_re[((size_t)dg * SSM_C + co) * SSM_P + pp], cim = p.c_im[((size_t)dg * SSM_C + co) * SSM_P + pp];
    float tr = ar * br - ai * bi, ti = ar * bi + ai * br;
    acc += cr * tr - cim * ti;
  }
  p.KT[idx] = acc;
}

HD void st_proj(const Params& p, int layer, int idx) {
  const int W = layer == 0 ? AB_IN : DIF_IN;
  const float* w = layer == 0 ? p.w_in_a : p.dif_w_in;
  const int rope_end = layer == 0 ? (SWA_QW + SWA_KVW) : (2 * DIF_QK);
  int t = idx / W, n = idx % W;
  int r = tok_r(t);
  if (layer == 1 && t >= TL && n < DIF_QK) return;
  const float* xr = xrow(p, layer, t);
  const float* sh = modp(p, layer, r, 0);
  const float* sc = modp(p, layer, r, 1);
  bool rope = (t < TL) && (n < rope_end);
  if (!rope) {
    float acc = 0.f;
    for (int k = 0; k < D; ++k) { float h = xr[k] * (1.0f + sc[k]) + sh[k]; acc += h * w[(size_t)k * W + n]; }
    p.P[(size_t)t * W + n] = f2bf(acc);
    return;
  }
  int d = n % 64, sub = d % 32;
  if (sub >= 16) return;
  float a1 = 0.f, a2 = 0.f;
  for (int k = 0; k < D; ++k) {
    float h = xr[k] * (1.0f + sc[k]) + sh[k];
    a1 += h * w[(size_t)k * W + n]; a2 += h * w[(size_t)k * W + n + 16];
  }
  int i = t % N;
  int pos = d < 32 ? i / GRID_W : i % GRID_W;
  float cs = p.ropeT[(pos * 16 + sub) * 2], sn = p.ropeT[(pos * 16 + sub) * 2 + 1];
  p.P[(size_t)t * W + n] = f2bf(a1 * cs - a2 * sn);
  p.P[(size_t)t * W + n + 16] = f2bf(a2 * cs + a1 * sn);
}

HD void st_swa(const Params& p, int layer, int idx) {
  int hq = idx / TA, t = idx % TA;
  int kvh = hq / 4;
  const uint16_t* P = p.P;
  float q[64], o[64];
  _Pragma("unroll") for (int d = 0; d < 64; ++d) { q[d] = bf2f(P[(size_t)t * AB_IN + hq * 64 + d]) * 0.125f; o[d] = 0.f; }
  float m = p.sink[hq], l = 1.0f;
  int b = t < TL ? t / N : (t - TL) / CTX;
  int nloc = t < TL ? 2 * SWA_WIN + 1 : 0;
  int i = t < TL ? t % N : 0;
  for (int kk = 0; kk < nloc + CTX; ++kk) {
    int row;
    if (kk < nloc) {
      int j = i - SWA_WIN + kk;
      if (j < 0 || j >= N) continue;
      row = b * N + j;
    } else row = TL + b * CTX + (kk - nloc);
    const uint16_t* kr = P + (size_t)row * AB_IN + A_KOFF + kvh * 64;
    const uint16_t* vr = P + (size_t)row * AB_IN + A_VOFF + kvh * 64;
    float s = 0.f;
    _Pragma("unroll") for (int d = 0; d < 64; ++d) s += q[d] * bf2f(kr[d]);
    if (s > m) { float f = expf(m - s); l *= f; for (int d = 0; d < 64; ++d) o[d] *= f; m = s; }
    float pe = expf(s - m);
    l += pe;
    _Pragma("unroll") for (int d = 0; d < 64; ++d) o[d] += pe * bf2f(vr[d]);
  }
  float il = 1.0f / l;
  _Pragma("unroll") for (int d = 0; d < 64; ++d) p.Ymix[(size_t)t * YW + hq * 64 + d] = f2bf(o[d] * il);
}

HD int ssm_row(int dir, int b, int tau) {
  if (dir == 0) return tau < CTX ? TL + b * CTX + tau : b * N + (tau - CTX);
  return tau < CTX ? TL + b * CTX + (CTX - 1 - tau) : b * N + (N - 1 - (tau - CTX));
}
constexpr int N_SSME = 2 * B * NCH * SSM_G * SSM_P;
HD void st_ssm_e(const Params& p, int layer, int idx) {
  int pp = idx % SSM_P; int g = (idx / SSM_P) % SSM_G; int ch = (idx / (SSM_P * SSM_G)) % NCH;
  int b = (idx / (SSM_P * SSM_G * NCH)) % B; int dir = idx / (SSM_P * SSM_G * NCH * B);
  int q = (dir * SSM_G + g) * SSM_P + pp;
  float er = 0.f, ei = 0.f;
  for (int j = 0; j < SL; ++j) {
    int row = ssm_row(dir, b, ch * SL + j);
    const uint16_t* u = p.P + (size_t)row * AB_IN + A_UOFF + g * 16;
    float vr = 0.f, vi = 0.f;
    _Pragma("unroll") for (int cc = 0; cc < 16; ++cc) {
      float uv = bf2f(u[cc]);
      vr += p.bbar[((size_t)q * 16 + cc) * 2] * uv; vi += p.bbar[((size_t)q * 16 + cc) * 2 + 1] * uv;
    }
    float ar = p.apow[((size_t)q * (SL + 1) + (SL - 1 - j)) * 2], ai = p.apow[((size_t)q * (SL + 1) + (SL - 1 - j)) * 2 + 1];
    er += ar * vr - ai * vi; ei += ar * vi + ai * vr;
  }
  p.E[(size_t)idx * 2] = er; p.E[(size_t)idx * 2 + 1] = ei;
}
constexpr int N_SSMC = 2 * B * SSM_G * SSM_P;
HD void st_ssm_c(const Params& p, int layer, int idx) {
  int pp = idx % SSM_P; int g = (idx / SSM_P) % SSM_G; int b = (idx / (SSM_P * SSM_G)) % B; int dir = idx / (SSM_P * SSM_G * B);
  int q = (dir * SSM_G + g) * SSM_P + pp;
  float ar = p.apow[((size_t)q * (SL + 1) + SL) * 2], ai = p.apow[((size_t)q * (SL + 1) + SL) * 2 + 1];
  float sr = 0.f, si = 0.f;
  for (int ch = 0; ch < NCH; ++ch) {
    size_t e = ((((size_t)dir * B + b) * NCH + ch) * SSM_G + g) * SSM_P + pp;
    p.Sin[e * 2] = sr; p.Sin[e * 2 + 1] = si;
    float er = p.E[e * 2], ei = p.E[e * 2 + 1];
    float nr = ar * sr - ai * si + er, ni = ar * si + ai * sr + ei;
    sr = nr; si = ni;
  }
}
HD void st_ssm_o(const Params& p, int layer, int idx) {
  int t = idx / SSM_W, n = idx % SSM_W; int g = n / 16, co = n % 16;
  int b, dirtau[2];
  if (t < TL) { b = t / N; int i = t % N; dirtau[0] = CTX + i; dirtau[1] = CTX + (N - 1 - i); }
  else { b = (t - TL) / CTX; int i = (t - TL) % CTX; dirtau[0] = i; dirtau[1] = CTX - 1 - i; }
  float y = p.ssm_d[n] * bf2f(p.P[(size_t)t * AB_IN + A_UOFF + n]);
  for (int dir = 0; dir < 2; ++dir) {
    int tau = dirtau[dir]; int ch = tau / SL, j = tau % SL;
    int dg = dir * SSM_G + g;
    size_t e0 = ((((size_t)dir * B + b) * NCH + ch) * SSM_G + g) * SSM_P;
    for (int pp = 0; pp < SSM_P; ++pp) {
      int q = dg * SSM_P + pp;
      float ar = p.apow[((size_t)q * (SL + 1) + (j + 1)) * 2], ai = p.apow[((size_t)q * (SL + 1) + (j + 1)) * 2 + 1];
      float sr = p.Sin[(e0 + pp) * 2], si = p.Sin[(e0 + pp) * 2 + 1];
      float tr = ar * sr - ai * si, ti = ar * si + ai * sr;
      float cr = p.c_re[((size_t)dg * 16 + co) * SSM_P + pp], cim = p.c_im[((size_t)dg * 16 + co) * SSM_P + pp];
      y += cr * tr - cim * ti;
    }
    for (int j2 = 0; j2 <= j; ++j2) {
      int row = ssm_row(dir, b, ch * SL + j2);
      const uint16_t* u = p.P + (size_t)row * AB_IN + A_UOFF + g * 16;
      const float* kt = p.KT + (((size_t)dg * SL + (j - j2)) * 16 + co) * 16;
      _Pragma("unroll") for (int ci = 0; ci < 16; ++ci) y += kt[ci] * bf2f(u[ci]);
    }
  }
  p.Gs[(size_t)t * SSM_W + n] = f2bf(geluf_(y));
}
HD void st_glu(const Params& p, int layer, int idx) {
  int t = idx / SSM_W, n = idx % SSM_W;
  float z = p.glu_b[n];
  const uint16_t* g = p.Gs + (size_t)t * SSM_W;
  for (int k = 0; k < SSM_W; ++k) z += bf2f(g[k]) * p.glu_w[(size_t)k * SSM_W + n];
  p.Ymix[(size_t)t * YW + SWA_QW + n] = f2bf(bf2f(g[n]) * sigmoidf_(z));
}

HD void st_dif(const Params& p, int layer, int idx) {
  int t = idx % TL; int he = idx / TL; int eh = he % 2, h = he / 2;
  int b = t / N;
  const uint16_t* P = p.P;
  float res[64];
  float lam = p.scal[0];
  _Pragma("unroll") for (int c = 0; c < 2; ++c) {
    float q[64], o[64];
    _Pragma("unroll") for (int d = 0; d < 64; ++d) { q[d] = bf2f(P[(size_t)t * DIF_IN + h * 128 + c * 64 + d]) * 0.125f; o[d] = 0.f; }
    float m = -1e30f, l = 0.f;
    for (int kk = 0; kk < N + CTX; ++kk) {
      int row = kk < N ? b * N + kk : TL + b * CTX + (kk - N);
      const uint16_t* kr = P + (size_t)row * DIF_IN + DIF_QK + h * 128 + c * 64;
      const uint16_t* vr = P + (size_t)row * DIF_IN + 2 * DIF_QK + h * 128 + eh * 64;
      float s = 0.f;
      _Pragma("unroll") for (int d = 0; d < 64; ++d) s += q[d] * bf2f(kr[d]);
      if (s > m) { float f = expf(m - s); l *= f; for (int d = 0; d < 64; ++d) o[d] *= f; m = s; }
      float pe = expf(s - m);
      l += pe;
      _Pragma("unroll") for (int d = 0; d < 64; ++d) o[d] += pe * bf2f(vr[d]);
    }
    float il = 1.0f / l;
    if (c == 0) { for (int d = 0; d < 64; ++d) res[d] = o[d] * il; }
    else { for (int d = 0; d < 64; ++d) res[d] -= lam * o[d] * il; }
  }
  _Pragma("unroll") for (int d = 0; d < 64; ++d) p.Ymix[(size_t)t * YW + h * 128 + eh * 64 + d] = f2bf(res[d]);
}
HD void st_difnorm(const Params& p, int layer, int idx) {
  int t = idx / DIF_H, h = idx % DIF_H;
  uint16_t* o = p.Ymix + (size_t)t * YW + h * 128;
  float ss = 0.f;
  for (int e = 0; e < 128; ++e) { float v = bf2f(o[e]); ss += v * v; }
  float r = 1.0f / sqrtf(ss / 128.0f + RMS_EPS) * p.scal[1];
  _Pragma("unroll 8") for (int e = 0; e < 128; ++e) o[e] = f2bf(bf2f(o[e]) * r * p.subln_g[e]);
}

HD void st_outproj(const Params& p, int layer, int idx) {
  int t = idx / D, n = idx % D;
  const float* w = layer == 0 ? p.w_out_a : p.dif_w_out;
  const uint16_t* y = p.Ymix + (size_t)t * YW;
  const int KW = layer == 0 ? AB_OUT : DIF_VW;
  float acc = 0.f;
  for (int k = 0; k < KW; ++k) acc += bf2f(y[k]) * w[(size_t)k * D + n];
  p.F[(size_t)t * D + n] = acc;
}
HD void st_ln1(const Params& p, int layer, int t) {
  int r = tok_r(t);
  const float* xr = xrow(p, layer, t); const float* g1 = modp(p, layer, r, 2);
  const float* y = p.F + (size_t)t * D;
  float mu = 0.f;
  for (int k = 0; k < D; ++k) mu += ALPHA * xr[k] + g1[k] * y[k];
  mu /= D;
  float var = 0.f;
  for (int k = 0; k < D; ++k) { float v = ALPHA * xr[k] + g1[k] * y[k] - mu; var += v * v; }
  var /= D;
  float rs = 1.0f / sqrtf(var + LN_EPS);
  const float* lg = p.ln1_g + (size_t)layer * D; const float* lb = p.ln1_b + (size_t)layer * D;
  for (int k = 0; k < D; ++k) p.X1[(size_t)t * D + k] = (ALPHA * xr[k] + g1[k] * y[k] - mu) * rs * lg[k] + lb[k];
}
HD void st_route(const Params& p, int layer, int t) {
  int r = tok_r(t);
  const float* x1 = p.X1 + (size_t)t * D; const float* sh = modp(p, layer, r, 3); const float* sc = modp(p, layer, r, 4);
  float lg[MOE_G];
  _Pragma("unroll") for (int g = 0; g < MOE_G; ++g) lg[g] = p.moe_bg[layer * MOE_G + g];
  const float* wg = p.moe_wg + (size_t)layer * D * MOE_G;
  for (int k = 0; k < D; ++k) {
    float h = x1[k] * (1.0f + sc[k]) + sh[k];
    _Pragma("unroll") for (int g = 0; g < MOE_G; ++g) lg[g] += h * wg[k * MOE_G + g];
  }
  int gi = 0; float mx = lg[0];
  _Pragma("unroll") for (int g = 1; g < MOE_G; ++g) if (lg[g] > mx) { mx = lg[g]; gi = g; }
  float den = 0.f;
  _Pragma("unroll") for (int g = 0; g < MOE_G; ++g) den += expf(lg[g] - mx);
  float gp = 1.0f / den;
  float le[MOE_EPG];
  _Pragma("unroll") for (int e = 0; e < MOE_EPG; ++e) le[e] = p.moe_be[(layer * MOE_G + gi) * MOE_EPG + e];
  const float* we = p.moe_we + ((size_t)layer * MOE_G + gi) * D * MOE_EPG;
  for (int k = 0; k < D; ++k) {
    float h = x1[k] * (1.0f + sc[k]) + sh[k];
    _Pragma("unroll") for (int e = 0; e < MOE_EPG; ++e) le[e] += h * we[k * MOE_EPG + e];
  }
  int i0 = 0; float v0 = le[0];
  _Pragma("unroll") for (int e = 1; e < MOE_EPG; ++e) if (le[e] > v0) { v0 = le[e]; i0 = e; }
  int i1 = -1; float v1 = -3e38f;
  _Pragma("unroll") for (int e = 0; e < MOE_EPG; ++e) if (e != i0 && le[e] > v1) { v1 = le[e]; i1 = e; }
  float e1 = expf(v1 - v0);
  float w0 = gp / (1.0f + e1), w1 = gp * e1 / (1.0f + e1);
  p.route[(size_t)t * 4 + 0] = (float)(gi * MOE_EPG + i0);
  p.route[(size_t)t * 4 + 1] = (float)(gi * MOE_EPG + i1);
  p.route[(size_t)t * 4 + 2] = w0;
  p.route[(size_t)t * 4 + 3] = w1;
}
HD void st_moe_h(const Params& p, int layer, int idx) {
  int f = idx % MOE_F; int j = (idx / MOE_F) % 2; int t = idx / (2 * MOE_F);
  int r = tok_r(t);
  const float* x1 = p.X1 + (size_t)t * D; const float* sh = modp(p, layer, r, 3); const float* sc = modp(p, layer, r, 4);
  int e = (int)p.route[(size_t)t * 4 + j]; float wgt = p.route[(size_t)t * 4 + 2 + j];
  const float* w1 = p.moe_w1 + ((size_t)layer * MOE_E + e) * D * MOE_F;
  const float* w3 = p.moe_w3 + ((size_t)layer * MOE_E + e) * D * MOE_F;
  float h1 = 0.f, h3 = 0.f;
  for (int k = 0; k < D; ++k) {
    float h = x1[k] * (1.0f + sc[k]) + sh[k];
    h1 += h * w1[(size_t)k * MOE_F + f]; h3 += h * w3[(size_t)k * MOE_F + f];
  }
  p.HH[(size_t)idx] = siluf(h1) * h3 * wgt;
}
HD void st_moe_o(const Params& p, int layer, int idx) {
  int t = idx / D, n = idx % D;
  float acc = 0.f;
  for (int j = 0; j < 2; ++j) {
    int e = (int)p.route[(size_t)t * 4 + j];
    const float* w2 = p.moe_w2 + ((size_t)layer * MOE_E + e) * MOE_F * D;
    const float* hh = p.HH + ((size_t)t * 2 + j) * MOE_F;
    for (int f = 0; f < MOE_F; ++f) acc += hh[f] * w2[(size_t)f * D + n];
  }
  p.F[(size_t)t * D + n] = acc;
}
HD void st_ln2(const Params& p, int layer, int t) {
  int r = tok_r(t);
  const float* x1 = p.X1 + (size_t)t * D; const float* g2 = modp(p, layer, r, 5);
  const float* y = p.F + (size_t)t * D;
  float mu = 0.f;
  for (int k = 0; k < D; ++k) mu += ALPHA * x1[k] + g2[k] * y[k];
  mu /= D;
  float var = 0.f;
  for (int k = 0; k < D; ++k) { float v = ALPHA * x1[k] + g2[k] * y[k] - mu; var += v * v; }
  var /= D;
  float rs = 1.0f / sqrtf(var + LN_EPS);
  const float* lg = p.ln2_g + (size_t)layer * D; const float* lb = p.ln2_b + (size_t)layer * D;
  float* dst = layer == DEPTH - 1 ? p.out + (size_t)t * D : p.X + (size_t)t * D;
  for (int k = 0; k < D; ++k) dst[k] = (ALPHA * x1[k] + g2[k] * y[k] - mu) * rs * lg[k] + lb[k];
}

enum { S_MOD, S_TABA, S_TABB, S_PROJ, S_SWA, S_SSME, S_SSMC, S_SSMO, S_GLU, S_DIF, S_DIFNORM, S_OUTPROJ, S_LN1, S_ROUTE, S_MOEH, S_MOEO, S_LN2 };
template <int S> HD void run_elem(const Params& p, int layer, int idx) {
  if (S == S_MOD) st_mod(p, layer, idx);
  else if (S == S_TABA) st_taba(p, layer, idx);
  else if (S == S_TABB) st_tabb(p, layer, idx);
  else if (S == S_PROJ) st_proj(p, layer, idx);
  else if (S == S_SWA) st_swa(p, layer, idx);
  else if (S == S_SSME) st_ssm_e(p, layer, idx);
  else if (S == S_SSMC) st_ssm_c(p, layer, idx);
  else if (S == S_SSMO) st_ssm_o(p, layer, idx);
  else if (S == S_GLU) st_glu(p, layer, idx);
  else if (S == S_DIF) st_dif(p, layer, idx);
  else if (S == S_DIFNORM) st_difnorm(p, layer, idx);
  else if (S == S_OUTPROJ) st_outproj(p, layer, idx);
  else if (S == S_LN1) st_ln1(p, layer, idx);
  else if (S == S_ROUTE) st_route(p, layer, idx);
  else if (S == S_MOEH) st_moe_h(p, layer, idx);
  else if (S == S_MOEO) st_moe_o(p, layer, idx);
  else if (S == S_LN2) st_ln2(p, layer, idx);
}

constexpr int NSLOT = 2 * TA + MOE_E * 256;
constexpr size_t CTL_BYTES = 1u << 20;
struct WsLayout {
  size_t A2, BtY, BtE, apow16, KT16, E16, Ypart, wgbase;
  size_t ctl, X, X1, P, Ymix, Gs, modv, ropeT, apow, bbar, KT, E, Sin, route, scal, WinA_t, DifIn_t, WoutA_t, DifOut_t, Glu_t, W13t, W2t, gate, tokslot, moe_meta, total;
};
inline WsLayout ws_layout() {
  WsLayout L; size_t o = 0;
  auto take = [&](size_t bytes) { size_t r = o; o += (bytes + 255) & ~(size_t)255; return r; };
  L.ctl = take(CTL_BYTES);
  L.X = take((size_t)TA * D * 4);
  L.X1 = L.X;
  L.P = take((size_t)TA * (AB_IN > DIF_IN ? AB_IN : DIF_IN) * 2);
  L.Ymix = take((size_t)TA * YW * 2);
  L.Gs = L.X;
  L.modv = take((size_t)N_MOD * 4);
  L.ropeT = take((size_t)N_ROPE * 2 * 4);
  L.apow = take((size_t)N_APOW * 2 * 4);
  L.bbar = take((size_t)N_BBAR * 2 * 4);
  L.KT = take((size_t)N_KT * 4);
  L.E = L.X + (((size_t)TA * SSM_W * 2 + 255) & ~(size_t)255);
  L.Sin = L.E + (((size_t)N_SSME * 2 * 4 + 255) & ~(size_t)255);
  L.route = take((size_t)TA * 8 * 4);
  L.scal = take(256);
  L.WinA_t = take((size_t)AB_IN * D * 2);
  L.DifIn_t = take((size_t)DIF_IN * D * 2);
  L.WoutA_t = take((size_t)D * AB_OUT * 2);
  L.DifOut_t = take((size_t)D * DIF_VW * 2);
  L.Glu_t = take((size_t)SSM_W * SSM_W * 2);
  L.W13t = take((size_t)MOE_E * 2 * MOE_F * D * 2);
  L.W2t = take((size_t)MOE_E * D * MOE_F * 2);
  L.gate = take((size_t)NSLOT * 4);
  L.tokslot = take((size_t)TA * 2 * 4);
  L.moe_meta = take(4096);
  L.wgbase = take((size_t)DEPTH * 1024 * MOE_E * 4);
  L.BtY = take((size_t)2 * SSM_G * 256 * 384 * 2);
  L.BtE = take((size_t)2 * SSM_G * 256 * 256 * 2);
  L.apow16 = take((size_t)2 * SSM_G * SSM_P * 17 * 2 * 4);
  L.KT16 = take((size_t)2 * SSM_G * 16 * 256 * 4);
  L.A2 = L.P + (size_t)48 * 1024 * 1024;
  L.E16 = L.X + (size_t)19 * 1024 * 1024;
  L.Ypart = L.E16;
  L.total = o;
  return L;
}
inline void fill_ws(Params& p, char* ws) {
  WsLayout L = ws_layout();
  p.X = (float*)(ws + L.X); p.X1 = (float*)(ws + L.X1); p.P = (uint16_t*)(ws + L.P); p.F = (float*)(ws + L.P);
  p.Ymix = (uint16_t*)(ws + L.Ymix); p.HH = (float*)(ws + L.Ymix);
  p.Gs = (uint16_t*)(ws + L.Gs); p.modv = (float*)(ws + L.modv); p.ropeT = (float*)(ws + L.ropeT);
  p.apow = (float*)(ws + L.apow); p.bbar = (float*)(ws + L.bbar); p.KT = (float*)(ws + L.KT);
  p.E = (float*)(ws + L.E); p.Sin = (float*)(ws + L.Sin); p.route = (float*)(ws + L.route); p.scal = (float*)(ws + L.scal);
  p.H = (uint16_t*)(ws + L.Ymix); p.WinA_t = (uint16_t*)(ws + L.WinA_t); p.DifIn_t = (uint16_t*)(ws + L.DifIn_t); p.ctl = (unsigned*)(ws + L.ctl);
  p.WoutA_t = (uint16_t*)(ws + L.WoutA_t); p.DifOut_t = (uint16_t*)(ws + L.DifOut_t); p.Glu_t = (uint16_t*)(ws + L.Glu_t);
  p.W13t = (uint16_t*)(ws + L.W13t); p.W2t = (uint16_t*)(ws + L.W2t);
  p.Amoe = (uint16_t*)(ws + L.P); p.F2 = (uint16_t*)(ws + L.P); p.HHb = (uint16_t*)(ws + L.Ymix);
  p.A2 = (uint16_t*)(ws + L.A2); p.BtY = (uint16_t*)(ws + L.BtY); p.BtE = (uint16_t*)(ws + L.BtE);
  p.apow16 = (float*)(ws + L.apow16); p.KT16 = (float*)(ws + L.KT16); p.E16 = (float*)(ws + L.E16); p.Ypart = (float*)(ws + L.Ypart);
  p.wgbase = (int*)(ws + L.wgbase);
  p.gate = (float*)(ws + L.gate); p.tokslot = (int*)(ws + L.tokslot); p.moe_meta = (int*)(ws + L.moe_meta);
}
inline void fill_inputs(Params& p, void* const* d_in) {
  const float* const* in = (const float* const*)d_in;
  p.x = in[0]; p.c = in[1]; p.ctx = in[2]; p.c_ctx = in[3]; p.mod_w = in[4]; p.mod_b = in[5];
  p.ln1_g = in[6]; p.ln1_b = in[7]; p.ln2_g = in[8]; p.ln2_b = in[9];
  p.w_in_a = in[10]; p.w_out_a = in[11]; p.sink = in[12]; p.a_re = in[13]; p.a_im = in[14]; p.log_step = in[15];
  p.b_re = in[16]; p.b_im = in[17]; p.c_re = in[18]; p.c_im = in[19]; p.ssm_d = in[20]; p.glu_w = in[21]; p.glu_b = in[22];
  p.dif_w_in = in[23]; p.dif_w_out = in[24]; p.lq1 = in[25]; p.lk1 = in[26]; p.lq2 = in[27]; p.lk2 = in[28]; p.subln_g = in[29];
  p.moe_wg = in[30]; p.moe_bg = in[31]; p.moe_we = in[32]; p.moe_be = in[33]; p.moe_w1 = in[34]; p.moe_w3 = in[35]; p.moe_w2 = in[36];
}

#define FORWARD_PROGRAM(RUN)                                   \
  RUN(S_MOD, 0, N_MOD)                                         \
  RUN(S_TABA, 0, N_TABA)                                       \
  RUN(S_TABB, 0, N_KT)                                         \
                                                   \
  RUN(S_PROJ, 0, TA * AB_IN)                                   \
  RUN(S_SWA, 0, SWA_H * TA)                                    \
  RUN(S_SSME, 0, N_SSME)                                       \
  RUN(S_SSMC, 0, N_SSMC)                                       \
  RUN(S_SSMO, 0, TA * SSM_W)                                   \
  RUN(S_GLU, 0, TA * SSM_W)                                    \
  RUN(S_OUTPROJ, 0, TA * D)                                    \
  RUN(S_LN1, 0, TA)                                            \
  RUN(S_ROUTE, 0, TA)                                          \
  RUN(S_MOEH, 0, TA * 2 * MOE_F)                               \
  RUN(S_MOEO, 0, TA * D)                                       \
  RUN(S_LN2, 0, TA)                                            \
                                                   \
  RUN(S_PROJ, 1, TA * DIF_IN)                                  \
  RUN(S_DIF, 1, DIF_H * 2 * TL)                                \
  RUN(S_DIFNORM, 1, TL * DIF_H)                                \
  RUN(S_OUTPROJ, 1, TL * D)                                    \
  RUN(S_LN1, 1, TL)                                            \
  RUN(S_ROUTE, 1, TL)                                          \
  RUN(S_MOEH, 1, TL * 2 * MOE_F)                               \
  RUN(S_MOEO, 1, TL * D)                                       \
  RUN(S_LN2, 1, TL)

#ifndef HOST_EMU
#include <cstdio>
#define LAS __attribute__((address_space(3)))
#define GAS __attribute__((address_space(1)))
typedef unsigned short bf16_t;
typedef short bf16x8 __attribute__((ext_vector_type(8)));
typedef float f32x4 __attribute__((ext_vector_type(4)));
typedef float f32x2 __attribute__((ext_vector_type(2)));
typedef unsigned u32x4 __attribute__((ext_vector_type(4)));
typedef unsigned u32x2 __attribute__((ext_vector_type(2)));
constexpr int NWAVES = 8, NTHR = 512;
constexpr int RING_BYTES = 131072, LDSCTL_OFF = RING_BYTES, MISC_OFF = LDSCTL_OFF + 320, LDS_BYTES = 147456;
#define LDS_WAIT() asm volatile("s_waitcnt lgkmcnt(0)" ::: "memory")
#define VM_WAIT() asm volatile("s_waitcnt vmcnt(0)" ::: "memory")
__device__ __forceinline__ unsigned cvt_pk_bf16(float lo, float hi) { unsigned r; asm volatile("v_cvt_pk_bf16_f32 %0, %1, %2" : "=v"(r) : "v"(lo), "v"(hi)); return r; }

namespace pg8 {
constexpr int BM = 256, BK = 64, HALF = 128, HTB = HALF * BK * 2, STAGE_BYTES = 8 * HTB, NXCD = 8, WGM = 8;
__host__ __device__ __forceinline__ int lds_byte(int r, int c) { const int st = (r >> 4) * 2 + (c >> 5), rr = r & 15, cc = c & 31, ob = rr * 64 + cc * 2; return st * 1024 + (ob ^ (((ob >> 9) & 1) << 5)); }
__host__ __device__ __forceinline__ void stage_rc(int b, int& R, int& C) { const int st = b / 1024, sb = b % 1024, swz = sb ^ (((sb >> 9) & 1) << 5); R = (st >> 1) * 16 + swz / 64; C = (st & 1) * 32 + (swz % 64) / 2; }
__host__ __device__ __forceinline__ int perm32(int rho) { const int n = rho >> 4, i = rho & 15; return 8 * (i >> 2) + 4 * n + (i & 3); }
struct Unit { int pm, pn; };
struct Gemm { const bf16_t* A; const bf16_t* Bt; int lda, ldb, K; };

struct StaticOrder {
  int nM, nN, nwg, G, c;
  __device__ void init(int M, int N, int G_, int c_) { nM = M / BM; nN = N / BM; nwg = nM * nN; G = G_; c = c_; }
  __device__ bool next(int i, Unit& u) const { return at((long)i * G + c, u); }
  __device__ bool at(long L, Unit& u) const {
    if (L >= nwg) return false;
    int wgid = (int)L; { const int q = nwg / NXCD, r = nwg % NXCD, xcd = wgid % NXCD, off = wgid / NXCD; wgid = (xcd < r ? xcd * (q + 1) : r * (q + 1) + (xcd - r) * q) + off; }
    const int nig = WGM * nN, gid = wgid / nig, fm = gid * WGM, gsz = (nM - fm) < WGM ? (nM - fm) : WGM;
    u.pm = fm + ((wgid % nig) % gsz); u.pn = (wgid % nig) / gsz; return true;
  }
  __device__ __forceinline__ void a_ready(const Unit&) const {}
  __device__ __forceinline__ void done(const Unit&) const {}
};

template <class Epi, class Sched, bool ALIGN_EPI = true, bool SP2 = true>
__device__ __forceinline__ void gemm_phase(LAS unsigned char* lds, const Gemm g, const Sched& S, const Epi& E) {
  int tid = threadIdx.x; asm volatile("" : "+v"(tid));
  const int wid = __builtin_amdgcn_readfirstlane(tid >> 6), lane = tid & 63, wr = wid >> 2, wc = wid & 3, fr = lane & 15, fq = lane >> 4;
  const int K = g.K, nt = K / BK;
  unsigned voffA[2], voffB[2];
#pragma unroll
  for (int i = 0; i < 2; ++i) { int R, C; stage_rc(tid * 16 + i * 8192, R, C); const int Rb = Epi::PERM ? ((R & ~31) + perm32(R & 31)) : R;
    voffA[i] = (unsigned)(R * g.lda + C) * 2u; voffB[i] = (unsigned)(Rb * g.ldb + C) * 2u; }
  const size_t kstep = (size_t)(BK * 2);
  const size_t hA = (size_t)HALF * g.lda * 2, hB = (size_t)HALF * g.ldb * 2;
  const size_t tA = 2 * hA, tB = 2 * hB;
  const unsigned ldsw = (unsigned)wid * 1024u;
  const int aoff = lds_byte(wr * 64 + fr, fq * 8), boff = lds_byte(wc * 32 + fr, fq * 8);
#define PG8_SA(b, h) (((b) * 2 + (h)) * HTB)
#define PG8_SB(b, h) ((4 + (b) * 2 + (h)) * HTB)
#define PG8_STAGE(bufoff, gbase, voff) do { _Pragma("unroll") for (int _i = 0; _i < 2; ++_i) \
    __builtin_amdgcn_global_load_lds((const unsigned*)((const char*)(gbase) + (voff)[_i]), (LAS unsigned*)(lds + (bufoff) + ldsw + _i * 8192), 16, 0, 0); } while (0)
#define PG8_LDA(dst, b, h) do { _Pragma("unroll") for (int m = 0; m < 4; ++m) _Pragma("unroll") for (int k = 0; k < 2; ++k) dst[m][k] = *(const LAS bf16x8*)(lds + PG8_SA(b, h) + aoff + m * 2048 + k * 1024); } while (0)
#define PG8_LDB(dst, b, h) do { _Pragma("unroll") for (int n = 0; n < 2; ++n) _Pragma("unroll") for (int k = 0; k < 2; ++k) dst[n][k] = *(const LAS bf16x8*)(lds + PG8_SB(b, h) + boff + n * 2048 + k * 1024); } while (0)
#define PG8_MMA(ai, bj, At, Bt) do { __builtin_amdgcn_s_setprio(1); _Pragma("unroll") for (int m = 0; m < 4; ++m) _Pragma("unroll") for (int n = 0; n < 2; ++n) _Pragma("unroll") for (int k = 0; k < 2; ++k) \
    acc[ai][bj][m][n] = __builtin_amdgcn_mfma_f32_16x16x32_bf16(Bt[n][k], At[m][k], acc[ai][bj][m][n], 0, 0, 0); __builtin_amdgcn_s_setprio(0); } while (0)
#define PG8_WAIT_V(n) asm volatile("s_waitcnt vmcnt(" #n ")" ::: "memory")
#define PG8_WAIT_L(n) asm volatile("s_waitcnt lgkmcnt(" #n ")" ::: "memory")
#define PG8_BAR __builtin_amdgcn_s_barrier()
#define PG8_SCHED __builtin_amdgcn_sched_barrier(0)
  Unit cur, nxt; int ui = 0;
  if (!S.next(0, cur)) return;
  f32x4 acc[2][2][4][2];
#pragma unroll
  for (int a = 0; a < 2; ++a)
#pragma unroll
    for (int b = 0; b < 2; ++b)
#pragma unroll
      for (int m = 0; m < 4; ++m)
#pragma unroll
        for (int n = 0; n < 2; ++n) acc[a][b][m][n] = (f32x4){0.f, 0.f, 0.f, 0.f};
  bf16x8 At[4][2], B0[2][2], B1[2][2];
  const char* cA = (const char*)g.A + (size_t)cur.pm * tA; const char* cB = (const char*)g.Bt + (size_t)cur.pn * tB;
  S.a_ready(cur);
  if constexpr (SP2) {
    PG8_STAGE(PG8_SB(0, 0), cB, voffB); PG8_STAGE(PG8_SB(0, 1), cB + hB, voffB); PG8_STAGE(PG8_SA(0, 0), cA, voffA); PG8_STAGE(PG8_SA(0, 1), cA + hA, voffA);
    if (wr == 1) PG8_BAR;
    PG8_WAIT_V(2); PG8_BAR;
    PG8_STAGE(PG8_SB(1, 0), cB + kstep, voffB); PG8_STAGE(PG8_SA(1, 0), cA + kstep, voffA); PG8_STAGE(PG8_SB(1, 1), cB + hB + kstep, voffB);
    PG8_WAIT_V(6); PG8_BAR;
  } else {
    PG8_STAGE(PG8_SB(0, 0), cB, voffB); PG8_STAGE(PG8_SA(0, 0), cA, voffA); PG8_STAGE(PG8_SB(0, 1), cB + hB, voffB); PG8_STAGE(PG8_SA(0, 1), cA + hA, voffA);
    if (wr == 1) PG8_BAR;
    PG8_WAIT_V(4); PG8_BAR;
    PG8_STAGE(PG8_SB(1, 0), cB + kstep, voffB); PG8_STAGE(PG8_SA(1, 0), cA + kstep, voffA); PG8_STAGE(PG8_SB(1, 1), cB + hB + kstep, voffB);
    PG8_WAIT_V(6); PG8_BAR;
  }
  for (;;) {
    const bool has_next = S.next(ui + 1, nxt);
    const char* nA = has_next ? (const char*)g.A + (size_t)nxt.pm * tA : cA; const char* nB = has_next ? (const char*)g.Bt + (size_t)nxt.pn * tB : cB;
#pragma unroll 1
    for (int t = 0; t < nt; t += 2) {
      const bool last = (t == nt - 2);
      const char* a1 = cA + (size_t)(t + 1) * kstep;
      const char* a2 = last ? nA : cA + (size_t)(t + 2) * kstep; const char* b2 = last ? nB : cB + (size_t)(t + 2) * kstep;
      const char* a3 = a2 + kstep; const char* b3 = b2 + kstep;
      if (last && has_next) S.a_ready(nxt);
      if constexpr (SP2) {
        PG8_LDB(B0, 0, 0); PG8_LDB(B1, 0, 1); PG8_SCHED; PG8_LDA(At, 0, 0); PG8_STAGE(PG8_SA(1, 1), a1 + hA, voffA);
        PG8_WAIT_V(8); PG8_WAIT_L(0); PG8_BAR; PG8_MMA(0, 0, At, B0); PG8_MMA(0, 1, At, B1); PG8_BAR; PG8_SCHED;
        PG8_LDA(At, 0, 1); PG8_STAGE(PG8_SB(0, 0), b2, voffB); PG8_STAGE(PG8_SB(0, 1), b2 + hB, voffB); PG8_STAGE(PG8_SA(0, 0), a2, voffA);
        PG8_WAIT_V(8); PG8_WAIT_L(0); PG8_BAR; PG8_MMA(1, 0, At, B0); PG8_MMA(1, 1, At, B1); PG8_BAR; PG8_SCHED;
        PG8_LDB(B0, 1, 0); PG8_LDB(B1, 1, 1); PG8_SCHED; PG8_LDA(At, 1, 0); PG8_STAGE(PG8_SA(0, 1), a2 + hA, voffA);
        PG8_WAIT_V(8); PG8_WAIT_L(0); PG8_BAR; PG8_MMA(0, 0, At, B0); PG8_MMA(0, 1, At, B1); PG8_BAR; PG8_SCHED;
        PG8_LDA(At, 1, 1); PG8_STAGE(PG8_SB(1, 0), b3, voffB); PG8_STAGE(PG8_SB(1, 1), b3 + hB, voffB); PG8_STAGE(PG8_SA(1, 0), a3, voffA);
        PG8_WAIT_V(8); PG8_WAIT_L(0); PG8_BAR; PG8_MMA(1, 0, At, B0); PG8_MMA(1, 1, At, B1); PG8_BAR; PG8_SCHED;
      } else {
        PG8_LDB(B0, 0, 0); PG8_SCHED; PG8_LDA(At, 0, 0); PG8_STAGE(PG8_SA(1, 1), a1 + hA, voffA);
        PG8_WAIT_L(8); PG8_BAR; PG8_WAIT_L(0); PG8_MMA(0, 0, At, B0); PG8_BAR; PG8_SCHED;
        PG8_LDB(B1, 0, 1); PG8_STAGE(PG8_SB(0, 0), b2, voffB);
        PG8_BAR; PG8_WAIT_L(0); PG8_MMA(0, 1, At, B1); PG8_BAR;
        PG8_LDA(At, 0, 1); PG8_STAGE(PG8_SA(0, 0), a2, voffA);
        PG8_BAR; PG8_WAIT_L(0); PG8_MMA(1, 0, At, B0); PG8_BAR; PG8_SCHED;
        PG8_STAGE(PG8_SB(0, 1), b2 + hB, voffB);
        PG8_WAIT_V(6); PG8_BAR; PG8_MMA(1, 1, At, B1); PG8_BAR;
        PG8_LDB(B0, 1, 0); PG8_SCHED; PG8_LDA(At, 1, 0); PG8_STAGE(PG8_SA(0, 1), a2 + hA, voffA);
        PG8_WAIT_L(8); PG8_BAR; PG8_WAIT_L(0); PG8_MMA(0, 0, At, B0); PG8_BAR; PG8_SCHED;
        PG8_LDB(B1, 1, 1); PG8_STAGE(PG8_SB(1, 0), b3, voffB);
        PG8_BAR; PG8_WAIT_L(0); PG8_MMA(0, 1, At, B1); PG8_BAR;
        PG8_LDA(At, 1, 1); PG8_STAGE(PG8_SA(1, 0), a3, voffA);
        PG8_BAR; PG8_WAIT_L(0); PG8_MMA(1, 0, At, B0); PG8_BAR; PG8_SCHED;
        PG8_STAGE(PG8_SB(1, 1), b3 + hB, voffB);
        PG8_WAIT_V(6); PG8_BAR; PG8_MMA(1, 1, At, B1); PG8_BAR;
      }
    }
    if constexpr (ALIGN_EPI) { if (wr == 0) PG8_BAR; }
    E(acc, cur, wr, wc, fr, fq); S.done(cur);
    if (!has_next) break;
#pragma unroll
    for (int a = 0; a < 2; ++a)
#pragma unroll
      for (int b = 0; b < 2; ++b)
#pragma unroll
        for (int m = 0; m < 4; ++m)
#pragma unroll
          for (int n = 0; n < 2; ++n) acc[a][b][m][n] = (f32x4){0.f, 0.f, 0.f, 0.f};
    cur = nxt; cA = nA; cB = nB; ++ui;
    if constexpr (ALIGN_EPI) { if (wr == 1) PG8_BAR; }
  }
  PG8_WAIT_V(0);
  if constexpr (!ALIGN_EPI) { if (wr == 0) PG8_BAR; }
  PG8_BAR;
#undef PG8_SA
#undef PG8_SB
#undef PG8_STAGE
#undef PG8_LDA
#undef PG8_LDB
#undef PG8_MMA
#undef PG8_WAIT_V
#undef PG8_WAIT_L
#undef PG8_BAR
#undef PG8_SCHED
}
}

constexpr int LC = 16, NCH16 = SS / LC, GROWS = 1280, A2K = 384;
static_assert(B * NCH16 <= GROWS && GROWS % 256 == 0, "ssm group rows");
__device__ __forceinline__ void ssm_tau(int t, int& b, int& tau0, int& tau1) {
  if (t < TL) { b = t / N; const int i = t % N; tau0 = CTX + i; tau1 = CTX + (N - 1 - i); }
  else { b = (t - TL) / CTX; const int i = (t - TL) % CTX; tau0 = i; tau1 = CTX - 1 - i; }
}
struct EpiProj {
  static constexpr bool PERM = false;
  bf16_t* O; int ldc; int rope_end; const float* ropeT; bf16_t* A2;
  __device__ __forceinline__ void operator()(const f32x4 (&acc)[2][2][4][2], const pg8::Unit& u, int wr, int wc, int fr, int fq) const {
    const int row0 = u.pm * 256 + wr * 64 + fr, colb = u.pn * 256 + wc * 32;
    const bool rope_cols = colb < rope_end;
#pragma unroll
    for (int ai = 0; ai < 2; ++ai)
#pragma unroll
      for (int m = 0; m < 4; ++m) {
        const int r = row0 + ai * 128 + m * 16;
        bf16_t* rowp = O + (size_t)r * ldc + colb + 4 * fq;
        f32x4 cs0 = {1.f, 0.f, 1.f, 0.f}, cs1 = {1.f, 0.f, 1.f, 0.f};
        const bool rp = rope_cols && (r < TL);
        if (rp) { const int i = r % N; const int pos = (wc & 1) ? (i % GRID_W) : (i / GRID_W);
          const f32x4* tp = (const f32x4*)(ropeT + (size_t)(pos * 16 + 4 * fq) * 2); cs0 = tp[0]; cs1 = tp[1]; }
#pragma unroll
        for (int bj = 0; bj < 2; ++bj) {
          const bool rpb = rp && (colb + bj * 128 < rope_end);
          f32x4 a1 = acc[ai][bj][m][0], a2 = acc[ai][bj][m][1];
          f32x4 o1 = a1, o2 = a2;
          if (rpb) {
            o1[0] = a1[0] * cs0[0] - a2[0] * cs0[1]; o2[0] = a2[0] * cs0[0] + a1[0] * cs0[1];
            o1[1] = a1[1] * cs0[2] - a2[1] * cs0[3]; o2[1] = a2[1] * cs0[2] + a1[1] * cs0[3];
            o1[2] = a1[2] * cs1[0] - a2[2] * cs1[1]; o2[2] = a2[2] * cs1[0] + a1[2] * cs1[1];
            o1[3] = a1[3] * cs1[2] - a2[3] * cs1[3]; o2[3] = a2[3] * cs1[2] + a1[3] * cs1[3];
          }
          u32x2 w1 = {cvt_pk_bf16(o1[0], o1[1]), cvt_pk_bf16(o1[2], o1[3])}, w2 = {cvt_pk_bf16(o2[0], o2[1]), cvt_pk_bf16(o2[2], o2[3])};
          *(u32x2*)(rowp + bj * 128) = w1; *(u32x2*)(rowp + bj * 128 + 16) = w2;
          if (A2 != nullptr && colb + bj * 128 >= A_UOFF) {
            int b, tau0, tau1; ssm_tau(r, b, tau0, tau1);
            const int g0 = (colb + bj * 128 - A_UOFF) / 16;
            bf16_t* d0 = A2 + (((size_t)g0 * GROWS + b * NCH16 + tau0 / LC) * A2K + (tau0 % LC) * 16 + 4 * fq);
            bf16_t* d1 = A2 + (((size_t)(SSM_G + g0) * GROWS + b * NCH16 + tau1 / LC) * A2K + (tau1 % LC) * 16 + 4 * fq);
            *(u32x2*)d0 = w1; *(u32x2*)(d0 + (size_t)GROWS * A2K) = w2; *(u32x2*)d1 = w1; *(u32x2*)(d1 + (size_t)GROWS * A2K) = w2;
          }
        }
      }
  }
};


struct ProjOrder1 {
  static constexpr int NM0 = TL / 256, NN = DIF_IN / 256, NQ = DIF_QK / 256, NU = NM0 * NN + (TC / 256) * (NN - NQ);
  pg8::StaticOrder S0; int G, c;
  __device__ __forceinline__ bool next(int i, pg8::Unit& u) const {
    const long L = (long)i * G + c;
    if (L < NM0 * NN) return S0.at(L, u);
    const int l2 = (int)(L - NM0 * NN); if (l2 >= (TC / 256) * (NN - NQ)) return false;
    u.pm = NM0 + l2 / (NN - NQ); u.pn = NQ + l2 % (NN - NQ); return true;
  }
  __device__ __forceinline__ void a_ready(const pg8::Unit&) const {}
  __device__ __forceinline__ void done(const pg8::Unit&) const {}
};
struct EpiF32Out {
  static constexpr bool PERM = false;
  float* C; int ldc;
  __device__ __forceinline__ void operator()(const f32x4 (&acc)[2][2][4][2], const pg8::Unit& u, int wr, int wc, int fr, int fq) const {
    const int row0 = u.pm * 256 + wr * 64 + fr, col0 = u.pn * 256 + wc * 32 + 4 * fq;
#pragma unroll
    for (int ai = 0; ai < 2; ++ai)
#pragma unroll
      for (int m = 0; m < 4; ++m) { float* rowp = C + (size_t)(row0 + ai * 128 + m * 16) * ldc + col0;
#pragma unroll
        for (int bj = 0; bj < 2; ++bj)
#pragma unroll
          for (int n = 0; n < 2; ++n) *(f32x4*)(rowp + bj * 128 + n * 16) = acc[ai][bj][m][n]; }
  }
};
struct EpiBf16Out {
  static constexpr bool PERM = true;
  bf16_t* O; int ldc; int NJ;
  __device__ __forceinline__ void operator()(const f32x4 (&acc)[2][2][4][2], const pg8::Unit& u, int wr, int wc, int fr, int fq) const {
    const int row0 = u.pm * 256 + wr * 64 + fr, col0 = (NJ ? (u.pn % NJ) : u.pn) * 256 + wc * 32 + 8 * fq;
#pragma unroll
    for (int ai = 0; ai < 2; ++ai)
#pragma unroll
      for (int m = 0; m < 4; ++m) { bf16_t* rowp = O + (size_t)(row0 + ai * 128 + m * 16) * ldc + col0;
#pragma unroll
        for (int bj = 0; bj < 2; ++bj) { const f32x4 v0 = acc[ai][bj][m][0], v1 = acc[ai][bj][m][1];
          u32x4 w; w.x = cvt_pk_bf16(v0[0], v0[1]); w.y = cvt_pk_bf16(v0[2], v0[3]); w.z = cvt_pk_bf16(v1[0], v1[1]); w.w = cvt_pk_bf16(v1[2], v1[3]);
          *(u32x4*)(rowp + bj * 128) = w; } }
  }
};
__device__ __forceinline__ float fast_sigmoid(float x) { return __builtin_amdgcn_rcpf(1.f + __builtin_amdgcn_exp2f(-1.4426950408889634f * x)); }
struct EpiGlu {
  static constexpr bool PERM = true;
  const bf16_t* Gs; const float* bias; bf16_t* O; int ldo, coloff;
  __device__ __forceinline__ void operator()(const f32x4 (&acc)[2][2][4][2], const pg8::Unit& u, int wr, int wc, int fr, int fq) const {
    const int row0 = u.pm * 256 + wr * 64 + fr, col0 = u.pn * 256 + wc * 32 + 8 * fq;
#pragma unroll
    for (int ai = 0; ai < 2; ++ai)
#pragma unroll
      for (int m = 0; m < 4; ++m) { const int r = row0 + ai * 128 + m * 16;
#pragma unroll
        for (int bj = 0; bj < 2; ++bj) { const int c = col0 + bj * 128;
          const u32x4 gv = *(const u32x4*)(Gs + (size_t)r * SSM_W + c);
          const f32x4 b0 = *(const f32x4*)(bias + c), b1 = *(const f32x4*)(bias + c + 4);
          const f32x4 v0 = acc[ai][bj][m][0] + b0, v1 = acc[ai][bj][m][1] + b1;
          float o[8];
#pragma unroll
          for (int j = 0; j < 4; ++j) { const unsigned gw_ = j < 2 ? (j == 0 ? gv.x : gv.y) : (j == 2 ? gv.z : gv.w);
            const float g0 = __builtin_bit_cast(float, gw_ << 16), g1 = __builtin_bit_cast(float, gw_ & 0xffff0000u);
            const float z0 = j < 2 ? v0[2 * j] : v1[2 * j - 4], z1 = j < 2 ? v0[2 * j + 1] : v1[2 * j - 3];
            o[2 * j] = g0 * fast_sigmoid(z0); o[2 * j + 1] = g1 * fast_sigmoid(z1); }
          u32x4 w; w.x = cvt_pk_bf16(o[0], o[1]); w.y = cvt_pk_bf16(o[2], o[3]); w.z = cvt_pk_bf16(o[4], o[5]); w.w = cvt_pk_bf16(o[6], o[7]);
          *(u32x4*)(O + (size_t)r * ldo + coloff + c) = w; } }
  }
};
struct EpiMoe1 {
  static constexpr bool PERM = true;
  bf16_t* HH; const float* gate;
  __device__ __forceinline__ void operator()(const f32x4 (&acc)[2][2][4][2], const pg8::Unit& u, int wr, int wc, int fr, int fq) const {
    const int row0 = u.pm * 256 + wr * 64 + fr, col0 = (u.pn & 1) * 128 + wc * 32 + 8 * fq;
#pragma unroll
    for (int ai = 0; ai < 2; ++ai)
#pragma unroll
      for (int m = 0; m < 4; ++m) { const int r = row0 + ai * 128 + m * 16; const float gt = gate[r];
        float o[8];
#pragma unroll
        for (int n = 0; n < 2; ++n)
#pragma unroll
          for (int j = 0; j < 4; ++j) { const float h1 = acc[ai][0][m][n][j], h3 = acc[ai][1][m][n][j]; o[4 * n + j] = h1 * fast_sigmoid(h1) * h3 * gt; }
        u32x4 w; w.x = cvt_pk_bf16(o[0], o[1]); w.y = cvt_pk_bf16(o[2], o[3]); w.z = cvt_pk_bf16(o[4], o[5]); w.w = cvt_pk_bf16(o[6], o[7]);
        *(u32x4*)(HH + (size_t)r * MOE_F + col0) = w; }
  }
};
struct MoeOrder {
  const int* meta; int NJ, G, c;
  __device__ __forceinline__ bool next(int i, pg8::Unit& u) const {
    const int nt = __builtin_amdgcn_readfirstlane(__hip_atomic_load(meta, __ATOMIC_RELAXED, __HIP_MEMORY_SCOPE_AGENT));
    const long L = (long)i * G + c; if (L >= (long)nt * NJ) return false;
    const int rt = (int)(L / NJ), jn = (int)(L % NJ);
    const int e = __builtin_amdgcn_readfirstlane(__hip_atomic_load(meta + 1 + rt, __ATOMIC_RELAXED, __HIP_MEMORY_SCOPE_AGENT));
    u.pm = rt; u.pn = e * NJ + jn; return true;
  }
  __device__ __forceinline__ void a_ready(const pg8::Unit&) const {}
  __device__ __forceinline__ void done(const pg8::Unit&) const {}
};


namespace att {
using f32x16 = __attribute__((ext_vector_type(16))) float;
using s16x4  = __attribute__((ext_vector_type(4))) short;
constexpr int KVBLK = 64;
constexpr float SCALE = 0.125f, THR = 8.f;
constexpr size_t SHM_V = KVBLK * 128 * 2, SHM_K = KVBLK * 128 * 2;
constexpr size_t SHM_WS = 2 * SHM_V + 2 * SHM_K;
#define KSWZ(row, colB) ((row) * 256 + ((colB) ^ (((row) & 7) << 4)))
#define SBAR() __builtin_amdgcn_sched_barrier(0)
__device__ __forceinline__ int crow(int r, int hi) { return (r & 3) + 8 * (r >> 2) + 4 * hi; }
__device__ __forceinline__ unsigned cvtpk(float lo, float hi) { unsigned r; asm volatile("v_cvt_pk_bf16_f32 %0, %1, %2" : "=v"(r) : "v"(lo), "v"(hi)); return r; }
__device__ __forceinline__ void partialSM(f32x16& p0, f32x16& p1, float& m_reg, float& mn, float& alpha) {
  constexpr float C = SCALE * 1.4426950408889634f;
  float pmax = p0[0];
#pragma unroll
  for (int r = 1; r < 16; ++r) pmax = fmaxf(pmax, p0[r]);
#pragma unroll
  for (int r = 0; r < 16; ++r) pmax = fmaxf(pmax, p1[r]);
  { auto rr = __builtin_amdgcn_permlane32_swap(__float_as_uint(pmax), __float_as_uint(pmax), false, false);
    pmax = fmaxf(__uint_as_float(rr[0]), __uint_as_float(rr[1])); }
  if (__builtin_expect(__all(pmax - m_reg <= THR / SCALE), 1)) { mn = m_reg; alpha = 1.f; }
  else { mn = fmaxf(m_reg, pmax); alpha = __builtin_amdgcn_exp2f((m_reg - mn) * C); m_reg = mn; }
  const float mnC = -mn * C;
#pragma unroll
  for (int r = 0; r < 16; ++r) p0[r] = fmaf(p0[r], C, mnC);
#pragma unroll
  for (int r = 0; r < 16; ++r) p1[r] = fmaf(p1[r], C, mnC);
#pragma unroll
  for (int r = 0; r < 16; ++r) p0[r] = __builtin_amdgcn_exp2f(p0[r]);
}
__device__ __forceinline__ void finishSM(f32x16& p0, f32x16& p1, float alpha, float& l_reg, bf16x8& pa0, bf16x8& pa1, bf16x8& pa2, bf16x8& pa3) {
#pragma unroll
  for (int r = 0; r < 16; ++r) p1[r] = __builtin_amdgcn_exp2f(p1[r]);
  float ps = 0;
#pragma unroll
  for (int r = 0; r < 16; ++r) ps += p0[r];
#pragma unroll
  for (int r = 0; r < 16; ++r) ps += p1[r];
  { auto rr = __builtin_amdgcn_permlane32_swap(__float_as_uint(ps), __float_as_uint(ps), false, false);
    ps = __uint_as_float(rr[0]) + __uint_as_float(rr[1]); }
  l_reg = l_reg * alpha + ps;
#define PK4(P, BASE, OUT) do { unsigned a0 = cvtpk(P[BASE + 0], P[BASE + 1]), a1 = cvtpk(P[BASE + 2], P[BASE + 3]);   \
    unsigned b0 = cvtpk(P[BASE + 4], P[BASE + 5]), b1 = cvtpk(P[BASE + 6], P[BASE + 7]);                              \
    auto r0 = __builtin_amdgcn_permlane32_swap(a0, b0, false, false); auto r1 = __builtin_amdgcn_permlane32_swap(a1, b1, false, false); \
    u32x4 w = {r0[0], r1[0], r0[1], r1[1]}; OUT = *reinterpret_cast<bf16x8*>(&w); } while (0)
  PK4(p0, 0, pa0); PK4(p0, 8, pa1); PK4(p1, 0, pa2); PK4(p1, 8, pa3);
#undef PK4
}
__device__ __forceinline__ void qkt(f32x16& p0, f32x16& p1, const char* Ks, const bf16x8* qr, int r32, int hi, int c) {
  p0 = f32x16{}; p1 = f32x16{};
#pragma unroll
  for (int d0 = 0; d0 < 4; ++d0) { const int cb = (c * 64 + d0 * 16 + hi * 8) * 2;
    const bf16x8 b0 = *reinterpret_cast<const bf16x8*>(Ks + KSWZ(r32, cb));
    const bf16x8 b1 = *reinterpret_cast<const bf16x8*>(Ks + KSWZ(32 + r32, cb));
    p0 = __builtin_amdgcn_mfma_f32_32x32x16_bf16(b0, qr[d0], p0, 0, 0, 0);
    p1 = __builtin_amdgcn_mfma_f32_32x32x16_bf16(b1, qr[d0], p1, 0, 0, 0); }
}
__device__ __forceinline__ int v_st(int k, int c) { const int kk = (k & ~0xC) | ((k & 4) << 1) | ((k & 8) >> 1); return ((kk >> 3) * 4 + (c >> 5)) * 512 + ((kk & 7) * 32 + (c & 31)) * 2; }
__device__ __forceinline__ int v_rd_base(int lane) { return ((lane & 3) << 3) | (((lane >> 2) & 3) << 6) | (((lane >> 4) & 1) << 5) | (((lane >> 5) & 1) << 8); }
constexpr int v_rd_off(int d0, int ks, int half) { return d0 * 512 + ks * 4096 + half * 2048; }
template <int OFF> __device__ __forceinline__ s16x4 tr_read(int vb) {
  s16x4 r; asm volatile("ds_read_b64_tr_b16 %0, %1 offset:%2" : "=&v"(r) : "v"(vb), "i"(OFF) : "memory"); return r;
}
template <int D0> __device__ __forceinline__ void pv_one(f32x16& od, int vb, bf16x8 pa0, bf16x8 pa1, bf16x8 pa2, bf16x8 pa3) {
  const s16x4 l0 = tr_read<v_rd_off(D0, 0, 0)>(vb), h0 = tr_read<v_rd_off(D0, 0, 1)>(vb), l1 = tr_read<v_rd_off(D0, 1, 0)>(vb), h1 = tr_read<v_rd_off(D0, 1, 1)>(vb);
  const s16x4 l2 = tr_read<v_rd_off(D0, 2, 0)>(vb), h2 = tr_read<v_rd_off(D0, 2, 1)>(vb), l3 = tr_read<v_rd_off(D0, 3, 0)>(vb), h3 = tr_read<v_rd_off(D0, 3, 1)>(vb);
  asm volatile("s_waitcnt lgkmcnt(0)" ::: "memory"); SBAR();
#define PK(L, H) (bf16x8){L[0], L[1], L[2], L[3], H[0], H[1], H[2], H[3]}
  od = __builtin_amdgcn_mfma_f32_32x32x16_bf16(pa0, PK(l0, h0), od, 0, 0, 0);
  od = __builtin_amdgcn_mfma_f32_32x32x16_bf16(pa1, PK(l1, h1), od, 0, 0, 0);
  od = __builtin_amdgcn_mfma_f32_32x32x16_bf16(pa2, PK(l2, h2), od, 0, 0, 0);
  od = __builtin_amdgcn_mfma_f32_32x32x16_bf16(pa3, PK(l3, h3), od, 0, 0, 0);
#undef PK
}
template <int NB> __device__ __forceinline__ void pv_blocks(f32x16* o, int vb, int vsel, bf16x8 pa0, bf16x8 pa1, bf16x8 pa2, bf16x8 pa3) {
  if constexpr (NB == 4) { pv_one<0>(o[0], vb, pa0, pa1, pa2, pa3); pv_one<1>(o[1], vb, pa0, pa1, pa2, pa3); pv_one<2>(o[2], vb, pa0, pa1, pa2, pa3); pv_one<3>(o[3], vb, pa0, pa1, pa2, pa3); }
  else { if (vsel == 0) { pv_one<0>(o[0], vb, pa0, pa1, pa2, pa3); pv_one<1>(o[1], vb, pa0, pa1, pa2, pa3); }
         else { pv_one<2>(o[0], vb, pa0, pa1, pa2, pa3); pv_one<3>(o[1], vb, pa0, pa1, pa2, pa3); } }
}
__device__ __forceinline__ void apply_mask(f32x16& p0, f32x16& p1, int mt, int i, int k0, int hi) {
  if (mt == 0) return;
#pragma unroll
  for (int r = 0; r < 16; ++r) { const int j0 = k0 + crow(r, hi), j1 = j0 + 32;
    const bool ok0 = (mt == 1) && (j0 - i <= SWA_WIN) && (i - j0 <= SWA_WIN), ok1 = (mt == 1) && (j1 - i <= SWA_WIN) && (i - j1 <= SWA_WIN);
    p0[r] = ok0 ? p0[r] : -1e30f; p1[r] = ok1 ? p1[r] : -1e30f; }
}

struct TileMap {
  int nl, tlo, bN, bC;
  __device__ __forceinline__ int row(int t) const { return t < nl ? bN + 64 * (tlo + t) : (t < nl + CTX / 64 ? bC + 64 * (t - nl) : bN + 64 * tlo); }
  __device__ __forceinline__ int mtype(int t) const { return t < nl ? 1 : (t < nl + CTX / 64 ? 0 : 2); }
  __device__ __forceinline__ int key0(int t) const { return 64 * (tlo + (t < nl ? t : 0)); }
};

template <int MODE>
__device__ __forceinline__ void attn_unit(const bf16_t* __restrict__ Pq, const bf16_t* __restrict__ Pk, const bf16_t* __restrict__ Pv, int LD, const TileMap tm, int NT,
                                          float m_init, float l_init, int i0, LAS unsigned char* ldsb, f32x16* o, float& l_out, int tid) {
  constexpr int NB = MODE == 0 ? 4 : 2;
  const int wid = tid >> 6, lane = tid & 63, r32 = lane & 31, hi = lane >> 5, c = wid >> 2;
  char* lds = (char*)ldsb;
  char* V_lds = lds; char* K_lds = lds + 2 * SHM_V;
  float* ws = (float*)(lds + SHM_WS) + wid * 64; float* al_l = ws + 32;
  float m_reg = m_init, l_reg = l_init; bf16x8 qr[4];
#pragma unroll
  for (int d = 0; d < NB; ++d) o[d] = f32x16{};
  const bf16_t* Qw = Pq + (size_t)r32 * LD + hi * 8;
#pragma unroll
  for (int d0 = 0; d0 < 4; ++d0) qr[d0] = *reinterpret_cast<const bf16x8*>(Qw + d0 * 16);
  const int sr = tid >> 4, sc = (tid & 15) * 8, vst0 = v_st(sr, sc), vst1 = v_st(32 + sr, sc);
  const int vb0 = (int)(uintptr_t)V_lds + v_rd_base(lane);
  struct { bf16x8 vs0, vs1, ks0, ks1; } sr_[2];
#define SLOAD(i, t) do { const size_t rb_ = (size_t)tm.row(t); \
    sr_[i].vs0 = *reinterpret_cast<const bf16x8*>(Pv + (rb_ + sr) * LD + sc); sr_[i].vs1 = *reinterpret_cast<const bf16x8*>(Pv + (rb_ + 32 + sr) * LD + sc); \
    sr_[i].ks0 = *reinterpret_cast<const bf16x8*>(Pk + (rb_ + sr) * LD + sc); sr_[i].ks1 = *reinterpret_cast<const bf16x8*>(Pk + (rb_ + 32 + sr) * LD + sc); } while (0)
#define SWRITE(b, i) do { *(bf16x8*)(V_lds + (b) * SHM_V + vst0) = sr_[i].vs0; *(bf16x8*)(V_lds + (b) * SHM_V + vst1) = sr_[i].vs1; const int kc = sc * 2; \
    *(bf16x8*)(K_lds + (b) * SHM_K + KSWZ(sr, kc)) = sr_[i].ks0; *(bf16x8*)(K_lds + (b) * SHM_K + KSWZ(32 + sr, kc)) = sr_[i].ks1; } while (0)
#define SWAIT() asm volatile("s_waitcnt vmcnt(4)" ::: "memory")
#define RESC(a) do { if (__any((a) < 1.f)) { if (hi == 0) al_l[r32] = (a); asm volatile("s_waitcnt lgkmcnt(0)" ::: "memory"); \
    _Pragma("unroll") for (int d = 0; d < NB; ++d) _Pragma("unroll") for (int r = 0; r < 16; ++r) o[d][r] *= al_l[crow(r, hi)]; } } while (0)
#define MASK(P0, P1, t) do { if constexpr (MODE == 1) apply_mask(P0, P1, tm.mtype(t), i0 + r32, tm.key0(t), hi); } while (0)
  f32x16 pA0, pA1, pB0, pB1; float mnA, mnB, alA, alB; bf16x8 pa0, pa1, pa2, pa3;
  constexpr int SE = 0, SO = 1;
  SLOAD(SE, 0); asm volatile("s_waitcnt vmcnt(0)" ::: "memory"); SWRITE(0, SE); __syncthreads();
  qkt(pA0, pA1, K_lds, qr, r32, hi, c); MASK(pA0, pA1, 0); partialSM(pA0, pA1, m_reg, mnA, alA);
  SLOAD(SO, 1); if (2 < NT) SLOAD(SE, 2);
  SWAIT(); SWRITE(1, SO); __syncthreads();
  for (int j = 1; j + 1 < NT; j += 2) {
    SBAR(); qkt(pB0, pB1, K_lds + SHM_K, qr, r32, hi, c);
    finishSM(pA0, pA1, alA, l_reg, pa0, pa1, pa2, pa3); SBAR();
    SLOAD(SO, j + 2); SBAR();
    pv_blocks<NB>(o, vb0, c, pa0, pa1, pa2, pa3); MASK(pB0, pB1, j); partialSM(pB0, pB1, m_reg, mnB, alB);
    __syncthreads(); SWAIT(); SWRITE(0, SE);
    RESC(alB); __syncthreads();
    SBAR(); qkt(pA0, pA1, K_lds, qr, r32, hi, c);
    finishSM(pB0, pB1, alB, l_reg, pa0, pa1, pa2, pa3); SBAR();
    if (j + 3 < NT) SLOAD(SE, j + 3);
    SBAR();
    pv_blocks<NB>(o, vb0 + (int)SHM_V, c, pa0, pa1, pa2, pa3); MASK(pA0, pA1, j + 1); partialSM(pA0, pA1, m_reg, mnA, alA);
    __syncthreads(); SWAIT(); SWRITE(1, SO);
    RESC(alA); __syncthreads();
  }
  SBAR(); qkt(pB0, pB1, K_lds + SHM_K, qr, r32, hi, c);
  finishSM(pA0, pA1, alA, l_reg, pa0, pa1, pa2, pa3); SBAR();
  pv_blocks<NB>(o, vb0, c, pa0, pa1, pa2, pa3); MASK(pB0, pB1, NT - 1); partialSM(pB0, pB1, m_reg, mnB, alB);
  __syncthreads(); RESC(alB);
  finishSM(pB0, pB1, alB, l_reg, pa0, pa1, pa2, pa3); SBAR();
  pv_blocks<NB>(o, vb0 + (int)SHM_V, c, pa0, pa1, pa2, pa3);
  l_out = l_reg;
  asm volatile("s_waitcnt vmcnt(0)" ::: "memory");
  __syncthreads();
#undef SLOAD
#undef SWRITE
#undef SWAIT
#undef RESC
#undef MASK
}

__device__ __forceinline__ void dif_phase(const Params& p, LAS unsigned char* ldsb, int G, int vcu, int tid) {
  const int wid = tid >> 6, lane = tid & 63, r32 = lane & 31, hi = lane >> 5, c = wid >> 2, rg = wid & 3;
  constexpr int NQB = N / 128, NU = B * DIF_H * NQB;
  const float lam = p.scal[0], oscale = p.scal[1];
  for (int L = vcu; L < NU; L += G) {
    const int qb = L % NQB, h = (L / NQB) % DIF_H, b = L / (NQB * DIF_H);
    const int t0 = b * N + qb * 128 + rg * 32;
    TileMap tm; tm.nl = N / 64; tm.tlo = 0; tm.bN = b * N; tm.bC = TL + b * CTX;
    f32x16 o[4]; float l_reg;
    attn_unit<0>(p.P + (size_t)t0 * DIF_IN + h * 128 + c * 64, p.P + DIF_QK + h * 128, p.P + 2 * DIF_QK + h * 128, DIF_IN, tm, (N + CTX) / 64,
                 -1e30f, 0.f, 0, ldsb, o, l_reg, tid);
    char* lds = (char*)ldsb;
    float* ws = (float*)(lds + SHM_WS) + wid * 64;
    float* xb = (float*)lds;
    if (hi == 0) ws[r32] = l_reg;
    asm volatile("s_waitcnt lgkmcnt(0)" ::: "memory");
    float rli[16];
#pragma unroll
    for (int r = 0; r < 16; ++r) rli[r] = __builtin_amdgcn_rcpf(ws[crow(r, hi)]);
    if (c == 1) {
#pragma unroll
      for (int d0 = 0; d0 < 4; ++d0)
#pragma unroll
        for (int r = 0; r < 16; ++r) xb[(rg * 32 + crow(r, hi)) * 128 + d0 * 32 + r32] = o[d0][r] * rli[r];
    }
    __syncthreads();
    if (c == 0) {
      float ss[16];
#pragma unroll
      for (int r = 0; r < 16; ++r) ss[r] = 0.f;
#pragma unroll
      for (int d0 = 0; d0 < 4; ++d0)
#pragma unroll
        for (int r = 0; r < 16; ++r) { const float v = o[d0][r] * rli[r] - lam * xb[(rg * 32 + crow(r, hi)) * 128 + d0 * 32 + r32]; o[d0][r] = v; ss[r] += v * v; }
#pragma unroll
      for (int r = 0; r < 16; ++r) {
#pragma unroll
        for (int sft = 1; sft < 32; sft <<= 1) ss[r] += __shfl_xor(ss[r], sft);
        ss[r] = oscale / sqrtf(ss[r] * (1.f / 128.f) + RMS_EPS); }
#pragma unroll
      for (int d0 = 0; d0 < 4; ++d0) { const float gsub = p.subln_g[d0 * 32 + r32];
#pragma unroll
        for (int r = 0; r < 16; ++r) p.Ymix[(size_t)(t0 + crow(r, hi)) * YW + h * 128 + d0 * 32 + r32] = f2bf(o[d0][r] * ss[r] * gsub); }
    }
    __syncthreads();
  }
}
__device__ __forceinline__ void swa_unit(const Params& p, LAS unsigned char* ldsb, int L, int tid) {
  const int wid = tid >> 6, lane = tid & 63, r32 = lane & 31, hi = lane >> 5;
  constexpr int NUL = TL / 32;
  const float sink_raw = p.sink[wid] * (1.0f / SCALE);
  TileMap tm; int t0, NT, i0;
  if (L < NUL) { const int b = L / (N / 32), qb = L % (N / 32); i0 = qb * 32; t0 = b * N + i0;
    const int lo = i0 - SWA_WIN < 0 ? 0 : i0 - SWA_WIN, hi_ = i0 + 31 + SWA_WIN > N - 1 ? N - 1 : i0 + 31 + SWA_WIN;
    tm.tlo = lo / 64; tm.nl = hi_ / 64 - tm.tlo + 1; tm.bN = b * N; tm.bC = TL + b * CTX; NT = (tm.nl + CTX / 64 + 1) & ~1;
  } else { const int Lc = L - NUL, b = Lc / (CTX / 32), qb = Lc % (CTX / 32); i0 = 0; t0 = TL + b * CTX + qb * 32;
    tm.tlo = 0; tm.nl = 0; tm.bN = b * N; tm.bC = TL + b * CTX; NT = CTX / 64; }
  f32x16 o[2]; float l_reg;
  attn_unit<1>(p.P + (size_t)t0 * AB_IN + wid * 64, p.P + A_KOFF, p.P + A_VOFF, AB_IN, tm, NT, sink_raw, 1.f, i0, ldsb, o, l_reg, tid);
  char* lds = (char*)ldsb;
  float* ws = (float*)(lds + SHM_WS) + wid * 64;
  if (hi == 0) ws[r32] = l_reg;
  asm volatile("s_waitcnt lgkmcnt(0)" ::: "memory");
#pragma unroll
  for (int r = 0; r < 16; ++r) { const float rl = __builtin_amdgcn_rcpf(ws[crow(r, hi)]);
#pragma unroll
    for (int d0 = 0; d0 < 2; ++d0) p.Ymix[(size_t)(t0 + crow(r, hi)) * YW + wid * 64 + d0 * 32 + r32] = f2bf(o[d0][r] * rl); }
  __syncthreads();
}
constexpr int SWA_UNITS = TL / 32 + TC / 32;
}


constexpr int N_TAB16A = 2 * SSM_G * SSM_P * 17;
__device__ __forceinline__ void st_tab16a(const Params& p, int idx) {
  const int k = idx % 17, q = idx / 17, dg = q / SSM_P;
  const float dt = expf(p.log_step[dg]), ar = p.a_re[q], ai = p.a_im[q], mag = expf((float)k * dt * ar), ang = (float)k * dt * ai;
  p.apow16[(size_t)idx * 2] = mag * cosf(ang); p.apow16[(size_t)idx * 2 + 1] = mag * sinf(ang);
}
constexpr int N_TAB16B = 2 * SSM_G * 16 * 256;
__device__ __forceinline__ void st_tab16b(const Params& p, int idx) {
  const int ci = idx % 16, co = (idx / 16) % 16, lag = (idx / 256) % 16, dg = idx / 4096;
  float acc = 0.f;
  for (int pp = 0; pp < SSM_P; ++pp) { const int q = dg * SSM_P + pp;
    const float ar = p.apow16[((size_t)q * 17 + lag) * 2], ai = p.apow16[((size_t)q * 17 + lag) * 2 + 1];
    const float br = p.bbar[((size_t)q * 16 + ci) * 2], bi = p.bbar[((size_t)q * 16 + ci) * 2 + 1];
    const float cr = p.c_re[((size_t)dg * 16 + co) * SSM_P + pp], cim = p.c_im[((size_t)dg * 16 + co) * SSM_P + pp];
    acc += cr * (ar * br - ai * bi) - cim * (ar * bi + ai * br); }
  p.KT16[idx] = acc;
}
constexpr int N_BTY = 2 * SSM_G * 256 * A2K, N_BTE = 2 * SSM_G * 256 * 256;
__device__ __forceinline__ void st_tab16c(const Params& p, int idx) {
  if (idx < N_BTY) {
    const int k = idx % A2K, n = (idx / A2K) % 256, dg = idx / (A2K * 256); const int j = n / 16, co = n % 16;
    float v;
    if (k < 256) { const int j2 = k / 16, ci = k % 16; v = j2 <= j ? p.KT16[(((size_t)dg * 16 + (j - j2)) * 16 + co) * 16 + ci] : 0.f; }
    else { const int pp = (k - 256) % 64, im = (k - 256) / 64, q = dg * SSM_P + pp;
      const float ar = p.apow16[((size_t)q * 17 + j + 1) * 2], ai = p.apow16[((size_t)q * 17 + j + 1) * 2 + 1];
      const float cr = p.c_re[((size_t)dg * 16 + co) * SSM_P + pp], cim = p.c_im[((size_t)dg * 16 + co) * SSM_P + pp];
      v = im ? -(cr * ai + cim * ar) : (cr * ar - cim * ai); }
    p.BtY[idx] = f2bf(v); return; }
  idx -= N_BTY;
  const int k = idx % 256, n = (idx / 256) % 256, dg = idx / 65536; const int j = k / 16, ci = k % 16;
  float v = 0.f;
  if (n < 128) { const int pp = n % 64, im = n / 64, q = dg * SSM_P + pp;
    const float ar = p.apow16[((size_t)q * 17 + (15 - j)) * 2], ai = p.apow16[((size_t)q * 17 + (15 - j)) * 2 + 1];
    const float br = p.bbar[((size_t)q * 16 + ci) * 2], bi = p.bbar[((size_t)q * 16 + ci) * 2 + 1];
    v = im ? (ar * bi + ai * br) : (ar * br - ai * bi); }
  p.BtE[idx] = f2bf(v);
}
struct SsmOrder {
  int first, count, G, c;
  __device__ __forceinline__ bool next(int i, pg8::Unit& u) const { const int L = i * G + c; if (L >= count) return false; u.pm = first + L; u.pn = u.pm / 5; return true; }
  __device__ __forceinline__ void a_ready(const pg8::Unit&) const {}
  __device__ __forceinline__ void done(const pg8::Unit&) const {}
};
struct EpiE {
  static constexpr bool PERM = false;
  float* E;
  __device__ __forceinline__ void operator()(const f32x4 (&acc)[2][2][4][2], const pg8::Unit& u, int wr, int wc, int fr, int fq) const {
    const int row0 = u.pm * 256 + wr * 64 + fr, col0 = wc * 32 + 4 * fq;
#pragma unroll
    for (int ai = 0; ai < 2; ++ai)
#pragma unroll
      for (int m = 0; m < 4; ++m) { float* rowp = E + (size_t)(row0 + ai * 128 + m * 16) * 128 + col0;
#pragma unroll
        for (int n = 0; n < 2; ++n) *(f32x4*)(rowp + n * 16) = acc[ai][0][m][n]; }
  }
};
template <int DIR> struct EpiY {
  static constexpr bool PERM = false;
  float* Ypart; const bf16_t* P0; const float* dskip; bf16_t* Gs;
  __device__ __forceinline__ void operator()(const f32x4 (&acc)[2][2][4][2], const pg8::Unit& u, int wr, int wc, int fr, int fq) const {
    const int grp = u.pm / 5, g = grp % SSM_G, rg0 = (u.pm % 5) * 256 + wr * 64 + fr;
#pragma unroll
    for (int ai = 0; ai < 2; ++ai)
#pragma unroll
      for (int m = 0; m < 4; ++m) { const int rg = rg0 + ai * 128 + m * 16;
        if (rg < B * NCH16) { const int b = rg / NCH16, ch = rg % NCH16;
#pragma unroll
          for (int bj = 0; bj < 2; ++bj)
#pragma unroll
            for (int n = 0; n < 2; ++n) { const int j = 8 * bj + 2 * wc + n, tau = ch * LC + j;
              const int t = ssm_row(DIR, b, tau); const size_t o = (size_t)t * SSM_W + g * 16 + 4 * fq;
              if (DIR == 0) *(f32x4*)(Ypart + o) = acc[ai][bj][m][n];
              else { const f32x4 y0 = *(const f32x4*)(Ypart + o); const f32x4 dk = *(const f32x4*)(dskip + g * 16 + 4 * fq);
                const u32x2 uu = *(const u32x2*)(P0 + (size_t)t * AB_IN + A_UOFF + g * 16 + 4 * fq);
                f32x4 uv; uv.x = __builtin_bit_cast(float, uu.x << 16); uv.y = __builtin_bit_cast(float, uu.x & 0xffff0000u); uv.z = __builtin_bit_cast(float, uu.y << 16); uv.w = __builtin_bit_cast(float, uu.y & 0xffff0000u);
                const f32x4 y = acc[ai][bj][m][n] + y0 + dk * uv; float gl[4];
#pragma unroll
                for (int q = 0; q < 4; ++q) { const float x = y[q], w = 0.7978845608028654f * (x + 0.044715f * x * x * x); gl[q] = x * fast_sigmoid(2.f * w); }
                const u32x2 wv = {cvt_pk_bf16(gl[0], gl[1]), cvt_pk_bf16(gl[2], gl[3])};
                *(u32x2*)(Gs + o) = wv; } } } }
  }
};
__device__ __forceinline__ void ssm_carry_phase(const Params& p, int bx, int G, int tid) {
  for (int idx = bx * NTHR + tid; idx < 2 * SSM_G * B * SSM_P; idx += G * NTHR) {
    const int pp = idx % SSM_P, b = (idx / SSM_P) % B, dg = idx / (SSM_P * B), q = dg * SSM_P + pp;
    const float ar = p.apow16[((size_t)q * 17 + 16) * 2], ai = p.apow16[((size_t)q * 17 + 16) * 2 + 1];
    float sr = 0.f, si = 0.f;
    const size_t row0 = (size_t)dg * GROWS + (size_t)b * NCH16;
#pragma unroll 8
    for (int ch = 0; ch < NCH16; ++ch) { const size_t row = row0 + ch;
      p.A2[row * A2K + 256 + pp] = f2bf(sr); p.A2[row * A2K + 320 + pp] = f2bf(si);
      const float er = p.E16[row * 128 + pp], ei = p.E16[row * 128 + 64 + pp];
      const float nr = ar * sr - ai * si + er, ni = ar * si + ai * sr + ei; sr = nr; si = ni; }
  }
}

#define XB_TMO      128
#define XB_XCNT(j)  (256  + 64 * (j))
#define XB_XSUB(j)  (1280 + 64 * (j))
#define XB_XGEN(j)  (2304 + 64 * (j))
#define XB_TOP      3328
#define XB_TOPGEN   3392
#define XCD_BAR_WORDS 3456
#define XB_SPIN_CAP (1u << 22)
constexpr int CW_BAR = 4096;
__device__ __forceinline__ unsigned xb_ld(unsigned* p)              { return __hip_atomic_load(p, __ATOMIC_RELAXED, __HIP_MEMORY_SCOPE_AGENT); }
__device__ __forceinline__ unsigned xb_add(unsigned* p, unsigned v) { return __hip_atomic_fetch_add(p, v, __ATOMIC_RELAXED, __HIP_MEMORY_SCOPE_AGENT); }
__device__ __forceinline__ unsigned xb_xcc_id() { return (unsigned)__builtin_amdgcn_s_getreg((3 << 11) | 20) & 0xFu; }
#define XB_SPIN(cond, bar) do { unsigned _sp = 0; while (cond) { __builtin_amdgcn_s_sleep(1); \
    if ((++_sp & 255u) == 0u) { if (xb_ld(&(bar)[XB_TMO])) break; if (_sp > XB_SPIN_CAP) { atomicAdd(&(bar)[XB_TMO], 1u); break; } } } } while (0)
struct XcdBarrier { unsigned* bar; unsigned x; volatile LAS unsigned* st; };
__device__ __forceinline__ XcdBarrier xcd_barrier_post(unsigned* bar, volatile LAS unsigned* st) {
  XcdBarrier b; b.bar = bar; b.x = xb_xcc_id(); b.st = st;
  if (threadIdx.x == 0) (void)xb_add(&bar[XB_XCNT(b.x)], 1u);
  return b;
}
__device__ __forceinline__ void xcd_barrier_complete(unsigned* bar, unsigned x, unsigned& nloc, unsigned& nx) {
  const unsigned G = gridDim.x * gridDim.y * gridDim.z;
  unsigned sum, cnt, mine, sp = 0u;
  for (;;) {
    sum = 0u; cnt = 0u; mine = 0u;
#pragma unroll
    for (unsigned j = 0; j < 16; ++j) { const unsigned c = xb_ld(&bar[XB_XCNT(j)]); sum += c; cnt += (c > 0u) ? 1u : 0u; mine = (j == x) ? c : mine; }
    if (sum == G) break;
    __builtin_amdgcn_s_sleep(1);
    if ((++sp & 255u) == 0u) { if (xb_ld(&bar[XB_TMO])) break; if (sp > XB_SPIN_CAP) { atomicAdd(&bar[XB_TMO], 1u); break; } }
  }
  nloc = mine > 0u ? mine : 1u; nx = cnt > 0u ? cnt : 1u;
}
__device__ __forceinline__ void xcd_barrier(const XcdBarrier& b) {
  asm volatile("s_waitcnt vmcnt(0)" ::: "memory");
  __syncthreads();
  if (threadIdx.x == 0) {
    unsigned* bar = b.bar;
    __builtin_amdgcn_s_waitcnt(0);
    unsigned nloc = b.st[0], nx = b.st[1];
    if (nloc == 0u) { xcd_barrier_complete(bar, b.x, nloc, nx); b.st[0] = nloc; b.st[1] = nx; }
    const unsigned old = xb_add(&bar[XB_XSUB(b.x)], 1u);
    const unsigned gen = old / nloc;
    if (old + 1u == (gen + 1u) * nloc) {
      __builtin_amdgcn_fence(__ATOMIC_RELEASE, "agent");
      asm volatile("s_waitcnt vmcnt(0)" ::: "memory");
      const unsigned og = xb_add(&bar[XB_TOP], 1u);
      const unsigned tg = og / nx;
      if (og + 1u == (tg + 1u) * nx) xb_add(&bar[XB_TOPGEN], 1u);
      else XB_SPIN(xb_ld(&bar[XB_TOPGEN]) == tg, bar);
      __builtin_amdgcn_fence(__ATOMIC_ACQUIRE, "agent");
      xb_add(&bar[XB_XGEN(b.x)], 1u);
      asm volatile("s_waitcnt vmcnt(0)" ::: "memory");
    } else {
      XB_SPIN(xb_ld(&bar[XB_XGEN(b.x)]) == gen, bar);
      __builtin_amdgcn_fence(__ATOMIC_ACQUIRE, "agent");
      asm volatile("s_waitcnt vmcnt(0)" ::: "memory");
    }
  }
  __syncthreads();
}

__device__ __forceinline__ unsigned pk2(float lo, float hi) { return (unsigned)f2bf(lo) | ((unsigned)f2bf(hi) << 16); }
struct TrItem { const float* W; int N, K, k0, n0, dst_row0; };
__device__ __forceinline__ void tr_load(const TrItem& it, f32x4 (&r)[8], int lane) {
#pragma unroll
  for (int i = 0; i < 8; ++i) r[i] = *(const f32x4*)(it.W + (size_t)(it.k0 + (lane >> 3) + 8 * i) * it.N + it.n0 + 4 * (lane & 7));
}
__device__ __forceinline__ void tr_store(const TrItem& it, const f32x4 (&r)[8], bf16_t* WT, LAS float* scr, int lane) {
#pragma unroll
  for (int i = 0; i < 8; ++i) { LAS float* d = scr + ((lane >> 3) + 8 * i) * 33 + 4 * (lane & 7); d[0] = r[i].x; d[1] = r[i].y; d[2] = r[i].z; d[3] = r[i].w; }
  LDS_WAIT(); asm volatile("" ::: "memory");
  const int c = lane & 7;
#pragma unroll
  for (int j = 0; j < 4; ++j) { const int n = (lane >> 3) + 8 * j; const LAS float* sp = scr + (8 * c) * 33 + n;
    u32x4 o; o.x = pk2(sp[0 * 33], sp[1 * 33]); o.y = pk2(sp[2 * 33], sp[3 * 33]); o.z = pk2(sp[4 * 33], sp[5 * 33]); o.w = pk2(sp[6 * 33], sp[7 * 33]);
    *(u32x4*)(WT + (size_t)(it.dst_row0 + n) * it.K + it.k0 + 8 * c) = o; }
  LDS_WAIT(); asm volatile("" ::: "memory");
}
__device__ __forceinline__ void transpose_matrix(const float* W, int K, int N, bf16_t* WT, LAS float* scr, int gw, int ngw, int lane) {
  const int nblk = N / 32, items = (K / 64) * nblk;
  f32x4 ra[8], rb[8]; TrItem ia, ib;
  int it = gw;
  if (it < items) { ia = TrItem{W, N, K, 64 * (it / nblk), 32 * (it % nblk), 32 * (it % nblk)}; tr_load(ia, ra, lane); }
  while (it < items) {
    const int nx = it + ngw;
    if (nx < items) { ib = TrItem{W, N, K, 64 * (nx / nblk), 32 * (nx % nblk), 32 * (nx % nblk)}; tr_load(ib, rb, lane); }
    tr_store(ia, ra, WT, scr, lane);
    if (nx < items) { ia = ib;
#pragma unroll
      for (int i = 0; i < 8; ++i) ra[i] = rb[i]; }
    it = nx;
  }
}
__device__ __forceinline__ void mod_row_to_bf16(const float* xr, const float* sc, const float* sh, bf16_t* orow, int lane) {
  const f32x4* x4 = (const f32x4*)xr + lane; const f32x4* c4 = (const f32x4*)sc + lane; const f32x4* h4 = (const f32x4*)sh + lane;
  unsigned long long* o8 = (unsigned long long*)orow + lane;
#pragma unroll
  for (int j = 0; j < 4; ++j) { const f32x4 v = x4[64 * j], c = c4[64 * j], h = h4[64 * j];
    const float a = v.x * (1.f + c.x) + h.x, b = v.y * (1.f + c.y) + h.y, cc = v.z * (1.f + c.z) + h.z, d = v.w * (1.f + c.w) + h.w;
    o8[64 * j] = (unsigned long long)pk2(a, b) | ((unsigned long long)pk2(cc, d) << 32); }
}


__device__ __forceinline__ float wave_sum(float v) {
#pragma unroll
  for (int o = 1; o < 64; o <<= 1) v += __shfl_xor(v, o);
  return v;
}
constexpr int CW_CNT = 8192;
#define CNT_WORD(layer, e) (CW_CNT + 64 * (MOE_E * (layer) + (e)))
#define LD4(dst, ptr) do { const f32x4* p4_ = (const f32x4*)(ptr) + lane; _Pragma("unroll") for (int j = 0; j < 4; ++j) dst[j] = p4_[64 * j]; } while (0)
constexpr int RT_CNT = 0, RT_WG = 256, RT_WE = RT_WG + D * 8;
__device__ __forceinline__ int rt_slot(int k) { return ((k & 3) * 4 + (k >> 8)) * 64 + ((k >> 2) & 63); }
__device__ __forceinline__ float bflo(unsigned w) { return __builtin_bit_cast(float, w << 16); }
__device__ __forceinline__ float bfhi(unsigned w) { return __builtin_bit_cast(float, w & 0xffff0000u); }
__device__ __forceinline__ void ln1_phase(const Params& p, int layer, int T, LAS unsigned char* lds, int gw, int ngw, int vcu, int lane, int tid) {
  LAS int* cnt_l = (LAS int*)(lds + RT_CNT);
  if (tid < MOE_E) cnt_l[tid] = 0;
  { const float* wg = p.moe_wg + (size_t)layer * D * MOE_G; const float* we = p.moe_we + (size_t)layer * MOE_G * D * MOE_EPG;
    for (int k = tid; k < D; k += NTHR) { const f32x4 w = *(const f32x4*)(wg + (size_t)k * 4); u32x2 o = {pk2(w.x, w.y), pk2(w.z, w.w)}; *(LAS u32x2*)(lds + RT_WG + rt_slot(k) * 8) = o; }
    for (int i = tid; i < MOE_G * D; i += NTHR) { const int g = i / D, k = i % D; const f32x4 a = *(const f32x4*)(we + (size_t)i * 8), b = *(const f32x4*)(we + (size_t)i * 8 + 4);
      u32x4 o = {pk2(a.x, a.y), pk2(a.z, a.w), pk2(b.x, b.y), pk2(b.z, b.w)}; *(LAS u32x4*)(lds + RT_WE + (g * D + rt_slot(k)) * 16) = o; } }
  __syncthreads();
  const int rpw = (T + ngw - 1) / ngw, t0 = gw * rpw;
  f32x4 g1[4], lg[4], lb[4], sc[4], sh[4]; int cur_r = -1;
  LD4(lg, p.ln1_g + (size_t)layer * D); LD4(lb, p.ln1_b + (size_t)layer * D);
  const int tend = (t0 + rpw < T) ? t0 + rpw : T;
#define LDY(dst, tt) do { const u32x2* y2_ = (const u32x2*)((const bf16_t*)p.F + (size_t)(tt) * D) + lane; _Pragma("unroll") for (int j = 0; j < 4; ++j) dst[j] = y2_[64 * j]; } while (0)
#define LDX16(dst, base, tt) do { const u32x2* x2_ = (const u32x2*)((const bf16_t*)(base) + (size_t)(tt) * D) + lane; _Pragma("unroll") for (int j = 0; j < 4; ++j) { const u32x2 w_ = x2_[64 * j]; dst[j] = (f32x4){bflo(w_.x), bfhi(w_.x), bflo(w_.y), bfhi(w_.y)}; } } while (0)
#define LDXR(dst, tt) do { if (layer == 0) LD4(dst, xrow(p, 0, tt)); else LDX16(dst, p.X, tt); } while (0)
  f32x4 xn[4]; u32x2 yn[4];
  if (t0 < tend) { LDXR(xn, t0); LDY(yn, t0); }
  for (int t = t0; t < tend; ++t) {
    const int r = tok_r(t);
    if (r != cur_r) { cur_r = r; LD4(g1, modp(p, layer, r, 2)); LD4(sc, modp(p, layer, r, 4)); LD4(sh, modp(p, layer, r, 3)); }
    f32x4 v[4], y[4];
#pragma unroll
    for (int j = 0; j < 4; ++j) { v[j] = xn[j]; y[j] = (f32x4){bflo(yn[j].x), bfhi(yn[j].x), bflo(yn[j].y), bfhi(yn[j].y)}; }
    if (t + 1 < tend) { LDXR(xn, t + 1); LDY(yn, t + 1); }
    float s = 0.f;
#pragma unroll
    for (int j = 0; j < 4; ++j) { v[j] = v[j] * ALPHA + g1[j] * y[j]; s += (v[j].x + v[j].y) + (v[j].z + v[j].w); }
    const float mean = wave_sum(s) * (1.f / D); float s2 = 0.f;
#pragma unroll
    for (int j = 0; j < 4; ++j) { v[j] = v[j] - mean; s2 += (v[j].x * v[j].x + v[j].y * v[j].y) + (v[j].z * v[j].z + v[j].w * v[j].w); }
    const float rstd = 1.f / sqrtf(wave_sum(s2) * (1.f / D) + LN_EPS);
    u32x2* o2 = (u32x2*)((bf16_t*)p.X1 + (size_t)t * D) + lane;
#pragma unroll
    for (int j = 0; j < 4; ++j) { v[j] = v[j] * rstd * lg[j] + lb[j]; o2[64 * j] = (u32x2){cvt_pk_bf16(v[j].x, v[j].y), cvt_pk_bf16(v[j].z, v[j].w)}; v[j] = v[j] * (sc[j] + 1.f) + sh[j]; }
    f32x4 gl = {0.f, 0.f, 0.f, 0.f};
#pragma unroll
    for (int j = 0; j < 4; ++j)
#pragma unroll
      for (int c = 0; c < 4; ++c) { const u32x2 w = *(const LAS u32x2*)(lds + RT_WG + ((4 * c + j) * 64 + lane) * 8); const float h = v[j][c];
        gl.x += h * bflo(w.x); gl.y += h * bfhi(w.x); gl.z += h * bflo(w.y); gl.w += h * bfhi(w.y); }
    float lgv[4];
#pragma unroll
    for (int g = 0; g < 4; ++g) lgv[g] = wave_sum(gl[g]) + p.moe_bg[layer * MOE_G + g];
    int gi = 0; float mx = lgv[0];
#pragma unroll
    for (int g = 1; g < 4; ++g) if (lgv[g] > mx) { mx = lgv[g]; gi = g; }
    float den = 0.f;
#pragma unroll
    for (int g = 0; g < 4; ++g) den += __expf(lgv[g] - mx);
    const float gp = 1.0f / den;
    gi = __builtin_amdgcn_readfirstlane(gi);
    f32x4 e0 = {0.f, 0.f, 0.f, 0.f}, e1 = {0.f, 0.f, 0.f, 0.f};
#pragma unroll
    for (int j = 0; j < 4; ++j)
#pragma unroll
      for (int c = 0; c < 4; ++c) { const u32x4 w = *(const LAS u32x4*)(lds + RT_WE + (gi * D + (4 * c + j) * 64 + lane) * 16); const float h = v[j][c];
        e0.x += h * bflo(w.x); e0.y += h * bfhi(w.x); e0.z += h * bflo(w.y); e0.w += h * bfhi(w.y);
        e1.x += h * bflo(w.z); e1.y += h * bfhi(w.z); e1.z += h * bflo(w.w); e1.w += h * bfhi(w.w); }
    float le[8];
#pragma unroll
    for (int e = 0; e < 4; ++e) { le[e] = wave_sum(e0[e]) + p.moe_be[(layer * MOE_G + gi) * MOE_EPG + e]; le[4 + e] = wave_sum(e1[e]) + p.moe_be[(layer * MOE_G + gi) * MOE_EPG + 4 + e]; }
    int i0 = 0; float v0 = le[0];
#pragma unroll
    for (int e = 1; e < 8; ++e) if (le[e] > v0) { v0 = le[e]; i0 = e; }
    int i1 = -1; float v1 = -3e38f;
#pragma unroll
    for (int e = 0; e < 8; ++e) if (e != i0 && le[e] > v1) { v1 = le[e]; i1 = e; }
    if (lane == 0) {
      const float ex = __expf(v1 - v0);
      const int ea = gi * MOE_EPG + i0, eb = gi * MOE_EPG + i1;
      const int pa = __hip_atomic_fetch_add(cnt_l + ea, 1, __ATOMIC_RELAXED, __HIP_MEMORY_SCOPE_WORKGROUP), pb = __hip_atomic_fetch_add(cnt_l + eb, 1, __ATOMIC_RELAXED, __HIP_MEMORY_SCOPE_WORKGROUP);
      float* rt = p.route + (size_t)t * 8;
      rt[0] = (float)ea; rt[1] = (float)eb; rt[2] = gp / (1.0f + ex); rt[3] = gp * ex / (1.0f + ex); rt[4] = (float)pa; rt[5] = (float)pb;
    }
  }
  __syncthreads();
  if (tid < MOE_E) { const int c = cnt_l[tid];
    const int base = c ? (int)__hip_atomic_fetch_add(p.ctl + CNT_WORD(layer, tid), (unsigned)c, __ATOMIC_RELAXED, __HIP_MEMORY_SCOPE_AGENT) : 0;
    p.wgbase[((size_t)layer * 1024 + vcu) * MOE_E + tid] = base; }
}
__device__ __forceinline__ void scatter_phase(const Params& p, int layer, int T, LAS unsigned char* lds, int gw, int ngw, int vcu, int lane, int tid) {
  LAS int* off = (LAS int*)lds;
  if (tid == 0) {
    int o = 0, ntile = 0;
    for (int e = 0; e < MOE_E; ++e) { const int c = (int)__hip_atomic_load(p.ctl + CNT_WORD(layer, e), __ATOMIC_RELAXED, __HIP_MEMORY_SCOPE_AGENT);
      off[e] = o + p.wgbase[((size_t)layer * 1024 + vcu) * MOE_E + e]; const int nt = (c + 255) >> 8;
      if (blockIdx.x == 0) for (int i = 0; i < nt; ++i) p.moe_meta[1 + ntile + i] = e;
      ntile += nt; o += nt * 256; }
    if (blockIdx.x == 0) p.moe_meta[0] = ntile;
  }
  __syncthreads();
  const int rpw = (T + ngw - 1) / ngw, t0 = gw * rpw;
  f32x4 sc[4], sh[4]; int cur_r = -1;
  const int tend = (t0 + rpw < T) ? t0 + rpw : T;
  f32x4 xn[4]; f32x4 rn0 = {0.f, 0.f, 0.f, 0.f}; f32x2 rn1 = {0.f, 0.f};
  if (t0 < tend) { LDX16(xn, p.X1, t0); rn0 = *(const f32x4*)(p.route + (size_t)t0 * 8); rn1 = *(const f32x2*)(p.route + (size_t)t0 * 8 + 4); }
  for (int t = t0; t < tend; ++t) {
    const int r = tok_r(t);
    if (r != cur_r) { cur_r = r; LD4(sc, modp(p, layer, r, 4)); LD4(sh, modp(p, layer, r, 3)); }
    const int ea = (int)rn0.x, eb = (int)rn0.y; const float wa = rn0.z, wb = rn0.w;
    const int sa = off[ea] + (int)rn1.x, sb = off[eb] + (int)rn1.y;
    f32x4 x[4];
#pragma unroll
    for (int j = 0; j < 4; ++j) x[j] = xn[j];
    if (t + 1 < tend) { LDX16(xn, p.X1, t + 1); rn0 = *(const f32x4*)(p.route + (size_t)(t + 1) * 8); rn1 = *(const f32x2*)(p.route + (size_t)(t + 1) * 8 + 4); }
    unsigned long long* oa = (unsigned long long*)(p.Amoe + (size_t)sa * D) + lane; unsigned long long* ob = (unsigned long long*)(p.Amoe + (size_t)sb * D) + lane;
#pragma unroll
    for (int j = 0; j < 4; ++j) { const f32x4 h = x[j] * (sc[j] + 1.f) + sh[j];
      const unsigned long long w = (unsigned long long)pk2(h.x, h.y) | ((unsigned long long)pk2(h.z, h.w) << 32); oa[64 * j] = w; ob[64 * j] = w; }
    if (lane == 0) { p.gate[sa] = wa; p.gate[sb] = wb; p.tokslot[2 * t] = sa; p.tokslot[2 * t + 1] = sb; }
  }
}
__device__ __forceinline__ void ln2_phase(const Params& p, int layer, int T, int gw, int ngw, int lane) {
  const int rpw = (T + ngw - 1) / ngw, t0 = gw * rpw;
  f32x4 g2[4], lg[4], lb[4], sc[4], sh[4]; int cur_r = -1;
  LD4(lg, p.ln2_g + (size_t)layer * D); LD4(lb, p.ln2_b + (size_t)layer * D);
  const int tend = (t0 + rpw < T) ? t0 + rpw : T;
  const int myslot = (2 * t0 + lane < 2 * tend) ? p.tokslot[2 * t0 + lane] : 0;
  f32x4 xn[4]; u32x2 an[4], bn[4];
#define LDF2(tt) do { const int sa_ = __shfl(myslot, 2 * ((tt) - t0)), sb_ = __shfl(myslot, 2 * ((tt) - t0) + 1); \
    const u32x2* fa_ = (const u32x2*)(p.F2 + (size_t)sa_ * D) + lane; const u32x2* fb_ = (const u32x2*)(p.F2 + (size_t)sb_ * D) + lane; \
    _Pragma("unroll") for (int j = 0; j < 4; ++j) { an[j] = fa_[64 * j]; bn[j] = fb_[64 * j]; } LDX16(xn, p.X1, tt); } while (0)
  if (t0 < tend) LDF2(t0);
  for (int t = t0; t < tend; ++t) {
    const int r = tok_r(t);
    if (r != cur_r) { cur_r = r; LD4(g2, modp(p, layer, r, 5)); if (layer + 1 < DEPTH) { LD4(sc, modp(p, layer + 1, r, 1)); LD4(sh, modp(p, layer + 1, r, 0)); } }
    f32x4 v[4]; u32x2 fa[4], fb[4];
#pragma unroll
    for (int j = 0; j < 4; ++j) { v[j] = xn[j]; fa[j] = an[j]; fb[j] = bn[j]; }
    if (t + 1 < tend) LDF2(t + 1);
    float s = 0.f;
#pragma unroll
    for (int j = 0; j < 4; ++j) { const u32x2 a = fa[j], b = fb[j];
      f32x4 f; f.x = bflo(a.x) + bflo(b.x); f.y = bfhi(a.x) + bfhi(b.x); f.z = bflo(a.y) + bflo(b.y); f.w = bfhi(a.y) + bfhi(b.y);
      v[j] = v[j] * ALPHA + g2[j] * f; s += (v[j].x + v[j].y) + (v[j].z + v[j].w); }
    const float mean = wave_sum(s) * (1.f / D); float s2 = 0.f;
#pragma unroll
    for (int j = 0; j < 4; ++j) { v[j] = v[j] - mean; s2 += (v[j].x * v[j].x + v[j].y * v[j].y) + (v[j].z * v[j].z + v[j].w * v[j].w); }
    const float rstd = 1.f / sqrtf(wave_sum(s2) * (1.f / D) + LN_EPS);
    if (layer == DEPTH - 1) {
      f32x4* o4 = (f32x4*)(p.out + (size_t)t * D) + lane;
#pragma unroll
      for (int j = 0; j < 4; ++j) o4[64 * j] = v[j] * rstd * lg[j] + lb[j];
    } else {
      u32x2* o2 = (u32x2*)((bf16_t*)p.X + (size_t)t * D) + lane;
      unsigned long long* h8 = (unsigned long long*)(p.H + (size_t)t * D) + lane;
#pragma unroll
      for (int j = 0; j < 4; ++j) { const f32x4 o = v[j] * rstd * lg[j] + lb[j]; o2[64 * j] = (u32x2){cvt_pk_bf16(o.x, o.y), cvt_pk_bf16(o.z, o.w)};
        const f32x4 h = o * (sc[j] + 1.f) + sh[j];
        h8[64 * j] = (unsigned long long)pk2(h.x, h.y) | ((unsigned long long)pk2(h.z, h.w) << 32); }
    }
  }
#undef LDF2
}
__device__ __forceinline__ void h0_phase(const Params& p, int gw, int ngw, int lane) {
  const int rpw = (TA + ngw - 1) / ngw, t0 = gw * rpw;
  f32x4 sc[4], sh[4]; int cur_r = -1;
  const int tend = (t0 + rpw < TA) ? t0 + rpw : TA;
  f32x4 xn[4], xm[4];
  if (t0 < tend) LD4(xn, xrow(p, 0, t0));
  if (t0 + 1 < tend) LD4(xm, xrow(p, 0, t0 + 1));
  for (int t = t0; t < tend; ++t) {
    const int r = tok_r(t);
    if (r != cur_r) { cur_r = r; LD4(sc, modp(p, 0, r, 1)); LD4(sh, modp(p, 0, r, 0)); }
    f32x4 x[4];
#pragma unroll
    for (int j = 0; j < 4; ++j) { x[j] = xn[j]; xn[j] = xm[j]; }
    if (t + 2 < tend) LD4(xm, xrow(p, 0, t + 2));
    unsigned long long* h8 = (unsigned long long*)(p.H + (size_t)t * D) + lane;
#pragma unroll
    for (int j = 0; j < 4; ++j) { const f32x4 h = x[j] * (sc[j] + 1.f) + sh[j]; h8[64 * j] = (unsigned long long)pk2(h.x, h.y) | ((unsigned long long)pk2(h.z, h.w) << 32); }
  }
}
__device__ __forceinline__ void moe_item(const Params& p, int layer, int it, TrItem& ti, bf16_t*& WT) {
  constexpr int I13 = (D / 64) * (MOE_F / 32), I2 = (MOE_F / 64) * (D / 32);
  const int e = it / (2 * I13 + I2); int r = it % (2 * I13 + I2);
  if (r < 2 * I13) { const int which = r / I13; r %= I13; const int kb = r / (MOE_F / 32), nb = r % (MOE_F / 32), n0 = 32 * nb;
    ti = TrItem{(which ? p.moe_w3 : p.moe_w1) + ((size_t)layer * MOE_E + e) * D * MOE_F, MOE_F, D, 64 * kb, n0, e * 2 * MOE_F + (n0 / 128) * 256 + which * 128 + (n0 % 128)}; WT = p.W13t;
  } else { r -= 2 * I13; const int kb = r / (D / 32), nb = r % (D / 32);
    ti = TrItem{p.moe_w2 + ((size_t)layer * MOE_E + e) * MOE_F * D, D, MOE_F, 64 * kb, 32 * nb, e * D + 32 * nb}; WT = p.W2t; }
}
__device__ __forceinline__ void moe_weight_transposes(const Params& p, int layer, LAS float* scr, int gw, int ngw, int lane) {
  constexpr int NIT = MOE_E * (2 * (D / 64) * (MOE_F / 32) + (MOE_F / 64) * (D / 32));
  f32x4 ra[8], rb[8]; TrItem ia, ib; bf16_t *wa = nullptr, *wb = nullptr;
  int it = gw;
  if (it < NIT) { moe_item(p, layer, it, ia, wa); tr_load(ia, ra, lane); }
  while (it < NIT) {
    const int nx = it + ngw;
    if (nx < NIT) { moe_item(p, layer, nx, ib, wb); tr_load(ib, rb, lane); }
    tr_store(ia, ra, wa, scr, lane);
    if (nx < NIT) { ia = ib; wa = wb;
#pragma unroll
      for (int i = 0; i < 8; ++i) ra[i] = rb[i]; }
    it = nx;
  }
}
__device__ __forceinline__ void mod_phase(const Params& p, LAS unsigned char* lds, int vcu, int G, int tid, int lane, int wave) {
  constexpr int NR = B + 1, RP = 12;
  LAS float* sT = (LAS float*)lds;
  LAS float* part = sT + D * RP;
  for (int i = tid; i < NR * D; i += NTHR) { const int r = i / D, k = i % D; const float c = r < B ? p.c[(size_t)r * D + k] : p.c_ctx[k]; sT[k * RP + r] = c / (1.0f + __expf(-c)); }
  __syncthreads();
  constexpr int NT_ = DEPTH * (6 * D / 64);
  for (int task = vcu; task < NT_; task += G) {
    const int l = task / (6 * D / 64), j = (task % (6 * D / 64)) * 64 + lane;
    const float* w = p.mod_w + (size_t)l * D * 6 * D + (size_t)(wave * 128) * 6 * D + j;
    float acc[NR];
#pragma unroll
    for (int r = 0; r < NR; ++r) acc[r] = 0.f;
#pragma unroll 1
    for (int k0 = 0; k0 < 128; k0 += 16) {
      float wv[16];
#pragma unroll
      for (int u = 0; u < 16; ++u) wv[u] = w[(size_t)(k0 + u) * 6 * D];
#pragma unroll
      for (int u = 0; u < 16; ++u) { const LAS float* sr = sT + (wave * 128 + k0 + u) * RP;
        const f32x4 s0 = *(const LAS f32x4*)sr, s1 = *(const LAS f32x4*)(sr + 4); const float s8 = sr[8];
        acc[0] += s0.x * wv[u]; acc[1] += s0.y * wv[u]; acc[2] += s0.z * wv[u]; acc[3] += s0.w * wv[u];
        acc[4] += s1.x * wv[u]; acc[5] += s1.y * wv[u]; acc[6] += s1.z * wv[u]; acc[7] += s1.w * wv[u]; acc[8] += s8 * wv[u]; }
    }
#pragma unroll
    for (int r = 0; r < NR; ++r) part[(wave * NR + r) * 64 + lane] = acc[r];
    __syncthreads();
    for (int i = tid; i < NR * 64; i += NTHR) { const int r = i / 64, c = i % 64; float v = p.mod_b[(size_t)l * 6 * D + (task % (6 * D / 64)) * 64 + c];
#pragma unroll
      for (int ww = 0; ww < 8; ++ww) v += part[(ww * NR + r) * 64 + c];
      p.modv[((size_t)(l * NR + r) * 6 * D) + (task % (6 * D / 64)) * 64 + c] = v; }
    __syncthreads();
  }
}

__global__ void __launch_bounds__(NTHR, 2) mega_kernel(Params p_by_value) {
  const Params& p = *(const Params*)__builtin_amdgcn_kernarg_segment_ptr();
  extern __shared__ __attribute__((aligned(16))) unsigned char lds_raw[];
  LAS unsigned char* lds = (LAS unsigned char*)lds_raw;
  volatile LAS unsigned* MISC = (volatile LAS unsigned*)(lds + MISC_OFF);
  for (int u = threadIdx.x; u < (LDS_BYTES - LDSCTL_OFF) / 4; u += NTHR) ((LAS unsigned*)(lds + LDSCTL_OFF))[u] = 0u;
  __syncthreads();
  XcdBarrier bar = xcd_barrier_post(p.ctl + CW_BAR, MISC + 8);
#define PH_VARS                                                                                                       \
  int tid = threadIdx.x; asm volatile("" : "+v"(tid));                                                                \
  int bx = blockIdx.x; asm volatile("" : "+s"(bx));                                                                   \
  const int lane = tid & 63, wave = __builtin_amdgcn_readfirstlane(tid >> 6), G = gridDim.x;                          \
  const int vcu = (G % 8 == 0) ? (bx % 8) * (G / 8) + bx / 8 : bx;                                                    \
  const int gw = vcu * NWAVES + wave, ngw = G * NWAVES;                                                               \
  LAS float* scr = (LAS float*)(lds + wave * 16384);                                                                  \
  (void)lane; (void)gw; (void)ngw; (void)scr; (void)vcu;
#define GRID_BAR() xcd_barrier(bar)
#define RUN_NAIVE(S, layer, cnt)                                                                                  \
  {                                                                                                               \
    const int n_ = (cnt);                                                                                         \
    PH_VARS                                                                                                       \
    for (int idx = bx * NTHR + tid; idx < n_; idx += G * NTHR) run_elem<S>(p, layer, idx);                        \
  }

  { PH_VARS mod_phase(p, lds, vcu, G, tid, lane, wave); }
  RUN_NAIVE(S_TABA, 0, N_TABA)
  { PH_VARS for (int idx = bx * NTHR + tid; idx < N_TAB16A; idx += G * NTHR) st_tab16a(p, idx); }
  { PH_VARS
  transpose_matrix(p.w_in_a, D, AB_IN, p.WinA_t, scr, gw, ngw, lane);
  transpose_matrix(p.dif_w_in, D, DIF_IN, p.DifIn_t, scr, gw, ngw, lane);
  transpose_matrix(p.w_out_a, AB_OUT, D, p.WoutA_t, scr, gw, ngw, lane);
  transpose_matrix(p.dif_w_out, DIF_VW, D, p.DifOut_t, scr, gw, ngw, lane);
  transpose_matrix(p.glu_w, SSM_W, SSM_W, p.Glu_t, scr, gw, ngw, lane); }
  GRID_BAR();
  { PH_VARS for (int idx = bx * NTHR + tid; idx < N_TAB16B; idx += G * NTHR) st_tab16b(p, idx); }
  { PH_VARS h0_phase(p, gw, ngw, lane); }
  GRID_BAR();
#define LAYER_BACK(layer, T, WOT_, KO_)                                                                                 \
  { PH_VARS                                                                    \
    pg8::Gemm g{p.Ymix, WOT_, YW, KO_, KO_};                                                                            \
    pg8::StaticOrder S; S.init(T, D, G, bx);                                                                            \
    EpiBf16Out E{(bf16_t*)p.F, D, 0};                                                                                   \
    pg8::gemm_phase<EpiBf16Out, pg8::StaticOrder>(lds, g, S, E);                                                        \
  }                                                                                                                     \
  GRID_BAR();                                                                                                           \
  { PH_VARS ln1_phase(p, layer, T, lds, gw, ngw, vcu, lane, tid); }                                                      \
  GRID_BAR();                                                                                                           \
  { PH_VARS scatter_phase(p, layer, T, lds, gw, ngw, vcu, lane, tid); }                                                 \
  GRID_BAR();                                                                                                           \
  { PH_VARS                                                             \
    pg8::Gemm g{p.Amoe, p.W13t, D, D, D};                                                                               \
    MoeOrder S{p.moe_meta, 2, G, vcu};                                                                                  \
    EpiMoe1 E{p.HHb, p.gate};                                                                                           \
    pg8::gemm_phase<EpiMoe1, MoeOrder>(lds, g, S, E);                                                                   \
  }                                                                                                                     \
  GRID_BAR();                                                                                                           \
  { PH_VARS                                                                                  \
    pg8::Gemm g{p.HHb, p.W2t, MOE_F, MOE_F, MOE_F};                                                                     \
    MoeOrder S{p.moe_meta, 4, G, vcu};                                                                                  \
    EpiBf16Out E{p.F2, D, 4};                                                                                           \
    pg8::gemm_phase<EpiBf16Out, MoeOrder>(lds, g, S, E);                                                                \
  }                                                                                                                     \
  GRID_BAR();                                                                                                           \
  { PH_VARS ln2_phase(p, layer, T, gw, ngw, lane); }
#define SWA_IF(cond, rank, first, cnt) { if (G == 256 && (cond) && (rank) < (cnt)) att::swa_unit(p, lds, (first) + (rank), tid); }

  { PH_VARS for (int idx = bx * NTHR + tid; idx < N_BTY + N_BTE; idx += G * NTHR) st_tab16c(p, idx); }
  { PH_VARS
    pg8::Gemm g{p.H, p.WinA_t, D, D, D};
    pg8::StaticOrder S; S.init(TA, AB_IN, G, bx);
    EpiProj E{p.P, AB_IN, SWA_QW + SWA_KVW, p.ropeT, p.A2};
    pg8::gemm_phase<EpiProj, pg8::StaticOrder>(lds, g, S, E);
    constexpr int NU_ = (TA / 256) * (AB_IN / 256);
    const int nlast = NU_ % G;
    if (nlast == 0) moe_weight_transposes(p, 0, scr, gw, ngw, lane);
    else if (bx >= nlast) moe_weight_transposes(p, 0, scr, (bx - nlast) * NWAVES + wave, (G - nlast) * NWAVES, lane);
  }
  GRID_BAR();
  { PH_VARS
    pg8::Gemm g{p.A2, p.BtE, A2K, 256, 256};
    SsmOrder S{0, 2 * SSM_G * 5, G, vcu};
    EpiE E{p.E16};
    pg8::gemm_phase<EpiE, SsmOrder>(lds, g, S, E);
    if (G != 256) { for (int L = vcu; L < att::SWA_UNITS; L += G) att::swa_unit(p, lds, L, tid); }
    SWA_IF(vcu >= 64, vcu - 64, 496, 80)
  }
  GRID_BAR();
  { PH_VARS ssm_carry_phase(p, bx, G, tid); SWA_IF(bx >= 64, bx - 64, 0, 192) }
  GRID_BAR();
  { PH_VARS
    pg8::Gemm g{p.A2, p.BtY, A2K, A2K, A2K};
    SsmOrder S{0, SSM_G * 5, G, vcu};
    EpiY<0> E{p.Ypart, p.P, p.ssm_d, p.Gs};
    pg8::gemm_phase<EpiY<0>, SsmOrder>(lds, g, S, E);
    SWA_IF(vcu >= 160, vcu - 160, 192, 96)
  }
  GRID_BAR();
  { PH_VARS
    pg8::Gemm g{p.A2, p.BtY, A2K, A2K, A2K};
    SsmOrder S{SSM_G * 5, SSM_G * 5, G, vcu};
    EpiY<1> E{p.Ypart, p.P, p.ssm_d, p.Gs};
    pg8::gemm_phase<EpiY<1>, SsmOrder>(lds, g, S, E);
    SWA_IF(vcu >= 160, vcu - 160, 288, 96)
  }
  GRID_BAR();
  { PH_VARS
    pg8::Gemm g{p.Gs, p.Glu_t, SSM_W, SSM_W, SSM_W};
    pg8::StaticOrder S; S.init(TA, SSM_W, G, bx);
    EpiGlu E{p.Gs, p.glu_b, p.Ymix, YW, SWA_QW};
    pg8::gemm_phase<EpiGlu, pg8::StaticOrder>(lds, g, S, E);
    SWA_IF(bx >= 144, bx - 144, 384, 112)
  }
  GRID_BAR();
  LAYER_BACK(0, TA, p.WoutA_t, AB_OUT)
  GRID_BAR();
  { PH_VARS
    pg8::Gemm g{p.H, p.DifIn_t, D, D, D};
    ProjOrder1 S; S.S0.init(TL, DIF_IN, G, bx); S.G = G; S.c = bx;
    EpiProj E{p.P, DIF_IN, 2 * DIF_QK, p.ropeT, nullptr};
    pg8::gemm_phase<EpiProj, ProjOrder1>(lds, g, S, E);
    constexpr int NU_ = ProjOrder1::NU;
    const int nlast = NU_ % G;
    if (nlast == 0) moe_weight_transposes(p, 1, scr, gw, ngw, lane);
    else if (bx >= nlast) moe_weight_transposes(p, 1, scr, (bx - nlast) * NWAVES + wave, (G - nlast) * NWAVES, lane);
  }
  GRID_BAR();
  { PH_VARS att::dif_phase(p, lds, G, vcu, tid); }
  GRID_BAR();
  LAYER_BACK(1, TL, p.DifOut_t, DIF_VW)
}

extern "C" void kernel_launch(void* const* d_in, const int* in_sizes, int n_in, void* d_out, int out_size, void* d_ws,
                              size_t ws_size, hipStream_t stream) {
  static int grid = 0;
  if (grid == 0) {
    if (ws_layout().total > ws_size || n_in != 37 || out_size != TL * D) { fprintf(stderr, "kernel_launch: bad sizes (ws need %zu have %zu)\n", ws_layout().total, ws_size); grid = -1; return; }
    int dev = 0, cus = 0;
    if (hipGetDevice(&dev) != hipSuccess || hipDeviceGetAttribute(&cus, hipDeviceAttributeMultiprocessorCount, dev) != hipSuccess) { grid = -1; return; }
    if (hipFuncSetAttribute((const void*)mega_kernel, hipFuncAttributeMaxDynamicSharedMemorySize, LDS_BYTES) != hipSuccess) { fprintf(stderr, "kernel_launch: hipFuncSetAttribute failed\n"); grid = -1; return; }
    grid = cus;
  }
  if (grid < 0) return;
  Params p{};
  fill_inputs(p, d_in);
  p.out = (float*)d_out;
  fill_ws(p, (char*)d_ws);
  if (hipMemsetAsync((char*)d_ws + ws_layout().ctl, 0, CTL_BYTES, stream) != hipSuccess) { fprintf(stderr, "kernel_launch: memset failed\n"); return; }
  hipLaunchKernelGGL(mega_kernel, dim3(grid), dim3(NTHR), LDS_BYTES, stream, p);
  const hipError_t le = hipPeekAtLastError();
  if (le != hipSuccess) fprintf(stderr, "kernel_launch: launch failed: %s\n", hipGetErrorName(le));
}
#endif
```

```cpp
#ifndef HOST_EMU
#include <hip/hip_runtime.h>
#define HD __host__ __device__ __forceinline__
#else
#define HD inline
#endif
#include <stdint.h>
#include <math.h>

#ifndef CFG_D
#define CFG_D 1024
#define CFG_B 8
#define CFG_N 2048
#define CFG_CTX 256
#endif

constexpr int D = CFG_D, B = CFG_B, N = CFG_N, CTX = CFG_CTX;
constexpr int DEPTH = 2, GRID_W = 64, HD_ = 64;
constexpr int TL = B * N, TC = B * CTX, TA = TL + TC;
constexpr int SWA_H = 8, SWA_QW = 512, SWA_KVW = 128, SWA_WIN = 128;
constexpr int SSM_W = D / 2, SSM_C = 16, SSM_G = SSM_W / 16, SSM_P = 64;
constexpr int AB_IN = SWA_QW + 2 * SWA_KVW + SSM_W;
constexpr int AB_OUT = SWA_QW + SSM_W;
constexpr int A_KOFF = SWA_QW, A_VOFF = SWA_QW + SWA_KVW, A_UOFF = SWA_QW + 2 * SWA_KVW;
constexpr int DIF_H = D / 128, DIF_QK = DIF_H * 128, DIF_VW = DIF_H * 128, DIF_IN = 2 * DIF_QK + DIF_VW;
constexpr int MOE_G = 4, MOE_EPG = 8, MOE_E = 32, MOE_F = D / 4;
constexpr int SL = 64;
constexpr int SS = CTX + N;
constexpr int NCH = SS / SL;
constexpr float LN_EPS = 1e-5f, RMS_EPS = 1e-5f;
constexpr float ALPHA = 1.41421356237309515f;
static_assert(CTX % SL == 0 && N % SL == 0, "chunking");
constexpr int YW = AB_OUT > D ? AB_OUT : D;

struct Params {
  const float *x, *c, *ctx, *c_ctx, *mod_w, *mod_b, *ln1_g, *ln1_b, *ln2_g, *ln2_b;
  const float *w_in_a, *w_out_a, *sink, *a_re, *a_im, *log_step, *b_re, *b_im, *c_re, *c_im, *ssm_d, *glu_w, *glu_b;
  const float *dif_w_in, *dif_w_out, *lq1, *lk1, *lq2, *lk2, *subln_g;
  const float *moe_wg, *moe_bg, *moe_we, *moe_be, *moe_w1, *moe_w3, *moe_w2;
  float* out;
  float *X, *X1, *F, *HH;
  uint16_t *P, *Ymix, *Gs;
  float *modv, *ropeT, *apow, *bbar, *KT, *E, *Sin, *route, *scal;
  uint16_t *H;
  uint16_t *WinA_t, *DifIn_t, *WoutA_t, *DifOut_t, *Glu_t, *W13t, *W2t;
  uint16_t *Amoe, *HHb, *F2;
  float* gate;
  int *wgbase;
  int *tokslot, *moe_meta;
  uint16_t *A2, *BtY, *BtE;
  float *apow16, *KT16, *E16, *Ypart;
  unsigned* ctl;
};

HD uint16_t f2bf(float f) {
  uint32_t u = __builtin_bit_cast(uint32_t, f);
  u += 0x7fffu + ((u >> 16) & 1u);
  return (uint16_t)(u >> 16);
}
HD float bf2f(uint16_t h) {
  uint32_t u = ((uint32_t)h) << 16;
  return __builtin_bit_cast(float, u);
}
HD float siluf(float x) { return x / (1.0f + expf(-x)); }
HD float sigmoidf_(float x) { return 1.0f / (1.0f + expf(-x)); }
HD float geluf_(float x) { return 0.5f * x * (1.0f + tanhf(0.7978845608028654f * (x + 0.044715f * x * x * x))); }

HD int tok_r(int t) { return t < TL ? t / N : B; }
HD const float* xrow(const Params& p, int layer, int t) {
  if (layer == 0) return t < TL ? p.x + (size_t)t * D : p.ctx + (size_t)(t - TL) * D;
  return p.X + (size_t)t * D;
}
HD const float* modp(const Params& p, int layer, int r, int which) {
  return p.modv + ((size_t)(layer * (B + 1) + r) * 6 + which) * D;
}

constexpr int N_MOD = DEPTH * (B + 1) * 6 * D;
HD void st_mod(const Params& p, int layer_unused, int idx) {
  int j = idx % (6 * D); int r = (idx / (6 * D)) % (B + 1); int l = idx / (6 * D * (B + 1));
  const float* cv = r < B ? p.c + (size_t)r * D : p.c_ctx;
  const float* w = p.mod_w + (size_t)l * D * 6 * D;
  float acc = p.mod_b[(size_t)l * 6 * D + j];
  for (int k = 0; k < D; ++k) acc += siluf(cv[k]) * w[(size_t)k * 6 * D + j];
  p.modv[idx] = acc;
}

constexpr int N_ROPE = 64 * 16;
constexpr int N_APOW = 2 * SSM_G * SSM_P * (SL + 1);
constexpr int N_BBAR = 2 * SSM_G * SSM_P * SSM_C;
constexpr int N_TABA = N_ROPE + N_APOW + N_BBAR + 1;
HD void st_taba(const Params& p, int layer_unused, int idx) {
  if (idx < N_ROPE) {
    int pos = idx / 16, f = idx % 16;
    float inv = powf(10000.0f, -(float)f / 16.0f);
    float ang = (float)pos * inv;
    p.ropeT[idx * 2] = cosf(ang); p.ropeT[idx * 2 + 1] = sinf(ang);
    return;
  }
  idx -= N_ROPE;
  if (idx < N_APOW) {
#ifndef HOST_EMU
    return;
#endif
    int k = idx % (SL + 1); int q = idx / (SL + 1);
    int dg = q / SSM_P;
    double dt = exp((double)p.log_step[dg]);
    double ar = p.a_re[q], ai = p.a_im[q];
    double mag = exp(k * dt * ar);
    p.apow[(size_t)idx * 2] = (float)(mag * cos(k * dt * ai));
    p.apow[(size_t)idx * 2 + 1] = (float)(mag * sin(k * dt * ai));
    return;
  }
  idx -= N_APOW;
  if (idx < N_BBAR) {
    int cc = idx % SSM_C; int q = idx / SSM_C; int dg = q / SSM_P;
    (void)cc;
    double dt = exp((double)p.log_step[dg]);
    double ar = p.a_re[q], ai = p.a_im[q];
    double mag = exp(dt * ar);
    double abr = mag * cos(dt * ai), abi = mag * sin(dt * ai);
    double den = ar * ar + ai * ai, nr = abr - 1.0;
    double cr = (nr * ar + abi * ai) / den, ci = (abi * ar - nr * ai) / den;
    double br = p.b_re[idx], bi = p.b_im[idx];
    p.bbar[(size_t)idx * 2] = (float)(cr * br - ci * bi);
    p.bbar[(size_t)idx * 2 + 1] = (float)(cr * bi + ci * br);
    return;
  }
  double s1 = 0, s2 = 0;
  for (int i = 0; i < HD_; ++i) { s1 += (double)p.lq1[i] * p.lk1[i]; s2 += (double)p.lq2[i] * p.lk2[i]; }
  double lam_init = 0.8 - 0.6 * exp(-0.3 * 1.0);
  p.scal[0] = (float)(exp(s1) - exp(s2) + lam_init);
  p.scal[1] = (float)(1.0 - lam_init);
}

constexpr int N_KT = 2 * SSM_G * SL * SSM_C * SSM_C;
HD void st_tabb(const Params& p, int layer_unused, int idx) {
  int ci = idx % SSM_C; int co = (idx / SSM_C) % SSM_C; int k = (idx / (SSM_C * SSM_C)) % SL; int dg = idx / (SSM_C * SSM_C * SL);
  float acc = 0.f;
  for (int pp = 0; pp < SSM_P; ++pp) {
    int q = dg * SSM_P + pp;
    float ar = p.apow[((size_t)q * (SL + 1) + k) * 2], ai = p.apow[((size_t)q * (SL + 1) + k) * 2 + 1];
    float br = p.bbar[((size_t)q * SSM_C + ci) * 2], bi = p.bbar[((size_t)q * SSM_C + ci) * 2 + 1];
    float cr = p.c_re[((size_t)dg * SSM_C + co) * SSM_P + pp], cim = p.c_im[((size_t)dg * SSM_C + co) * SSM_P + pp];
    float tr = ar * br - ai * bi, ti = ar * bi + ai * br;
    acc += cr * tr - cim * ti;
  }
  p.KT[idx] = acc;
}

HD void st_proj(const Params& p, int layer, int idx) {
  const int W = layer == 0 ? AB_IN : DIF_IN;
  const float* w = layer == 0 ? p.w_in_a : p.dif_w_in;
  const int rope_end = layer == 0 ? (SWA_QW + SWA_KVW) : (2 * DIF_QK);
  int t = idx / W, n = idx % W;
  int r = tok_r(t);
  if (layer == 1 && t >= TL && n < DIF_QK) return;
  const float* xr = xrow(p, layer, t);
  const float* sh = modp(p, layer, r, 0);
  const float* sc = modp(p, layer, r, 1);
  bool rope = (t < TL) && (n < rope_end);
  if (!rope) {
    float acc = 0.f;
    for (int k = 0; k < D; ++k) { float h = xr[k] * (1.0f + sc[k]) + sh[k]; acc += h * w[(size_t)k * W + n]; }
    p.P[(size_t)t * W + n] = f2bf(acc);
    return;
  }
  int d = n % 64, sub = d % 32;
  if (sub >= 16) return;
  float a1 = 0.f, a2 = 0.f;
  for (int k = 0; k < D; ++k) {
    float h = xr[k] * (1.0f + sc[k]) + sh[k];
    a1 += h * w[(size_t)k * W + n]; a2 += h * w[(size_t)k * W + n + 16];
  }
  int i = t % N;
  int pos = d < 32 ? i / GRID_W : i % GRID_W;
  float cs = p.ropeT[(pos * 16 + sub) * 2], sn = p.ropeT[(pos * 16 + sub) * 2 + 1];
  p.P[(size_t)t * W + n] = f2bf(a1 * cs - a2 * sn);
  p.P[(size_t)t * W + n + 16] = f2bf(a2 * cs + a1 * sn);
}

HD void st_swa(const Params& p, int layer, int idx) {
  int hq = idx / TA, t = idx % TA;
  int kvh = hq / 4;
  const uint16_t* P = p.P;
  float q[64], o[64];
  _Pragma("unroll") for (int d = 0; d < 64; ++d) { q[d] = bf2f(P[(size_t)t * AB_IN + hq * 64 + d]) * 0.125f; o[d] = 0.f; }
  float m = p.sink[hq], l = 1.0f;
  int b = t < TL ? t / N : (t - TL) / CTX;
  int nloc = t < TL ? 2 * SWA_WIN + 1 : 0;
  int i = t < TL ? t % N : 0;
  for (int kk = 0; kk < nloc + CTX; ++kk) {
    int row;
    if (kk < nloc) {
      int j = i - SWA_WIN + kk;
      if (j < 0 || j >= N) continue;
      row = b * N + j;
    } else row = TL + b * CTX + (kk - nloc);
    const uint16_t* kr = P + (size_t)row * AB_IN + A_KOFF + kvh * 64;
    const uint16_t* vr = P + (size_t)row * AB_IN + A_VOFF + kvh * 64;
    float s = 0.f;
    _Pragma("unroll") for (int d = 0; d < 64; ++d) s += q[d] * bf2f(kr[d]);
    if (s > m) { float f = expf(m - s); l *= f; for (int d = 0; d < 64; ++d) o[d] *= f; m = s; }
    float pe = expf(s - m);
    l += pe;
    _Pragma("unroll") for (int d = 0; d < 64; ++d) o[d] += pe * bf2f(vr[d]);
  }
  float il = 1.0f / l;
  _Pragma("unroll") for (int d = 0; d < 64; ++d) p.Ymix[(size_t)t * YW + hq * 64 + d] = f2bf(o[d] * il);
}

HD int ssm_row(int dir, int b, int tau) {
  if (dir == 0) return tau < CTX ? TL + b * CTX + tau : b * N + (tau - CTX);
  return tau < CTX ? TL + b * CTX + (CTX - 1 - tau) : b * N + (N - 1 - (tau - CTX));
}
constexpr int N_SSME = 2 * B * NCH * SSM_G * SSM_P;
HD void st_ssm_e(const Params& p, int layer, int idx) {
  int pp = idx % SSM_P; int g = (idx / SSM_P) % SSM_G; int ch = (idx / (SSM_P * SSM_G)) % NCH;
  int b = (idx / (SSM_P * SSM_G * NCH)) % B; int dir = idx / (SSM_P * SSM_G * NCH * B);
  int q = (dir * SSM_G + g) * SSM_P + pp;
  float er = 0.f, ei = 0.f;
  for (int j = 0; j < SL; ++j) {
    int row = ssm_row(dir, b, ch * SL + j);
    const uint16_t* u = p.P + (size_t)row * AB_IN + A_UOFF + g * 16;
    float vr = 0.f, vi = 0.f;
    _Pragma("unroll") for (int cc = 0; cc < 16; ++cc) {
      float uv = bf2f(u[cc]);
      vr += p.bbar[((size_t)q * 16 + cc) * 2] * uv; vi += p.bbar[((size_t)q * 16 + cc) * 2 + 1] * uv;
    }
    float ar = p.apow[((size_t)q * (SL + 1) + (SL - 1 - j)) * 2], ai = p.apow[((size_t)q * (SL + 1) + (SL - 1 - j)) * 2 + 1];
    er += ar * vr - ai * vi; ei += ar * vi + ai * vr;
  }
  p.E[(size_t)idx * 2] = er; p.E[(size_t)idx * 2 + 1] = ei;
}
constexpr int N_SSMC = 2 * B * SSM_G * SSM_P;
HD void st_ssm_c(const Params& p, int layer, int idx) {
  int pp = idx % SSM_P; int g = (idx / SSM_P) % SSM_G; int b = (idx / (SSM_P * SSM_G)) % B; int dir = idx / (SSM_P * SSM_G * B);
  int q = (dir * SSM_G + g) * SSM_P + pp;
  float ar = p.apow[((size_t)q * (SL + 1) + SL) * 2], ai = p.apow[((size_t)q * (SL + 1) + SL) * 2 + 1];
  float sr = 0.f, si = 0.f;
  for (int ch = 0; ch < NCH; ++ch) {
    size_t e = ((((size_t)dir * B + b) * NCH + ch) * SSM_G + g) * SSM_P + pp;
    p.Sin[e * 2] = sr; p.Sin[e * 2 + 1] = si;
    float er = p.E[e * 2], ei = p.E[e * 2 + 1];
    float nr = ar * sr - ai * si + er, ni = ar * si + ai * sr + ei;
    sr = nr; si = ni;
  }
}
HD void st_ssm_o(const Params& p, int layer, int idx) {
  int t = idx / SSM_W, n = idx % SSM_W; int g = n / 16, co = n % 16;
  int b, dirtau[2];
  if (t < TL) { b = t / N; int i = t % N; dirtau[0] = CTX + i; dirtau[1] = CTX + (N - 1 - i); }
  else { b = (t - TL) / CTX; int i = (t - TL) % CTX; dirtau[0] = i; dirtau[1] = CTX - 1 - i; }
  float y = p.ssm_d[n] * bf2f(p.P[(size_t)t * AB_IN + A_UOFF + n]);
  for (int dir = 0; dir < 2; ++dir) {
    int tau = dirtau[dir]; int ch = tau / SL, j = tau % SL;
    int dg = dir * SSM_G + g;
    size_t e0 = ((((size_t)dir * B + b) * NCH + ch) * SSM_G + g) * SSM_P;
    for (int pp = 0; pp < SSM_P; ++pp) {
      int q = dg * SSM_P + pp;
      float ar = p.apow[((size_t)q * (SL + 1) + (j + 1)) * 2], ai = p.apow[((size_t)q * (SL + 1) + (j + 1)) * 2 + 1];
      float sr = p.Sin[(e0 + pp) * 2], si = p.Sin[(e0 + pp) * 2 + 1];
      float tr = ar * sr - ai * si, ti = ar * si + ai * sr;
      float cr = p.c_re[((size_t)dg * 16 + co) * SSM_P + pp], cim = p.c_im[((size_t)dg * 16 + co) * SSM_P + pp];
      y += cr * tr - cim * ti;
    }
    for (int j2 = 0; j2 <= j; ++j2) {
      int row = ssm_row(dir, b, ch * SL + j2);
      const uint16_t* u = p.P + (size_t)row * AB_IN + A_UOFF + g * 16;
      const float* kt = p.KT + (((size_t)dg * SL + (j - j2)) * 16 + co) * 16;
      _Pragma("unroll") for (int ci = 0; ci < 16; ++ci) y += kt[ci] * bf2f(u[ci]);
    }
  }
  p.Gs[(size_t)t * SSM_W + n] = f2bf(geluf_(y));
}
HD void st_glu(const Params& p, int layer, int idx) {
  int t = idx / SSM_W, n = idx % SSM_W;
  float z = p.glu_b[n];
  const uint16_t* g = p.Gs + (size_t)t * SSM_W;
  for (int k = 0; k < SSM_W; ++k) z += bf2f(g[k]) * p.glu_w[(size_t)k * SSM_W + n];
  p.Ymix[(size_t)t * YW + SWA_QW + n] = f2bf(bf2f(g[n]) * sigmoidf_(z));
}

HD void st_dif(const Params& p, int layer, int idx) {
  int t = idx % TL; int he = idx / TL; int eh = he % 2, h = he / 2;
  int b = t / N;
  const uint16_t* P = p.P;
  float res[64];
  float lam = p.scal[0];
  _Pragma("unroll") for (int c = 0; c < 2; ++c) {
    float q[64], o[64];
    _Pragma("unroll") for (int d = 0; d < 64; ++d) { q[d] = bf2f(P[(size_t)t * DIF_IN + h * 128 + c * 64 + d]) * 0.125f; o[d] = 0.f; }
    float m = -1e30f, l = 0.f;
    for (int kk = 0; kk < N + CTX; ++kk) {
      int row = kk < N ? b * N + kk : TL + b * CTX + (kk - N);
      const uint16_t* kr = P + (size_t)row * DIF_IN + DIF_QK + h * 128 + c * 64;
      const uint16_t* vr = P + (size_t)row * DIF_IN + 2 * DIF_QK + h * 128 + eh * 64;
      float s = 0.f;
      _Pragma("unroll") for (int d = 0; d < 64; ++d) s += q[d] * bf2f(kr[d]);
      if (s > m) { float f = expf(m - s); l *= f; for (int d = 0; d < 64; ++d) o[d] *= f; m = s; }
      float pe = expf(s - m);
      l += pe;
      _Pragma("unroll") for (int d = 0; d < 64; ++d) o[d] += pe * bf2f(vr[d]);
    }
    float il = 1.0f / l;
    if (c == 0) { for (int d = 0; d < 64; ++d) res[d] = o[d] * il; }
    else { for (int d = 0; d < 64; ++d) res[d] -= lam * o[d] * il; }
  }
  _Pragma("unroll") for (int d = 0; d < 64; ++d) p.Ymix[(size_t)t * YW + h * 128 + eh * 64 + d] = f2bf(res[d]);
}
HD void st_difnorm(const Params& p, int layer, int idx) {
  int t = idx / DIF_H, h = idx % DIF_H;
  uint16_t* o = p.Ymix + (size_t)t * YW + h * 128;
  float ss = 0.f;
  for (int e = 0; e < 128; ++e) { float v = bf2f(o[e]); ss += v * v; }
  float r = 1.0f / sqrtf(ss / 128.0f + RMS_EPS) * p.scal[1];
  _Pragma("unroll 8") for (int e = 0; e < 128; ++e) o[e] = f2bf(bf2f(o[e]) * r * p.subln_g[e]);
}

HD void st_outproj(const Params& p, int layer, int idx) {
  int t = idx / D, n = idx % D;
  const float* w = layer == 0 ? p.w_out_a : p.dif_w_out;
  const uint16_t* y = p.Ymix + (size_t)t * YW;
  const int KW = layer == 0 ? AB_OUT : DIF_VW;
  float acc = 0.f;
  for (int k = 0; k < KW; ++k) acc += bf2f(y[k]) * w[(size_t)k * D + n];
  p.F[(size_t)t * D + n] = acc;
}
HD void st_ln1(const Params& p, int layer, int t) {
  int r = tok_r(t);
  const float* xr = xrow(p, layer, t); const float* g1 = modp(p, layer, r, 2);
  const float* y = p.F + (size_t)t * D;
  float mu = 0.f;
  for (int k = 0; k < D; ++k) mu += ALPHA * xr[k] + g1[k] * y[k];
  mu /= D;
  float var = 0.f;
  for (int k = 0; k < D; ++k) { float v = ALPHA * xr[k] + g1[k] * y[k] - mu; var += v * v; }
  var /= D;
  float rs = 1.0f / sqrtf(var + LN_EPS);
  const float* lg = p.ln1_g + (size_t)layer * D; const float* lb = p.ln1_b + (size_t)layer * D;
  for (int k = 0; k < D; ++k) p.X1[(size_t)t * D + k] = (ALPHA * xr[k] + g1[k] * y[k] - mu) * rs * lg[k] + lb[k];
}
HD void st_route(const Params& p, int layer, int t) {
  int r = tok_r(t);
  const float* x1 = p.X1 + (size_t)t * D; const float* sh = modp(p, layer, r, 3); const float* sc = modp(p, layer, r, 4);
  float lg[MOE_G];
  _Pragma("unroll") for (int g = 0; g < MOE_G; ++g) lg[g] = p.moe_bg[layer * MOE_G + g];
  const float* wg = p.moe_wg + (size_t)layer * D * MOE_G;
  for (int k = 0; k < D; ++k) {
    float h = x1[k] * (1.0f + sc[k]) + sh[k];
    _Pragma("unroll") for (int g = 0; g < MOE_G; ++g) lg[g] += h * wg[k * MOE_G + g];
  }
  int gi = 0; float mx = lg[0];
  _Pragma("unroll") for (int g = 1; g < MOE_G; ++g) if (lg[g] > mx) { mx = lg[g]; gi = g; }
  float den = 0.f;
  _Pragma("unroll") for (int g = 0; g < MOE_G; ++g) den += expf(lg[g] - mx);
  float gp = 1.0f / den;
  float le[MOE_EPG];
  _Pragma("unroll") for (int e = 0; e < MOE_EPG; ++e) le[e] = p.moe_be[(layer * MOE_G + gi) * MOE_EPG + e];
  const float* we = p.moe_we + ((size_t)layer * MOE_G + gi) * D * MOE_EPG;
  for (int k = 0; k < D; ++k) {
    float h = x1[k] * (1.0f + sc[k]) + sh[k];
    _Pragma("unroll") for (int e = 0; e < MOE_EPG; ++e) le[e] += h * we[k * MOE_EPG + e];
  }
  int i0 = 0; float v0 = le[0];
  _Pragma("unroll") for (int e = 1; e < MOE_EPG; ++e) if (le[e] > v0) { v0 = le[e]; i0 = e; }
  int i1 = -1; float v1 = -3e38f;
  _Pragma("unroll") for (int e = 0; e < MOE_EPG; ++e) if (e != i0 && le[e] > v1) { v1 = le[e]; i1 = e; }
  float e1 = expf(v1 - v0);
  float w0 = gp / (1.0f + e1), w1 = gp * e1 / (1.0f + e1);
  p.route[(size_t)t * 4 + 0] = (float)(gi * MOE_EPG + i0);
  p.route[(size_t)t * 4 + 1] = (float)(gi * MOE_EPG + i1);
  p.route[(size_t)t * 4 + 2] = w0;
  p.route[(size_t)t * 4 + 3] = w1;
}
HD void st_moe_h(const Params& p, int layer, int idx) {
  int f = idx % MOE_F; int j = (idx / MOE_F) % 2; int t = idx / (2 * MOE_F);
  int r = tok_r(t);
  const float* x1 = p.X1 + (size_t)t * D; const float* sh = modp(p, layer, r, 3); const float* sc = modp(p, layer, r, 4);
  int e = (int)p.route[(size_t)t * 4 + j]; float wgt = p.route[(size_t)t * 4 + 2 + j];
  const float* w1 = p.moe_w1 + ((size_t)layer * MOE_E + e) * D * MOE_F;
  const float* w3 = p.moe_w3 + ((size_t)layer * MOE_E + e) * D * MOE_F;
  float h1 = 0.f, h3 = 0.f;
  for (int k = 0; k < D; ++k) {
    float h = x1[k] * (1.0f + sc[k]) + sh[k];
    h1 += h * w1[(size_t)k * MOE_F + f]; h3 += h * w3[(size_t)k * MOE_F + f];
  }
  p.HH[(size_t)idx] = siluf(h1) * h3 * wgt;
}
HD void st_moe_o(const Params& p, int layer, int idx) {
  int t = idx / D, n = idx % D;
  float acc = 0.f;
  for (int j = 0; j < 2; ++j) {
    int e = (int)p.route[(size_t)t * 4 + j];
    const float* w2 = p.moe_w2 + ((size_t)layer * MOE_E + e) * MOE_F * D;
    const float* hh = p.HH + ((size_t)t * 2 + j) * MOE_F;
    for (int f = 0; f < MOE_F; ++f) acc += hh[f] * w2[(size_t)f * D + n];
  }
  p.F[(size_t)t * D + n] = acc;
}
HD void st_ln2(const Params& p, int layer, int t) {
  int r = tok_r(t);
  const float* x1 = p.X1 + (size_t)t * D; const float* g2 = modp(p, layer, r, 5);
  const float* y = p.F + (size_t)t * D;
  float mu = 0.f;
  for (int k = 0; k < D; ++k) mu += ALPHA * x1[k] + g2[k] * y[k];
  mu /= D;
  float var = 0.f;
  for (int k = 0; k < D; ++k) { float v = ALPHA * x1[k] + g2[k] * y[k] - mu; var += v * v; }
  var /= D;
  float rs = 1.0f / sqrtf(var + LN_EPS);
  const float* lg = p.ln2_g + (size_t)layer * D; const float* lb = p.ln2_b + (size_t)layer * D;
  float* dst = layer == DEPTH - 1 ? p.out + (size_t)t * D : p.X + (size_t)t * D;
  for (int k = 0; k < D; ++k) dst[k] = (ALPHA * x1[k] + g2[k] * y[k] - mu) * rs * lg[k] + lb[k];
}

enum { S_MOD, S_TABA, S_TABB, S_PROJ, S_SWA, S_SSME, S_SSMC, S_SSMO, S_GLU, S_DIF, S_DIFNORM, S_OUTPROJ, S_LN1, S_ROUTE, S_MOEH, S_MOEO, S_LN2 };
template <int S> HD void run_elem(const Params& p, int layer, int idx) {
  if (S == S_MOD) st_mod(p, layer, idx);
  else if (S == S_TABA) st_taba(p, layer, idx);
  else if (S == S_TABB) st_tabb(p, layer, idx);
  else if (S == S_PROJ) st_proj(p, layer, idx);
  else if (S == S_SWA) st_swa(p, layer, idx);
  else if (S == S_SSME) st_ssm_e(p, layer, idx);
  else if (S == S_SSMC) st_ssm_c(p, layer, idx);
  else if (S == S_SSMO) st_ssm_o(p, layer, idx);
  else if (S == S_GLU) st_glu(p, layer, idx);
  else if (S == S_DIF) st_dif(p, layer, idx);
  else if (S == S_DIFNORM) st_difnorm(p, layer, idx);
  else if (S == S_OUTPROJ) st_outproj(p, layer, idx);
  else if (S == S_LN1) st_ln1(p, layer, idx);
  else if (S == S_ROUTE) st_route(p, layer, idx);
  else if (S == S_MOEH) st_moe_h(p, layer, idx);
  else if (S == S_MOEO) st_moe_o(p, layer, idx);
  else if (S == S_LN2) st_ln2(p, layer, idx);
}

constexpr int NSLOT = 2 * TA + MOE_E * 256;
constexpr size_t CTL_BYTES = 1u << 20;
struct WsLayout {
  size_t A2, BtY, BtE, apow16, KT16, E16, Ypart, wgbase;
  size_t ctl, X, X1, P, Ymix, Gs, modv, ropeT, apow, bbar, KT, E, Sin, route, scal, WinA_t, DifIn_t, WoutA_t, DifOut_t, Glu_t, W13t, W2t, gate, tokslot, moe_meta, total;
};
inline WsLayout ws_layout() {
  WsLayout L; size_t o = 0;
  auto take = [&](size_t bytes) { size_t r = o; o += (bytes + 255) & ~(size_t)255; return r; };
  L.ctl = take(CTL_BYTES);
  L.X = take((size_t)TA * D * 4);
  L.X1 = L.X;
  L.P = take((size_t)TA * (AB_IN > DIF_IN ? AB_IN : DIF_IN) * 2);
  L.Ymix = take((size_t)TA * YW * 2);
  L.Gs = L.X;
  L.modv = take((size_t)N_MOD * 4);
  L.ropeT = take((size_t)N_ROPE * 2 * 4);
  L.apow = take((size_t)N_APOW * 2 * 4);
  L.bbar = take((size_t)N_BBAR * 2 * 4);
  L.KT = take((size_t)N_KT * 4);
  L.E = L.X + (((size_t)TA * SSM_W * 2 + 255) & ~(size_t)255);
  L.Sin = L.E + (((size_t)N_SSME * 2 * 4 + 255) & ~(size_t)255);
  L.route = take((size_t)TA * 8 * 4);
  L.scal = take(256);
  L.WinA_t = take((size_t)AB_IN * D * 2);
  L.DifIn_t = take((size_t)DIF_IN * D * 2);
  L.WoutA_t = take((size_t)D * AB_OUT * 2);
  L.DifOut_t = take((size_t)D * DIF_VW * 2);
  L.Glu_t = take((size_t)SSM_W * SSM_W * 2);
  L.W13t = take((size_t)MOE_E * 2 * MOE_F * D * 2);
  L.W2t = take((size_t)MOE_E * D * MOE_F * 2);
  L.gate = take((size_t)NSLOT * 4);
  L.tokslot = take((size_t)TA * 2 * 4);
  L.moe_meta = take(4096);
  L.wgbase = take((size_t)DEPTH * 1024 * MOE_E * 4);
  L.BtY = take((size_t)2 * SSM_G * 256 * 384 * 2);
  L.BtE = take((size_t)2 * SSM_G * 256 * 256 * 2);
  L.apow16 = take((size_t)2 * SSM_G * SSM_P * 17 * 2 * 4);
  L.KT16 = take((size_t)2 * SSM_G * 16 * 256 * 4);
  L.A2 = L.P + (size_t)48 * 1024 * 1024;
  L.E16 = L.X + (size_t)19 * 1024 * 1024;
  L.Ypart = L.E16;
  L.total = o;
  return L;
}
inline void fill_ws(Params& p, char* ws) {
  WsLayout L = ws_layout();
  p.X = (float*)(ws + L.X); p.X1 = (float*)(ws + L.X1); p.P = (uint16_t*)(ws + L.P); p.F = (float*)(ws + L.P);
  p.Ymix = (uint16_t*)(ws + L.Ymix); p.HH = (float*)(ws + L.Ymix);
  p.Gs = (uint16_t*)(ws + L.Gs); p.modv = (float*)(ws + L.modv); p.ropeT = (float*)(ws + L.ropeT);
  p.apow = (float*)(ws + L.apow); p.bbar = (float*)(ws + L.bbar); p.KT = (float*)(ws + L.KT);
  p.E = (float*)(ws + L.E); p.Sin = (float*)(ws + L.Sin); p.route = (float*)(ws + L.route); p.scal = (float*)(ws + L.scal);
  p.H = (uint16_t*)(ws + L.Ymix); p.WinA_t = (uint16_t*)(ws + L.WinA_t); p.DifIn_t = (uint16_t*)(ws + L.DifIn_t); p.ctl = (unsigned*)(ws + L.ctl);
  p.WoutA_t = (uint16_t*)(ws + L.WoutA_t); p.DifOut_t = (uint16_t*)(ws + L.DifOut_t); p.Glu_t = (uint16_t*)(ws + L.Glu_t);
  p.W13t = (uint16_t*)(ws + L.W13t); p.W2t = (uint16_t*)(ws + L.W2t);
  p.Amoe = (uint16_t*)(ws + L.P); p.F2 = (uint16_t*)(ws + L.P); p.HHb = (uint16_t*)(ws + L.Ymix);
  p.A2 = (uint16_t*)(ws + L.A2); p.BtY = (uint16_t*)(ws + L.BtY); p.BtE = (uint16_t*)(ws + L.BtE);
  p.apow16 = (float*)(ws + L.apow16); p.KT16 = (float*)(ws + L.KT16); p.E16 = (float*)(ws + L.E16); p.Ypart = (float*)(ws + L.Ypart);
  p.wgbase = (int*)(ws + L.wgbase);
  p.gate = (float*)(ws + L.gate); p.tokslot = (int*)(ws + L.tokslot); p.moe_meta = (int*)(ws + L.moe_meta);
}
inline void fill_inputs(Params& p, void* const* d_in) {
  const float* const* in = (const float* const*)d_in;
  p.x = in[0]; p.c = in[1]; p.ctx = in[2]; p.c_ctx = in[3]; p.mod_w = in[4]; p.mod_b = in[5];
  p.ln1_g = in[6]; p.ln1_b = in[7]; p.ln2_g = in[8]; p.ln2_b = in[9];
  p.w_in_a = in[10]; p.w_out_a = in[11]; p.sink = in[12]; p.a_re = in[13]; p.a_im = in[14]; p.log_step = in[15];
  p.b_re = in[16]; p.b_im = in[17]; p.c_re = in[18]; p.c_im = in[19]; p.ssm_d = in[20]; p.glu_w = in[21]; p.glu_b = in[22];
  p.dif_w_in = in[23]; p.dif_w_out = in[24]; p.lq1 = in[25]; p.lk1 = in[26]; p.lq2 = in[27]; p.lk2 = in[28]; p.subln_g = in[29];
  p.moe_wg = in[30]; p.moe_bg = in[31]; p.moe_we = in[32]; p.moe_be = in[33]; p.moe_w1 = in[34]; p.moe_w3 = in[35]; p.moe_w2 = in[36];
}

#define FORWARD_PROGRAM(RUN)                                   \
  RUN(S_MOD, 0, N_MOD)                                         \
  RUN(S_TABA, 0, N_TABA)                                       \
  RUN(S_TABB, 0, N_KT)                                         \
                                                   \
  RUN(S_PROJ, 0, TA * AB_IN)                                   \
  RUN(S_SWA, 0, SWA_H * TA)                                    \
  RUN(S_SSME, 0, N_SSME)                                       \
  RUN(S_SSMC, 0, N_SSMC)                                       \
  RUN(S_SSMO, 0, TA * SSM_W)                                   \
  RUN(S_GLU, 0, TA * SSM_W)                                    \
  RUN(S_OUTPROJ, 0, TA * D)                                    \
  RUN(S_LN1, 0, TA)                                            \
  RUN(S_ROUTE, 0, TA)                                          \
  RUN(S_MOEH, 0, TA * 2 * MOE_F)                               \
  RUN(S_MOEO, 0, TA * D)                                       \
  RUN(S_LN2, 0, TA)                                            \
                                                   \
  RUN(S_PROJ, 1, TA * DIF_IN)                                  \
  RUN(S_DIF, 1, DIF_H * 2 * TL)                                \
  RUN(S_DIFNORM, 1, TL * DIF_H)                                \
  RUN(S_OUTPROJ, 1, TL * D)                                    \
  RUN(S_LN1, 1, TL)                                            \
  RUN(S_ROUTE, 1, TL)                                          \
  RUN(S_MOEH, 1, TL * 2 * MOE_F)                               \
  RUN(S_MOEO, 1, TL * D)                                       \
  RUN(S_LN2, 1, TL)

#ifndef HOST_EMU
#include <cstdio>
#define LAS __attribute__((address_space(3)))
#define GAS __attribute__((address_space(1)))
typedef unsigned short bf16_t;
typedef short bf16x8 __attribute__((ext_vector_type(8)));
typedef float f32x4 __attribute__((ext_vector_type(4)));
typedef float f32x2 __attribute__((ext_vector_type(2)));
typedef unsigned u32x4 __attribute__((ext_vector_type(4)));
typedef unsigned u32x2 __attribute__((ext_vector_type(2)));
constexpr int NWAVES = 8, NTHR = 512;
constexpr int RING_BYTES = 131072, LDSCTL_OFF = RING_BYTES, MISC_OFF = LDSCTL_OFF + 320, LDS_BYTES = 147456;
#define LDS_WAIT() asm volatile("s_waitcnt lgkmcnt(0)" ::: "memory")
#define VM_WAIT() asm volatile("s_waitcnt vmcnt(0)" ::: "memory")
__device__ __forceinline__ unsigned cvt_pk_bf16(float lo, float hi) { unsigned r; asm volatile("v_cvt_pk_bf16_f32 %0, %1, %2" : "=v"(r) : "v"(lo), "v"(hi)); return r; }

namespace pg8 {
constexpr int BM = 256, BK = 64, HALF = 128, HTB = HALF * BK * 2, STAGE_BYTES = 8 * HTB, NXCD = 8, WGM = 8;
__host__ __device__ __forceinline__ int lds_byte(int r, int c) { const int st = (r >> 4) * 2 + (c >> 5), rr = r & 15, cc = c & 31, ob = rr * 64 + cc * 2; return st * 1024 + (ob ^ (((ob >> 9) & 1) << 5)); }
__host__ __device__ __forceinline__ void stage_rc(int b, int& R, int& C) { const int st = b / 1024, sb = b % 1024, swz = sb ^ (((sb >> 9) & 1) << 5); R = (st >> 1) * 16 + swz / 64; C = (st & 1) * 32 + (swz % 64) / 2; }
__host__ __device__ __forceinline__ int perm32(int rho) { const int n = rho >> 4, i = rho & 15; return 8 * (i >> 2) + 4 * n + (i & 3); }
struct Unit { int pm, pn; };
struct Gemm { const bf16_t* A; const bf16_t* Bt; int lda, ldb, K; };

struct StaticOrder {
  int nM, nN, nwg, G, c;
  __device__ void init(int M, int N, int G_, int c_) { nM = M / BM; nN = N / BM; nwg = nM * nN; G = G_; c = c_; }
  __device__ bool next(int i, Unit& u) const { return at((long)i * G + c, u); }
  __device__ bool at(long L, Unit& u) const {
    if (L >= nwg) return false;
    int wgid = (int)L; { const int q = nwg / NXCD, r = nwg % NXCD, xcd = wgid % NXCD, off = wgid / NXCD; wgid = (xcd < r ? xcd * (q + 1) : r * (q + 1) + (xcd - r) * q) + off; }
    const int nig = WGM * nN, gid = wgid / nig, fm = gid * WGM, gsz = (nM - fm) < WGM ? (nM - fm) : WGM;
    u.pm = fm + ((wgid % nig) % gsz); u.pn = (wgid % nig) / gsz; return true;
  }
  __device__ __forceinline__ void a_ready(const Unit&) const {}
  __device__ __forceinline__ void done(const Unit&) const {}
};

template <class Epi, class Sched, bool ALIGN_EPI = true, bool SP2 = true>
__device__ __forceinline__ void gemm_phase(LAS unsigned char* lds, const Gemm g, const Sched& S, const Epi& E) {
  int tid = threadIdx.x; asm volatile("" : "+v"(tid));
  const int wid = __builtin_amdgcn_readfirstlane(tid >> 6), lane = tid & 63, wr = wid >> 2, wc = wid & 3, fr = lane & 15, fq = lane >> 4;
  const int K = g.K, nt = K / BK;
  unsigned voffA[2], voffB[2];
#pragma unroll
  for (int i = 0; i < 2; ++i) { int R, C; stage_rc(tid * 16 + i * 8192, R, C); const int Rb = Epi::PERM ? ((R & ~31) + perm32(R & 31)) : R;
    voffA[i] = (unsigned)(R * g.lda + C) * 2u; voffB[i] = (unsigned)(Rb * g.ldb + C) * 2u; }
  const size_t kstep = (size_t)(BK * 2);
  const size_t hA = (size_t)HALF * g.lda * 2, hB = (size_t)HALF * g.ldb * 2;
  const size_t tA = 2 * hA, tB = 2 * hB;
  const unsigned ldsw = (unsigned)wid * 1024u;
  const int aoff = lds_byte(wr * 64 + fr, fq * 8), boff = lds_byte(wc * 32 + fr, fq * 8);
#define PG8_SA(b, h) (((b) * 2 + (h)) * HTB)
#define PG8_SB(b, h) ((4 + (b) * 2 + (h)) * HTB)
#define PG8_STAGE(bufoff, gbase, voff) do { _Pragma("unroll") for (int _i = 0; _i < 2; ++_i) \
    __builtin_amdgcn_global_load_lds((const unsigned*)((const char*)(gbase) + (voff)[_i]), (LAS unsigned*)(lds + (bufoff) + ldsw + _i * 8192), 16, 0, 0); } while (0)
#define PG8_LDA(dst, b, h) do { _Pragma("unroll") for (int m = 0; m < 4; ++m) _Pragma("unroll") for (int k = 0; k < 2; ++k) dst[m][k] = *(const LAS bf16x8*)(lds + PG8_SA(b, h) + aoff + m * 2048 + k * 1024); } while (0)
#define PG8_LDB(dst, b, h) do { _Pragma("unroll") for (int n = 0; n < 2; ++n) _Pragma("unroll") for (int k = 0; k < 2; ++k) dst[n][k] = *(const LAS bf16x8*)(lds + PG8_SB(b, h) + boff + n * 2048 + k * 1024); } while (0)
#define PG8_MMA(ai, bj, At, Bt) do { __builtin_amdgcn_s_setprio(1); _Pragma("unroll") for (int m = 0; m < 4; ++m) _Pragma("unroll") for (int n = 0; n < 2; ++n) _Pragma("unroll") for (int k = 0; k < 2; ++k) \
    acc[ai][bj][m][n] = __builtin_amdgcn_mfma_f32_16x16x32_bf16(Bt[n][k], At[m][k], acc[ai][bj][m][n], 0, 0, 0); __builtin_amdgcn_s_setprio(0); } while (0)
#define PG8_WAIT_V(n) asm volatile("s_waitcnt vmcnt(" #n ")" ::: "memory")
#define PG8_WAIT_L(n) asm volatile("s_waitcnt lgkmcnt(" #n ")" ::: "memory")
#define PG8_BAR __builtin_amdgcn_s_barrier()
#define PG8_SCHED __builtin_amdgcn_sched_barrier(0)
  Unit cur, nxt; int ui = 0;
  if (!S.next(0, cur)) return;
  f32x4 acc[2][2][4][2];
#pragma unroll
  for (int a = 0; a < 2; ++a)
#pragma unroll
    for (int b = 0; b < 2; ++b)
#pragma unroll
      for (int m = 0; m < 4; ++m)
#pragma unroll
        for (int n = 0; n < 2; ++n) acc[a][b][m][n] = (f32x4){0.f, 0.f, 0.f, 0.f};
  bf16x8 At[4][2], B0[2][2], B1[2][2];
  const char* cA = (const char*)g.A + (size_t)cur.pm * tA; const char* cB = (const char*)g.Bt + (size_t)cur.pn * tB;
  S.a_ready(cur);
  if constexpr (SP2) {
    PG8_STAGE(PG8_SB(0, 0), cB, voffB); PG8_STAGE(PG8_SB(0, 1), cB + hB, voffB); PG8_STAGE(PG8_SA(0, 0), cA, voffA); PG8_STAGE(PG8_SA(0, 1), cA + hA, voffA);
    if (wr == 1) PG8_BAR;
    PG8_WAIT_V(2); PG8_BAR;
    PG8_STAGE(PG8_SB(1, 0), cB + kstep, voffB); PG8_STAGE(PG8_SA(1, 0), cA + kstep, voffA); PG8_STAGE(PG8_SB(1, 1), cB + hB + kstep, voffB);
    PG8_WAIT_V(6); PG8_BAR;
  } else {
    PG8_STAGE(PG8_SB(0, 0), cB, voffB); PG8_STAGE(PG8_SA(0, 0), cA, voffA); PG8_STAGE(PG8_SB(0, 1), cB + hB, voffB); PG8_STAGE(PG8_SA(0, 1), cA + hA, voffA);
    if (wr == 1) PG8_BAR;
    PG8_WAIT_V(4); PG8_BAR;
    PG8_STAGE(PG8_SB(1, 0), cB + kstep, voffB); PG8_STAGE(PG8_SA(1, 0), cA + kstep, voffA); PG8_STAGE(PG8_SB(1, 1), cB + hB + kstep, voffB);
    PG8_WAIT_V(6); PG8_BAR;
  }
  for (;;) {
    const bool has_next = S.next(ui + 1, nxt);
    const char* nA = has_next ? (const char*)g.A + (size_t)nxt.pm * tA : cA; const char* nB = has_next ? (const char*)g.Bt + (size_t)nxt.pn * tB : cB;
#pragma unroll 1
    for (int t = 0; t < nt; t += 2) {
      const bool last = (t == nt - 2);
      const char* a1 = cA + (size_t)(t + 1) * kstep;
      const char* a2 = last ? nA : cA + (size_t)(t + 2) * kstep; const char* b2 = last ? nB : cB + (size_t)(t + 2) * kstep;
      const char* a3 = a2 + kstep; const char* b3 = b2 + kstep;
      if (last && has_next) S.a_ready(nxt);
      if constexpr (SP2) {
        PG8_LDB(B0, 0, 0); PG8_LDB(B1, 0, 1); PG8_SCHED; PG8_LDA(At, 0, 0); PG8_STAGE(PG8_SA(1, 1), a1 + hA, voffA);
        PG8_WAIT_V(8); PG8_WAIT_L(0); PG8_BAR; PG8_MMA(0, 0, At, B0); PG8_MMA(0, 1, At, B1); PG8_BAR; PG8_SCHED;
        PG8_LDA(At, 0, 1); PG8_STAGE(PG8_SB(0, 0), b2, voffB); PG8_STAGE(PG8_SB(0, 1), b2 + hB, voffB); PG8_STAGE(PG8_SA(0, 0), a2, voffA);
        PG8_WAIT_V(8); PG8_WAIT_L(0); PG8_BAR; PG8_MMA(1, 0, At, B0); PG8_MMA(1, 1, At, B1); PG8_BAR; PG8_SCHED;
        PG8_LDB(B0, 1, 0); PG8_LDB(B1, 1, 1); PG8_SCHED; PG8_LDA(At, 1, 0); PG8_STAGE(PG8_SA(0, 1), a2 + hA, voffA);
        PG8_WAIT_V(8); PG8_WAIT_L(0); PG8_BAR; PG8_MMA(0, 0, At, B0); PG8_MMA(0, 1, At, B1); PG8_BAR; PG8_SCHED;
        PG8_LDA(At, 1, 1); PG8_STAGE(PG8_SB(1, 0), b3, voffB); PG8_STAGE(PG8_SB(1, 1), b3 + hB, voffB); PG8_STAGE(PG8_SA(1, 0), a3, voffA);
        PG8_WAIT_V(8); PG8_WAIT_L(0); PG8_BAR; PG8_MMA(1, 0, At, B0); PG8_MMA(1, 1, At, B1); PG8_BAR; PG8_SCHED;
      } else {
        PG8_LDB(B0, 0, 0); PG8_SCHED; PG8_LDA(At, 0, 0); PG8_STAGE(PG8_SA(1, 1), a1 + hA, voffA);
        PG8_WAIT_L(8); PG8_BAR; PG8_WAIT_L(0); PG8_MMA(0, 0, At, B0); PG8_BAR; PG8_SCHED;
        PG8_LDB(B1, 0, 1); PG8_STAGE(PG8_SB(0, 0), b2, voffB);
        PG8_BAR; PG8_WAIT_L(0); PG8_MMA(0, 1, At, B1); PG8_BAR;
        PG8_LDA(At, 0, 1); PG8_STAGE(PG8_SA(0, 0), a2, voffA);
        PG8_BAR; PG8_WAIT_L(0); PG8_MMA(1, 0, At, B0); PG8_BAR; PG8_SCHED;
        PG8_STAGE(PG8_SB(0, 1), b2 + hB, voffB);
        PG8_WAIT_V(6); PG8_BAR; PG8_MMA(1, 1, At, B1); PG8_BAR;
        PG8_LDB(B0, 1, 0); PG8_SCHED; PG8_LDA(At, 1, 0); PG8_STAGE(PG8_SA(0, 1), a2 + hA, voffA);
        PG8_WAIT_L(8); PG8_BAR; PG8_WAIT_L(0); PG8_MMA(0, 0, At, B0); PG8_BAR; PG8_SCHED;
        PG8_LDB(B1, 1, 1); PG8_STAGE(PG8_SB(1, 0), b3, voffB);
        PG8_BAR; PG8_WAIT_L(0); PG8_MMA(0, 1, At, B1); PG8_BAR;
        PG8_LDA(At, 1, 1); PG8_STAGE(PG8_SA(1, 0), a3, voffA);
        PG8_BAR; PG8_WAIT_L(0); PG8_MMA(1, 0, At, B0); PG8_BAR; PG8_SCHED;
        PG8_STAGE(PG8_SB(1, 1), b3 + hB, voffB);
        PG8_WAIT_V(6); PG8_BAR; PG8_MMA(1, 1, At, B1); PG8_BAR;
      }
    }
    if constexpr (ALIGN_EPI) { if (wr == 0) PG8_BAR; }
    E(acc, cur, wr, wc, fr, fq); S.done(cur);
    if (!has_next) break;
#pragma unroll
    for (int a = 0; a < 2; ++a)
#pragma unroll
      for (int b = 0; b < 2; ++b)
#pragma unroll
        for (int m = 0; m < 4; ++m)
#pragma unroll
          for (int n = 0; n < 2; ++n) acc[a][b][m][n] = (f32x4){0.f, 0.f, 0.f, 0.f};
    cur = nxt; cA = nA; cB = nB; ++ui;
    if constexpr (ALIGN_EPI) { if (wr == 1) PG8_BAR; }
  }
  PG8_WAIT_V(0);
  if constexpr (!ALIGN_EPI) { if (wr == 0) PG8_BAR; }
  PG8_BAR;
#undef PG8_SA
#undef PG8_SB
#undef PG8_STAGE
#undef PG8_LDA
#undef PG8_LDB
#undef PG8_MMA
#undef PG8_WAIT_V
#undef PG8_WAIT_L
#undef PG8_BAR
#undef PG8_SCHED
}
}

constexpr int LC = 16, NCH16 = SS / LC, GROWS = 1280, A2K = 384;
static_assert(B * NCH16 <= GROWS && GROWS % 256 == 0, "ssm group rows");
__device__ __forceinline__ void ssm_tau(int t, int& b, int& tau0, int& tau1) {
  if (t < TL) { b = t / N; const int i = t % N; tau0 = CTX + i; tau1 = CTX + (N - 1 - i); }
  else { b = (t - TL) / CTX; const int i = (t - TL) % CTX; tau0 = i; tau1 = CTX - 1 - i; }
}
struct EpiProj {
  static constexpr bool PERM = false;
  bf16_t* O; int ldc; int rope_end; const float* ropeT; bf16_t* A2;
  __device__ __forceinline__ void operator()(const f32x4 (&acc)[2][2][4][2], const pg8::Unit& u, int wr, int wc, int fr, int fq) const {
    const int row0 = u.pm * 256 + wr * 64 + fr, colb = u.pn * 256 + wc * 32;
    const bool rope_cols = colb < rope_end;
#pragma unroll
    for (int ai = 0; ai < 2; ++ai)
#pragma unroll
      for (int m = 0; m < 4; ++m) {
        const int r = row0 + ai * 128 + m * 16;
        bf16_t* rowp = O + (size_t)r * ldc + colb + 4 * fq;
        f32x4 cs0 = {1.f, 0.f, 1.f, 0.f}, cs1 = {1.f, 0.f, 1.f, 0.f};
        const bool rp = rope_cols && (r < TL);
        if (rp) { const int i = r % N; const int pos = (wc & 1) ? (i % GRID_W) : (i / GRID_W);
          const f32x4* tp = (const f32x4*)(ropeT + (size_t)(pos * 16 + 4 * fq) * 2); cs0 = tp[0]; cs1 = tp[1]; }
#pragma unroll
        for (int bj = 0; bj < 2; ++bj) {
          const bool rpb = rp && (colb + bj * 128 < rope_end);
          f32x4 a1 = acc[ai][bj][m][0], a2 = acc[ai][bj][m][1];
          f32x4 o1 = a1, o2 = a2;
          if (rpb) {
            o1[0] = a1[0] * cs0[0] - a2[0] * cs0[1]; o2[0] = a2[0] * cs0[0] + a1[0] * cs0[1];
            o1[1] = a1[1] * cs0[2] - a2[1] * cs0[3]; o2[1] = a2[1] * cs0[2] + a1[1] * cs0[3];
            o1[2] = a1[2] * cs1[0] - a2[2] * cs1[1]; o2[2] = a2[2] * cs1[0] + a1[2] * cs1[1];
            o1[3] = a1[3] * cs1[2] - a2[3] * cs1[3]; o2[3] = a2[3] * cs1[2] + a1[3] * cs1[3];
          }
          u32x2 w1 = {cvt_pk_bf16(o1[0], o1[1]), cvt_pk_bf16(o1[2], o1[3])}, w2 = {cvt_pk_bf16(o2[0], o2[1]), cvt_pk_bf16(o2[2], o2[3])};
          *(u32x2*)(rowp + bj * 128) = w1; *(u32x2*)(rowp + bj * 128 + 16) = w2;
          if (A2 != nullptr && colb + bj * 128 >= A_UOFF) {
            int b, tau0, tau1; ssm_tau(r, b, tau0, tau1);
            const int g0 = (colb + bj * 128 - A_UOFF) / 16;
            bf16_t* d0 = A2 + (((size_t)g0 * GROWS + b * NCH16 + tau0 / LC) * A2K + (tau0 % LC) * 16 + 4 * fq);
            bf16_t* d1 = A2 + (((size_t)(SSM_G + g0) * GROWS + b * NCH16 + tau1 / LC) * A2K + (tau1 % LC) * 16 + 4 * fq);
            *(u32x2*)d0 = w1; *(u32x2*)(d0 + (size_t)GROWS * A2K) = w2; *(u32x2*)d1 = w1; *(u32x2*)(d1 + (size_t)GROWS * A2K) = w2;
          }
        }
      }
  }
};


struct ProjOrder1 {
  static constexpr int NM0 = TL / 256, NN = DIF_IN / 256, NQ = DIF_QK / 256, NU = NM0 * NN + (TC / 256) * (NN - NQ);
  pg8::StaticOrder S0; int G, c;
  __device__ __forceinline__ bool next(int i, pg8::Unit& u) const {
    const long L = (long)i * G + c;
    if (L < NM0 * NN) return S0.at(L, u);
    const int l2 = (int)(L - NM0 * NN); if (l2 >= (TC / 256) * (NN - NQ)) return false;
    u.pm = NM0 + l2 / (NN - NQ); u.pn = NQ + l2 % (NN - NQ); return true;
  }
  __device__ __forceinline__ void a_ready(const pg8::Unit&) const {}
  __device__ __forceinline__ void done(const pg8::Unit&) const {}
};
struct EpiF32Out {
  static constexpr bool PERM = false;
  float* C; int ldc;
  __device__ __forceinline__ void operator()(const f32x4 (&acc)[2][2][4][2], const pg8::Unit& u, int wr, int wc, int fr, int fq) const {
    const int row0 = u.pm * 256 + wr * 64 + fr, col0 = u.pn * 256 + wc * 32 + 4 * fq;
#pragma unroll
    for (int ai = 0; ai < 2; ++ai)
#pragma unroll
      for (int m = 0; m < 4; ++m) { float* rowp = C + (size_t)(row0 + ai * 128 + m * 16) * ldc + col0;
#pragma unroll
        for (int bj = 0; bj < 2; ++bj)
#pragma unroll
          for (int n = 0; n < 2; ++n) *(f32x4*)(rowp + bj * 128 + n * 16) = acc[ai][bj][m][n]; }
  }
};
struct EpiBf16Out {
  static constexpr bool PERM = true;
  bf16_t* O; int ldc; int NJ;
  __device__ __forceinline__ void operator()(const f32x4 (&acc)[2][2][4][2], const pg8::Unit& u, int wr, int wc, int fr, int fq) const {
    const int row0 = u.pm * 256 + wr * 64 + fr, col0 = (NJ ? (u.pn % NJ) : u.pn) * 256 + wc * 32 + 8 * fq;
#pragma unroll
    for (int ai = 0; ai < 2; ++ai)
#pragma unroll
      for (int m = 0; m < 4; ++m) { bf16_t* rowp = O + (size_t)(row0 + ai * 128 + m * 16) * ldc + col0;
#pragma unroll
        for (int bj = 0; bj < 2; ++bj) { const f32x4 v0 = acc[ai][bj][m][0], v1 = acc[ai][bj][m][1];
          u32x4 w; w.x = cvt_pk_bf16(v0[0], v0[1]); w.y = cvt_pk_bf16(v0[2], v0[3]); w.z = cvt_pk_bf16(v1[0], v1[1]); w.w = cvt_pk_bf16(v1[2], v1[3]);
          *(u32x4*)(rowp + bj * 128) = w; } }
  }
};
__device__ __forceinline__ float fast_sigmoid(float x) { return __builtin_amdgcn_rcpf(1.f + __builtin_amdgcn_exp2f(-1.4426950408889634f * x)); }
struct EpiGlu {
  static constexpr bool PERM = true;
  const bf16_t* Gs; const float* bias; bf16_t* O; int ldo, coloff;
  __device__ __forceinline__ void operator()(const f32x4 (&acc)[2][2][4][2], const pg8::Unit& u, int wr, int wc, int fr, int fq) const {
    const int row0 = u.pm * 256 + wr * 64 + fr, col0 = u.pn * 256 + wc * 32 + 8 * fq;
#pragma unroll
    for (int ai = 0; ai < 2; ++ai)
#pragma unroll
      for (int m = 0; m < 4; ++m) { const int r = row0 + ai * 128 + m * 16;
#pragma unroll
        for (int bj = 0; bj < 2; ++bj) { const int c = col0 + bj * 128;
          const u32x4 gv = *(const u32x4*)(Gs + (size_t)r * SSM_W + c);
          const f32x4 b0 = *(const f32x4*)(bias + c), b1 = *(const f32x4*)(bias + c + 4);
          const f32x4 v0 = acc[ai][bj][m][0] + b0, v1 = acc[ai][bj][m][1] + b1;
          float o[8];
#pragma unroll
          for (int j = 0; j < 4; ++j) { const unsigned gw_ = j < 2 ? (j == 0 ? gv.x : gv.y) : (j == 2 ? gv.z : gv.w);
            const float g0 = __builtin_bit_cast(float, gw_ << 16), g1 = __builtin_bit_cast(float, gw_ & 0xffff0000u);
            const float z0 = j < 2 ? v0[2 * j] : v1[2 * j - 4], z1 = j < 2 ? v0[2 * j + 1] : v1[2 * j - 3];
            o[2 * j] = g0 * fast_sigmoid(z0); o[2 * j + 1] = g1 * fast_sigmoid(z1); }
          u32x4 w; w.x = cvt_pk_bf16(o[0], o[1]); w.y = cvt_pk_bf16(o[2], o[3]); w.z = cvt_pk_bf16(o[4], o[5]); w.w = cvt_pk_bf16(o[6], o[7]);
          *(u32x4*)(O + (size_t)r * ldo + coloff + c) = w; } }
  }
};
struct EpiMoe1 {
  static constexpr bool PERM = true;
  bf16_t* HH; const float* gate;
  __device__ __forceinline__ void operator()(const f32x4 (&acc)[2][2][4][2], const pg8::Unit& u, int wr, int wc, int fr, int fq) const {
    const int row0 = u.pm * 256 + wr * 64 + fr, col0 = (u.pn & 1) * 128 + wc * 32 + 8 * fq;
#pragma unroll
    for (int ai = 0; ai < 2; ++ai)
#pragma unroll
      for (int m = 0; m < 4; ++m) { const int r = row0 + ai * 128 + m * 16; const float gt = gate[r];
        float o[8];
#pragma unroll
        for (int n = 0; n < 2; ++n)
#pragma unroll
          for (int j = 0; j < 4; ++j) { const float h1 = acc[ai][0][m][n][j], h3 = acc[ai][1][m][n][j]; o[4 * n + j] = h1 * fast_sigmoid(h1) * h3 * gt; }
        u32x4 w; w.x = cvt_pk_bf16(o[0], o[1]); w.y = cvt_pk_bf16(o[2], o[3]); w.z = cvt_pk_bf16(o[4], o[5]); w.w = cvt_pk_bf16(o[6], o[7]);
        *(u32x4*)(HH + (size_t)r * MOE_F + col0) = w; }
  }
};
struct MoeOrder {
  const int* meta; int NJ, G, c;
  __device__ __forceinline__ bool next(int i, pg8::Unit& u) const {
    const int nt = __builtin_amdgcn_readfirstlane(__hip_atomic_load(meta, __ATOMIC_RELAXED, __HIP_MEMORY_SCOPE_AGENT));
    const long L = (long)i * G + c; if (L >= (long)nt * NJ) return false;
    const int rt = (int)(L / NJ), jn = (int)(L % NJ);
    const int e = __builtin_amdgcn_readfirstlane(__hip_atomic_load(meta + 1 + rt, __ATOMIC_RELAXED, __HIP_MEMORY_SCOPE_AGENT));
    u.pm = rt; u.pn = e * NJ + jn; return true;
  }
  __device__ __forceinline__ void a_ready(const pg8::Unit&) const {}
  __device__ __forceinline__ void done(const pg8::Unit&) const {}
};


namespace att {
using f32x16 = __attribute__((ext_vector_type(16))) float;
using s16x4  = __attribute__((ext_vector_type(4))) short;
constexpr int KVBLK = 64;
constexpr float SCALE = 0.125f, THR = 8.f;
constexpr size_t SHM_V = KVBLK * 128 * 2, SHM_K = KVBLK * 128 * 2;
constexpr size_t SHM_WS = 2 * SHM_V + 2 * SHM_K;
#define KSWZ(row, colB) ((row) * 256 + ((colB) ^ (((row) & 15) << 4)))
#define SBAR() __builtin_amdgcn_sched_barrier(0)
__device__ __forceinline__ int crow(int r, int hi) { return (r & 3) + 8 * (r >> 2) + 4 * hi; }
__device__ __forceinline__ unsigned cvtpk(float lo, float hi) { unsigned r; asm volatile("v_cvt_pk_bf16_f32 %0, %1, %2" : "=v"(r) : "v"(lo), "v"(hi)); return r; }
__device__ __forceinline__ void partialSM(f32x16& p0, f32x16& p1, float& m_reg, float& mn, float& alpha) {
  constexpr float C = SCALE * 1.4426950408889634f;
  float pmax = p0[0];
#pragma unroll
  for (int r = 1; r < 16; ++r) pmax = fmaxf(pmax, p0[r]);
#pragma unroll
  for (int r = 0; r < 16; ++r) pmax = fmaxf(pmax, p1[r]);
  { auto rr = __builtin_amdgcn_permlane32_swap(__float_as_uint(pmax), __float_as_uint(pmax), false, false);
    pmax = fmaxf(__uint_as_float(rr[0]), __uint_as_float(rr[1])); }
  if (__builtin_expect(__all(pmax - m_reg <= THR / SCALE), 1)) { mn = m_reg; alpha = 1.f; }
  else { mn = fmaxf(m_reg, pmax); alpha = __builtin_amdgcn_exp2f((m_reg - mn) * C); m_reg = mn; }
  const float mnC = -mn * C;
#pragma unroll
  for (int r = 0; r < 16; ++r) p0[r] = fmaf(p0[r], C, mnC);
#pragma unroll
  for (int r = 0; r < 16; ++r) p1[r] = fmaf(p1[r], C, mnC);
#pragma unroll
  for (int r = 0; r < 16; ++r) p0[r] = __builtin_amdgcn_exp2f(p0[r]);
}
__device__ __forceinline__ void finishSM(f32x16& p0, f32x16& p1, float alpha, float& l_reg, bf16x8& pa0, bf16x8& pa1, bf16x8& pa2, bf16x8& pa3) {
#pragma unroll
  for (int r = 0; r < 16; ++r) p1[r] = __builtin_amdgcn_exp2f(p1[r]);
  float ps = 0;
#pragma unroll
  for (int r = 0; r < 16; ++r) ps += p0[r];
#pragma unroll
  for (int r = 0; r < 16; ++r) ps += p1[r];
  { auto rr = __builtin_amdgcn_permlane32_swap(__float_as_uint(ps), __float_as_uint(ps), false, false);
    ps = __uint_as_float(rr[0]) + __uint_as_float(rr[1]); }
  l_reg = l_reg * alpha + ps;
#define PK4(P, BASE, OUT) do { unsigned a0 = cvtpk(P[BASE + 0], P[BASE + 1]), a1 = cvtpk(P[BASE + 2], P[BASE + 3]);   \
    unsigned b0 = cvtpk(P[BASE + 4], P[BASE + 5]), b1 = cvtpk(P[BASE + 6], P[BASE + 7]);                              \
    auto r0 = __builtin_amdgcn_permlane32_swap(a0, b0, false, false); auto r1 = __builtin_amdgcn_permlane32_swap(a1, b1, false, false); \
    u32x4 w = {r0[0], r1[0], r0[1], r1[1]}; OUT = *reinterpret_cast<bf16x8*>(&w); } while (0)
  PK4(p0, 0, pa0); PK4(p0, 8, pa1); PK4(p1, 0, pa2); PK4(p1, 8, pa3);
#undef PK4
}
__device__ __forceinline__ void qkt(f32x16& p0, f32x16& p1, const char* Ks, const bf16x8* qr, int r32, int hi, int c) {
  p0 = f32x16{}; p1 = f32x16{};
#pragma unroll
  for (int d0 = 0; d0 < 4; ++d0) { const int cb = (c * 64 + d0 * 16 + hi * 8) * 2;
    const bf16x8 b0 = *reinterpret_cast<const bf16x8*>(Ks + KSWZ(r32, cb));
    const bf16x8 b1 = *reinterpret_cast<const bf16x8*>(Ks + KSWZ(32 + r32, cb));
    p0 = __builtin_amdgcn_mfma_f32_32x32x16_bf16(b0, qr[d0], p0, 0, 0, 0);
    p1 = __builtin_amdgcn_mfma_f32_32x32x16_bf16(b1, qr[d0], p1, 0, 0, 0); }
}
__device__ __forceinline__ int v_st(int k, int c) { const int kk = (k & ~0xC) | ((k & 4) << 1) | ((k & 8) >> 1); return ((kk >> 3) * 4 + (c >> 5)) * 512 + ((kk & 7) * 32 + (c & 31)) * 2; }
__device__ __forceinline__ int v_rd_base(int lane) { return ((lane & 3) << 3) | (((lane >> 2) & 3) << 6) | (((lane >> 4) & 1) << 5) | (((lane >> 5) & 1) << 8); }
constexpr int v_rd_off(int d0, int ks, int half) { return d0 * 512 + ks * 4096 + half * 2048; }
template <int OFF> __device__ __forceinline__ s16x4 tr_read(int vb) {
  s16x4 r; asm volatile("ds_read_b64_tr_b16 %0, %1 offset:%2" : "=&v"(r) : "v"(vb), "i"(OFF) : "memory"); return r;
}
template <int D0> __device__ __forceinline__ void pv_one(f32x16& od, int vb, bf16x8 pa0, bf16x8 pa1, bf16x8 pa2, bf16x8 pa3) {
  const s16x4 l0 = tr_read<v_rd_off(D0, 0, 0)>(vb), h0 = tr_read<v_rd_off(D0, 0, 1)>(vb), l1 = tr_read<v_rd_off(D0, 1, 0)>(vb), h1 = tr_read<v_rd_off(D0, 1, 1)>(vb);
  const s16x4 l2 = tr_read<v_rd_off(D0, 2, 0)>(vb), h2 = tr_read<v_rd_off(D0, 2, 1)>(vb), l3 = tr_read<v_rd_off(D0, 3, 0)>(vb), h3 = tr_read<v_rd_off(D0, 3, 1)>(vb);
  asm volatile("s_waitcnt lgkmcnt(0)" ::: "memory"); SBAR();
#define PK(L, H) (bf16x8){L[0], L[1], L[2], L[3], H[0], H[1], H[2], H[3]}
  od = __builtin_amdgcn_mfma_f32_32x32x16_bf16(pa0, PK(l0, h0), od, 0, 0, 0);
  od = __builtin_amdgcn_mfma_f32_32x32x16_bf16(pa1, PK(l1, h1), od, 0, 0, 0);
  od = __builtin_amdgcn_mfma_f32_32x32x16_bf16(pa2, PK(l2, h2), od, 0, 0, 0);
  od = __builtin_amdgcn_mfma_f32_32x32x16_bf16(pa3, PK(l3, h3), od, 0, 0, 0);
#undef PK
}
template <int NB> __device__ __forceinline__ void pv_blocks(f32x16* o, int vb, int vsel, bf16x8 pa0, bf16x8 pa1, bf16x8 pa2, bf16x8 pa3) {
  if constexpr (NB == 4) { pv_one<0>(o[0], vb, pa0, pa1, pa2, pa3); pv_one<1>(o[1], vb, pa0, pa1, pa2, pa3); pv_one<2>(o[2], vb, pa0, pa1, pa2, pa3); pv_one<3>(o[3], vb, pa0, pa1, pa2, pa3); }
  else { if (vsel == 0) { pv_one<0>(o[0], vb, pa0, pa1, pa2, pa3); pv_one<1>(o[1], vb, pa0, pa1, pa2, pa3); }
         else { pv_one<2>(o[0], vb, pa0, pa1, pa2, pa3); pv_one<3>(o[1], vb, pa0, pa1, pa2, pa3); } }
}
__device__ __forceinline__ void apply_mask(f32x16& p0, f32x16& p1, int mt, int i, int k0, int hi) {
  if (mt == 0) return;
#pragma unroll
  for (int r = 0; r < 16; ++r) { const int j0 = k0 + crow(r, hi), j1 = j0 + 32;
    const bool ok0 = (mt == 1) && (j0 - i <= SWA_WIN) && (i - j0 <= SWA_WIN), ok1 = (mt == 1) && (j1 - i <= SWA_WIN) && (i - j1 <= SWA_WIN);
    p0[r] = ok0 ? p0[r] : -1e30f; p1[r] = ok1 ? p1[r] : -1e30f; }
}

struct TileMap {
  int nl, tlo, bN, bC;
  __device__ __forceinline__ int row(int t) const { return t < nl ? bN + 64 * (tlo + t) : (t < nl + CTX / 64 ? bC + 64 * (t - nl) : bN + 64 * tlo); }
  __device__ __forceinline__ int mtype(int t) const { return t < nl ? 1 : (t < nl + CTX / 64 ? 0 : 2); }
  __device__ __forceinline__ int key0(int t) const { return 64 * (tlo + (t < nl ? t : 0)); }
};

template <int MODE>
__device__ __forceinline__ void attn_unit(const bf16_t* __restrict__ Pq, const bf16_t* __restrict__ Pk, const bf16_t* __restrict__ Pv, int LD, const TileMap tm, int NT,
                                          float m_init, float l_init, int i0, LAS unsigned char* ldsb, f32x16* o, float& l_out, int tid) {
  constexpr int NB = MODE == 0 ? 4 : 2;
  const int wid = tid >> 6, lane = tid & 63, r32 = lane & 31, hi = lane >> 5, c = wid >> 2;
  char* lds = (char*)ldsb;
  char* V_lds = lds; char* K_lds = lds + 2 * SHM_V;
  float* ws = (float*)(lds + SHM_WS) + wid * 64; float* al_l = ws + 32;
  float m_reg = m_init, l_reg = l_init; bf16x8 qr[4];
#pragma unroll
  for (int d = 0; d < NB; ++d) o[d] = f32x16{};
  const bf16_t* Qw = Pq + (size_t)r32 * LD + hi * 8;
#pragma unroll
  for (int d0 = 0; d0 < 4; ++d0) qr[d0] = *reinterpret_cast<const bf16x8*>(Qw + d0 * 16);
  const int sr = tid >> 4, sc = (tid & 15) * 8, vst0 = v_st(sr, sc), vst1 = v_st(32 + sr, sc);
  const int vb0 = (int)(uintptr_t)V_lds + v_rd_base(lane);
  struct { bf16x8 vs0, vs1, ks0, ks1; } sr_[2];
#define SLOAD(i, t) do { const size_t rb_ = (size_t)tm.row(t); \
    sr_[i].vs0 = *reinterpret_cast<const bf16x8*>(Pv + (rb_ + sr) * LD + sc); sr_[i].vs1 = *reinterpret_cast<const bf16x8*>(Pv + (rb_ + 32 + sr) * LD + sc); \
    sr_[i].ks0 = *reinterpret_cast<const bf16x8*>(Pk + (rb_ + sr) * LD + sc); sr_[i].ks1 = *reinterpret_cast<const bf16x8*>(Pk + (rb_ + 32 + sr) * LD + sc); } while (0)
#define SWRITE(b, i) do { *(bf16x8*)(V_lds + (b) * SHM_V + vst0) = sr_[i].vs0; *(bf16x8*)(V_lds + (b) * SHM_V + vst1) = sr_[i].vs1; const int kc = sc * 2; \
    *(bf16x8*)(K_lds + (b) * SHM_K + KSWZ(sr, kc)) = sr_[i].ks0; *(bf16x8*)(K_lds + (b) * SHM_K + KSWZ(32 + sr, kc)) = sr_[i].ks1; } while (0)
#define SWAIT() asm volatile("s_waitcnt vmcnt(4)" ::: "memory")
#define RESC(a) do { if (__any((a) < 1.f)) { if (hi == 0) al_l[r32] = (a); asm volatile("s_waitcnt lgkmcnt(0)" ::: "memory"); \
    _Pragma("unroll") for (int d = 0; d < NB; ++d) _Pragma("unroll") for (int r = 0; r < 16; ++r) o[d][r] *= al_l[crow(r, hi)]; } } while (0)
#define MASK(P0, P1, t) do { if constexpr (MODE == 1) apply_mask(P0, P1, tm.mtype(t), i0 + r32, tm.key0(t), hi); } while (0)
  f32x16 pA0, pA1, pB0, pB1; float mnA, mnB, alA, alB; bf16x8 pa0, pa1, pa2, pa3;
  constexpr int SE = 0, SO = 1;
  SLOAD(SE, 0); asm volatile("s_waitcnt vmcnt(0)" ::: "memory"); SWRITE(0, SE); __syncthreads();
  qkt(pA0, pA1, K_lds, qr, r32, hi, c); MASK(pA0, pA1, 0); partialSM(pA0, pA1, m_reg, mnA, alA);
  SLOAD(SO, 1); if (2 < NT) SLOAD(SE, 2);
  SWAIT(); SWRITE(1, SO); __syncthreads();
  for (int j = 1; j + 1 < NT; j += 2) {
    SBAR(); qkt(pB0, pB1, K_lds + SHM_K, qr, r32, hi, c);
    finishSM(pA0, pA1, alA, l_reg, pa0, pa1, pa2, pa3); SBAR();
    SLOAD(SO, j + 2); SBAR();
    pv_blocks<NB>(o, vb0, c, pa0, pa1, pa2, pa3); MASK(pB0, pB1, j); partialSM(pB0, pB1, m_reg, mnB, alB);
    __syncthreads(); SWAIT(); SWRITE(0, SE);
    RESC(alB); __syncthreads();
    SBAR(); qkt(pA0, pA1, K_lds, qr, r32, hi, c);
    finishSM(pB0, pB1, alB, l_reg, pa0, pa1, pa2, pa3); SBAR();
    if (j + 3 < NT) SLOAD(SE, j + 3);
    SBAR();
    pv_blocks<NB>(o, vb0 + (int)SHM_V, c, pa0, pa1, pa2, pa3); MASK(pA0, pA1, j + 1); partialSM(pA0, pA1, m_reg, mnA, alA);
    __syncthreads(); SWAIT(); SWRITE(1, SO);
    RESC(alA); __syncthreads();
  }
  SBAR(); qkt(pB0, pB1, K_lds + SHM_K, qr, r32, hi, c);
  finishSM(pA0, pA1, alA, l_reg, pa0, pa1, pa2, pa3); SBAR();
  pv_blocks<NB>(o, vb0, c, pa0, pa1, pa2, pa3); MASK(pB0, pB1, NT - 1); partialSM(pB0, pB1, m_reg, mnB, alB);
  __syncthreads(); RESC(alB);
  finishSM(pB0, pB1, alB, l_reg, pa0, pa1, pa2, pa3); SBAR();
  pv_blocks<NB>(o, vb0 + (int)SHM_V, c, pa0, pa1, pa2, pa3);
  l_out = l_reg;
  asm volatile("s_waitcnt vmcnt(0)" ::: "memory");
  __syncthreads();
#undef SLOAD
#undef SWRITE
#undef SWAIT
#undef RESC
#undef MASK
}

__device__ __forceinline__ void dif_phase(const Params& p, LAS unsigned char* ldsb, int G, int vcu, int tid) {
  const int wid = tid >> 6, lane = tid & 63, r32 = lane & 31, hi = lane >> 5, c = wid >> 2, rg = wid & 3;
  constexpr int NQB = N / 128, NU = B * DIF_H * NQB;
  const float lam = p.scal[0], oscale = p.scal[1];
  for (int L = vcu; L < NU; L += G) {
    const int qb = L % NQB, h = (L / NQB) % DIF_H, b = L / (NQB * DIF_H);
    const int t0 = b * N + qb * 128 + rg * 32;
    TileMap tm; tm.nl = N / 64; tm.tlo = 0; tm.bN = b * N; tm.bC = TL + b * CTX;
    f32x16 o[4]; float l_reg;
    attn_unit<0>(p.P + (size_t)t0 * DIF_IN + h * 128 + c * 64, p.P + DIF_QK + h * 128, p.P + 2 * DIF_QK + h * 128, DIF_IN, tm, (N + CTX) / 64,
                 -1e30f, 0.f, 0, ldsb, o, l_reg, tid);
    char* lds = (char*)ldsb;
    float* ws = (float*)(lds + SHM_WS) + wid * 64;
    float* xb = (float*)lds;
    if (hi == 0) ws[r32] = l_reg;
    asm volatile("s_waitcnt lgkmcnt(0)" ::: "memory");
    float rli[16];
#pragma unroll
    for (int r = 0; r < 16; ++r) rli[r] = __builtin_amdgcn_rcpf(ws[crow(r, hi)]);
    if (c == 1) {
#pragma unroll
      for (int d0 = 0; d0 < 4; ++d0)
#pragma unroll
        for (int r = 0; r < 16; ++r) xb[(rg * 32 + crow(r, hi)) * 128 + d0 * 32 + r32] = o[d0][r] * rli[r];
    }
    __syncthreads();
    if (c == 0) {
      float ss[16];
#pragma unroll
      for (int r = 0; r < 16; ++r) ss[r] = 0.f;
#pragma unroll
      for (int d0 = 0; d0 < 4; ++d0)
#pragma unroll
        for (int r = 0; r < 16; ++r) { const float v = o[d0][r] * rli[r] - lam * xb[(rg * 32 + crow(r, hi)) * 128 + d0 * 32 + r32]; o[d0][r] = v; ss[r] += v * v; }
#pragma unroll
      for (int r = 0; r < 16; ++r) {
#pragma unroll
        for (int sft = 1; sft < 32; sft <<= 1) ss[r] += __shfl_xor(ss[r], sft);
        ss[r] = oscale / sqrtf(ss[r] * (1.f / 128.f) + RMS_EPS); }
#pragma unroll
      for (int d0 = 0; d0 < 4; ++d0) { const float gsub = p.subln_g[d0 * 32 + r32];
#pragma unroll
        for (int r = 0; r < 16; ++r) p.Ymix[(size_t)(t0 + crow(r, hi)) * YW + h * 128 + d0 * 32 + r32] = f2bf(o[d0][r] * ss[r] * gsub); }
    }
    __syncthreads();
  }
}
__device__ __forceinline__ void swa_unit(const Params& p, LAS unsigned char* ldsb, int L, int tid) {
  const int wid = tid >> 6, lane = tid & 63, r32 = lane & 31, hi = lane >> 5;
  constexpr int NUL = TL / 32;
  const float sink_raw = p.sink[wid] * (1.0f / SCALE);
  TileMap tm; int t0, NT, i0;
  if (L < NUL) { const int b = L / (N / 32), qb = L % (N / 32); i0 = qb * 32; t0 = b * N + i0;
    const int lo = i0 - SWA_WIN < 0 ? 0 : i0 - SWA_WIN, hi_ = i0 + 31 + SWA_WIN > N - 1 ? N - 1 : i0 + 31 + SWA_WIN;
    tm.tlo = lo / 64; tm.nl = hi_ / 64 - tm.tlo + 1; tm.bN = b * N; tm.bC = TL + b * CTX; NT = (tm.nl + CTX / 64 + 1) & ~1;
  } else { const int Lc = L - NUL, b = Lc / (CTX / 32), qb = Lc % (CTX / 32); i0 = 0; t0 = TL + b * CTX + qb * 32;
    tm.tlo = 0; tm.nl = 0; tm.bN = b * N; tm.bC = TL + b * CTX; NT = CTX / 64; }
  f32x16 o[2]; float l_reg;
  attn_unit<1>(p.P + (size_t)t0 * AB_IN + wid * 64, p.P + A_KOFF, p.P + A_VOFF, AB_IN, tm, NT, sink_raw, 1.f, i0, ldsb, o, l_reg, tid);
  char* lds = (char*)ldsb;
  float* ws = (float*)(lds + SHM_WS) + wid * 64;
  if (hi == 0) ws[r32] = l_reg;
  asm volatile("s_waitcnt lgkmcnt(0)" ::: "memory");
#pragma unroll
  for (int r = 0; r < 16; ++r) { const float rl = __builtin_amdgcn_rcpf(ws[crow(r, hi)]);
#pragma unroll
    for (int d0 = 0; d0 < 2; ++d0) p.Ymix[(size_t)(t0 + crow(r, hi)) * YW + wid * 64 + d0 * 32 + r32] = f2bf(o[d0][r] * rl); }
  __syncthreads();
}
constexpr int SWA_UNITS = TL / 32 + TC / 32;


#define TRRD8(X, D0) do { X[0] = tr_read<v_rd_off(D0, 0, 0)>(vb); X[1] = tr_read<v_rd_off(D0, 0, 1)>(vb); X[2] = tr_read<v_rd_off(D0, 1, 0)>(vb); X[3] = tr_read<v_rd_off(D0, 1, 1)>(vb); \
    X[4] = tr_read<v_rd_off(D0, 2, 0)>(vb); X[5] = tr_read<v_rd_off(D0, 2, 1)>(vb); X[6] = tr_read<v_rd_off(D0, 3, 0)>(vb); X[7] = tr_read<v_rd_off(D0, 3, 1)>(vb); } while (0)
#define PKV(L, H) (bf16x8){L[0], L[1], L[2], L[3], H[0], H[1], H[2], H[3]}
#define MMA4(O, X) do { O = __builtin_amdgcn_mfma_f32_32x32x16_bf16(pa0, PKV(X[0], X[1]), O, 0, 0, 0); O = __builtin_amdgcn_mfma_f32_32x32x16_bf16(pa1, PKV(X[2], X[3]), O, 0, 0, 0); \
    O = __builtin_amdgcn_mfma_f32_32x32x16_bf16(pa2, PKV(X[4], X[5]), O, 0, 0, 0); O = __builtin_amdgcn_mfma_f32_32x32x16_bf16(pa3, PKV(X[6], X[7]), O, 0, 0, 0); } while (0)
__device__ __forceinline__ void pv4p(f32x16* o, int vb, bf16x8 pa0, bf16x8 pa1, bf16x8 pa2, bf16x8 pa3) {
  s16x4 A[8], Bv[8];
  TRRD8(A, 0); TRRD8(Bv, 1);
  asm volatile("s_waitcnt lgkmcnt(8)" ::: "memory"); SBAR(); MMA4(o[0], A);
  TRRD8(A, 2);
  asm volatile("s_waitcnt lgkmcnt(8)" ::: "memory"); SBAR(); MMA4(o[1], Bv);
  TRRD8(Bv, 3);
  asm volatile("s_waitcnt lgkmcnt(8)" ::: "memory"); SBAR(); MMA4(o[2], A);
  asm volatile("s_waitcnt lgkmcnt(0)" ::: "memory"); SBAR(); MMA4(o[3], Bv);
}
#undef TRRD8
#undef PKV
#undef MMA4
constexpr int D2_K = 0, D2_V = 2 * 16384, D2_Q = 4 * 16384, D2_WS = 133120;
__device__ __forceinline__ void qkt2(f32x16& p0, f32x16& p1, const char* Ks, const char* Qs, int r32, int hi, int c) {
  p0 = f32x16{}; p1 = f32x16{};
#pragma unroll
  for (int d0 = 0; d0 < 4; ++d0) { const int cb = (c * 64 + d0 * 16 + hi * 8) * 2;
    const bf16x8 b0 = *reinterpret_cast<const bf16x8*>(Ks + KSWZ(r32, cb));
    const bf16x8 b1 = *reinterpret_cast<const bf16x8*>(Ks + KSWZ(32 + r32, cb));
    const bf16x8 q = *reinterpret_cast<const bf16x8*>(Qs + KSWZ(r32, cb));
    p0 = __builtin_amdgcn_mfma_f32_32x32x16_bf16(b0, q, p0, 0, 0, 0);
    p1 = __builtin_amdgcn_mfma_f32_32x32x16_bf16(b1, q, p1, 0, 0, 0); }
}
__device__ __forceinline__ void dif_phase2(const Params& p, LAS unsigned char* ldsb, int G, int vcu, int tid) {
  const int wid = __builtin_amdgcn_readfirstlane(tid >> 6), lane = tid & 63, r32 = lane & 31, hi = lane >> 5;
  constexpr int NQB = N / 256, NU = B * DIF_H * NQB, NT = (N + CTX) / 64, LD = DIF_IN;
  const float lam = p.scal[0], oscale = p.scal[1];
  char* lds = (char*)ldsb;
  char* Qs = lds + D2_Q + wid * 8192;
  float* ws = (float*)(lds + D2_WS) + wid * 64; float* al_l = ws + 32;
  const int vb0 = (int)(uintptr_t)(lds + D2_V) + v_rd_base(lane);
  int koff[2], voff[2];
#pragma unroll
  for (int k = 0; k < 2; ++k) { const int i = 2 * wid + k;
    { const int row = 4 * i + (lane >> 4), ch = (lane & 15) ^ (row & 15); koff[k] = row * LD + ch * 8; }
    { const int sub = 2 * i + (lane >> 5), kk = (sub >> 2) * 8 + ((lane & 31) >> 2), key = (kk & ~0xC) | ((kk & 4) << 1) | ((kk & 8) >> 1), c = (sub & 3) * 32 + (lane & 3) * 8; voff[k] = key * LD + c; } }
  for (int L = vcu; L < NU; L += G) {
    const int qb = L % NQB, h = (L / NQB) % DIF_H, b = L / (NQB * DIF_H);
    const int t0 = b * N + qb * 256 + wid * 32;
    const bf16_t* Pk = p.P + DIF_QK + h * 128; const bf16_t* Pv = p.P + 2 * DIF_QK + h * 128;
    TileMap tm; tm.nl = N / 64; tm.tlo = 0; tm.bN = b * N; tm.bC = TL + b * CTX;
#define DMA_K(t, buf) do { const bf16_t* g_ = Pk + (size_t)tm.row(t) * LD; _Pragma("unroll") for (int k = 0; k < 2; ++k) \
    __builtin_amdgcn_global_load_lds((const unsigned*)(g_ + koff[k]), (LAS unsigned*)(ldsb + D2_K + (buf) * 16384 + (2 * wid + k) * 1024), 16, 0, 0); } while (0)
#define DMA_V(t, buf) do { const bf16_t* g_ = Pv + (size_t)tm.row(t) * LD; _Pragma("unroll") for (int k = 0; k < 2; ++k) \
    __builtin_amdgcn_global_load_lds((const unsigned*)(g_ + voff[k]), (LAS unsigned*)(ldsb + D2_V + (buf) * 16384 + (2 * wid + k) * 1024), 16, 0, 0); } while (0)
    DMA_K(0, 0); DMA_V(0, 0);
    { const bf16_t* Qg = p.P + (size_t)t0 * LD + h * 128;
#pragma unroll
      for (int i = 0; i < 8; ++i) { const int row = 4 * i + (lane >> 4), ch = lane & 15;
        const bf16x8 v = *reinterpret_cast<const bf16x8*>(Qg + (size_t)row * LD + ch * 8);
        *reinterpret_cast<bf16x8*>(Qs + KSWZ(row, ch * 16)) = v; } }
    f32x16 o1[4], o2[4];
#pragma unroll
    for (int d = 0; d < 4; ++d) { o1[d] = f32x16{}; o2[d] = f32x16{}; }
    float mA = -1e30f, lA = 0.f, mB = -1e30f, lB = 0.f;
#define RESC2(O, a) do { if (__any((a) < 1.f)) { if (hi == 0) al_l[r32] = (a); asm volatile("s_waitcnt lgkmcnt(0)" ::: "memory"); \
    _Pragma("unroll") for (int d = 0; d < 4; ++d) _Pragma("unroll") for (int r = 0; r < 16; ++r) O[d][r] *= al_l[crow(r, hi)]; } } while (0)
    for (int t = 0; t < NT; ++t) {
      const int bb = t & 1;
      asm volatile("s_waitcnt vmcnt(0)" ::: "memory");
      __syncthreads();
      if (t + 1 < NT) { DMA_K(t + 1, bb ^ 1); DMA_V(t + 1, bb ^ 1); }
      f32x16 p0, p1; float mn, al; bf16x8 pa0, pa1, pa2, pa3;
      qkt2(p0, p1, lds + D2_K + bb * 16384, Qs, r32, hi, 0); partialSM(p0, p1, mA, mn, al); RESC2(o1, al);
      finishSM(p0, p1, al, lA, pa0, pa1, pa2, pa3); SBAR();
      pv4p(o1, vb0 + bb * 16384, pa0, pa1, pa2, pa3);
      SBAR();
      qkt2(p0, p1, lds + D2_K + bb * 16384, Qs, r32, hi, 1); partialSM(p0, p1, mB, mn, al); RESC2(o2, al);
      finishSM(p0, p1, al, lB, pa0, pa1, pa2, pa3); SBAR();
      pv4p(o2, vb0 + bb * 16384, pa0, pa1, pa2, pa3);
    }
    if (hi == 0) { ws[r32] = lA; al_l[r32] = lB; }
    asm volatile("s_waitcnt lgkmcnt(0)" ::: "memory");
    float ss[16];
#pragma unroll
    for (int r = 0; r < 16; ++r) { const float r1 = __builtin_amdgcn_rcpf(ws[crow(r, hi)]), r2 = lam * __builtin_amdgcn_rcpf(al_l[crow(r, hi)]); float a = 0.f;
#pragma unroll
      for (int d0 = 0; d0 < 4; ++d0) { const float v = o1[d0][r] * r1 - o2[d0][r] * r2; o1[d0][r] = v; a += v * v; }
      ss[r] = a; }
#pragma unroll
    for (int r = 0; r < 16; ++r) {
#pragma unroll
      for (int sft = 1; sft < 32; sft <<= 1) ss[r] += __shfl_xor(ss[r], sft);
      ss[r] = oscale / sqrtf(ss[r] * (1.f / 128.f) + RMS_EPS); }
#pragma unroll
    for (int d0 = 0; d0 < 4; ++d0) { const float gsub = p.subln_g[d0 * 32 + r32];
#pragma unroll
      for (int r = 0; r < 16; ++r) p.Ymix[(size_t)(t0 + crow(r, hi)) * YW + h * 128 + d0 * 32 + r32] = f2bf(o1[d0][r] * ss[r] * gsub); }
    __syncthreads();
#undef DMA_K
#undef DMA_V
#undef RESC2
  }
}
}


constexpr int N_TAB16A = 2 * SSM_G * SSM_P * 17;
__device__ __forceinline__ void st_tab16a(const Params& p, int idx) {
  const int k = idx % 17, q = idx / 17, dg = q / SSM_P;
  const float dt = expf(p.log_step[dg]), ar = p.a_re[q], ai = p.a_im[q], mag = expf((float)k * dt * ar), ang = (float)k * dt * ai;
  p.apow16[(size_t)idx * 2] = mag * cosf(ang); p.apow16[(size_t)idx * 2 + 1] = mag * sinf(ang);
}
constexpr int N_TAB16B = 2 * SSM_G * 16 * 256;
__device__ __forceinline__ void st_tab16b(const Params& p, int idx) {
  const int ci = idx % 16, co = (idx / 16) % 16, lag = (idx / 256) % 16, dg = idx / 4096;
  float acc = 0.f;
  for (int pp = 0; pp < SSM_P; ++pp) { const int q = dg * SSM_P + pp;
    const float ar = p.apow16[((size_t)q * 17 + lag) * 2], ai = p.apow16[((size_t)q * 17 + lag) * 2 + 1];
    const float br = p.bbar[((size_t)q * 16 + ci) * 2], bi = p.bbar[((size_t)q * 16 + ci) * 2 + 1];
    const float cr = p.c_re[((size_t)dg * 16 + co) * SSM_P + pp], cim = p.c_im[((size_t)dg * 16 + co) * SSM_P + pp];
    acc += cr * (ar * br - ai * bi) - cim * (ar * bi + ai * br); }
  p.KT16[idx] = acc;
}
constexpr int N_BTY = 2 * SSM_G * 256 * A2K, N_BTE = 2 * SSM_G * 256 * 256;
__device__ __forceinline__ void st_tab16c(const Params& p, int idx) {
  if (idx < N_BTY) {
    const int k = idx % A2K, n = (idx / A2K) % 256, dg = idx / (A2K * 256); const int j = n / 16, co = n % 16;
    float v;
    if (k < 256) { const int j2 = k / 16, ci = k % 16; v = j2 <= j ? p.KT16[(((size_t)dg * 16 + (j - j2)) * 16 + co) * 16 + ci] : 0.f; }
    else { const int pp = (k - 256) % 64, im = (k - 256) / 64, q = dg * SSM_P + pp;
      const float ar = p.apow16[((size_t)q * 17 + j + 1) * 2], ai = p.apow16[((size_t)q * 17 + j + 1) * 2 + 1];
      const float cr = p.c_re[((size_t)dg * 16 + co) * SSM_P + pp], cim = p.c_im[((size_t)dg * 16 + co) * SSM_P + pp];
      v = im ? -(cr * ai + cim * ar) : (cr * ar - cim * ai); }
    p.BtY[idx] = f2bf(v); return; }
  idx -= N_BTY;
  const int k = idx % 256, n = (idx / 256) % 256, dg = idx / 65536; const int j = k / 16, ci = k % 16;
  float v = 0.f;
  if (n < 128) { const int pp = n % 64, im = n / 64, q = dg * SSM_P + pp;
    const float ar = p.apow16[((size_t)q * 17 + (15 - j)) * 2], ai = p.apow16[((size_t)q * 17 + (15 - j)) * 2 + 1];
    const float br = p.bbar[((size_t)q * 16 + ci) * 2], bi = p.bbar[((size_t)q * 16 + ci) * 2 + 1];
    v = im ? (ar * bi + ai * br) : (ar * br - ai * bi); }
  p.BtE[idx] = f2bf(v);
}
struct SsmOrder {
  int first, count, G, c;
  __device__ __forceinline__ bool next(int i, pg8::Unit& u) const { const int L = i * G + c; if (L >= count) return false; u.pm = first + L; u.pn = u.pm / 5; return true; }
  __device__ __forceinline__ void a_ready(const pg8::Unit&) const {}
  __device__ __forceinline__ void done(const pg8::Unit&) const {}
};
struct EpiE {
  static constexpr bool PERM = false;
  float* E;
  __device__ __forceinline__ void operator()(const f32x4 (&acc)[2][2][4][2], const pg8::Unit& u, int wr, int wc, int fr, int fq) const {
    const int row0 = u.pm * 256 + wr * 64 + fr, col0 = wc * 32 + 4 * fq;
#pragma unroll
    for (int ai = 0; ai < 2; ++ai)
#pragma unroll
      for (int m = 0; m < 4; ++m) { float* rowp = E + (size_t)(row0 + ai * 128 + m * 16) * 128 + col0;
#pragma unroll
        for (int n = 0; n < 2; ++n) *(f32x4*)(rowp + n * 16) = acc[ai][0][m][n]; }
  }
};
template <int DIR> struct EpiY {
  static constexpr bool PERM = false;
  float* Ypart; const bf16_t* P0; const float* dskip; bf16_t* Gs;
  __device__ __forceinline__ void operator()(const f32x4 (&acc)[2][2][4][2], const pg8::Unit& u, int wr, int wc, int fr, int fq) const {
    const int grp = u.pm / 5, g = grp % SSM_G, rg0 = (u.pm % 5) * 256 + wr * 64 + fr;
#pragma unroll
    for (int ai = 0; ai < 2; ++ai)
#pragma unroll
      for (int m = 0; m < 4; ++m) { const int rg = rg0 + ai * 128 + m * 16;
        if (rg < B * NCH16) { const int b = rg / NCH16, ch = rg % NCH16;
#pragma unroll
          for (int bj = 0; bj < 2; ++bj)
#pragma unroll
            for (int n = 0; n < 2; ++n) { const int j = 8 * bj + 2 * wc + n, tau = ch * LC + j;
              const int t = ssm_row(DIR, b, tau); const size_t o = (size_t)t * SSM_W + g * 16 + 4 * fq;
              if (DIR == 0) *(f32x4*)(Ypart + o) = acc[ai][bj][m][n];
              else { const f32x4 y0 = *(const f32x4*)(Ypart + o); const f32x4 dk = *(const f32x4*)(dskip + g * 16 + 4 * fq);
                const u32x2 uu = *(const u32x2*)(P0 + (size_t)t * AB_IN + A_UOFF + g * 16 + 4 * fq);
                f32x4 uv; uv.x = __builtin_bit_cast(float, uu.x << 16); uv.y = __builtin_bit_cast(float, uu.x & 0xffff0000u); uv.z = __builtin_bit_cast(float, uu.y << 16); uv.w = __builtin_bit_cast(float, uu.y & 0xffff0000u);
                const f32x4 y = acc[ai][bj][m][n] + y0 + dk * uv; float gl[4];
#pragma unroll
                for (int q = 0; q < 4; ++q) { const float x = y[q], w = 0.7978845608028654f * (x + 0.044715f * x * x * x); gl[q] = x * fast_sigmoid(2.f * w); }
                const u32x2 wv = {cvt_pk_bf16(gl[0], gl[1]), cvt_pk_bf16(gl[2], gl[3])};
                *(u32x2*)(Gs + o) = wv; } } } }
  }
};
__device__ __forceinline__ void ssm_carry_phase(const Params& p, int bx, int G, int tid) {
  for (int idx = bx * NTHR + tid; idx < 2 * SSM_G * B * SSM_P; idx += G * NTHR) {
    const int pp = idx % SSM_P, b = (idx / SSM_P) % B, dg = idx / (SSM_P * B), q = dg * SSM_P + pp;
    const float ar = p.apow16[((size_t)q * 17 + 16) * 2], ai = p.apow16[((size_t)q * 17 + 16) * 2 + 1];
    float sr = 0.f, si = 0.f;
    const size_t row0 = (size_t)dg * GROWS + (size_t)b * NCH16;
#pragma unroll 8
    for (int ch = 0; ch < NCH16; ++ch) { const size_t row = row0 + ch;
      p.A2[row * A2K + 256 + pp] = f2bf(sr); p.A2[row * A2K + 320 + pp] = f2bf(si);
      const float er = p.E16[row * 128 + pp], ei = p.E16[row * 128 + 64 + pp];
      const float nr = ar * sr - ai * si + er, ni = ar * si + ai * sr + ei; sr = nr; si = ni; }
  }
}

#define XB_TMO      128
#define XB_XCNT(j)  (256  + 64 * (j))
#define XB_XSUB(j)  (1280 + 64 * (j))
#define XB_XGEN(j)  (2304 + 64 * (j))
#define XB_TOP      3328
#define XB_TOPGEN   3392
#define XCD_BAR_WORDS 3456
#define XB_SPIN_CAP (1u << 22)
constexpr int CW_BAR = 4096;
__device__ __forceinline__ unsigned xb_ld(unsigned* p)              { return __hip_atomic_load(p, __ATOMIC_RELAXED, __HIP_MEMORY_SCOPE_AGENT); }
__device__ __forceinline__ unsigned xb_add(unsigned* p, unsigned v) { return __hip_atomic_fetch_add(p, v, __ATOMIC_RELAXED, __HIP_MEMORY_SCOPE_AGENT); }
__device__ __forceinline__ unsigned xb_xcc_id() { return (unsigned)__builtin_amdgcn_s_getreg((3 << 11) | 20) & 0xFu; }
#define XB_SPIN(cond, bar) do { unsigned _sp = 0; while (cond) { __builtin_amdgcn_s_sleep(1); \
    if ((++_sp & 255u) == 0u) { if (xb_ld(&(bar)[XB_TMO])) break; if (_sp > XB_SPIN_CAP) { atomicAdd(&(bar)[XB_TMO], 1u); break; } } } } while (0)
struct XcdBarrier { unsigned* bar; unsigned x; volatile LAS unsigned* st; };
__device__ __forceinline__ XcdBarrier xcd_barrier_post(unsigned* bar, volatile LAS unsigned* st) {
  XcdBarrier b; b.bar = bar; b.x = xb_xcc_id(); b.st = st;
  if (threadIdx.x == 0) (void)xb_add(&bar[XB_XCNT(b.x)], 1u);
  return b;
}
__device__ __forceinline__ void xcd_barrier_complete(unsigned* bar, unsigned x, unsigned& nloc, unsigned& nx) {
  const unsigned G = gridDim.x * gridDim.y * gridDim.z;
  unsigned sum, cnt, mine, sp = 0u;
  for (;;) {
    sum = 0u; cnt = 0u; mine = 0u;
#pragma unroll
    for (unsigned j = 0; j < 16; ++j) { const unsigned c = xb_ld(&bar[XB_XCNT(j)]); sum += c; cnt += (c > 0u) ? 1u : 0u; mine = (j == x) ? c : mine; }
    if (sum == G) break;
    __builtin_amdgcn_s_sleep(1);
    if ((++sp & 255u) == 0u) { if (xb_ld(&bar[XB_TMO])) break; if (sp > XB_SPIN_CAP) { atomicAdd(&bar[XB_TMO], 1u); break; } }
  }
  nloc = mine > 0u ? mine : 1u; nx = cnt > 0u ? cnt : 1u;
}
__device__ __forceinline__ void xcd_barrier(const XcdBarrier& b) {
  asm volatile("s_waitcnt vmcnt(0)" ::: "memory");
  __syncthreads();
  if (threadIdx.x == 0) {
    unsigned* bar = b.bar;
    __builtin_amdgcn_s_waitcnt(0);
    unsigned nloc = b.st[0], nx = b.st[1];
    if (nloc == 0u) { xcd_barrier_complete(bar, b.x, nloc, nx); b.st[0] = nloc; b.st[1] = nx; }
    const unsigned old = xb_add(&bar[XB_XSUB(b.x)], 1u);
    const unsigned gen = old / nloc;
    if (old + 1u == (gen + 1u) * nloc) {
      __builtin_amdgcn_fence(__ATOMIC_RELEASE, "agent");
      asm volatile("s_waitcnt vmcnt(0)" ::: "memory");
      const unsigned og = xb_add(&bar[XB_TOP], 1u);
      const unsigned tg = og / nx;
      if (og + 1u == (tg + 1u) * nx) xb_add(&bar[XB_TOPGEN], 1u);
      else XB_SPIN(xb_ld(&bar[XB_TOPGEN]) == tg, bar);
      __builtin_amdgcn_fence(__ATOMIC_ACQUIRE, "agent");
      xb_add(&bar[XB_XGEN(b.x)], 1u);
      asm volatile("s_waitcnt vmcnt(0)" ::: "memory");
    } else {
      XB_SPIN(xb_ld(&bar[XB_XGEN(b.x)]) == gen, bar);
      __builtin_amdgcn_fence(__ATOMIC_ACQUIRE, "agent");
      asm volatile("s_waitcnt vmcnt(0)" ::: "memory");
    }
  }
  __syncthreads();
}

__device__ __forceinline__ unsigned pk2(float lo, float hi) { return (unsigned)f2bf(lo) | ((unsigned)f2bf(hi) << 16); }
struct TrItem { const float* W; int N, K, k0, n0, dst_row0; };
__device__ __forceinline__ void tr_load(const TrItem& it, f32x4 (&r)[8], int lane) {
#pragma unroll
  for (int i = 0; i < 8; ++i) r[i] = *(const f32x4*)(it.W + (size_t)(it.k0 + (lane >> 3) + 8 * i) * it.N + it.n0 + 4 * (lane & 7));
}
__device__ __forceinline__ void tr_store(const TrItem& it, const f32x4 (&r)[8], bf16_t* WT, LAS float* scr, int lane) {
#pragma unroll
  for (int i = 0; i < 8; ++i) { LAS float* d = scr + ((lane >> 3) + 8 * i) * 33 + 4 * (lane & 7); d[0] = r[i].x; d[1] = r[i].y; d[2] = r[i].z; d[3] = r[i].w; }
  LDS_WAIT(); asm volatile("" ::: "memory");
  const int c = lane & 7;
#pragma unroll
  for (int j = 0; j < 4; ++j) { const int n = (lane >> 3) + 8 * j; const LAS float* sp = scr + (8 * c) * 33 + n;
    u32x4 o; o.x = pk2(sp[0 * 33], sp[1 * 33]); o.y = pk2(sp[2 * 33], sp[3 * 33]); o.z = pk2(sp[4 * 33], sp[5 * 33]); o.w = pk2(sp[6 * 33], sp[7 * 33]);
    *(u32x4*)(WT + (size_t)(it.dst_row0 + n) * it.K + it.k0 + 8 * c) = o; }
  LDS_WAIT(); asm volatile("" ::: "memory");
}
__device__ __forceinline__ void transpose_matrix(const float* W, int K, int N, bf16_t* WT, LAS float* scr, int gw, int ngw, int lane) {
  const int nblk = N / 32, items = (K / 64) * nblk;
  f32x4 ra[8], rb[8]; TrItem ia, ib;
  int it = gw;
  if (it < items) { ia = TrItem{W, N, K, 64 * (it / nblk), 32 * (it % nblk), 32 * (it % nblk)}; tr_load(ia, ra, lane); }
  while (it < items) {
    const int nx = it + ngw;
    if (nx < items) { ib = TrItem{W, N, K, 64 * (nx / nblk), 32 * (nx % nblk), 32 * (nx % nblk)}; tr_load(ib, rb, lane); }
    tr_store(ia, ra, WT, scr, lane);
    if (nx < items) { ia = ib;
#pragma unroll
      for (int i = 0; i < 8; ++i) ra[i] = rb[i]; }
    it = nx;
  }
}
__device__ __forceinline__ void mod_row_to_bf16(const float* xr, const float* sc, const float* sh, bf16_t* orow, int lane) {
  const f32x4* x4 = (const f32x4*)xr + lane; const f32x4* c4 = (const f32x4*)sc + lane; const f32x4* h4 = (const f32x4*)sh + lane;
  unsigned long long* o8 = (unsigned long long*)orow + lane;
#pragma unroll
  for (int j = 0; j < 4; ++j) { const f32x4 v = x4[64 * j], c = c4[64 * j], h = h4[64 * j];
    const float a = v.x * (1.f + c.x) + h.x, b = v.y * (1.f + c.y) + h.y, cc = v.z * (1.f + c.z) + h.z, d = v.w * (1.f + c.w) + h.w;
    o8[64 * j] = (unsigned long long)pk2(a, b) | ((unsigned long long)pk2(cc, d) << 32); }
}


__device__ __forceinline__ float wave_sum(float v) {
#pragma unroll
  for (int o = 1; o < 64; o <<= 1) v += __shfl_xor(v, o);
  return v;
}
constexpr int CW_CNT = 8192;
#define CNT_WORD(layer, e) (CW_CNT + 64 * (MOE_E * (layer) + (e)))
#define LD4(dst, ptr) do { const f32x4* p4_ = (const f32x4*)(ptr) + lane; _Pragma("unroll") for (int j = 0; j < 4; ++j) dst[j] = p4_[64 * j]; } while (0)
constexpr int RT_CNT = 0, RT_WG = 256, RT_WE = RT_WG + D * 8;
__device__ __forceinline__ int rt_slot(int k) { return ((k & 3) * 4 + (k >> 8)) * 64 + ((k >> 2) & 63); }
__device__ __forceinline__ float bflo(unsigned w) { return __builtin_bit_cast(float, w << 16); }
__device__ __forceinline__ float bfhi(unsigned w) { return __builtin_bit_cast(float, w & 0xffff0000u); }
__device__ __forceinline__ void ln1_phase(const Params& p, int layer, int T, LAS unsigned char* lds, int gw, int ngw, int vcu, int lane, int tid) {
  LAS int* cnt_l = (LAS int*)(lds + RT_CNT);
  if (tid < MOE_E) cnt_l[tid] = 0;
  { const float* wg = p.moe_wg + (size_t)layer * D * MOE_G; const float* we = p.moe_we + (size_t)layer * MOE_G * D * MOE_EPG;
    for (int k = tid; k < D; k += NTHR) { const f32x4 w = *(const f32x4*)(wg + (size_t)k * 4); u32x2 o = {pk2(w.x, w.y), pk2(w.z, w.w)}; *(LAS u32x2*)(lds + RT_WG + rt_slot(k) * 8) = o; }
    for (int i = tid; i < MOE_G * D; i += NTHR) { const int g = i / D, k = i % D; const f32x4 a = *(const f32x4*)(we + (size_t)i * 8), b = *(const f32x4*)(we + (size_t)i * 8 + 4);
      u32x4 o = {pk2(a.x, a.y), pk2(a.z, a.w), pk2(b.x, b.y), pk2(b.z, b.w)}; *(LAS u32x4*)(lds + RT_WE + (g * D + rt_slot(k)) * 16) = o; } }
  __syncthreads();
  const int rpw = (T + ngw - 1) / ngw, t0 = gw * rpw;
  f32x4 g1[4], lg[4], lb[4], sc[4], sh[4]; int cur_r = -1;
  LD4(lg, p.ln1_g + (size_t)layer * D); LD4(lb, p.ln1_b + (size_t)layer * D);
  const int tend = (t0 + rpw < T) ? t0 + rpw : T;
#define LDY(dst, tt) do { const u32x2* y2_ = (const u32x2*)((const bf16_t*)p.F + (size_t)(tt) * D) + lane; _Pragma("unroll") for (int j = 0; j < 4; ++j) dst[j] = y2_[64 * j]; } while (0)
#define LDX16(dst, base, tt) do { const u32x2* x2_ = (const u32x2*)((const bf16_t*)(base) + (size_t)(tt) * D) + lane; _Pragma("unroll") for (int j = 0; j < 4; ++j) { const u32x2 w_ = x2_[64 * j]; dst[j] = (f32x4){bflo(w_.x), bfhi(w_.x), bflo(w_.y), bfhi(w_.y)}; } } while (0)
#define LDXR(dst, tt) do { if (layer == 0) LD4(dst, xrow(p, 0, tt)); else LDX16(dst, p.X, tt); } while (0)
  f32x4 xn[4]; u32x2 yn[4];
  if (t0 < tend) { LDXR(xn, t0); LDY(yn, t0); }
  for (int t = t0; t < tend; ++t) {
    const int r = tok_r(t);
    if (r != cur_r) { cur_r = r; LD4(g1, modp(p, layer, r, 2)); LD4(sc, modp(p, layer, r, 4)); LD4(sh, modp(p, layer, r, 3)); }
    f32x4 v[4], y[4];
#pragma unroll
    for (int j = 0; j < 4; ++j) { v[j] = xn[j]; y[j] = (f32x4){bflo(yn[j].x), bfhi(yn[j].x), bflo(yn[j].y), bfhi(yn[j].y)}; }
    if (t + 1 < tend) { LDXR(xn, t + 1); LDY(yn, t + 1); }
    float s = 0.f;
#pragma unroll
    for (int j = 0; j < 4; ++j) { v[j] = v[j] * ALPHA + g1[j] * y[j]; s += (v[j].x + v[j].y) + (v[j].z + v[j].w); }
    const float mean = wave_sum(s) * (1.f / D); float s2 = 0.f;
#pragma unroll
    for (int j = 0; j < 4; ++j) { v[j] = v[j] - mean; s2 += (v[j].x * v[j].x + v[j].y * v[j].y) + (v[j].z * v[j].z + v[j].w * v[j].w); }
    const float rstd = 1.f / sqrtf(wave_sum(s2) * (1.f / D) + LN_EPS);
    u32x2* o2 = (u32x2*)((bf16_t*)p.X1 + (size_t)t * D) + lane;
#pragma unroll
    for (int j = 0; j < 4; ++j) { v[j] = v[j] * rstd * lg[j] + lb[j]; o2[64 * j] = (u32x2){cvt_pk_bf16(v[j].x, v[j].y), cvt_pk_bf16(v[j].z, v[j].w)}; v[j] = v[j] * (sc[j] + 1.f) + sh[j]; }
    f32x4 gl = {0.f, 0.f, 0.f, 0.f};
#pragma unroll
    for (int j = 0; j < 4; ++j)
#pragma unroll
      for (int c = 0; c < 4; ++c) { const u32x2 w = *(const LAS u32x2*)(lds + RT_WG + ((4 * c + j) * 64 + lane) * 8); const float h = v[j][c];
        gl.x += h * bflo(w.x); gl.y += h * bfhi(w.x); gl.z += h * bflo(w.y); gl.w += h * bfhi(w.y); }
    float lgv[4];
#pragma unroll
    for (int g = 0; g < 4; ++g) lgv[g] = wave_sum(gl[g]) + p.moe_bg[layer * MOE_G + g];
    int gi = 0; float mx = lgv[0];
#pragma unroll
    for (int g = 1; g < 4; ++g) if (lgv[g] > mx) { mx = lgv[g]; gi = g; }
    float den = 0.f;
#pragma unroll
    for (int g = 0; g < 4; ++g) den += __expf(lgv[g] - mx);
    const float gp = 1.0f / den;
    gi = __builtin_amdgcn_readfirstlane(gi);
    f32x4 e0 = {0.f, 0.f, 0.f, 0.f}, e1 = {0.f, 0.f, 0.f, 0.f};
#pragma unroll
    for (int j = 0; j < 4; ++j)
#pragma unroll
      for (int c = 0; c < 4; ++c) { const u32x4 w = *(const LAS u32x4*)(lds + RT_WE + (gi * D + (4 * c + j) * 64 + lane) * 16); const float h = v[j][c];
        e0.x += h * bflo(w.x); e0.y += h * bfhi(w.x); e0.z += h * bflo(w.y); e0.w += h * bfhi(w.y);
        e1.x += h * bflo(w.z); e1.y += h * bfhi(w.z); e1.z += h * bflo(w.w); e1.w += h * bfhi(w.w); }
    float le[8];
#pragma unroll
    for (int e = 0; e < 4; ++e) { le[e] = wave_sum(e0[e]) + p.moe_be[(layer * MOE_G + gi) * MOE_EPG + e]; le[4 + e] = wave_sum(e1[e]) + p.moe_be[(layer * MOE_G + gi) * MOE_EPG + 4 + e]; }
    int i0 = 0; float v0 = le[0];
#pragma unroll
    for (int e = 1; e < 8; ++e) if (le[e] > v0) { v0 = le[e]; i0 = e; }
    int i1 = -1; float v1 = -3e38f;
#pragma unroll
    for (int e = 0; e < 8; ++e) if (e != i0 && le[e] > v1) { v1 = le[e]; i1 = e; }
    if (lane == 0) {
      const float ex = __expf(v1 - v0);
      const int ea = gi * MOE_EPG + i0, eb = gi * MOE_EPG + i1;
      const int pa = __hip_atomic_fetch_add(cnt_l + ea, 1, __ATOMIC_RELAXED, __HIP_MEMORY_SCOPE_WORKGROUP), pb = __hip_atomic_fetch_add(cnt_l + eb, 1, __ATOMIC_RELAXED, __HIP_MEMORY_SCOPE_WORKGROUP);
      float* rt = p.route + (size_t)t * 8;
      rt[0] = (float)ea; rt[1] = (float)eb; rt[2] = gp / (1.0f + ex); rt[3] = gp * ex / (1.0f + ex); rt[4] = (float)pa; rt[5] = (float)pb;
    }
  }
  __syncthreads();
  if (tid < MOE_E) { const int c = cnt_l[tid];
    const int base = c ? (int)__hip_atomic_fetch_add(p.ctl + CNT_WORD(layer, tid), (unsigned)c, __ATOMIC_RELAXED, __HIP_MEMORY_SCOPE_AGENT) : 0;
    p.wgbase[((size_t)layer * 1024 + vcu) * MOE_E + tid] = base; }
}
__device__ __forceinline__ void scatter_phase(const Params& p, int layer, int T, LAS unsigned char* lds, int gw, int ngw, int vcu, int lane, int tid) {
  LAS int* off = (LAS int*)lds;
  if (tid == 0) {
    int o = 0, ntile = 0;
    for (int e = 0; e < MOE_E; ++e) { const int c = (int)__hip_atomic_load(p.ctl + CNT_WORD(layer, e), __ATOMIC_RELAXED, __HIP_MEMORY_SCOPE_AGENT);
      off[e] = o + p.wgbase[((size_t)layer * 1024 + vcu) * MOE_E + e]; const int nt = (c + 255) >> 8;
      if (blockIdx.x == 0) for (int i = 0; i < nt; ++i) p.moe_meta[1 + ntile + i] = e;
      ntile += nt; o += nt * 256; }
    if (blockIdx.x == 0) p.moe_meta[0] = ntile;
  }
  __syncthreads();
  const int rpw = (T + ngw - 1) / ngw, t0 = gw * rpw;
  f32x4 sc[4], sh[4]; int cur_r = -1;
  const int tend = (t0 + rpw < T) ? t0 + rpw : T;
  f32x4 xn[4]; f32x4 rn0 = {0.f, 0.f, 0.f, 0.f}; f32x2 rn1 = {0.f, 0.f};
  if (t0 < tend) { LDX16(xn, p.X1, t0); rn0 = *(const f32x4*)(p.route + (size_t)t0 * 8); rn1 = *(const f32x2*)(p.route + (size_t)t0 * 8 + 4); }
  for (int t = t0; t < tend; ++t) {
    const int r = tok_r(t);
    if (r != cur_r) { cur_r = r; LD4(sc, modp(p, layer, r, 4)); LD4(sh, modp(p, layer, r, 3)); }
    const int ea = (int)rn0.x, eb = (int)rn0.y; const float wa = rn0.z, wb = rn0.w;
    const int sa = off[ea] + (int)rn1.x, sb = off[eb] + (int)rn1.y;
    f32x4 x[4];
#pragma unroll
    for (int j = 0; j < 4; ++j) x[j] = xn[j];
    if (t + 1 < tend) { LDX16(xn, p.X1, t + 1); rn0 = *(const f32x4*)(p.route + (size_t)(t + 1) * 8); rn1 = *(const f32x2*)(p.route + (size_t)(t + 1) * 8 + 4); }
    unsigned long long* oa = (unsigned long long*)(p.Amoe + (size_t)sa * D) + lane; unsigned long long* ob = (unsigned long long*)(p.Amoe + (size_t)sb * D) + lane;
#pragma unroll
    for (int j = 0; j < 4; ++j) { const f32x4 h = x[j] * (sc[j] + 1.f) + sh[j];
      const unsigned long long w = (unsigned long long)pk2(h.x, h.y) | ((unsigned long long)pk2(h.z, h.w) << 32); oa[64 * j] = w; ob[64 * j] = w; }
    if (lane == 0) { p.gate[sa] = wa; p.gate[sb] = wb; p.tokslot[2 * t] = sa; p.tokslot[2 * t + 1] = sb; }
  }
}
__device__ __forceinline__ void ln2_phase(const Params& p, int layer, int T, int gw, int ngw, int lane) {
  const int rpw = (T + ngw - 1) / ngw, t0 = gw * rpw;
  f32x4 g2[4], lg[4], lb[4], sc[4], sh[4]; int cur_r = -1;
  LD4(lg, p.ln2_g + (size_t)layer * D); LD4(lb, p.ln2_b + (size_t)layer * D);
  const int tend = (t0 + rpw < T) ? t0 + rpw : T;
  const int myslot = (2 * t0 + lane < 2 * tend) ? p.tokslot[2 * t0 + lane] : 0;
  f32x4 xn[4]; u32x2 an[4], bn[4];
#define LDF2(tt) do { const int sa_ = __shfl(myslot, 2 * ((tt) - t0)), sb_ = __shfl(myslot, 2 * ((tt) - t0) + 1); \
    const u32x2* fa_ = (const u32x2*)(p.F2 + (size_t)sa_ * D) + lane; const u32x2* fb_ = (const u32x2*)(p.F2 + (size_t)sb_ * D) + lane; \
    _Pragma("unroll") for (int j = 0; j < 4; ++j) { an[j] = fa_[64 * j]; bn[j] = fb_[64 * j]; } LDX16(xn, p.X1, tt); } while (0)
  if (t0 < tend) LDF2(t0);
  for (int t = t0; t < tend; ++t) {
    const int r = tok_r(t);
    if (r != cur_r) { cur_r = r; LD4(g2, modp(p, layer, r, 5)); if (layer + 1 < DEPTH) { LD4(sc, modp(p, layer + 1, r, 1)); LD4(sh, modp(p, layer + 1, r, 0)); } }
    f32x4 v[4]; u32x2 fa[4], fb[4];
#pragma unroll
    for (int j = 0; j < 4; ++j) { v[j] = xn[j]; fa[j] = an[j]; fb[j] = bn[j]; }
    if (t + 1 < tend) LDF2(t + 1);
    float s = 0.f;
#pragma unroll
    for (int j = 0; j < 4; ++j) { const u32x2 a = fa[j], b = fb[j];
      f32x4 f; f.x = bflo(a.x) + bflo(b.x); f.y = bfhi(a.x) + bfhi(b.x); f.z = bflo(a.y) + bflo(b.y); f.w = bfhi(a.y) + bfhi(b.y);
      v[j] = v[j] * ALPHA + g2[j] * f; s += (v[j].x + v[j].y) + (v[j].z + v[j].w); }
    const float mean = wave_sum(s) * (1.f / D); float s2 = 0.f;
#pragma unroll
    for (int j = 0; j < 4; ++j) { v[j] = v[j] - mean; s2 += (v[j].x * v[j].x + v[j].y * v[j].y) + (v[j].z * v[j].z + v[j].w * v[j].w); }
    const float rstd = 1.f / sqrtf(wave_sum(s2) * (1.f / D) + LN_EPS);
    if (layer == DEPTH - 1) {
      f32x4* o4 = (f32x4*)(p.out + (size_t)t * D) + lane;
#pragma unroll
      for (int j = 0; j < 4; ++j) o4[64 * j] = v[j] * rstd * lg[j] + lb[j];
    } else {
      u32x2* o2 = (u32x2*)((bf16_t*)p.X + (size_t)t * D) + lane;
      unsigned long long* h8 = (unsigned long long*)(p.H + (size_t)t * D) + lane;
#pragma unroll
      for (int j = 0; j < 4; ++j) { const f32x4 o = v[j] * rstd * lg[j] + lb[j]; o2[64 * j] = (u32x2){cvt_pk_bf16(o.x, o.y), cvt_pk_bf16(o.z, o.w)};
        const f32x4 h = o * (sc[j] + 1.f) + sh[j];
        h8[64 * j] = (unsigned long long)pk2(h.x, h.y) | ((unsigned long long)pk2(h.z, h.w) << 32); }
    }
  }
#undef LDF2
}
__device__ __forceinline__ void h0_phase(const Params& p, int gw, int ngw, int lane) {
  const int rpw = (TA + ngw - 1) / ngw, t0 = gw * rpw;
  f32x4 sc[4], sh[4]; int cur_r = -1;
  const int tend = (t0 + rpw < TA) ? t0 + rpw : TA;
  f32x4 xn[4], xm[4];
  if (t0 < tend) LD4(xn, xrow(p, 0, t0));
  if (t0 + 1 < tend) LD4(xm, xrow(p, 0, t0 + 1));
  for (int t = t0; t < tend; ++t) {
    const int r = tok_r(t);
    if (r != cur_r) { cur_r = r; LD4(sc, modp(p, 0, r, 1)); LD4(sh, modp(p, 0, r, 0)); }
    f32x4 x[4];
#pragma unroll
    for (int j = 0; j < 4; ++j) { x[j] = xn[j]; xn[j] = xm[j]; }
    if (t + 2 < tend) LD4(xm, xrow(p, 0, t + 2));
    unsigned long long* h8 = (unsigned long long*)(p.H + (size_t)t * D) + lane;
#pragma unroll
    for (int j = 0; j < 4; ++j) { const f32x4 h = x[j] * (sc[j] + 1.f) + sh[j]; h8[64 * j] = (unsigned long long)pk2(h.x, h.y) | ((unsigned long long)pk2(h.z, h.w) << 32); }
  }
}
__device__ __forceinline__ void moe_item(const Params& p, int layer, int it, TrItem& ti, bf16_t*& WT) {
  constexpr int I13 = (D / 64) * (MOE_F / 32), I2 = (MOE_F / 64) * (D / 32);
  const int e = it / (2 * I13 + I2); int r = it % (2 * I13 + I2);
  if (r < 2 * I13) { const int which = r / I13; r %= I13; const int kb = r / (MOE_F / 32), nb = r % (MOE_F / 32), n0 = 32 * nb;
    ti = TrItem{(which ? p.moe_w3 : p.moe_w1) + ((size_t)layer * MOE_E + e) * D * MOE_F, MOE_F, D, 64 * kb, n0, e * 2 * MOE_F + (n0 / 128) * 256 + which * 128 + (n0 % 128)}; WT = p.W13t;
  } else { r -= 2 * I13; const int kb = r / (D / 32), nb = r % (D / 32);
    ti = TrItem{p.moe_w2 + ((size_t)layer * MOE_E + e) * MOE_F * D, D, MOE_F, 64 * kb, 32 * nb, e * D + 32 * nb}; WT = p.W2t; }
}
__device__ __forceinline__ void moe_weight_transposes(const Params& p, int layer, LAS float* scr, int gw, int ngw, int lane) {
  constexpr int NIT = MOE_E * (2 * (D / 64) * (MOE_F / 32) + (MOE_F / 64) * (D / 32));
  f32x4 ra[8], rb[8]; TrItem ia, ib; bf16_t *wa = nullptr, *wb = nullptr;
  int it = gw;
  if (it < NIT) { moe_item(p, layer, it, ia, wa); tr_load(ia, ra, lane); }
  while (it < NIT) {
    const int nx = it + ngw;
    if (nx < NIT) { moe_item(p, layer, nx, ib, wb); tr_load(ib, rb, lane); }
    tr_store(ia, ra, wa, scr, lane);
    if (nx < NIT) { ia = ib; wa = wb;
#pragma unroll
      for (int i = 0; i < 8; ++i) ra[i] = rb[i]; }
    it = nx;
  }
}
__device__ __forceinline__ void mod_phase(const Params& p, LAS unsigned char* lds, int vcu, int G, int tid, int lane, int wave) {
  constexpr int NR = B + 1, RP = 12;
  LAS float* sT = (LAS float*)lds;
  LAS float* part = sT + D * RP;
  for (int i = tid; i < NR * D; i += NTHR) { const int r = i / D, k = i % D; const float c = r < B ? p.c[(size_t)r * D + k] : p.c_ctx[k]; sT[k * RP + r] = c / (1.0f + __expf(-c)); }
  __syncthreads();
  constexpr int NT_ = DEPTH * (6 * D / 64);
  for (int task = vcu; task < NT_; task += G) {
    const int l = task / (6 * D / 64), j = (task % (6 * D / 64)) * 64 + lane;
    const float* w = p.mod_w + (size_t)l * D * 6 * D + (size_t)(wave * 128) * 6 * D + j;
    float acc[NR];
#pragma unroll
    for (int r = 0; r < NR; ++r) acc[r] = 0.f;
#pragma unroll 1
    for (int k0 = 0; k0 < 128; k0 += 16) {
      float wv[16];
#pragma unroll
      for (int u = 0; u < 16; ++u) wv[u] = w[(size_t)(k0 + u) * 6 * D];
#pragma unroll
      for (int u = 0; u < 16; ++u) { const LAS float* sr = sT + (wave * 128 + k0 + u) * RP;
        const f32x4 s0 = *(const LAS f32x4*)sr, s1 = *(const LAS f32x4*)(sr + 4); const float s8 = sr[8];
        acc[0] += s0.x * wv[u]; acc[1] += s0.y * wv[u]; acc[2] += s0.z * wv[u]; acc[3] += s0.w * wv[u];
        acc[4] += s1.x * wv[u]; acc[5] += s1.y * wv[u]; acc[6] += s1.z * wv[u]; acc[7] += s1.w * wv[u]; acc[8] += s8 * wv[u]; }
    }
#pragma unroll
    for (int r = 0; r < NR; ++r) part[(wave * NR + r) * 64 + lane] = acc[r];
    __syncthreads();
    for (int i = tid; i < NR * 64; i += NTHR) { const int r = i / 64, c = i % 64; float v = p.mod_b[(size_t)l * 6 * D + (task % (6 * D / 64)) * 64 + c];
#pragma unroll
      for (int ww = 0; ww < 8; ++ww) v += part[(ww * NR + r) * 64 + c];
      p.modv[((size_t)(l * NR + r) * 6 * D) + (task % (6 * D / 64)) * 64 + c] = v; }
    __syncthreads();
  }
}

__global__ void __launch_bounds__(NTHR, 2) mega_kernel(Params p_by_value) {
  const Params& p = *(const Params*)__builtin_amdgcn_kernarg_segment_ptr();
  extern __shared__ __attribute__((aligned(16))) unsigned char lds_raw[];
  LAS unsigned char* lds = (LAS unsigned char*)lds_raw;
  volatile LAS unsigned* MISC = (volatile LAS unsigned*)(lds + MISC_OFF);
  for (int u = threadIdx.x; u < (LDS_BYTES - LDSCTL_OFF) / 4; u += NTHR) ((LAS unsigned*)(lds + LDSCTL_OFF))[u] = 0u;
  __syncthreads();
  XcdBarrier bar = xcd_barrier_post(p.ctl + CW_BAR, MISC + 8);
#define PH_VARS                                                                                                       \
  int tid = threadIdx.x; asm volatile("" : "+v"(tid));                                                                \
  int bx = blockIdx.x; asm volatile("" : "+s"(bx));                                                                   \
  const int lane = tid & 63, wave = __builtin_amdgcn_readfirstlane(tid >> 6), G = gridDim.x;                          \
  const int vcu = (G % 8 == 0) ? (bx % 8) * (G / 8) + bx / 8 : bx;                                                    \
  const int gw = vcu * NWAVES + wave, ngw = G * NWAVES;                                                               \
  LAS float* scr = (LAS float*)(lds + wave * 16384);                                                                  \
  (void)lane; (void)gw; (void)ngw; (void)scr; (void)vcu;
#define GRID_BAR() xcd_barrier(bar)
#define RUN_NAIVE(S, layer, cnt)                                                                                  \
  {                                                                                                               \
    const int n_ = (cnt);                                                                                         \
    PH_VARS                                                                                                       \
    for (int idx = bx * NTHR + tid; idx < n_; idx += G * NTHR) run_elem<S>(p, layer, idx);                        \
  }

  { PH_VARS mod_phase(p, lds, vcu, G, tid, lane, wave); }
  RUN_NAIVE(S_TABA, 0, N_TABA)
  { PH_VARS for (int idx = bx * NTHR + tid; idx < N_TAB16A; idx += G * NTHR) st_tab16a(p, idx); }
  { PH_VARS
  transpose_matrix(p.w_in_a, D, AB_IN, p.WinA_t, scr, gw, ngw, lane);
  transpose_matrix(p.dif_w_in, D, DIF_IN, p.DifIn_t, scr, gw, ngw, lane);
  transpose_matrix(p.w_out_a, AB_OUT, D, p.WoutA_t, scr, gw, ngw, lane);
  transpose_matrix(p.dif_w_out, DIF_VW, D, p.DifOut_t, scr, gw, ngw, lane);
  transpose_matrix(p.glu_w, SSM_W, SSM_W, p.Glu_t, scr, gw, ngw, lane); }
  GRID_BAR();
  { PH_VARS for (int idx = bx * NTHR + tid; idx < N_TAB16B; idx += G * NTHR) st_tab16b(p, idx); }
  { PH_VARS h0_phase(p, gw, ngw, lane); }
  GRID_BAR();
#define LAYER_BACK(layer, T, WOT_, KO_)                                                                                 \
  { PH_VARS                                                                    \
    pg8::Gemm g{p.Ymix, WOT_, YW, KO_, KO_};                                                                            \
    pg8::StaticOrder S; S.init(T, D, G, bx);                                                                            \
    EpiBf16Out E{(bf16_t*)p.F, D, 0};                                                                                   \
    pg8::gemm_phase<EpiBf16Out, pg8::StaticOrder>(lds, g, S, E);                                                        \
  }                                                                                                                     \
  GRID_BAR();                                                                                                           \
  { PH_VARS ln1_phase(p, layer, T, lds, gw, ngw, vcu, lane, tid); }                                                      \
  GRID_BAR();                                                                                                           \
  { PH_VARS scatter_phase(p, layer, T, lds, gw, ngw, vcu, lane, tid); }                                                 \
  GRID_BAR();                                                                                                           \
  { PH_VARS                                                             \
    pg8::Gemm g{p.Amoe, p.W13t, D, D, D};                                                                               \
    MoeOrder S{p.moe_meta, 2, G, vcu};                                                                                  \
    EpiMoe1 E{p.HHb, p.gate};                                                                                           \
    pg8::gemm_phase<EpiMoe1, MoeOrder>(lds, g, S, E);                                                                   \
  }                                                                                                                     \
  GRID_BAR();                                                                                                           \
  { PH_VARS                                                                                  \
    pg8::Gemm g{p.HHb, p.W2t, MOE_F, MOE_F, MOE_F};                                                                     \
    MoeOrder S{p.moe_meta, 4, G, vcu};                                                                                  \
    EpiBf16Out E{p.F2, D, 4};                                                                                           \
    pg8::gemm_phase<EpiBf16Out, MoeOrder>(lds, g, S, E);                                                                \
  }                                                                                                                     \
  GRID_BAR();                                                                                                           \
  { PH_VARS ln2_phase(p, layer, T, gw, ngw, lane); }
#define SWA_IF(cond, rank, first, cnt) { if (G == 256 && (cond) && (rank) < (cnt)) att::swa_unit(p, lds, (first) + (rank), tid); }

  { PH_VARS for (int idx = bx * NTHR + tid; idx < N_BTY + N_BTE; idx += G * NTHR) st_tab16c(p, idx); }
  { PH_VARS
    pg8::Gemm g{p.H, p.WinA_t, D, D, D};
    pg8::StaticOrder S; S.init(TA, AB_IN, G, bx);
    EpiProj E{p.P, AB_IN, SWA_QW + SWA_KVW, p.ropeT, p.A2};
    pg8::gemm_phase<EpiProj, pg8::StaticOrder>(lds, g, S, E);
    constexpr int NU_ = (TA / 256) * (AB_IN / 256);
    const int nlast = NU_ % G;
    if (nlast == 0) moe_weight_transposes(p, 0, scr, gw, ngw, lane);
    else if (bx >= nlast) moe_weight_transposes(p, 0, scr, (bx - nlast) * NWAVES + wave, (G - nlast) * NWAVES, lane);
  }
  GRID_BAR();
  { PH_VARS
    pg8::Gemm g{p.A2, p.BtE, A2K, 256, 256};
    SsmOrder S{0, 2 * SSM_G * 5, G, vcu};
    EpiE E{p.E16};
    pg8::gemm_phase<EpiE, SsmOrder>(lds, g, S, E);
    if (G != 256) { for (int L = vcu; L < att::SWA_UNITS; L += G) att::swa_unit(p, lds, L, tid); }
    SWA_IF(vcu >= 64, vcu - 64, 496, 80)
  }
  GRID_BAR();
  { PH_VARS ssm_carry_phase(p, bx, G, tid); SWA_IF(bx >= 64, bx - 64, 0, 192) }
  GRID_BAR();
  { PH_VARS
    pg8::Gemm g{p.A2, p.BtY, A2K, A2K, A2K};
    SsmOrder S{0, SSM_G * 5, G, vcu};
    EpiY<0> E{p.Ypart, p.P, p.ssm_d, p.Gs};
    pg8::gemm_phase<EpiY<0>, SsmOrder>(lds, g, S, E);
    SWA_IF(vcu >= 160, vcu - 160, 192, 96)
  }
  GRID_BAR();
  { PH_VARS
    pg8::Gemm g{p.A2, p.BtY, A2K, A2K, A2K};
    SsmOrder S{SSM_G * 5, SSM_G * 5, G, vcu};
    EpiY<1> E{p.Ypart, p.P, p.ssm_d, p.Gs};
    pg8::gemm_phase<EpiY<1>, SsmOrder>(lds, g, S, E);
    SWA_IF(vcu >= 160, vcu - 160, 288, 96)
  }
  GRID_BAR();
  { PH_VARS
    pg8::Gemm g{p.Gs, p.Glu_t, SSM_W, SSM_W, SSM_W};
    pg8::StaticOrder S; S.init(TA, SSM_W, G, bx);
    EpiGlu E{p.Gs, p.glu_b, p.Ymix, YW, SWA_QW};
    pg8::gemm_phase<EpiGlu, pg8::StaticOrder>(lds, g, S, E);
    SWA_IF(bx >= 144, bx - 144, 384, 112)
  }
  GRID_BAR();
  LAYER_BACK(0, TA, p.WoutA_t, AB_OUT)
  GRID_BAR();
  { PH_VARS
    pg8::Gemm g{p.H, p.DifIn_t, D, D, D};
    ProjOrder1 S; S.S0.init(TL, DIF_IN, G, bx); S.G = G; S.c = bx;
    EpiProj E{p.P, DIF_IN, 2 * DIF_QK, p.ropeT, nullptr};
    pg8::gemm_phase<EpiProj, ProjOrder1>(lds, g, S, E);
    constexpr int NU_ = ProjOrder1::NU;
    const int nlast = NU_ % G;
    if (nlast == 0) moe_weight_transposes(p, 1, scr, gw, ngw, lane);
    else if (bx >= nlast) moe_weight_transposes(p, 1, scr, (bx - nlast) * NWAVES + wave, (G - nlast) * NWAVES, lane);
  }
  GRID_BAR();
  { PH_VARS att::dif_phase2(p, lds, G, vcu, tid); }
  GRID_BAR();
  LAYER_BACK(1, TL, p.DifOut_t, DIF_VW)
}

extern "C" void kernel_launch(void* const* d_in, const int* in_sizes, int n_in, void* d_out, int out_size, void* d_ws,
                              size_t ws_size, hipStream_t stream) {
  static int grid = 0;
  if (grid == 0) {
    if (ws_layout().total > ws_size || n_in != 37 || out_size != TL * D) { fprintf(stderr, "kernel_launch: bad sizes (ws need %zu have %zu)\n", ws_layout().total, ws_size); grid = -1; return; }
    int dev = 0, cus = 0;
    if (hipGetDevice(&dev) != hipSuccess || hipDeviceGetAttribute(&cus, hipDeviceAttributeMultiprocessorCount, dev) != hipSuccess) { grid = -1; return; }
    if (hipFuncSetAttribute((const void*)mega_kernel, hipFuncAttributeMaxDynamicSharedMemorySize, LDS_BYTES) != hipSuccess) { fprintf(stderr, "kernel_launch: hipFuncSetAttribute failed\n"); grid = -1; return; }
    grid = cus;
  }
  if (grid < 0) return;
  Params p{};
  fill_inputs(p, d_in);
  p.out = (float*)d_out;
  fill_ws(p, (char*)d_ws);
  if (hipMemsetAsync((char*)d_ws + ws_layout().ctl, 0, CTL_BYTES, stream) != hipSuccess) { fprintf(stderr, "kernel_launch: memset failed\n"); return; }
  hipLaunchKernelGGL(mega_kernel, dim3(grid), dim3(NTHR), LDS_BYTES, stream, p);
  const hipError_t le = hipPeekAtLastError();
  if (le != hipSuccess) fprintf(stderr, "kernel_launch: launch failed: %s\n", hipGetErrorName(le));
}
#endif
```

```cpp
#ifndef HOST_EMU
#include <hip/hip_runtime.h>
#define HD __host__ __device__ __forceinline__
#else
#define HD inline
#endif
#include <stdint.h>
#include <math.h>

#ifndef CFG_D
#define CFG_D 1024
#define CFG_B 8
#define CFG_N 2048
#define CFG_CTX 256
#endif

constexpr int D = CFG_D, B = CFG_B, N = CFG_N, CTX = CFG_CTX;
constexpr int DEPTH = 2, GRID_W = 64, HD_ = 64;
constexpr int TL = B * N, TC = B * CTX, TA = TL + TC;
constexpr int SWA_H = 8, SWA_QW = 512, SWA_KVW = 128, SWA_WIN = 128;
constexpr int SSM_W = D / 2, SSM_C = 16, SSM_G = SSM_W / 16, SSM_P = 64;
constexpr int AB_IN = SWA_QW + 2 * SWA_KVW + SSM_W;
constexpr int AB_OUT = SWA_QW + SSM_W;
constexpr int A_KOFF = SWA_QW, A_VOFF = SWA_QW + SWA_KVW, A_UOFF = SWA_QW + 2 * SWA_KVW;
constexpr int DIF_H = D / 128, DIF_QK = DIF_H * 128, DIF_VW = DIF_H * 128, DIF_IN = 2 * DIF_QK + DIF_VW;
constexpr int MOE_G = 4, MOE_EPG = 8, MOE_E = 32, MOE_F = D / 4;
constexpr int SL = 64;
constexpr int SS = CTX + N;
constexpr int NCH = SS / SL;
constexpr float LN_EPS = 1e-5f, RMS_EPS = 1e-5f;
constexpr float ALPHA = 1.41421356237309515f;
static_assert(CTX % SL == 0 && N % SL == 0, "chunking");
constexpr int YW = AB_OUT > D ? AB_OUT : D;

struct Params {
  const float *x, *c, *ctx, *c_ctx, *mod_w, *mod_b, *ln1_g, *ln1_b, *ln2_g, *ln2_b;
  const float *w_in_a, *w_out_a, *sink, *a_re, *a_im, *log_step, *b_re, *b_im, *c_re, *c_im, *ssm_d, *glu_w, *glu_b;
  const float *dif_w_in, *dif_w_out, *lq1, *lk1, *lq2, *lk2, *subln_g;
  const float *moe_wg, *moe_bg, *moe_we, *moe_be, *moe_w1, *moe_w3, *moe_w2;
  float* out;
  float *X, *X1, *F, *HH;
  uint16_t *P, *Ymix, *Gs;
  float *modv, *ropeT, *apow, *bbar, *KT, *E, *Sin, *route, *scal;
  uint16_t *H;
  uint16_t *WinA_t, *DifIn_t, *WoutA_t, *DifOut_t, *Glu_t, *W13t, *W2t;
  uint16_t *Amoe, *HHb, *F2;
  float* gate;
  int *wgbase;
  int *tokslot, *moe_meta;
  uint16_t *A2, *BtY, *BtE;
  float *apow16, *KT16, *E16, *Ypart;
  unsigned* ctl;
};

HD uint16_t f2bf(float f) {
  uint32_t u = __builtin_bit_cast(uint32_t, f);
  u += 0x7fffu + ((u >> 16) & 1u);
  return (uint16_t)(u >> 16);
}
HD float bf2f(uint16_t h) {
  uint32_t u = ((uint32_t)h) << 16;
  return __builtin_bit_cast(float, u);
}
HD float siluf(float x) { return x / (1.0f + expf(-x)); }
HD float sigmoidf_(float x) { return 1.0f / (1.0f + expf(-x)); }
HD float geluf_(float x) { return 0.5f * x * (1.0f + tanhf(0.7978845608028654f * (x + 0.044715f * x * x * x))); }

HD int tok_r(int t) { return t < TL ? t / N : B; }
HD const float* xrow(const Params& p, int layer, int t) {
  if (layer == 0) return t < TL ? p.x + (size_t)t * D : p.ctx + (size_t)(t - TL) * D;
  return p.X + (size_t)t * D;
}
HD const float* modp(const Params& p, int layer, int r, int which) {
  return p.modv + ((size_t)(layer * (B + 1) + r) * 6 + which) * D;
}

constexpr int N_MOD = DEPTH * (B + 1) * 6 * D;
HD void st_mod(const Params& p, int layer_unused, int idx) {
  int j = idx % (6 * D); int r = (idx / (6 * D)) % (B + 1); int l = idx / (6 * D * (B + 1));
  const float* cv = r < B ? p.c + (size_t)r * D : p.c_ctx;
  const float* w = p.mod_w + (size_t)l * D * 6 * D;
  float acc = p.mod_b[(size_t)l * 6 * D + j];
  for (int k = 0; k < D; ++k) acc += siluf(cv[k]) * w[(size_t)k * 6 * D + j];
  p.modv[idx] = acc;
}

constexpr int N_ROPE = 64 * 16;
constexpr int N_APOW = 2 * SSM_G * SSM_P * (SL + 1);
constexpr int N_BBAR = 2 * SSM_G * SSM_P * SSM_C;
constexpr int N_TABA = N_ROPE + N_APOW + N_BBAR + 1;
HD void st_taba(const Params& p, int layer_unused, int idx) {
  if (idx < N_ROPE) {
    int pos = idx / 16, f = idx % 16;
    float inv = powf(10000.0f, -(float)f / 16.0f);
    float ang = (float)pos * inv;
    p.ropeT[idx * 2] = cosf(ang); p.ropeT[idx * 2 + 1] = sinf(ang);
    return;
  }
  idx -= N_ROPE;
  if (idx < N_APOW) {
#ifndef HOST_EMU
    return;
#endif
    int k = idx % (SL + 1); int q = idx / (SL + 1);
    int dg = q / SSM_P;
    double dt = exp((double)p.log_step[dg]);
    double ar = p.a_re[q], ai = p.a_im[q];
    double mag = exp(k * dt * ar);
    p.apow[(size_t)idx * 2] = (float)(mag * cos(k * dt * ai));
    p.apow[(size_t)idx * 2 + 1] = (float)(mag * sin(k * dt * ai));
    return;
  }
  idx -= N_APOW;
  if (idx < N_BBAR) {
    int cc = idx % SSM_C; int q = idx / SSM_C; int dg = q / SSM_P;
    (void)cc;
    double dt = exp((double)p.log_step[dg]);
    double ar = p.a_re[q], ai = p.a_im[q];
    double mag = exp(dt * ar);
    double abr = mag * cos(dt * ai), abi = mag * sin(dt * ai);
    double den = ar * ar + ai * ai, nr = abr - 1.0;
    double cr = (nr * ar + abi * ai) / den, ci = (abi * ar - nr * ai) / den;
    double br = p.b_re[idx], bi = p.b_im[idx];
    p.bbar[(size_t)idx * 2] = (float)(cr * br - ci * bi);
    p.bbar[(size_t)idx * 2 + 1] = (float)(cr * bi + ci * br);
    return;
  }
  double s1 = 0, s2 = 0;
  for (int i = 0; i < HD_; ++i) { s1 += (double)p.lq1[i] * p.lk1[i]; s2 += (double)p.lq2[i] * p.lk2[i]; }
  double lam_init = 0.8 - 0.6 * exp(-0.3 * 1.0);
  p.scal[0] = (float)(exp(s1) - exp(s2) + lam_init);
  p.scal[1] = (float)(1.0 - lam_init);
}

constexpr int N_KT = 2 * SSM_G * SL * SSM_C * SSM_C;
HD void st_tabb(const Params& p, int layer_unused, int idx) {
  int ci = idx % SSM_C; int co = (idx / SSM_C) % SSM_C; int k = (idx / (SSM_C * SSM_C)) % SL; int dg = idx / (SSM_C * SSM_C * SL);
  float acc = 0.f;
  for (int pp = 0; pp < SSM_P; ++pp) {
    int q = dg * SSM_P + pp;
    float ar = p.apow[((size_t)q * (SL + 1) + k) * 2], ai = p.apow[((size_t)q * (SL + 1) + k) * 2 + 1];
    float br = p.bbar[((size_t)q * SSM_C + ci) * 2], bi = p.bbar[((size_t)q * SSM_C + ci) * 2 + 1];
    float cr = p.c_re[((size_t)dg * SSM_C + co) * SSM_P + pp], cim = p.c_im[((size_t)dg * SSM_C + co) * SSM_P + pp];
    float tr = ar * br - ai * bi, ti = ar * bi + ai * br;
    acc += cr * tr - cim * ti;
  }
  p.KT[idx] = acc;
}

HD void st_proj(const Params& p, int layer, int idx) {
  const int W = layer == 0 ? AB_IN : DIF_IN;
  const float* w = layer == 0 ? p.w_in_a : p.dif_w_in;
  const int rope_end = layer == 0 ? (SWA_QW + SWA_KVW) : (2 * DIF_QK);
  int t = idx / W, n = idx % W;
  int r = tok_r(t);
  if (layer == 1 && t >= TL && n < DIF_QK) return;
  const float* xr = xrow(p, layer, t);
  const float* sh = modp(p, layer, r, 0);
  const float* sc = modp(p, layer, r, 1);
  bool rope = (t < TL) && (n < rope_end);
  if (!rope) {
    float acc = 0.f;
    for (int k = 0; k < D; ++k) { float h = xr[k] * (1.0f + sc[k]) + sh[k]; acc += h * w[(size_t)k * W + n]; }
    p.P[(size_t)t * W + n] = f2bf(acc);
    return;
  }
  int d = n % 64, sub = d % 32;
  if (sub >= 16) return;
  float a1 = 0.f, a2 = 0.f;
  for (int k = 0; k < D; ++k) {
    float h = xr[k] * (1.0f + sc[k]) + sh[k];
    a1 += h * w[(size_t)k * W + n]; a2 += h * w[(size_t)k * W + n + 16];
  }
  int i = t % N;
  int pos = d < 32 ? i / GRID_W : i % GRID_W;
  float cs = p.ropeT[(pos * 16 + sub) * 2], sn = p.ropeT[(pos * 16 + sub) * 2 + 1];
  p.P[(size_t)t * W + n] = f2bf(a1 * cs - a2 * sn);
  p.P[(size_t)t * W + n + 16] = f2bf(a2 * cs + a1 * sn);
}

HD void st_swa(const Params& p, int layer, int idx) {
  int hq = idx / TA, t = idx % TA;
  int kvh = hq / 4;
  const uint16_t* P = p.P;
  float q[64], o[64];
  _Pragma("unroll") for (int d = 0; d < 64; ++d) { q[d] = bf2f(P[(size_t)t * AB_IN + hq * 64 + d]) * 0.125f; o[d] = 0.f; }
  float m = p.sink[hq], l = 1.0f;
  int b = t < TL ? t / N : (t - TL) / CTX;
  int nloc = t < TL ? 2 * SWA_WIN + 1 : 0;
  int i = t < TL ? t % N : 0;
  for (int kk = 0; kk < nloc + CTX; ++kk) {
    int row;
    if (kk < nloc) {
      int j = i - SWA_WIN + kk;
      if (j < 0 || j >= N) continue;
      row = b * N + j;
    } else row = TL + b * CTX + (kk - nloc);
    const uint16_t* kr = P + (size_t)row * AB_IN + A_KOFF + kvh * 64;
    const uint16_t* vr = P + (size_t)row * AB_IN + A_VOFF + kvh * 64;
    float s = 0.f;
    _Pragma("unroll") for (int d = 0; d < 64; ++d) s += q[d] * bf2f(kr[d]);
    if (s > m) { float f = expf(m - s); l *= f; for (int d = 0; d < 64; ++d) o[d] *= f; m = s; }
    float pe = expf(s - m);
    l += pe;
    _Pragma("unroll") for (int d = 0; d < 64; ++d) o[d] += pe * bf2f(vr[d]);
  }
  float il = 1.0f / l;
  _Pragma("unroll") for (int d = 0; d < 64; ++d) p.Ymix[(size_t)t * YW + hq * 64 + d] = f2bf(o[d] * il);
}

HD int ssm_row(int dir, int b, int tau) {
  if (dir == 0) return tau < CTX ? TL + b * CTX + tau : b * N + (tau - CTX);
  return tau < CTX ? TL + b * CTX + (CTX - 1 - tau) : b * N + (N - 1 - (tau - CTX));
}
constexpr int N_SSME = 2 * B * NCH * SSM_G * SSM_P;
HD void st_ssm_e(const Params& p, int layer, int idx) {
  int pp = idx % SSM_P; int g = (idx / SSM_P) % SSM_G; int ch = (idx / (SSM_P * SSM_G)) % NCH;
  int b = (idx / (SSM_P * SSM_G * NCH)) % B; int dir = idx / (SSM_P * SSM_G * NCH * B);
  int q = (dir * SSM_G + g) * SSM_P + pp;
  float er = 0.f, ei = 0.f;
  for (int j = 0; j < SL; ++j) {
    int row = ssm_row(dir, b, ch * SL + j);
    const uint16_t* u = p.P + (size_t)row * AB_IN + A_UOFF + g * 16;
    float vr = 0.f, vi = 0.f;
    _Pragma("unroll") for (int cc = 0; cc < 16; ++cc) {
      float uv = bf2f(u[cc]);
      vr += p.bbar[((size_t)q * 16 + cc) * 2] * uv; vi += p.bbar[((size_t)q * 16 + cc) * 2 + 1] * uv;
    }
    float ar = p.apow[((size_t)q * (SL + 1) + (SL - 1 - j)) * 2], ai = p.apow[((size_t)q * (SL + 1) + (SL - 1 - j)) * 2 + 1];
    er += ar * vr - ai * vi; ei += ar * vi + ai * vr;
  }
  p.E[(size_t)idx * 2] = er; p.E[(size_t)idx * 2 + 1] = ei;
}
constexpr int N_SSMC = 2 * B * SSM_G * SSM_P;
HD void st_ssm_c(const Params& p, int layer, int idx) {
  int pp = idx % SSM_P; int g = (idx / SSM_P) % SSM_G; int b = (idx / (SSM_P * SSM_G)) % B; int dir = idx / (SSM_P * SSM_G * B);
  int q = (dir * SSM_G + g) * SSM_P + pp;
  float ar = p.apow[((size_t)q * (SL + 1) + SL) * 2], ai = p.apow[((size_t)q * (SL + 1) + SL) * 2 + 1];
  float sr = 0.f, si = 0.f;
  for (int ch = 0; ch < NCH; ++ch) {
    size_t e = ((((size_t)dir * B + b) * NCH + ch) * SSM_G + g) * SSM_P + pp;
    p.Sin[e * 2] = sr; p.Sin[e * 2 + 1] = si;
    float er = p.E[e * 2], ei = p.E[e * 2 + 1];
    float nr = ar * sr - ai * si + er, ni = ar * si + ai * sr + ei;
    sr = nr; si = ni;
  }
}
HD void st_ssm_o(const Params& p, int layer, int idx) {
  int t = idx / SSM_W, n = idx % SSM_W; int g = n / 16, co = n % 16;
  int b, dirtau[2];
  if (t < TL) { b = t / N; int i = t % N; dirtau[0] = CTX + i; dirtau[1] = CTX + (N - 1 - i); }
  else { b = (t - TL) / CTX; int i = (t - TL) % CTX; dirtau[0] = i; dirtau[1] = CTX - 1 - i; }
  float y = p.ssm_d[n] * bf2f(p.P[(size_t)t * AB_IN + A_UOFF + n]);
  for (int dir = 0; dir < 2; ++dir) {
    int tau = dirtau[dir]; int ch = tau / SL, j = tau % SL;
    int dg = dir * SSM_G + g;
    size_t e0 = ((((size_t)dir * B + b) * NCH + ch) * SSM_G + g) * SSM_P;
    for (int pp = 0; pp < SSM_P; ++pp) {
      int q = dg * SSM_P + pp;
      float ar = p.apow[((size_t)q * (SL + 1) + (j + 1)) * 2], ai = p.apow[((size_t)q * (SL + 1) + (j + 1)) * 2 + 1];
      float sr = p.Sin[(e0 + pp) * 2], si = p.Sin[(e0 + pp) * 2 + 1];
      float tr = ar * sr - ai * si, ti = ar * si + ai * sr;
      float cr = p.c_re[((size_t)dg * 16 + co) * SSM_P + pp], cim = p.c_im[((size_t)dg * 16 + co) * SSM_P + pp];
      y += cr * tr - cim * ti;
    }
    for (int j2 = 0; j2 <= j; ++j2) {
      int row = ssm_row(dir, b, ch * SL + j2);
      const uint16_t* u = p.P + (size_t)row * AB_IN + A_UOFF + g * 16;
      const float* kt = p.KT + (((size_t)dg * SL + (j - j2)) * 16 + co) * 16;
      _Pragma("unroll") for (int ci = 0; ci < 16; ++ci) y += kt[ci] * bf2f(u[ci]);
    }
  }
  p.Gs[(size_t)t * SSM_W + n] = f2bf(geluf_(y));
}
HD void st_glu(const Params& p, int layer, int idx) {
  int t = idx / SSM_W, n = idx % SSM_W;
  float z = p.glu_b[n];
  const uint16_t* g = p.Gs + (size_t)t * SSM_W;
  for (int k = 0; k < SSM_W; ++k) z += bf2f(g[k]) * p.glu_w[(size_t)k * SSM_W + n];
  p.Ymix[(size_t)t * YW + SWA_QW + n] = f2bf(bf2f(g[n]) * sigmoidf_(z));
}

HD void st_dif(const Params& p, int layer, int idx) {
  int t = idx % TL; int he = idx / TL; int eh = he % 2, h = he / 2;
  int b = t / N;
  const uint16_t* P = p.P;
  float res[64];
  float lam = p.scal[0];
  _Pragma("unroll") for (int c = 0; c < 2; ++c) {
    float q[64], o[64];
    _Pragma("unroll") for (int d = 0; d < 64; ++d) { q[d] = bf2f(P[(size_t)t * DIF_IN + h * 128 + c * 64 + d]) * 0.125f; o[d] = 0.f; }
    float m = -1e30f, l = 0.f;
    for (int kk = 0; kk < N + CTX; ++kk) {
      int row = kk < N ? b * N + kk : TL + b * CTX + (kk - N);
      const uint16_t* kr = P + (size_t)row * DIF_IN + DIF_QK + h * 128 + c * 64;
      const uint16_t* vr = P + (size_t)row * DIF_IN + 2 * DIF_QK + h * 128 + eh * 64;
      float s = 0.f;
      _Pragma("unroll") for (int d = 0; d < 64; ++d) s += q[d] * bf2f(kr[d]);
      if (s > m) { float f = expf(m - s); l *= f; for (int d = 0; d < 64; ++d) o[d] *= f; m = s; }
      float pe = expf(s - m);
      l += pe;
      _Pragma("unroll") for (int d = 0; d < 64; ++d) o[d] += pe * bf2f(vr[d]);
    }
    float il = 1.0f / l;
    if (c == 0) { for (int d = 0; d < 64; ++d) res[d] = o[d] * il; }
    else { for (int d = 0; d < 64; ++d) res[d] -= lam * o[d] * il; }
  }
  _Pragma("unroll") for (int d = 0; d < 64; ++d) p.Ymix[(size_t)t * YW + h * 128 + eh * 64 + d] = f2bf(res[d]);
}
HD void st_difnorm(const Params& p, int layer, int idx) {
  int t = idx / DIF_H, h = idx % DIF_H;
  uint16_t* o = p.Ymix + (size_t)t * YW + h * 128;
  float ss = 0.f;
  for (int e = 0; e < 128; ++e) { float v = bf2f(o[e]); ss += v * v; }
  float r = 1.0f / sqrtf(ss / 128.0f + RMS_EPS) * p.scal[1];
  _Pragma("unroll 8") for (int e = 0; e < 128; ++e) o[e] = f2bf(bf2f(o[e]) * r * p.subln_g[e]);
}

HD void st_outproj(const Params& p, int layer, int idx) {
  int t = idx / D, n = idx % D;
  const float* w = layer == 0 ? p.w_out_a : p.dif_w_out;
  const uint16_t* y = p.Ymix + (size_t)t * YW;
  const int KW = layer == 0 ? AB_OUT : DIF_VW;
  float acc = 0.f;
  for (int k = 0; k < KW; ++k) acc += bf2f(y[k]) * w[(size_t)k * D + n];
  p.F[(size_t)t * D + n] = acc;
}
HD void st_ln1(const Params& p, int layer, int t) {
  int r = tok_r(t);
  const float* xr = xrow(p, layer, t); const float* g1 = modp(p, layer, r, 2);
  const float* y = p.F + (size_t)t * D;
  float mu = 0.f;
  for (int k = 0; k < D; ++k) mu += ALPHA * xr[k] + g1[k] * y[k];
  mu /= D;
  float var = 0.f;
  for (int k = 0; k < D; ++k) { float v = ALPHA * xr[k] + g1[k] * y[k] - mu; var += v * v; }
  var /= D;
  float rs = 1.0f / sqrtf(var + LN_EPS);
  const float* lg = p.ln1_g + (size_t)layer * D; const float* lb = p.ln1_b + (size_t)layer * D;
  for (int k = 0; k < D; ++k) p.X1[(size_t)t * D + k] = (ALPHA * xr[k] + g1[k] * y[k] - mu) * rs * lg[k] + lb[k];
}
HD void st_route(const Params& p, int layer, int t) {
  int r = tok_r(t);
  const float* x1 = p.X1 + (size_t)t * D; const float* sh = modp(p, layer, r, 3); const float* sc = modp(p, layer, r, 4);
  float lg[MOE_G];
  _Pragma("unroll") for (int g = 0; g < MOE_G; ++g) lg[g] = p.moe_bg[layer * MOE_G + g];
  const float* wg = p.moe_wg + (size_t)layer * D * MOE_G;
  for (int k = 0; k < D; ++k) {
    float h = x1[k] * (1.0f + sc[k]) + sh[k];
    _Pragma("unroll") for (int g = 0; g < MOE_G; ++g) lg[g] += h * wg[k * MOE_G + g];
  }
  int gi = 0; float mx = lg[0];
  _Pragma("unroll") for (int g = 1; g < MOE_G; ++g) if (lg[g] > mx) { mx = lg[g]; gi = g; }
  float den = 0.f;
  _Pragma("unroll") for (int g = 0; g < MOE_G; ++g) den += expf(lg[g] - mx);
  float gp = 1.0f / den;
  float le[MOE_EPG];
  _Pragma("unroll") for (int e = 0; e < MOE_EPG; ++e) le[e] = p.moe_be[(layer * MOE_G + gi) * MOE_EPG + e];
  const float* we = p.moe_we + ((size_t)layer * MOE_G + gi) * D * MOE_EPG;
  for (int k = 0; k < D; ++k) {
    float h = x1[k] * (1.0f + sc[k]) + sh[k];
    _Pragma("unroll") for (int e = 0; e < MOE_EPG; ++e) le[e] += h * we[k * MOE_EPG + e];
  }
  int i0 = 0; float v0 = le[0];
  _Pragma("unroll") for (int e = 1; e < MOE_EPG; ++e) if (le[e] > v0) { v0 = le[e]; i0 = e; }
  int i1 = -1; float v1 = -3e38f;
  _Pragma("unroll") for (int e = 0; e < MOE_EPG; ++e) if (e != i0 && le[e] > v1) { v1 = le[e]; i1 = e; }
  float e1 = expf(v1 - v0);
  float w0 = gp / (1.0f + e1), w1 = gp * e1 / (1.0f + e1);
  p.route[(size_t)t * 4 + 0] = (float)(gi * MOE_EPG + i0);
  p.route[(size_t)t * 4 + 1] = (float)(gi * MOE_EPG + i1);
  p.route[(size_t)t * 4 + 2] = w0;
  p.route[(size_t)t * 4 + 3] = w1;
}
HD void st_moe_h(const Params& p, int layer, int idx) {
  int f = idx % MOE_F; int j = (idx / MOE_F) % 2; int t = idx / (2 * MOE_F);
  int r = tok_r(t);
  const float* x1 = p.X1 + (size_t)t * D; const float* sh = modp(p, layer, r, 3); const float* sc = modp(p, layer, r, 4);
  int e = (int)p.route[(size_t)t * 4 + j]; float wgt = p.route[(size_t)t * 4 + 2 + j];
  const float* w1 = p.moe_w1 + ((size_t)layer * MOE_E + e) * D * MOE_F;
  const float* w3 = p.moe_w3 + ((size_t)layer * MOE_E + e) * D * MOE_F;
  float h1 = 0.f, h3 = 0.f;
  for (int k = 0; k < D; ++k) {
    float h = x1[k] * (1.0f + sc[k]) + sh[k];
    h1 += h * w1[(size_t)k * MOE_F + f]; h3 += h * w3[(size_t)k * MOE_F + f];
  }
  p.HH[(size_t)idx] = siluf(h1) * h3 * wgt;
}
HD void st_moe_o(const Params& p, int layer, int idx) {
  int t = idx / D, n = idx % D;
  float acc = 0.f;
  for (int j = 0; j < 2; ++j) {
    int e = (int)p.route[(size_t)t * 4 + j];
    const float* w2 = p.moe_w2 + ((size_t)layer * MOE_E + e) * MOE_F * D;
    const float* hh = p.HH + ((size_t)t * 2 + j) * MOE_F;
    for (int f = 0; f < MOE_F; ++f) acc += hh[f] * w2[(size_t)f * D + n];
  }
  p.F[(size_t)t * D + n] = acc;
}
HD void st_ln2(const Params& p, int layer, int t) {
  int r = tok_r(t);
  const float* x1 = p.X1 + (size_t)t * D; const float* g2 = modp(p, layer, r, 5);
  const float* y = p.F + (size_t)t * D;
  float mu = 0.f;
  for (int k = 0; k < D; ++k) mu += ALPHA * x1[k] + g2[k] * y[k];
  mu /= D;
  float var = 0.f;
  for (int k = 0; k < D; ++k) { float v = ALPHA * x1[k] + g2[k] * y[k] - mu; var += v * v; }
  var /= D;
  float rs = 1.0f / sqrtf(var + LN_EPS);
  const float* lg = p.ln2_g + (size_t)layer * D; const float* lb = p.ln2_b + (size_t)layer * D;
  float* dst = layer == DEPTH - 1 ? p.out + (size_t)t * D : p.X + (size_t)t * D;
  for (int k = 0; k < D; ++k) dst[k] = (ALPHA * x1[k] + g2[k] * y[k] - mu) * rs * lg[k] + lb[k];
}

enum { S_MOD, S_TABA, S_TABB, S_PROJ, S_SWA, S_SSME, S_SSMC, S_SSMO, S_GLU, S_DIF, S_DIFNORM, S_OUTPROJ, S_LN1, S_ROUTE, S_MOEH, S_MOEO, S_LN2 };
template <int S> HD void run_elem(const Params& p, int layer, int idx) {
  if (S == S_MOD) st_mod(p, layer, idx);
  else if (S == S_TABA) st_taba(p, layer, idx);
  else if (S == S_TABB) st_tabb(p, layer, idx);
  else if (S == S_PROJ) st_proj(p, layer, idx);
  else if (S == S_SWA) st_swa(p, layer, idx);
  else if (S == S_SSME) st_ssm_e(p, layer, idx);
  else if (S == S_SSMC) st_ssm_c(p, layer, idx);
  else if (S == S_SSMO) st_ssm_o(p, layer, idx);
  else if (S == S_GLU) st_glu(p, layer, idx);
  else if (S == S_DIF) st_dif(p, layer, idx);
  else if (S == S_DIFNORM) st_difnorm(p, layer, idx);
  else if (S == S_OUTPROJ) st_outproj(p, layer, idx);
  else if (S == S_LN1) st_ln1(p, layer, idx);
  else if (S == S_ROUTE) st_route(p, layer, idx);
  else if (S == S_MOEH) st_moe_h(p, layer, idx);
  else if (S == S_MOEO) st_moe_o(p, layer, idx);
  else if (S == S_LN2) st_ln2(p, layer, idx);
}

constexpr int NSLOT = 2 * TA + MOE_E * 256;
constexpr size_t CTL_BYTES = 1u << 20;
struct WsLayout {
  size_t A2, BtY, BtE, apow16, KT16, E16, Ypart, wgbase;
  size_t ctl, X, X1, P, Ymix, Gs, modv, ropeT, apow, bbar, KT, E, Sin, route, scal, WinA_t, DifIn_t, WoutA_t, DifOut_t, Glu_t, W13t, W2t, gate, tokslot, moe_meta, total;
};
inline WsLayout ws_layout() {
  WsLayout L; size_t o = 0;
  auto take = [&](size_t bytes) { size_t r = o; o += (bytes + 255) & ~(size_t)255; return r; };
  L.ctl = take(CTL_BYTES);
  L.X = take((size_t)TA * D * 4);
  L.X1 = L.X;
  L.P = take((size_t)TA * (AB_IN > DIF_IN ? AB_IN : DIF_IN) * 2);
  L.Ymix = take((size_t)TA * YW * 2);
  L.Gs = L.X;
  L.modv = take((size_t)N_MOD * 4);
  L.ropeT = take((size_t)N_ROPE * 2 * 4);
  L.apow = take((size_t)N_APOW * 2 * 4);
  L.bbar = take((size_t)N_BBAR * 2 * 4);
  L.KT = take((size_t)N_KT * 4);
  L.E = L.X + (((size_t)TA * SSM_W * 2 + 255) & ~(size_t)255);
  L.Sin = L.E + (((size_t)N_SSME * 2 * 4 + 255) & ~(size_t)255);
  L.route = take((size_t)TA * 8 * 4);
  L.scal = take(256);
  L.WinA_t = take((size_t)AB_IN * D * 2);
  L.DifIn_t = take((size_t)DIF_IN * D * 2);
  L.WoutA_t = take((size_t)D * AB_OUT * 2);
  L.DifOut_t = take((size_t)D * DIF_VW * 2);
  L.Glu_t = take((size_t)SSM_W * SSM_W * 2);
  L.W13t = take((size_t)MOE_E * 2 * MOE_F * D * 2);
  L.W2t = take((size_t)MOE_E * D * MOE_F * 2);
  L.gate = take((size_t)NSLOT * 4);
  L.tokslot = take((size_t)TA * 2 * 4);
  L.moe_meta = take(8192);
  L.wgbase = take((size_t)DEPTH * 1024 * MOE_E * 4);
  L.BtY = take((size_t)2 * SSM_G * 256 * 384 * 2);
  L.BtE = take((size_t)2 * SSM_G * 256 * 256 * 2);
  L.apow16 = take((size_t)2 * SSM_G * SSM_P * 17 * 2 * 4);
  L.KT16 = take((size_t)2 * SSM_G * 16 * 256 * 4);
  L.A2 = L.P + (size_t)48 * 1024 * 1024;
  L.E16 = L.X + (size_t)19 * 1024 * 1024;
  L.Ypart = L.E16;
  L.total = o;
  return L;
}
inline void fill_ws(Params& p, char* ws) {
  WsLayout L = ws_layout();
  p.X = (float*)(ws + L.X); p.X1 = (float*)(ws + L.X1); p.P = (uint16_t*)(ws + L.P); p.F = (float*)(ws + L.P);
  p.Ymix = (uint16_t*)(ws + L.Ymix); p.HH = (float*)(ws + L.Ymix);
  p.Gs = (uint16_t*)(ws + L.Gs); p.modv = (float*)(ws + L.modv); p.ropeT = (float*)(ws + L.ropeT);
  p.apow = (float*)(ws + L.apow); p.bbar = (float*)(ws + L.bbar); p.KT = (float*)(ws + L.KT);
  p.E = (float*)(ws + L.E); p.Sin = (float*)(ws + L.Sin); p.route = (float*)(ws + L.route); p.scal = (float*)(ws + L.scal);
  p.H = (uint16_t*)(ws + L.Ymix); p.WinA_t = (uint16_t*)(ws + L.WinA_t); p.DifIn_t = (uint16_t*)(ws + L.DifIn_t); p.ctl = (unsigned*)(ws + L.ctl);
  p.WoutA_t = (uint16_t*)(ws + L.WoutA_t); p.DifOut_t = (uint16_t*)(ws + L.DifOut_t); p.Glu_t = (uint16_t*)(ws + L.Glu_t);
  p.W13t = (uint16_t*)(ws + L.W13t); p.W2t = (uint16_t*)(ws + L.W2t);
  p.Amoe = (uint16_t*)(ws + L.P); p.F2 = (uint16_t*)(ws + L.P); p.HHb = (uint16_t*)(ws + L.Ymix);
  p.A2 = (uint16_t*)(ws + L.A2); p.BtY = (uint16_t*)(ws + L.BtY); p.BtE = (uint16_t*)(ws + L.BtE);
  p.apow16 = (float*)(ws + L.apow16); p.KT16 = (float*)(ws + L.KT16); p.E16 = (float*)(ws + L.E16); p.Ypart = (float*)(ws + L.Ypart);
  p.wgbase = (int*)(ws + L.wgbase);
  p.gate = (float*)(ws + L.gate); p.tokslot = (int*)(ws + L.tokslot); p.moe_meta = (int*)(ws + L.moe_meta);
}
inline void fill_inputs(Params& p, void* const* d_in) {
  const float* const* in = (const float* const*)d_in;
  p.x = in[0]; p.c = in[1]; p.ctx = in[2]; p.c_ctx = in[3]; p.mod_w = in[4]; p.mod_b = in[5];
  p.ln1_g = in[6]; p.ln1_b = in[7]; p.ln2_g = in[8]; p.ln2_b = in[9];
  p.w_in_a = in[10]; p.w_out_a = in[11]; p.sink = in[12]; p.a_re = in[13]; p.a_im = in[14]; p.log_step = in[15];
  p.b_re = in[16]; p.b_im = in[17]; p.c_re = in[18]; p.c_im = in[19]; p.ssm_d = in[20]; p.glu_w = in[21]; p.glu_b = in[22];
  p.dif_w_in = in[23]; p.dif_w_out = in[24]; p.lq1 = in[25]; p.lk1 = in[26]; p.lq2 = in[27]; p.lk2 = in[28]; p.subln_g = in[29];
  p.moe_wg = in[30]; p.moe_bg = in[31]; p.moe_we = in[32]; p.moe_be = in[33]; p.moe_w1 = in[34]; p.moe_w3 = in[35]; p.moe_w2 = in[36];
}

#define FORWARD_PROGRAM(RUN)                                   \
  RUN(S_MOD, 0, N_MOD)                                         \
  RUN(S_TABA, 0, N_TABA)                                       \
  RUN(S_TABB, 0, N_KT)                                         \
                                                   \
  RUN(S_PROJ, 0, TA * AB_IN)                                   \
  RUN(S_SWA, 0, SWA_H * TA)                                    \
  RUN(S_SSME, 0, N_SSME)                                       \
  RUN(S_SSMC, 0, N_SSMC)                                       \
  RUN(S_SSMO, 0, TA * SSM_W)                                   \
  RUN(S_GLU, 0, TA * SSM_W)                                    \
  RUN(S_OUTPROJ, 0, TA * D)                                    \
  RUN(S_LN1, 0, TA)                                            \
  RUN(S_ROUTE, 0, TA)                                          \
  RUN(S_MOEH, 0, TA * 2 * MOE_F)                               \
  RUN(S_MOEO, 0, TA * D)                                       \
  RUN(S_LN2, 0, TA)                                            \
                                                   \
  RUN(S_PROJ, 1, TA * DIF_IN)                                  \
  RUN(S_DIF, 1, DIF_H * 2 * TL)                                \
  RUN(S_DIFNORM, 1, TL * DIF_H)                                \
  RUN(S_OUTPROJ, 1, TL * D)                                    \
  RUN(S_LN1, 1, TL)                                            \
  RUN(S_ROUTE, 1, TL)                                          \
  RUN(S_MOEH, 1, TL * 2 * MOE_F)                               \
  RUN(S_MOEO, 1, TL * D)                                       \
  RUN(S_LN2, 1, TL)

#ifndef HOST_EMU
#include <cstdio>
#define LAS __attribute__((address_space(3)))
#define GAS __attribute__((address_space(1)))
typedef unsigned short bf16_t;
typedef short bf16x8 __attribute__((ext_vector_type(8)));
typedef float f32x4 __attribute__((ext_vector_type(4)));
typedef float f32x2 __attribute__((ext_vector_type(2)));
typedef unsigned u32x4 __attribute__((ext_vector_type(4)));
typedef unsigned u32x2 __attribute__((ext_vector_type(2)));
constexpr int NWAVES = 8, NTHR = 512;
constexpr int RING_BYTES = 131072, LDSCTL_OFF = RING_BYTES, MISC_OFF = LDSCTL_OFF + 320, LDS_BYTES = 147456;
#define LDS_WAIT() asm volatile("s_waitcnt lgkmcnt(0)" ::: "memory")
#define VM_WAIT() asm volatile("s_waitcnt vmcnt(0)" ::: "memory")
__device__ __forceinline__ unsigned cvt_pk_bf16(float lo, float hi) { unsigned r; asm volatile("v_cvt_pk_bf16_f32 %0, %1, %2" : "=v"(r) : "v"(lo), "v"(hi)); return r; }

namespace pg8 {
constexpr int BM = 256, BK = 64, HALF = 128, HTB = HALF * BK * 2, STAGE_BYTES = 8 * HTB, NXCD = 8, WGM = 8;
__host__ __device__ __forceinline__ int lds_byte(int r, int c) { const int st = (r >> 4) * 2 + (c >> 5), rr = r & 15, cc = c & 31, ob = rr * 64 + cc * 2; return st * 1024 + (ob ^ (((ob >> 9) & 1) << 5)); }
__host__ __device__ __forceinline__ void stage_rc(int b, int& R, int& C) { const int st = b / 1024, sb = b % 1024, swz = sb ^ (((sb >> 9) & 1) << 5); R = (st >> 1) * 16 + swz / 64; C = (st & 1) * 32 + (swz % 64) / 2; }
__host__ __device__ __forceinline__ int perm32(int rho) { const int n = rho >> 4, i = rho & 15; return 8 * (i >> 2) + 4 * n + (i & 3); }
struct Unit { int pm, pn; };
struct Gemm { const bf16_t* A; const bf16_t* Bt; int lda, ldb, K; };

struct StaticOrder {
  int nM, nN, nwg, G, c;
  __device__ void init(int M, int N, int G_, int c_) { nM = M / BM; nN = N / BM; nwg = nM * nN; G = G_; c = c_; }
  __device__ bool next(int i, Unit& u) const { return at((long)i * G + c, u); }
  __device__ bool at(long L, Unit& u) const {
    if (L >= nwg) return false;
    int wgid = (int)L; { const int q = nwg / NXCD, r = nwg % NXCD, xcd = wgid % NXCD, off = wgid / NXCD; wgid = (xcd < r ? xcd * (q + 1) : r * (q + 1) + (xcd - r) * q) + off; }
    const int nig = WGM * nN, gid = wgid / nig, fm = gid * WGM, gsz = (nM - fm) < WGM ? (nM - fm) : WGM;
    u.pm = fm + ((wgid % nig) % gsz); u.pn = (wgid % nig) / gsz; return true;
  }
  __device__ __forceinline__ void a_ready(const Unit&) const {}
  __device__ __forceinline__ void done(const Unit&) const {}
};

template <class Epi, class Sched, bool ALIGN_EPI = true, bool SP2 = true>
__device__ __forceinline__ void gemm_phase(LAS unsigned char* lds, const Gemm g, const Sched& S, const Epi& E) {
  int tid = threadIdx.x; asm volatile("" : "+v"(tid));
  const int wid = __builtin_amdgcn_readfirstlane(tid >> 6), lane = tid & 63, wr = wid >> 2, wc = wid & 3, fr = lane & 15, fq = lane >> 4;
  const int K = g.K, nt = K / BK;
  unsigned voffA[2], voffB[2];
#pragma unroll
  for (int i = 0; i < 2; ++i) { int R, C; stage_rc(tid * 16 + i * 8192, R, C); const int Rb = Epi::PERM ? ((R & ~31) + perm32(R & 31)) : R;
    voffA[i] = (unsigned)(R * g.lda + C) * 2u; voffB[i] = (unsigned)(Rb * g.ldb + C) * 2u; }
  const size_t kstep = (size_t)(BK * 2);
  const size_t hA = (size_t)HALF * g.lda * 2, hB = (size_t)HALF * g.ldb * 2;
  const size_t tA = 2 * hA, tB = 2 * hB;
  const unsigned ldsw = (unsigned)wid * 1024u;
  const int aoff = lds_byte(wr * 64 + fr, fq * 8), boff = lds_byte(wc * 32 + fr, fq * 8);
#define PG8_SA(b, h) (((b) * 2 + (h)) * HTB)
#define PG8_SB(b, h) ((4 + (b) * 2 + (h)) * HTB)
#define PG8_STAGE(bufoff, gbase, voff) do { _Pragma("unroll") for (int _i = 0; _i < 2; ++_i) \
    __builtin_amdgcn_global_load_lds((const unsigned*)((const char*)(gbase) + (voff)[_i]), (LAS unsigned*)(lds + (bufoff) + ldsw + _i * 8192), 16, 0, 0); } while (0)
#define PG8_LDA(dst, b, h) do { _Pragma("unroll") for (int m = 0; m < 4; ++m) _Pragma("unroll") for (int k = 0; k < 2; ++k) dst[m][k] = *(const LAS bf16x8*)(lds + PG8_SA(b, h) + aoff + m * 2048 + k * 1024); } while (0)
#define PG8_LDB(dst, b, h) do { _Pragma("unroll") for (int n = 0; n < 2; ++n) _Pragma("unroll") for (int k = 0; k < 2; ++k) dst[n][k] = *(const LAS bf16x8*)(lds + PG8_SB(b, h) + boff + n * 2048 + k * 1024); } while (0)
#define PG8_MMA(ai, bj, At, Bt) do { __builtin_amdgcn_s_setprio(1); _Pragma("unroll") for (int m = 0; m < 4; ++m) _Pragma("unroll") for (int n = 0; n < 2; ++n) _Pragma("unroll") for (int k = 0; k < 2; ++k) \
    acc[ai][bj][m][n] = __builtin_amdgcn_mfma_f32_16x16x32_bf16(Bt[n][k], At[m][k], acc[ai][bj][m][n], 0, 0, 0); __builtin_amdgcn_s_setprio(0); } while (0)
#define PG8_WAIT_V(n) asm volatile("s_waitcnt vmcnt(" #n ")" ::: "memory")
#define PG8_WAIT_L(n) asm volatile("s_waitcnt lgkmcnt(" #n ")" ::: "memory")
#define PG8_BAR __builtin_amdgcn_s_barrier()
#define PG8_SCHED __builtin_amdgcn_sched_barrier(0)
  Unit cur, nxt; int ui = 0;
  if (!S.next(0, cur)) return;
  f32x4 acc[2][2][4][2];
#pragma unroll
  for (int a = 0; a < 2; ++a)
#pragma unroll
    for (int b = 0; b < 2; ++b)
#pragma unroll
      for (int m = 0; m < 4; ++m)
#pragma unroll
        for (int n = 0; n < 2; ++n) acc[a][b][m][n] = (f32x4){0.f, 0.f, 0.f, 0.f};
  bf16x8 At[4][2], B0[2][2], B1[2][2];
  const char* cA = (const char*)g.A + (size_t)cur.pm * tA; const char* cB = (const char*)g.Bt + (size_t)cur.pn * tB;
  S.a_ready(cur);
  if constexpr (SP2) {
    PG8_STAGE(PG8_SB(0, 0), cB, voffB); PG8_STAGE(PG8_SB(0, 1), cB + hB, voffB); PG8_STAGE(PG8_SA(0, 0), cA, voffA); PG8_STAGE(PG8_SA(0, 1), cA + hA, voffA);
    if (wr == 1) PG8_BAR;
    PG8_WAIT_V(2); PG8_BAR;
    PG8_STAGE(PG8_SB(1, 0), cB + kstep, voffB); PG8_STAGE(PG8_SA(1, 0), cA + kstep, voffA); PG8_STAGE(PG8_SB(1, 1), cB + hB + kstep, voffB);
    PG8_WAIT_V(6); PG8_BAR;
  } else {
    PG8_STAGE(PG8_SB(0, 0), cB, voffB); PG8_STAGE(PG8_SA(0, 0), cA, voffA); PG8_STAGE(PG8_SB(0, 1), cB + hB, voffB); PG8_STAGE(PG8_SA(0, 1), cA + hA, voffA);
    if (wr == 1) PG8_BAR;
    PG8_WAIT_V(4); PG8_BAR;
    PG8_STAGE(PG8_SB(1, 0), cB + kstep, voffB); PG8_STAGE(PG8_SA(1, 0), cA + kstep, voffA); PG8_STAGE(PG8_SB(1, 1), cB + hB + kstep, voffB);
    PG8_WAIT_V(6); PG8_BAR;
  }
  for (;;) {
    const bool has_next = S.next(ui + 1, nxt);
    const char* nA = has_next ? (const char*)g.A + (size_t)nxt.pm * tA : cA; const char* nB = has_next ? (const char*)g.Bt + (size_t)nxt.pn * tB : cB;
#pragma unroll 1
    for (int t = 0; t < nt; t += 2) {
      const bool last = (t == nt - 2);
      const char* a1 = cA + (size_t)(t + 1) * kstep;
      const char* a2 = last ? nA : cA + (size_t)(t + 2) * kstep; const char* b2 = last ? nB : cB + (size_t)(t + 2) * kstep;
      const char* a3 = a2 + kstep; const char* b3 = b2 + kstep;
      if (last && has_next) S.a_ready(nxt);
      if constexpr (SP2) {
        PG8_LDB(B0, 0, 0); PG8_LDB(B1, 0, 1); PG8_SCHED; PG8_LDA(At, 0, 0); PG8_STAGE(PG8_SA(1, 1), a1 + hA, voffA);
        PG8_WAIT_V(8); PG8_WAIT_L(0); PG8_BAR; PG8_MMA(0, 0, At, B0); PG8_MMA(0, 1, At, B1); PG8_BAR; PG8_SCHED;
        PG8_LDA(At, 0, 1); PG8_STAGE(PG8_SB(0, 0), b2, voffB); PG8_STAGE(PG8_SB(0, 1), b2 + hB, voffB); PG8_STAGE(PG8_SA(0, 0), a2, voffA);
        PG8_WAIT_V(8); PG8_WAIT_L(0); PG8_BAR; PG8_MMA(1, 0, At, B0); PG8_MMA(1, 1, At, B1); PG8_BAR; PG8_SCHED;
        PG8_LDB(B0, 1, 0); PG8_LDB(B1, 1, 1); PG8_SCHED; PG8_LDA(At, 1, 0); PG8_STAGE(PG8_SA(0, 1), a2 + hA, voffA);
        PG8_WAIT_V(8); PG8_WAIT_L(0); PG8_BAR; PG8_MMA(0, 0, At, B0); PG8_MMA(0, 1, At, B1); PG8_BAR; PG8_SCHED;
        PG8_LDA(At, 1, 1); PG8_STAGE(PG8_SB(1, 0), b3, voffB); PG8_STAGE(PG8_SB(1, 1), b3 + hB, voffB); PG8_STAGE(PG8_SA(1, 0), a3, voffA);
        PG8_WAIT_V(8); PG8_WAIT_L(0); PG8_BAR; PG8_MMA(1, 0, At, B0); PG8_MMA(1, 1, At, B1); PG8_BAR; PG8_SCHED;
      } else {
        PG8_LDB(B0, 0, 0); PG8_SCHED; PG8_LDA(At, 0, 0); PG8_STAGE(PG8_SA(1, 1), a1 + hA, voffA);
        PG8_WAIT_L(8); PG8_BAR; PG8_WAIT_L(0); PG8_MMA(0, 0, At, B0); PG8_BAR; PG8_SCHED;
        PG8_LDB(B1, 0, 1); PG8_STAGE(PG8_SB(0, 0), b2, voffB);
        PG8_BAR; PG8_WAIT_L(0); PG8_MMA(0, 1, At, B1); PG8_BAR;
        PG8_LDA(At, 0, 1); PG8_STAGE(PG8_SA(0, 0), a2, voffA);
        PG8_BAR; PG8_WAIT_L(0); PG8_MMA(1, 0, At, B0); PG8_BAR; PG8_SCHED;
        PG8_STAGE(PG8_SB(0, 1), b2 + hB, voffB);
        PG8_WAIT_V(6); PG8_BAR; PG8_MMA(1, 1, At, B1); PG8_BAR;
        PG8_LDB(B0, 1, 0); PG8_SCHED; PG8_LDA(At, 1, 0); PG8_STAGE(PG8_SA(0, 1), a2 + hA, voffA);
        PG8_WAIT_L(8); PG8_BAR; PG8_WAIT_L(0); PG8_MMA(0, 0, At, B0); PG8_BAR; PG8_SCHED;
        PG8_LDB(B1, 1, 1); PG8_STAGE(PG8_SB(1, 0), b3, voffB);
        PG8_BAR; PG8_WAIT_L(0); PG8_MMA(0, 1, At, B1); PG8_BAR;
        PG8_LDA(At, 1, 1); PG8_STAGE(PG8_SA(1, 0), a3, voffA);
        PG8_BAR; PG8_WAIT_L(0); PG8_MMA(1, 0, At, B0); PG8_BAR; PG8_SCHED;
        PG8_STAGE(PG8_SB(1, 1), b3 + hB, voffB);
        PG8_WAIT_V(6); PG8_BAR; PG8_MMA(1, 1, At, B1); PG8_BAR;
      }
    }
    if constexpr (ALIGN_EPI) { if (wr == 0) PG8_BAR; }
    E(acc, cur, wr, wc, fr, fq); S.done(cur);
    if (!has_next) break;
#pragma unroll
    for (int a = 0; a < 2; ++a)
#pragma unroll
      for (int b = 0; b < 2; ++b)
#pragma unroll
        for (int m = 0; m < 4; ++m)
#pragma unroll
          for (int n = 0; n < 2; ++n) acc[a][b][m][n] = (f32x4){0.f, 0.f, 0.f, 0.f};
    cur = nxt; cA = nA; cB = nB; ++ui;
    if constexpr (ALIGN_EPI) { if (wr == 1) PG8_BAR; }
  }
  PG8_WAIT_V(0);
  if constexpr (!ALIGN_EPI) { if (wr == 0) PG8_BAR; }
  PG8_BAR;
#undef PG8_SA
#undef PG8_SB
#undef PG8_STAGE
#undef PG8_LDA
#undef PG8_LDB
#undef PG8_MMA
#undef PG8_WAIT_V
#undef PG8_WAIT_L
#undef PG8_BAR
#undef PG8_SCHED
}
}

constexpr int LC = 16, NCH16 = SS / LC, GROWS = 1280, A2K = 384;
static_assert(B * NCH16 <= GROWS && GROWS % 256 == 0, "ssm group rows");
__device__ __forceinline__ void ssm_tau(int t, int& b, int& tau0, int& tau1) {
  if (t < TL) { b = t / N; const int i = t % N; tau0 = CTX + i; tau1 = CTX + (N - 1 - i); }
  else { b = (t - TL) / CTX; const int i = (t - TL) % CTX; tau0 = i; tau1 = CTX - 1 - i; }
}
struct EpiProj {
  static constexpr bool PERM = false;
  bf16_t* O; int ldc; int rope_end; const float* ropeT; bf16_t* A2;
  __device__ __forceinline__ void operator()(const f32x4 (&acc)[2][2][4][2], const pg8::Unit& u, int wr, int wc, int fr, int fq) const {
    const int row0 = u.pm * 256 + wr * 64 + fr, colb = u.pn * 256 + wc * 32;
    const bool rope_cols = colb < rope_end;
#pragma unroll
    for (int ai = 0; ai < 2; ++ai)
#pragma unroll
      for (int m = 0; m < 4; ++m) {
        const int r = row0 + ai * 128 + m * 16;
        bf16_t* rowp = O + (size_t)r * ldc + colb + 4 * fq;
        f32x4 cs0 = {1.f, 0.f, 1.f, 0.f}, cs1 = {1.f, 0.f, 1.f, 0.f};
        const bool rp = rope_cols && (r < TL);
        if (rp) { const int i = r % N; const int pos = (wc & 1) ? (i % GRID_W) : (i / GRID_W);
          const f32x4* tp = (const f32x4*)(ropeT + (size_t)(pos * 16 + 4 * fq) * 2); cs0 = tp[0]; cs1 = tp[1]; }
#pragma unroll
        for (int bj = 0; bj < 2; ++bj) {
          const bool rpb = rp && (colb + bj * 128 < rope_end);
          f32x4 a1 = acc[ai][bj][m][0], a2 = acc[ai][bj][m][1];
          f32x4 o1 = a1, o2 = a2;
          if (rpb) {
            o1[0] = a1[0] * cs0[0] - a2[0] * cs0[1]; o2[0] = a2[0] * cs0[0] + a1[0] * cs0[1];
            o1[1] = a1[1] * cs0[2] - a2[1] * cs0[3]; o2[1] = a2[1] * cs0[2] + a1[1] * cs0[3];
            o1[2] = a1[2] * cs1[0] - a2[2] * cs1[1]; o2[2] = a2[2] * cs1[0] + a1[2] * cs1[1];
            o1[3] = a1[3] * cs1[2] - a2[3] * cs1[3]; o2[3] = a2[3] * cs1[2] + a1[3] * cs1[3];
          }
          u32x2 w1 = {cvt_pk_bf16(o1[0], o1[1]), cvt_pk_bf16(o1[2], o1[3])}, w2 = {cvt_pk_bf16(o2[0], o2[1]), cvt_pk_bf16(o2[2], o2[3])};
          *(u32x2*)(rowp + bj * 128) = w1; *(u32x2*)(rowp + bj * 128 + 16) = w2;
          if (A2 != nullptr && colb + bj * 128 >= A_UOFF) {
            int b, tau0, tau1; ssm_tau(r, b, tau0, tau1);
            const int g0 = (colb + bj * 128 - A_UOFF) / 16;
            bf16_t* d0 = A2 + (((size_t)g0 * GROWS + b * NCH16 + tau0 / LC) * A2K + (tau0 % LC) * 16 + 4 * fq);
            bf16_t* d1 = A2 + (((size_t)(SSM_G + g0) * GROWS + b * NCH16 + tau1 / LC) * A2K + (tau1 % LC) * 16 + 4 * fq);
            *(u32x2*)d0 = w1; *(u32x2*)(d0 + (size_t)GROWS * A2K) = w2; *(u32x2*)d1 = w1; *(u32x2*)(d1 + (size_t)GROWS * A2K) = w2;
          }
        }
      }
  }
};


struct ProjOrder1 {
  static constexpr int NM0 = TL / 256, NN = DIF_IN / 256, NQ = DIF_QK / 256, NU = NM0 * NN + (TC / 256) * (NN - NQ);
  pg8::StaticOrder S0; int G, c;
  __device__ __forceinline__ bool next(int i, pg8::Unit& u) const {
    const long L = (long)i * G + c;
    if (L < NM0 * NN) return S0.at(L, u);
    const int l2 = (int)(L - NM0 * NN); if (l2 >= (TC / 256) * (NN - NQ)) return false;
    u.pm = NM0 + l2 / (NN - NQ); u.pn = NQ + l2 % (NN - NQ); return true;
  }
  __device__ __forceinline__ void a_ready(const pg8::Unit&) const {}
  __device__ __forceinline__ void done(const pg8::Unit&) const {}
};
struct EpiF32Out {
  static constexpr bool PERM = false;
  float* C; int ldc;
  __device__ __forceinline__ void operator()(const f32x4 (&acc)[2][2][4][2], const pg8::Unit& u, int wr, int wc, int fr, int fq) const {
    const int row0 = u.pm * 256 + wr * 64 + fr, col0 = u.pn * 256 + wc * 32 + 4 * fq;
#pragma unroll
    for (int ai = 0; ai < 2; ++ai)
#pragma unroll
      for (int m = 0; m < 4; ++m) { float* rowp = C + (size_t)(row0 + ai * 128 + m * 16) * ldc + col0;
#pragma unroll
        for (int bj = 0; bj < 2; ++bj)
#pragma unroll
          for (int n = 0; n < 2; ++n) *(f32x4*)(rowp + bj * 128 + n * 16) = acc[ai][bj][m][n]; }
  }
};
struct EpiBf16Out {
  static constexpr bool PERM = true;
  bf16_t* O; int ldc; int NJ;
  __device__ __forceinline__ void operator()(const f32x4 (&acc)[2][2][4][2], const pg8::Unit& u, int wr, int wc, int fr, int fq) const {
    const int row0 = u.pm * 256 + wr * 64 + fr, col0 = (NJ ? (u.pn % NJ) : u.pn) * 256 + wc * 32 + 8 * fq;
#pragma unroll
    for (int ai = 0; ai < 2; ++ai)
#pragma unroll
      for (int m = 0; m < 4; ++m) { bf16_t* rowp = O + (size_t)(row0 + ai * 128 + m * 16) * ldc + col0;
#pragma unroll
        for (int bj = 0; bj < 2; ++bj) { const f32x4 v0 = acc[ai][bj][m][0], v1 = acc[ai][bj][m][1];
          u32x4 w; w.x = cvt_pk_bf16(v0[0], v0[1]); w.y = cvt_pk_bf16(v0[2], v0[3]); w.z = cvt_pk_bf16(v1[0], v1[1]); w.w = cvt_pk_bf16(v1[2], v1[3]);
          *(u32x4*)(rowp + bj * 128) = w; } }
  }
};
__device__ __forceinline__ float fast_sigmoid(float x) { return __builtin_amdgcn_rcpf(1.f + __builtin_amdgcn_exp2f(-1.4426950408889634f * x)); }
struct EpiGlu {
  static constexpr bool PERM = true;
  const bf16_t* Gs; const float* bias; bf16_t* O; int ldo, coloff;
  __device__ __forceinline__ void operator()(const f32x4 (&acc)[2][2][4][2], const pg8::Unit& u, int wr, int wc, int fr, int fq) const {
    const int row0 = u.pm * 256 + wr * 64 + fr, col0 = u.pn * 256 + wc * 32 + 8 * fq;
#pragma unroll
    for (int ai = 0; ai < 2; ++ai)
#pragma unroll
      for (int m = 0; m < 4; ++m) { const int r = row0 + ai * 128 + m * 16;
#pragma unroll
        for (int bj = 0; bj < 2; ++bj) { const int c = col0 + bj * 128;
          const u32x4 gv = *(const u32x4*)(Gs + (size_t)r * SSM_W + c);
          const f32x4 b0 = *(const f32x4*)(bias + c), b1 = *(const f32x4*)(bias + c + 4);
          const f32x4 v0 = acc[ai][bj][m][0] + b0, v1 = acc[ai][bj][m][1] + b1;
          float o[8];
#pragma unroll
          for (int j = 0; j < 4; ++j) { const unsigned gw_ = j < 2 ? (j == 0 ? gv.x : gv.y) : (j == 2 ? gv.z : gv.w);
            const float g0 = __builtin_bit_cast(float, gw_ << 16), g1 = __builtin_bit_cast(float, gw_ & 0xffff0000u);
            const float z0 = j < 2 ? v0[2 * j] : v1[2 * j - 4], z1 = j < 2 ? v0[2 * j + 1] : v1[2 * j - 3];
            o[2 * j] = g0 * fast_sigmoid(z0); o[2 * j + 1] = g1 * fast_sigmoid(z1); }
          u32x4 w; w.x = cvt_pk_bf16(o[0], o[1]); w.y = cvt_pk_bf16(o[2], o[3]); w.z = cvt_pk_bf16(o[4], o[5]); w.w = cvt_pk_bf16(o[6], o[7]);
          *(u32x4*)(O + (size_t)r * ldo + coloff + c) = w; } }
  }
};
struct EpiMoe1 {
  static constexpr bool PERM = true;
  bf16_t* HH; const float* gate;
  __device__ __forceinline__ void operator()(const f32x4 (&acc)[2][2][4][2], const pg8::Unit& u, int wr, int wc, int fr, int fq) const {
    const int row0 = u.pm * 256 + wr * 64 + fr, col0 = (u.pn & 1) * 128 + wc * 32 + 8 * fq;
#pragma unroll
    for (int ai = 0; ai < 2; ++ai)
#pragma unroll
      for (int m = 0; m < 4; ++m) { const int r = row0 + ai * 128 + m * 16; const float gt = gate[r];
        float o[8];
#pragma unroll
        for (int n = 0; n < 2; ++n)
#pragma unroll
          for (int j = 0; j < 4; ++j) { const float h1 = acc[ai][0][m][n][j], h3 = acc[ai][1][m][n][j]; o[4 * n + j] = h1 * fast_sigmoid(h1) * h3 * gt; }
        u32x4 w; w.x = cvt_pk_bf16(o[0], o[1]); w.y = cvt_pk_bf16(o[2], o[3]); w.z = cvt_pk_bf16(o[4], o[5]); w.w = cvt_pk_bf16(o[6], o[7]);
        *(u32x4*)(HH + (size_t)r * MOE_F + col0) = w; }
  }
};
constexpr int LDS_MOE_TAB = 139264;
struct MoeOrder {
  const LAS int* tab; int nt, NJ, G, c;
  __device__ __forceinline__ void init(const int* meta, LAS unsigned char* lds, int NJ_, int G_, int c_, int tid) {
    NJ = NJ_; G = G_; c = c_; tab = (const LAS int*)(lds + LDS_MOE_TAB);
    if (tid < 256) ((LAS int*)(lds + LDS_MOE_TAB))[tid] = __hip_atomic_load(meta + 1 + tid, __ATOMIC_RELAXED, __HIP_MEMORY_SCOPE_AGENT);
    nt = __builtin_amdgcn_readfirstlane(__hip_atomic_load(meta, __ATOMIC_RELAXED, __HIP_MEMORY_SCOPE_AGENT));
    __syncthreads();
  }
  __device__ __forceinline__ bool next(int i, pg8::Unit& u) const {
    const long L = (long)i * G + c; if (L >= (long)nt * NJ) return false;
    const int rt = (int)(L / NJ), jn = (int)(L % NJ);
    const int e = __builtin_amdgcn_readfirstlane(tab[rt]);
    u.pm = rt; u.pn = e * NJ + jn; return true;
  }
  __device__ __forceinline__ void a_ready(const pg8::Unit&) const {}
  __device__ __forceinline__ void done(const pg8::Unit&) const {}
};


namespace att {
using f32x16 = __attribute__((ext_vector_type(16))) float;
using s16x4  = __attribute__((ext_vector_type(4))) short;
constexpr int KVBLK = 64;
constexpr float SCALE = 0.125f, THR = 8.f;
constexpr size_t SHM_V = KVBLK * 128 * 2, SHM_K = KVBLK * 128 * 2;
constexpr size_t SHM_WS = 2 * SHM_V + 2 * SHM_K;
#define KSWZ(row, colB) ((row) * 256 + ((colB) ^ (((row) & 15) << 4)))
#define SBAR() __builtin_amdgcn_sched_barrier(0)
__device__ __forceinline__ int crow(int r, int hi) { return (r & 3) + 8 * (r >> 2) + 4 * hi; }
__device__ __forceinline__ unsigned cvtpk(float lo, float hi) { unsigned r; asm volatile("v_cvt_pk_bf16_f32 %0, %1, %2" : "=v"(r) : "v"(lo), "v"(hi)); return r; }
__device__ __forceinline__ void partialSM(f32x16& p0, f32x16& p1, float& m_reg, float& mn, float& alpha) {
  constexpr float C = SCALE * 1.4426950408889634f;
  float pmax = p0[0];
#pragma unroll
  for (int r = 1; r < 16; ++r) pmax = fmaxf(pmax, p0[r]);
#pragma unroll
  for (int r = 0; r < 16; ++r) pmax = fmaxf(pmax, p1[r]);
  { auto rr = __builtin_amdgcn_permlane32_swap(__float_as_uint(pmax), __float_as_uint(pmax), false, false);
    pmax = fmaxf(__uint_as_float(rr[0]), __uint_as_float(rr[1])); }
  if (__builtin_expect(__all(pmax - m_reg <= THR / SCALE), 1)) { mn = m_reg; alpha = 1.f; }
  else { mn = fmaxf(m_reg, pmax); alpha = __builtin_amdgcn_exp2f((m_reg - mn) * C); m_reg = mn; }
  const float mnC = -mn * C;
#pragma unroll
  for (int r = 0; r < 16; ++r) p0[r] = fmaf(p0[r], C, mnC);
#pragma unroll
  for (int r = 0; r < 16; ++r) p1[r] = fmaf(p1[r], C, mnC);
#pragma unroll
  for (int r = 0; r < 16; ++r) p0[r] = __builtin_amdgcn_exp2f(p0[r]);
}
__device__ __forceinline__ void finishSM(f32x16& p0, f32x16& p1, float alpha, float& l_reg, bf16x8& pa0, bf16x8& pa1, bf16x8& pa2, bf16x8& pa3) {
#pragma unroll
  for (int r = 0; r < 16; ++r) p1[r] = __builtin_amdgcn_exp2f(p1[r]);
  float ps = 0;
#pragma unroll
  for (int r = 0; r < 16; ++r) ps += p0[r];
#pragma unroll
  for (int r = 0; r < 16; ++r) ps += p1[r];
  { auto rr = __builtin_amdgcn_permlane32_swap(__float_as_uint(ps), __float_as_uint(ps), false, false);
    ps = __uint_as_float(rr[0]) + __uint_as_float(rr[1]); }
  l_reg = l_reg * alpha + ps;
#define PK4(P, BASE, OUT) do { unsigned a0 = cvtpk(P[BASE + 0], P[BASE + 1]), a1 = cvtpk(P[BASE + 2], P[BASE + 3]);   \
    unsigned b0 = cvtpk(P[BASE + 4], P[BASE + 5]), b1 = cvtpk(P[BASE + 6], P[BASE + 7]);                              \
    auto r0 = __builtin_amdgcn_permlane32_swap(a0, b0, false, false); auto r1 = __builtin_amdgcn_permlane32_swap(a1, b1, false, false); \
    u32x4 w = {r0[0], r1[0], r0[1], r1[1]}; OUT = *reinterpret_cast<bf16x8*>(&w); } while (0)
  PK4(p0, 0, pa0); PK4(p0, 8, pa1); PK4(p1, 0, pa2); PK4(p1, 8, pa3);
#undef PK4
}
__device__ __forceinline__ void qkt(f32x16& p0, f32x16& p1, const char* Ks, const bf16x8* qr, int r32, int hi, int c) {
  p0 = f32x16{}; p1 = f32x16{};
#pragma unroll
  for (int d0 = 0; d0 < 4; ++d0) { const int cb = (c * 64 + d0 * 16 + hi * 8) * 2;
    const bf16x8 b0 = *reinterpret_cast<const bf16x8*>(Ks + KSWZ(r32, cb));
    const bf16x8 b1 = *reinterpret_cast<const bf16x8*>(Ks + KSWZ(32 + r32, cb));
    p0 = __builtin_amdgcn_mfma_f32_32x32x16_bf16(b0, qr[d0], p0, 0, 0, 0);
    p1 = __builtin_amdgcn_mfma_f32_32x32x16_bf16(b1, qr[d0], p1, 0, 0, 0); }
}
__device__ __forceinline__ int v_st(int k, int c) { const int kk = (k & ~0xC) | ((k & 4) << 1) | ((k & 8) >> 1); return ((kk >> 3) * 4 + (c >> 5)) * 512 + ((kk & 7) * 32 + (c & 31)) * 2; }
__device__ __forceinline__ int v_rd_base(int lane) { return ((lane & 3) << 3) | (((lane >> 2) & 3) << 6) | (((lane >> 4) & 1) << 5) | (((lane >> 5) & 1) << 8); }
constexpr int v_rd_off(int d0, int ks, int half) { return d0 * 512 + ks * 4096 + half * 2048; }
template <int OFF> __device__ __forceinline__ s16x4 tr_read(int vb) {
  s16x4 r; asm volatile("ds_read_b64_tr_b16 %0, %1 offset:%2" : "=&v"(r) : "v"(vb), "i"(OFF) : "memory"); return r;
}
template <int D0> __device__ __forceinline__ void pv_one(f32x16& od, int vb, bf16x8 pa0, bf16x8 pa1, bf16x8 pa2, bf16x8 pa3) {
  const s16x4 l0 = tr_read<v_rd_off(D0, 0, 0)>(vb), h0 = tr_read<v_rd_off(D0, 0, 1)>(vb), l1 = tr_read<v_rd_off(D0, 1, 0)>(vb), h1 = tr_read<v_rd_off(D0, 1, 1)>(vb);
  const s16x4 l2 = tr_read<v_rd_off(D0, 2, 0)>(vb), h2 = tr_read<v_rd_off(D0, 2, 1)>(vb), l3 = tr_read<v_rd_off(D0, 3, 0)>(vb), h3 = tr_read<v_rd_off(D0, 3, 1)>(vb);
  asm volatile("s_waitcnt lgkmcnt(0)" ::: "memory"); SBAR();
#define PK(L, H) (bf16x8){L[0], L[1], L[2], L[3], H[0], H[1], H[2], H[3]}
  od = __builtin_amdgcn_mfma_f32_32x32x16_bf16(pa0, PK(l0, h0), od, 0, 0, 0);
  od = __builtin_amdgcn_mfma_f32_32x32x16_bf16(pa1, PK(l1, h1), od, 0, 0, 0);
  od = __builtin_amdgcn_mfma_f32_32x32x16_bf16(pa2, PK(l2, h2), od, 0, 0, 0);
  od = __builtin_amdgcn_mfma_f32_32x32x16_bf16(pa3, PK(l3, h3), od, 0, 0, 0);
#undef PK
}
template <int NB> __device__ __forceinline__ void pv_blocks(f32x16* o, int vb, int vsel, bf16x8 pa0, bf16x8 pa1, bf16x8 pa2, bf16x8 pa3) {
  if constexpr (NB == 4) { pv_one<0>(o[0], vb, pa0, pa1, pa2, pa3); pv_one<1>(o[1], vb, pa0, pa1, pa2, pa3); pv_one<2>(o[2], vb, pa0, pa1, pa2, pa3); pv_one<3>(o[3], vb, pa0, pa1, pa2, pa3); }
  else { if (vsel == 0) { pv_one<0>(o[0], vb, pa0, pa1, pa2, pa3); pv_one<1>(o[1], vb, pa0, pa1, pa2, pa3); }
         else { pv_one<2>(o[0], vb, pa0, pa1, pa2, pa3); pv_one<3>(o[1], vb, pa0, pa1, pa2, pa3); } }
}
__device__ __forceinline__ void apply_mask(f32x16& p0, f32x16& p1, int mt, int i, int k0, int hi) {
  if (mt == 0) return;
#pragma unroll
  for (int r = 0; r < 16; ++r) { const int j0 = k0 + crow(r, hi), j1 = j0 + 32;
    const bool ok0 = (mt == 1) && (j0 - i <= SWA_WIN) && (i - j0 <= SWA_WIN), ok1 = (mt == 1) && (j1 - i <= SWA_WIN) && (i - j1 <= SWA_WIN);
    p0[r] = ok0 ? p0[r] : -1e30f; p1[r] = ok1 ? p1[r] : -1e30f; }
}

struct TileMap {
  int nl, tlo, bN, bC;
  __device__ __forceinline__ int row(int t) const { return t < nl ? bN + 64 * (tlo + t) : (t < nl + CTX / 64 ? bC + 64 * (t - nl) : bN + 64 * tlo); }
  __device__ __forceinline__ int mtype(int t) const { return t < nl ? 1 : (t < nl + CTX / 64 ? 0 : 2); }
  __device__ __forceinline__ int key0(int t) const { return 64 * (tlo + (t < nl ? t : 0)); }
};

template <int MODE>
__device__ __forceinline__ void attn_unit(const bf16_t* __restrict__ Pq, const bf16_t* __restrict__ Pk, const bf16_t* __restrict__ Pv, int LD, const TileMap tm, int NT,
                                          float m_init, float l_init, int i0, LAS unsigned char* ldsb, f32x16* o, float& l_out, int tid) {
  constexpr int NB = MODE == 0 ? 4 : 2;
  const int wid = tid >> 6, lane = tid & 63, r32 = lane & 31, hi = lane >> 5, c = wid >> 2;
  char* lds = (char*)ldsb;
  char* V_lds = lds; char* K_lds = lds + 2 * SHM_V;
  float* ws = (float*)(lds + SHM_WS) + wid * 64; float* al_l = ws + 32;
  float m_reg = m_init, l_reg = l_init; bf16x8 qr[4];
#pragma unroll
  for (int d = 0; d < NB; ++d) o[d] = f32x16{};
  const bf16_t* Qw = Pq + (size_t)r32 * LD + hi * 8;
#pragma unroll
  for (int d0 = 0; d0 < 4; ++d0) qr[d0] = *reinterpret_cast<const bf16x8*>(Qw + d0 * 16);
  const int sr = tid >> 4, sc = (tid & 15) * 8, vst0 = v_st(sr, sc), vst1 = v_st(32 + sr, sc);
  const int vb0 = (int)(uintptr_t)V_lds + v_rd_base(lane);
  struct { bf16x8 vs0, vs1, ks0, ks1; } sr_[2];
#define SLOAD(i, t) do { const size_t rb_ = (size_t)tm.row(t); \
    sr_[i].vs0 = *reinterpret_cast<const bf16x8*>(Pv + (rb_ + sr) * LD + sc); sr_[i].vs1 = *reinterpret_cast<const bf16x8*>(Pv + (rb_ + 32 + sr) * LD + sc); \
    sr_[i].ks0 = *reinterpret_cast<const bf16x8*>(Pk + (rb_ + sr) * LD + sc); sr_[i].ks1 = *reinterpret_cast<const bf16x8*>(Pk + (rb_ + 32 + sr) * LD + sc); } while (0)
#define SWRITE(b, i) do { *(bf16x8*)(V_lds + (b) * SHM_V + vst0) = sr_[i].vs0; *(bf16x8*)(V_lds + (b) * SHM_V + vst1) = sr_[i].vs1; const int kc = sc * 2; \
    *(bf16x8*)(K_lds + (b) * SHM_K + KSWZ(sr, kc)) = sr_[i].ks0; *(bf16x8*)(K_lds + (b) * SHM_K + KSWZ(32 + sr, kc)) = sr_[i].ks1; } while (0)
#define SWAIT() asm volatile("s_waitcnt vmcnt(4)" ::: "memory")
#define RESC(a) do { if (__any((a) < 1.f)) { if (hi == 0) al_l[r32] = (a); asm volatile("s_waitcnt lgkmcnt(0)" ::: "memory"); \
    _Pragma("unroll") for (int d = 0; d < NB; ++d) _Pragma("unroll") for (int r = 0; r < 16; ++r) o[d][r] *= al_l[crow(r, hi)]; } } while (0)
#define MASK(P0, P1, t) do { if constexpr (MODE == 1) apply_mask(P0, P1, tm.mtype(t), i0 + r32, tm.key0(t), hi); } while (0)
  f32x16 pA0, pA1, pB0, pB1; float mnA, mnB, alA, alB; bf16x8 pa0, pa1, pa2, pa3;
  constexpr int SE = 0, SO = 1;
  SLOAD(SE, 0); asm volatile("s_waitcnt vmcnt(0)" ::: "memory"); SWRITE(0, SE); __syncthreads();
  qkt(pA0, pA1, K_lds, qr, r32, hi, c); MASK(pA0, pA1, 0); partialSM(pA0, pA1, m_reg, mnA, alA);
  SLOAD(SO, 1); if (2 < NT) SLOAD(SE, 2);
  SWAIT(); SWRITE(1, SO); __syncthreads();
  for (int j = 1; j + 1 < NT; j += 2) {
    SBAR(); qkt(pB0, pB1, K_lds + SHM_K, qr, r32, hi, c);
    finishSM(pA0, pA1, alA, l_reg, pa0, pa1, pa2, pa3); SBAR();
    SLOAD(SO, j + 2); SBAR();
    pv_blocks<NB>(o, vb0, c, pa0, pa1, pa2, pa3); MASK(pB0, pB1, j); partialSM(pB0, pB1, m_reg, mnB, alB);
    __syncthreads(); SWAIT(); SWRITE(0, SE);
    RESC(alB); __syncthreads();
    SBAR(); qkt(pA0, pA1, K_lds, qr, r32, hi, c);
    finishSM(pB0, pB1, alB, l_reg, pa0, pa1, pa2, pa3); SBAR();
    if (j + 3 < NT) SLOAD(SE, j + 3);
    SBAR();
    pv_blocks<NB>(o, vb0 + (int)SHM_V, c, pa0, pa1, pa2, pa3); MASK(pA0, pA1, j + 1); partialSM(pA0, pA1, m_reg, mnA, alA);
    __syncthreads(); SWAIT(); SWRITE(1, SO);
    RESC(alA); __syncthreads();
  }
  SBAR(); qkt(pB0, pB1, K_lds + SHM_K, qr, r32, hi, c);
  finishSM(pA0, pA1, alA, l_reg, pa0, pa1, pa2, pa3); SBAR();
  pv_blocks<NB>(o, vb0, c, pa0, pa1, pa2, pa3); MASK(pB0, pB1, NT - 1); partialSM(pB0, pB1, m_reg, mnB, alB);
  __syncthreads(); RESC(alB);
  finishSM(pB0, pB1, alB, l_reg, pa0, pa1, pa2, pa3); SBAR();
  pv_blocks<NB>(o, vb0 + (int)SHM_V, c, pa0, pa1, pa2, pa3);
  l_out = l_reg;
  asm volatile("s_waitcnt vmcnt(0)" ::: "memory");
  __syncthreads();
#undef SLOAD
#undef SWRITE
#undef SWAIT
#undef RESC
#undef MASK
}

__device__ __forceinline__ void dif_phase(const Params& p, LAS unsigned char* ldsb, int G, int vcu, int tid) {
  const int wid = tid >> 6, lane = tid & 63, r32 = lane & 31, hi = lane >> 5, c = wid >> 2, rg = wid & 3;
  constexpr int NQB = N / 128, NU = B * DIF_H * NQB;
  const float lam = p.scal[0], oscale = p.scal[1];
  for (int L = vcu; L < NU; L += G) {
    const int qb = L % NQB, h = (L / NQB) % DIF_H, b = L / (NQB * DIF_H);
    const int t0 = b * N + qb * 128 + rg * 32;
    TileMap tm; tm.nl = N / 64; tm.tlo = 0; tm.bN = b * N; tm.bC = TL + b * CTX;
    f32x16 o[4]; float l_reg;
    attn_unit<0>(p.P + (size_t)t0 * DIF_IN + h * 128 + c * 64, p.P + DIF_QK + h * 128, p.P + 2 * DIF_QK + h * 128, DIF_IN, tm, (N + CTX) / 64,
                 -1e30f, 0.f, 0, ldsb, o, l_reg, tid);
    char* lds = (char*)ldsb;
    float* ws = (float*)(lds + SHM_WS) + wid * 64;
    float* xb = (float*)lds;
    if (hi == 0) ws[r32] = l_reg;
    asm volatile("s_waitcnt lgkmcnt(0)" ::: "memory");
    float rli[16];
#pragma unroll
    for (int r = 0; r < 16; ++r) rli[r] = __builtin_amdgcn_rcpf(ws[crow(r, hi)]);
    if (c == 1) {
#pragma unroll
      for (int d0 = 0; d0 < 4; ++d0)
#pragma unroll
        for (int r = 0; r < 16; ++r) xb[(rg * 32 + crow(r, hi)) * 128 + d0 * 32 + r32] = o[d0][r] * rli[r];
    }
    __syncthreads();
    if (c == 0) {
      float ss[16];
#pragma unroll
      for (int r = 0; r < 16; ++r) ss[r] = 0.f;
#pragma unroll
      for (int d0 = 0; d0 < 4; ++d0)
#pragma unroll
        for (int r = 0; r < 16; ++r) { const float v = o[d0][r] * rli[r] - lam * xb[(rg * 32 + crow(r, hi)) * 128 + d0 * 32 + r32]; o[d0][r] = v; ss[r] += v * v; }
#pragma unroll
      for (int r = 0; r < 16; ++r) {
#pragma unroll
        for (int sft = 1; sft < 32; sft <<= 1) ss[r] += __shfl_xor(ss[r], sft);
        ss[r] = oscale / sqrtf(ss[r] * (1.f / 128.f) + RMS_EPS); }
#pragma unroll
      for (int d0 = 0; d0 < 4; ++d0) { const float gsub = p.subln_g[d0 * 32 + r32];
#pragma unroll
        for (int r = 0; r < 16; ++r) p.Ymix[(size_t)(t0 + crow(r, hi)) * YW + h * 128 + d0 * 32 + r32] = f2bf(o[d0][r] * ss[r] * gsub); }
    }
    __syncthreads();
  }
}
__device__ __forceinline__ void swa_unit(const Params& p, LAS unsigned char* ldsb, int L, int tid) {
  const int wid = tid >> 6, lane = tid & 63, r32 = lane & 31, hi = lane >> 5;
  constexpr int NUL = TL / 32;
  const float sink_raw = p.sink[wid] * (1.0f / SCALE);
  TileMap tm; int t0, NT, i0;
  if (L < NUL) { const int b = L / (N / 32), qb = L % (N / 32); i0 = qb * 32; t0 = b * N + i0;
    const int lo = i0 - SWA_WIN < 0 ? 0 : i0 - SWA_WIN, hi_ = i0 + 31 + SWA_WIN > N - 1 ? N - 1 : i0 + 31 + SWA_WIN;
    tm.tlo = lo / 64; tm.nl = hi_ / 64 - tm.tlo + 1; tm.bN = b * N; tm.bC = TL + b * CTX; NT = (tm.nl + CTX / 64 + 1) & ~1;
  } else { const int Lc = L - NUL, b = Lc / (CTX / 32), qb = Lc % (CTX / 32); i0 = 0; t0 = TL + b * CTX + qb * 32;
    tm.tlo = 0; tm.nl = 0; tm.bN = b * N; tm.bC = TL + b * CTX; NT = CTX / 64; }
  f32x16 o[2]; float l_reg;
  attn_unit<1>(p.P + (size_t)t0 * AB_IN + wid * 64, p.P + A_KOFF, p.P + A_VOFF, AB_IN, tm, NT, sink_raw, 1.f, i0, ldsb, o, l_reg, tid);
  char* lds = (char*)ldsb;
  float* ws = (float*)(lds + SHM_WS) + wid * 64;
  if (hi == 0) ws[r32] = l_reg;
  asm volatile("s_waitcnt lgkmcnt(0)" ::: "memory");
#pragma unroll
  for (int r = 0; r < 16; ++r) { const float rl = __builtin_amdgcn_rcpf(ws[crow(r, hi)]);
#pragma unroll
    for (int d0 = 0; d0 < 2; ++d0) p.Ymix[(size_t)(t0 + crow(r, hi)) * YW + wid * 64 + d0 * 32 + r32] = f2bf(o[d0][r] * rl); }
  __syncthreads();
}
constexpr int SWA_UNITS = TL / 32 + TC / 32;


#define TRRD8(X, D0) do { X[0] = tr_read<v_rd_off(D0, 0, 0)>(vb); X[1] = tr_read<v_rd_off(D0, 0, 1)>(vb); X[2] = tr_read<v_rd_off(D0, 1, 0)>(vb); X[3] = tr_read<v_rd_off(D0, 1, 1)>(vb); \
    X[4] = tr_read<v_rd_off(D0, 2, 0)>(vb); X[5] = tr_read<v_rd_off(D0, 2, 1)>(vb); X[6] = tr_read<v_rd_off(D0, 3, 0)>(vb); X[7] = tr_read<v_rd_off(D0, 3, 1)>(vb); } while (0)
#define PKV(L, H) (bf16x8){L[0], L[1], L[2], L[3], H[0], H[1], H[2], H[3]}
#define MMA4(O, X) do { O = __builtin_amdgcn_mfma_f32_32x32x16_bf16(pa0, PKV(X[0], X[1]), O, 0, 0, 0); O = __builtin_amdgcn_mfma_f32_32x32x16_bf16(pa1, PKV(X[2], X[3]), O, 0, 0, 0); \
    O = __builtin_amdgcn_mfma_f32_32x32x16_bf16(pa2, PKV(X[4], X[5]), O, 0, 0, 0); O = __builtin_amdgcn_mfma_f32_32x32x16_bf16(pa3, PKV(X[6], X[7]), O, 0, 0, 0); } while (0)
__device__ __forceinline__ void pv4p(f32x16* o, int vb, bf16x8 pa0, bf16x8 pa1, bf16x8 pa2, bf16x8 pa3) {
  s16x4 A[8], Bv[8];
  TRRD8(A, 0); TRRD8(Bv, 1);
  asm volatile("s_waitcnt lgkmcnt(8)" ::: "memory"); SBAR(); MMA4(o[0], A);
  TRRD8(A, 2);
  asm volatile("s_waitcnt lgkmcnt(8)" ::: "memory"); SBAR(); MMA4(o[1], Bv);
  TRRD8(Bv, 3);
  asm volatile("s_waitcnt lgkmcnt(8)" ::: "memory"); SBAR(); MMA4(o[2], A);
  asm volatile("s_waitcnt lgkmcnt(0)" ::: "memory"); SBAR(); MMA4(o[3], Bv);
}
#undef TRRD8
#undef PKV
#undef MMA4
constexpr int D2_K = 0, D2_V = 2 * 16384, D2_Q = 4 * 16384, D2_WS = 133120;
__device__ __forceinline__ void qkt2(f32x16& p0, f32x16& p1, const char* Ks, const char* Qs, int r32, int hi, int c) {
  p0 = f32x16{}; p1 = f32x16{};
#pragma unroll
  for (int d0 = 0; d0 < 4; ++d0) { const int cb = (c * 64 + d0 * 16 + hi * 8) * 2;
    const bf16x8 b0 = *reinterpret_cast<const bf16x8*>(Ks + KSWZ(r32, cb));
    const bf16x8 b1 = *reinterpret_cast<const bf16x8*>(Ks + KSWZ(32 + r32, cb));
    const bf16x8 q = *reinterpret_cast<const bf16x8*>(Qs + KSWZ(r32, cb));
    p0 = __builtin_amdgcn_mfma_f32_32x32x16_bf16(b0, q, p0, 0, 0, 0);
    p1 = __builtin_amdgcn_mfma_f32_32x32x16_bf16(b1, q, p1, 0, 0, 0); }
}
__device__ __forceinline__ void dif_phase2(const Params& p, LAS unsigned char* ldsb, int G, int vcu, int tid) {
  const int wid = __builtin_amdgcn_readfirstlane(tid >> 6), lane = tid & 63, r32 = lane & 31, hi = lane >> 5;
  constexpr int NQB = N / 256, NU = B * DIF_H * NQB, NT = (N + CTX) / 64, LD = DIF_IN;
  const float lam = p.scal[0], oscale = p.scal[1];
  char* lds = (char*)ldsb;
  char* Qs = lds + D2_Q + wid * 8192;
  float* ws = (float*)(lds + D2_WS) + wid * 64; float* al_l = ws + 32;
  const int vb0 = (int)(uintptr_t)(lds + D2_V) + v_rd_base(lane);
  int koff[2], voff[2];
#pragma unroll
  for (int k = 0; k < 2; ++k) { const int i = 2 * wid + k;
    { const int row = 4 * i + (lane >> 4), ch = (lane & 15) ^ (row & 15); koff[k] = row * LD + ch * 8; }
    { const int sub = 2 * i + (lane >> 5), kk = (sub >> 2) * 8 + ((lane & 31) >> 2), key = (kk & ~0xC) | ((kk & 4) << 1) | ((kk & 8) >> 1), c = (sub & 3) * 32 + (lane & 3) * 8; voff[k] = key * LD + c; } }
  for (int L = vcu; L < NU; L += G) {
    const int qb = L % NQB, h = (L / NQB) % DIF_H, b = L / (NQB * DIF_H);
    const int t0 = b * N + qb * 256 + wid * 32;
    const bf16_t* Pk = p.P + DIF_QK + h * 128; const bf16_t* Pv = p.P + 2 * DIF_QK + h * 128;
    TileMap tm; tm.nl = N / 64; tm.tlo = 0; tm.bN = b * N; tm.bC = TL + b * CTX;
#define DMA_K(t, buf) do { const bf16_t* g_ = Pk + (size_t)tm.row(t) * LD; _Pragma("unroll") for (int k = 0; k < 2; ++k) \
    __builtin_amdgcn_global_load_lds((const unsigned*)(g_ + koff[k]), (LAS unsigned*)(ldsb + D2_K + (buf) * 16384 + (2 * wid + k) * 1024), 16, 0, 0); } while (0)
#define DMA_V(t, buf) do { const bf16_t* g_ = Pv + (size_t)tm.row(t) * LD; _Pragma("unroll") for (int k = 0; k < 2; ++k) \
    __builtin_amdgcn_global_load_lds((const unsigned*)(g_ + voff[k]), (LAS unsigned*)(ldsb + D2_V + (buf) * 16384 + (2 * wid + k) * 1024), 16, 0, 0); } while (0)
    DMA_K(0, 0); DMA_V(0, 0);
    { const bf16_t* Qg = p.P + (size_t)t0 * LD + h * 128;
#pragma unroll
      for (int i = 0; i < 8; ++i) { const int row = 4 * i + (lane >> 4), ch = lane & 15;
        const bf16x8 v = *reinterpret_cast<const bf16x8*>(Qg + (size_t)row * LD + ch * 8);
        *reinterpret_cast<bf16x8*>(Qs + KSWZ(row, ch * 16)) = v; } }
    f32x16 o1[4], o2[4];
#pragma unroll
    for (int d = 0; d < 4; ++d) { o1[d] = f32x16{}; o2[d] = f32x16{}; }
    float mA = -1e30f, lA = 0.f, mB = -1e30f, lB = 0.f;
#define RESC2(O, a) do { if (__any((a) < 1.f)) { if (hi == 0) al_l[r32] = (a); asm volatile("s_waitcnt lgkmcnt(0)" ::: "memory"); \
    _Pragma("unroll") for (int d = 0; d < 4; ++d) _Pragma("unroll") for (int r = 0; r < 16; ++r) O[d][r] *= al_l[crow(r, hi)]; } } while (0)
    for (int t = 0; t < NT; ++t) {
      const int bb = t & 1;
      asm volatile("s_waitcnt vmcnt(0)" ::: "memory");
      __syncthreads();
      if (t + 1 < NT) { DMA_K(t + 1, bb ^ 1); DMA_V(t + 1, bb ^ 1); }
      f32x16 p0, p1; float mn, al; bf16x8 pa0, pa1, pa2, pa3;
      qkt2(p0, p1, lds + D2_K + bb * 16384, Qs, r32, hi, 0); partialSM(p0, p1, mA, mn, al); RESC2(o1, al);
      finishSM(p0, p1, al, lA, pa0, pa1, pa2, pa3); SBAR();
      pv4p(o1, vb0 + bb * 16384, pa0, pa1, pa2, pa3);
      SBAR();
      qkt2(p0, p1, lds + D2_K + bb * 16384, Qs, r32, hi, 1); partialSM(p0, p1, mB, mn, al); RESC2(o2, al);
      finishSM(p0, p1, al, lB, pa0, pa1, pa2, pa3); SBAR();
      pv4p(o2, vb0 + bb * 16384, pa0, pa1, pa2, pa3);
    }
    if (hi == 0) { ws[r32] = lA; al_l[r32] = lB; }
    asm volatile("s_waitcnt lgkmcnt(0)" ::: "memory");
    float ss[16];
#pragma unroll
    for (int r = 0; r < 16; ++r) { const float r1 = __builtin_amdgcn_rcpf(ws[crow(r, hi)]), r2 = lam * __builtin_amdgcn_rcpf(al_l[crow(r, hi)]); float a = 0.f;
#pragma unroll
      for (int d0 = 0; d0 < 4; ++d0) { const float v = o1[d0][r] * r1 - o2[d0][r] * r2; o1[d0][r] = v; a += v * v; }
      ss[r] = a; }
#pragma unroll
    for (int r = 0; r < 16; ++r) {
#pragma unroll
      for (int sft = 1; sft < 32; sft <<= 1) ss[r] += __shfl_xor(ss[r], sft);
      ss[r] = oscale / sqrtf(ss[r] * (1.f / 128.f) + RMS_EPS); }
#pragma unroll
    for (int d0 = 0; d0 < 4; ++d0) { const float gsub = p.subln_g[d0 * 32 + r32];
#pragma unroll
      for (int r = 0; r < 16; ++r) p.Ymix[(size_t)(t0 + crow(r, hi)) * YW + h * 128 + d0 * 32 + r32] = f2bf(o1[d0][r] * ss[r] * gsub); }
    __syncthreads();
#undef DMA_K
#undef DMA_V
#undef RESC2
  }
}
}


constexpr int N_TAB16A = 2 * SSM_G * SSM_P * 17;
__device__ __forceinline__ void st_tab16a(const Params& p, int idx) {
  const int k = idx % 17, q = idx / 17, dg = q / SSM_P;
  const float dt = expf(p.log_step[dg]), ar = p.a_re[q], ai = p.a_im[q], mag = expf((float)k * dt * ar), ang = (float)k * dt * ai;
  p.apow16[(size_t)idx * 2] = mag * cosf(ang); p.apow16[(size_t)idx * 2 + 1] = mag * sinf(ang);
}
constexpr int N_TAB16B = 2 * SSM_G * 16 * 256;
__device__ __forceinline__ void st_tab16b(const Params& p, int idx) {
  const int ci = idx % 16, co = (idx / 16) % 16, lag = (idx / 256) % 16, dg = idx / 4096;
  float acc = 0.f;
  for (int pp = 0; pp < SSM_P; ++pp) { const int q = dg * SSM_P + pp;
    const float ar = p.apow16[((size_t)q * 17 + lag) * 2], ai = p.apow16[((size_t)q * 17 + lag) * 2 + 1];
    const float br = p.bbar[((size_t)q * 16 + ci) * 2], bi = p.bbar[((size_t)q * 16 + ci) * 2 + 1];
    const float cr = p.c_re[((size_t)dg * 16 + co) * SSM_P + pp], cim = p.c_im[((size_t)dg * 16 + co) * SSM_P + pp];
    acc += cr * (ar * br - ai * bi) - cim * (ar * bi + ai * br); }
  p.KT16[idx] = acc;
}
constexpr int N_BTY = 2 * SSM_G * 256 * A2K, N_BTE = 2 * SSM_G * 256 * 256;
__device__ __forceinline__ void st_tab16c(const Params& p, int idx) {
  if (idx < N_BTY) {
    const int k = idx % A2K, n = (idx / A2K) % 256, dg = idx / (A2K * 256); const int j = n / 16, co = n % 16;
    float v;
    if (k < 256) { const int j2 = k / 16, ci = k % 16; v = j2 <= j ? p.KT16[(((size_t)dg * 16 + (j - j2)) * 16 + co) * 16 + ci] : 0.f; }
    else { const int pp = (k - 256) % 64, im = (k - 256) / 64, q = dg * SSM_P + pp;
      const float ar = p.apow16[((size_t)q * 17 + j + 1) * 2], ai = p.apow16[((size_t)q * 17 + j + 1) * 2 + 1];
      const float cr = p.c_re[((size_t)dg * 16 + co) * SSM_P + pp], cim = p.c_im[((size_t)dg * 16 + co) * SSM_P + pp];
      v = im ? -(cr * ai + cim * ar) : (cr * ar - cim * ai); }
    p.BtY[idx] = f2bf(v); return; }
  idx -= N_BTY;
  const int k = idx % 256, n = (idx / 256) % 256, dg = idx / 65536; const int j = k / 16, ci = k % 16;
  float v = 0.f;
  if (n < 128) { const int pp = n % 64, im = n / 64, q = dg * SSM_P + pp;
    const float ar = p.apow16[((size_t)q * 17 + (15 - j)) * 2], ai = p.apow16[((size_t)q * 17 + (15 - j)) * 2 + 1];
    const float br = p.bbar[((size_t)q * 16 + ci) * 2], bi = p.bbar[((size_t)q * 16 + ci) * 2 + 1];
    v = im ? (ar * bi + ai * br) : (ar * br - ai * bi); }
  p.BtE[idx] = f2bf(v);
}
struct SsmOrder {
  int first, count, G, c;
  __device__ __forceinline__ bool next(int i, pg8::Unit& u) const { const int L = i * G + c; if (L >= count) return false; u.pm = first + L; u.pn = u.pm / 5; return true; }
  __device__ __forceinline__ void a_ready(const pg8::Unit&) const {}
  __device__ __forceinline__ void done(const pg8::Unit&) const {}
};
struct EpiE {
  static constexpr bool PERM = false;
  float* E;
  __device__ __forceinline__ void operator()(const f32x4 (&acc)[2][2][4][2], const pg8::Unit& u, int wr, int wc, int fr, int fq) const {
    const int row0 = u.pm * 256 + wr * 64 + fr, col0 = wc * 32 + 4 * fq;
#pragma unroll
    for (int ai = 0; ai < 2; ++ai)
#pragma unroll
      for (int m = 0; m < 4; ++m) { float* rowp = E + (size_t)(row0 + ai * 128 + m * 16) * 128 + col0;
#pragma unroll
        for (int n = 0; n < 2; ++n) *(f32x4*)(rowp + n * 16) = acc[ai][0][m][n]; }
  }
};
template <int DIR> struct EpiY {
  static constexpr bool PERM = false;
  float* Ypart; const bf16_t* P0; const float* dskip; bf16_t* Gs;
  __device__ __forceinline__ void operator()(const f32x4 (&acc)[2][2][4][2], const pg8::Unit& u, int wr, int wc, int fr, int fq) const {
    const int grp = u.pm / 5, g = grp % SSM_G, rg0 = (u.pm % 5) * 256 + wr * 64 + fr;
#pragma unroll
    for (int ai = 0; ai < 2; ++ai)
#pragma unroll
      for (int m = 0; m < 4; ++m) { const int rg = rg0 + ai * 128 + m * 16;
        if (rg < B * NCH16) { const int b = rg / NCH16, ch = rg % NCH16;
#pragma unroll
          for (int bj = 0; bj < 2; ++bj)
#pragma unroll
            for (int n = 0; n < 2; ++n) { const int j = 8 * bj + 2 * wc + n, tau = ch * LC + j;
              const int t = ssm_row(DIR, b, tau); const size_t o = (size_t)t * SSM_W + g * 16 + 4 * fq;
              if (DIR == 0) *(f32x4*)(Ypart + o) = acc[ai][bj][m][n];
              else { const f32x4 y0 = *(const f32x4*)(Ypart + o); const f32x4 dk = *(const f32x4*)(dskip + g * 16 + 4 * fq);
                const u32x2 uu = *(const u32x2*)(P0 + (size_t)t * AB_IN + A_UOFF + g * 16 + 4 * fq);
                f32x4 uv; uv.x = __builtin_bit_cast(float, uu.x << 16); uv.y = __builtin_bit_cast(float, uu.x & 0xffff0000u); uv.z = __builtin_bit_cast(float, uu.y << 16); uv.w = __builtin_bit_cast(float, uu.y & 0xffff0000u);
                const f32x4 y = acc[ai][bj][m][n] + y0 + dk * uv; float gl[4];
#pragma unroll
                for (int q = 0; q < 4; ++q) { const float x = y[q], w = 0.7978845608028654f * (x + 0.044715f * x * x * x); gl[q] = x * fast_sigmoid(2.f * w); }
                const u32x2 wv = {cvt_pk_bf16(gl[0], gl[1]), cvt_pk_bf16(gl[2], gl[3])};
                *(u32x2*)(Gs + o) = wv; } } } }
  }
};
__device__ __forceinline__ void ssm_carry_phase(const Params& p, int bx, int G, int tid) {
  for (int idx = bx * NTHR + tid; idx < 2 * SSM_G * B * SSM_P; idx += G * NTHR) {
    const int pp = idx % SSM_P, b = (idx / SSM_P) % B, dg = idx / (SSM_P * B), q = dg * SSM_P + pp;
    const float ar = p.apow16[((size_t)q * 17 + 16) * 2], ai = p.apow16[((size_t)q * 17 + 16) * 2 + 1];
    float sr = 0.f, si = 0.f;
    const size_t row0 = (size_t)dg * GROWS + (size_t)b * NCH16;
#pragma unroll 8
    for (int ch = 0; ch < NCH16; ++ch) { const size_t row = row0 + ch;
      p.A2[row * A2K + 256 + pp] = f2bf(sr); p.A2[row * A2K + 320 + pp] = f2bf(si);
      const float er = p.E16[row * 128 + pp], ei = p.E16[row * 128 + 64 + pp];
      const float nr = ar * sr - ai * si + er, ni = ar * si + ai * sr + ei; sr = nr; si = ni; }
  }
}

#define XB_TMO      128
#define XB_XCNT(j)  (256  + 64 * (j))
#define XB_XSUB(j)  (1280 + 64 * (j))
#define XB_XGEN(j)  (2304 + 64 * (j))
#define XB_TOP      3328
#define XB_TOPGEN   3392
#define XCD_BAR_WORDS 3456
#define XB_SPIN_CAP (1u << 22)
constexpr int CW_BAR = 4096;
__device__ __forceinline__ unsigned xb_ld(unsigned* p)              { return __hip_atomic_load(p, __ATOMIC_RELAXED, __HIP_MEMORY_SCOPE_AGENT); }
__device__ __forceinline__ unsigned xb_add(unsigned* p, unsigned v) { return __hip_atomic_fetch_add(p, v, __ATOMIC_RELAXED, __HIP_MEMORY_SCOPE_AGENT); }
__device__ __forceinline__ unsigned xb_xcc_id() { return (unsigned)__builtin_amdgcn_s_getreg((3 << 11) | 20) & 0xFu; }
#define XB_SPIN(cond, bar) do { unsigned _sp = 0; while (cond) { __builtin_amdgcn_s_sleep(1); \
    if ((++_sp & 255u) == 0u) { if (xb_ld(&(bar)[XB_TMO])) break; if (_sp > XB_SPIN_CAP) { atomicAdd(&(bar)[XB_TMO], 1u); break; } } } } while (0)
struct XcdBarrier { unsigned* bar; unsigned x; volatile LAS unsigned* st; };
__device__ __forceinline__ XcdBarrier xcd_barrier_post(unsigned* bar, volatile LAS unsigned* st) {
  XcdBarrier b; b.bar = bar; b.x = xb_xcc_id(); b.st = st;
  if (threadIdx.x == 0) (void)xb_add(&bar[XB_XCNT(b.x)], 1u);
  return b;
}
__device__ __forceinline__ void xcd_barrier_complete(unsigned* bar, unsigned x, unsigned& nloc, unsigned& nx) {
  const unsigned G = gridDim.x * gridDim.y * gridDim.z;
  unsigned sum, cnt, mine, sp = 0u;
  for (;;) {
    sum = 0u; cnt = 0u; mine = 0u;
#pragma unroll
    for (unsigned j = 0; j < 16; ++j) { const unsigned c = xb_ld(&bar[XB_XCNT(j)]); sum += c; cnt += (c > 0u) ? 1u : 0u; mine = (j == x) ? c : mine; }
    if (sum == G) break;
    __builtin_amdgcn_s_sleep(1);
    if ((++sp & 255u) == 0u) { if (xb_ld(&bar[XB_TMO])) break; if (sp > XB_SPIN_CAP) { atomicAdd(&bar[XB_TMO], 1u); break; } }
  }
  nloc = mine > 0u ? mine : 1u; nx = cnt > 0u ? cnt : 1u;
}
__device__ __forceinline__ void xcd_barrier(const XcdBarrier& b) {
  asm volatile("s_waitcnt vmcnt(0)" ::: "memory");
  __syncthreads();
  if (threadIdx.x == 0) {
    unsigned* bar = b.bar;
    __builtin_amdgcn_s_waitcnt(0);
    unsigned nloc = b.st[0], nx = b.st[1];
    if (nloc == 0u) { xcd_barrier_complete(bar, b.x, nloc, nx); b.st[0] = nloc; b.st[1] = nx; }
    const unsigned old = xb_add(&bar[XB_XSUB(b.x)], 1u);
    const unsigned gen = old / nloc;
    if (old + 1u == (gen + 1u) * nloc) {
      __builtin_amdgcn_fence(__ATOMIC_RELEASE, "agent");
      asm volatile("s_waitcnt vmcnt(0)" ::: "memory");
      const unsigned og = xb_add(&bar[XB_TOP], 1u);
      const unsigned tg = og / nx;
      if (og + 1u == (tg + 1u) * nx) xb_add(&bar[XB_TOPGEN], 1u);
      else XB_SPIN(xb_ld(&bar[XB_TOPGEN]) == tg, bar);
      __builtin_amdgcn_fence(__ATOMIC_ACQUIRE, "agent");
      xb_add(&bar[XB_XGEN(b.x)], 1u);
      asm volatile("s_waitcnt vmcnt(0)" ::: "memory");
    } else {
      XB_SPIN(xb_ld(&bar[XB_XGEN(b.x)]) == gen, bar);
      __builtin_amdgcn_fence(__ATOMIC_ACQUIRE, "agent");
      asm volatile("s_waitcnt vmcnt(0)" ::: "memory");
    }
  }
  __syncthreads();
}

__device__ __forceinline__ unsigned pk2(float lo, float hi) { return (unsigned)f2bf(lo) | ((unsigned)f2bf(hi) << 16); }
struct TrItem { const float* W; int N, K, k0, n0, dst_row0; };
__device__ __forceinline__ void tr_load(const TrItem& it, f32x4 (&r)[8], int lane) {
#pragma unroll
  for (int i = 0; i < 8; ++i) r[i] = *(const f32x4*)(it.W + (size_t)(it.k0 + (lane >> 3) + 8 * i) * it.N + it.n0 + 4 * (lane & 7));
}
__device__ __forceinline__ void tr_store(const TrItem& it, const f32x4 (&r)[8], bf16_t* WT, LAS float* scr, int lane) {
#pragma unroll
  for (int i = 0; i < 8; ++i) { LAS float* d = scr + ((lane >> 3) + 8 * i) * 33 + 4 * (lane & 7); d[0] = r[i].x; d[1] = r[i].y; d[2] = r[i].z; d[3] = r[i].w; }
  LDS_WAIT(); asm volatile("" ::: "memory");
  const int c = lane & 7;
#pragma unroll
  for (int j = 0; j < 4; ++j) { const int n = (lane >> 3) + 8 * j; const LAS float* sp = scr + (8 * c) * 33 + n;
    u32x4 o; o.x = pk2(sp[0 * 33], sp[1 * 33]); o.y = pk2(sp[2 * 33], sp[3 * 33]); o.z = pk2(sp[4 * 33], sp[5 * 33]); o.w = pk2(sp[6 * 33], sp[7 * 33]);
    *(u32x4*)(WT + (size_t)(it.dst_row0 + n) * it.K + it.k0 + 8 * c) = o; }
  LDS_WAIT(); asm volatile("" ::: "memory");
}
__device__ __forceinline__ void transpose_matrix(const float* W, int K, int N, bf16_t* WT, LAS float* scr, int gw, int ngw, int lane) {
  const int nblk = N / 32, items = (K / 64) * nblk;
  f32x4 ra[8], rb[8]; TrItem ia, ib;
  int it = gw;
  if (it < items) { ia = TrItem{W, N, K, 64 * (it / nblk), 32 * (it % nblk), 32 * (it % nblk)}; tr_load(ia, ra, lane); }
  while (it < items) {
    const int nx = it + ngw;
    if (nx < items) { ib = TrItem{W, N, K, 64 * (nx / nblk), 32 * (nx % nblk), 32 * (nx % nblk)}; tr_load(ib, rb, lane); }
    tr_store(ia, ra, WT, scr, lane);
    if (nx < items) { ia = ib;
#pragma unroll
      for (int i = 0; i < 8; ++i) ra[i] = rb[i]; }
    it = nx;
  }
}
__device__ __forceinline__ void mod_row_to_bf16(const float* xr, const float* sc, const float* sh, bf16_t* orow, int lane) {
  const f32x4* x4 = (const f32x4*)xr + lane; const f32x4* c4 = (const f32x4*)sc + lane; const f32x4* h4 = (const f32x4*)sh + lane;
  unsigned long long* o8 = (unsigned long long*)orow + lane;
#pragma unroll
  for (int j = 0; j < 4; ++j) { const f32x4 v = x4[64 * j], c = c4[64 * j], h = h4[64 * j];
    const float a = v.x * (1.f + c.x) + h.x, b = v.y * (1.f + c.y) + h.y, cc = v.z * (1.f + c.z) + h.z, d = v.w * (1.f + c.w) + h.w;
    o8[64 * j] = (unsigned long long)pk2(a, b) | ((unsigned long long)pk2(cc, d) << 32); }
}


__device__ __forceinline__ float wave_sum(float v) {
#pragma unroll
  for (int o = 1; o < 64; o <<= 1) v += __shfl_xor(v, o);
  return v;
}
constexpr int CW_CNT = 8192;
#define CNT_WORD(layer, e) (CW_CNT + 64 * (MOE_E * (layer) + (e)))
#define LD4(dst, ptr) do { const f32x4* p4_ = (const f32x4*)(ptr) + lane; _Pragma("unroll") for (int j = 0; j < 4; ++j) dst[j] = p4_[64 * j]; } while (0)
constexpr int RT_CNT = 0, RT_WG = 256, RT_WE = RT_WG + D * 8;
__device__ __forceinline__ int rt_slot(int k) { return ((k & 3) * 4 + (k >> 8)) * 64 + ((k >> 2) & 63); }
__device__ __forceinline__ float bflo(unsigned w) { return __builtin_bit_cast(float, w << 16); }
__device__ __forceinline__ float bfhi(unsigned w) { return __builtin_bit_cast(float, w & 0xffff0000u); }
__device__ __forceinline__ void ln1_phase(const Params& p, int layer, int T, LAS unsigned char* lds, int gw, int ngw, int vcu, int lane, int tid) {
  LAS int* cnt_l = (LAS int*)(lds + RT_CNT);
  if (tid < MOE_E) cnt_l[tid] = 0;
  { const float* wg = p.moe_wg + (size_t)layer * D * MOE_G; const float* we = p.moe_we + (size_t)layer * MOE_G * D * MOE_EPG;
    for (int k = tid; k < D; k += NTHR) { const f32x4 w = *(const f32x4*)(wg + (size_t)k * 4); u32x2 o = {pk2(w.x, w.y), pk2(w.z, w.w)}; *(LAS u32x2*)(lds + RT_WG + rt_slot(k) * 8) = o; }
    for (int i = tid; i < MOE_G * D; i += NTHR) { const int g = i / D, k = i % D; const f32x4 a = *(const f32x4*)(we + (size_t)i * 8), b = *(const f32x4*)(we + (size_t)i * 8 + 4);
      u32x4 o = {pk2(a.x, a.y), pk2(a.z, a.w), pk2(b.x, b.y), pk2(b.z, b.w)}; *(LAS u32x4*)(lds + RT_WE + (g * D + rt_slot(k)) * 16) = o; } }
  __syncthreads();
  const int rpw = (T + ngw - 1) / ngw, t0 = gw * rpw;
  f32x4 g1[4], lg[4], lb[4], sc[4], sh[4]; int cur_r = -1;
  LD4(lg, p.ln1_g + (size_t)layer * D); LD4(lb, p.ln1_b + (size_t)layer * D);
  const int tend = (t0 + rpw < T) ? t0 + rpw : T;
#define LDY(dst, tt) do { const u32x2* y2_ = (const u32x2*)((const bf16_t*)p.F + (size_t)(tt) * D) + lane; _Pragma("unroll") for (int j = 0; j < 4; ++j) dst[j] = y2_[64 * j]; } while (0)
#define LDX16(dst, base, tt) do { const u32x2* x2_ = (const u32x2*)((const bf16_t*)(base) + (size_t)(tt) * D) + lane; _Pragma("unroll") for (int j = 0; j < 4; ++j) { const u32x2 w_ = x2_[64 * j]; dst[j] = (f32x4){bflo(w_.x), bfhi(w_.x), bflo(w_.y), bfhi(w_.y)}; } } while (0)
#define LDXR(dst, tt) do { if (layer == 0) LD4(dst, xrow(p, 0, tt)); else LDX16(dst, p.X, tt); } while (0)
  f32x4 xn[4]; u32x2 yn[4];
  if (t0 < tend) { LDXR(xn, t0); LDY(yn, t0); }
  for (int t = t0; t < tend; ++t) {
    const int r = tok_r(t);
    if (r != cur_r) { cur_r = r; LD4(g1, modp(p, layer, r, 2)); LD4(sc, modp(p, layer, r, 4)); LD4(sh, modp(p, layer, r, 3)); }
    f32x4 v[4], y[4];
#pragma unroll
    for (int j = 0; j < 4; ++j) { v[j] = xn[j]; y[j] = (f32x4){bflo(yn[j].x), bfhi(yn[j].x), bflo(yn[j].y), bfhi(yn[j].y)}; }
    if (t + 1 < tend) { LDXR(xn, t + 1); LDY(yn, t + 1); }
    float s = 0.f;
#pragma unroll
    for (int j = 0; j < 4; ++j) { v[j] = v[j] * ALPHA + g1[j] * y[j]; s += (v[j].x + v[j].y) + (v[j].z + v[j].w); }
    const float mean = wave_sum(s) * (1.f / D); float s2 = 0.f;
#pragma unroll
    for (int j = 0; j < 4; ++j) { v[j] = v[j] - mean; s2 += (v[j].x * v[j].x + v[j].y * v[j].y) + (v[j].z * v[j].z + v[j].w * v[j].w); }
    const float rstd = 1.f / sqrtf(wave_sum(s2) * (1.f / D) + LN_EPS);
    u32x2* o2 = (u32x2*)((bf16_t*)p.X1 + (size_t)t * D) + lane;
#pragma unroll
    for (int j = 0; j < 4; ++j) { v[j] = v[j] * rstd * lg[j] + lb[j]; o2[64 * j] = (u32x2){cvt_pk_bf16(v[j].x, v[j].y), cvt_pk_bf16(v[j].z, v[j].w)}; v[j] = v[j] * (sc[j] + 1.f) + sh[j]; }
    f32x4 gl = {0.f, 0.f, 0.f, 0.f};
#pragma unroll
    for (int j = 0; j < 4; ++j)
#pragma unroll
      for (int c = 0; c < 4; ++c) { const u32x2 w = *(const LAS u32x2*)(lds + RT_WG + ((4 * c + j) * 64 + lane) * 8); const float h = v[j][c];
        gl.x += h * bflo(w.x); gl.y += h * bfhi(w.x); gl.z += h * bflo(w.y); gl.w += h * bfhi(w.y); }
    float lgv[4];
#pragma unroll
    for (int g = 0; g < 4; ++g) lgv[g] = wave_sum(gl[g]) + p.moe_bg[layer * MOE_G + g];
    int gi = 0; float mx = lgv[0];
#pragma unroll
    for (int g = 1; g < 4; ++g) if (lgv[g] > mx) { mx = lgv[g]; gi = g; }
    float den = 0.f;
#pragma unroll
    for (int g = 0; g < 4; ++g) den += __expf(lgv[g] - mx);
    const float gp = 1.0f / den;
    gi = __builtin_amdgcn_readfirstlane(gi);
    f32x4 e0 = {0.f, 0.f, 0.f, 0.f}, e1 = {0.f, 0.f, 0.f, 0.f};
#pragma unroll
    for (int j = 0; j < 4; ++j)
#pragma unroll
      for (int c = 0; c < 4; ++c) { const u32x4 w = *(const LAS u32x4*)(lds + RT_WE + (gi * D + (4 * c + j) * 64 + lane) * 16); const float h = v[j][c];
        e0.x += h * bflo(w.x); e0.y += h * bfhi(w.x); e0.z += h * bflo(w.y); e0.w += h * bfhi(w.y);
        e1.x += h * bflo(w.z); e1.y += h * bfhi(w.z); e1.z += h * bflo(w.w); e1.w += h * bfhi(w.w); }
    float le[8];
#pragma unroll
    for (int e = 0; e < 4; ++e) { le[e] = wave_sum(e0[e]) + p.moe_be[(layer * MOE_G + gi) * MOE_EPG + e]; le[4 + e] = wave_sum(e1[e]) + p.moe_be[(layer * MOE_G + gi) * MOE_EPG + 4 + e]; }
    int i0 = 0; float v0 = le[0];
#pragma unroll
    for (int e = 1; e < 8; ++e) if (le[e] > v0) { v0 = le[e]; i0 = e; }
    int i1 = -1; float v1 = -3e38f;
#pragma unroll
    for (int e = 0; e < 8; ++e) if (e != i0 && le[e] > v1) { v1 = le[e]; i1 = e; }
    if (lane == 0) {
      const float ex = __expf(v1 - v0);
      const int ea = gi * MOE_EPG + i0, eb = gi * MOE_EPG + i1;
      const int pa = __hip_atomic_fetch_add(cnt_l + ea, 1, __ATOMIC_RELAXED, __HIP_MEMORY_SCOPE_WORKGROUP), pb = __hip_atomic_fetch_add(cnt_l + eb, 1, __ATOMIC_RELAXED, __HIP_MEMORY_SCOPE_WORKGROUP);
      float* rt = p.route + (size_t)t * 8;
      rt[0] = (float)ea; rt[1] = (float)eb; rt[2] = gp / (1.0f + ex); rt[3] = gp * ex / (1.0f + ex); rt[4] = (float)pa; rt[5] = (float)pb;
    }
  }
  __syncthreads();
  if (tid < MOE_E) { const int c = cnt_l[tid];
    const int base = c ? (int)__hip_atomic_fetch_add(p.ctl + CNT_WORD(layer, tid), (unsigned)c, __ATOMIC_RELAXED, __HIP_MEMORY_SCOPE_AGENT) : 0;
    p.wgbase[((size_t)layer * 1024 + vcu) * MOE_E + tid] = base; }
}
__device__ __forceinline__ void scatter_phase(const Params& p, int layer, int T, LAS unsigned char* lds, int gw, int ngw, int vcu, int lane, int tid) {
  LAS int* off = (LAS int*)lds;
  if (tid == 0) {
    int o = 0, ntile = 0;
    for (int e = 0; e < MOE_E; ++e) { const int c = (int)__hip_atomic_load(p.ctl + CNT_WORD(layer, e), __ATOMIC_RELAXED, __HIP_MEMORY_SCOPE_AGENT);
      off[e] = o + p.wgbase[((size_t)layer * 1024 + vcu) * MOE_E + e]; const int nt = (c + 255) >> 8;
      if (blockIdx.x == 0) for (int i = 0; i < nt; ++i) p.moe_meta[1 + ntile + i] = e;
      ntile += nt; o += nt * 256; }
    if (blockIdx.x == 0) p.moe_meta[0] = ntile;
  }
  __syncthreads();
  const int rpw = (T + ngw - 1) / ngw, t0 = gw * rpw;
  f32x4 sc[4], sh[4]; int cur_r = -1;
  const int tend = (t0 + rpw < T) ? t0 + rpw : T;
  f32x4 xn[4]; f32x4 rn0 = {0.f, 0.f, 0.f, 0.f}; f32x2 rn1 = {0.f, 0.f};
  if (t0 < tend) { LDX16(xn, p.X1, t0); rn0 = *(const f32x4*)(p.route + (size_t)t0 * 8); rn1 = *(const f32x2*)(p.route + (size_t)t0 * 8 + 4); }
  for (int t = t0; t < tend; ++t) {
    const int r = tok_r(t);
    if (r != cur_r) { cur_r = r; LD4(sc, modp(p, layer, r, 4)); LD4(sh, modp(p, layer, r, 3)); }
    const int ea = (int)rn0.x, eb = (int)rn0.y; const float wa = rn0.z, wb = rn0.w;
    const int sa = off[ea] + (int)rn1.x, sb = off[eb] + (int)rn1.y;
    f32x4 x[4];
#pragma unroll
    for (int j = 0; j < 4; ++j) x[j] = xn[j];
    if (t + 1 < tend) { LDX16(xn, p.X1, t + 1); rn0 = *(const f32x4*)(p.route + (size_t)(t + 1) * 8); rn1 = *(const f32x2*)(p.route + (size_t)(t + 1) * 8 + 4); }
    unsigned long long* oa = (unsigned long long*)(p.Amoe + (size_t)sa * D) + lane; unsigned long long* ob = (unsigned long long*)(p.Amoe + (size_t)sb * D) + lane;
#pragma unroll
    for (int j = 0; j < 4; ++j) { const f32x4 h = x[j] * (sc[j] + 1.f) + sh[j];
      const unsigned long long w = (unsigned long long)pk2(h.x, h.y) | ((unsigned long long)pk2(h.z, h.w) << 32); oa[64 * j] = w; ob[64 * j] = w; }
    if (lane == 0) { p.gate[sa] = wa; p.gate[sb] = wb; p.tokslot[2 * t] = sa; p.tokslot[2 * t + 1] = sb; }
  }
}
__device__ __forceinline__ void ln2_phase(const Params& p, int layer, int T, int gw, int ngw, int lane) {
  const int rpw = (T + ngw - 1) / ngw, t0 = gw * rpw;
  f32x4 g2[4], lg[4], lb[4], sc[4], sh[4]; int cur_r = -1;
  LD4(lg, p.ln2_g + (size_t)layer * D); LD4(lb, p.ln2_b + (size_t)layer * D);
  const int tend = (t0 + rpw < T) ? t0 + rpw : T;
  const int myslot = (2 * t0 + lane < 2 * tend) ? p.tokslot[2 * t0 + lane] : 0;
  f32x4 xn[4]; u32x2 an[4], bn[4];
#define LDF2(tt) do { const int sa_ = __shfl(myslot, 2 * ((tt) - t0)), sb_ = __shfl(myslot, 2 * ((tt) - t0) + 1); \
    const u32x2* fa_ = (const u32x2*)(p.F2 + (size_t)sa_ * D) + lane; const u32x2* fb_ = (const u32x2*)(p.F2 + (size_t)sb_ * D) + lane; \
    _Pragma("unroll") for (int j = 0; j < 4; ++j) { an[j] = fa_[64 * j]; bn[j] = fb_[64 * j]; } LDX16(xn, p.X1, tt); } while (0)
  if (t0 < tend) LDF2(t0);
  for (int t = t0; t < tend; ++t) {
    const int r = tok_r(t);
    if (r != cur_r) { cur_r = r; LD4(g2, modp(p, layer, r, 5)); if (layer + 1 < DEPTH) { LD4(sc, modp(p, layer + 1, r, 1)); LD4(sh, modp(p, layer + 1, r, 0)); } }
    f32x4 v[4]; u32x2 fa[4], fb[4];
#pragma unroll
    for (int j = 0; j < 4; ++j) { v[j] = xn[j]; fa[j] = an[j]; fb[j] = bn[j]; }
    if (t + 1 < tend) LDF2(t + 1);
    float s = 0.f;
#pragma unroll
    for (int j = 0; j < 4; ++j) { const u32x2 a = fa[j], b = fb[j];
      f32x4 f; f.x = bflo(a.x) + bflo(b.x); f.y = bfhi(a.x) + bfhi(b.x); f.z = bflo(a.y) + bflo(b.y); f.w = bfhi(a.y) + bfhi(b.y);
      v[j] = v[j] * ALPHA + g2[j] * f; s += (v[j].x + v[j].y) + (v[j].z + v[j].w); }
    const float mean = wave_sum(s) * (1.f / D); float s2 = 0.f;
#pragma unroll
    for (int j = 0; j < 4; ++j) { v[j] = v[j] - mean; s2 += (v[j].x * v[j].x + v[j].y * v[j].y) + (v[j].z * v[j].z + v[j].w * v[j].w); }
    const float rstd = 1.f / sqrtf(wave_sum(s2) * (1.f / D) + LN_EPS);
    if (layer == DEPTH - 1) {
      f32x4* o4 = (f32x4*)(p.out + (size_t)t * D) + lane;
#pragma unroll
      for (int j = 0; j < 4; ++j) o4[64 * j] = v[j] * rstd * lg[j] + lb[j];
    } else {
      u32x2* o2 = (u32x2*)((bf16_t*)p.X + (size_t)t * D) + lane;
      unsigned long long* h8 = (unsigned long long*)(p.H + (size_t)t * D) + lane;
#pragma unroll
      for (int j = 0; j < 4; ++j) { const f32x4 o = v[j] * rstd * lg[j] + lb[j]; o2[64 * j] = (u32x2){cvt_pk_bf16(o.x, o.y), cvt_pk_bf16(o.z, o.w)};
        const f32x4 h = o * (sc[j] + 1.f) + sh[j];
        h8[64 * j] = (unsigned long long)pk2(h.x, h.y) | ((unsigned long long)pk2(h.z, h.w) << 32); }
    }
  }
#undef LDF2
}
__device__ __forceinline__ void h0_phase(const Params& p, int gw, int ngw, int lane) {
  const int rpw = (TA + ngw - 1) / ngw, t0 = gw * rpw;
  f32x4 sc[4], sh[4]; int cur_r = -1;
  const int tend = (t0 + rpw < TA) ? t0 + rpw : TA;
  f32x4 xn[4], xm[4];
  if (t0 < tend) LD4(xn, xrow(p, 0, t0));
  if (t0 + 1 < tend) LD4(xm, xrow(p, 0, t0 + 1));
  for (int t = t0; t < tend; ++t) {
    const int r = tok_r(t);
    if (r != cur_r) { cur_r = r; LD4(sc, modp(p, 0, r, 1)); LD4(sh, modp(p, 0, r, 0)); }
    f32x4 x[4];
#pragma unroll
    for (int j = 0; j < 4; ++j) { x[j] = xn[j]; xn[j] = xm[j]; }
    if (t + 2 < tend) LD4(xm, xrow(p, 0, t + 2));
    unsigned long long* h8 = (unsigned long long*)(p.H + (size_t)t * D) + lane;
#pragma unroll
    for (int j = 0; j < 4; ++j) { const f32x4 h = x[j] * (sc[j] + 1.f) + sh[j]; h8[64 * j] = (unsigned long long)pk2(h.x, h.y) | ((unsigned long long)pk2(h.z, h.w) << 32); }
  }
}
__device__ __forceinline__ void moe_item(const Params& p, int layer, int it, TrItem& ti, bf16_t*& WT) {
  constexpr int I13 = (D / 64) * (MOE_F / 32), I2 = (MOE_F / 64) * (D / 32);
  const int e = it / (2 * I13 + I2); int r = it % (2 * I13 + I2);
  if (r < 2 * I13) { const int which = r / I13; r %= I13; const int kb = r / (MOE_F / 32), nb = r % (MOE_F / 32), n0 = 32 * nb;
    ti = TrItem{(which ? p.moe_w3 : p.moe_w1) + ((size_t)layer * MOE_E + e) * D * MOE_F, MOE_F, D, 64 * kb, n0, e * 2 * MOE_F + (n0 / 128) * 256 + which * 128 + (n0 % 128)}; WT = p.W13t;
  } else { r -= 2 * I13; const int kb = r / (D / 32), nb = r % (D / 32);
    ti = TrItem{p.moe_w2 + ((size_t)layer * MOE_E + e) * MOE_F * D, D, MOE_F, 64 * kb, 32 * nb, e * D + 32 * nb}; WT = p.W2t; }
}
__device__ __forceinline__ void moe_weight_transposes(const Params& p, int layer, LAS float* scr, int gw, int ngw, int lane) {
  constexpr int NIT = MOE_E * (2 * (D / 64) * (MOE_F / 32) + (MOE_F / 64) * (D / 32));
  f32x4 ra[8], rb[8]; TrItem ia, ib; bf16_t *wa = nullptr, *wb = nullptr;
  int it = gw;
  if (it < NIT) { moe_item(p, layer, it, ia, wa); tr_load(ia, ra, lane); }
  while (it < NIT) {
    const int nx = it + ngw;
    if (nx < NIT) { moe_item(p, layer, nx, ib, wb); tr_load(ib, rb, lane); }
    tr_store(ia, ra, wa, scr, lane);
    if (nx < NIT) { ia = ib; wa = wb;
#pragma unroll
      for (int i = 0; i < 8; ++i) ra[i] = rb[i]; }
    it = nx;
  }
}
__device__ __forceinline__ void mod_phase(const Params& p, LAS unsigned char* lds, int vcu, int G, int tid, int lane, int wave) {
  constexpr int NR = B + 1, RP = 12;
  LAS float* sT = (LAS float*)lds;
  LAS float* part = sT + D * RP;
  for (int i = tid; i < NR * D; i += NTHR) { const int r = i / D, k = i % D; const float c = r < B ? p.c[(size_t)r * D + k] : p.c_ctx[k]; sT[k * RP + r] = c / (1.0f + __expf(-c)); }
  __syncthreads();
  constexpr int NT_ = DEPTH * (6 * D / 64);
  for (int task = vcu; task < NT_; task += G) {
    const int l = task / (6 * D / 64), j = (task % (6 * D / 64)) * 64 + lane;
    const float* w = p.mod_w + (size_t)l * D * 6 * D + (size_t)(wave * 128) * 6 * D + j;
    float acc[NR];
#pragma unroll
    for (int r = 0; r < NR; ++r) acc[r] = 0.f;
#pragma unroll 1
    for (int k0 = 0; k0 < 128; k0 += 16) {
      float wv[16];
#pragma unroll
      for (int u = 0; u < 16; ++u) wv[u] = w[(size_t)(k0 + u) * 6 * D];
#pragma unroll
      for (int u = 0; u < 16; ++u) { const LAS float* sr = sT + (wave * 128 + k0 + u) * RP;
        const f32x4 s0 = *(const LAS f32x4*)sr, s1 = *(const LAS f32x4*)(sr + 4); const float s8 = sr[8];
        acc[0] += s0.x * wv[u]; acc[1] += s0.y * wv[u]; acc[2] += s0.z * wv[u]; acc[3] += s0.w * wv[u];
        acc[4] += s1.x * wv[u]; acc[5] += s1.y * wv[u]; acc[6] += s1.z * wv[u]; acc[7] += s1.w * wv[u]; acc[8] += s8 * wv[u]; }
    }
#pragma unroll
    for (int r = 0; r < NR; ++r) part[(wave * NR + r) * 64 + lane] = acc[r];
    __syncthreads();
    for (int i = tid; i < NR * 64; i += NTHR) { const int r = i / 64, c = i % 64; float v = p.mod_b[(size_t)l * 6 * D + (task % (6 * D / 64)) * 64 + c];
#pragma unroll
      for (int ww = 0; ww < 8; ++ww) v += part[(ww * NR + r) * 64 + c];
      p.modv[((size_t)(l * NR + r) * 6 * D) + (task % (6 * D / 64)) * 64 + c] = v; }
    __syncthreads();
  }
}

__global__ void __launch_bounds__(NTHR, 2) mega_kernel(Params p_by_value) {
  const Params& p = *(const Params*)__builtin_amdgcn_kernarg_segment_ptr();
  extern __shared__ __attribute__((aligned(16))) unsigned char lds_raw[];
  LAS unsigned char* lds = (LAS unsigned char*)lds_raw;
  volatile LAS unsigned* MISC = (volatile LAS unsigned*)(lds + MISC_OFF);
  for (int u = threadIdx.x; u < (LDS_BYTES - LDSCTL_OFF) / 4; u += NTHR) ((LAS unsigned*)(lds + LDSCTL_OFF))[u] = 0u;
  __syncthreads();
  XcdBarrier bar = xcd_barrier_post(p.ctl + CW_BAR, MISC + 8);
#define PH_VARS                                                                                                       \
  int tid = threadIdx.x; asm volatile("" : "+v"(tid));                                                                \
  int bx = blockIdx.x; asm volatile("" : "+s"(bx));                                                                   \
  const int lane = tid & 63, wave = __builtin_amdgcn_readfirstlane(tid >> 6), G = gridDim.x;                          \
  const int vcu = (G % 8 == 0) ? (bx % 8) * (G / 8) + bx / 8 : bx;                                                    \
  const int gw = vcu * NWAVES + wave, ngw = G * NWAVES;                                                               \
  LAS float* scr = (LAS float*)(lds + wave * 16384);                                                                  \
  (void)lane; (void)gw; (void)ngw; (void)scr; (void)vcu;
#define GRID_BAR() xcd_barrier(bar)
#define RUN_NAIVE(S, layer, cnt)                                                                                  \
  {                                                                                                               \
    const int n_ = (cnt);                                                                                         \
    PH_VARS                                                                                                       \
    for (int idx = bx * NTHR + tid; idx < n_; idx += G * NTHR) run_elem<S>(p, layer, idx);                        \
  }

  { PH_VARS mod_phase(p, lds, vcu, G, tid, lane, wave); }
  RUN_NAIVE(S_TABA, 0, N_TABA)
  { PH_VARS for (int idx = bx * NTHR + tid; idx < N_TAB16A; idx += G * NTHR) st_tab16a(p, idx); }
  { PH_VARS
  transpose_matrix(p.w_in_a, D, AB_IN, p.WinA_t, scr, gw, ngw, lane);
  transpose_matrix(p.dif_w_in, D, DIF_IN, p.DifIn_t, scr, gw, ngw, lane);
  transpose_matrix(p.w_out_a, AB_OUT, D, p.WoutA_t, scr, gw, ngw, lane);
  transpose_matrix(p.dif_w_out, DIF_VW, D, p.DifOut_t, scr, gw, ngw, lane);
  transpose_matrix(p.glu_w, SSM_W, SSM_W, p.Glu_t, scr, gw, ngw, lane); }
  GRID_BAR();
  { PH_VARS for (int idx = bx * NTHR + tid; idx < N_TAB16B; idx += G * NTHR) st_tab16b(p, idx); }
  { PH_VARS h0_phase(p, gw, ngw, lane); }
  GRID_BAR();
#define LAYER_BACK(layer, T, WOT_, KO_)                                                                                 \
  { PH_VARS                                                                    \
    pg8::Gemm g{p.Ymix, WOT_, YW, KO_, KO_};                                                                            \
    pg8::StaticOrder S; S.init(T, D, G, bx);                                                                            \
    EpiBf16Out E{(bf16_t*)p.F, D, 0};                                                                                   \
    pg8::gemm_phase<EpiBf16Out, pg8::StaticOrder>(lds, g, S, E);                                                        \
  }                                                                                                                     \
  GRID_BAR();                                                                                                           \
  { PH_VARS ln1_phase(p, layer, T, lds, gw, ngw, vcu, lane, tid); }                                                      \
  GRID_BAR();                                                                                                           \
  { PH_VARS scatter_phase(p, layer, T, lds, gw, ngw, vcu, lane, tid); }                                                 \
  GRID_BAR();                                                                                                           \
  { PH_VARS                                                             \
    pg8::Gemm g{p.Amoe, p.W13t, D, D, D};                                                                               \
    MoeOrder S; S.init(p.moe_meta, lds, 2, G, vcu, tid);                                                                     \
    EpiMoe1 E{p.HHb, p.gate};                                                                                           \
    pg8::gemm_phase<EpiMoe1, MoeOrder>(lds, g, S, E);                                                                   \
  }                                                                                                                     \
  GRID_BAR();                                                                                                           \
  { PH_VARS                                                                                  \
    pg8::Gemm g{p.HHb, p.W2t, MOE_F, MOE_F, MOE_F};                                                                     \
    MoeOrder S; S.init(p.moe_meta, lds, 4, G, vcu, tid);                                                                     \
    EpiBf16Out E{p.F2, D, 4};                                                                                           \
    pg8::gemm_phase<EpiBf16Out, MoeOrder>(lds, g, S, E);                                                                \
  }                                                                                                                     \
  GRID_BAR();                                                                                                           \
  { PH_VARS ln2_phase(p, layer, T, gw, ngw, lane); }
#define SWA_IF(cond, rank, first, cnt) { if (G == 256 && (cond) && (rank) < (cnt)) att::swa_unit(p, lds, (first) + (rank), tid); }

  { PH_VARS for (int idx = bx * NTHR + tid; idx < N_BTY + N_BTE; idx += G * NTHR) st_tab16c(p, idx); }
  { PH_VARS
    pg8::Gemm g{p.H, p.WinA_t, D, D, D};
    pg8::StaticOrder S; S.init(TA, AB_IN, G, bx);
    EpiProj E{p.P, AB_IN, SWA_QW + SWA_KVW, p.ropeT, p.A2};
    pg8::gemm_phase<EpiProj, pg8::StaticOrder>(lds, g, S, E);
    constexpr int NU_ = (TA / 256) * (AB_IN / 256);
    const int nlast = NU_ % G;
    if (nlast == 0) moe_weight_transposes(p, 0, scr, gw, ngw, lane);
    else if (bx >= nlast) moe_weight_transposes(p, 0, scr, (bx - nlast) * NWAVES + wave, (G - nlast) * NWAVES, lane);
  }
  GRID_BAR();
  { PH_VARS
    pg8::Gemm g{p.A2, p.BtE, A2K, 256, 256};
    SsmOrder S{0, 2 * SSM_G * 5, G, vcu};
    EpiE E{p.E16};
    pg8::gemm_phase<EpiE, SsmOrder>(lds, g, S, E);
    if (G != 256) { for (int L = vcu; L < att::SWA_UNITS; L += G) att::swa_unit(p, lds, L, tid); }
    SWA_IF(vcu >= 64, vcu - 64, 496, 80)
  }
  GRID_BAR();
  { PH_VARS ssm_carry_phase(p, bx, G, tid); SWA_IF(bx >= 64, bx - 64, 0, 192) }
  GRID_BAR();
  { PH_VARS
    pg8::Gemm g{p.A2, p.BtY, A2K, A2K, A2K};
    SsmOrder S{0, SSM_G * 5, G, vcu};
    EpiY<0> E{p.Ypart, p.P, p.ssm_d, p.Gs};
    pg8::gemm_phase<EpiY<0>, SsmOrder>(lds, g, S, E);
    SWA_IF(vcu >= 160, vcu - 160, 192, 96)
  }
  GRID_BAR();
  { PH_VARS
    pg8::Gemm g{p.A2, p.BtY, A2K, A2K, A2K};
    SsmOrder S{SSM_G * 5, SSM_G * 5, G, vcu};
    EpiY<1> E{p.Ypart, p.P, p.ssm_d, p.Gs};
    pg8::gemm_phase<EpiY<1>, SsmOrder>(lds, g, S, E);
    SWA_IF(vcu >= 160, vcu - 160, 288, 96)
  }
  GRID_BAR();
  { PH_VARS
    pg8::Gemm g{p.Gs, p.Glu_t, SSM_W, SSM_W, SSM_W};
    pg8::StaticOrder S; S.init(TA, SSM_W, G, bx);
    EpiGlu E{p.Gs, p.glu_b, p.Ymix, YW, SWA_QW};
    pg8::gemm_phase<EpiGlu, pg8::StaticOrder>(lds, g, S, E);
    SWA_IF(bx >= 144, bx - 144, 384, 112)
  }
  GRID_BAR();
  LAYER_BACK(0, TA, p.WoutA_t, AB_OUT)
  GRID_BAR();
  { PH_VARS
    pg8::Gemm g{p.H, p.DifIn_t, D, D, D};
    ProjOrder1 S; S.S0.init(TL, DIF_IN, G, bx); S.G = G; S.c = bx;
    EpiProj E{p.P, DIF_IN, 2 * DIF_QK, p.ropeT, nullptr};
    pg8::gemm_phase<EpiProj, ProjOrder1>(lds, g, S, E);
    constexpr int NU_ = ProjOrder1::NU;
    const int nlast = NU_ % G;
    if (nlast == 0) moe_weight_transposes(p, 1, scr, gw, ngw, lane);
    else if (bx >= nlast) moe_weight_transposes(p, 1, scr, (bx - nlast) * NWAVES + wave, (G - nlast) * NWAVES, lane);
  }
  GRID_BAR();
  { PH_VARS att::dif_phase2(p, lds, G, vcu, tid); }
  GRID_BAR();
  LAYER_BACK(1, TL, p.DifOut_t, DIF_VW)
}

extern "C" void kernel_launch(void* const* d_in, const int* in_sizes, int n_in, void* d_out, int out_size, void* d_ws,
                              size_t ws_size, hipStream_t stream) {
  static int grid = 0;
  if (grid == 0) {
    if (ws_layout().total > ws_size || n_in != 37 || out_size != TL * D) { fprintf(stderr, "kernel_launch: bad sizes (ws need %zu have %zu)\n", ws_layout().total, ws_size); grid = -1; return; }
    int dev = 0, cus = 0;
    if (hipGetDevice(&dev) != hipSuccess || hipDeviceGetAttribute(&cus, hipDeviceAttributeMultiprocessorCount, dev) != hipSuccess) { grid = -1; return; }
    if (hipFuncSetAttribute((const void*)mega_kernel, hipFuncAttributeMaxDynamicSharedMemorySize, LDS_BYTES) != hipSuccess) { fprintf(stderr, "kernel_launch: hipFuncSetAttribute failed\n"); grid = -1; return; }
    grid = cus;
  }
  if (grid < 0) return;
  Params p{};
  fill_inputs(p, d_in);
  p.out = (float*)d_out;
  fill_ws(p, (char*)d_ws);
  if (hipMemsetAsync((char*)d_ws + ws_layout().ctl, 0, CTL_BYTES, stream) != hipSuccess) { fprintf(stderr, "kernel_launch: memset failed\n"); return; }
  hipLaunchKernelGGL(mega_kernel, dim3(grid), dim3(NTHR), LDS_BYTES, stream, p);
  const hipError_t le = hipPeekAtLastError();
  if (le != hipSuccess) fprintf(stderr, "kernel_launch: launch failed: %s\n", hipGetErrorName(le));
}
#endif
```
